# Optimizing an MI355X kernel written in HIP

```python
import jax, jax.numpy as jnp
from jax import lax
import numpy as np

D_MODEL = 1024
BATCH = 32
SEQ = 2048
DEPTH = 2

RMS_EPS = 1e-6
GLA_HEADS = 4
GLA_KEY_DIM = 64
GLA_VALUE_DIM = 128
GLA_GATE_RANK = 16
GLA_GATE_NORMALIZER = 16.0
GLA_CHUNK = 64
LRU_WIDTH = 512
LRU_BLOCKS = 8
LRU_CONV_WIDTH = 4
LRU_C = 8.0
DIL_PATTERNS = ((128, 1), (512, 4), (2048, 16))
N_PATTERNS = 3
DIL_HEADS = 4
DIL_HEAD_DIM = 128
ATTN_BLOCK = 128
ROPE_THETA = 500000.0
ROPE_DIMS = DIL_HEAD_DIM // 4
N_BRANCHES = 3
BRANCH_WIDTH = 512
N_EXPERTS = 16
N_GROUPS = 4
EXPERTS_PER_GROUP = N_EXPERTS // N_GROUPS
TOPK_GROUPS = 1
TOP_K = 2
EXPERT_FF = 512
MOE_BLOCK = 256

IN_SPLITS = (GLA_HEADS * GLA_KEY_DIM, GLA_HEADS * GLA_KEY_DIM, GLA_HEADS * GLA_VALUE_DIM,
             GLA_HEADS * GLA_VALUE_DIM, GLA_GATE_RANK, LRU_WIDTH, LRU_WIDTH,
             3 * N_PATTERNS * DIL_HEADS * DIL_HEAD_DIM, N_BRANCHES * D_MODEL)
IN_COLS = sum(IN_SPLITS)

kernel_name = 'hybrid_gla_rglru_dilated_moe'


def rmsnorm(x, gain):
    xf = x.astype(jnp.float32)
    y = xf * lax.rsqrt(jnp.mean(xf * xf, axis=-1, keepdims=True) + RMS_EPS)
    return (y * gain.astype(jnp.float32)).astype(x.dtype)


def gla_branch(q, k, v, og, g_low, w_gate_up, b_gate, out_gain):
    B, S, _ = q.shape
    H, DK, DV, C = GLA_HEADS, GLA_KEY_DIM, GLA_VALUE_DIM, GLA_CHUNK
    N = S // C
    f32 = jnp.float32
    log_alpha = jax.nn.log_sigmoid(jnp.einsum('bsr,rk->bsk', g_low, w_gate_up).astype(f32)
                                   + b_gate.astype(f32)) / GLA_GATE_NORMALIZER

    def to_chunks(t, d):
        return t.astype(f32).reshape(B, N, C, H, d).transpose(0, 3, 1, 2, 4)

    qc = to_chunks(q, DK) * (DK ** -0.5)
    kc = to_chunks(k, DK)
    vc = to_chunks(v, DV)
    cum = jnp.cumsum(to_chunks(log_alpha, DK), axis=3)
    q_dec = qc * jnp.exp(cum)
    k_inv = kc * jnp.exp(-cum)
    causal = jnp.tril(jnp.ones((C, C), dtype=bool))
    scores = jnp.where(causal, jnp.einsum('bhnid,bhnjd->bhnij', q_dec, k_inv), 0.0)
    o_intra = jnp.einsum('bhnij,bhnjv->bhniv', scores, vc)
    total = cum[:, :, :, -1]
    kv_chunk = jnp.einsum('bhncd,bhncv->bhndv', kc * jnp.exp(total[:, :, :, None] - cum), vc)

    def step(state, inp):
        decay, kv = inp
        return state * jnp.exp(decay)[..., None] + kv, state

    init = jnp.zeros((B, H, DK, DV), f32)
    _, prev = lax.scan(step, init, (jnp.moveaxis(total, 2, 0), jnp.moveaxis(kv_chunk, 2, 0)))
    prev = jnp.moveaxis(prev, 0, 2)
    o = o_intra + jnp.einsum('bhncd,bhndv->bhncv', q_dec, prev)
    o = o.transpose(0, 2, 3, 1, 4).reshape(B, S, H, DV).astype(v.dtype)
    o = rmsnorm(o, out_gain).reshape(B, S, H * DV)
    return o * jax.nn.silu(og)


def rglru_branch(xb, yb, conv_w, conv_b, w_a, b_a, w_x, b_x, lam):
    B, S, W = xb.shape
    f32 = jnp.float32
    xc = lax.conv_general_dilated(xb, conv_w[:, None, :], window_strides=(1,),
                                  padding=((LRU_CONV_WIDTH - 1, 0),),
                                  dimension_numbers=('NWC', 'WIO', 'NWC'),
                                  feature_group_count=W) + conv_b
    xg = xc.reshape(B, S, LRU_BLOCKS, W // LRU_BLOCKS)
    r = jax.nn.sigmoid(jnp.einsum('bsnc,ncd->bsnd', xg, w_a).reshape(B, S, W).astype(f32) + b_a.astype(f32))
    i = jax.nn.sigmoid(jnp.einsum('bsnc,ncd->bsnd', xg, w_x).reshape(B, S, W).astype(f32) + b_x.astype(f32))
    log_a = -LRU_C * r * jax.nn.softplus(-lam.astype(f32))
    a = jnp.exp(log_a)
    u = jnp.sqrt(-jnp.expm1(2.0 * log_a)) * i * xc.astype(f32)

    def combine(left, right):
        a_l, h_l = left
        a_r, h_r = right
        return a_l * a_r, a_r * h_l + h_r

    _, h = lax.associative_scan(combine, (a, u), axis=1)
    return (h * jax.nn.gelu(yb.astype(f32))).astype(xb.dtype)


def partial_rope(t, positions):
    half = ROPE_DIMS // 2
    f32 = jnp.float32
    inv_freq = ROPE_THETA ** (-jnp.arange(half, dtype=f32) / half)
    ang = positions.astype(f32)[:, :, None] * inv_freq
    cos = jnp.cos(ang)[:, :, None, None, :]
    sin = jnp.sin(ang)[:, :, None, None, :]
    tf = t.astype(f32)
    x1 = tf[..., :half]
    x2 = tf[..., half:ROPE_DIMS]
    return jnp.concatenate([x1 * cos - x2 * sin, x2 * cos + x1 * sin, tf[..., ROPE_DIMS:]],
                           axis=-1).astype(t.dtype)


def banded_causal_attention(q, k, v, span):
    Bp, L, H, Dh = q.shape
    BLK = ATTN_BLOCK
    nb = -(-L // BLK)
    pad = nb * BLK - L
    f32 = jnp.float32

    def blocks(t):
        return jnp.pad(t.astype(f32), ((0, 0), (0, pad), (0, 0), (0, 0))).reshape(Bp, nb, BLK, H, Dh)

    def with_prev(t):
        prev = jnp.pad(t, ((0, 0), (1, 0), (0, 0), (0, 0), (0, 0)))[:, :-1]
        return jnp.concatenate([prev, t], axis=2)

    qb = blocks(q)
    kk = with_prev(blocks(k))
    vv = with_prev(blocks(v))
    s = jnp.einsum('bnqhd,bnkhd->bnhqk', qb, kk) * (Dh ** -0.5)
    qi = jnp.arange(BLK)[:, None]
    kj = jnp.arange(2 * BLK)[None, :]
    dist = qi + BLK - kj
    band = (dist >= 0) & (dist <= span)
    first = jnp.arange(nb)[:, None, None] == 0
    valid = band[None] & ~(first & (kj < BLK)[None])
    s = jnp.where(valid[None, :, None], s, -jnp.inf)
    m = jnp.max(s, axis=-1, keepdims=True)
    p = jnp.exp(s - m)
    denom = jnp.sum(p, axis=-1)
    o = jnp.einsum('bnhqk,bnkhd->bnqhd', p, vv) / jnp.transpose(denom, (0, 1, 3, 2))[..., None]
    lse = jnp.transpose(m[..., 0] + jnp.log(denom), (0, 1, 3, 2))
    return o.reshape(Bp, nb * BLK, H, Dh)[:, :L], lse.reshape(Bp, nb * BLK, H)[:, :L]


def stride_gather(t, dil):
    B, S, H, Dh = t.shape
    return t.reshape(B, S // dil, dil, H, Dh).transpose(0, 2, 1, 3, 4).reshape(B * dil, S // dil, H, Dh)


def stride_scatter(t, B, dil):
    L = t.shape[1]
    rest = t.shape[2:]
    t = t.reshape((B, dil, L) + rest)
    t = jnp.moveaxis(t, 1, 2)
    return t.reshape((B, L * dil) + rest)


def dilated_branch(q, k, v, positions, q_gain, k_gain):
    B, S, P, H, Dh = q.shape
    q = partial_rope(rmsnorm(q, q_gain), positions)
    k = partial_rope(rmsnorm(k, k_gain), positions)
    outs, lses = [], []
    for p, (window, dil) in enumerate(DIL_PATTERNS):
        o, lse = banded_causal_attention(stride_gather(q[:, :, p], dil), stride_gather(k[:, :, p], dil),
                                         stride_gather(v[:, :, p], dil), window // dil)
        outs.append(stride_scatter(o, B, dil))
        lses.append(stride_scatter(lse, B, dil))
    w = jax.nn.softmax(jnp.stack(lses, axis=-1), axis=-1)
    o = jnp.einsum('bshpd,bshp->bshd', jnp.stack(outs, axis=3), w)
    return o.reshape(B, S, H * Dh).astype(v.dtype)


def mixer_block(h, positions, w_in, gla_gate_up, gla_gate_bias, gla_out_gain, lru_conv_w, lru_conv_b,
                lru_w_a, lru_b_a, lru_w_x, lru_b_x, lru_lambda, q_norm_gain, k_norm_gain, w_branch, w_out):
    B, S, D = h.shape
    proj = jnp.einsum('bsd,de->bse', h, w_in)
    cuts = np.cumsum(IN_SPLITS)[:-1].tolist()
    q_a, k_a, v_a, og_a, glow_a, x_b, y_b, qkv_c, gate_logits = jnp.split(proj, cuts, axis=-1)
    br_a = gla_branch(q_a, k_a, v_a, og_a, glow_a, gla_gate_up, gla_gate_bias, gla_out_gain)
    br_b = rglru_branch(x_b, y_b, lru_conv_w, lru_conv_b, lru_w_a, lru_b_a, lru_w_x, lru_b_x, lru_lambda)
    qkv = qkv_c.reshape(B, S, 3, N_PATTERNS, DIL_HEADS, DIL_HEAD_DIM)
    br_c = dilated_branch(qkv[:, :, 0], qkv[:, :, 1], qkv[:, :, 2], positions, q_norm_gain, k_norm_gain)
    gates = jax.nn.sigmoid(gate_logits.astype(jnp.float32)).reshape(B, S, N_BRANCHES, D)
    merged = sum(gates[:, :, n] * jnp.einsum('bsw,wd->bsd', br, w_branch[n]).astype(jnp.float32)
                 for n, br in enumerate((br_a, br_b, br_c)))
    return jnp.einsum('bsd,de->bse', merged.astype(h.dtype), w_out)


def moe_ffn(h, router_w, router_b, w_gate, w_up, w_down):
    B, S, D = h.shape
    T = B * S
    TK = T * TOP_K
    xt = h.reshape(T, D)
    logits = jnp.einsum('td,de->te', xt, router_w).astype(jnp.float32) + router_b.astype(jnp.float32)
    scores = jax.nn.softmax(logits, axis=-1)
    group_score = lax.top_k(scores.reshape(T, N_GROUPS, EXPERTS_PER_GROUP), TOP_K)[0].sum(-1)
    _, gsel = lax.top_k(group_score, TOPK_GROUPS)
    gmask = jnp.any(gsel[..., None] == jnp.arange(N_GROUPS), axis=-2)
    emask = jnp.repeat(gmask, EXPERTS_PER_GROUP, axis=-1)
    topw, topi = lax.top_k(jnp.where(emask, scores, -jnp.inf), TOP_K)
    topw = topw / jnp.sum(topw, axis=-1, keepdims=True)
    flat_e = topi.reshape(TK)
    order = jnp.argsort(flat_e)
    sorted_e = flat_e[order]
    tok = order // TOP_K
    counts = jnp.bincount(flat_e, length=N_EXPERTS)
    starts = jnp.cumsum(counts) - counts
    padded = (counts + MOE_BLOCK - 1) // MOE_BLOCK * MOE_BLOCK
    pad_ends = jnp.cumsum(padded)
    pad_starts = pad_ends - padded
    dest = pad_starts[sorted_e] + jnp.arange(TK) - starts[sorted_e]
    n_rows = TK + N_EXPERTS * MOE_BLOCK
    n_blocks = n_rows // MOE_BLOCK
    xs = jnp.zeros((n_rows, D), h.dtype).at[dest].set(xt[tok])
    block_e = jnp.minimum(jnp.searchsorted(pad_ends, jnp.arange(n_blocks) * MOE_BLOCK, side='right'),
                          N_EXPERTS - 1)

    def expert_rows(args):
        xb, e = args
        return (jax.nn.silu(xb @ w_gate[e]) * (xb @ w_up[e])) @ w_down[e]

    ys = lax.map(expert_rows, (xs.reshape(n_blocks, MOE_BLOCK, D), block_e)).reshape(n_rows, D)
    contrib = ys[dest] * topw.reshape(TK)[order][:, None].astype(ys.dtype)
    return jax.ops.segment_sum(contrib, tok, num_segments=T).reshape(B, S, D)


def setup_inputs(seed: int = 0) -> dict:
    key = jax.random.key(seed)
    ks = jax.random.split(key, 26)
    f32 = jnp.float32
    nrm = lambda k, shape, scale: jax.random.normal(k, shape, f32) * scale
    W = LRU_WIDTH
    u = jax.random.uniform(ks[13], (DEPTH, W), f32, minval=0.9, maxval=0.999) ** (1.0 / LRU_C)
    offsets = jax.random.randint(ks[1], (BATCH, 1), 0, 4096, dtype=jnp.int32)
    res_scale = (2 * DEPTH) ** -0.5
    return {
        'x': nrm(ks[0], (BATCH, SEQ, D_MODEL), 1.0),
        'positions': offsets + jnp.arange(SEQ, dtype=jnp.int32)[None, :],
        'norm1_gain': 1.0 + nrm(ks[2], (DEPTH, D_MODEL), 0.02),
        'w_in': nrm(ks[3], (DEPTH, D_MODEL, IN_COLS), D_MODEL ** -0.5),
        'gla_gate_up': nrm(ks[4], (DEPTH, GLA_GATE_RANK, GLA_HEADS * GLA_KEY_DIM), GLA_GATE_RANK ** -0.5),
        'gla_gate_bias': nrm(ks[5], (DEPTH, GLA_HEADS * GLA_KEY_DIM), 0.1),
        'gla_out_gain': 1.0 + nrm(ks[6], (DEPTH, GLA_VALUE_DIM), 0.02),
        'lru_conv_w': nrm(ks[7], (DEPTH, LRU_CONV_WIDTH, W), LRU_CONV_WIDTH ** -0.5),
        'lru_conv_b': nrm(ks[8], (DEPTH, W), 0.02),
        'lru_w_a': nrm(ks[9], (DEPTH, LRU_BLOCKS, W // LRU_BLOCKS, W // LRU_BLOCKS), (W // LRU_BLOCKS) ** -0.5),
        'lru_b_a': nrm(ks[10], (DEPTH, W), 0.02),
        'lru_w_x': nrm(ks[11], (DEPTH, LRU_BLOCKS, W // LRU_BLOCKS, W // LRU_BLOCKS), (W // LRU_BLOCKS) ** -0.5),
        'lru_b_x': nrm(ks[12], (DEPTH, W), 0.02),
        'lru_lambda': jnp.log(u) - jnp.log1p(-u),
        'q_norm_gain': 1.0 + nrm(ks[14], (DEPTH, DIL_HEAD_DIM), 0.02),
        'k_norm_gain': 1.0 + nrm(ks[15], (DEPTH, DIL_HEAD_DIM), 0.02),
        'w_branch': nrm(ks[16], (DEPTH, N_BRANCHES, BRANCH_WIDTH, D_MODEL), BRANCH_WIDTH ** -0.5),
        'w_out': nrm(ks[17], (DEPTH, D_MODEL, D_MODEL), D_MODEL ** -0.5 * res_scale),
        'norm2_gain': 1.0 + nrm(ks[18], (DEPTH, D_MODEL), 0.02),
        'router_w': nrm(ks[19], (D_MODEL, N_EXPERTS), D_MODEL ** -0.5),
        'router_b': nrm(ks[20], (N_EXPERTS,), 0.01),
        'w_gate': nrm(ks[21], (DEPTH, N_EXPERTS, D_MODEL, EXPERT_FF), D_MODEL ** -0.5),
        'w_up': nrm(ks[22], (DEPTH, N_EXPERTS, D_MODEL, EXPERT_FF), D_MODEL ** -0.5),
        'w_down': nrm(ks[23], (DEPTH, N_EXPERTS, EXPERT_FF, D_MODEL), EXPERT_FF ** -0.5 * res_scale),
    }


def reference(x, positions, norm1_gain, w_in, gla_gate_up, gla_gate_bias, gla_out_gain, lru_conv_w,
              lru_conv_b, lru_w_a, lru_b_a, lru_w_x, lru_b_x, lru_lambda, q_norm_gain, k_norm_gain,
              w_branch, w_out, norm2_gain, router_w, router_b, w_gate, w_up, w_down):
    for l in range(DEPTH):
        h = rmsnorm(x, norm1_gain[l])
        x = x + mixer_block(h, positions, w_in[l], gla_gate_up[l], gla_gate_bias[l], gla_out_gain[l],
                            lru_conv_w[l], lru_conv_b[l], lru_w_a[l], lru_b_a[l], lru_w_x[l], lru_b_x[l],
                            lru_lambda[l], q_norm_gain[l], k_norm_gain[l], w_branch[l], w_out[l])
        h = rmsnorm(x, norm2_gain[l])
        x = x + moe_ffn(h, router_w, router_b, w_gate[l], w_up[l], w_down[l])
    return x
```

```cpp
#include <hip/hip_runtime.h>
#include <cstdio>
#include <cstdint>

#define LAS __attribute__((address_space(3)))
#define GAS __attribute__((address_space(1)))
typedef unsigned short bf16_t;
typedef short bf16x8 __attribute__((ext_vector_type(8)));
typedef float f32x4 __attribute__((ext_vector_type(4)));
typedef float f32x2 __attribute__((ext_vector_type(2)));
typedef unsigned u32x4 __attribute__((ext_vector_type(4)));
typedef unsigned u32x2 __attribute__((ext_vector_type(2)));

namespace pg8 {
constexpr int BM = 256, BK = 64, HALF = 128, HTB = HALF * BK * 2, STAGE_BYTES = 8 * HTB, NXCD = 8, WGM = 8;
__host__ __device__ __forceinline__ int lds_byte(int r, int c) { const int st = (r >> 4) * 2 + (c >> 5), rr = r & 15, cc = c & 31, ob = rr * 64 + cc * 2; return st * 1024 + (ob ^ (((ob >> 9) & 1) << 5)); }
__host__ __device__ __forceinline__ void stage_rc(int b, int& R, int& C) { const int st = b / 1024, sb = b % 1024, swz = sb ^ (((sb >> 9) & 1) << 5); R = (st >> 1) * 16 + swz / 64; C = (st & 1) * 32 + (swz % 64) / 2; }
__host__ __device__ __forceinline__ int perm32(int rho) { const int n = rho >> 4, i = rho & 15; return 8 * (i >> 2) + 4 * n + (i & 3); }

struct Unit { int pm, pn, g; };

__device__ __forceinline__ bool static_tile(int nM, int nN, int G, int c, int i, int& pm, int& pn) {
    const int nwg = nM * nN; const long L = (long)i * G + c; if (L >= nwg) return false;
    int wgid = (int)L; { const int q = nwg / NXCD, r = nwg % NXCD, xcd = wgid % NXCD, off = wgid / NXCD; wgid = (xcd < r ? xcd * (q + 1) : r * (q + 1) + (xcd - r) * q) + off; }
    const int nig = WGM * nN, gid = wgid / nig, fm = gid * WGM, gsz = (nM - fm) < WGM ? (nM - fm) : WGM;
    pm = fm + ((wgid % nig) % gsz); pn = (wgid % nig) / gsz; return true;
}
__device__ __forceinline__ unsigned cvt_pk_bf16(float lo, float hi) { unsigned r; asm volatile("v_cvt_pk_bf16_f32 %0, %1, %2" : "=v"(r) : "v"(lo), "v"(hi)); return r; }

template <class Epi, class Sched, bool GATHER>
__device__ __forceinline__ void gemm_phase(LAS unsigned char* lds, const Sched& S, const Epi& E, const int K, const int lda) {
    int tid_ = threadIdx.x; asm volatile("" : "+v"(tid_));
    const int tid = tid_, wid = __builtin_amdgcn_readfirstlane(tid >> 6), lane = tid & 63, wr = wid >> 2, wc = wid & 3, fr = lane & 15, fq = lane >> 4;
    const int nt = K / BK;
    int sR[2], sC[2];
    unsigned voffB[2], voffA[2], vAc[2][2], vAn[2][2];
#pragma unroll
    for (int i = 0; i < 2; ++i) { int R, C; stage_rc(tid * 16 + i * 8192, R, C); sR[i] = R; sC[i] = C; const int Rb = Epi::PERM ? ((R & ~31) + perm32(R & 31)) : R;
        voffB[i] = (unsigned)(Rb * K + C) * 2u; voffA[i] = (unsigned)(R * lda + C) * 2u; }
    const size_t kstep = (size_t)(BK * 2);
    const size_t hstepB = (size_t)HALF * K * 2, hstepA = (size_t)HALF * lda * 2;
    const unsigned ldsw = (unsigned)wid * 1024u;
    const int aoff = lds_byte(wr * 64 + fr, fq * 8), boff = lds_byte(wc * 32 + fr, fq * 8);
#define PG8_SA(b, h) (((b) * 2 + (h)) * HTB)
#define PG8_SB(b, h) ((4 + (b) * 2 + (h)) * HTB)
#define PG8_STAGE(bufoff, gbase, voff) do { _Pragma("unroll") for (int _i = 0; _i < 2; ++_i) \
        __builtin_amdgcn_global_load_lds((const unsigned*)((const char*)(gbase) + (voff)[_i]), (LAS unsigned*)(lds + (bufoff) + ldsw + _i * 8192), 16, 0, 0); } while (0)
#define PG8_LDA(dst, b, h) do { _Pragma("unroll") for (int m = 0; m < 4; ++m) _Pragma("unroll") for (int k = 0; k < 2; ++k) dst[m][k] = *(const LAS bf16x8*)(lds + PG8_SA(b, h) + aoff + m * 2048 + k * 1024); } while (0)
#define PG8_LDB(dst, b, h) do { _Pragma("unroll") for (int n = 0; n < 2; ++n) _Pragma("unroll") for (int k = 0; k < 2; ++k) dst[n][k] = *(const LAS bf16x8*)(lds + PG8_SB(b, h) + boff + n * 2048 + k * 1024); } while (0)
#define PG8_MMA(ai, bj, At, Bt) do { __builtin_amdgcn_s_setprio(1); _Pragma("unroll") for (int m = 0; m < 4; ++m) _Pragma("unroll") for (int n = 0; n < 2; ++n) _Pragma("unroll") for (int k = 0; k < 2; ++k) \
        acc[ai][bj][m][n] = __builtin_amdgcn_mfma_f32_16x16x32_bf16(Bt[n][k], At[m][k], acc[ai][bj][m][n], 0, 0, 0); __builtin_amdgcn_s_setprio(0); } while (0)
#define PG8_WAIT_V(n) asm volatile("s_waitcnt vmcnt(" #n ")" ::: "memory")
#define PG8_WAIT_L(n) asm volatile("s_waitcnt lgkmcnt(" #n ")" ::: "memory")
#define PG8_BAR __builtin_amdgcn_s_barrier()
#define PG8_SCHED __builtin_amdgcn_sched_barrier(0)
#define PG8_AOFF(dst, u) do { if constexpr (GATHER) { _Pragma("unroll") for (int _h = 0; _h < 2; ++_h) _Pragma("unroll") for (int _i = 0; _i < 2; ++_i) \
        dst[_h][_i] = S.arow(u, _h * HALF + sR[_i]) + (unsigned)sC[_i] * 2u; } } while (0)
#define PG8_STAGE_A(bufoff, gptr, h, usenext) do { if constexpr (GATHER) { _Pragma("unroll") for (int _i = 0; _i < 2; ++_i) { const unsigned _vo = (usenext) ? vAn[h][_i] : vAc[h][_i]; \
        __builtin_amdgcn_global_load_lds((const unsigned*)((const char*)(gptr) + _vo), (LAS unsigned*)(lds + (bufoff) + ldsw + _i * 8192), 16, 0, 0); } } \
        else { PG8_STAGE(bufoff, (gptr) + (h) * hstepA, voffA); } } while (0)
    Unit cur, nxt; int ui = 0;
    if (!S.next(0, cur)) return;
    f32x4 acc[2][2][4][2];
#pragma unroll
    for (int a = 0; a < 2; ++a)
#pragma unroll
        for (int b = 0; b < 2; ++b)
#pragma unroll
            for (int m = 0; m < 4; ++m)
#pragma unroll
                for (int n = 0; n < 2; ++n) acc[a][b][m][n] = (f32x4){0.f, 0.f, 0.f, 0.f};
    bf16x8 At[4][2], B0[2][2], B1[2][2];
    const char* cA = S.aptr(cur); const char* cB = S.bptr(cur);
    PG8_AOFF(vAc, cur);
    PG8_STAGE(PG8_SB(0, 0), cB, voffB); PG8_STAGE(PG8_SB(0, 1), cB + hstepB, voffB); PG8_STAGE_A(PG8_SA(0, 0), cA, 0, false); PG8_STAGE_A(PG8_SA(0, 1), cA, 1, false);
    if (wr == 1) PG8_BAR;
    PG8_WAIT_V(2); PG8_BAR;
    PG8_STAGE(PG8_SB(1, 0), cB + kstep, voffB); PG8_STAGE_A(PG8_SA(1, 0), cA + kstep, 0, false); PG8_STAGE(PG8_SB(1, 1), cB + hstepB + kstep, voffB);
    PG8_WAIT_V(6); PG8_BAR;
    for (;;) {
        const bool has_next = S.next(ui + 1, nxt);
        const char* nA = has_next ? S.aptr(nxt) : cA; const char* nB = has_next ? S.bptr(nxt) : cB;
        if constexpr (GATHER) { if (has_next) { PG8_AOFF(vAn, nxt); } else {
#pragma unroll
            for (int h = 0; h < 2; ++h)
#pragma unroll
                for (int i = 0; i < 2; ++i) vAn[h][i] = vAc[h][i]; } }
        for (int t = 0; t < nt; t += 2) {
            const bool last = (t == nt - 2);
            const char* a1 = cA + (size_t)(t + 1) * kstep;
            const char* a2 = last ? nA : cA + (size_t)(t + 2) * kstep; const char* b2 = last ? nB : cB + (size_t)(t + 2) * kstep;
            const char* a3 = a2 + kstep; const char* b3 = b2 + kstep;
            PG8_LDB(B0, 0, 0); PG8_LDB(B1, 0, 1); PG8_SCHED; PG8_LDA(At, 0, 0); PG8_STAGE_A(PG8_SA(1, 1), a1, 1, false);
            PG8_WAIT_V(8); PG8_WAIT_L(0); PG8_BAR; PG8_MMA(0, 0, At, B0); PG8_MMA(0, 1, At, B1); PG8_BAR; PG8_SCHED;
            PG8_LDA(At, 0, 1); PG8_STAGE(PG8_SB(0, 0), b2, voffB); PG8_STAGE(PG8_SB(0, 1), b2 + hstepB, voffB); PG8_STAGE_A(PG8_SA(0, 0), a2, 0, last);
            PG8_WAIT_V(8); PG8_WAIT_L(0); PG8_BAR; PG8_MMA(1, 0, At, B0); PG8_MMA(1, 1, At, B1); PG8_BAR; PG8_SCHED;
            PG8_LDB(B0, 1, 0); PG8_LDB(B1, 1, 1); PG8_SCHED; PG8_LDA(At, 1, 0); PG8_STAGE_A(PG8_SA(0, 1), a2, 1, last);
            PG8_WAIT_V(8); PG8_WAIT_L(0); PG8_BAR; PG8_MMA(0, 0, At, B0); PG8_MMA(0, 1, At, B1); PG8_BAR; PG8_SCHED;
            PG8_LDA(At, 1, 1); PG8_STAGE(PG8_SB(1, 0), b3, voffB); PG8_STAGE(PG8_SB(1, 1), b3 + hstepB, voffB); PG8_STAGE_A(PG8_SA(1, 0), a3, 0, last);
            PG8_WAIT_V(8); PG8_WAIT_L(0); PG8_BAR; PG8_MMA(1, 0, At, B0); PG8_MMA(1, 1, At, B1); PG8_BAR; PG8_SCHED;
        }
        if (wr == 0) PG8_BAR;
        E(acc, cur, wr, wc, fr, fq);
        if (!has_next) break;
#pragma unroll
        for (int a = 0; a < 2; ++a)
#pragma unroll
            for (int b = 0; b < 2; ++b)
#pragma unroll
                for (int m = 0; m < 4; ++m)
#pragma unroll
                    for (int n = 0; n < 2; ++n) acc[a][b][m][n] = (f32x4){0.f, 0.f, 0.f, 0.f};
        cur = nxt; cA = nA; cB = nB; ++ui;
        if constexpr (GATHER) {
#pragma unroll
        for (int h = 0; h < 2; ++h)
#pragma unroll
            for (int i = 0; i < 2; ++i) vAc[h][i] = vAn[h][i]; }
        if (wr == 1) PG8_BAR;
    }
    PG8_WAIT_V(0);
    PG8_BAR;
#undef PG8_SA
#undef PG8_SB
#undef PG8_STAGE
#undef PG8_LDA
#undef PG8_LDB
#undef PG8_MMA
#undef PG8_WAIT_V
#undef PG8_WAIT_L
#undef PG8_BAR
#undef PG8_SCHED
#undef PG8_AOFF
#undef PG8_STAGE_A
}
}

constexpr int D = 1024, BATCH = 32, SEQ = 2048, DEPTH = 2;
constexpr int NCH = 2, BC = BATCH / NCH, TC = BC * SEQ;
constexpr int NP = 10496;
constexpr int C_QA = 0, C_KA = 256, C_VA = 512, C_OG = 1024, C_GP = 1536, C_XB = 1792, C_YB = 2304, C_QKV = 2816, C_G = 7424;
constexpr int WIN_N = 10256;
constexpr int NE = 16, FF = 512;
constexpr int RP = 2 * TC + NE * 256;
constexpr float RMS_EPS = 1e-6f;
constexpr int NWAVES = 8, NTHR = 512;

constexpr size_t MiB = 1u << 20;
constexpr size_t WS_CTL = 0, CTL_ZERO_BYTES = 1 * MiB;
constexpr size_t WS_REC = 1 * MiB;
constexpr size_t WS_LIST = 2 * MiB;
constexpr size_t WS_W = 4 * MiB;
constexpr size_t LW_WIN = 0, LW_WBR = LW_WIN + (size_t)NP * D * 2, LW_WOUT = LW_WBR + (size_t)3 * D * 512 * 2, LW_WGU = LW_WOUT + (size_t)D * D * 2,
                 LW_WDN = LW_WGU + (size_t)NE * 1024 * D * 2, LW_SIZE = LW_WDN + (size_t)NE * D * FF * 2;
static_assert(LW_SIZE == 77070336, "layer weights");
constexpr size_t WS_ACT = 152 * MiB;
constexpr size_t WS_BRC = 216 * MiB;
constexpr size_t WS_PROJ = 248 * MiB;
constexpr size_t WS_HID = WS_PROJ;
constexpr size_t WS_YS = WS_PROJ + 72 * MiB;
constexpr size_t WS_END = WS_PROJ + 656 * MiB;
static_assert(WS_W + 2 * LW_SIZE <= WS_ACT && (size_t)TC * NP * 2 <= 656 * MiB && (size_t)RP * 512 * 2 <= 72 * MiB && WS_YS + (size_t)RP * 2048 <= WS_END, "ws map");
constexpr int CW_BAR = 4096;
constexpr int CW_CNT = 8192;
constexpr int CW_Q = 12288;

constexpr int RING_BYTES = 131072;
constexpr int MISC_OFF = RING_BYTES;
constexpr int LDS_BYTES = 147456;

#define LDS_WAIT() asm volatile("s_waitcnt lgkmcnt(0)" ::: "memory")
#define VM_WAIT() asm volatile("s_waitcnt vmcnt(0)" ::: "memory")
__device__ __forceinline__ float bf2f(unsigned short b) { return __uint_as_float(((unsigned)b) << 16); }
__device__ __forceinline__ float bflo(unsigned u) { return __uint_as_float(u << 16); }
__device__ __forceinline__ float bfhi(unsigned u) { return __uint_as_float(u & 0xffff0000u); }
__device__ __forceinline__ unsigned f2bf(float f) { unsigned u = __float_as_uint(f); return (u + 0x7fffu + ((u >> 16) & 1u)) >> 16; }
__device__ __forceinline__ unsigned pk2(float lo, float hi) { return f2bf(lo) | (f2bf(hi) << 16); }
template <int O> __device__ __forceinline__ float swz_xor(float v) { return __int_as_float(__builtin_amdgcn_ds_swizzle(__float_as_int(v), (O << 10) | 0x1f)); }
__device__ __forceinline__ float xor32(float v) {
    const auto r = __builtin_amdgcn_permlane32_swap(__float_as_uint(v), __float_as_uint(v), false, false);
    return (threadIdx.x & 32) ? __uint_as_float(r[0]) : __uint_as_float(r[1]);
}
__device__ __forceinline__ float wave_sum(float v) {
    v += swz_xor<1>(v); v += swz_xor<2>(v); v += swz_xor<4>(v); v += swz_xor<8>(v); v += swz_xor<16>(v);
    const auto r = __builtin_amdgcn_permlane32_swap(__float_as_uint(v), __float_as_uint(v), false, false);
    return __uint_as_float(r[0]) + __uint_as_float(r[1]);
}
__device__ __forceinline__ float wave_max(float v) {
    v = fmaxf(v, swz_xor<1>(v)); v = fmaxf(v, swz_xor<2>(v)); v = fmaxf(v, swz_xor<4>(v)); v = fmaxf(v, swz_xor<8>(v)); v = fmaxf(v, swz_xor<16>(v));
    const auto r = __builtin_amdgcn_permlane32_swap(__float_as_uint(v), __float_as_uint(v), false, false);
    return fmaxf(__uint_as_float(r[0]), __uint_as_float(r[1]));
}
__device__ __forceinline__ float sigmoidf_(float x) { return 1.f / (1.f + __expf(-x)); }

#define XB_TMO      128
#define XB_XCNT(j)  (256  + 64 * (j))
#define XB_XSUB(j)  (1280 + 64 * (j))
#define XB_XGEN(j)  (2304 + 64 * (j))
#define XB_TOP      3328
#define XB_TOPGEN   3392
#define XCD_BAR_WORDS 3456
#define XB_SPIN_CAP (1u << 21)
__device__ __forceinline__ unsigned xb_ld(unsigned* p)              { return __hip_atomic_load(p, __ATOMIC_RELAXED, __HIP_MEMORY_SCOPE_AGENT); }
__device__ __forceinline__ unsigned xb_add(unsigned* p, unsigned v) { return __hip_atomic_fetch_add(p, v, __ATOMIC_RELAXED, __HIP_MEMORY_SCOPE_AGENT); }
__device__ __forceinline__ unsigned xb_xcc_id() { return (unsigned)__builtin_amdgcn_s_getreg((3 << 11) | 20) & 0xFu; }
#define XB_SPIN(cond, bar) do { unsigned _sp = 0; while (cond) { __builtin_amdgcn_s_sleep(1); \
    if ((++_sp & 255u) == 0u) { if (xb_ld(&(bar)[XB_TMO])) break; if (_sp > XB_SPIN_CAP) { atomicAdd(&(bar)[XB_TMO], 1u); break; } } } } while (0)
struct XcdBarrier { unsigned* bar; unsigned x; volatile LAS unsigned* st; };
__device__ __forceinline__ XcdBarrier xcd_barrier_post(unsigned* bar, volatile LAS unsigned* st) {
    XcdBarrier b; b.bar = bar; b.x = xb_xcc_id(); b.st = st;
    if (threadIdx.x == 0) (void)xb_add(&bar[XB_XCNT(b.x)], 1u);
    return b;
}
__device__ __forceinline__ void xcd_barrier_complete(unsigned* bar, unsigned x, unsigned& nloc, unsigned& nx) {
    const unsigned G = gridDim.x * gridDim.y * gridDim.z;
    unsigned sum, cnt, mine, sp = 0u;
    for (;;) {
        sum = 0u; cnt = 0u; mine = 0u;
#pragma unroll
        for (unsigned j = 0; j < 16; ++j) { const unsigned c = xb_ld(&bar[XB_XCNT(j)]); sum += c; cnt += (c > 0u) ? 1u : 0u; mine = (j == x) ? c : mine; }
        if (sum == G) break;
        __builtin_amdgcn_s_sleep(1);
        if ((++sp & 255u) == 0u) { if (xb_ld(&bar[XB_TMO])) break; if (sp > XB_SPIN_CAP) { atomicAdd(&bar[XB_TMO], 1u); break; } }
    }
    nloc = mine > 0u ? mine : 1u; nx = cnt > 0u ? cnt : 1u;
}
__device__ __forceinline__ void xcd_barrier(const XcdBarrier& b) {
    asm volatile("s_waitcnt vmcnt(0)" ::: "memory");
    __syncthreads();
    if (threadIdx.x == 0) {
        unsigned* bar = b.bar;
        __builtin_amdgcn_s_waitcnt(0);
        unsigned nloc = b.st[0], nx = b.st[1];
        if (nloc == 0u) { xcd_barrier_complete(bar, b.x, nloc, nx); b.st[0] = nloc; b.st[1] = nx; }
        const unsigned old = xb_add(&bar[XB_XSUB(b.x)], 1u);
        const unsigned gen = old / nloc;
        if (old + 1u == (gen + 1u) * nloc) {
            __builtin_amdgcn_fence(__ATOMIC_RELEASE, "agent");
            asm volatile("s_waitcnt vmcnt(0)" ::: "memory");
            const unsigned og = xb_add(&bar[XB_TOP], 1u);
            const unsigned tg = og / nx;
            if (og + 1u == (tg + 1u) * nx) xb_add(&bar[XB_TOPGEN], 1u);
            else XB_SPIN(xb_ld(&bar[XB_TOPGEN]) == tg, bar);
            __builtin_amdgcn_fence(__ATOMIC_ACQUIRE, "agent");
            xb_add(&bar[XB_XGEN(b.x)], 1u);
            asm volatile("s_waitcnt vmcnt(0)" ::: "memory");
        } else {
            XB_SPIN(xb_ld(&bar[XB_XGEN(b.x)]) == gen, bar);
            __builtin_amdgcn_fence(__ATOMIC_ACQUIRE, "agent");
            asm volatile("s_waitcnt vmcnt(0)" ::: "memory");
        }
    }
    __syncthreads();
}

struct Args { const void* in[24]; float* out; unsigned char* ws; int ph_lo, ph_hi; };
struct Ctx {
    LAS unsigned char* lds;
    unsigned* ctl;
    int tid, lane, wave, bid, G;
    int chunk, layer, pass;
    const float* x_in; float* xo;
    const int* pos;
    const unsigned char* lw;
    bf16_t *act, *proj, *hid, *ys;
    unsigned* rec; int* list;
};

__device__ __forceinline__ void tr_item(const float* srcp, int Nsrc, float scale, bf16_t* WT, int K, int n0, int k0, LAS float* scr, int lane) {
#pragma unroll 8
    for (int i = 0; i < 32; ++i) { const int kk = 2 * i + (lane >> 5); scr[kk * 33 + (lane & 31)] = srcp[(size_t)(k0 + kk) * Nsrc] * scale; }
    LDS_WAIT(); asm volatile("" ::: "memory");
    const int c = lane & 7;
#pragma unroll
    for (int j = 0; j < 4; ++j) { const int n = (lane >> 3) + 8 * j; const LAS float* s = scr + (8 * c) * 33 + n;
        u32x4 o; o.x = pk2(s[0 * 33], s[1 * 33]); o.y = pk2(s[2 * 33], s[3 * 33]); o.z = pk2(s[4 * 33], s[5 * 33]); o.w = pk2(s[6 * 33], s[7 * 33]);
        *(u32x4*)(WT + (size_t)(n0 + n) * K + k0 + 8 * c) = o; }
    LDS_WAIT(); asm volatile("" ::: "memory");
}
constexpr int IT_WIN = (NP / 32) * 16, IT_WBR = 3 * 32 * 8, IT_WOUT = 32 * 16, IT_WGU = NE * 32 * 16, IT_WDN = NE * 32 * 8, IT_LAYER = IT_WIN + IT_WBR + IT_WOUT + IT_WGU + IT_WDN;
__device__ __forceinline__ void phase_prep(const Args& a, LAS unsigned char* lds, int gw, int NGW, int wave, int lane, int gtid, int NGT) {
    LAS float* scr = (LAS float*)(lds + wave * 16384);
    for (int it = gw; it < DEPTH * IT_LAYER; it += NGW) {
        const int l = it / IT_LAYER; int r = it % IT_LAYER;
        unsigned char* lw = a.ws + WS_W + (size_t)l * LW_SIZE;
        const int rl = lane & 31;
        if (r < IT_WIN) {
            const int g = r / 16, kb = r % 16;
            if (g >= C_GP / 32 && g < C_XB / 32) continue;
            const int n = 32 * g + rl; const int src = n < C_GP ? n : n - 240;
            const float* W = (const float*)a.in[3] + (size_t)l * D * WIN_N;
            tr_item(W + src, WIN_N, n < 256 ? 0.125f : 1.f, (bf16_t*)(lw + LW_WIN), D, 32 * g, 64 * kb, scr, lane);
            continue; }
        r -= IT_WIN;
        if (r < IT_WBR) {
            const int b = r / 256, g = (r % 256) / 8, kb = r % 8;
            const float* W = (const float*)a.in[16] + ((size_t)l * 3 + b) * 512 * D;
            tr_item(W + 32 * g + rl, D, 1.f, (bf16_t*)(lw + LW_WBR) + (size_t)b * D * 512, 512, 32 * g, 64 * kb, scr, lane);
            continue; }
        r -= IT_WBR;
        if (r < IT_WOUT) {
            const int g = r / 16, kb = r % 16;
            const float* W = (const float*)a.in[17] + (size_t)l * D * D;
            tr_item(W + 32 * g + rl, D, 1.f, (bf16_t*)(lw + LW_WOUT), D, 32 * g, 64 * kb, scr, lane);
            continue; }
        r -= IT_WOUT;
        if (r < IT_WGU) {
            const int e = r / 512, g = (r % 512) / 16, kb = r % 16;
            const float* Wg = (const float*)a.in[21] + ((size_t)l * NE + e) * D * FF;
            const float* Wu = (const float*)a.in[22] + ((size_t)l * NE + e) * D * FF;
            const float* sp = (rl < 16 ? Wg : Wu) + 16 * g + (rl & 15);
            tr_item(sp, FF, 1.f, (bf16_t*)(lw + LW_WGU) + (size_t)e * 1024 * D, D, 32 * g, 64 * kb, scr, lane);
            continue; }
        r -= IT_WGU;
        {
            const int e = r / 256, g = (r % 256) / 8, kb = r % 8;
            const float* W = (const float*)a.in[23] + ((size_t)l * NE + e) * FF * D;
            tr_item(W + 32 * g + rl, D, 1.f, (bf16_t*)(lw + LW_WDN) + (size_t)e * D * FF, FF, 32 * g, 64 * kb, scr, lane);
        }
    }
    for (int idx = gtid; idx < DEPTH * 256 * D; idx += NGT) {
        const int l = idx / (256 * D), j = (idx / D) % 256, k = idx % D;
        const float* W = (const float*)a.in[3] + (size_t)l * D * WIN_N + (size_t)k * WIN_N + 1536;
        const float* gu = (const float*)a.in[4] + (size_t)l * 16 * 256 + j;
        float s = 0.f;
#pragma unroll
        for (int r = 0; r < 16; ++r) s += W[r] * gu[r * 256];
        ((bf16_t*)(a.ws + WS_W + (size_t)l * LW_SIZE + LW_WIN))[(size_t)(C_GP + j) * D + k] = (bf16_t)f2bf(s);
    }
}

__device__ __forceinline__ void moe_tables(const unsigned* cnt, LAS int* pt, LAS int* lc, int tid) {
    if (tid == 0) { int s = 0;
        for (int e = 0; e < NE; ++e) { const int c = (int)__hip_atomic_load(cnt + e, __ATOMIC_RELAXED, __HIP_MEMORY_SCOPE_AGENT); pt[e] = s; lc[e] = c; s += (c + 255) >> 8; }
        pt[NE] = s; }
    __syncthreads();
}

template <bool COMBINE, bool NORM, bool SRC_OUT>
__device__ __forceinline__ void phase_norm1(const Ctx& c, const float* gain, LAS const int* pt) {
    const int gw = c.bid * NWAVES + c.wave, NGW = c.G * NWAVES, lane = c.lane;
    f32x4 g4[4];
    if (NORM) {
#pragma unroll
        for (int j = 0; j < 4; ++j) g4[j] = *((const f32x4*)gain + 64 * j + lane); }
    for (int tok = gw; tok < TC; tok += NGW) {
        const f32x4* xr = (const f32x4*)((SRC_OUT ? (const float*)c.xo : c.x_in) + (size_t)tok * D) + lane;
        f32x4 v[4];
#pragma unroll
        for (int j = 0; j < 4; ++j) v[j] = xr[64 * j];
        if (COMBINE) {
            const u32x4 rc = *(const u32x4*)(c.rec + (size_t)tok * 4);
            const int e0 = rc.x >> 20, e1 = rc.y >> 20;
            const size_t r0 = (size_t)pt[e0] * 256 + (rc.x & 0xfffffu), r1 = (size_t)pt[e1] * 256 + (rc.y & 0xfffffu);
            const float w0 = __uint_as_float(rc.z), w1 = __uint_as_float(rc.w);
            const u32x2* y0 = (const u32x2*)(c.ys + r0 * D) + lane; const u32x2* y1 = (const u32x2*)(c.ys + r1 * D) + lane;
#pragma unroll
            for (int j = 0; j < 4; ++j) { const u32x2 a = y0[64 * j], b = y1[64 * j];
                v[j].x += w0 * bflo(a.x) + w1 * bflo(b.x); v[j].y += w0 * bfhi(a.x) + w1 * bfhi(b.x);
                v[j].z += w0 * bflo(a.y) + w1 * bflo(b.y); v[j].w += w0 * bfhi(a.y) + w1 * bfhi(b.y); }
            f32x4* xw = (f32x4*)(c.xo + (size_t)tok * D) + lane;
#pragma unroll
            for (int j = 0; j < 4; ++j) xw[64 * j] = v[j];
        }
        if (NORM) {
            float ss = 0.f;
#pragma unroll
            for (int j = 0; j < 4; ++j) ss += (v[j].x * v[j].x + v[j].y * v[j].y) + (v[j].z * v[j].z + v[j].w * v[j].w);
            const float rs = rsqrtf(wave_sum(ss) * (1.f / D) + RMS_EPS);
            u32x2* o = (u32x2*)(c.act + (size_t)tok * D) + lane;
#pragma unroll
            for (int j = 0; j < 4; ++j) { u32x2 w; w.x = pk2(v[j].x * rs * g4[j].x, v[j].y * rs * g4[j].y); w.y = pk2(v[j].z * rs * g4[j].z, v[j].w * rs * g4[j].w); o[64 * j] = w; }
        }
    }
}

__constant__ double kInvFreq[16] = {1.0, 0.44036660267178046, 0.19392274474868576, 0.08539710028576561, 0.03760603093086393, 0.016560440080994446, 0.007292664737217109, 0.003211445994752591,
    0.001414213562373095, 0.000622772421914596, 0.0002742481756762073, 0.00012076973741146504, 5.318295896944988e-05, 2.341999896140934e-05, 1.031338537721246e-05, 4.5416704806078695e-06};
__device__ __forceinline__ void phase_qkrope(const Ctx& c, const float* qg, const float* kg) {
    const int gw = c.bid * NWAVES + c.wave, NGW = c.G * NWAVES, lane = c.lane;
    const float qg0 = qg[2 * lane], qg1 = qg[2 * lane + 1], kg0 = kg[2 * lane], kg1 = kg[2 * lane + 1];
    const int i0 = 2 * (lane & 7);
    const double f0 = kInvFreq[i0], f1 = kInvFreq[i0 + 1];
    const float sgn = (lane & 8) ? 1.f : -1.f;
    for (int tok = gw; tok < TC; tok += NGW) {
        const double p = (double)c.pos[tok];
        double a0 = p * f0 * 0.15915494309189535, a1 = p * f1 * 0.15915494309189535;
        a0 -= rint(a0); a1 -= rint(a1);
        const float c0 = __builtin_amdgcn_cosf((float)a0), s0 = __builtin_amdgcn_sinf((float)a0), c1 = __builtin_amdgcn_cosf((float)a1), s1 = __builtin_amdgcn_sinf((float)a1);
        bf16_t* row = c.proj + (size_t)tok * NP + C_QKV;
#pragma unroll 4
        for (int hr = 0; hr < 24; ++hr) {
            unsigned* pp = (unsigned*)(row + hr * 128) + lane;
            const unsigned u = *pp; const float v0 = bflo(u), v1 = bfhi(u);
            const float rs = rsqrtf(wave_sum(v0 * v0 + v1 * v1) * (1.f / 128.f) + RMS_EPS);
            float y0 = v0 * rs * (hr < 12 ? qg0 : kg0), y1 = v1 * rs * (hr < 12 ? qg1 : kg1);
            const float p0 = __shfl_xor(y0, 8), p1 = __shfl_xor(y1, 8);
            if (lane < 16) { y0 = y0 * c0 + sgn * p0 * s0; y1 = y1 * c1 + sgn * p1 * s1; }
            *pp = pk2(y0, y1);
        }
    }
}

__device__ __forceinline__ float logsigmoidf_(float g) { return fminf(g, 0.f) - log1pf(__expf(-fabsf(g))); }
__device__ __forceinline__ float gelu_tanh(float y) { const float u = 0.7978845608028654f * (y + 0.044715f * y * y * y); const float t = 1.f - 2.f / (1.f + __expf(2.f * u)); return 0.5f * y * (1.f + t); }

__device__ __forceinline__ void gla_simple(const Ctx& c, int b, const float* gbias, const float* ogain) {
    LAS float* sQ = (LAS float*)c.lds; LAS float* sK = sQ + 16 * 256; LAS float* sA = sK + 16 * 256; LAS float* sO = sA + 16 * 256; LAS float* sV = sO + 16 * 512;
    const int tid = c.tid, h = tid >> 7, lane = c.lane;
    float S[64];
#pragma unroll
    for (int i = 0; i < 64; ++i) S[i] = 0.f;
    const float og0 = ogain[2 * lane], og1 = ogain[2 * lane + 1];
    for (int tc = 0; tc < SEQ / 16; ++tc) {
        const size_t tok0 = (size_t)b * SEQ + tc * 16;
        __syncthreads();
        for (int idx = tid; idx < 16 * 256; idx += NTHR) { const int s = idx >> 8, ci = idx & 255; const bf16_t* row = c.proj + (tok0 + s) * NP;
            sQ[idx] = bf2f(row[C_QA + ci]); sK[idx] = bf2f(row[C_KA + ci]);
            sA[idx] = __expf(logsigmoidf_(bf2f(row[C_GP + ci]) + gbias[ci]) * (1.f / 16.f)); }
#pragma unroll
        for (int s = 0; s < 16; ++s) sV[s * 512 + tid] = bf2f(c.proj[(tok0 + s) * NP + C_VA + tid]);
        __syncthreads();
        for (int s = 0; s < 16; ++s) {
            const float v = sV[s * 512 + tid]; float o = 0.f;
            const LAS f32x4* a4 = (const LAS f32x4*)(sA + s * 256 + h * 64); const LAS f32x4* k4 = (const LAS f32x4*)(sK + s * 256 + h * 64); const LAS f32x4* q4 = (const LAS f32x4*)(sQ + s * 256 + h * 64);
#pragma unroll
            for (int d = 0; d < 16; ++d) { const f32x4 a = a4[d], k = k4[d], q = q4[d];
                S[4 * d + 0] = S[4 * d + 0] * a.x + k.x * v; o += q.x * S[4 * d + 0];
                S[4 * d + 1] = S[4 * d + 1] * a.y + k.y * v; o += q.y * S[4 * d + 1];
                S[4 * d + 2] = S[4 * d + 2] * a.z + k.z * v; o += q.z * S[4 * d + 2];
                S[4 * d + 3] = S[4 * d + 3] * a.w + k.w * v; o += q.w * S[4 * d + 3]; }
            sO[s * 512 + tid] = o;
        }
        __syncthreads();
#pragma unroll 2
        for (int k = 0; k < 8; ++k) { const int rr = c.wave * 8 + k, s = rr >> 2, hh = rr & 3;
            const float o0 = sO[s * 512 + hh * 128 + 2 * lane], o1 = sO[s * 512 + hh * 128 + 2 * lane + 1];
            const float rs = rsqrtf(wave_sum(o0 * o0 + o1 * o1) * (1.f / 128.f) + RMS_EPS);
            unsigned* pp = (unsigned*)(c.proj + (tok0 + s) * NP + C_OG + hh * 128) + lane;
            const unsigned u = *pp; const float g0 = bflo(u), g1 = bfhi(u);
            *pp = pk2(o0 * rs * og0 * g0 * sigmoidf_(g0), o1 * rs * og1 * g1 * sigmoidf_(g1)); }
    }
}

__device__ __forceinline__ void lru_simple(const Ctx& c, int b, const float* convw, const float* convb, const float* wa_, const float* ba_, const float* wx_, const float* bx_, const float* lam_) {
    const int ch = c.tid, n = c.wave, lane = c.lane;
    LAS float* sX = (LAS float*)(c.lds + n * 4096);
    const float* wap = wa_ + n * 4096 + lane; const float* wxp = wx_ + n * 4096 + lane;
    const float cw0 = convw[ch], cw1 = convw[512 + ch], cw2 = convw[1024 + ch], cw3 = convw[1536 + ch], cb = convb[ch], ba = ba_[ch], bx = bx_[ch];
    const float lam = lam_[ch]; const float c8 = 8.f * (fmaxf(-lam, 0.f) + log1pf(__expf(-fabsf(lam))));
    float xm1 = 0.f, xm2 = 0.f, xm3 = 0.f, hs = 0.f;
    for (int tc = 0; tc < SEQ / 16; ++tc) {
        const size_t tok0 = (size_t)b * SEQ + tc * 16;
        float xc[16], yv[16], ar[16], ai[16];
#pragma unroll
        for (int s = 0; s < 16; ++s) { xc[s] = bf2f(c.proj[(tok0 + s) * NP + C_XB + ch]); yv[s] = bf2f(c.proj[(tok0 + s) * NP + C_YB + ch]); }
#pragma unroll
        for (int s = 0; s < 16; ++s) { const float x = xc[s]; xc[s] = cb + cw0 * xm3 + cw1 * xm2 + cw2 * xm1 + cw3 * x; xm3 = xm2; xm2 = xm1; xm1 = x; sX[s * 64 + lane] = xc[s]; ar[s] = ba; ai[s] = bx; }
        LDS_WAIT(); asm volatile("" ::: "memory"); __builtin_amdgcn_wave_barrier();
#pragma unroll 2
        for (int k = 0; k < 64; ++k) { const float wa = wap[k * 64], wx = wxp[k * 64];
#pragma unroll
            for (int s = 0; s < 16; ++s) { const float x = sX[s * 64 + k]; ar[s] += x * wa; ai[s] += x * wx; } }
#pragma unroll
        for (int s = 0; s < 16; ++s) {
            const float r = sigmoidf_(ar[s]), ig = sigmoidf_(ai[s]);
            const float a = __expf(-c8 * r);
            const float u = sqrtf(fmaxf(1.f - a * a, 0.f)) * ig * xc[s];
            hs = a * hs + u;
            c.proj[(tok0 + s) * NP + C_YB + ch] = (bf16_t)f2bf(hs * gelu_tanh(yv[s]));
        }
        LDS_WAIT(); asm volatile("" ::: "memory"); __builtin_amdgcn_wave_barrier();
    }
}

__device__ __forceinline__ void attn_simple(const Ctx& c, int aw, int NAW) {
    const int lane = c.lane;
    for (int task = aw; task < TC * 4; task += NAW) {
        const int tok = task >> 2, h = task & 3, t = tok & (SEQ - 1);
        float ml = -INFINITY, wsum = 0.f, acc0 = 0.f, acc1 = 0.f;
#pragma unroll 1
        for (int p = 0; p < 3; ++p) {
            const int dsh = 2 * p, i = t >> dsh, nk = i + 1 < 129 ? i + 1 : 129;
            const bf16_t* qrow = c.proj + (size_t)tok * NP + C_QKV + (p * 4 + h) * 128;
            const int kcol = C_QKV + (12 + p * 4 + h) * 128, vcol = C_QKV + (24 + p * 4 + h) * 128;
            float sc[3];
#pragma unroll
            for (int r = 0; r < 3; ++r) {
                sc[r] = -INFINITY;
                if (64 * r < nk) {
                    const int m = 64 * r + lane; const bool valid = m < nk;
                    const bf16_t* krow = c.proj + (size_t)(tok - ((valid ? m : 0) << dsh)) * NP + kcol;
                    float s = 0.f;
#pragma unroll 1
                    for (int cb = 0; cb < 4; ++cb) {
                        u32x4 kq[4], qq[4];
#pragma unroll
                        for (int j = 0; j < 4; ++j) { kq[j] = *((const u32x4*)krow + cb * 4 + j); qq[j] = *((const u32x4*)qrow + cb * 4 + j); }
#pragma unroll
                        for (int j = 0; j < 4; ++j) {
                            s += bflo(kq[j].x) * bflo(qq[j].x) + bfhi(kq[j].x) * bfhi(qq[j].x) + bflo(kq[j].y) * bflo(qq[j].y) + bfhi(kq[j].y) * bfhi(qq[j].y)
                               + bflo(kq[j].z) * bflo(qq[j].z) + bfhi(kq[j].z) * bfhi(qq[j].z) + bflo(kq[j].w) * bflo(qq[j].w) + bfhi(kq[j].w) * bfhi(qq[j].w); }
                    }
                    sc[r] = valid ? s * 0.08838834764831845f : -INFINITY;
                }
            }
            const float mx = wave_max(fmaxf(sc[0], fmaxf(sc[1], sc[2])));
            float pr[3];
#pragma unroll
            for (int r = 0; r < 3; ++r) pr[r] = __expf(sc[r] - mx);
            const float den = wave_sum(pr[0] + pr[1] + pr[2]);
            float o0 = 0.f, o1 = 0.f;
#pragma unroll
            for (int r = 0; r < 3; ++r) {
                const int cnt = nk - 64 * r < 64 ? nk - 64 * r : 64;
                if (cnt > 0) {
                const unsigned* vb = (const unsigned*)(c.proj + (size_t)(tok - ((64 * r) << dsh)) * NP + vcol) + lane;
#pragma unroll 4
                for (int mm = 0; mm < cnt; ++mm) {
                    const float pm = __int_as_float(__builtin_amdgcn_readlane(__float_as_int(pr[r]), mm));
                    const unsigned u = *(const unsigned*)((const char*)vb - (size_t)(mm << dsh) * NP * 2);
                    o0 += pm * bflo(u); o1 += pm * bfhi(u); }
                }
            }
            const float inv = 1.f / den, lse = mx + __logf(den);
            const float nml = fmaxf(ml, lse), sc_old = __expf(ml - nml), w = __expf(lse - nml);
            acc0 = acc0 * sc_old + w * o0 * inv; acc1 = acc1 * sc_old + w * o1 * inv; wsum = wsum * sc_old + w; ml = nml;
        }
        const float wi = 1.f / wsum;
        unsigned* op = (unsigned*)(c.proj + (size_t)tok * NP + C_QKV + h * 128) + lane;
        *op = pk2(acc0 * wi, acc1 * wi);
    }
}

constexpr int TPB = TC / 256;
__device__ __forceinline__ void phase_router(const Ctx& c, const float* gain, const float* rw, const float* rb, unsigned* gcnt) {
    LAS float* sRW = (LAS float*)c.lds;
    LAS unsigned* sRec = (LAS unsigned*)(c.lds + 65536);
    LAS unsigned* sCnt = (LAS unsigned*)(c.lds + MISC_OFF + 256);
    LAS unsigned* sBase = sCnt + 16;
    const int tid = c.tid, lane = c.lane;
    for (int idx = tid; idx < D * NE; idx += NTHR) sRW[(idx & 15) * D + (idx >> 4)] = rw[idx];
    if (tid < 16) sCnt[tid] = 0u;
    f32x4 g4[4];
#pragma unroll
    for (int j = 0; j < 4; ++j) g4[j] = *((const f32x4*)gain + 64 * j + lane);
    float rbv[16];
#pragma unroll
    for (int e = 0; e < 16; ++e) rbv[e] = rb[e];
    __syncthreads();
    for (int lt = c.wave; lt < TPB; lt += NWAVES) {
        const int tok = c.bid * TPB + lt;
        const f32x4* xr = (const f32x4*)(c.xo + (size_t)tok * D) + lane;
        f32x4 v[4]; float ss = 0.f;
#pragma unroll
        for (int j = 0; j < 4; ++j) { v[j] = xr[64 * j]; ss += (v[j].x * v[j].x + v[j].y * v[j].y) + (v[j].z * v[j].z + v[j].w * v[j].w); }
        const float rs = rsqrtf(wave_sum(ss) * (1.f / D) + RMS_EPS);
        u32x2* o = (u32x2*)(c.act + (size_t)tok * D) + lane;
#pragma unroll
        for (int j = 0; j < 4; ++j) { v[j] = v[j] * rs * g4[j]; u32x2 w; w.x = pk2(v[j].x, v[j].y); w.y = pk2(v[j].z, v[j].w); o[64 * j] = w; }
        float sc[16]; float mx = -INFINITY;
#pragma unroll
        for (int e = 0; e < 16; ++e) { float p = 0.f;
#pragma unroll
            for (int j = 0; j < 4; ++j) { const f32x4 w = *((const LAS f32x4*)(sRW + e * D) + 64 * j + lane); p += (v[j].x * w.x + v[j].y * w.y) + (v[j].z * w.z + v[j].w * w.w); }
            sc[e] = wave_sum(p) + rbv[e]; mx = fmaxf(mx, sc[e]); }
        float sum = 0.f;
#pragma unroll
        for (int e = 0; e < 16; ++e) { sc[e] = __expf(sc[e] - mx); sum += sc[e]; }
        const float isum = 1.f / sum;
#pragma unroll
        for (int e = 0; e < 16; ++e) sc[e] *= isum;
        int gsel = 0; float gbest = -1.f;
#pragma unroll
        for (int g = 0; g < 4; ++g) { const float a = sc[4 * g], b = sc[4 * g + 1], cc = sc[4 * g + 2], d = sc[4 * g + 3];
            const float hi1 = fmaxf(a, b), lo1 = fminf(a, b), hi2 = fmaxf(cc, d), lo2 = fminf(cc, d);
            const float top = fmaxf(hi1, hi2), second = fmaxf(fminf(hi1, hi2), fmaxf(lo1, lo2));
            const float gs = top + second; if (gs > gbest) { gbest = gs; gsel = g; } }
        float s4[4];
#pragma unroll
        for (int k = 0; k < 4; ++k) s4[k] = gsel == 0 ? sc[k] : gsel == 1 ? sc[4 + k] : gsel == 2 ? sc[8 + k] : sc[12 + k];
        int i0 = 0; float b0 = s4[0];
#pragma unroll
        for (int k = 1; k < 4; ++k) if (s4[k] > b0) { b0 = s4[k]; i0 = k; }
        int i1 = -1; float b1 = -1.f;
#pragma unroll
        for (int k = 0; k < 4; ++k) if (k != i0 && s4[k] > b1) { b1 = s4[k]; i1 = k; }
        const int e0 = 4 * gsel + i0, e1 = 4 * gsel + i1; const float wn = 1.f / (b0 + b1);
        if (lane == 0) { const unsigned l0 = atomicAdd((unsigned*)&sCnt[e0], 1u), l1 = atomicAdd((unsigned*)&sCnt[e1], 1u);
            sRec[lt * 6 + 0] = (unsigned)e0; sRec[lt * 6 + 1] = l0; sRec[lt * 6 + 2] = (unsigned)e1; sRec[lt * 6 + 3] = l1; sRec[lt * 6 + 4] = __float_as_uint(b0 * wn); sRec[lt * 6 + 5] = __float_as_uint(b1 * wn); }
    }
    __syncthreads();
    if (tid < 16) sBase[tid] = __hip_atomic_fetch_add(gcnt + tid, sCnt[tid], __ATOMIC_RELAXED, __HIP_MEMORY_SCOPE_AGENT);
    __syncthreads();
    if (tid < TPB) { const int tok = c.bid * TPB + tid; const unsigned e0 = sRec[tid * 6], e1 = sRec[tid * 6 + 2];
        const unsigned p0 = sBase[e0] + sRec[tid * 6 + 1], p1 = sBase[e1] + sRec[tid * 6 + 3];
        u32x4 r; r.x = (e0 << 20) | p0; r.y = (e1 << 20) | p1; r.z = sRec[tid * 6 + 4]; r.w = sRec[tid * 6 + 5];
        *(u32x4*)(c.rec + (size_t)tok * 4) = r;
        c.list[(size_t)e0 * TC + p0] = tok; c.list[(size_t)e1 * TC + p1] = tok; }
}

struct PlainOrder {
    int nM, nN, G, c; const char* A; const char* Bt; size_t a_tile, b_tile;
    __device__ __forceinline__ bool next(int i, pg8::Unit& u) const { u.g = 0; return pg8::static_tile(nM, nN, G, c, i, u.pm, u.pn); }
    __device__ __forceinline__ const char* aptr(const pg8::Unit& u) const { return A + (size_t)u.pm * a_tile; }
    __device__ __forceinline__ const char* bptr(const pg8::Unit& u) const { return Bt + (size_t)u.pn * b_tile; }
    __device__ __forceinline__ unsigned arow(const pg8::Unit&, int) const { return 0u; }
};
struct MergeOrder {
    int G, c; const char* proj; const char* wbr;
    __device__ __forceinline__ bool next(int i, pg8::Unit& u) const { u.g = i % 3; return pg8::static_tile(TC / 256, 4, G, c, i / 3, u.pm, u.pn); }
    __device__ __forceinline__ const char* aptr(const pg8::Unit& u) const { const int col = u.g == 0 ? C_OG : (u.g == 1 ? C_YB : C_QKV); return proj + ((size_t)u.pm * 256 * NP + col) * 2; }
    __device__ __forceinline__ const char* bptr(const pg8::Unit& u) const { return wbr + ((size_t)u.g * D * 512 + (size_t)u.pn * 256 * 512) * 2; }
    __device__ __forceinline__ unsigned arow(const pg8::Unit&, int) const { return 0u; }
};
template <bool UP> struct MoeOrder {
    int G, c; LAS const int* pt; LAS const int* lc; const char* A; const char* W; const int* list;
    __device__ __forceinline__ bool next(int i, pg8::Unit& u) const { const int L = i * G + c, tau = L >> 2; if (tau >= pt[NE]) return false;
        int e = 0;
#pragma unroll
        for (int k = 1; k < NE; ++k) e += (tau >= pt[k]) ? 1 : 0;
        u.pm = tau; u.pn = L & 3; u.g = e; return true; }
    __device__ __forceinline__ const char* aptr(const pg8::Unit& u) const { return UP ? A : A + (size_t)u.pm * 256 * FF * 2; }
    __device__ __forceinline__ const char* bptr(const pg8::Unit& u) const { return UP ? W + ((size_t)u.g * 1024 * D + (size_t)u.pn * 256 * D) * 2 : W + ((size_t)u.g * D * FF + (size_t)u.pn * 256 * FF) * 2; }
    __device__ __forceinline__ unsigned arow(const pg8::Unit& u, int r) const { int p = (u.pm - pt[u.g]) * 256 + r; const int n = lc[u.g]; p = p < n ? p : n - 1;
        return (unsigned)list[(size_t)u.g * TC + p] * (unsigned)(D * 2); }
};

struct EpiStoreBf16 {
    static constexpr bool PERM = true;
    bf16_t* O; int ldc;
    __device__ __forceinline__ void operator()(const f32x4 (&acc)[2][2][4][2], const pg8::Unit& u, int wr, int wc, int fr, int fq) const {
        const int row0 = u.pm * 256 + wr * 64 + fr, col0 = u.pn * 256 + wc * 32 + 8 * fq;
#pragma unroll
        for (int ai = 0; ai < 2; ++ai)
#pragma unroll
            for (int m = 0; m < 4; ++m) { bf16_t* rowp = O + (size_t)(row0 + ai * 128 + m * 16) * ldc + col0;
#pragma unroll
                for (int bj = 0; bj < 2; ++bj) { const f32x4 v0 = acc[ai][bj][m][0], v1 = acc[ai][bj][m][1];
                    u32x4 w; w.x = pg8::cvt_pk_bf16(v0[0], v0[1]); w.y = pg8::cvt_pk_bf16(v0[2], v0[3]); w.z = pg8::cvt_pk_bf16(v1[0], v1[1]); w.w = pg8::cvt_pk_bf16(v1[2], v1[3]);
                    *(u32x4*)(rowp + bj * 128) = w; } }
    }
};
struct EpiMerge {
    static constexpr bool PERM = true;
    const bf16_t* proj; bf16_t* mg;
    __device__ __forceinline__ void operator()(const f32x4 (&acc)[2][2][4][2], const pg8::Unit& u, int wr, int wc, int fr, int fq) const {
        const int row0 = u.pm * 256 + wr * 64 + fr, col0 = u.pn * 256 + wc * 32 + 8 * fq;
#pragma unroll
        for (int ai = 0; ai < 2; ++ai)
#pragma unroll
            for (int m = 0; m < 4; ++m) { const size_t row = (size_t)(row0 + ai * 128 + m * 16);
#pragma unroll
                for (int bj = 0; bj < 2; ++bj) { const int col = col0 + bj * 128;
                    const u32x4 gv = *(const u32x4*)(proj + row * NP + C_G + u.g * D + col);
                    const f32x4 v0 = acc[ai][bj][m][0], v1 = acc[ai][bj][m][1];
                    float r[8];
                    r[0] = v0[0] * sigmoidf_(bflo(gv.x)); r[1] = v0[1] * sigmoidf_(bfhi(gv.x)); r[2] = v0[2] * sigmoidf_(bflo(gv.y)); r[3] = v0[3] * sigmoidf_(bfhi(gv.y));
                    r[4] = v1[0] * sigmoidf_(bflo(gv.z)); r[5] = v1[1] * sigmoidf_(bfhi(gv.z)); r[6] = v1[2] * sigmoidf_(bflo(gv.w)); r[7] = v1[3] * sigmoidf_(bfhi(gv.w));
                    u32x4* mp = (u32x4*)(mg + row * D + col);
                    if (u.g > 0) { const u32x4 pv = *mp;
                        r[0] += bflo(pv.x); r[1] += bfhi(pv.x); r[2] += bflo(pv.y); r[3] += bfhi(pv.y); r[4] += bflo(pv.z); r[5] += bfhi(pv.z); r[6] += bflo(pv.w); r[7] += bfhi(pv.w); }
                    u32x4 w; w.x = pg8::cvt_pk_bf16(r[0], r[1]); w.y = pg8::cvt_pk_bf16(r[2], r[3]); w.z = pg8::cvt_pk_bf16(r[4], r[5]); w.w = pg8::cvt_pk_bf16(r[6], r[7]);
                    *mp = w; } }
    }
};
struct EpiResid {
    static constexpr bool PERM = false;
    const float* base; float* out;
    __device__ __forceinline__ void operator()(const f32x4 (&acc)[2][2][4][2], const pg8::Unit& u, int wr, int wc, int fr, int fq) const {
        const int row0 = u.pm * 256 + wr * 64 + fr, col0 = u.pn * 256 + wc * 32 + 4 * fq;
#pragma unroll
        for (int ai = 0; ai < 2; ++ai)
#pragma unroll
            for (int m = 0; m < 4; ++m) { const size_t off = (size_t)(row0 + ai * 128 + m * 16) * D + col0;
#pragma unroll
                for (int bj = 0; bj < 2; ++bj)
#pragma unroll
                    for (int n = 0; n < 2; ++n) { const f32x4 b = *(const f32x4*)(base + off + bj * 128 + n * 16); *(f32x4*)(out + off + bj * 128 + n * 16) = b + acc[ai][bj][m][n]; } }
    }
};
struct EpiSwiGLU {
    static constexpr bool PERM = false;
    bf16_t* hid;
    __device__ __forceinline__ void operator()(const f32x4 (&acc)[2][2][4][2], const pg8::Unit& u, int wr, int wc, int fr, int fq) const {
        const int row0 = u.pm * 256 + wr * 64 + fr, col0 = u.pn * 128 + wc * 16 + 4 * fq;
#pragma unroll
        for (int ai = 0; ai < 2; ++ai)
#pragma unroll
            for (int m = 0; m < 4; ++m) { bf16_t* rowp = hid + (size_t)(row0 + ai * 128 + m * 16) * FF + col0;
#pragma unroll
                for (int bj = 0; bj < 2; ++bj) { const f32x4 g = acc[ai][bj][m][0], up = acc[ai][bj][m][1];
                    u32x2 w; w.x = pg8::cvt_pk_bf16(g[0] * sigmoidf_(g[0]) * up[0], g[1] * sigmoidf_(g[1]) * up[1]); w.y = pg8::cvt_pk_bf16(g[2] * sigmoidf_(g[2]) * up[2], g[3] * sigmoidf_(g[3]) * up[3]);
                    *(u32x2*)(rowp + bj * 64) = w; } }
    }
};

constexpr int PH_PER_PASS = 9, N_PASS = NCH * DEPTH, PH_TOTAL = 1 + N_PASS * PH_PER_PASS + 1;
#ifndef MK_LAUNCH_PER_PHASE
#define MK_LAUNCH_PER_PHASE 0
#endif
#ifndef PHMASK
#define PHMASK 0xFFFF
#endif
#ifndef MIXM
#define MIXM 7
#endif
#define EN(j) (((PHMASK) >> (j)) & 1)
typedef const __attribute__((address_space(4))) char* kptr_t;
__device__ __forceinline__ const void* karg_ptr(kptr_t kp, int i) { return *(const void* const __attribute__((address_space(4)))*)(kp + 8 * i); }
__device__ __forceinline__ void make_ctx(Ctx& c, kptr_t& kp, int pass) {
    int t = threadIdx.x; asm volatile("" : "+v"(t));
    kp = (kptr_t)__builtin_amdgcn_kernarg_segment_ptr(); asm volatile("" : "+s"(kp));
    c.tid = t; c.lane = t & 63; c.wave = __builtin_amdgcn_readfirstlane(t >> 6); c.bid = blockIdx.x; c.G = gridDim.x;
    unsigned char* ws = (unsigned char*)karg_ptr(kp, 25); float* out = (float*)karg_ptr(kp, 24);
    c.ctl = (unsigned*)(ws + WS_CTL);
    c.act = (bf16_t*)(ws + WS_ACT); c.proj = (bf16_t*)(ws + WS_PROJ); c.hid = (bf16_t*)(ws + WS_HID); c.ys = (bf16_t*)(ws + WS_YS);
    c.rec = (unsigned*)(ws + WS_REC); c.list = (int*)(ws + WS_LIST);
    const int chunk = pass / DEPTH, layer = pass % DEPTH;
    c.chunk = chunk; c.layer = layer; c.pass = pass;
    c.x_in = (const float*)karg_ptr(kp, 0) + (size_t)chunk * TC * D; c.xo = out + (size_t)chunk * TC * D;
    c.pos = (const int*)karg_ptr(kp, 1) + (size_t)chunk * TC;
    c.lw = ws + WS_W + (size_t)layer * LW_SIZE;
}
#define INP(i) ((const float*)karg_ptr(kp, (i)))
__global__ void __launch_bounds__(NTHR, 2) fwd(Args args) {
    extern __shared__ __attribute__((aligned(16))) unsigned char lds_raw[];
    Ctx c; kptr_t kp;
    c.lds = (LAS unsigned char*)lds_raw;
    make_ctx(c, kp, 0);
    volatile LAS unsigned* MISC = (volatile LAS unsigned*)(c.lds + MISC_OFF);
    LAS int* sPT = (LAS int*)(c.lds + MISC_OFF + 64);
    LAS int* sLC = (LAS int*)(c.lds + MISC_OFF + 160);
    for (int u = c.tid; u < 1024; u += NTHR) MISC[u] = 0u;
    __syncthreads();
    XcdBarrier bar; bar.bar = c.ctl + CW_BAR; bar.x = 0; bar.st = nullptr;
    if (!MK_LAUNCH_PER_PHASE) bar = xcd_barrier_post(c.ctl + CW_BAR, MISC);
    const int lo = args.ph_lo, hi = args.ph_hi;
#define IN(k) (lo <= (k) && (k) < hi)
#define SEAM(k) do { if (IN(k) && IN((k) + 1)) { XcdBarrier _b = bar; kptr_t _k = (kptr_t)__builtin_amdgcn_kernarg_segment_ptr(); asm volatile("" : "+s"(_k)); _b.bar = (unsigned*)((unsigned char*)karg_ptr(_k, 25) + WS_CTL) + CW_BAR; xcd_barrier(_b); } } while (0)

    if (EN(0) && IN(0)) { Args a2;
#pragma unroll
        for (int i = 0; i < 24; ++i) a2.in[i] = karg_ptr(kp, i);
        a2.ws = (unsigned char*)karg_ptr(kp, 25); a2.out = nullptr; a2.ph_lo = 0; a2.ph_hi = 0;
        phase_prep(a2, c.lds, c.bid * NWAVES + c.wave, c.G * NWAVES, c.wave, c.lane, c.bid * NTHR + c.tid, c.G * NTHR); }
    SEAM(0);

    for (int pass = 0; pass < N_PASS; ++pass) {
        const int pb = 1 + pass * PH_PER_PASS;
        if (EN(1) && IN(pb + 0)) { make_ctx(c, kp, pass);
            const float* g1 = INP(2) + c.layer * D;
            if (c.layer == 0) {
                if (c.chunk > 0) {
                    Ctx p = c; p.xo = c.xo - (size_t)TC * D;
                    moe_tables(c.ctl + CW_CNT + 64 * (pass - 1), sPT, sLC, c.tid);
                    phase_norm1<true, false, true>(p, nullptr, sPT);
                }
                phase_norm1<false, true, false>(c, g1, sPT);
            } else {
                moe_tables(c.ctl + CW_CNT + 64 * (pass - 1), sPT, sLC, c.tid);
                phase_norm1<true, true, true>(c, g1, sPT);
            }
        }
        SEAM(pb + 0);
        if (EN(2) && IN(pb + 1)) { make_ctx(c, kp, pass);
            PlainOrder S{TC / 256, NP / 256, c.G, c.bid, (const char*)c.act, (const char*)(c.lw + LW_WIN), (size_t)256 * D * 2, (size_t)256 * D * 2};
            EpiStoreBf16 E{c.proj, NP};
            pg8::gemm_phase<EpiStoreBf16, PlainOrder, false>(c.lds, S, E, D, D);
        }
        SEAM(pb + 1);
        if (EN(3) && IN(pb + 2)) { make_ctx(c, kp, pass); phase_qkrope(c, INP(14) + c.layer * 128, INP(15) + c.layer * 128); }
        SEAM(pb + 2);
        if (EN(4) && IN(pb + 3)) { make_ctx(c, kp, pass); const int layer = c.layer;
            if ((MIXM & 1) && c.bid < BC) gla_simple(c, c.bid, INP(5) + layer * 256, INP(6) + layer * 128);
            else if ((MIXM & 2) && c.bid < 2 * BC) lru_simple(c, c.bid - BC, INP(7) + layer * 4 * 512, INP(8) + layer * 512, INP(9) + layer * 8 * 64 * 64,
                                                INP(10) + layer * 512, INP(11) + layer * 8 * 64 * 64, INP(12) + layer * 512, INP(13) + layer * 512);
            else if (MIXM & 4) attn_simple(c, (c.bid - 2 * BC) * NWAVES + c.wave, (c.G - 2 * BC) * NWAVES);
        }
        SEAM(pb + 3);
        if (EN(5) && IN(pb + 4)) { make_ctx(c, kp, pass);
            MergeOrder S{c.G, c.bid, (const char*)c.proj, (const char*)(c.lw + LW_WBR)};
            EpiMerge E{c.proj, c.act};
            pg8::gemm_phase<EpiMerge, MergeOrder, false>(c.lds, S, E, 512, NP);
        }
        SEAM(pb + 4);
        if (EN(6) && IN(pb + 5)) { make_ctx(c, kp, pass);
            PlainOrder S{TC / 256, D / 256, c.G, c.bid, (const char*)c.act, (const char*)(c.lw + LW_WOUT), (size_t)256 * D * 2, (size_t)256 * D * 2};
            EpiResid E{c.layer == 0 ? c.x_in : (const float*)c.xo, c.xo};
            pg8::gemm_phase<EpiResid, PlainOrder, false>(c.lds, S, E, D, D);
        }
        SEAM(pb + 5);
        if (EN(7) && IN(pb + 6)) { make_ctx(c, kp, pass); phase_router(c, INP(18) + c.layer * D, INP(19), INP(20), c.ctl + CW_CNT + 64 * pass); }
        SEAM(pb + 6);
        if (EN(8) && IN(pb + 7)) { make_ctx(c, kp, pass);
            moe_tables(c.ctl + CW_CNT + 64 * pass, sPT, sLC, c.tid);
            MoeOrder<true> S{c.G, c.bid, sPT, sLC, (const char*)c.act, (const char*)(c.lw + LW_WGU), c.list};
            EpiSwiGLU E{c.hid};
            pg8::gemm_phase<EpiSwiGLU, MoeOrder<true>, true>(c.lds, S, E, D, D);
        }
        SEAM(pb + 7);
        if (EN(9) && IN(pb + 8)) { make_ctx(c, kp, pass);
            moe_tables(c.ctl + CW_CNT + 64 * pass, sPT, sLC, c.tid);
            MoeOrder<false> S{c.G, c.bid, sPT, sLC, (const char*)c.hid, (const char*)(c.lw + LW_WDN), c.list};
            EpiStoreBf16 E{c.ys, D};
            pg8::gemm_phase<EpiStoreBf16, MoeOrder<false>, false>(c.lds, S, E, FF, FF);
        }
        SEAM(pb + 8);
    }
    if (EN(10) && IN(PH_TOTAL - 1)) { make_ctx(c, kp, N_PASS - 1);
        moe_tables(c.ctl + CW_CNT + 64 * (N_PASS - 1), sPT, sLC, c.tid);
        phase_norm1<true, false, true>(c, nullptr, sPT);
    }
#undef IN
#undef SEAM
}

extern "C" void kernel_launch(void* const* d_in, const int* in_sizes, int n_in, void* d_out, int out_size, void* d_ws, size_t ws_size, hipStream_t stream) {
    static int grid = 0;
    if (grid == 0) {
        if (n_in != 24 || in_sizes[0] != BATCH * SEQ * D || out_size != BATCH * SEQ * D || ws_size < WS_END) { fprintf(stderr, "kernel_launch: unexpected shapes / workspace (%zu < %zu)\n", ws_size, (size_t)WS_END); grid = -1; return; }
        int dev = 0, cus = 0;
        if (hipGetDevice(&dev) != hipSuccess || hipDeviceGetAttribute(&cus, hipDeviceAttributeMultiprocessorCount, dev) != hipSuccess || cus < 256) { fprintf(stderr, "kernel_launch: needs a 256-CU device\n"); grid = -1; return; }
        if (hipFuncSetAttribute((const void*)fwd, hipFuncAttributeMaxDynamicSharedMemorySize, LDS_BYTES) != hipSuccess) { fprintf(stderr, "kernel_launch: hipFuncSetAttribute failed\n"); grid = -1; return; }
        int per_cu = 0;
        if (hipOccupancyMaxActiveBlocksPerMultiprocessor(&per_cu, (const void*)fwd, NTHR, LDS_BYTES) != hipSuccess || per_cu < 1) fprintf(stderr, "kernel_launch: occupancy query says %d\n", per_cu);
        (void)hipGetLastError();
        grid = 256;
    }
    if (grid < 0) return;
    if (hipMemsetAsync((char*)d_ws + WS_CTL, 0, CTL_ZERO_BYTES, stream) != hipSuccess) return;
    Args a{};
    for (int i = 0; i < 24; ++i) a.in[i] = d_in[i];
    a.out = (float*)d_out; a.ws = (unsigned char*)d_ws;
#if MK_LAUNCH_PER_PHASE
    for (int k = 0; k < PH_TOTAL; ++k) { a.ph_lo = k; a.ph_hi = k + 1; hipLaunchKernelGGL(fwd, dim3(grid), dim3(NTHR), LDS_BYTES, stream, a); }
#else
    a.ph_lo = 0; a.ph_hi = PH_TOTAL;
    hipLaunchKernelGGL(fwd, dim3(grid), dim3(NTHR), LDS_BYTES, stream, a);
#endif
}
```

```cpp
#include <hip/hip_runtime.h>
#include <cstdio>
#include <cstdint>

#define LAS __attribute__((address_space(3)))
#define GAS __attribute__((address_space(1)))
typedef unsigned short bf16_t;
typedef short bf16x8 __attribute__((ext_vector_type(8)));
typedef float f32x4 __attribute__((ext_vector_type(4)));
typedef float f32x2 __attribute__((ext_vector_type(2)));
typedef unsigned u32x4 __attribute__((ext_vector_type(4)));
typedef unsigned u32x2 __attribute__((ext_vector_type(2)));

namespace pg8 {
constexpr int BM = 256, BK = 64, HALF = 128, HTB = HALF * BK * 2, STAGE_BYTES = 8 * HTB, NXCD = 8, WGM = 8;
__host__ __device__ __forceinline__ int lds_byte(int r, int c) { const int st = (r >> 4) * 2 + (c >> 5), rr = r & 15, cc = c & 31, ob = rr * 64 + cc * 2; return st * 1024 + (ob ^ (((ob >> 9) & 1) << 5)); }
__host__ __device__ __forceinline__ void stage_rc(int b, int& R, int& C) { const int st = b / 1024, sb = b % 1024, swz = sb ^ (((sb >> 9) & 1) << 5); R = (st >> 1) * 16 + swz / 64; C = (st & 1) * 32 + (swz % 64) / 2; }
__host__ __device__ __forceinline__ int perm32(int rho) { const int n = rho >> 4, i = rho & 15; return 8 * (i >> 2) + 4 * n + (i & 3); }

struct Unit { int pm, pn, g; };

__device__ __forceinline__ bool static_tile(int nM, int nN, int G, int c, int i, int& pm, int& pn) {
    const int nwg = nM * nN; const long L = (long)i * G + c; if (L >= nwg) return false;
    int wgid = (int)L; { const int q = nwg / NXCD, r = nwg % NXCD, xcd = wgid % NXCD, off = wgid / NXCD; wgid = (xcd < r ? xcd * (q + 1) : r * (q + 1) + (xcd - r) * q) + off; }
    const int nig = WGM * nN, gid = wgid / nig, fm = gid * WGM, gsz = (nM - fm) < WGM ? (nM - fm) : WGM;
    pm = fm + ((wgid % nig) % gsz); pn = (wgid % nig) / gsz; return true;
}
__device__ __forceinline__ unsigned cvt_pk_bf16(float lo, float hi) { unsigned r; asm volatile("v_cvt_pk_bf16_f32 %0, %1, %2" : "=v"(r) : "v"(lo), "v"(hi)); return r; }

template <class Epi, class Sched, bool GATHER>
__device__ __forceinline__ void gemm_phase(LAS unsigned char* lds, const Sched& S, const Epi& E, const int K, const int lda) {
    int tid_ = threadIdx.x; asm volatile("" : "+v"(tid_));
    const int tid = tid_, wid = __builtin_amdgcn_readfirstlane(tid >> 6), lane = tid & 63, wr = wid >> 2, wc = wid & 3, fr = lane & 15, fq = lane >> 4;
    const int nt = K / BK;
    int sR[2], sC[2];
    unsigned voffB[2], voffA[2], vAc[2][2], vAn[2][2];
#pragma unroll
    for (int i = 0; i < 2; ++i) { int R, C; stage_rc(tid * 16 + i * 8192, R, C); sR[i] = R; sC[i] = C; const int Rb = Epi::PERM ? ((R & ~31) + perm32(R & 31)) : R;
        voffB[i] = (unsigned)(Rb * K + C) * 2u; voffA[i] = (unsigned)(R * lda + C) * 2u; }
    const size_t kstep = (size_t)(BK * 2);
    const size_t hstepB = (size_t)HALF * K * 2, hstepA = (size_t)HALF * lda * 2;
    const unsigned ldsw = (unsigned)wid * 1024u;
    const int aoff = lds_byte(wr * 64 + fr, fq * 8), boff = lds_byte(wc * 32 + fr, fq * 8);
#define PG8_SA(b, h) (((b) * 2 + (h)) * HTB)
#define PG8_SB(b, h) ((4 + (b) * 2 + (h)) * HTB)
#define PG8_STAGE(bufoff, gbase, voff) do { _Pragma("unroll") for (int _i = 0; _i < 2; ++_i) \
        __builtin_amdgcn_global_load_lds((const unsigned*)((const char*)(gbase) + (voff)[_i]), (LAS unsigned*)(lds + (bufoff) + ldsw + _i * 8192), 16, 0, 0); } while (0)
#define PG8_LDA(dst, b, h) do { _Pragma("unroll") for (int m = 0; m < 4; ++m) _Pragma("unroll") for (int k = 0; k < 2; ++k) dst[m][k] = *(const LAS bf16x8*)(lds + PG8_SA(b, h) + aoff + m * 2048 + k * 1024); } while (0)
#define PG8_LDB(dst, b, h) do { _Pragma("unroll") for (int n = 0; n < 2; ++n) _Pragma("unroll") for (int k = 0; k < 2; ++k) dst[n][k] = *(const LAS bf16x8*)(lds + PG8_SB(b, h) + boff + n * 2048 + k * 1024); } while (0)
#define PG8_MMA(ai, bj, At, Bt) do { __builtin_amdgcn_s_setprio(1); _Pragma("unroll") for (int m = 0; m < 4; ++m) _Pragma("unroll") for (int n = 0; n < 2; ++n) _Pragma("unroll") for (int k = 0; k < 2; ++k) \
        acc[ai][bj][m][n] = __builtin_amdgcn_mfma_f32_16x16x32_bf16(Bt[n][k], At[m][k], acc[ai][bj][m][n], 0, 0, 0); __builtin_amdgcn_s_setprio(0); } while (0)
#define PG8_WAIT_V(n) asm volatile("s_waitcnt vmcnt(" #n ")" ::: "memory")
#define PG8_WAIT_L(n) asm volatile("s_waitcnt lgkmcnt(" #n ")" ::: "memory")
#define PG8_BAR __builtin_amdgcn_s_barrier()
#define PG8_SCHED __builtin_amdgcn_sched_barrier(0)
#define PG8_AOFF(dst, u) do { if constexpr (GATHER) { _Pragma("unroll") for (int _h = 0; _h < 2; ++_h) _Pragma("unroll") for (int _i = 0; _i < 2; ++_i) \
        dst[_h][_i] = S.arow(u, _h * HALF + sR[_i]) + (unsigned)sC[_i] * 2u; } } while (0)
#define PG8_STAGE_A(bufoff, gptr, h, usenext) do { if constexpr (GATHER) { _Pragma("unroll") for (int _i = 0; _i < 2; ++_i) { const unsigned _vo = (usenext) ? vAn[h][_i] : vAc[h][_i]; \
        __builtin_amdgcn_global_load_lds((const unsigned*)((const char*)(gptr) + _vo), (LAS unsigned*)(lds + (bufoff) + ldsw + _i * 8192), 16, 0, 0); } } \
        else { PG8_STAGE(bufoff, (gptr) + (h) * hstepA, voffA); } } while (0)
    Unit cur, nxt; int ui = 0;
    if (!S.next(0, cur)) return;
    f32x4 acc[2][2][4][2];
#pragma unroll
    for (int a = 0; a < 2; ++a)
#pragma unroll
        for (int b = 0; b < 2; ++b)
#pragma unroll
            for (int m = 0; m < 4; ++m)
#pragma unroll
                for (int n = 0; n < 2; ++n) acc[a][b][m][n] = (f32x4){0.f, 0.f, 0.f, 0.f};
    bf16x8 At[4][2], B0[2][2], B1[2][2];
    const char* cA = S.aptr(cur); const char* cB = S.bptr(cur);
    PG8_AOFF(vAc, cur);
    PG8_STAGE(PG8_SB(0, 0), cB, voffB); PG8_STAGE(PG8_SB(0, 1), cB + hstepB, voffB); PG8_STAGE_A(PG8_SA(0, 0), cA, 0, false); PG8_STAGE_A(PG8_SA(0, 1), cA, 1, false);
    if (wr == 1) PG8_BAR;
    PG8_WAIT_V(2); PG8_BAR;
    PG8_STAGE(PG8_SB(1, 0), cB + kstep, voffB); PG8_STAGE_A(PG8_SA(1, 0), cA + kstep, 0, false); PG8_STAGE(PG8_SB(1, 1), cB + hstepB + kstep, voffB);
    PG8_WAIT_V(6); PG8_BAR;
    for (;;) {
        const bool has_next = S.next(ui + 1, nxt);
        const char* nA = has_next ? S.aptr(nxt) : cA; const char* nB = has_next ? S.bptr(nxt) : cB;
        if constexpr (GATHER) { if (has_next) { PG8_AOFF(vAn, nxt); } else {
#pragma unroll
            for (int h = 0; h < 2; ++h)
#pragma unroll
                for (int i = 0; i < 2; ++i) vAn[h][i] = vAc[h][i]; } }
        for (int t = 0; t < nt; t += 2) {
            const bool last = (t == nt - 2);
            const char* a1 = cA + (size_t)(t + 1) * kstep;
            const char* a2 = last ? nA : cA + (size_t)(t + 2) * kstep; const char* b2 = last ? nB : cB + (size_t)(t + 2) * kstep;
            const char* a3 = a2 + kstep; const char* b3 = b2 + kstep;
            PG8_LDB(B0, 0, 0); PG8_LDB(B1, 0, 1); PG8_SCHED; PG8_LDA(At, 0, 0); PG8_STAGE_A(PG8_SA(1, 1), a1, 1, false);
            PG8_WAIT_V(8); PG8_WAIT_L(0); PG8_BAR; PG8_MMA(0, 0, At, B0); PG8_MMA(0, 1, At, B1); PG8_BAR; PG8_SCHED;
            PG8_LDA(At, 0, 1); PG8_STAGE(PG8_SB(0, 0), b2, voffB); PG8_STAGE(PG8_SB(0, 1), b2 + hstepB, voffB); PG8_STAGE_A(PG8_SA(0, 0), a2, 0, last);
            PG8_WAIT_V(8); PG8_WAIT_L(0); PG8_BAR; PG8_MMA(1, 0, At, B0); PG8_MMA(1, 1, At, B1); PG8_BAR; PG8_SCHED;
            PG8_LDB(B0, 1, 0); PG8_LDB(B1, 1, 1); PG8_SCHED; PG8_LDA(At, 1, 0); PG8_STAGE_A(PG8_SA(0, 1), a2, 1, last);
            PG8_WAIT_V(8); PG8_WAIT_L(0); PG8_BAR; PG8_MMA(0, 0, At, B0); PG8_MMA(0, 1, At, B1); PG8_BAR; PG8_SCHED;
            PG8_LDA(At, 1, 1); PG8_STAGE(PG8_SB(1, 0), b3, voffB); PG8_STAGE(PG8_SB(1, 1), b3 + hstepB, voffB); PG8_STAGE_A(PG8_SA(1, 0), a3, 0, last);
            PG8_WAIT_V(8); PG8_WAIT_L(0); PG8_BAR; PG8_MMA(1, 0, At, B0); PG8_MMA(1, 1, At, B1); PG8_BAR; PG8_SCHED;
        }
        if (wr == 0) PG8_BAR;
        E(acc, cur, wr, wc, fr, fq);
        if (!has_next) break;
#pragma unroll
        for (int a = 0; a < 2; ++a)
#pragma unroll
            for (int b = 0; b < 2; ++b)
#pragma unroll
                for (int m = 0; m < 4; ++m)
#pragma unroll
                    for (int n = 0; n < 2; ++n) acc[a][b][m][n] = (f32x4){0.f, 0.f, 0.f, 0.f};
        cur = nxt; cA = nA; cB = nB; ++ui;
        if constexpr (GATHER) {
#pragma unroll
        for (int h = 0; h < 2; ++h)
#pragma unroll
            for (int i = 0; i < 2; ++i) vAc[h][i] = vAn[h][i]; }
        if (wr == 1) PG8_BAR;
    }
    PG8_WAIT_V(0);
    PG8_BAR;
#undef PG8_SA
#undef PG8_SB
#undef PG8_STAGE
#undef PG8_LDA
#undef PG8_LDB
#undef PG8_MMA
#undef PG8_WAIT_V
#undef PG8_WAIT_L
#undef PG8_BAR
#undef PG8_SCHED
#undef PG8_AOFF
#undef PG8_STAGE_A
}
}

constexpr int D = 1024, BATCH = 32, SEQ = 2048, DEPTH = 2;
constexpr int NCH = 2, BC = BATCH / NCH, TC = BC * SEQ;
constexpr int NP = 10496;
constexpr int C_QA = 0, C_KA = 256, C_VA = 512, C_OG = 1024, C_GP = 1536, C_XB = 1792, C_YB = 2304, C_QKV = 2816, C_G = 7424;
constexpr int WIN_N = 10256;
constexpr int NE = 16, FF = 512;
constexpr int RP = 2 * TC + NE * 256;
constexpr float RMS_EPS = 1e-6f;
constexpr int NWAVES = 8, NTHR = 512;

constexpr size_t MiB = 1u << 20;
constexpr size_t WS_CTL = 0, CTL_ZERO_BYTES = 1 * MiB;
constexpr size_t WS_REC = 1 * MiB;
constexpr size_t WS_LIST = 2 * MiB;
constexpr size_t WS_W = 4 * MiB;
constexpr size_t LW_WIN = 0, LW_WBR = LW_WIN + (size_t)NP * D * 2, LW_WOUT = LW_WBR + (size_t)3 * D * 512 * 2, LW_WGU = LW_WOUT + (size_t)D * D * 2,
                 LW_WDN = LW_WGU + (size_t)NE * 1024 * D * 2, LW_SIZE = LW_WDN + (size_t)NE * D * FF * 2;
static_assert(LW_SIZE == 77070336, "layer weights");
constexpr size_t WS_ACT = 152 * MiB;
constexpr size_t WS_BRC = 216 * MiB;
constexpr size_t WS_PROJ = 248 * MiB;
constexpr size_t WS_HID = WS_PROJ;
constexpr size_t WS_YS = WS_PROJ + 72 * MiB;
constexpr size_t WS_END = WS_PROJ + 656 * MiB;
static_assert(WS_W + 2 * LW_SIZE <= WS_ACT && (size_t)TC * NP * 2 <= 656 * MiB && (size_t)RP * 512 * 2 <= 72 * MiB && WS_YS + (size_t)RP * 2048 <= WS_END, "ws map");
constexpr int CW_BAR = 4096;
constexpr int CW_CNT = 8192;
constexpr int CW_Q = 12288;

constexpr int RING_BYTES = 131072;
constexpr int MISC_OFF = RING_BYTES;
constexpr int LDS_BYTES = 147456;

#define LDS_WAIT() asm volatile("s_waitcnt lgkmcnt(0)" ::: "memory")
#define VM_WAIT() asm volatile("s_waitcnt vmcnt(0)" ::: "memory")
__device__ __forceinline__ float bf2f(unsigned short b) { return __uint_as_float(((unsigned)b) << 16); }
__device__ __forceinline__ float bflo(unsigned u) { return __uint_as_float(u << 16); }
__device__ __forceinline__ float bfhi(unsigned u) { return __uint_as_float(u & 0xffff0000u); }
__device__ __forceinline__ unsigned f2bf(float f) { unsigned u = __float_as_uint(f); return (u + 0x7fffu + ((u >> 16) & 1u)) >> 16; }
__device__ __forceinline__ unsigned pk2(float lo, float hi) { return f2bf(lo) | (f2bf(hi) << 16); }
template <int O> __device__ __forceinline__ float swz_xor(float v) { return __int_as_float(__builtin_amdgcn_ds_swizzle(__float_as_int(v), (O << 10) | 0x1f)); }
__device__ __forceinline__ float xor32(float v) {
    const auto r = __builtin_amdgcn_permlane32_swap(__float_as_uint(v), __float_as_uint(v), false, false);
    return (threadIdx.x & 32) ? __uint_as_float(r[0]) : __uint_as_float(r[1]);
}
__device__ __forceinline__ float wave_sum(float v) {
    v += swz_xor<1>(v); v += swz_xor<2>(v); v += swz_xor<4>(v); v += swz_xor<8>(v); v += swz_xor<16>(v);
    const auto r = __builtin_amdgcn_permlane32_swap(__float_as_uint(v), __float_as_uint(v), false, false);
    return __uint_as_float(r[0]) + __uint_as_float(r[1]);
}
__device__ __forceinline__ float wave_max(float v) {
    v = fmaxf(v, swz_xor<1>(v)); v = fmaxf(v, swz_xor<2>(v)); v = fmaxf(v, swz_xor<4>(v)); v = fmaxf(v, swz_xor<8>(v)); v = fmaxf(v, swz_xor<16>(v));
    const auto r = __builtin_amdgcn_permlane32_swap(__float_as_uint(v), __float_as_uint(v), false, false);
    return fmaxf(__uint_as_float(r[0]), __uint_as_float(r[1]));
}
__device__ __forceinline__ float sigmoidf_(float x) { return 1.f / (1.f + __expf(-x)); }

#define XB_TMO      128
#define XB_XCNT(j)  (256  + 64 * (j))
#define XB_XSUB(j)  (1280 + 64 * (j))
#define XB_XGEN(j)  (2304 + 64 * (j))
#define XB_TOP      3328
#define XB_TOPGEN   3392
#define XCD_BAR_WORDS 3456
#define XB_SPIN_CAP (1u << 21)
__device__ __forceinline__ unsigned xb_ld(unsigned* p)              { return __hip_atomic_load(p, __ATOMIC_RELAXED, __HIP_MEMORY_SCOPE_AGENT); }
__device__ __forceinline__ unsigned xb_add(unsigned* p, unsigned v) { return __hip_atomic_fetch_add(p, v, __ATOMIC_RELAXED, __HIP_MEMORY_SCOPE_AGENT); }
__device__ __forceinline__ unsigned xb_xcc_id() { return (unsigned)__builtin_amdgcn_s_getreg((3 << 11) | 20) & 0xFu; }
#define XB_SPIN(cond, bar) do { unsigned _sp = 0; while (cond) { __builtin_amdgcn_s_sleep(1); \
    if ((++_sp & 255u) == 0u) { if (xb_ld(&(bar)[XB_TMO])) break; if (_sp > XB_SPIN_CAP) { atomicAdd(&(bar)[XB_TMO], 1u); break; } } } } while (0)
struct XcdBarrier { unsigned* bar; unsigned x; volatile LAS unsigned* st; };
__device__ __forceinline__ XcdBarrier xcd_barrier_post(unsigned* bar, volatile LAS unsigned* st) {
    XcdBarrier b; b.bar = bar; b.x = xb_xcc_id(); b.st = st;
    if (threadIdx.x == 0) (void)xb_add(&bar[XB_XCNT(b.x)], 1u);
    return b;
}
__device__ __forceinline__ void xcd_barrier_complete(unsigned* bar, unsigned x, unsigned& nloc, unsigned& nx) {
    const unsigned G = gridDim.x * gridDim.y * gridDim.z;
    unsigned sum, cnt, sp = 0u;
    for (;;) {
        sum = 0u; cnt = 0u;
#pragma unroll 1
        for (unsigned j = 0; j < 16; ++j) { const unsigned c = xb_ld(&bar[XB_XCNT(j)]); sum += c; cnt += (c > 0u) ? 1u : 0u; }
        if (sum == G) break;
        __builtin_amdgcn_s_sleep(1);
        if ((++sp & 255u) == 0u) { if (xb_ld(&bar[XB_TMO])) break; if (sp > XB_SPIN_CAP) { atomicAdd(&bar[XB_TMO], 1u); break; } }
    }
    const unsigned mine = xb_ld(&bar[XB_XCNT(x)]);
    nloc = mine > 0u ? mine : 1u; nx = cnt > 0u ? cnt : 1u;
}
__device__ __noinline__ void xcd_barrier(const XcdBarrier b) {
    asm volatile("s_waitcnt vmcnt(0)" ::: "memory");
    __syncthreads();
    if (threadIdx.x == 0) {
        unsigned* bar = b.bar;
        __builtin_amdgcn_s_waitcnt(0);
        unsigned nloc = b.st[0], nx = b.st[1];
        if (nloc == 0u) { xcd_barrier_complete(bar, b.x, nloc, nx); b.st[0] = nloc; b.st[1] = nx; }
        const unsigned old = xb_add(&bar[XB_XSUB(b.x)], 1u);
        const unsigned gen = old / nloc;
        if (old + 1u == (gen + 1u) * nloc) {
            __builtin_amdgcn_fence(__ATOMIC_RELEASE, "agent");
            asm volatile("s_waitcnt vmcnt(0)" ::: "memory");
            const unsigned og = xb_add(&bar[XB_TOP], 1u);
            const unsigned tg = og / nx;
            if (og + 1u == (tg + 1u) * nx) xb_add(&bar[XB_TOPGEN], 1u);
            else XB_SPIN(xb_ld(&bar[XB_TOPGEN]) == tg, bar);
            __builtin_amdgcn_fence(__ATOMIC_ACQUIRE, "agent");
            xb_add(&bar[XB_XGEN(b.x)], 1u);
            asm volatile("s_waitcnt vmcnt(0)" ::: "memory");
        } else {
            XB_SPIN(xb_ld(&bar[XB_XGEN(b.x)]) == gen, bar);
            __builtin_amdgcn_fence(__ATOMIC_ACQUIRE, "agent");
            asm volatile("s_waitcnt vmcnt(0)" ::: "memory");
        }
    }
    __syncthreads();
}

struct Args { const void* in[24]; float* out; unsigned char* ws; int ph_lo, ph_hi; };
struct Ctx {
    LAS unsigned char* lds;
    unsigned* ctl;
    int tid, lane, wave, bid, G;
    int chunk, layer, pass;
    const float* x_in; float* xo;
    const int* pos;
    const unsigned char* lw;
    bf16_t *act, *proj, *hid, *ys;
    unsigned* rec; int* list;
};

__device__ __forceinline__ void tr_item(const float* srcp, int Nsrc, float scale, bf16_t* WT, int K, int n0, int k0, LAS float* scr, int lane) {
#pragma unroll 8
    for (int i = 0; i < 32; ++i) { const int kk = 2 * i + (lane >> 5); scr[kk * 33 + (lane & 31)] = srcp[(size_t)(k0 + kk) * Nsrc] * scale; }
    LDS_WAIT(); asm volatile("" ::: "memory");
    const int c = lane & 7;
#pragma unroll
    for (int j = 0; j < 4; ++j) { const int n = (lane >> 3) + 8 * j; const LAS float* s = scr + (8 * c) * 33 + n;
        u32x4 o; o.x = pk2(s[0 * 33], s[1 * 33]); o.y = pk2(s[2 * 33], s[3 * 33]); o.z = pk2(s[4 * 33], s[5 * 33]); o.w = pk2(s[6 * 33], s[7 * 33]);
        *(u32x4*)(WT + (size_t)(n0 + n) * K + k0 + 8 * c) = o; }
    LDS_WAIT(); asm volatile("" ::: "memory");
}
constexpr int IT_WIN = (NP / 32) * 16, IT_WBR = 3 * 32 * 8, IT_WOUT = 32 * 16, IT_WGU = NE * 32 * 16, IT_WDN = NE * 32 * 8, IT_LAYER = IT_WIN + IT_WBR + IT_WOUT + IT_WGU + IT_WDN;
__device__ __forceinline__ void phase_prep(const Args& a, LAS unsigned char* lds, int gw, int NGW, int wave, int lane, int gtid, int NGT) {
    LAS float* scr = (LAS float*)(lds + wave * 16384);
    for (int it = gw; it < DEPTH * IT_LAYER; it += NGW) {
        const int l = it / IT_LAYER; int r = it % IT_LAYER;
        unsigned char* lw = a.ws + WS_W + (size_t)l * LW_SIZE;
        const int rl = lane & 31;
        if (r < IT_WIN) {
            const int g = r / 16, kb = r % 16;
            if (g >= C_GP / 32 && g < C_XB / 32) continue;
            const int n = 32 * g + rl; const int src = n < C_GP ? n : n - 240;
            const float* W = (const float*)a.in[3] + (size_t)l * D * WIN_N;
            tr_item(W + src, WIN_N, n < 256 ? 0.125f : 1.f, (bf16_t*)(lw + LW_WIN), D, 32 * g, 64 * kb, scr, lane);
            continue; }
        r -= IT_WIN;
        if (r < IT_WBR) {
            const int b = r / 256, g = (r % 256) / 8, kb = r % 8;
            const float* W = (const float*)a.in[16] + ((size_t)l * 3 + b) * 512 * D;
            tr_item(W + 32 * g + rl, D, 1.f, (bf16_t*)(lw + LW_WBR) + (size_t)b * D * 512, 512, 32 * g, 64 * kb, scr, lane);
            continue; }
        r -= IT_WBR;
        if (r < IT_WOUT) {
            const int g = r / 16, kb = r % 16;
            const float* W = (const float*)a.in[17] + (size_t)l * D * D;
            tr_item(W + 32 * g + rl, D, 1.f, (bf16_t*)(lw + LW_WOUT), D, 32 * g, 64 * kb, scr, lane);
            continue; }
        r -= IT_WOUT;
        if (r < IT_WGU) {
            const int e = r / 512, g = (r % 512) / 16, kb = r % 16;
            const float* Wg = (const float*)a.in[21] + ((size_t)l * NE + e) * D * FF;
            const float* Wu = (const float*)a.in[22] + ((size_t)l * NE + e) * D * FF;
            const float* sp = (rl < 16 ? Wg : Wu) + 16 * g + (rl & 15);
            tr_item(sp, FF, 1.f, (bf16_t*)(lw + LW_WGU) + (size_t)e * 1024 * D, D, 32 * g, 64 * kb, scr, lane);
            continue; }
        r -= IT_WGU;
        {
            const int e = r / 256, g = (r % 256) / 8, kb = r % 8;
            const float* W = (const float*)a.in[23] + ((size_t)l * NE + e) * FF * D;
            tr_item(W + 32 * g + rl, D, 1.f, (bf16_t*)(lw + LW_WDN) + (size_t)e * D * FF, FF, 32 * g, 64 * kb, scr, lane);
        }
    }
    for (int idx = gtid; idx < DEPTH * 256 * D; idx += NGT) {
        const int l = idx / (256 * D), j = (idx / D) % 256, k = idx % D;
        const float* W = (const float*)a.in[3] + (size_t)l * D * WIN_N + (size_t)k * WIN_N + 1536;
        const float* gu = (const float*)a.in[4] + (size_t)l * 16 * 256 + j;
        float s = 0.f;
#pragma unroll
        for (int r = 0; r < 16; ++r) s += W[r] * gu[r * 256];
        ((bf16_t*)(a.ws + WS_W + (size_t)l * LW_SIZE + LW_WIN))[(size_t)(C_GP + j) * D + k] = (bf16_t)f2bf(s);
    }
}

__device__ __forceinline__ void moe_tables(const unsigned* cnt, LAS int* pt, LAS int* lc, int tid) {
    if (tid == 0) { int s = 0;
        for (int e = 0; e < NE; ++e) { const int c = (int)__hip_atomic_load(cnt + e, __ATOMIC_RELAXED, __HIP_MEMORY_SCOPE_AGENT); pt[e] = s; lc[e] = c; s += (c + 255) >> 8; }
        pt[NE] = s; }
    __syncthreads();
}

template <bool COMBINE, bool NORM, bool SRC_OUT>
__device__ __forceinline__ void phase_norm1(const Ctx& c, const float* gain, LAS const int* pt) {
    const int gw = c.bid * NWAVES + c.wave, NGW = c.G * NWAVES, lane = c.lane;
    f32x4 g4[4];
    if (NORM) {
#pragma unroll
        for (int j = 0; j < 4; ++j) g4[j] = *((const f32x4*)gain + 64 * j + lane); }
    for (int tok = gw; tok < TC; tok += NGW) {
        const f32x4* xr = (const f32x4*)((SRC_OUT ? (const float*)c.xo : c.x_in) + (size_t)tok * D) + lane;
        f32x4 v[4];
#pragma unroll
        for (int j = 0; j < 4; ++j) v[j] = xr[64 * j];
        if (COMBINE) {
            const u32x4 rc = *(const u32x4*)(c.rec + (size_t)tok * 4);
            const int e0 = rc.x >> 20, e1 = rc.y >> 20;
            const size_t r0 = (size_t)pt[e0] * 256 + (rc.x & 0xfffffu), r1 = (size_t)pt[e1] * 256 + (rc.y & 0xfffffu);
            const float w0 = __uint_as_float(rc.z), w1 = __uint_as_float(rc.w);
            const u32x2* y0 = (const u32x2*)(c.ys + r0 * D) + lane; const u32x2* y1 = (const u32x2*)(c.ys + r1 * D) + lane;
#pragma unroll
            for (int j = 0; j < 4; ++j) { const u32x2 a = y0[64 * j], b = y1[64 * j];
                v[j].x += w0 * bflo(a.x) + w1 * bflo(b.x); v[j].y += w0 * bfhi(a.x) + w1 * bfhi(b.x);
                v[j].z += w0 * bflo(a.y) + w1 * bflo(b.y); v[j].w += w0 * bfhi(a.y) + w1 * bfhi(b.y); }
            f32x4* xw = (f32x4*)(c.xo + (size_t)tok * D) + lane;
#pragma unroll
            for (int j = 0; j < 4; ++j) xw[64 * j] = v[j];
        }
        if (NORM) {
            float ss = 0.f;
#pragma unroll
            for (int j = 0; j < 4; ++j) ss += (v[j].x * v[j].x + v[j].y * v[j].y) + (v[j].z * v[j].z + v[j].w * v[j].w);
            const float rs = rsqrtf(wave_sum(ss) * (1.f / D) + RMS_EPS);
            u32x2* o = (u32x2*)(c.act + (size_t)tok * D) + lane;
#pragma unroll
            for (int j = 0; j < 4; ++j) { u32x2 w; w.x = pk2(v[j].x * rs * g4[j].x, v[j].y * rs * g4[j].y); w.y = pk2(v[j].z * rs * g4[j].z, v[j].w * rs * g4[j].w); o[64 * j] = w; }
        }
    }
}

__constant__ double kInvFreq[16] = {1.0, 0.44036660267178046, 0.19392274474868576, 0.08539710028576561, 0.03760603093086393, 0.016560440080994446, 0.007292664737217109, 0.003211445994752591,
    0.001414213562373095, 0.000622772421914596, 0.0002742481756762073, 0.00012076973741146504, 5.318295896944988e-05, 2.341999896140934e-05, 1.031338537721246e-05, 4.5416704806078695e-06};
__device__ __forceinline__ void phase_qkrope(const Ctx& c, const float* qg, const float* kg) {
    const int gw = c.bid * NWAVES + c.wave, NGW = c.G * NWAVES, lane = c.lane;
    const float qg0 = qg[2 * lane], qg1 = qg[2 * lane + 1], kg0 = kg[2 * lane], kg1 = kg[2 * lane + 1];
    const int i0 = 2 * (lane & 7);
    const double f0 = kInvFreq[i0], f1 = kInvFreq[i0 + 1];
    const float sgn = (lane & 8) ? 1.f : -1.f;
    for (int tok = gw; tok < TC; tok += NGW) {
        const double p = (double)c.pos[tok];
        double a0 = p * f0 * 0.15915494309189535, a1 = p * f1 * 0.15915494309189535;
        a0 -= rint(a0); a1 -= rint(a1);
        const float c0 = __builtin_amdgcn_cosf((float)a0), s0 = __builtin_amdgcn_sinf((float)a0), c1 = __builtin_amdgcn_cosf((float)a1), s1 = __builtin_amdgcn_sinf((float)a1);
        bf16_t* row = c.proj + (size_t)tok * NP + C_QKV;
#pragma unroll 4
        for (int hr = 0; hr < 24; ++hr) {
            unsigned* pp = (unsigned*)(row + hr * 128) + lane;
            const unsigned u = *pp; const float v0 = bflo(u), v1 = bfhi(u);
            const float rs = rsqrtf(wave_sum(v0 * v0 + v1 * v1) * (1.f / 128.f) + RMS_EPS);
            float y0 = v0 * rs * (hr < 12 ? qg0 : kg0), y1 = v1 * rs * (hr < 12 ? qg1 : kg1);
            const float p0 = __shfl_xor(y0, 8), p1 = __shfl_xor(y1, 8);
            if (lane < 16) { y0 = y0 * c0 + sgn * p0 * s0; y1 = y1 * c1 + sgn * p1 * s1; }
            *pp = pk2(y0, y1);
        }
    }
}

__device__ __forceinline__ float logsigmoidf_(float g) { return fminf(g, 0.f) - log1pf(__expf(-fabsf(g))); }
__device__ __forceinline__ float gelu_tanh(float y) { const float u = 0.7978845608028654f * (y + 0.044715f * y * y * y); const float t = 1.f - 2.f / (1.f + __expf(2.f * u)); return 0.5f * y * (1.f + t); }

__device__ __forceinline__ void gla_simple(const Ctx& c, int b, const float* gbias, const float* ogain) {
    LAS float* sQ = (LAS float*)c.lds; LAS float* sK = sQ + 16 * 256; LAS float* sA = sK + 16 * 256; LAS float* sO = sA + 16 * 256; LAS float* sV = sO + 16 * 512;
    const int tid = c.tid, h = tid >> 7, lane = c.lane;
    float S[64];
#pragma unroll
    for (int i = 0; i < 64; ++i) S[i] = 0.f;
    const float og0 = ogain[2 * lane], og1 = ogain[2 * lane + 1];
    for (int tc = 0; tc < SEQ / 16; ++tc) {
        const size_t tok0 = (size_t)b * SEQ + tc * 16;
        __syncthreads();
        for (int idx = tid; idx < 16 * 256; idx += NTHR) { const int s = idx >> 8, ci = idx & 255; const bf16_t* row = c.proj + (tok0 + s) * NP;
            sQ[idx] = bf2f(row[C_QA + ci]); sK[idx] = bf2f(row[C_KA + ci]);
            sA[idx] = __expf(logsigmoidf_(bf2f(row[C_GP + ci]) + gbias[ci]) * (1.f / 16.f)); }
#pragma unroll
        for (int s = 0; s < 16; ++s) sV[s * 512 + tid] = bf2f(c.proj[(tok0 + s) * NP + C_VA + tid]);
        __syncthreads();
        for (int s = 0; s < 16; ++s) {
            const float v = sV[s * 512 + tid]; float o = 0.f;
            const LAS f32x4* a4 = (const LAS f32x4*)(sA + s * 256 + h * 64); const LAS f32x4* k4 = (const LAS f32x4*)(sK + s * 256 + h * 64); const LAS f32x4* q4 = (const LAS f32x4*)(sQ + s * 256 + h * 64);
#pragma unroll
            for (int d = 0; d < 16; ++d) { const f32x4 a = a4[d], k = k4[d], q = q4[d];
                S[4 * d + 0] = S[4 * d + 0] * a.x + k.x * v; o += q.x * S[4 * d + 0];
                S[4 * d + 1] = S[4 * d + 1] * a.y + k.y * v; o += q.y * S[4 * d + 1];
                S[4 * d + 2] = S[4 * d + 2] * a.z + k.z * v; o += q.z * S[4 * d + 2];
                S[4 * d + 3] = S[4 * d + 3] * a.w + k.w * v; o += q.w * S[4 * d + 3]; }
            sO[s * 512 + tid] = o;
        }
        __syncthreads();
#pragma unroll 2
        for (int k = 0; k < 8; ++k) { const int rr = c.wave * 8 + k, s = rr >> 2, hh = rr & 3;
            const float o0 = sO[s * 512 + hh * 128 + 2 * lane], o1 = sO[s * 512 + hh * 128 + 2 * lane + 1];
            const float rs = rsqrtf(wave_sum(o0 * o0 + o1 * o1) * (1.f / 128.f) + RMS_EPS);
            unsigned* pp = (unsigned*)(c.proj + (tok0 + s) * NP + C_OG + hh * 128) + lane;
            const unsigned u = *pp; const float g0 = bflo(u), g1 = bfhi(u);
            *pp = pk2(o0 * rs * og0 * g0 * sigmoidf_(g0), o1 * rs * og1 * g1 * sigmoidf_(g1)); }
    }
}

__device__ __forceinline__ void lru_simple(const Ctx& c, int b, const float* convw, const float* convb, const float* wa_, const float* ba_, const float* wx_, const float* bx_, const float* lam_) {
    const int ch = c.tid, n = c.wave, lane = c.lane;
    LAS float* sX = (LAS float*)(c.lds + n * 4096);
    const float* wap = wa_ + n * 4096 + lane; const float* wxp = wx_ + n * 4096 + lane;
    const float cw0 = convw[ch], cw1 = convw[512 + ch], cw2 = convw[1024 + ch], cw3 = convw[1536 + ch], cb = convb[ch], ba = ba_[ch], bx = bx_[ch];
    const float lam = lam_[ch]; const float c8 = 8.f * (fmaxf(-lam, 0.f) + log1pf(__expf(-fabsf(lam))));
    float xm1 = 0.f, xm2 = 0.f, xm3 = 0.f, hs = 0.f;
    for (int tc = 0; tc < SEQ / 16; ++tc) {
        const size_t tok0 = (size_t)b * SEQ + tc * 16;
        float xc[16], yv[16], ar[16], ai[16];
#pragma unroll
        for (int s = 0; s < 16; ++s) { xc[s] = bf2f(c.proj[(tok0 + s) * NP + C_XB + ch]); yv[s] = bf2f(c.proj[(tok0 + s) * NP + C_YB + ch]); }
#pragma unroll
        for (int s = 0; s < 16; ++s) { const float x = xc[s]; xc[s] = cb + cw0 * xm3 + cw1 * xm2 + cw2 * xm1 + cw3 * x; xm3 = xm2; xm2 = xm1; xm1 = x; sX[s * 64 + lane] = xc[s]; ar[s] = ba; ai[s] = bx; }
        LDS_WAIT(); asm volatile("" ::: "memory"); __builtin_amdgcn_wave_barrier();
#pragma unroll 2
        for (int k = 0; k < 64; ++k) { const float wa = wap[k * 64], wx = wxp[k * 64];
#pragma unroll
            for (int s = 0; s < 16; ++s) { const float x = sX[s * 64 + k]; ar[s] += x * wa; ai[s] += x * wx; } }
#pragma unroll
        for (int s = 0; s < 16; ++s) {
            const float r = sigmoidf_(ar[s]), ig = sigmoidf_(ai[s]);
            const float a = __expf(-c8 * r);
            const float u = sqrtf(fmaxf(1.f - a * a, 0.f)) * ig * xc[s];
            hs = a * hs + u;
            c.proj[(tok0 + s) * NP + C_YB + ch] = (bf16_t)f2bf(hs * gelu_tanh(yv[s]));
        }
        LDS_WAIT(); asm volatile("" ::: "memory"); __builtin_amdgcn_wave_barrier();
    }
}

__device__ __forceinline__ void attn_simple(const Ctx& c, int aw, int NAW) {
    const int lane = c.lane;
    for (int task = aw; task < TC * 4; task += NAW) {
        const int tok = task >> 2, h = task & 3, t = tok & (SEQ - 1);
        float ml = -INFINITY, wsum = 0.f, acc0 = 0.f, acc1 = 0.f;
#pragma unroll 1
        for (int p = 0; p < 3; ++p) {
            const int dsh = 2 * p, i = t >> dsh, nk = i + 1 < 129 ? i + 1 : 129;
            const bf16_t* qrow = c.proj + (size_t)tok * NP + C_QKV + (p * 4 + h) * 128;
            const int kcol = C_QKV + (12 + p * 4 + h) * 128, vcol = C_QKV + (24 + p * 4 + h) * 128;
            float sc[3];
#pragma unroll
            for (int r = 0; r < 3; ++r) {
                sc[r] = -INFINITY;
                if (64 * r < nk) {
                    const int m = 64 * r + lane; const bool valid = m < nk;
                    const bf16_t* krow = c.proj + (size_t)(tok - ((valid ? m : 0) << dsh)) * NP + kcol;
                    float s = 0.f;
#pragma unroll 1
                    for (int cb = 0; cb < 4; ++cb) {
                        u32x4 kq[4], qq[4];
#pragma unroll
                        for (int j = 0; j < 4; ++j) { kq[j] = *((const u32x4*)krow + cb * 4 + j); qq[j] = *((const u32x4*)qrow + cb * 4 + j); }
#pragma unroll
                        for (int j = 0; j < 4; ++j) {
                            s += bflo(kq[j].x) * bflo(qq[j].x) + bfhi(kq[j].x) * bfhi(qq[j].x) + bflo(kq[j].y) * bflo(qq[j].y) + bfhi(kq[j].y) * bfhi(qq[j].y)
                               + bflo(kq[j].z) * bflo(qq[j].z) + bfhi(kq[j].z) * bfhi(qq[j].z) + bflo(kq[j].w) * bflo(qq[j].w) + bfhi(kq[j].w) * bfhi(qq[j].w); }
                    }
                    sc[r] = valid ? s * 0.08838834764831845f : -INFINITY;
                }
            }
            const float mx = wave_max(fmaxf(sc[0], fmaxf(sc[1], sc[2])));
            float pr[3];
#pragma unroll
            for (int r = 0; r < 3; ++r) pr[r] = __expf(sc[r] - mx);
            const float den = wave_sum(pr[0] + pr[1] + pr[2]);
            float o0 = 0.f, o1 = 0.f;
#pragma unroll
            for (int r = 0; r < 3; ++r) {
                const int cnt = nk - 64 * r < 64 ? nk - 64 * r : 64;
                if (cnt > 0) {
                const unsigned* vb = (const unsigned*)(c.proj + (size_t)(tok - ((64 * r) << dsh)) * NP + vcol) + lane;
#pragma unroll 4
                for (int mm = 0; mm < cnt; ++mm) {
                    const float pm = __int_as_float(__builtin_amdgcn_readlane(__float_as_int(pr[r]), mm));
                    const unsigned u = *(const unsigned*)((const char*)vb - (size_t)(mm << dsh) * NP * 2);
                    o0 += pm * bflo(u); o1 += pm * bfhi(u); }
                }
            }
            const float inv = 1.f / den, lse = mx + __logf(den);
            const float nml = fmaxf(ml, lse), sc_old = __expf(ml - nml), w = __expf(lse - nml);
            acc0 = acc0 * sc_old + w * o0 * inv; acc1 = acc1 * sc_old + w * o1 * inv; wsum = wsum * sc_old + w; ml = nml;
        }
        const float wi = 1.f / wsum;
        unsigned* op = (unsigned*)(c.proj + (size_t)tok * NP + C_QKV + h * 128) + lane;
        *op = pk2(acc0 * wi, acc1 * wi);
    }
}

typedef unsigned short u16x4 __attribute__((ext_vector_type(4)));
__device__ __forceinline__ unsigned offb(unsigned row, unsigned ch) { return 256u * row + 16u * (ch ^ (((row & 3u) << 2) | ((row >> 2) & 3u))); }
constexpr int ATT_UNITS_PER_SEQ = 3 * 4 * 16;
__device__ __forceinline__ void attn_unit(const Ctx& c, int unit, float* lse_buf) {
    const int tid = c.tid, lane = c.lane, w = c.wave;
    const int b = unit / ATT_UNITS_PER_SEQ, rem = unit % ATT_UNITS_PER_SEQ, p = rem / 64, h = (rem / 16) & 3, qb = rem & 15;
    const int dsh = 2 * p, dil = 1 << dsh, nblk = 16 >> dsh;
    const int r = qb / nblk, blk = qb % nblk;
    const size_t tok0 = (size_t)b * SEQ + r;
    const int qcol = C_QKV + (p * 4 + h) * 128, kcol = C_QKV + (12 + p * 4 + h) * 128, vcol = C_QKV + (24 + p * 4 + h) * 128;
    LAS unsigned char* sK = c.lds; LAS unsigned char* sV = c.lds + 65536;
    {
#pragma unroll
        for (int it = 0; it < 8; ++it) { const int q = w + 8 * it; const unsigned n = 64u * q + lane, row = n >> 4, cs = n & 15u, ch = cs ^ (((row & 3u) << 2) | ((row >> 2) & 3u));
            int srow = (blk - 1) * 128 + (int)row; if (srow < 0) srow += 128;
            const bf16_t* g = c.proj + (tok0 + ((size_t)srow << dsh)) * NP + kcol + ch * 8;
            __builtin_amdgcn_global_load_lds((const unsigned*)g, (LAS unsigned*)(sK + 1024 * q), 16, 0, 0); }
#pragma unroll
        for (int it = 0; it < 8; ++it) { const int q = w + 8 * it; const unsigned n = 64u * q + lane, row = n >> 4, cs = n & 15u, ch = cs ^ (((row & 3u) << 2) | ((row >> 2) & 3u));
            int srow = (blk - 1) * 128 + (int)row; if (srow < 0) srow += 128;
            const bf16_t* g = c.proj + (tok0 + ((size_t)srow << dsh)) * NP + vcol + ch * 8;
            __builtin_amdgcn_global_load_lds((const unsigned*)g, (LAS unsigned*)(sV + 1024 * q), 16, 0, 0); }
    }
    const int qq = lane & 15, g = lane >> 4, qi = 16 * w + qq;
    const size_t qtok = tok0 + ((size_t)(blk * 128 + qi) << dsh);
    bf16x8 qf[4];
#pragma unroll
    for (int s = 0; s < 4; ++s) qf[s] = *(const bf16x8*)(c.proj + qtok * NP + qcol + 32 * s + 8 * g);
    asm volatile("s_waitcnt vmcnt(0)" ::: "memory");
    __syncthreads();
    const int ks0 = w >> 1;
    f32x4 st[5][2];
    const unsigned krow_l = 8u * (qq >> 2) + (qq & 3u);
#pragma unroll
    for (int n = 0; n < 5; ++n)
#pragma unroll
        for (int T = 0; T < 2; ++T) { f32x4 a = {0.f, 0.f, 0.f, 0.f}; const unsigned key = 32u * (ks0 + n) + krow_l + 4u * T;
#pragma unroll
            for (int s = 0; s < 4; ++s) { const bf16x8 kf = *(const LAS bf16x8*)(sK + offb(key, 4 * s + g)); a = __builtin_amdgcn_mfma_f32_16x16x32_bf16(kf, qf[s], a, 0, 0, 0); }
            st[n][T] = a; }
    const float SC = 0.08838834764831845f * 1.4426950408889634f;
    float mx = -INFINITY;
#pragma unroll
    for (int n = 0; n < 5; ++n)
#pragma unroll
        for (int T = 0; T < 2; ++T)
#pragma unroll
            for (int i = 0; i < 4; ++i) { const int kj = 32 * (ks0 + n) + 8 * g + 4 * T + i; const bool ok = (kj >= qi) && (kj <= qi + 128) && (blk > 0 || kj >= 128);
                const float v = ok ? st[n][T][i] : -INFINITY; st[n][T][i] = v; mx = fmaxf(mx, v); }
    mx = fmaxf(mx, swz_xor<16>(mx));
    { const auto rr = __builtin_amdgcn_permlane32_swap(__float_as_uint(mx), __float_as_uint(mx), false, false); mx = fmaxf(__uint_as_float(rr[0]), __uint_as_float(rr[1])); }
    float sum = 0.f;
#pragma unroll
    for (int n = 0; n < 5; ++n)
#pragma unroll
        for (int T = 0; T < 2; ++T)
#pragma unroll
            for (int i = 0; i < 4; ++i) { const float e = __builtin_amdgcn_exp2f((st[n][T][i] - mx) * SC); st[n][T][i] = e; sum += e; }
    sum += swz_xor<16>(sum);
    { const auto rr = __builtin_amdgcn_permlane32_swap(__float_as_uint(sum), __float_as_uint(sum), false, false); sum = __uint_as_float(rr[0]) + __uint_as_float(rr[1]); }
    const float inv = 1.f / sum;
    f32x4 ot[8];
#pragma unroll
    for (int cc = 0; cc < 8; ++cc) ot[cc] = (f32x4){0.f, 0.f, 0.f, 0.f};
    const unsigned tq = (unsigned)qq >> 2, tp = (unsigned)qq & 3u;
    const unsigned vbase = (unsigned)(size_t)sV;
#pragma unroll
    for (int n = 0; n < 5; ++n) {
        u32x4 pw; pw.x = pg8::cvt_pk_bf16(st[n][0][0], st[n][0][1]); pw.y = pg8::cvt_pk_bf16(st[n][0][2], st[n][0][3]); pw.z = pg8::cvt_pk_bf16(st[n][1][0], st[n][1][1]); pw.w = pg8::cvt_pk_bf16(st[n][1][2], st[n][1][3]);
        const bf16x8 pf = __builtin_bit_cast(bf16x8, pw);
#pragma unroll
        for (int cc = 0; cc < 8; ++cc) {
            const unsigned a0 = vbase + offb(32u * (ks0 + n) + 8u * g + tq, 2 * cc + (tp >> 1)) + 8u * (tp & 1u);
            const unsigned a1 = vbase + offb(32u * (ks0 + n) + 8u * g + 4u + tq, 2 * cc + (tp >> 1)) + 8u * (tp & 1u);
            u16x4 v0, v1;
            asm volatile("ds_read_b64_tr_b16 %0, %2\n\tds_read_b64_tr_b16 %1, %3\n\ts_waitcnt lgkmcnt(0)" : "=&v"(v0), "=&v"(v1) : "v"(a0), "v"(a1) : "memory");
            bf16x8 vf; vf[0] = (short)v0[0]; vf[1] = (short)v0[1]; vf[2] = (short)v0[2]; vf[3] = (short)v0[3]; vf[4] = (short)v1[0]; vf[5] = (short)v1[1]; vf[6] = (short)v1[2]; vf[7] = (short)v1[3];
            ot[cc] = __builtin_amdgcn_mfma_f32_16x16x32_bf16(vf, pf, ot[cc], 0, 0, 0);
        }
    }
    bf16_t* orow = c.proj + qtok * NP + qcol;
#pragma unroll
    for (int cc = 0; cc < 8; ++cc) { u32x2 o; o.x = pg8::cvt_pk_bf16(ot[cc][0] * inv, ot[cc][1] * inv); o.y = pg8::cvt_pk_bf16(ot[cc][2] * inv, ot[cc][3] * inv); *(u32x2*)(orow + 16 * cc + 4 * g) = o; }
    if (g == 0) lse_buf[qtok * 12 + p * 4 + h] = mx * 0.08838834764831845f + __logf(sum);
    __syncthreads();
}

__device__ __forceinline__ void phase_attn_combine(const Ctx& c, const float* lse_buf) {
    const int gw = c.bid * NWAVES + c.wave, NGW = c.G * NWAVES, lane = c.lane;
    for (int tok = gw; tok < TC; tok += NGW) {
        const float* ls = lse_buf + (size_t)tok * 12;
        bf16_t* row = c.proj + (size_t)tok * NP + C_QKV;
#pragma unroll
        for (int h = 0; h < 4; ++h) {
            const float l0 = ls[h], l1 = ls[4 + h], l2 = ls[8 + h], ml = fmaxf(l0, fmaxf(l1, l2));
            const float w0 = __expf(l0 - ml), w1 = __expf(l1 - ml), w2 = __expf(l2 - ml), wi = 1.f / (w0 + w1 + w2);
            unsigned* p0 = (unsigned*)(row + h * 128) + lane;
            const unsigned u0 = *p0, u1 = *((const unsigned*)(row + (4 + h) * 128) + lane), u2 = *((const unsigned*)(row + (8 + h) * 128) + lane);
            *p0 = pk2((w0 * bflo(u0) + w1 * bflo(u1) + w2 * bflo(u2)) * wi, (w0 * bfhi(u0) + w1 * bfhi(u1) + w2 * bfhi(u2)) * wi);
        }
    }
}

constexpr int TPB = TC / 256;
__device__ __forceinline__ void phase_router(const Ctx& c, const float* gain, const float* rw, const float* rb, unsigned* gcnt) {
    LAS float* sRW = (LAS float*)c.lds;
    LAS unsigned* sRec = (LAS unsigned*)(c.lds + 65536);
    LAS unsigned* sCnt = (LAS unsigned*)(c.lds + MISC_OFF + 256);
    LAS unsigned* sBase = sCnt + 16;
    const int tid = c.tid, lane = c.lane;
    for (int idx = tid; idx < D * NE; idx += NTHR) sRW[(idx & 15) * D + (idx >> 4)] = rw[idx];
    if (tid < 16) sCnt[tid] = 0u;
    f32x4 g4[4];
#pragma unroll
    for (int j = 0; j < 4; ++j) g4[j] = *((const f32x4*)gain + 64 * j + lane);
    float rbv[16];
#pragma unroll
    for (int e = 0; e < 16; ++e) rbv[e] = rb[e];
    __syncthreads();
    for (int lt = c.wave; lt < TPB; lt += NWAVES) {
        const int tok = c.bid * TPB + lt;
        const f32x4* xr = (const f32x4*)(c.xo + (size_t)tok * D) + lane;
        f32x4 v[4]; float ss = 0.f;
#pragma unroll
        for (int j = 0; j < 4; ++j) { v[j] = xr[64 * j]; ss += (v[j].x * v[j].x + v[j].y * v[j].y) + (v[j].z * v[j].z + v[j].w * v[j].w); }
        const float rs = rsqrtf(wave_sum(ss) * (1.f / D) + RMS_EPS);
        u32x2* o = (u32x2*)(c.act + (size_t)tok * D) + lane;
#pragma unroll
        for (int j = 0; j < 4; ++j) { v[j] = v[j] * rs * g4[j]; u32x2 w; w.x = pk2(v[j].x, v[j].y); w.y = pk2(v[j].z, v[j].w); o[64 * j] = w; }
        float sc[16]; float mx = -INFINITY;
#pragma unroll
        for (int e = 0; e < 16; ++e) { float p = 0.f;
#pragma unroll
            for (int j = 0; j < 4; ++j) { const f32x4 w = *((const LAS f32x4*)(sRW + e * D) + 64 * j + lane); p += (v[j].x * w.x + v[j].y * w.y) + (v[j].z * w.z + v[j].w * w.w); }
            sc[e] = wave_sum(p) + rbv[e]; mx = fmaxf(mx, sc[e]); }
        float sum = 0.f;
#pragma unroll
        for (int e = 0; e < 16; ++e) { sc[e] = __expf(sc[e] - mx); sum += sc[e]; }
        const float isum = 1.f / sum;
#pragma unroll
        for (int e = 0; e < 16; ++e) sc[e] *= isum;
        int gsel = 0; float gbest = -1.f;
#pragma unroll
        for (int g = 0; g < 4; ++g) { const float a = sc[4 * g], b = sc[4 * g + 1], cc = sc[4 * g + 2], d = sc[4 * g + 3];
            const float hi1 = fmaxf(a, b), lo1 = fminf(a, b), hi2 = fmaxf(cc, d), lo2 = fminf(cc, d);
            const float top = fmaxf(hi1, hi2), second = fmaxf(fminf(hi1, hi2), fmaxf(lo1, lo2));
            const float gs = top + second; if (gs > gbest) { gbest = gs; gsel = g; } }
        float s4[4];
#pragma unroll
        for (int k = 0; k < 4; ++k) s4[k] = gsel == 0 ? sc[k] : gsel == 1 ? sc[4 + k] : gsel == 2 ? sc[8 + k] : sc[12 + k];
        int i0 = 0; float b0 = s4[0];
#pragma unroll
        for (int k = 1; k < 4; ++k) if (s4[k] > b0) { b0 = s4[k]; i0 = k; }
        int i1 = -1; float b1 = -1.f;
#pragma unroll
        for (int k = 0; k < 4; ++k) if (k != i0 && s4[k] > b1) { b1 = s4[k]; i1 = k; }
        const int e0 = 4 * gsel + i0, e1 = 4 * gsel + i1; const float wn = 1.f / (b0 + b1);
        if (lane == 0) { const unsigned l0 = atomicAdd((unsigned*)&sCnt[e0], 1u), l1 = atomicAdd((unsigned*)&sCnt[e1], 1u);
            sRec[lt * 6 + 0] = (unsigned)e0; sRec[lt * 6 + 1] = l0; sRec[lt * 6 + 2] = (unsigned)e1; sRec[lt * 6 + 3] = l1; sRec[lt * 6 + 4] = __float_as_uint(b0 * wn); sRec[lt * 6 + 5] = __float_as_uint(b1 * wn); }
    }
    __syncthreads();
    if (tid < 16) sBase[tid] = __hip_atomic_fetch_add(gcnt + tid, sCnt[tid], __ATOMIC_RELAXED, __HIP_MEMORY_SCOPE_AGENT);
    __syncthreads();
    if (tid < TPB) { const int tok = c.bid * TPB + tid; const unsigned e0 = sRec[tid * 6], e1 = sRec[tid * 6 + 2];
        const unsigned p0 = sBase[e0] + sRec[tid * 6 + 1], p1 = sBase[e1] + sRec[tid * 6 + 3];
        u32x4 r; r.x = (e0 << 20) | p0; r.y = (e1 << 20) | p1; r.z = sRec[tid * 6 + 4]; r.w = sRec[tid * 6 + 5];
        *(u32x4*)(c.rec + (size_t)tok * 4) = r;
        c.list[(size_t)e0 * TC + p0] = tok; c.list[(size_t)e1 * TC + p1] = tok; }
}

struct PlainOrder {
    int nM, nN, G, c; const char* A; const char* Bt; size_t a_tile, b_tile;
    __device__ __forceinline__ bool next(int i, pg8::Unit& u) const { u.g = 0; return pg8::static_tile(nM, nN, G, c, i, u.pm, u.pn); }
    __device__ __forceinline__ const char* aptr(const pg8::Unit& u) const { return A + (size_t)u.pm * a_tile; }
    __device__ __forceinline__ const char* bptr(const pg8::Unit& u) const { return Bt + (size_t)u.pn * b_tile; }
    __device__ __forceinline__ unsigned arow(const pg8::Unit&, int) const { return 0u; }
};
struct MergeOrder {
    int G, c; const char* proj; const char* wbr;
    __device__ __forceinline__ bool next(int i, pg8::Unit& u) const { u.g = i % 3; return pg8::static_tile(TC / 256, 4, G, c, i / 3, u.pm, u.pn); }
    __device__ __forceinline__ const char* aptr(const pg8::Unit& u) const { const int col = u.g == 0 ? C_OG : (u.g == 1 ? C_YB : C_QKV); return proj + ((size_t)u.pm * 256 * NP + col) * 2; }
    __device__ __forceinline__ const char* bptr(const pg8::Unit& u) const { return wbr + ((size_t)u.g * D * 512 + (size_t)u.pn * 256 * 512) * 2; }
    __device__ __forceinline__ unsigned arow(const pg8::Unit&, int) const { return 0u; }
};
template <bool UP> struct MoeOrder {
    int G, c; LAS const int* pt; LAS const int* lc; const char* A; const char* W; const int* list;
    __device__ __forceinline__ bool next(int i, pg8::Unit& u) const { const int L = i * G + c, tau = L >> 2; if (tau >= pt[NE]) return false;
        int e = 0;
#pragma unroll
        for (int k = 1; k < NE; ++k) e += (tau >= pt[k]) ? 1 : 0;
        u.pm = tau; u.pn = L & 3; u.g = e; return true; }
    __device__ __forceinline__ const char* aptr(const pg8::Unit& u) const { return UP ? A : A + (size_t)u.pm * 256 * FF * 2; }
    __device__ __forceinline__ const char* bptr(const pg8::Unit& u) const { return UP ? W + ((size_t)u.g * 1024 * D + (size_t)u.pn * 256 * D) * 2 : W + ((size_t)u.g * D * FF + (size_t)u.pn * 256 * FF) * 2; }
    __device__ __forceinline__ unsigned arow(const pg8::Unit& u, int r) const { int p = (u.pm - pt[u.g]) * 256 + r; const int n = lc[u.g]; p = p < n ? p : n - 1;
        return (unsigned)list[(size_t)u.g * TC + p] * (unsigned)(D * 2); }
};

struct EpiStoreBf16 {
    static constexpr bool PERM = true;
    bf16_t* O; int ldc;
    __device__ __forceinline__ void operator()(const f32x4 (&acc)[2][2][4][2], const pg8::Unit& u, int wr, int wc, int fr, int fq) const {
        const int row0 = u.pm * 256 + wr * 64 + fr, col0 = u.pn * 256 + wc * 32 + 8 * fq;
#pragma unroll
        for (int ai = 0; ai < 2; ++ai)
#pragma unroll
            for (int m = 0; m < 4; ++m) { bf16_t* rowp = O + (size_t)(row0 + ai * 128 + m * 16) * ldc + col0;
#pragma unroll
                for (int bj = 0; bj < 2; ++bj) { const f32x4 v0 = acc[ai][bj][m][0], v1 = acc[ai][bj][m][1];
                    u32x4 w; w.x = pg8::cvt_pk_bf16(v0[0], v0[1]); w.y = pg8::cvt_pk_bf16(v0[2], v0[3]); w.z = pg8::cvt_pk_bf16(v1[0], v1[1]); w.w = pg8::cvt_pk_bf16(v1[2], v1[3]);
                    *(u32x4*)(rowp + bj * 128) = w; } }
    }
};
struct EpiMerge {
    static constexpr bool PERM = true;
    const bf16_t* proj; bf16_t* mg;
    __device__ __forceinline__ void operator()(const f32x4 (&acc)[2][2][4][2], const pg8::Unit& u, int wr, int wc, int fr, int fq) const {
        const int row0 = u.pm * 256 + wr * 64 + fr, col0 = u.pn * 256 + wc * 32 + 8 * fq;
#pragma unroll
        for (int ai = 0; ai < 2; ++ai)
#pragma unroll
            for (int m = 0; m < 4; ++m) { const size_t row = (size_t)(row0 + ai * 128 + m * 16);
#pragma unroll
                for (int bj = 0; bj < 2; ++bj) { const int col = col0 + bj * 128;
                    const u32x4 gv = *(const u32x4*)(proj + row * NP + C_G + u.g * D + col);
                    const f32x4 v0 = acc[ai][bj][m][0], v1 = acc[ai][bj][m][1];
                    float r[8];
                    r[0] = v0[0] * sigmoidf_(bflo(gv.x)); r[1] = v0[1] * sigmoidf_(bfhi(gv.x)); r[2] = v0[2] * sigmoidf_(bflo(gv.y)); r[3] = v0[3] * sigmoidf_(bfhi(gv.y));
                    r[4] = v1[0] * sigmoidf_(bflo(gv.z)); r[5] = v1[1] * sigmoidf_(bfhi(gv.z)); r[6] = v1[2] * sigmoidf_(bflo(gv.w)); r[7] = v1[3] * sigmoidf_(bfhi(gv.w));
                    u32x4* mp = (u32x4*)(mg + row * D + col);
                    if (u.g > 0) { const u32x4 pv = *mp;
                        r[0] += bflo(pv.x); r[1] += bfhi(pv.x); r[2] += bflo(pv.y); r[3] += bfhi(pv.y); r[4] += bflo(pv.z); r[5] += bfhi(pv.z); r[6] += bflo(pv.w); r[7] += bfhi(pv.w); }
                    u32x4 w; w.x = pg8::cvt_pk_bf16(r[0], r[1]); w.y = pg8::cvt_pk_bf16(r[2], r[3]); w.z = pg8::cvt_pk_bf16(r[4], r[5]); w.w = pg8::cvt_pk_bf16(r[6], r[7]);
                    *mp = w; } }
    }
};
struct EpiResid {
    static constexpr bool PERM = false;
    const float* base; float* out;
    __device__ __forceinline__ void operator()(const f32x4 (&acc)[2][2][4][2], const pg8::Unit& u, int wr, int wc, int fr, int fq) const {
        const int row0 = u.pm * 256 + wr * 64 + fr, col0 = u.pn * 256 + wc * 32 + 4 * fq;
#pragma unroll
        for (int ai = 0; ai < 2; ++ai)
#pragma unroll
            for (int m = 0; m < 4; ++m) { const size_t off = (size_t)(row0 + ai * 128 + m * 16) * D + col0;
#pragma unroll
                for (int bj = 0; bj < 2; ++bj)
#pragma unroll
                    for (int n = 0; n < 2; ++n) { const f32x4 b = *(const f32x4*)(base + off + bj * 128 + n * 16); *(f32x4*)(out + off + bj * 128 + n * 16) = b + acc[ai][bj][m][n]; } }
    }
};
struct EpiSwiGLU {
    static constexpr bool PERM = false;
    bf16_t* hid;
    __device__ __forceinline__ void operator()(const f32x4 (&acc)[2][2][4][2], const pg8::Unit& u, int wr, int wc, int fr, int fq) const {
        const int row0 = u.pm * 256 + wr * 64 + fr, col0 = u.pn * 128 + wc * 16 + 4 * fq;
#pragma unroll
        for (int ai = 0; ai < 2; ++ai)
#pragma unroll
            for (int m = 0; m < 4; ++m) { bf16_t* rowp = hid + (size_t)(row0 + ai * 128 + m * 16) * FF + col0;
#pragma unroll
                for (int bj = 0; bj < 2; ++bj) { const f32x4 g = acc[ai][bj][m][0], up = acc[ai][bj][m][1];
                    u32x2 w; w.x = pg8::cvt_pk_bf16(g[0] * sigmoidf_(g[0]) * up[0], g[1] * sigmoidf_(g[1]) * up[1]); w.y = pg8::cvt_pk_bf16(g[2] * sigmoidf_(g[2]) * up[2], g[3] * sigmoidf_(g[3]) * up[3]);
                    *(u32x2*)(rowp + bj * 64) = w; } }
    }
};

constexpr int PH_PER_PASS = 10, N_PASS = NCH * DEPTH, PH_TOTAL = 1 + N_PASS * PH_PER_PASS + 1;
#ifndef MK_LAUNCH_PER_PHASE
#define MK_LAUNCH_PER_PHASE 0
#endif
#ifndef PHMASK
#define PHMASK 0xFFFF
#endif
#ifndef MIXM
#define MIXM 7
#endif
#define EN(j) (((PHMASK) >> (j)) & 1)
typedef const __attribute__((address_space(4))) char* kptr_t;
__device__ __forceinline__ const void* karg_ptr(kptr_t kp, int i) { return *(const void* const __attribute__((address_space(4)))*)(kp + 8 * i); }
__device__ __forceinline__ void make_ctx(Ctx& c, kptr_t& kp, int pass) {
    int t = threadIdx.x; asm volatile("" : "+v"(t));
    kp = (kptr_t)__builtin_amdgcn_kernarg_segment_ptr(); asm volatile("" : "+s"(kp));
    c.tid = t; c.lane = t & 63; c.wave = __builtin_amdgcn_readfirstlane(t >> 6); c.bid = blockIdx.x; c.G = gridDim.x;
    unsigned char* ws = (unsigned char*)karg_ptr(kp, 25); float* out = (float*)karg_ptr(kp, 24);
    c.ctl = (unsigned*)(ws + WS_CTL);
    c.act = (bf16_t*)(ws + WS_ACT); c.proj = (bf16_t*)(ws + WS_PROJ); c.hid = (bf16_t*)(ws + WS_HID); c.ys = (bf16_t*)(ws + WS_YS);
    c.rec = (unsigned*)(ws + WS_REC); c.list = (int*)(ws + WS_LIST);
    const int chunk = pass / DEPTH, layer = pass % DEPTH;
    c.chunk = chunk; c.layer = layer; c.pass = pass;
    c.x_in = (const float*)karg_ptr(kp, 0) + (size_t)chunk * TC * D; c.xo = out + (size_t)chunk * TC * D;
    c.pos = (const int*)karg_ptr(kp, 1) + (size_t)chunk * TC;
    c.lw = ws + WS_W + (size_t)layer * LW_SIZE;
}
#define INP(i) ((const float*)karg_ptr(kp, (i)))
__global__ void __launch_bounds__(NTHR, 2) fwd(Args args) {
    extern __shared__ __attribute__((aligned(16))) unsigned char lds_raw[];
    Ctx c; kptr_t kp;
    c.lds = (LAS unsigned char*)lds_raw;
    make_ctx(c, kp, 0);
    volatile LAS unsigned* MISC = (volatile LAS unsigned*)(c.lds + MISC_OFF);
    LAS int* sPT = (LAS int*)(c.lds + MISC_OFF + 64);
    LAS int* sLC = (LAS int*)(c.lds + MISC_OFF + 160);
    for (int u = c.tid; u < 1024; u += NTHR) MISC[u] = 0u;
    __syncthreads();
    XcdBarrier bar; bar.bar = c.ctl + CW_BAR; bar.x = 0; bar.st = nullptr;
    if (!MK_LAUNCH_PER_PHASE) bar = xcd_barrier_post(c.ctl + CW_BAR, MISC);
    const int lo = args.ph_lo, hi = args.ph_hi;
#define IN(k) (lo <= (k) && (k) < hi)
#define SEAM(k) do { if (IN(k) && IN((k) + 1)) { XcdBarrier _b = bar; kptr_t _k = (kptr_t)__builtin_amdgcn_kernarg_segment_ptr(); asm volatile("" : "+s"(_k)); _b.bar = (unsigned*)((unsigned char*)karg_ptr(_k, 25) + WS_CTL) + CW_BAR; xcd_barrier(_b); } } while (0)

    if (EN(0) && IN(0)) { Args a2;
#pragma unroll
        for (int i = 0; i < 24; ++i) a2.in[i] = karg_ptr(kp, i);
        a2.ws = (unsigned char*)karg_ptr(kp, 25); a2.out = nullptr; a2.ph_lo = 0; a2.ph_hi = 0;
        phase_prep(a2, c.lds, c.bid * NWAVES + c.wave, c.G * NWAVES, c.wave, c.lane, c.bid * NTHR + c.tid, c.G * NTHR); }
    SEAM(0);

    for (int pass = 0; pass < N_PASS; ++pass) {
        const int pb = 1 + pass * PH_PER_PASS;
        if (EN(1) && IN(pb + 0)) { make_ctx(c, kp, pass);
            const float* g1 = INP(2) + c.layer * D;
            if (c.layer == 0) {
                if (c.chunk > 0) {
                    Ctx p = c; p.xo = c.xo - (size_t)TC * D;
                    moe_tables(c.ctl + CW_CNT + 64 * (pass - 1), sPT, sLC, c.tid);
                    phase_norm1<true, false, true>(p, nullptr, sPT);
                }
                phase_norm1<false, true, false>(c, g1, sPT);
            } else {
                moe_tables(c.ctl + CW_CNT + 64 * (pass - 1), sPT, sLC, c.tid);
                phase_norm1<true, true, true>(c, g1, sPT);
            }
        }
        SEAM(pb + 0);
        if (EN(2) && IN(pb + 1)) { make_ctx(c, kp, pass);
            PlainOrder S{TC / 256, NP / 256, c.G, c.bid, (const char*)c.act, (const char*)(c.lw + LW_WIN), (size_t)256 * D * 2, (size_t)256 * D * 2};
            EpiStoreBf16 E{c.proj, NP};
            pg8::gemm_phase<EpiStoreBf16, PlainOrder, false>(c.lds, S, E, D, D);
        }
        SEAM(pb + 1);
        if (EN(3) && IN(pb + 2)) { make_ctx(c, kp, pass); phase_qkrope(c, INP(14) + c.layer * 128, INP(15) + c.layer * 128); }
        SEAM(pb + 2);
        if (EN(4) && IN(pb + 3)) { make_ctx(c, kp, pass); const int layer = c.layer;
            if ((MIXM & 1) && c.bid < BC) gla_simple(c, c.bid, INP(5) + layer * 256, INP(6) + layer * 128);
            else if ((MIXM & 2) && c.bid < 2 * BC) lru_simple(c, c.bid - BC, INP(7) + layer * 4 * 512, INP(8) + layer * 512, INP(9) + layer * 8 * 64 * 64,
                                                INP(10) + layer * 512, INP(11) + layer * 8 * 64 * 64, INP(12) + layer * 512, INP(13) + layer * 512);
            else if (MIXM & 4) { float* lse = (float*)(c.ctl) + (WS_BRC / 4);
                for (int u = c.bid - 2 * BC; u < BC * ATT_UNITS_PER_SEQ; u += c.G - 2 * BC) attn_unit(c, u, lse); }
        }
        SEAM(pb + 3);
        if (EN(11) && IN(pb + 4)) { make_ctx(c, kp, pass); phase_attn_combine(c, (const float*)(c.ctl) + (WS_BRC / 4)); }
        SEAM(pb + 4);
        if (EN(5) && IN(pb + 5)) { make_ctx(c, kp, pass);
            MergeOrder S{c.G, c.bid, (const char*)c.proj, (const char*)(c.lw + LW_WBR)};
            EpiMerge E{c.proj, c.act};
            pg8::gemm_phase<EpiMerge, MergeOrder, false>(c.lds, S, E, 512, NP);
        }
        SEAM(pb + 5);
        if (EN(6) && IN(pb + 6)) { make_ctx(c, kp, pass);
            PlainOrder S{TC / 256, D / 256, c.G, c.bid, (const char*)c.act, (const char*)(c.lw + LW_WOUT), (size_t)256 * D * 2, (size_t)256 * D * 2};
            EpiResid E{c.layer == 0 ? c.x_in : (const float*)c.xo, c.xo};
            pg8::gemm_phase<EpiResid, PlainOrder, false>(c.lds, S, E, D, D);
        }
        SEAM(pb + 6);
        if (EN(7) && IN(pb + 7)) { make_ctx(c, kp, pass); phase_router(c, INP(18) + c.layer * D, INP(19), INP(20), c.ctl + CW_CNT + 64 * pass); }
        SEAM(pb + 7);
        if (EN(8) && IN(pb + 8)) { make_ctx(c, kp, pass);
            moe_tables(c.ctl + CW_CNT + 64 * pass, sPT, sLC, c.tid);
            MoeOrder<true> S{c.G, c.bid, sPT, sLC, (const char*)c.act, (const char*)(c.lw + LW_WGU), c.list};
            EpiSwiGLU E{c.hid};
            pg8::gemm_phase<EpiSwiGLU, MoeOrder<true>, true>(c.lds, S, E, D, D);
        }
        SEAM(pb + 8);
        if (EN(9) && IN(pb + 9)) { make_ctx(c, kp, pass);
            moe_tables(c.ctl + CW_CNT + 64 * pass, sPT, sLC, c.tid);
            MoeOrder<false> S{c.G, c.bid, sPT, sLC, (const char*)c.hid, (const char*)(c.lw + LW_WDN), c.list};
            EpiStoreBf16 E{c.ys, D};
            pg8::gemm_phase<EpiStoreBf16, MoeOrder<false>, false>(c.lds, S, E, FF, FF);
        }
        SEAM(pb + 9);
    }
    if (EN(10) && IN(PH_TOTAL - 1)) { make_ctx(c, kp, N_PASS - 1);
        moe_tables(c.ctl + CW_CNT + 64 * (N_PASS - 1), sPT, sLC, c.tid);
        phase_norm1<true, false, true>(c, nullptr, sPT);
    }
#undef IN
#undef SEAM
}

extern "C" void kernel_launch(void* const* d_in, const int* in_sizes, int n_in, void* d_out, int out_size, void* d_ws, size_t ws_size, hipStream_t stream) {
    static int grid = 0;
    if (grid == 0) {
        if (n_in != 24 || in_sizes[0] != BATCH * SEQ * D || out_size != BATCH * SEQ * D || ws_size < WS_END) { fprintf(stderr, "kernel_launch: unexpected shapes / workspace (%zu < %zu)\n", ws_size, (size_t)WS_END); grid = -1; return; }
        int dev = 0, cus = 0;
        if (hipGetDevice(&dev) != hipSuccess || hipDeviceGetAttribute(&cus, hipDeviceAttributeMultiprocessorCount, dev) != hipSuccess || cus < 256) { fprintf(stderr, "kernel_launch: needs a 256-CU device\n"); grid = -1; return; }
        if (hipFuncSetAttribute((const void*)fwd, hipFuncAttributeMaxDynamicSharedMemorySize, LDS_BYTES) != hipSuccess) { fprintf(stderr, "kernel_launch: hipFuncSetAttribute failed\n"); grid = -1; return; }
        int per_cu = 0;
        if (hipOccupancyMaxActiveBlocksPerMultiprocessor(&per_cu, (const void*)fwd, NTHR, LDS_BYTES) != hipSuccess || per_cu < 1) fprintf(stderr, "kernel_launch: occupancy query says %d\n", per_cu);
        (void)hipGetLastError();
        grid = 256;
    }
    if (grid < 0) return;
    if (hipMemsetAsync((char*)d_ws + WS_CTL, 0, CTL_ZERO_BYTES, stream) != hipSuccess) return;
    Args a{};
    for (int i = 0; i < 24; ++i) a.in[i] = d_in[i];
    a.out = (float*)d_out; a.ws = (unsigned char*)d_ws;
#if MK_LAUNCH_PER_PHASE
    for (int k = 0; k < PH_TOTAL; ++k) { a.ph_lo = k; a.ph_hi = k + 1; hipLaunchKernelGGL(fwd, dim3(grid), dim3(NTHR), LDS_BYTES, stream, a); }
#else
    a.ph_lo = 0; a.ph_hi = PH_TOTAL;
    hipLaunchKernelGGL(fwd, dim3(grid), dim3(NTHR), LDS_BYTES, stream, a);
#endif
}
```

```cpp
#include <hip/hip_runtime.h>
#include <cstdio>
#include <cstdint>

#define LAS __attribute__((address_space(3)))
#define GAS __attribute__((address_space(1)))
typedef unsigned short bf16_t;
typedef short bf16x8 __attribute__((ext_vector_type(8)));
typedef float f32x4 __attribute__((ext_vector_type(4)));
typedef float f32x2 __attribute__((ext_vector_type(2)));
typedef unsigned u32x4 __attribute__((ext_vector_type(4)));
typedef unsigned u32x2 __attribute__((ext_vector_type(2)));

namespace pg8 {
constexpr int BM = 256, BK = 64, HALF = 128, HTB = HALF * BK * 2, STAGE_BYTES = 8 * HTB, NXCD = 8, WGM = 8;
__host__ __device__ __forceinline__ int lds_byte(int r, int c) { const int st = (r >> 4) * 2 + (c >> 5), rr = r & 15, cc = c & 31, ob = rr * 64 + cc * 2; return st * 1024 + (ob ^ (((ob >> 9) & 1) << 5)); }
__host__ __device__ __forceinline__ void stage_rc(int b, int& R, int& C) { const int st = b / 1024, sb = b % 1024, swz = sb ^ (((sb >> 9) & 1) << 5); R = (st >> 1) * 16 + swz / 64; C = (st & 1) * 32 + (swz % 64) / 2; }
__host__ __device__ __forceinline__ int perm32(int rho) { const int n = rho >> 4, i = rho & 15; return 8 * (i >> 2) + 4 * n + (i & 3); }

struct Unit { int pm, pn, g; };

__device__ __forceinline__ bool static_tile(int nM, int nN, int G, int c, int i, int& pm, int& pn) {
    const int nwg = nM * nN; const long L = (long)i * G + c; if (L >= nwg) return false;
    int wgid = (int)L; { const int q = nwg / NXCD, r = nwg % NXCD, xcd = wgid % NXCD, off = wgid / NXCD; wgid = (xcd < r ? xcd * (q + 1) : r * (q + 1) + (xcd - r) * q) + off; }
    const int nig = WGM * nN, gid = wgid / nig, fm = gid * WGM, gsz = (nM - fm) < WGM ? (nM - fm) : WGM;
    pm = fm + ((wgid % nig) % gsz); pn = (wgid % nig) / gsz; return true;
}
__device__ __forceinline__ unsigned cvt_pk_bf16(float lo, float hi) { unsigned r; asm volatile("v_cvt_pk_bf16_f32 %0, %1, %2" : "=v"(r) : "v"(lo), "v"(hi)); return r; }

template <class Epi, class Sched, bool GATHER>
__device__ __forceinline__ void gemm_phase(LAS unsigned char* lds, const Sched& S, const Epi& E, const int K, const int lda) {
    int tid_ = threadIdx.x; asm volatile("" : "+v"(tid_));
    const int tid = tid_, wid = __builtin_amdgcn_readfirstlane(tid >> 6), lane = tid & 63, wr = wid >> 2, wc = wid & 3, fr = lane & 15, fq = lane >> 4;
    const int nt = K / BK;
    int sR[2], sC[2];
    unsigned voffB[2], voffA[2], vAc[2][2], vAn[2][2];
#pragma unroll
    for (int i = 0; i < 2; ++i) { int R, C; stage_rc(tid * 16 + i * 8192, R, C); sR[i] = R; sC[i] = C; const int Rb = Epi::PERM ? ((R & ~31) + perm32(R & 31)) : R;
        voffB[i] = (unsigned)(Rb * K + C) * 2u; voffA[i] = (unsigned)(R * lda + C) * 2u; }
    const size_t kstep = (size_t)(BK * 2);
    const size_t hstepB = (size_t)HALF * K * 2, hstepA = (size_t)HALF * lda * 2;
    const unsigned ldsw = (unsigned)wid * 1024u;
    const int aoff = lds_byte(wr * 64 + fr, fq * 8), boff = lds_byte(wc * 32 + fr, fq * 8);
#define PG8_SA(b, h) (((b) * 2 + (h)) * HTB)
#define PG8_SB(b, h) ((4 + (b) * 2 + (h)) * HTB)
#define PG8_STAGE(bufoff, gbase, voff) do { _Pragma("unroll") for (int _i = 0; _i < 2; ++_i) \
        __builtin_amdgcn_global_load_lds((const unsigned*)((const char*)(gbase) + (voff)[_i]), (LAS unsigned*)(lds + (bufoff) + ldsw + _i * 8192), 16, 0, 0); } while (0)
#define PG8_LDA(dst, b, h) do { _Pragma("unroll") for (int m = 0; m < 4; ++m) _Pragma("unroll") for (int k = 0; k < 2; ++k) dst[m][k] = *(const LAS bf16x8*)(lds + PG8_SA(b, h) + aoff + m * 2048 + k * 1024); } while (0)
#define PG8_LDB(dst, b, h) do { _Pragma("unroll") for (int n = 0; n < 2; ++n) _Pragma("unroll") for (int k = 0; k < 2; ++k) dst[n][k] = *(const LAS bf16x8*)(lds + PG8_SB(b, h) + boff + n * 2048 + k * 1024); } while (0)
#define PG8_MMA(ai, bj, At, Bt) do { __builtin_amdgcn_s_setprio(1); _Pragma("unroll") for (int m = 0; m < 4; ++m) _Pragma("unroll") for (int n = 0; n < 2; ++n) _Pragma("unroll") for (int k = 0; k < 2; ++k) \
        acc[ai][bj][m][n] = __builtin_amdgcn_mfma_f32_16x16x32_bf16(Bt[n][k], At[m][k], acc[ai][bj][m][n], 0, 0, 0); __builtin_amdgcn_s_setprio(0); } while (0)
#define PG8_WAIT_V(n) asm volatile("s_waitcnt vmcnt(" #n ")" ::: "memory")
#define PG8_WAIT_L(n) asm volatile("s_waitcnt lgkmcnt(" #n ")" ::: "memory")
#define PG8_BAR __builtin_amdgcn_s_barrier()
#define PG8_SCHED __builtin_amdgcn_sched_barrier(0)
#define PG8_AOFF(dst, u) do { if constexpr (GATHER) { _Pragma("unroll") for (int _h = 0; _h < 2; ++_h) _Pragma("unroll") for (int _i = 0; _i < 2; ++_i) \
        dst[_h][_i] = S.arow(u, _h * HALF + sR[_i]) + (unsigned)sC[_i] * 2u; } } while (0)
#define PG8_STAGE_A(bufoff, gptr, h, usenext) do { if constexpr (GATHER) { _Pragma("unroll") for (int _i = 0; _i < 2; ++_i) { const unsigned _vo = (usenext) ? vAn[h][_i] : vAc[h][_i]; \
        __builtin_amdgcn_global_load_lds((const unsigned*)((const char*)(gptr) + _vo), (LAS unsigned*)(lds + (bufoff) + ldsw + _i * 8192), 16, 0, 0); } } \
        else { PG8_STAGE(bufoff, (gptr) + (h) * hstepA, voffA); } } while (0)
    Unit cur, nxt; int ui = 0;
    if (!S.next(0, cur)) return;
    f32x4 acc[2][2][4][2];
#pragma unroll
    for (int a = 0; a < 2; ++a)
#pragma unroll
        for (int b = 0; b < 2; ++b)
#pragma unroll
            for (int m = 0; m < 4; ++m)
#pragma unroll
                for (int n = 0; n < 2; ++n) acc[a][b][m][n] = (f32x4){0.f, 0.f, 0.f, 0.f};
    bf16x8 At[4][2], B0[2][2], B1[2][2];
    const char* cA = S.aptr(cur); const char* cB = S.bptr(cur);
    PG8_AOFF(vAc, cur);
    PG8_STAGE(PG8_SB(0, 0), cB, voffB); PG8_STAGE(PG8_SB(0, 1), cB + hstepB, voffB); PG8_STAGE_A(PG8_SA(0, 0), cA, 0, false); PG8_STAGE_A(PG8_SA(0, 1), cA, 1, false);
    if (wr == 1) PG8_BAR;
    PG8_WAIT_V(2); PG8_BAR;
    PG8_STAGE(PG8_SB(1, 0), cB + kstep, voffB); PG8_STAGE_A(PG8_SA(1, 0), cA + kstep, 0, false); PG8_STAGE(PG8_SB(1, 1), cB + hstepB + kstep, voffB);
    PG8_WAIT_V(6); PG8_BAR;
    for (;;) {
        const bool has_next = S.next(ui + 1, nxt);
        const char* nA = has_next ? S.aptr(nxt) : cA; const char* nB = has_next ? S.bptr(nxt) : cB;
        if constexpr (GATHER) { if (has_next) { PG8_AOFF(vAn, nxt); } else {
#pragma unroll
            for (int h = 0; h < 2; ++h)
#pragma unroll
                for (int i = 0; i < 2; ++i) vAn[h][i] = vAc[h][i]; } }
        for (int t = 0; t < nt; t += 2) {
            const bool last = (t == nt - 2);
            const char* a1 = cA + (size_t)(t + 1) * kstep;
            const char* a2 = last ? nA : cA + (size_t)(t + 2) * kstep; const char* b2 = last ? nB : cB + (size_t)(t + 2) * kstep;
            const char* a3 = a2 + kstep; const char* b3 = b2 + kstep;
            PG8_LDB(B0, 0, 0); PG8_LDB(B1, 0, 1); PG8_SCHED; PG8_LDA(At, 0, 0); PG8_STAGE_A(PG8_SA(1, 1), a1, 1, false);
            PG8_WAIT_V(8); PG8_WAIT_L(0); PG8_BAR; PG8_MMA(0, 0, At, B0); PG8_MMA(0, 1, At, B1); PG8_BAR; PG8_SCHED;
            PG8_LDA(At, 0, 1); PG8_STAGE(PG8_SB(0, 0), b2, voffB); PG8_STAGE(PG8_SB(0, 1), b2 + hstepB, voffB); PG8_STAGE_A(PG8_SA(0, 0), a2, 0, last);
            PG8_WAIT_V(8); PG8_WAIT_L(0); PG8_BAR; PG8_MMA(1, 0, At, B0); PG8_MMA(1, 1, At, B1); PG8_BAR; PG8_SCHED;
            PG8_LDB(B0, 1, 0); PG8_LDB(B1, 1, 1); PG8_SCHED; PG8_LDA(At, 1, 0); PG8_STAGE_A(PG8_SA(0, 1), a2, 1, last);
            PG8_WAIT_V(8); PG8_WAIT_L(0); PG8_BAR; PG8_MMA(0, 0, At, B0); PG8_MMA(0, 1, At, B1); PG8_BAR; PG8_SCHED;
            PG8_LDA(At, 1, 1); PG8_STAGE(PG8_SB(1, 0), b3, voffB); PG8_STAGE(PG8_SB(1, 1), b3 + hstepB, voffB); PG8_STAGE_A(PG8_SA(1, 0), a3, 0, last);
            PG8_WAIT_V(8); PG8_WAIT_L(0); PG8_BAR; PG8_MMA(1, 0, At, B0); PG8_MMA(1, 1, At, B1); PG8_BAR; PG8_SCHED;
        }
        if (wr == 0) PG8_BAR;
        E(acc, cur, wr, wc, fr, fq);
        if (!has_next) break;
#pragma unroll
        for (int a = 0; a < 2; ++a)
#pragma unroll
            for (int b = 0; b < 2; ++b)
#pragma unroll
                for (int m = 0; m < 4; ++m)
#pragma unroll
                    for (int n = 0; n < 2; ++n) acc[a][b][m][n] = (f32x4){0.f, 0.f, 0.f, 0.f};
        cur = nxt; cA = nA; cB = nB; ++ui;
        if constexpr (GATHER) {
#pragma unroll
        for (int h = 0; h < 2; ++h)
#pragma unroll
            for (int i = 0; i < 2; ++i) vAc[h][i] = vAn[h][i]; }
        if (wr == 1) PG8_BAR;
    }
    PG8_WAIT_V(0);
    PG8_BAR;
#undef PG8_SA
#undef PG8_SB
#undef PG8_STAGE
#undef PG8_LDA
#undef PG8_LDB
#undef PG8_MMA
#undef PG8_WAIT_V
#undef PG8_WAIT_L
#undef PG8_BAR
#undef PG8_SCHED
#undef PG8_AOFF
#undef PG8_STAGE_A
}
}

constexpr int D = 1024, BATCH = 32, SEQ = 2048, DEPTH = 2;
constexpr int NCH = 2, BC = BATCH / NCH, TC = BC * SEQ;
constexpr int NP = 10496;
constexpr int C_QA = 0, C_KA = 256, C_VA = 512, C_OG = 1024, C_GP = 1536, C_XB = 1792, C_YB = 2304, C_QKV = 2816, C_G = 7424;
constexpr int WIN_N = 10256;
constexpr int NE = 16, FF = 512;
constexpr int RP = 2 * TC + NE * 256;
constexpr float RMS_EPS = 1e-6f;
constexpr int NWAVES = 8, NTHR = 512;

constexpr size_t MiB = 1u << 20;
constexpr size_t WS_CTL = 0, CTL_ZERO_BYTES = 1 * MiB;
constexpr size_t WS_REC = 1 * MiB;
constexpr size_t WS_LIST = 2 * MiB;
constexpr size_t WS_W = 4 * MiB;
constexpr size_t LW_WIN = 0, LW_WBR = LW_WIN + (size_t)NP * D * 2, LW_WOUT = LW_WBR + (size_t)3 * D * 512 * 2, LW_WGU = LW_WOUT + (size_t)D * D * 2,
                 LW_WDN = LW_WGU + (size_t)NE * 1024 * D * 2, LW_SIZE = LW_WDN + (size_t)NE * D * FF * 2;
static_assert(LW_SIZE == 77070336, "layer weights");
constexpr size_t WS_ACT = 152 * MiB;
constexpr size_t WS_BRC = 216 * MiB;
constexpr size_t WS_PROJ = 248 * MiB;
constexpr size_t WS_HID = WS_PROJ;
constexpr size_t WS_YS = WS_PROJ + 72 * MiB;
constexpr size_t WS_END = WS_PROJ + 656 * MiB;
static_assert(WS_W + 2 * LW_SIZE <= WS_ACT && (size_t)TC * NP * 2 <= 656 * MiB && (size_t)RP * 512 * 2 <= 72 * MiB && WS_YS + (size_t)RP * 2048 <= WS_END, "ws map");
constexpr int CW_BAR = 4096;
constexpr int CW_CNT = 8192;
constexpr int CW_Q = 12288;

constexpr int RING_BYTES = 131072;
constexpr int MISC_OFF = RING_BYTES;
constexpr int LDS_BYTES = 147456;

#define LDS_WAIT() asm volatile("s_waitcnt lgkmcnt(0)" ::: "memory")
#define VM_WAIT() asm volatile("s_waitcnt vmcnt(0)" ::: "memory")
__device__ __forceinline__ float bf2f(unsigned short b) { return __uint_as_float(((unsigned)b) << 16); }
__device__ __forceinline__ float bflo(unsigned u) { return __uint_as_float(u << 16); }
__device__ __forceinline__ float bfhi(unsigned u) { return __uint_as_float(u & 0xffff0000u); }
__device__ __forceinline__ unsigned f2bf(float f) { unsigned u = __float_as_uint(f); return (u + 0x7fffu + ((u >> 16) & 1u)) >> 16; }
__device__ __forceinline__ unsigned pk2(float lo, float hi) { return f2bf(lo) | (f2bf(hi) << 16); }
template <int O> __device__ __forceinline__ float swz_xor(float v) { return __int_as_float(__builtin_amdgcn_ds_swizzle(__float_as_int(v), (O << 10) | 0x1f)); }
__device__ __forceinline__ float xor32(float v) {
    const auto r = __builtin_amdgcn_permlane32_swap(__float_as_uint(v), __float_as_uint(v), false, false);
    return (threadIdx.x & 32) ? __uint_as_float(r[0]) : __uint_as_float(r[1]);
}
__device__ __forceinline__ float wave_sum(float v) {
    v += swz_xor<1>(v); v += swz_xor<2>(v); v += swz_xor<4>(v); v += swz_xor<8>(v); v += swz_xor<16>(v);
    const auto r = __builtin_amdgcn_permlane32_swap(__float_as_uint(v), __float_as_uint(v), false, false);
    return __uint_as_float(r[0]) + __uint_as_float(r[1]);
}
__device__ __forceinline__ float wave_max(float v) {
    v = fmaxf(v, swz_xor<1>(v)); v = fmaxf(v, swz_xor<2>(v)); v = fmaxf(v, swz_xor<4>(v)); v = fmaxf(v, swz_xor<8>(v)); v = fmaxf(v, swz_xor<16>(v));
    const auto r = __builtin_amdgcn_permlane32_swap(__float_as_uint(v), __float_as_uint(v), false, false);
    return fmaxf(__uint_as_float(r[0]), __uint_as_float(r[1]));
}
__device__ __forceinline__ float sigmoidf_(float x) { return 1.f / (1.f + __expf(-x)); }

#define XB_TMO      128
#define XB_XCNT(j)  (256  + 64 * (j))
#define XB_XSUB(j)  (1280 + 64 * (j))
#define XB_XGEN(j)  (2304 + 64 * (j))
#define XB_TOP      3328
#define XB_TOPGEN   3392
#define XCD_BAR_WORDS 3456
#define XB_SPIN_CAP (1u << 21)
__device__ __forceinline__ unsigned xb_ld(unsigned* p)              { return __hip_atomic_load(p, __ATOMIC_RELAXED, __HIP_MEMORY_SCOPE_AGENT); }
__device__ __forceinline__ unsigned xb_add(unsigned* p, unsigned v) { return __hip_atomic_fetch_add(p, v, __ATOMIC_RELAXED, __HIP_MEMORY_SCOPE_AGENT); }
__device__ __forceinline__ unsigned xb_xcc_id() { return (unsigned)__builtin_amdgcn_s_getreg((3 << 11) | 20) & 0xFu; }
#define XB_SPIN(cond, bar) do { unsigned _sp = 0; while (cond) { __builtin_amdgcn_s_sleep(1); \
    if ((++_sp & 255u) == 0u) { if (xb_ld(&(bar)[XB_TMO])) break; if (_sp > XB_SPIN_CAP) { atomicAdd(&(bar)[XB_TMO], 1u); break; } } } } while (0)
struct XcdBarrier { unsigned* bar; unsigned x; volatile LAS unsigned* st; };
__device__ __forceinline__ XcdBarrier xcd_barrier_post(unsigned* bar, volatile LAS unsigned* st) {
    XcdBarrier b; b.bar = bar; b.x = xb_xcc_id(); b.st = st;
    if (threadIdx.x == 0) (void)xb_add(&bar[XB_XCNT(b.x)], 1u);
    return b;
}
__device__ __forceinline__ void xcd_barrier_complete(unsigned* bar, unsigned x, unsigned& nloc, unsigned& nx) {
    const unsigned G = gridDim.x * gridDim.y * gridDim.z;
    unsigned sum, cnt, sp = 0u;
    for (;;) {
        sum = 0u; cnt = 0u;
#pragma unroll 1
        for (unsigned j = 0; j < 16; ++j) { const unsigned c = xb_ld(&bar[XB_XCNT(j)]); sum += c; cnt += (c > 0u) ? 1u : 0u; }
        if (sum == G) break;
        __builtin_amdgcn_s_sleep(1);
        if ((++sp & 255u) == 0u) { if (xb_ld(&bar[XB_TMO])) break; if (sp > XB_SPIN_CAP) { atomicAdd(&bar[XB_TMO], 1u); break; } }
    }
    const unsigned mine = xb_ld(&bar[XB_XCNT(x)]);
    nloc = mine > 0u ? mine : 1u; nx = cnt > 0u ? cnt : 1u;
}
__device__ __noinline__ void xcd_barrier(const XcdBarrier b) {
    asm volatile("s_waitcnt vmcnt(0)" ::: "memory");
    __syncthreads();
    if (threadIdx.x == 0) {
        unsigned* bar = b.bar;
        __builtin_amdgcn_s_waitcnt(0);
        unsigned nloc = b.st[0], nx = b.st[1];
        if (nloc == 0u) { xcd_barrier_complete(bar, b.x, nloc, nx); b.st[0] = nloc; b.st[1] = nx; }
        const unsigned old = xb_add(&bar[XB_XSUB(b.x)], 1u);
        const unsigned gen = old / nloc;
        if (old + 1u == (gen + 1u) * nloc) {
            __builtin_amdgcn_fence(__ATOMIC_RELEASE, "agent");
            asm volatile("s_waitcnt vmcnt(0)" ::: "memory");
            const unsigned og = xb_add(&bar[XB_TOP], 1u);
            const unsigned tg = og / nx;
            if (og + 1u == (tg + 1u) * nx) xb_add(&bar[XB_TOPGEN], 1u);
            else XB_SPIN(xb_ld(&bar[XB_TOPGEN]) == tg, bar);
            __builtin_amdgcn_fence(__ATOMIC_ACQUIRE, "agent");
            xb_add(&bar[XB_XGEN(b.x)], 1u);
            asm volatile("s_waitcnt vmcnt(0)" ::: "memory");
        } else {
            XB_SPIN(xb_ld(&bar[XB_XGEN(b.x)]) == gen, bar);
            __builtin_amdgcn_fence(__ATOMIC_ACQUIRE, "agent");
            asm volatile("s_waitcnt vmcnt(0)" ::: "memory");
        }
    }
    __syncthreads();
}

struct Args { const void* in[24]; float* out; unsigned char* ws; int ph_lo, ph_hi; };
struct Ctx {
    LAS unsigned char* lds;
    unsigned* ctl;
    int tid, lane, wave, bid, G;
    int chunk, layer, pass;
    const float* x_in; float* xo;
    const int* pos;
    const unsigned char* lw;
    bf16_t *act, *proj, *hid, *ys;
    unsigned* rec; int* list;
};

__device__ __forceinline__ void tr_item(const float* srcp, int Nsrc, float scale, bf16_t* WT, int K, int n0, int k0, LAS float* scr, int lane) {
#pragma unroll 8
    for (int i = 0; i < 32; ++i) { const int kk = 2 * i + (lane >> 5); scr[kk * 33 + (lane & 31)] = srcp[(size_t)(k0 + kk) * Nsrc] * scale; }
    LDS_WAIT(); asm volatile("" ::: "memory");
    const int c = lane & 7;
#pragma unroll
    for (int j = 0; j < 4; ++j) { const int n = (lane >> 3) + 8 * j; const LAS float* s = scr + (8 * c) * 33 + n;
        u32x4 o; o.x = pk2(s[0 * 33], s[1 * 33]); o.y = pk2(s[2 * 33], s[3 * 33]); o.z = pk2(s[4 * 33], s[5 * 33]); o.w = pk2(s[6 * 33], s[7 * 33]);
        *(u32x4*)(WT + (size_t)(n0 + n) * K + k0 + 8 * c) = o; }
    LDS_WAIT(); asm volatile("" ::: "memory");
}
constexpr int IT_WIN = (NP / 32) * 16, IT_WBR = 3 * 32 * 8, IT_WOUT = 32 * 16, IT_WGU = NE * 32 * 16, IT_WDN = NE * 32 * 8, IT_LAYER = IT_WIN + IT_WBR + IT_WOUT + IT_WGU + IT_WDN;
__device__ __forceinline__ void phase_prep(const Args& a, LAS unsigned char* lds, int gw, int NGW, int wave, int lane, int gtid, int NGT) {
    LAS float* scr = (LAS float*)(lds + wave * 16384);
    for (int it = gw; it < DEPTH * IT_LAYER; it += NGW) {
        const int l = it / IT_LAYER; int r = it % IT_LAYER;
        unsigned char* lw = a.ws + WS_W + (size_t)l * LW_SIZE;
        const int rl = lane & 31;
        if (r < IT_WIN) {
            const int g = r / 16, kb = r % 16;
            if (g >= C_GP / 32 && g < C_XB / 32) continue;
            const int n = 32 * g + rl; const int src = n < C_GP ? n : n - 240;
            const float* W = (const float*)a.in[3] + (size_t)l * D * WIN_N;
            tr_item(W + src, WIN_N, n < 256 ? 0.125f : 1.f, (bf16_t*)(lw + LW_WIN), D, 32 * g, 64 * kb, scr, lane);
            continue; }
        r -= IT_WIN;
        if (r < IT_WBR) {
            const int b = r / 256, g = (r % 256) / 8, kb = r % 8;
            const float* W = (const float*)a.in[16] + ((size_t)l * 3 + b) * 512 * D;
            tr_item(W + 32 * g + rl, D, 1.f, (bf16_t*)(lw + LW_WBR) + (size_t)b * D * 512, 512, 32 * g, 64 * kb, scr, lane);
            continue; }
        r -= IT_WBR;
        if (r < IT_WOUT) {
            const int g = r / 16, kb = r % 16;
            const float* W = (const float*)a.in[17] + (size_t)l * D * D;
            tr_item(W + 32 * g + rl, D, 1.f, (bf16_t*)(lw + LW_WOUT), D, 32 * g, 64 * kb, scr, lane);
            continue; }
        r -= IT_WOUT;
        if (r < IT_WGU) {
            const int e = r / 512, g = (r % 512) / 16, kb = r % 16;
            const float* Wg = (const float*)a.in[21] + ((size_t)l * NE + e) * D * FF;
            const float* Wu = (const float*)a.in[22] + ((size_t)l * NE + e) * D * FF;
            const float* sp = (rl < 16 ? Wg : Wu) + 16 * g + (rl & 15);
            tr_item(sp, FF, 1.f, (bf16_t*)(lw + LW_WGU) + (size_t)e * 1024 * D, D, 32 * g, 64 * kb, scr, lane);
            continue; }
        r -= IT_WGU;
        {
            const int e = r / 256, g = (r % 256) / 8, kb = r % 8;
            const float* W = (const float*)a.in[23] + ((size_t)l * NE + e) * FF * D;
            tr_item(W + 32 * g + rl, D, 1.f, (bf16_t*)(lw + LW_WDN) + (size_t)e * D * FF, FF, 32 * g, 64 * kb, scr, lane);
        }
    }
    for (int idx = gtid; idx < DEPTH * 256 * D; idx += NGT) {
        const int l = idx / (256 * D), j = (idx / D) % 256, k = idx % D;
        const float* W = (const float*)a.in[3] + (size_t)l * D * WIN_N + (size_t)k * WIN_N + 1536;
        const float* gu = (const float*)a.in[4] + (size_t)l * 16 * 256 + j;
        float s = 0.f;
#pragma unroll
        for (int r = 0; r < 16; ++r) s += W[r] * gu[r * 256];
        ((bf16_t*)(a.ws + WS_W + (size_t)l * LW_SIZE + LW_WIN))[(size_t)(C_GP + j) * D + k] = (bf16_t)f2bf(s);
    }
}

__device__ __forceinline__ void moe_tables(const unsigned* cnt, LAS int* pt, LAS int* lc, int tid) {
    if (tid == 0) { int s = 0;
        for (int e = 0; e < NE; ++e) { const int c = (int)__hip_atomic_load(cnt + e, __ATOMIC_RELAXED, __HIP_MEMORY_SCOPE_AGENT); pt[e] = s; lc[e] = c; s += (c + 255) >> 8; }
        pt[NE] = s; }
    __syncthreads();
}

template <bool COMBINE, bool NORM, bool SRC_OUT>
__device__ __forceinline__ void phase_norm1(const Ctx& c, const float* gain, LAS const int* pt) {
    const int gw = c.bid * NWAVES + c.wave, NGW = c.G * NWAVES, lane = c.lane;
    f32x4 g4[4];
    if (NORM) {
#pragma unroll
        for (int j = 0; j < 4; ++j) g4[j] = *((const f32x4*)gain + 64 * j + lane); }
    for (int tok = gw; tok < TC; tok += NGW) {
        const f32x4* xr = (const f32x4*)((SRC_OUT ? (const float*)c.xo : c.x_in) + (size_t)tok * D) + lane;
        f32x4 v[4];
#pragma unroll
        for (int j = 0; j < 4; ++j) v[j] = xr[64 * j];
        if (COMBINE) {
            const u32x4 rc = *(const u32x4*)(c.rec + (size_t)tok * 4);
            const int e0 = rc.x >> 20, e1 = rc.y >> 20;
            const size_t r0 = (size_t)pt[e0] * 256 + (rc.x & 0xfffffu), r1 = (size_t)pt[e1] * 256 + (rc.y & 0xfffffu);
            const float w0 = __uint_as_float(rc.z), w1 = __uint_as_float(rc.w);
            const u32x2* y0 = (const u32x2*)(c.ys + r0 * D) + lane; const u32x2* y1 = (const u32x2*)(c.ys + r1 * D) + lane;
#pragma unroll
            for (int j = 0; j < 4; ++j) { const u32x2 a = y0[64 * j], b = y1[64 * j];
                v[j].x += w0 * bflo(a.x) + w1 * bflo(b.x); v[j].y += w0 * bfhi(a.x) + w1 * bfhi(b.x);
                v[j].z += w0 * bflo(a.y) + w1 * bflo(b.y); v[j].w += w0 * bfhi(a.y) + w1 * bfhi(b.y); }
            f32x4* xw = (f32x4*)(c.xo + (size_t)tok * D) + lane;
#pragma unroll
            for (int j = 0; j < 4; ++j) xw[64 * j] = v[j];
        }
        if (NORM) {
            float ss = 0.f;
#pragma unroll
            for (int j = 0; j < 4; ++j) ss += (v[j].x * v[j].x + v[j].y * v[j].y) + (v[j].z * v[j].z + v[j].w * v[j].w);
            const float rs = rsqrtf(wave_sum(ss) * (1.f / D) + RMS_EPS);
            u32x2* o = (u32x2*)(c.act + (size_t)tok * D) + lane;
#pragma unroll
            for (int j = 0; j < 4; ++j) { u32x2 w; w.x = pk2(v[j].x * rs * g4[j].x, v[j].y * rs * g4[j].y); w.y = pk2(v[j].z * rs * g4[j].z, v[j].w * rs * g4[j].w); o[64 * j] = w; }
        }
    }
}

__constant__ double kInvFreq[16] = {1.0, 0.44036660267178046, 0.19392274474868576, 0.08539710028576561, 0.03760603093086393, 0.016560440080994446, 0.007292664737217109, 0.003211445994752591,
    0.001414213562373095, 0.000622772421914596, 0.0002742481756762073, 0.00012076973741146504, 5.318295896944988e-05, 2.341999896140934e-05, 1.031338537721246e-05, 4.5416704806078695e-06};
__device__ __forceinline__ void phase_qkrope(const Ctx& c, const float* qg, const float* kg) {
    const int gw = c.bid * NWAVES + c.wave, NGW = c.G * NWAVES, lane = c.lane;
    const float qg0 = qg[2 * lane], qg1 = qg[2 * lane + 1], kg0 = kg[2 * lane], kg1 = kg[2 * lane + 1];
    const int i0 = 2 * (lane & 7);
    const double f0 = kInvFreq[i0], f1 = kInvFreq[i0 + 1];
    const float sgn = (lane & 8) ? 1.f : -1.f;
    for (int tok = gw; tok < TC; tok += NGW) {
        const double p = (double)c.pos[tok];
        double a0 = p * f0 * 0.15915494309189535, a1 = p * f1 * 0.15915494309189535;
        a0 -= rint(a0); a1 -= rint(a1);
        const float c0 = __builtin_amdgcn_cosf((float)a0), s0 = __builtin_amdgcn_sinf((float)a0), c1 = __builtin_amdgcn_cosf((float)a1), s1 = __builtin_amdgcn_sinf((float)a1);
        bf16_t* row = c.proj + (size_t)tok * NP + C_QKV;
#pragma unroll 4
        for (int hr = 0; hr < 24; ++hr) {
            unsigned* pp = (unsigned*)(row + hr * 128) + lane;
            const unsigned u = *pp; const float v0 = bflo(u), v1 = bfhi(u);
            const float rs = rsqrtf(wave_sum(v0 * v0 + v1 * v1) * (1.f / 128.f) + RMS_EPS);
            float y0 = v0 * rs * (hr < 12 ? qg0 : kg0), y1 = v1 * rs * (hr < 12 ? qg1 : kg1);
            const float p0 = __shfl_xor(y0, 8), p1 = __shfl_xor(y1, 8);
            if (lane < 16) { y0 = y0 * c0 + sgn * p0 * s0; y1 = y1 * c1 + sgn * p1 * s1; }
            *pp = pk2(y0, y1);
        }
    }
}

__device__ __forceinline__ float logsigmoidf_(float g) { return fminf(g, 0.f) - log1pf(__expf(-fabsf(g))); }
__device__ __forceinline__ float gelu_tanh(float y) { const float u = 0.7978845608028654f * (y + 0.044715f * y * y * y); const float t = 1.f - 2.f / (1.f + __expf(2.f * u)); return 0.5f * y * (1.f + t); }

__device__ __forceinline__ void gla_simple(const Ctx& c, int b, const float* gbias, const float* ogain) {
    LAS float* sQ = (LAS float*)c.lds; LAS float* sK = sQ + 16 * 256; LAS float* sA = sK + 16 * 256; LAS float* sO = sA + 16 * 256; LAS float* sV = sO + 16 * 512;
    const int tid = c.tid, h = tid >> 7, lane = c.lane;
    float S[64];
#pragma unroll
    for (int i = 0; i < 64; ++i) S[i] = 0.f;
    const float og0 = ogain[2 * lane], og1 = ogain[2 * lane + 1];
    for (int tc = 0; tc < SEQ / 16; ++tc) {
        const size_t tok0 = (size_t)b * SEQ + tc * 16;
        __syncthreads();
        for (int idx = tid; idx < 16 * 256; idx += NTHR) { const int s = idx >> 8, ci = idx & 255; const bf16_t* row = c.proj + (tok0 + s) * NP;
            sQ[idx] = bf2f(row[C_QA + ci]); sK[idx] = bf2f(row[C_KA + ci]);
            sA[idx] = __expf(logsigmoidf_(bf2f(row[C_GP + ci]) + gbias[ci]) * (1.f / 16.f)); }
#pragma unroll
        for (int s = 0; s < 16; ++s) sV[s * 512 + tid] = bf2f(c.proj[(tok0 + s) * NP + C_VA + tid]);
        __syncthreads();
        for (int s = 0; s < 16; ++s) {
            const float v = sV[s * 512 + tid]; float o = 0.f;
            const LAS f32x4* a4 = (const LAS f32x4*)(sA + s * 256 + h * 64); const LAS f32x4* k4 = (const LAS f32x4*)(sK + s * 256 + h * 64); const LAS f32x4* q4 = (const LAS f32x4*)(sQ + s * 256 + h * 64);
#pragma unroll
            for (int d = 0; d < 16; ++d) { const f32x4 a = a4[d], k = k4[d], q = q4[d];
                S[4 * d + 0] = S[4 * d + 0] * a.x + k.x * v; o += q.x * S[4 * d + 0];
                S[4 * d + 1] = S[4 * d + 1] * a.y + k.y * v; o += q.y * S[4 * d + 1];
                S[4 * d + 2] = S[4 * d + 2] * a.z + k.z * v; o += q.z * S[4 * d + 2];
                S[4 * d + 3] = S[4 * d + 3] * a.w + k.w * v; o += q.w * S[4 * d + 3]; }
            sO[s * 512 + tid] = o;
        }
        __syncthreads();
#pragma unroll 2
        for (int k = 0; k < 8; ++k) { const int rr = c.wave * 8 + k, s = rr >> 2, hh = rr & 3;
            const float o0 = sO[s * 512 + hh * 128 + 2 * lane], o1 = sO[s * 512 + hh * 128 + 2 * lane + 1];
            const float rs = rsqrtf(wave_sum(o0 * o0 + o1 * o1) * (1.f / 128.f) + RMS_EPS);
            unsigned* pp = (unsigned*)(c.proj + (tok0 + s) * NP + C_OG + hh * 128) + lane;
            const unsigned u = *pp; const float g0 = bflo(u), g1 = bfhi(u);
            *pp = pk2(o0 * rs * og0 * g0 * sigmoidf_(g0), o1 * rs * og1 * g1 * sigmoidf_(g1)); }
    }
}

__device__ __forceinline__ void lru_simple(const Ctx& c, int b, const float* convw, const float* convb, const float* wa_, const float* ba_, const float* wx_, const float* bx_, const float* lam_) {
    const int ch = c.tid, n = c.wave, lane = c.lane;
    LAS float* sX = (LAS float*)(c.lds + n * 4096);
    const float* wap = wa_ + n * 4096 + lane; const float* wxp = wx_ + n * 4096 + lane;
    const float cw0 = convw[ch], cw1 = convw[512 + ch], cw2 = convw[1024 + ch], cw3 = convw[1536 + ch], cb = convb[ch], ba = ba_[ch], bx = bx_[ch];
    const float lam = lam_[ch]; const float c8 = 8.f * (fmaxf(-lam, 0.f) + log1pf(__expf(-fabsf(lam))));
    float xm1 = 0.f, xm2 = 0.f, xm3 = 0.f, hs = 0.f;
    for (int tc = 0; tc < SEQ / 16; ++tc) {
        const size_t tok0 = (size_t)b * SEQ + tc * 16;
        float xc[16], yv[16], ar[16], ai[16];
#pragma unroll
        for (int s = 0; s < 16; ++s) { xc[s] = bf2f(c.proj[(tok0 + s) * NP + C_XB + ch]); yv[s] = bf2f(c.proj[(tok0 + s) * NP + C_YB + ch]); }
#pragma unroll
        for (int s = 0; s < 16; ++s) { const float x = xc[s]; xc[s] = cb + cw0 * xm3 + cw1 * xm2 + cw2 * xm1 + cw3 * x; xm3 = xm2; xm2 = xm1; xm1 = x; sX[s * 64 + lane] = xc[s]; ar[s] = ba; ai[s] = bx; }
        LDS_WAIT(); asm volatile("" ::: "memory"); __builtin_amdgcn_wave_barrier();
#pragma unroll 2
        for (int k = 0; k < 64; ++k) { const float wa = wap[k * 64], wx = wxp[k * 64];
#pragma unroll
            for (int s = 0; s < 16; ++s) { const float x = sX[s * 64 + k]; ar[s] += x * wa; ai[s] += x * wx; } }
#pragma unroll
        for (int s = 0; s < 16; ++s) {
            const float r = sigmoidf_(ar[s]), ig = sigmoidf_(ai[s]);
            const float a = __expf(-c8 * r);
            const float u = sqrtf(fmaxf(1.f - a * a, 0.f)) * ig * xc[s];
            hs = a * hs + u;
            c.proj[(tok0 + s) * NP + C_YB + ch] = (bf16_t)f2bf(hs * gelu_tanh(yv[s]));
        }
        LDS_WAIT(); asm volatile("" ::: "memory"); __builtin_amdgcn_wave_barrier();
    }
}

__device__ __forceinline__ void attn_simple(const Ctx& c, int aw, int NAW) {
    const int lane = c.lane;
    for (int task = aw; task < TC * 4; task += NAW) {
        const int tok = task >> 2, h = task & 3, t = tok & (SEQ - 1);
        float ml = -INFINITY, wsum = 0.f, acc0 = 0.f, acc1 = 0.f;
#pragma unroll 1
        for (int p = 0; p < 3; ++p) {
            const int dsh = 2 * p, i = t >> dsh, nk = i + 1 < 129 ? i + 1 : 129;
            const bf16_t* qrow = c.proj + (size_t)tok * NP + C_QKV + (p * 4 + h) * 128;
            const int kcol = C_QKV + (12 + p * 4 + h) * 128, vcol = C_QKV + (24 + p * 4 + h) * 128;
            float sc[3];
#pragma unroll
            for (int r = 0; r < 3; ++r) {
                sc[r] = -INFINITY;
                if (64 * r < nk) {
                    const int m = 64 * r + lane; const bool valid = m < nk;
                    const bf16_t* krow = c.proj + (size_t)(tok - ((valid ? m : 0) << dsh)) * NP + kcol;
                    float s = 0.f;
#pragma unroll 1
                    for (int cb = 0; cb < 4; ++cb) {
                        u32x4 kq[4], qq[4];
#pragma unroll
                        for (int j = 0; j < 4; ++j) { kq[j] = *((const u32x4*)krow + cb * 4 + j); qq[j] = *((const u32x4*)qrow + cb * 4 + j); }
#pragma unroll
                        for (int j = 0; j < 4; ++j) {
                            s += bflo(kq[j].x) * bflo(qq[j].x) + bfhi(kq[j].x) * bfhi(qq[j].x) + bflo(kq[j].y) * bflo(qq[j].y) + bfhi(kq[j].y) * bfhi(qq[j].y)
                               + bflo(kq[j].z) * bflo(qq[j].z) + bfhi(kq[j].z) * bfhi(qq[j].z) + bflo(kq[j].w) * bflo(qq[j].w) + bfhi(kq[j].w) * bfhi(qq[j].w); }
                    }
                    sc[r] = valid ? s * 0.08838834764831845f : -INFINITY;
                }
            }
            const float mx = wave_max(fmaxf(sc[0], fmaxf(sc[1], sc[2])));
            float pr[3];
#pragma unroll
            for (int r = 0; r < 3; ++r) pr[r] = __expf(sc[r] - mx);
            const float den = wave_sum(pr[0] + pr[1] + pr[2]);
            float o0 = 0.f, o1 = 0.f;
#pragma unroll
            for (int r = 0; r < 3; ++r) {
                const int cnt = nk - 64 * r < 64 ? nk - 64 * r : 64;
                if (cnt > 0) {
                const unsigned* vb = (const unsigned*)(c.proj + (size_t)(tok - ((64 * r) << dsh)) * NP + vcol) + lane;
#pragma unroll 4
                for (int mm = 0; mm < cnt; ++mm) {
                    const float pm = __int_as_float(__builtin_amdgcn_readlane(__float_as_int(pr[r]), mm));
                    const unsigned u = *(const unsigned*)((const char*)vb - (size_t)(mm << dsh) * NP * 2);
                    o0 += pm * bflo(u); o1 += pm * bfhi(u); }
                }
            }
            const float inv = 1.f / den, lse = mx + __logf(den);
            const float nml = fmaxf(ml, lse), sc_old = __expf(ml - nml), w = __expf(lse - nml);
            acc0 = acc0 * sc_old + w * o0 * inv; acc1 = acc1 * sc_old + w * o1 * inv; wsum = wsum * sc_old + w; ml = nml;
        }
        const float wi = 1.f / wsum;
        unsigned* op = (unsigned*)(c.proj + (size_t)tok * NP + C_QKV + h * 128) + lane;
        *op = pk2(acc0 * wi, acc1 * wi);
    }
}

typedef unsigned short u16x4 __attribute__((ext_vector_type(4)));
__device__ __forceinline__ unsigned offb(unsigned row, unsigned ch) { return 256u * row + 16u * (ch ^ (((row & 3u) << 2) | ((row >> 2) & 3u))); }
constexpr int ATT_UNITS_PER_SEQ = 3 * 4 * 16;
__device__ __forceinline__ void attn_unit(const Ctx& c, int unit, float* lse_buf) {
    const int tid = c.tid, lane = c.lane, w = c.wave;
    const int b = unit / ATT_UNITS_PER_SEQ, rem = unit % ATT_UNITS_PER_SEQ, p = rem / 64, h = (rem / 16) & 3, qb = rem & 15;
    const int dsh = 2 * p, dil = 1 << dsh, nblk = 16 >> dsh;
    const int r = qb / nblk, blk = qb % nblk;
    const size_t tok0 = (size_t)b * SEQ + r;
    const int qcol = C_QKV + (p * 4 + h) * 128, kcol = C_QKV + (12 + p * 4 + h) * 128, vcol = C_QKV + (24 + p * 4 + h) * 128;
    LAS unsigned char* sK = c.lds; LAS unsigned char* sV = c.lds + 65536;
    {
#pragma unroll
        for (int it = 0; it < 8; ++it) { const int q = w + 8 * it; const unsigned n = 64u * q + lane, row = n >> 4, cs = n & 15u, ch = cs ^ (((row & 3u) << 2) | ((row >> 2) & 3u));
            int srow = (blk - 1) * 128 + (int)row; if (srow < 0) srow += 128;
            const bf16_t* g = c.proj + (tok0 + ((size_t)srow << dsh)) * NP + kcol + ch * 8;
            __builtin_amdgcn_global_load_lds((const unsigned*)g, (LAS unsigned*)(sK + 1024 * q), 16, 0, 0); }
#pragma unroll
        for (int it = 0; it < 8; ++it) { const int q = w + 8 * it; const unsigned n = 64u * q + lane, row = n >> 4, cs = n & 15u, ch = cs ^ (((row & 3u) << 2) | ((row >> 2) & 3u));
            int srow = (blk - 1) * 128 + (int)row; if (srow < 0) srow += 128;
            const bf16_t* g = c.proj + (tok0 + ((size_t)srow << dsh)) * NP + vcol + ch * 8;
            __builtin_amdgcn_global_load_lds((const unsigned*)g, (LAS unsigned*)(sV + 1024 * q), 16, 0, 0); }
    }
    const int qq = lane & 15, g = lane >> 4, qi = 16 * w + qq;
    const size_t qtok = tok0 + ((size_t)(blk * 128 + qi) << dsh);
    bf16x8 qf[4];
#pragma unroll
    for (int s = 0; s < 4; ++s) qf[s] = *(const bf16x8*)(c.proj + qtok * NP + qcol + 32 * s + 8 * g);
    asm volatile("s_waitcnt vmcnt(0)" ::: "memory");
    __syncthreads();
    const int ks0 = w >> 1;
    f32x4 st[5][2];
    const unsigned krow_l = 8u * (qq >> 2) + (qq & 3u);
#pragma unroll
    for (int n = 0; n < 5; ++n)
#pragma unroll
        for (int T = 0; T < 2; ++T) { f32x4 a = {0.f, 0.f, 0.f, 0.f}; const unsigned key = 32u * (ks0 + n) + krow_l + 4u * T;
#pragma unroll
            for (int s = 0; s < 4; ++s) { const bf16x8 kf = *(const LAS bf16x8*)(sK + offb(key, 4 * s + g)); a = __builtin_amdgcn_mfma_f32_16x16x32_bf16(kf, qf[s], a, 0, 0, 0); }
            st[n][T] = a; }
    const float SC = 0.08838834764831845f * 1.4426950408889634f;
    float mx = -INFINITY;
#pragma unroll
    for (int n = 0; n < 5; ++n)
#pragma unroll
        for (int T = 0; T < 2; ++T)
#pragma unroll
            for (int i = 0; i < 4; ++i) { const int kj = 32 * (ks0 + n) + 8 * g + 4 * T + i; const bool ok = (kj >= qi) && (kj <= qi + 128) && (blk > 0 || kj >= 128);
                const float v = ok ? st[n][T][i] : -INFINITY; st[n][T][i] = v; mx = fmaxf(mx, v); }
    mx = fmaxf(mx, swz_xor<16>(mx));
    { const auto rr = __builtin_amdgcn_permlane32_swap(__float_as_uint(mx), __float_as_uint(mx), false, false); mx = fmaxf(__uint_as_float(rr[0]), __uint_as_float(rr[1])); }
    float sum = 0.f;
#pragma unroll
    for (int n = 0; n < 5; ++n)
#pragma unroll
        for (int T = 0; T < 2; ++T)
#pragma unroll
            for (int i = 0; i < 4; ++i) { const float e = __builtin_amdgcn_exp2f((st[n][T][i] - mx) * SC); st[n][T][i] = e; sum += e; }
    sum += swz_xor<16>(sum);
    { const auto rr = __builtin_amdgcn_permlane32_swap(__float_as_uint(sum), __float_as_uint(sum), false, false); sum = __uint_as_float(rr[0]) + __uint_as_float(rr[1]); }
    const float inv = 1.f / sum;
    f32x4 ot[8];
#pragma unroll
    for (int cc = 0; cc < 8; ++cc) ot[cc] = (f32x4){0.f, 0.f, 0.f, 0.f};
    const unsigned tq = (unsigned)qq >> 2, tp = (unsigned)qq & 3u;
    const unsigned vbase = (unsigned)(size_t)sV;
#pragma unroll
    for (int n = 0; n < 5; ++n) {
        u32x4 pw; pw.x = pg8::cvt_pk_bf16(st[n][0][0], st[n][0][1]); pw.y = pg8::cvt_pk_bf16(st[n][0][2], st[n][0][3]); pw.z = pg8::cvt_pk_bf16(st[n][1][0], st[n][1][1]); pw.w = pg8::cvt_pk_bf16(st[n][1][2], st[n][1][3]);
        const bf16x8 pf = __builtin_bit_cast(bf16x8, pw);
#pragma unroll
        for (int cc = 0; cc < 8; ++cc) {
            const unsigned a0 = vbase + offb(32u * (ks0 + n) + 8u * g + tq, 2 * cc + (tp >> 1)) + 8u * (tp & 1u);
            const unsigned a1 = vbase + offb(32u * (ks0 + n) + 8u * g + 4u + tq, 2 * cc + (tp >> 1)) + 8u * (tp & 1u);
            u16x4 v0, v1;
            asm volatile("ds_read_b64_tr_b16 %0, %2\n\tds_read_b64_tr_b16 %1, %3\n\ts_waitcnt lgkmcnt(0)" : "=&v"(v0), "=&v"(v1) : "v"(a0), "v"(a1) : "memory");
            bf16x8 vf; vf[0] = (short)v0[0]; vf[1] = (short)v0[1]; vf[2] = (short)v0[2]; vf[3] = (short)v0[3]; vf[4] = (short)v1[0]; vf[5] = (short)v1[1]; vf[6] = (short)v1[2]; vf[7] = (short)v1[3];
            ot[cc] = __builtin_amdgcn_mfma_f32_16x16x32_bf16(vf, pf, ot[cc], 0, 0, 0);
        }
    }
    bf16_t* orow = c.proj + qtok * NP + qcol;
#pragma unroll
    for (int cc = 0; cc < 8; ++cc) { u32x2 o; o.x = pg8::cvt_pk_bf16(ot[cc][0] * inv, ot[cc][1] * inv); o.y = pg8::cvt_pk_bf16(ot[cc][2] * inv, ot[cc][3] * inv); *(u32x2*)(orow + 16 * cc + 4 * g) = o; }
    if (g == 0) lse_buf[qtok * 12 + p * 4 + h] = mx * 0.08838834764831845f + __logf(sum);
    __syncthreads();
}

__device__ __forceinline__ void phase_attn_combine(const Ctx& c, const float* lse_buf) {
    const int gw = c.bid * NWAVES + c.wave, NGW = c.G * NWAVES, lane = c.lane;
    for (int tok = gw; tok < TC; tok += NGW) {
        const float* ls = lse_buf + (size_t)tok * 12;
        bf16_t* row = c.proj + (size_t)tok * NP + C_QKV;
#pragma unroll
        for (int h = 0; h < 4; ++h) {
            const float l0 = ls[h], l1 = ls[4 + h], l2 = ls[8 + h], ml = fmaxf(l0, fmaxf(l1, l2));
            const float w0 = __expf(l0 - ml), w1 = __expf(l1 - ml), w2 = __expf(l2 - ml), wi = 1.f / (w0 + w1 + w2);
            unsigned* p0 = (unsigned*)(row + h * 128) + lane;
            const unsigned u0 = *p0, u1 = *((const unsigned*)(row + (4 + h) * 128) + lane), u2 = *((const unsigned*)(row + (8 + h) * 128) + lane);
            *p0 = pk2((w0 * bflo(u0) + w1 * bflo(u1) + w2 * bflo(u2)) * wi, (w0 * bfhi(u0) + w1 * bfhi(u1) + w2 * bfhi(u2)) * wi);
        }
    }
}

__device__ __forceinline__ int crow(int reg, int hh) { return (reg & 3) + 8 * (reg >> 2) + 4 * hh; }
typedef float f32x16 __attribute__((ext_vector_type(16)));
__device__ __forceinline__ unsigned tr_addr32(unsigned lane, unsigned rowbase, unsigned cblk, unsigned t, bool perm) {
    const unsigned hh = lane >> 5, blk = (lane >> 4) & 1u, q = (lane & 15u) >> 2, p = lane & 3u;
    const unsigned row = rowbase + (perm ? 8u * t + 4u * hh : 8u * hh + 4u * t) + q;
    return offb(row, 4u * cblk + 2u * blk + (p >> 1)) + 8u * (p & 1u);
}
__device__ __forceinline__ bf16x8 tr_frag(unsigned a0, unsigned a1) {
    u16x4 v0, v1;
    asm volatile("ds_read_b64_tr_b16 %0, %2\n\tds_read_b64_tr_b16 %1, %3\n\ts_waitcnt lgkmcnt(0)" : "=&v"(v0), "=&v"(v1) : "v"(a0), "v"(a1) : "memory");
    bf16x8 f; f[0] = (short)v0[0]; f[1] = (short)v0[1]; f[2] = (short)v0[2]; f[3] = (short)v0[3]; f[4] = (short)v1[0]; f[5] = (short)v1[1]; f[6] = (short)v1[2]; f[7] = (short)v1[3];
    return f;
}
constexpr int GLA_QK = 0, GLA_KD = 16384, GLA_V = 32768, GLA_ST = 49152  , GLA_O = 86016  , GLA_SEG = 119808  , GLA_DEC = 121856  ;
static_assert(GLA_DEC + 256 <= RING_BYTES, "gla lds");
__device__ __forceinline__ void gla_unit(const Ctx& c, int unit, const float* gbias, const float* ogain) {
    const int tid = c.tid, lane = c.lane, w = c.wave;
    const int b = unit >> 2, h = unit & 3;
    LAS unsigned char* L = c.lds;
    const unsigned hh = lane >> 5, r31 = lane & 31;
    const int ti = w >> 2, tv = w & 3;
    f32x16 St;
#pragma unroll
    for (int i = 0; i < 16; ++i) St[i] = 0.f;
    for (int i = tid; i < 18432 / 4; i += NTHR) ((LAS unsigned*)(L + GLA_ST))[i] = 0u;
    const float bias_d = gbias[h * 64 + lane];
    const int i3 = tid >> 3, seg = tid & 7;
    float gn[16];
#pragma unroll
    for (int k = 0; k < 16; ++k) gn[k] = ogain[16 * seg + k];
    const size_t tokb = (size_t)b * SEQ;
    unsigned short pq[8], pk[8], pg[8];
#define GLA_PREFETCH(n) do { _Pragma("unroll") for (int rr = 0; rr < 8; ++rr) { const bf16_t* row = c.proj + (tokb + (n) * 64 + 8 * w + rr) * NP + h * 64 + lane; \
        pq[rr] = row[C_QA]; pk[rr] = row[C_KA]; pg[rr] = row[C_GP]; } } while (0)
#define GLA_VDMA(n) do { _Pragma("unroll") for (int it = 0; it < 2; ++it) { const int q = w + 8 * it; const unsigned nn = 64u * q + lane, row = nn >> 4, cs = nn & 15u, ch = cs ^ (((row & 3u) << 2) | ((row >> 2) & 3u)); \
        __builtin_amdgcn_global_load_lds((const unsigned*)(c.proj + (tokb + (n) * 64 + row) * NP + C_VA + h * 128 + ch * 8), (LAS unsigned*)(L + GLA_V + 1024 * q), 16, 0, 0); } } while (0)
    GLA_PREFETCH(0);
    GLA_VDMA(0);
    for (int n = 0; n < SEQ / 64; ++n) {
        LAS unsigned char* STr = L + GLA_ST + (n & 1) * 18432; LAS unsigned char* STw = L + GLA_ST + ((n + 1) & 1) * 18432;
        float cl[8], qv[8], kv[8];
        { float run = 0.f;
#pragma unroll
          for (int rr = 0; rr < 8; ++rr) { const float g = bf2f(pg[rr]) + bias_d; run += (fminf(g, 0.f) - log1pf(__expf(-fabsf(g)))) * (1.f / 16.f); cl[rr] = run; qv[rr] = bf2f(pq[rr]); kv[rr] = bf2f(pk[rr]); }
          ((LAS float*)(L + GLA_SEG))[w * 64 + lane] = run; }
        __syncthreads();
        { float pre = 0.f, tot = 0.f;
#pragma unroll
          for (int s = 0; s < 8; ++s) { const float v = ((LAS float*)(L + GLA_SEG))[s * 64 + lane]; tot += v; pre += (s < w) ? v : 0.f; }
          if (w == 0) ((LAS float*)(L + GLA_DEC))[lane] = __expf(tot);
#pragma unroll
          for (int rr = 0; rr < 8; ++rr) { const float cum = pre + cl[rr]; const unsigned row = 8 * w + rr;
              const float e = __expf(cum), ei = __expf(-cum), ed = __expf(tot - cum);
              const unsigned o1 = offb(row, lane >> 3) + (lane & 7) * 2, o2 = offb(row, 8 + (lane >> 3)) + (lane & 7) * 2;
              *(LAS unsigned short*)(L + GLA_QK + o1) = (unsigned short)f2bf(qv[rr] * e);
              *(LAS unsigned short*)(L + GLA_QK + o2) = (unsigned short)f2bf(kv[rr] * ei);
              *(LAS unsigned short*)(L + GLA_KD + o1) = (unsigned short)f2bf(kv[rr] * ed); } }
        asm volatile("s_waitcnt vmcnt(0)" ::: "memory");
        __syncthreads();
        const bf16_t* ogp = c.proj + (tokb + n * 64 + i3) * NP + C_OG + h * 128 + 16 * seg;
        const u32x4 og0 = *(const u32x4*)ogp, og1 = *((const u32x4*)ogp + 1);
        if (n + 1 < SEQ / 64) GLA_PREFETCH(n + 1);
        bf16x8 qdf[4];
#pragma unroll
        for (int s = 0; s < 4; ++s) qdf[s] = *(const LAS bf16x8*)(L + GLA_QK + offb(32 * ti + r31, 2 * s + hh));
        f32x16 Z;
#pragma unroll
        for (int i = 0; i < 16; ++i) Z[i] = 0.f;
#pragma unroll
        for (int s = 0; s < 4; ++s) { const bf16x8 sf = *(const LAS bf16x8*)(STr + (32 * tv + r31) * 144 + 32 * s + 16 * hh); Z = __builtin_amdgcn_mfma_f32_32x32x16_bf16(qdf[s], sf, Z, 0, 0, 0); }
#pragma unroll
        for (int tj = 0; tj < 2; ++tj) {
            if (tj <= ti) {
                f32x16 X;
#pragma unroll
                for (int i = 0; i < 16; ++i) X[i] = 0.f;
#pragma unroll
                for (int s = 0; s < 4; ++s) { const bf16x8 kf = *(const LAS bf16x8*)(L + GLA_QK + offb(32 * tj + r31, 8 + 2 * s + hh)); X = __builtin_amdgcn_mfma_f32_32x32x16_bf16(kf, qdf[s], X, 0, 0, 0); }
                const int ig = 32 * ti + (int)r31;
#pragma unroll
                for (int i = 0; i < 16; ++i) X[i] = (ig >= 32 * tj + crow(i, hh)) ? X[i] : 0.f;
#pragma unroll
                for (int s = 0; s < 2; ++s) {
                    u32x4 pw; pw.x = pg8::cvt_pk_bf16(X[8 * s + 0], X[8 * s + 1]); pw.y = pg8::cvt_pk_bf16(X[8 * s + 2], X[8 * s + 3]); pw.z = pg8::cvt_pk_bf16(X[8 * s + 4], X[8 * s + 5]); pw.w = pg8::cvt_pk_bf16(X[8 * s + 6], X[8 * s + 7]);
                    const unsigned vb = (unsigned)(size_t)(L + GLA_V);
                    const bf16x8 vf = tr_frag(vb + tr_addr32(lane, 32 * tj + 16 * s, tv, 0, true), vb + tr_addr32(lane, 32 * tj + 16 * s, tv, 1, true));
                    Z = __builtin_amdgcn_mfma_f32_32x32x16_bf16(__builtin_bit_cast(bf16x8, pw), vf, Z, 0, 0, 0);
                }
            }
        }
#pragma unroll
        for (int i = 0; i < 16; ++i) ((LAS float*)(L + GLA_O))[(32 * ti + crow(i, hh)) * 132 + 32 * tv + r31] = Z[i];
#pragma unroll
        for (int i = 0; i < 16; ++i) St[i] *= ((LAS float*)(L + GLA_DEC))[32 * ti + crow(i, hh)];
#pragma unroll
        for (int s = 0; s < 4; ++s) { const unsigned kb = (unsigned)(size_t)(L + GLA_KD), vb = (unsigned)(size_t)(L + GLA_V);
            const bf16x8 af = tr_frag(kb + tr_addr32(lane, 16 * s, ti, 0, false), kb + tr_addr32(lane, 16 * s, ti, 1, false));
            const bf16x8 bf = tr_frag(vb + tr_addr32(lane, 16 * s, tv, 0, false), vb + tr_addr32(lane, 16 * s, tv, 1, false));
            St = __builtin_amdgcn_mfma_f32_32x32x16_bf16(af, bf, St, 0, 0, 0); }
#pragma unroll
        for (int gq = 0; gq < 4; ++gq) { const float s0 = St[4 * gq], s1 = St[4 * gq + 1], s2 = St[4 * gq + 2], s3 = St[4 * gq + 3];
            u32x2 o; o.x = pk2(s0, s1); o.y = pk2(s2, s3);
            *(LAS u32x2*)(STw + (32 * tv + r31) * 144 + (32 * ti + 8 * gq + 4 * hh) * 2) = o; }
        __syncthreads();
        if (n + 1 < SEQ / 64) GLA_VDMA(n + 1);
        { const LAS f32x4* op = (const LAS f32x4*)(L + GLA_O + i3 * 528 + seg * 64);
          f32x4 o4[4]; float ss = 0.f;
#pragma unroll
          for (int k = 0; k < 4; ++k) { o4[k] = op[k]; ss += (o4[k].x * o4[k].x + o4[k].y * o4[k].y) + (o4[k].z * o4[k].z + o4[k].w * o4[k].w); }
          ss += swz_xor<1>(ss); ss += swz_xor<2>(ss); ss += swz_xor<4>(ss);
          const float rs = rsqrtf(ss * (1.f / 128.f) + RMS_EPS);
          const unsigned ogw[8] = {og0.x, og0.y, og0.z, og0.w, og1.x, og1.y, og1.z, og1.w};
          unsigned ow[8];
#pragma unroll
          for (int k = 0; k < 8; ++k) { const float g0 = bflo(ogw[k]), g1 = bfhi(ogw[k]);
              const float a0 = o4[k >> 1][(2 * k) & 3] * rs * gn[2 * k] * g0 * sigmoidf_(g0), a1 = o4[k >> 1][(2 * k + 1) & 3] * rs * gn[2 * k + 1] * g1 * sigmoidf_(g1);
              ow[k] = pk2(a0, a1); }
          u32x4 w0, w1; w0.x = ow[0]; w0.y = ow[1]; w0.z = ow[2]; w0.w = ow[3]; w1.x = ow[4]; w1.y = ow[5]; w1.z = ow[6]; w1.w = ow[7];
          bf16_t* dst = c.proj + (tokb + n * 64 + i3) * NP + C_OG + h * 128 + 16 * seg;
          *(u32x4*)dst = w0; *((u32x4*)dst + 1) = w1; }
    }
    asm volatile("s_waitcnt vmcnt(0)" ::: "memory");
    __syncthreads();
#undef GLA_PREFETCH
#undef GLA_VDMA
}

constexpr int TPB = TC / 256;
__device__ __forceinline__ void phase_router(const Ctx& c, const float* gain, const float* rw, const float* rb, unsigned* gcnt) {
    LAS float* sRW = (LAS float*)c.lds;
    LAS unsigned* sRec = (LAS unsigned*)(c.lds + 65536);
    LAS unsigned* sCnt = (LAS unsigned*)(c.lds + MISC_OFF + 256);
    LAS unsigned* sBase = sCnt + 16;
    const int tid = c.tid, lane = c.lane;
    for (int idx = tid; idx < D * NE; idx += NTHR) sRW[(idx & 15) * D + (idx >> 4)] = rw[idx];
    if (tid < 16) sCnt[tid] = 0u;
    f32x4 g4[4];
#pragma unroll
    for (int j = 0; j < 4; ++j) g4[j] = *((const f32x4*)gain + 64 * j + lane);
    float rbv[16];
#pragma unroll
    for (int e = 0; e < 16; ++e) rbv[e] = rb[e];
    __syncthreads();
    for (int lt = c.wave; lt < TPB; lt += NWAVES) {
        const int tok = c.bid * TPB + lt;
        const f32x4* xr = (const f32x4*)(c.xo + (size_t)tok * D) + lane;
        f32x4 v[4]; float ss = 0.f;
#pragma unroll
        for (int j = 0; j < 4; ++j) { v[j] = xr[64 * j]; ss += (v[j].x * v[j].x + v[j].y * v[j].y) + (v[j].z * v[j].z + v[j].w * v[j].w); }
        const float rs = rsqrtf(wave_sum(ss) * (1.f / D) + RMS_EPS);
        u32x2* o = (u32x2*)(c.act + (size_t)tok * D) + lane;
#pragma unroll
        for (int j = 0; j < 4; ++j) { v[j] = v[j] * rs * g4[j]; u32x2 w; w.x = pk2(v[j].x, v[j].y); w.y = pk2(v[j].z, v[j].w); o[64 * j] = w; }
        float sc[16]; float mx = -INFINITY;
#pragma unroll
        for (int e = 0; e < 16; ++e) { float p = 0.f;
#pragma unroll
            for (int j = 0; j < 4; ++j) { const f32x4 w = *((const LAS f32x4*)(sRW + e * D) + 64 * j + lane); p += (v[j].x * w.x + v[j].y * w.y) + (v[j].z * w.z + v[j].w * w.w); }
            sc[e] = wave_sum(p) + rbv[e]; mx = fmaxf(mx, sc[e]); }
        float sum = 0.f;
#pragma unroll
        for (int e = 0; e < 16; ++e) { sc[e] = __expf(sc[e] - mx); sum += sc[e]; }
        const float isum = 1.f / sum;
#pragma unroll
        for (int e = 0; e < 16; ++e) sc[e] *= isum;
        int gsel = 0; float gbest = -1.f;
#pragma unroll
        for (int g = 0; g < 4; ++g) { const float a = sc[4 * g], b = sc[4 * g + 1], cc = sc[4 * g + 2], d = sc[4 * g + 3];
            const float hi1 = fmaxf(a, b), lo1 = fminf(a, b), hi2 = fmaxf(cc, d), lo2 = fminf(cc, d);
            const float top = fmaxf(hi1, hi2), second = fmaxf(fminf(hi1, hi2), fmaxf(lo1, lo2));
            const float gs = top + second; if (gs > gbest) { gbest = gs; gsel = g; } }
        float s4[4];
#pragma unroll
        for (int k = 0; k < 4; ++k) s4[k] = gsel == 0 ? sc[k] : gsel == 1 ? sc[4 + k] : gsel == 2 ? sc[8 + k] : sc[12 + k];
        int i0 = 0; float b0 = s4[0];
#pragma unroll
        for (int k = 1; k < 4; ++k) if (s4[k] > b0) { b0 = s4[k]; i0 = k; }
        int i1 = -1; float b1 = -1.f;
#pragma unroll
        for (int k = 0; k < 4; ++k) if (k != i0 && s4[k] > b1) { b1 = s4[k]; i1 = k; }
        const int e0 = 4 * gsel + i0, e1 = 4 * gsel + i1; const float wn = 1.f / (b0 + b1);
        if (lane == 0) { const unsigned l0 = atomicAdd((unsigned*)&sCnt[e0], 1u), l1 = atomicAdd((unsigned*)&sCnt[e1], 1u);
            sRec[lt * 6 + 0] = (unsigned)e0; sRec[lt * 6 + 1] = l0; sRec[lt * 6 + 2] = (unsigned)e1; sRec[lt * 6 + 3] = l1; sRec[lt * 6 + 4] = __float_as_uint(b0 * wn); sRec[lt * 6 + 5] = __float_as_uint(b1 * wn); }
    }
    __syncthreads();
    if (tid < 16) sBase[tid] = __hip_atomic_fetch_add(gcnt + tid, sCnt[tid], __ATOMIC_RELAXED, __HIP_MEMORY_SCOPE_AGENT);
    __syncthreads();
    if (tid < TPB) { const int tok = c.bid * TPB + tid; const unsigned e0 = sRec[tid * 6], e1 = sRec[tid * 6 + 2];
        const unsigned p0 = sBase[e0] + sRec[tid * 6 + 1], p1 = sBase[e1] + sRec[tid * 6 + 3];
        u32x4 r; r.x = (e0 << 20) | p0; r.y = (e1 << 20) | p1; r.z = sRec[tid * 6 + 4]; r.w = sRec[tid * 6 + 5];
        *(u32x4*)(c.rec + (size_t)tok * 4) = r;
        c.list[(size_t)e0 * TC + p0] = tok; c.list[(size_t)e1 * TC + p1] = tok; }
}

struct PlainOrder {
    int nM, nN, G, c; const char* A; const char* Bt; size_t a_tile, b_tile;
    __device__ __forceinline__ bool next(int i, pg8::Unit& u) const { u.g = 0; return pg8::static_tile(nM, nN, G, c, i, u.pm, u.pn); }
    __device__ __forceinline__ const char* aptr(const pg8::Unit& u) const { return A + (size_t)u.pm * a_tile; }
    __device__ __forceinline__ const char* bptr(const pg8::Unit& u) const { return Bt + (size_t)u.pn * b_tile; }
    __device__ __forceinline__ unsigned arow(const pg8::Unit&, int) const { return 0u; }
};
struct MergeOrder {
    int G, c; const char* proj; const char* wbr;
    __device__ __forceinline__ bool next(int i, pg8::Unit& u) const { u.g = i % 3; return pg8::static_tile(TC / 256, 4, G, c, i / 3, u.pm, u.pn); }
    __device__ __forceinline__ const char* aptr(const pg8::Unit& u) const { const int col = u.g == 0 ? C_OG : (u.g == 1 ? C_YB : C_QKV); return proj + ((size_t)u.pm * 256 * NP + col) * 2; }
    __device__ __forceinline__ const char* bptr(const pg8::Unit& u) const { return wbr + ((size_t)u.g * D * 512 + (size_t)u.pn * 256 * 512) * 2; }
    __device__ __forceinline__ unsigned arow(const pg8::Unit&, int) const { return 0u; }
};
template <bool UP> struct MoeOrder {
    int G, c; LAS const int* pt; LAS const int* lc; const char* A; const char* W; const int* list;
    __device__ __forceinline__ bool next(int i, pg8::Unit& u) const { const int L = i * G + c, tau = L >> 2; if (tau >= pt[NE]) return false;
        int e = 0;
#pragma unroll
        for (int k = 1; k < NE; ++k) e += (tau >= pt[k]) ? 1 : 0;
        u.pm = tau; u.pn = L & 3; u.g = e; return true; }
    __device__ __forceinline__ const char* aptr(const pg8::Unit& u) const { return UP ? A : A + (size_t)u.pm * 256 * FF * 2; }
    __device__ __forceinline__ const char* bptr(const pg8::Unit& u) const { return UP ? W + ((size_t)u.g * 1024 * D + (size_t)u.pn * 256 * D) * 2 : W + ((size_t)u.g * D * FF + (size_t)u.pn * 256 * FF) * 2; }
    __device__ __forceinline__ unsigned arow(const pg8::Unit& u, int r) const { int p = (u.pm - pt[u.g]) * 256 + r; const int n = lc[u.g]; p = p < n ? p : n - 1;
        return (unsigned)list[(size_t)u.g * TC + p] * (unsigned)(D * 2); }
};

struct EpiStoreBf16 {
    static constexpr bool PERM = true;
    bf16_t* O; int ldc;
    __device__ __forceinline__ void operator()(const f32x4 (&acc)[2][2][4][2], const pg8::Unit& u, int wr, int wc, int fr, int fq) const {
        const int row0 = u.pm * 256 + wr * 64 + fr, col0 = u.pn * 256 + wc * 32 + 8 * fq;
#pragma unroll
        for (int ai = 0; ai < 2; ++ai)
#pragma unroll
            for (int m = 0; m < 4; ++m) { bf16_t* rowp = O + (size_t)(row0 + ai * 128 + m * 16) * ldc + col0;
#pragma unroll
                for (int bj = 0; bj < 2; ++bj) { const f32x4 v0 = acc[ai][bj][m][0], v1 = acc[ai][bj][m][1];
                    u32x4 w; w.x = pg8::cvt_pk_bf16(v0[0], v0[1]); w.y = pg8::cvt_pk_bf16(v0[2], v0[3]); w.z = pg8::cvt_pk_bf16(v1[0], v1[1]); w.w = pg8::cvt_pk_bf16(v1[2], v1[3]);
                    *(u32x4*)(rowp + bj * 128) = w; } }
    }
};
struct EpiMerge {
    static constexpr bool PERM = true;
    const bf16_t* proj; bf16_t* mg;
    __device__ __forceinline__ void operator()(const f32x4 (&acc)[2][2][4][2], const pg8::Unit& u, int wr, int wc, int fr, int fq) const {
        const int row0 = u.pm * 256 + wr * 64 + fr, col0 = u.pn * 256 + wc * 32 + 8 * fq;
#pragma unroll
        for (int ai = 0; ai < 2; ++ai)
#pragma unroll
            for (int m = 0; m < 4; ++m) { const size_t row = (size_t)(row0 + ai * 128 + m * 16);
#pragma unroll
                for (int bj = 0; bj < 2; ++bj) { const int col = col0 + bj * 128;
                    const u32x4 gv = *(const u32x4*)(proj + row * NP + C_G + u.g * D + col);
                    const f32x4 v0 = acc[ai][bj][m][0], v1 = acc[ai][bj][m][1];
                    float r[8];
                    r[0] = v0[0] * sigmoidf_(bflo(gv.x)); r[1] = v0[1] * sigmoidf_(bfhi(gv.x)); r[2] = v0[2] * sigmoidf_(bflo(gv.y)); r[3] = v0[3] * sigmoidf_(bfhi(gv.y));
                    r[4] = v1[0] * sigmoidf_(bflo(gv.z)); r[5] = v1[1] * sigmoidf_(bfhi(gv.z)); r[6] = v1[2] * sigmoidf_(bflo(gv.w)); r[7] = v1[3] * sigmoidf_(bfhi(gv.w));
                    u32x4* mp = (u32x4*)(mg + row * D + col);
                    if (u.g > 0) { const u32x4 pv = *mp;
                        r[0] += bflo(pv.x); r[1] += bfhi(pv.x); r[2] += bflo(pv.y); r[3] += bfhi(pv.y); r[4] += bflo(pv.z); r[5] += bfhi(pv.z); r[6] += bflo(pv.w); r[7] += bfhi(pv.w); }
                    u32x4 w; w.x = pg8::cvt_pk_bf16(r[0], r[1]); w.y = pg8::cvt_pk_bf16(r[2], r[3]); w.z = pg8::cvt_pk_bf16(r[4], r[5]); w.w = pg8::cvt_pk_bf16(r[6], r[7]);
                    *mp = w; } }
    }
};
struct EpiResid {
    static constexpr bool PERM = false;
    const float* base; float* out;
    __device__ __forceinline__ void operator()(const f32x4 (&acc)[2][2][4][2], const pg8::Unit& u, int wr, int wc, int fr, int fq) const {
        const int row0 = u.pm * 256 + wr * 64 + fr, col0 = u.pn * 256 + wc * 32 + 4 * fq;
#pragma unroll
        for (int ai = 0; ai < 2; ++ai)
#pragma unroll
            for (int m = 0; m < 4; ++m) { const size_t off = (size_t)(row0 + ai * 128 + m * 16) * D + col0;
#pragma unroll
                for (int bj = 0; bj < 2; ++bj)
#pragma unroll
                    for (int n = 0; n < 2; ++n) { const f32x4 b = *(const f32x4*)(base + off + bj * 128 + n * 16); *(f32x4*)(out + off + bj * 128 + n * 16) = b + acc[ai][bj][m][n]; } }
    }
};
struct EpiSwiGLU {
    static constexpr bool PERM = false;
    bf16_t* hid;
    __device__ __forceinline__ void operator()(const f32x4 (&acc)[2][2][4][2], const pg8::Unit& u, int wr, int wc, int fr, int fq) const {
        const int row0 = u.pm * 256 + wr * 64 + fr, col0 = u.pn * 128 + wc * 16 + 4 * fq;
#pragma unroll
        for (int ai = 0; ai < 2; ++ai)
#pragma unroll
            for (int m = 0; m < 4; ++m) { bf16_t* rowp = hid + (size_t)(row0 + ai * 128 + m * 16) * FF + col0;
#pragma unroll
                for (int bj = 0; bj < 2; ++bj) { const f32x4 g = acc[ai][bj][m][0], up = acc[ai][bj][m][1];
                    u32x2 w; w.x = pg8::cvt_pk_bf16(g[0] * sigmoidf_(g[0]) * up[0], g[1] * sigmoidf_(g[1]) * up[1]); w.y = pg8::cvt_pk_bf16(g[2] * sigmoidf_(g[2]) * up[2], g[3] * sigmoidf_(g[3]) * up[3]);
                    *(u32x2*)(rowp + bj * 64) = w; } }
    }
};

constexpr int PH_PER_PASS = 10, N_PASS = NCH * DEPTH, PH_TOTAL = 1 + N_PASS * PH_PER_PASS + 1;
#ifndef MK_LAUNCH_PER_PHASE
#define MK_LAUNCH_PER_PHASE 0
#endif
#ifndef PHMASK
#define PHMASK 0xFFFF
#endif
#ifndef MIXM
#define MIXM 7
#endif
#define EN(j) (((PHMASK) >> (j)) & 1)
typedef const __attribute__((address_space(4))) char* kptr_t;
__device__ __forceinline__ const void* karg_ptr(kptr_t kp, int i) { return *(const void* const __attribute__((address_space(4)))*)(kp + 8 * i); }
__device__ __forceinline__ void make_ctx(Ctx& c, kptr_t& kp, int pass) {
    int t = threadIdx.x; asm volatile("" : "+v"(t));
    kp = (kptr_t)__builtin_amdgcn_kernarg_segment_ptr(); asm volatile("" : "+s"(kp));
    c.tid = t; c.lane = t & 63; c.wave = __builtin_amdgcn_readfirstlane(t >> 6); c.bid = blockIdx.x; c.G = gridDim.x;
    unsigned char* ws = (unsigned char*)karg_ptr(kp, 25); float* out = (float*)karg_ptr(kp, 24);
    c.ctl = (unsigned*)(ws + WS_CTL);
    c.act = (bf16_t*)(ws + WS_ACT); c.proj = (bf16_t*)(ws + WS_PROJ); c.hid = (bf16_t*)(ws + WS_HID); c.ys = (bf16_t*)(ws + WS_YS);
    c.rec = (unsigned*)(ws + WS_REC); c.list = (int*)(ws + WS_LIST);
    const int chunk = pass / DEPTH, layer = pass % DEPTH;
    c.chunk = chunk; c.layer = layer; c.pass = pass;
    c.x_in = (const float*)karg_ptr(kp, 0) + (size_t)chunk * TC * D; c.xo = out + (size_t)chunk * TC * D;
    c.pos = (const int*)karg_ptr(kp, 1) + (size_t)chunk * TC;
    c.lw = ws + WS_W + (size_t)layer * LW_SIZE;
}
#define INP(i) ((const float*)karg_ptr(kp, (i)))
__global__ void __launch_bounds__(NTHR, 2) fwd(Args args) {
    extern __shared__ __attribute__((aligned(16))) unsigned char lds_raw[];
    Ctx c; kptr_t kp;
    c.lds = (LAS unsigned char*)lds_raw;
    make_ctx(c, kp, 0);
    volatile LAS unsigned* MISC = (volatile LAS unsigned*)(c.lds + MISC_OFF);
    LAS int* sPT = (LAS int*)(c.lds + MISC_OFF + 64);
    LAS int* sLC = (LAS int*)(c.lds + MISC_OFF + 160);
    for (int u = c.tid; u < 1024; u += NTHR) MISC[u] = 0u;
    __syncthreads();
    XcdBarrier bar; bar.bar = c.ctl + CW_BAR; bar.x = 0; bar.st = nullptr;
    if (!MK_LAUNCH_PER_PHASE) bar = xcd_barrier_post(c.ctl + CW_BAR, MISC);
    const int lo = args.ph_lo, hi = args.ph_hi;
#define IN(k) (lo <= (k) && (k) < hi)
#define SEAM(k) do { if (IN(k) && IN((k) + 1)) { XcdBarrier _b = bar; kptr_t _k = (kptr_t)__builtin_amdgcn_kernarg_segment_ptr(); asm volatile("" : "+s"(_k)); _b.bar = (unsigned*)((unsigned char*)karg_ptr(_k, 25) + WS_CTL) + CW_BAR; xcd_barrier(_b); } } while (0)

    if (EN(0) && IN(0)) { Args a2;
#pragma unroll
        for (int i = 0; i < 24; ++i) a2.in[i] = karg_ptr(kp, i);
        a2.ws = (unsigned char*)karg_ptr(kp, 25); a2.out = nullptr; a2.ph_lo = 0; a2.ph_hi = 0;
        phase_prep(a2, c.lds, c.bid * NWAVES + c.wave, c.G * NWAVES, c.wave, c.lane, c.bid * NTHR + c.tid, c.G * NTHR); }
    SEAM(0);

    for (int pass = 0; pass < N_PASS; ++pass) {
        const int pb = 1 + pass * PH_PER_PASS;
        if (EN(1) && IN(pb + 0)) { make_ctx(c, kp, pass);
            const float* g1 = INP(2) + c.layer * D;
            if (c.layer == 0) {
                if (c.chunk > 0) {
                    Ctx p = c; p.xo = c.xo - (size_t)TC * D;
                    moe_tables(c.ctl + CW_CNT + 64 * (pass - 1), sPT, sLC, c.tid);
                    phase_norm1<true, false, true>(p, nullptr, sPT);
                }
                phase_norm1<false, true, false>(c, g1, sPT);
            } else {
                moe_tables(c.ctl + CW_CNT + 64 * (pass - 1), sPT, sLC, c.tid);
                phase_norm1<true, true, true>(c, g1, sPT);
            }
        }
        SEAM(pb + 0);
        if (EN(2) && IN(pb + 1)) { make_ctx(c, kp, pass);
            PlainOrder S{TC / 256, NP / 256, c.G, c.bid, (const char*)c.act, (const char*)(c.lw + LW_WIN), (size_t)256 * D * 2, (size_t)256 * D * 2};
            EpiStoreBf16 E{c.proj, NP};
            pg8::gemm_phase<EpiStoreBf16, PlainOrder, false>(c.lds, S, E, D, D);
        }
        SEAM(pb + 1);
        if (EN(3) && IN(pb + 2)) { make_ctx(c, kp, pass); phase_qkrope(c, INP(14) + c.layer * 128, INP(15) + c.layer * 128); }
        SEAM(pb + 2);
        if (EN(4) && IN(pb + 3)) { make_ctx(c, kp, pass); const int layer = c.layer;
            float* lse = (float*)(c.ctl) + (WS_BRC / 4);
            if (c.bid < 4 * BC) gla_unit(c, c.bid, INP(5) + layer * 256, INP(6) + layer * 128);
            else if (c.bid < 5 * BC) lru_simple(c, c.bid - 4 * BC, INP(7) + layer * 4 * 512, INP(8) + layer * 512, INP(9) + layer * 8 * 64 * 64,
                                                INP(10) + layer * 512, INP(11) + layer * 8 * 64 * 64, INP(12) + layer * 512, INP(13) + layer * 512);
            else { for (int u = c.bid - 5 * BC; u < BC * ATT_UNITS_PER_SEQ; u += c.G - 5 * BC) attn_unit(c, u, lse); }
        }
        SEAM(pb + 3);
        if (EN(11) && IN(pb + 4)) { make_ctx(c, kp, pass); phase_attn_combine(c, (const float*)(c.ctl) + (WS_BRC / 4)); }
        SEAM(pb + 4);
        if (EN(5) && IN(pb + 5)) { make_ctx(c, kp, pass);
            MergeOrder S{c.G, c.bid, (const char*)c.proj, (const char*)(c.lw + LW_WBR)};
            EpiMerge E{c.proj, c.act};
            pg8::gemm_phase<EpiMerge, MergeOrder, false>(c.lds, S, E, 512, NP);
        }
        SEAM(pb + 5);
        if (EN(6) && IN(pb + 6)) { make_ctx(c, kp, pass);
            PlainOrder S{TC / 256, D / 256, c.G, c.bid, (const char*)c.act, (const char*)(c.lw + LW_WOUT), (size_t)256 * D * 2, (size_t)256 * D * 2};
            EpiResid E{c.layer == 0 ? c.x_in : (const float*)c.xo, c.xo};
            pg8::gemm_phase<EpiResid, PlainOrder, false>(c.lds, S, E, D, D);
        }
        SEAM(pb + 6);
        if (EN(7) && IN(pb + 7)) { make_ctx(c, kp, pass); phase_router(c, INP(18) + c.layer * D, INP(19), INP(20), c.ctl + CW_CNT + 64 * pass); }
        SEAM(pb + 7);
        if (EN(8) && IN(pb + 8)) { make_ctx(c, kp, pass);
            moe_tables(c.ctl + CW_CNT + 64 * pass, sPT, sLC, c.tid);
            MoeOrder<true> S{c.G, c.bid, sPT, sLC, (const char*)c.act, (const char*)(c.lw + LW_WGU), c.list};
            EpiSwiGLU E{c.hid};
            pg8::gemm_phase<EpiSwiGLU, MoeOrder<true>, true>(c.lds, S, E, D, D);
        }
        SEAM(pb + 8);
        if (EN(9) && IN(pb + 9)) { make_ctx(c, kp, pass);
            moe_tables(c.ctl + CW_CNT + 64 * pass, sPT, sLC, c.tid);
            MoeOrder<false> S{c.G, c.bid, sPT, sLC, (const char*)c.hid, (const char*)(c.lw + LW_WDN), c.list};
            EpiStoreBf16 E{c.ys, D};
            pg8::gemm_phase<EpiStoreBf16, MoeOrder<false>, false>(c.lds, S, E, FF, FF);
        }
        SEAM(pb + 9);
    }
    if (EN(10) && IN(PH_TOTAL - 1)) { make_ctx(c, kp, N_PASS - 1);
        moe_tables(c.ctl + CW_CNT + 64 * (N_PASS - 1), sPT, sLC, c.tid);
        phase_norm1<true, false, true>(c, nullptr, sPT);
    }
#undef IN
#undef SEAM
}

extern "C" void kernel_launch(void* const* d_in, const int* in_sizes, int n_in, void* d_out, int out_size, void* d_ws, size_t ws_size, hipStream_t stream) {
    static int grid = 0;
    if (grid == 0) {
        if (n_in != 24 || in_sizes[0] != BATCH * SEQ * D || out_size != BATCH * SEQ * D || ws_size < WS_END) { fprintf(stderr, "kernel_launch: unexpected shapes / workspace (%zu < %zu)\n", ws_size, (size_t)WS_END); grid = -1; return; }
        int dev = 0, cus = 0;
        if (hipGetDevice(&dev) != hipSuccess || hipDeviceGetAttribute(&cus, hipDeviceAttributeMultiprocessorCount, dev) != hipSuccess || cus < 256) { fprintf(stderr, "kernel_launch: needs a 256-CU device\n"); grid = -1; return; }
        if (hipFuncSetAttribute((const void*)fwd, hipFuncAttributeMaxDynamicSharedMemorySize, LDS_BYTES) != hipSuccess) { fprintf(stderr, "kernel_launch: hipFuncSetAttribute failed\n"); grid = -1; return; }
        int per_cu = 0;
        if (hipOccupancyMaxActiveBlocksPerMultiprocessor(&per_cu, (const void*)fwd, NTHR, LDS_BYTES) != hipSuccess || per_cu < 1) fprintf(stderr, "kernel_launch: occupancy query says %d\n", per_cu);
        (void)hipGetLastError();
        grid = 256;
    }
    if (grid < 0) return;
    if (hipMemsetAsync((char*)d_ws + WS_CTL, 0, CTL_ZERO_BYTES, stream) != hipSuccess) return;
    Args a{};
    for (int i = 0; i < 24; ++i) a.in[i] = d_in[i];
    a.out = (float*)d_out; a.ws = (unsigned char*)d_ws;
#if MK_LAUNCH_PER_PHASE
    for (int k = 0; k < PH_TOTAL; ++k) { a.ph_lo = k; a.ph_hi = k + 1; hipLaunchKernelGGL(fwd, dim3(grid), dim3(NTHR), LDS_BYTES, stream, a); }
#else
    a.ph_lo = 0; a.ph_hi = PH_TOTAL;
    hipLaunchKernelGGL(fwd, dim3(grid), dim3(NTHR), LDS_BYTES, stream, a);
#endif
}
```

```cpp
#include <hip/hip_runtime.h>
#include <cstdio>
#include <cstdint>

#define LAS __attribute__((address_space(3)))
#define GAS __attribute__((address_space(1)))
typedef unsigned short bf16_t;
typedef short bf16x8 __attribute__((ext_vector_type(8)));
typedef float f32x4 __attribute__((ext_vector_type(4)));
typedef float f32x2 __attribute__((ext_vector_type(2)));
typedef unsigned u32x4 __attribute__((ext_vector_type(4)));
typedef unsigned u32x2 __attribute__((ext_vector_type(2)));

namespace pg8 {
constexpr int BM = 256, BK = 64, HALF = 128, HTB = HALF * BK * 2, STAGE_BYTES = 8 * HTB, NXCD = 8, WGM = 8;
__host__ __device__ __forceinline__ int lds_byte(int r, int c) { const int st = (r >> 4) * 2 + (c >> 5), rr = r & 15, cc = c & 31, ob = rr * 64 + cc * 2; return st * 1024 + (ob ^ (((ob >> 9) & 1) << 5)); }
__host__ __device__ __forceinline__ void stage_rc(int b, int& R, int& C) { const int st = b / 1024, sb = b % 1024, swz = sb ^ (((sb >> 9) & 1) << 5); R = (st >> 1) * 16 + swz / 64; C = (st & 1) * 32 + (swz % 64) / 2; }
__host__ __device__ __forceinline__ int perm32(int rho) { const int n = rho >> 4, i = rho & 15; return 8 * (i >> 2) + 4 * n + (i & 3); }

struct Unit { int pm, pn, g; };

__device__ __forceinline__ bool static_tile(int nM, int nN, int G, int c, int i, int& pm, int& pn) {
    const int nwg = nM * nN; const long L = (long)i * G + c; if (L >= nwg) return false;
    int wgid = (int)L; { const int q = nwg / NXCD, r = nwg % NXCD, xcd = wgid % NXCD, off = wgid / NXCD; wgid = (xcd < r ? xcd * (q + 1) : r * (q + 1) + (xcd - r) * q) + off; }
    const int nig = WGM * nN, gid = wgid / nig, fm = gid * WGM, gsz = (nM - fm) < WGM ? (nM - fm) : WGM;
    pm = fm + ((wgid % nig) % gsz); pn = (wgid % nig) / gsz; return true;
}
__device__ __forceinline__ unsigned cvt_pk_bf16(float lo, float hi) { unsigned r; asm volatile("v_cvt_pk_bf16_f32 %0, %1, %2" : "=v"(r) : "v"(lo), "v"(hi)); return r; }

template <class Epi, class Sched, bool GATHER>
__device__ __forceinline__ void gemm_phase(LAS unsigned char* lds, const Sched& S, const Epi& E, const int K, const int lda, int tid_) {
    asm volatile("" : "+v"(tid_));
    const int tid = tid_, wid = __builtin_amdgcn_readfirstlane(tid >> 6), lane = tid & 63, wr = wid >> 2, wc = wid & 3, fr = lane & 15, fq = lane >> 4;
    const int nt = K / BK;
    int sR[2], sC[2];
    unsigned voffB[2], voffA[2], vAc[2][2], vAn[2][2];
#pragma unroll
    for (int i = 0; i < 2; ++i) { int R, C; stage_rc(tid * 16 + i * 8192, R, C); sR[i] = R; sC[i] = C; const int Rb = Epi::PERM ? ((R & ~31) + perm32(R & 31)) : R;
        voffB[i] = (unsigned)(Rb * K + C) * 2u; voffA[i] = (unsigned)(R * lda + C) * 2u; }
    const size_t kstep = (size_t)(BK * 2);
    const size_t hstepB = (size_t)HALF * K * 2, hstepA = (size_t)HALF * lda * 2;
    const unsigned ldsw = (unsigned)wid * 1024u;
    const int aoff = lds_byte(wr * 64 + fr, fq * 8), boff = lds_byte(wc * 32 + fr, fq * 8);
#define PG8_SA(b, h) (((b) * 2 + (h)) * HTB)
#define PG8_SB(b, h) ((4 + (b) * 2 + (h)) * HTB)
#define PG8_STAGE(bufoff, gbase, voff) do { _Pragma("unroll") for (int _i = 0; _i < 2; ++_i) \
        __builtin_amdgcn_global_load_lds((const unsigned*)((const char*)(gbase) + (voff)[_i]), (LAS unsigned*)(lds + (bufoff) + ldsw + _i * 8192), 16, 0, 0); } while (0)
#define PG8_LDA(dst, b, h) do { _Pragma("unroll") for (int m = 0; m < 4; ++m) _Pragma("unroll") for (int k = 0; k < 2; ++k) dst[m][k] = *(const LAS bf16x8*)(lds + PG8_SA(b, h) + aoff + m * 2048 + k * 1024); } while (0)
#define PG8_LDB(dst, b, h) do { _Pragma("unroll") for (int n = 0; n < 2; ++n) _Pragma("unroll") for (int k = 0; k < 2; ++k) dst[n][k] = *(const LAS bf16x8*)(lds + PG8_SB(b, h) + boff + n * 2048 + k * 1024); } while (0)
#define PG8_MMA(ai, bj, At, Bt) do { __builtin_amdgcn_s_setprio(1); _Pragma("unroll") for (int m = 0; m < 4; ++m) _Pragma("unroll") for (int n = 0; n < 2; ++n) _Pragma("unroll") for (int k = 0; k < 2; ++k) \
        acc[ai][bj][m][n] = __builtin_amdgcn_mfma_f32_16x16x32_bf16(Bt[n][k], At[m][k], acc[ai][bj][m][n], 0, 0, 0); __builtin_amdgcn_s_setprio(0); } while (0)
#define PG8_WAIT_V(n) asm volatile("s_waitcnt vmcnt(" #n ")" ::: "memory")
#define PG8_WAIT_L(n) asm volatile("s_waitcnt lgkmcnt(" #n ")" ::: "memory")
#define PG8_BAR __builtin_amdgcn_s_barrier()
#define PG8_SCHED __builtin_amdgcn_sched_barrier(0)
#define PG8_AOFF(dst, u) do { if constexpr (GATHER) { _Pragma("unroll") for (int _h = 0; _h < 2; ++_h) _Pragma("unroll") for (int _i = 0; _i < 2; ++_i) \
        dst[_h][_i] = S.arow(u, _h * HALF + sR[_i]) + (unsigned)sC[_i] * 2u; } } while (0)
#define PG8_STAGE_A(bufoff, gptr, h, usenext) do { if constexpr (GATHER) { _Pragma("unroll") for (int _i = 0; _i < 2; ++_i) { const unsigned _vo = (usenext) ? vAn[h][_i] : vAc[h][_i]; \
        __builtin_amdgcn_global_load_lds((const unsigned*)((const char*)(gptr) + _vo), (LAS unsigned*)(lds + (bufoff) + ldsw + _i * 8192), 16, 0, 0); } } \
        else { PG8_STAGE(bufoff, (gptr) + (h) * hstepA, voffA); } } while (0)
    Unit cur, nxt; int ui = 0;
    if (!S.next(0, cur)) return;
    f32x4 acc[2][2][4][2];
#pragma unroll
    for (int a = 0; a < 2; ++a)
#pragma unroll
        for (int b = 0; b < 2; ++b)
#pragma unroll
            for (int m = 0; m < 4; ++m)
#pragma unroll
                for (int n = 0; n < 2; ++n) acc[a][b][m][n] = (f32x4){0.f, 0.f, 0.f, 0.f};
    bf16x8 At[4][2], B0[2][2], B1[2][2];
    const char* cA = S.aptr(cur); const char* cB = S.bptr(cur);
    PG8_AOFF(vAc, cur);
    PG8_STAGE(PG8_SB(0, 0), cB, voffB); PG8_STAGE(PG8_SB(0, 1), cB + hstepB, voffB); PG8_STAGE_A(PG8_SA(0, 0), cA, 0, false); PG8_STAGE_A(PG8_SA(0, 1), cA, 1, false);
    if (wr == 1) PG8_BAR;
    PG8_WAIT_V(2); PG8_BAR;
    PG8_STAGE(PG8_SB(1, 0), cB + kstep, voffB); PG8_STAGE_A(PG8_SA(1, 0), cA + kstep, 0, false); PG8_STAGE(PG8_SB(1, 1), cB + hstepB + kstep, voffB);
    PG8_WAIT_V(6); PG8_BAR;
    for (;;) {
        const bool has_next = S.next(ui + 1, nxt);
        const char* nA = has_next ? S.aptr(nxt) : cA; const char* nB = has_next ? S.bptr(nxt) : cB;
        if constexpr (GATHER) { if (has_next) { PG8_AOFF(vAn, nxt); } else {
#pragma unroll
            for (int h = 0; h < 2; ++h)
#pragma unroll
                for (int i = 0; i < 2; ++i) vAn[h][i] = vAc[h][i]; } }
        for (int t = 0; t < nt; t += 2) {
            const bool last = (t == nt - 2);
            const char* a1 = cA + (size_t)(t + 1) * kstep;
            const char* a2 = last ? nA : cA + (size_t)(t + 2) * kstep; const char* b2 = last ? nB : cB + (size_t)(t + 2) * kstep;
            const char* a3 = a2 + kstep; const char* b3 = b2 + kstep;
            PG8_LDB(B0, 0, 0); PG8_LDB(B1, 0, 1); PG8_SCHED; PG8_LDA(At, 0, 0); PG8_STAGE_A(PG8_SA(1, 1), a1, 1, false);
            PG8_WAIT_V(8); PG8_WAIT_L(0); PG8_BAR; PG8_MMA(0, 0, At, B0); PG8_MMA(0, 1, At, B1); PG8_BAR; PG8_SCHED;
            PG8_LDA(At, 0, 1); PG8_STAGE(PG8_SB(0, 0), b2, voffB); PG8_STAGE(PG8_SB(0, 1), b2 + hstepB, voffB); PG8_STAGE_A(PG8_SA(0, 0), a2, 0, last);
            PG8_WAIT_V(8); PG8_WAIT_L(0); PG8_BAR; PG8_MMA(1, 0, At, B0); PG8_MMA(1, 1, At, B1); PG8_BAR; PG8_SCHED;
            PG8_LDB(B0, 1, 0); PG8_LDB(B1, 1, 1); PG8_SCHED; PG8_LDA(At, 1, 0); PG8_STAGE_A(PG8_SA(0, 1), a2, 1, last);
            PG8_WAIT_V(8); PG8_WAIT_L(0); PG8_BAR; PG8_MMA(0, 0, At, B0); PG8_MMA(0, 1, At, B1); PG8_BAR; PG8_SCHED;
            PG8_LDA(At, 1, 1); PG8_STAGE(PG8_SB(1, 0), b3, voffB); PG8_STAGE(PG8_SB(1, 1), b3 + hstepB, voffB); PG8_STAGE_A(PG8_SA(1, 0), a3, 0, last);
            PG8_WAIT_V(8); PG8_WAIT_L(0); PG8_BAR; PG8_MMA(1, 0, At, B0); PG8_MMA(1, 1, At, B1); PG8_BAR; PG8_SCHED;
        }
        if (wr == 0) PG8_BAR;
        E(acc, cur, wr, wc, fr, fq);
        if (!has_next) break;
#pragma unroll
        for (int a = 0; a < 2; ++a)
#pragma unroll
            for (int b = 0; b < 2; ++b)
#pragma unroll
                for (int m = 0; m < 4; ++m)
#pragma unroll
                    for (int n = 0; n < 2; ++n) acc[a][b][m][n] = (f32x4){0.f, 0.f, 0.f, 0.f};
        cur = nxt; cA = nA; cB = nB; ++ui;
        if constexpr (GATHER) {
#pragma unroll
        for (int h = 0; h < 2; ++h)
#pragma unroll
            for (int i = 0; i < 2; ++i) vAc[h][i] = vAn[h][i]; }
        if (wr == 1) PG8_BAR;
    }
    PG8_WAIT_V(0);
    PG8_BAR;
#undef PG8_SA
#undef PG8_SB
#undef PG8_STAGE
#undef PG8_LDA
#undef PG8_LDB
#undef PG8_MMA
#undef PG8_WAIT_V
#undef PG8_WAIT_L
#undef PG8_BAR
#undef PG8_SCHED
#undef PG8_AOFF
#undef PG8_STAGE_A
}
}

constexpr int D = 1024, BATCH = 32, SEQ = 2048, DEPTH = 2;
constexpr int NCH = 2, BC = BATCH / NCH, TC = BC * SEQ;
constexpr int NP = 10496;
constexpr int C_QA = 0, C_KA = 256, C_VA = 512, C_OG = 1024, C_GP = 1536, C_XB = 1792, C_YB = 2304, C_QKV = 2816, C_G = 7424;
constexpr int WIN_N = 10256;
constexpr int NE = 16, FF = 512;
constexpr int RP = 2 * TC + NE * 256;
constexpr float RMS_EPS = 1e-6f;
constexpr int NWAVES = 8, NTHR = 512;

constexpr size_t MiB = 1u << 20;
constexpr size_t WS_CTL = 0, CTL_ZERO_BYTES = 1 * MiB;
constexpr size_t WS_REC = 1 * MiB;
constexpr size_t WS_LIST = 2 * MiB;
constexpr size_t WS_W = 4 * MiB;
constexpr size_t LW_WIN = 0, LW_WBR = LW_WIN + (size_t)NP * D * 2, LW_WOUT = LW_WBR + (size_t)3 * D * 512 * 2, LW_WGU = LW_WOUT + (size_t)D * D * 2,
                 LW_WDN = LW_WGU + (size_t)NE * 1024 * D * 2, LW_SIZE = LW_WDN + (size_t)NE * D * FF * 2;
static_assert(LW_SIZE == 77070336, "layer weights");
constexpr size_t WS_ACT = 152 * MiB;
constexpr size_t WS_BRC = 216 * MiB;
constexpr size_t WS_PROJ = 248 * MiB;
constexpr size_t WS_HID = WS_PROJ;
constexpr size_t WS_YS = WS_PROJ + 72 * MiB;
constexpr size_t WS_END = WS_PROJ + 656 * MiB;
static_assert(WS_W + 2 * LW_SIZE <= WS_ACT && (size_t)TC * NP * 2 <= 656 * MiB && (size_t)RP * 512 * 2 <= 72 * MiB && WS_YS + (size_t)RP * 2048 <= WS_END, "ws map");
constexpr int CW_BAR = 4096;
constexpr int CW_CNT = 8192;
constexpr int CW_Q = 12288;

constexpr int RING_BYTES = 131072;
constexpr int MISC_OFF = RING_BYTES;
constexpr int LDS_BYTES = 147456;

#define LDS_WAIT() asm volatile("s_waitcnt lgkmcnt(0)" ::: "memory")
#define VM_WAIT() asm volatile("s_waitcnt vmcnt(0)" ::: "memory")
__device__ __forceinline__ float bf2f(unsigned short b) { return __uint_as_float(((unsigned)b) << 16); }
__device__ __forceinline__ float bflo(unsigned u) { return __uint_as_float(u << 16); }
__device__ __forceinline__ float bfhi(unsigned u) { return __uint_as_float(u & 0xffff0000u); }
__device__ __forceinline__ unsigned f2bf(float f) { unsigned u = __float_as_uint(f); return (u + 0x7fffu + ((u >> 16) & 1u)) >> 16; }
__device__ __forceinline__ unsigned pk2(float lo, float hi) { return f2bf(lo) | (f2bf(hi) << 16); }
template <int O> __device__ __forceinline__ float swz_xor(float v) { return __int_as_float(__builtin_amdgcn_ds_swizzle(__float_as_int(v), (O << 10) | 0x1f)); }
__device__ __forceinline__ float wave_sum(float v) {
    v += swz_xor<1>(v); v += swz_xor<2>(v); v += swz_xor<4>(v); v += swz_xor<8>(v); v += swz_xor<16>(v);
    const auto r = __builtin_amdgcn_permlane32_swap(__float_as_uint(v), __float_as_uint(v), false, false);
    return __uint_as_float(r[0]) + __uint_as_float(r[1]);
}
__device__ __forceinline__ float wave_max(float v) {
    v = fmaxf(v, swz_xor<1>(v)); v = fmaxf(v, swz_xor<2>(v)); v = fmaxf(v, swz_xor<4>(v)); v = fmaxf(v, swz_xor<8>(v)); v = fmaxf(v, swz_xor<16>(v));
    const auto r = __builtin_amdgcn_permlane32_swap(__float_as_uint(v), __float_as_uint(v), false, false);
    return fmaxf(__uint_as_float(r[0]), __uint_as_float(r[1]));
}
__device__ __forceinline__ float sigmoidf_(float x) { return 1.f / (1.f + __expf(-x)); }

#define XB_TMO      128
#define XB_XCNT(j)  (256  + 64 * (j))
#define XB_XSUB(j)  (1280 + 64 * (j))
#define XB_XGEN(j)  (2304 + 64 * (j))
#define XB_TOP      3328
#define XB_TOPGEN   3392
#define XCD_BAR_WORDS 3456
#define XB_SPIN_CAP (1u << 21)
__device__ __forceinline__ unsigned xb_ld(unsigned* p)              { return __hip_atomic_load(p, __ATOMIC_RELAXED, __HIP_MEMORY_SCOPE_AGENT); }
__device__ __forceinline__ unsigned xb_add(unsigned* p, unsigned v) { return __hip_atomic_fetch_add(p, v, __ATOMIC_RELAXED, __HIP_MEMORY_SCOPE_AGENT); }
__device__ __forceinline__ unsigned xb_xcc_id() { return (unsigned)__builtin_amdgcn_s_getreg((3 << 11) | 20) & 0xFu; }
#define XB_SPIN(cond, bar) do { unsigned _sp = 0; while (cond) { __builtin_amdgcn_s_sleep(1); \
    if ((++_sp & 255u) == 0u) { if (xb_ld(&(bar)[XB_TMO])) break; if (_sp > XB_SPIN_CAP) { atomicAdd(&(bar)[XB_TMO], 1u); break; } } } } while (0)
struct XcdBarrier { unsigned* bar; unsigned x; volatile LAS unsigned* st; };
__device__ __forceinline__ XcdBarrier xcd_barrier_post(unsigned* bar, volatile LAS unsigned* st, int tid) {
    XcdBarrier b; b.bar = bar; b.x = xb_xcc_id(); b.st = st;
    if (tid == 0) (void)xb_add(&bar[XB_XCNT(b.x)], 1u);
    return b;
}
__device__ __forceinline__ void xcd_barrier_complete(unsigned* bar, unsigned x, unsigned& nloc, unsigned& nx) {
    const unsigned G = gridDim.x * gridDim.y * gridDim.z;
    unsigned sum, cnt, sp = 0u;
    for (;;) {
        sum = 0u; cnt = 0u;
#pragma unroll 1
        for (unsigned j = 0; j < 16; ++j) { const unsigned c = xb_ld(&bar[XB_XCNT(j)]); sum += c; cnt += (c > 0u) ? 1u : 0u; }
        if (sum == G) break;
        __builtin_amdgcn_s_sleep(1);
        if ((++sp & 255u) == 0u) { if (xb_ld(&bar[XB_TMO])) break; if (sp > XB_SPIN_CAP) { atomicAdd(&bar[XB_TMO], 1u); break; } }
    }
    const unsigned mine = xb_ld(&bar[XB_XCNT(x)]);
    nloc = mine > 0u ? mine : 1u; nx = cnt > 0u ? cnt : 1u;
}
__device__ __noinline__ void xcd_barrier(const XcdBarrier b, const int tid) {
    asm volatile("s_waitcnt vmcnt(0)" ::: "memory");
    __syncthreads();
    if (tid == 0) {
        unsigned* bar = b.bar;
        __builtin_amdgcn_s_waitcnt(0);
        unsigned nloc = b.st[0], nx = b.st[1];
        if (nloc == 0u) { xcd_barrier_complete(bar, b.x, nloc, nx); b.st[0] = nloc; b.st[1] = nx; }
        const unsigned old = xb_add(&bar[XB_XSUB(b.x)], 1u);
        const unsigned gen = old / nloc;
        if (old + 1u == (gen + 1u) * nloc) {
            __builtin_amdgcn_fence(__ATOMIC_RELEASE, "agent");
            asm volatile("s_waitcnt vmcnt(0)" ::: "memory");
            const unsigned og = xb_add(&bar[XB_TOP], 1u);
            const unsigned tg = og / nx;
            if (og + 1u == (tg + 1u) * nx) xb_add(&bar[XB_TOPGEN], 1u);
            else XB_SPIN(xb_ld(&bar[XB_TOPGEN]) == tg, bar);
            __builtin_amdgcn_fence(__ATOMIC_ACQUIRE, "agent");
            xb_add(&bar[XB_XGEN(b.x)], 1u);
            asm volatile("s_waitcnt vmcnt(0)" ::: "memory");
        } else {
            XB_SPIN(xb_ld(&bar[XB_XGEN(b.x)]) == gen, bar);
            __builtin_amdgcn_fence(__ATOMIC_ACQUIRE, "agent");
            asm volatile("s_waitcnt vmcnt(0)" ::: "memory");
        }
    }
    __syncthreads();
}

struct Args { const void* in[24]; float* out; unsigned char* ws; int ph_lo, ph_hi; };
struct Ctx {
    LAS unsigned char* lds;
    unsigned* ctl;
    int tid, lane, wave, bid, G;
    int chunk, layer, pass;
    const float* x_in; float* xo;
    const int* pos;
    const unsigned char* lw;
    bf16_t *act, *proj, *hid, *ys;
    unsigned* rec; int* list;
};

__device__ __forceinline__ void tr_item(const float* srcp, int Nsrc, float scale, bf16_t* WT, int K, int n0, int k0, LAS float* scr, int lane) {
#pragma unroll 8
    for (int i = 0; i < 32; ++i) { const int kk = 2 * i + (lane >> 5); scr[kk * 33 + (lane & 31)] = srcp[(size_t)(k0 + kk) * Nsrc] * scale; }
    LDS_WAIT(); asm volatile("" ::: "memory");
    const int c = lane & 7;
#pragma unroll
    for (int j = 0; j < 4; ++j) { const int n = (lane >> 3) + 8 * j; const LAS float* s = scr + (8 * c) * 33 + n;
        u32x4 o; o.x = pk2(s[0 * 33], s[1 * 33]); o.y = pk2(s[2 * 33], s[3 * 33]); o.z = pk2(s[4 * 33], s[5 * 33]); o.w = pk2(s[6 * 33], s[7 * 33]);
        *(u32x4*)(WT + (size_t)(n0 + n) * K + k0 + 8 * c) = o; }
    LDS_WAIT(); asm volatile("" ::: "memory");
}
constexpr int IT_WIN = (NP / 32) * 16, IT_WBR = 3 * 32 * 8, IT_WOUT = 32 * 16, IT_WGU = NE * 32 * 16, IT_WDN = NE * 32 * 8, IT_LAYER = IT_WIN + IT_WBR + IT_WOUT + IT_WGU + IT_WDN;
__device__ __forceinline__ void phase_prep(const Args& a, LAS unsigned char* lds, int gw, int NGW, int wave, int lane, int gtid, int NGT) {
    LAS float* scr = (LAS float*)(lds + wave * 16384);
    for (int it = gw; it < DEPTH * IT_LAYER; it += NGW) {
        const int l = it / IT_LAYER; int r = it % IT_LAYER;
        unsigned char* lw = a.ws + WS_W + (size_t)l * LW_SIZE;
        const int rl = lane & 31;
        if (r < IT_WIN) {
            const int g = r / 16, kb = r % 16;
            if (g >= C_GP / 32 && g < C_XB / 32) continue;
            const int n = 32 * g + rl; const int src = n < C_GP ? n : n - 240;
            const float* W = (const float*)a.in[3] + (size_t)l * D * WIN_N;
            tr_item(W + src, WIN_N, n < 256 ? 0.125f : 1.f, (bf16_t*)(lw + LW_WIN), D, 32 * g, 64 * kb, scr, lane);
            continue; }
        r -= IT_WIN;
        if (r < IT_WBR) {
            const int b = r / 256, g = (r % 256) / 8, kb = r % 8;
            const float* W = (const float*)a.in[16] + ((size_t)l * 3 + b) * 512 * D;
            tr_item(W + 32 * g + rl, D, 1.f, (bf16_t*)(lw + LW_WBR) + (size_t)b * D * 512, 512, 32 * g, 64 * kb, scr, lane);
            continue; }
        r -= IT_WBR;
        if (r < IT_WOUT) {
            const int g = r / 16, kb = r % 16;
            const float* W = (const float*)a.in[17] + (size_t)l * D * D;
            tr_item(W + 32 * g + rl, D, 1.f, (bf16_t*)(lw + LW_WOUT), D, 32 * g, 64 * kb, scr, lane);
            continue; }
        r -= IT_WOUT;
        if (r < IT_WGU) {
            const int e = r / 512, g = (r % 512) / 16, kb = r % 16;
            const float* Wg = (const float*)a.in[21] + ((size_t)l * NE + e) * D * FF;
            const float* Wu = (const float*)a.in[22] + ((size_t)l * NE + e) * D * FF;
            const float* sp = (rl < 16 ? Wg : Wu) + 16 * g + (rl & 15);
            tr_item(sp, FF, 1.f, (bf16_t*)(lw + LW_WGU) + (size_t)e * 1024 * D, D, 32 * g, 64 * kb, scr, lane);
            continue; }
        r -= IT_WGU;
        {
            const int e = r / 256, g = (r % 256) / 8, kb = r % 8;
            const float* W = (const float*)a.in[23] + ((size_t)l * NE + e) * FF * D;
            tr_item(W + 32 * g + rl, D, 1.f, (bf16_t*)(lw + LW_WDN) + (size_t)e * D * FF, FF, 32 * g, 64 * kb, scr, lane);
        }
    }
    for (int idx = gtid; idx < DEPTH * 256 * D; idx += NGT) {
        const int l = idx / (256 * D), j = (idx / D) % 256, k = idx % D;
        const float* W = (const float*)a.in[3] + (size_t)l * D * WIN_N + (size_t)k * WIN_N + 1536;
        const float* gu = (const float*)a.in[4] + (size_t)l * 16 * 256 + j;
        float s = 0.f;
#pragma unroll
        for (int r = 0; r < 16; ++r) s += W[r] * gu[r * 256];
        ((bf16_t*)(a.ws + WS_W + (size_t)l * LW_SIZE + LW_WIN))[(size_t)(C_GP + j) * D + k] = (bf16_t)f2bf(s);
    }
}

__device__ __forceinline__ void moe_tables(const unsigned* cnt, LAS int* pt, LAS int* lc, int tid) {
    if (tid == 0) { int s = 0;
        for (int e = 0; e < NE; ++e) { const int c = (int)__hip_atomic_load(cnt + e, __ATOMIC_RELAXED, __HIP_MEMORY_SCOPE_AGENT); pt[e] = s; lc[e] = c; s += (c + 255) >> 8; }
        pt[NE] = s; }
    __syncthreads();
}

template <bool COMBINE, bool NORM, bool SRC_OUT>
__device__ __forceinline__ void phase_norm1(const Ctx& c, const float* gain, LAS const int* pt) {
    const int gw = c.bid * NWAVES + c.wave, NGW = c.G * NWAVES, lane = c.lane;
    f32x4 g4[4];
    if (NORM) {
#pragma unroll
        for (int j = 0; j < 4; ++j) g4[j] = *((const f32x4*)gain + 64 * j + lane); }
    for (int tok = gw; tok < TC; tok += NGW) {
        const f32x4* xr = (const f32x4*)((SRC_OUT ? (const float*)c.xo : c.x_in) + (size_t)tok * D) + lane;
        f32x4 v[4];
#pragma unroll
        for (int j = 0; j < 4; ++j) v[j] = xr[64 * j];
        if (COMBINE) {
            const u32x4 rc = *(const u32x4*)(c.rec + (size_t)tok * 4);
            const int e0 = rc.x >> 20, e1 = rc.y >> 20;
            const size_t r0 = (size_t)pt[e0] * 256 + (rc.x & 0xfffffu), r1 = (size_t)pt[e1] * 256 + (rc.y & 0xfffffu);
            const float w0 = __uint_as_float(rc.z), w1 = __uint_as_float(rc.w);
            const u32x2* y0 = (const u32x2*)(c.ys + r0 * D) + lane; const u32x2* y1 = (const u32x2*)(c.ys + r1 * D) + lane;
#pragma unroll
            for (int j = 0; j < 4; ++j) { const u32x2 a = y0[64 * j], b = y1[64 * j];
                v[j].x += w0 * bflo(a.x) + w1 * bflo(b.x); v[j].y += w0 * bfhi(a.x) + w1 * bfhi(b.x);
                v[j].z += w0 * bflo(a.y) + w1 * bflo(b.y); v[j].w += w0 * bfhi(a.y) + w1 * bfhi(b.y); }
            f32x4* xw = (f32x4*)(c.xo + (size_t)tok * D) + lane;
#pragma unroll
            for (int j = 0; j < 4; ++j) xw[64 * j] = v[j];
        }
        if (NORM) {
            float ss = 0.f;
#pragma unroll
            for (int j = 0; j < 4; ++j) ss += (v[j].x * v[j].x + v[j].y * v[j].y) + (v[j].z * v[j].z + v[j].w * v[j].w);
            const float rs = rsqrtf(wave_sum(ss) * (1.f / D) + RMS_EPS);
            u32x2* o = (u32x2*)(c.act + (size_t)tok * D) + lane;
#pragma unroll
            for (int j = 0; j < 4; ++j) { u32x2 w; w.x = pk2(v[j].x * rs * g4[j].x, v[j].y * rs * g4[j].y); w.y = pk2(v[j].z * rs * g4[j].z, v[j].w * rs * g4[j].w); o[64 * j] = w; }
        }
    }
}

__constant__ double kInvFreq[16] = {1.0, 0.44036660267178046, 0.19392274474868576, 0.08539710028576561, 0.03760603093086393, 0.016560440080994446, 0.007292664737217109, 0.003211445994752591,
    0.001414213562373095, 0.000622772421914596, 0.0002742481756762073, 0.00012076973741146504, 5.318295896944988e-05, 2.341999896140934e-05, 1.031338537721246e-05, 4.5416704806078695e-06};
__device__ __forceinline__ void phase_qkrope(const Ctx& c, const float* qg, const float* kg) {
    const int gw = c.bid * NWAVES + c.wave, NGW = c.G * NWAVES, lane = c.lane;
    const float qg0 = qg[2 * lane], qg1 = qg[2 * lane + 1], kg0 = kg[2 * lane], kg1 = kg[2 * lane + 1];
    const int i0 = 2 * (lane & 7);
    const double f0 = kInvFreq[i0], f1 = kInvFreq[i0 + 1];
    const float sgn = (lane & 8) ? 1.f : -1.f;
    for (int tok = gw; tok < TC; tok += NGW) {
        const double p = (double)c.pos[tok];
        double a0 = p * f0 * 0.15915494309189535, a1 = p * f1 * 0.15915494309189535;
        a0 -= rint(a0); a1 -= rint(a1);
        const float c0 = __builtin_amdgcn_cosf((float)a0), s0 = __builtin_amdgcn_sinf((float)a0), c1 = __builtin_amdgcn_cosf((float)a1), s1 = __builtin_amdgcn_sinf((float)a1);
        bf16_t* row = c.proj + (size_t)tok * NP + C_QKV;
#pragma unroll 4
        for (int hr = 0; hr < 24; ++hr) {
            unsigned* pp = (unsigned*)(row + hr * 128) + lane;
            const unsigned u = *pp; const float v0 = bflo(u), v1 = bfhi(u);
            const float rs = rsqrtf(wave_sum(v0 * v0 + v1 * v1) * (1.f / 128.f) + RMS_EPS);
            float y0 = v0 * rs * (hr < 12 ? qg0 : kg0), y1 = v1 * rs * (hr < 12 ? qg1 : kg1);
            const float p0 = __shfl_xor(y0, 8), p1 = __shfl_xor(y1, 8);
            if (lane < 16) { y0 = y0 * c0 + sgn * p0 * s0; y1 = y1 * c1 + sgn * p1 * s1; }
            *pp = pk2(y0, y1);
        }
    }
}

__device__ __forceinline__ float logsigmoidf_(float g) { return fminf(g, 0.f) - log1pf(__expf(-fabsf(g))); }
__device__ __forceinline__ float gelu_tanh(float y) { const float u = 0.7978845608028654f * (y + 0.044715f * y * y * y); const float t = 1.f - 2.f / (1.f + __expf(2.f * u)); return 0.5f * y * (1.f + t); }

__device__ __forceinline__ void gla_simple(const Ctx& c, int b, const float* gbias, const float* ogain) {
    LAS float* sQ = (LAS float*)c.lds; LAS float* sK = sQ + 16 * 256; LAS float* sA = sK + 16 * 256; LAS float* sO = sA + 16 * 256; LAS float* sV = sO + 16 * 512;
    const int tid = c.tid, h = tid >> 7, lane = c.lane;
    float S[64];
#pragma unroll
    for (int i = 0; i < 64; ++i) S[i] = 0.f;
    const float og0 = ogain[2 * lane], og1 = ogain[2 * lane + 1];
    for (int tc = 0; tc < SEQ / 16; ++tc) {
        const size_t tok0 = (size_t)b * SEQ + tc * 16;
        __syncthreads();
        for (int idx = tid; idx < 16 * 256; idx += NTHR) { const int s = idx >> 8, ci = idx & 255; const bf16_t* row = c.proj + (tok0 + s) * NP;
            sQ[idx] = bf2f(row[C_QA + ci]); sK[idx] = bf2f(row[C_KA + ci]);
            sA[idx] = __expf(logsigmoidf_(bf2f(row[C_GP + ci]) + gbias[ci]) * (1.f / 16.f)); }
#pragma unroll
        for (int s = 0; s < 16; ++s) sV[s * 512 + tid] = bf2f(c.proj[(tok0 + s) * NP + C_VA + tid]);
        __syncthreads();
        for (int s = 0; s < 16; ++s) {
            const float v = sV[s * 512 + tid]; float o = 0.f;
            const LAS f32x4* a4 = (const LAS f32x4*)(sA + s * 256 + h * 64); const LAS f32x4* k4 = (const LAS f32x4*)(sK + s * 256 + h * 64); const LAS f32x4* q4 = (const LAS f32x4*)(sQ + s * 256 + h * 64);
#pragma unroll
            for (int d = 0; d < 16; ++d) { const f32x4 a = a4[d], k = k4[d], q = q4[d];
                S[4 * d + 0] = S[4 * d + 0] * a.x + k.x * v; o += q.x * S[4 * d + 0];
                S[4 * d + 1] = S[4 * d + 1] * a.y + k.y * v; o += q.y * S[4 * d + 1];
                S[4 * d + 2] = S[4 * d + 2] * a.z + k.z * v; o += q.z * S[4 * d + 2];
                S[4 * d + 3] = S[4 * d + 3] * a.w + k.w * v; o += q.w * S[4 * d + 3]; }
            sO[s * 512 + tid] = o;
        }
        __syncthreads();
#pragma unroll 2
        for (int k = 0; k < 8; ++k) { const int rr = c.wave * 8 + k, s = rr >> 2, hh = rr & 3;
            const float o0 = sO[s * 512 + hh * 128 + 2 * lane], o1 = sO[s * 512 + hh * 128 + 2 * lane + 1];
            const float rs = rsqrtf(wave_sum(o0 * o0 + o1 * o1) * (1.f / 128.f) + RMS_EPS);
            unsigned* pp = (unsigned*)(c.proj + (tok0 + s) * NP + C_OG + hh * 128) + lane;
            const unsigned u = *pp; const float g0 = bflo(u), g1 = bfhi(u);
            *pp = pk2(o0 * rs * og0 * g0 * sigmoidf_(g0), o1 * rs * og1 * g1 * sigmoidf_(g1)); }
    }
}

__device__ __forceinline__ void lru_simple(const Ctx& c, int b, const float* convw, const float* convb, const float* wa_, const float* ba_, const float* wx_, const float* bx_, const float* lam_) {
    const int ch = c.tid, n = c.wave, lane = c.lane;
    LAS float* sX = (LAS float*)(c.lds + n * 4096);
    const float* wap = wa_ + n * 4096 + lane; const float* wxp = wx_ + n * 4096 + lane;
    const float cw0 = convw[ch], cw1 = convw[512 + ch], cw2 = convw[1024 + ch], cw3 = convw[1536 + ch], cb = convb[ch], ba = ba_[ch], bx = bx_[ch];
    const float lam = lam_[ch]; const float c8 = 8.f * (fmaxf(-lam, 0.f) + log1pf(__expf(-fabsf(lam))));
    float xm1 = 0.f, xm2 = 0.f, xm3 = 0.f, hs = 0.f;
    for (int tc = 0; tc < SEQ / 16; ++tc) {
        const size_t tok0 = (size_t)b * SEQ + tc * 16;
        float xc[16], yv[16], ar[16], ai[16];
#pragma unroll
        for (int s = 0; s < 16; ++s) { xc[s] = bf2f(c.proj[(tok0 + s) * NP + C_XB + ch]); yv[s] = bf2f(c.proj[(tok0 + s) * NP + C_YB + ch]); }
#pragma unroll
        for (int s = 0; s < 16; ++s) { const float x = xc[s]; xc[s] = cb + cw0 * xm3 + cw1 * xm2 + cw2 * xm1 + cw3 * x; xm3 = xm2; xm2 = xm1; xm1 = x; sX[s * 64 + lane] = xc[s]; ar[s] = ba; ai[s] = bx; }
        LDS_WAIT(); asm volatile("" ::: "memory"); __builtin_amdgcn_wave_barrier();
#pragma unroll 2
        for (int k = 0; k < 64; ++k) { const float wa = wap[k * 64], wx = wxp[k * 64];
#pragma unroll
            for (int s = 0; s < 16; ++s) { const float x = sX[s * 64 + k]; ar[s] += x * wa; ai[s] += x * wx; } }
#pragma unroll
        for (int s = 0; s < 16; ++s) {
            const float r = sigmoidf_(ar[s]), ig = sigmoidf_(ai[s]);
            const float a = __expf(-c8 * r);
            const float u = sqrtf(fmaxf(1.f - a * a, 0.f)) * ig * xc[s];
            hs = a * hs + u;
            c.proj[(tok0 + s) * NP + C_YB + ch] = (bf16_t)f2bf(hs * gelu_tanh(yv[s]));
        }
        LDS_WAIT(); asm volatile("" ::: "memory"); __builtin_amdgcn_wave_barrier();
    }
}

__device__ __forceinline__ void attn_simple(const Ctx& c, int aw, int NAW) {
    const int lane = c.lane;
    for (int task = aw; task < TC * 4; task += NAW) {
        const int tok = task >> 2, h = task & 3, t = tok & (SEQ - 1);
        float ml = -INFINITY, wsum = 0.f, acc0 = 0.f, acc1 = 0.f;
#pragma unroll 1
        for (int p = 0; p < 3; ++p) {
            const int dsh = 2 * p, i = t >> dsh, nk = i + 1 < 129 ? i + 1 : 129;
            const bf16_t* qrow = c.proj + (size_t)tok * NP + C_QKV + (p * 4 + h) * 128;
            const int kcol = C_QKV + (12 + p * 4 + h) * 128, vcol = C_QKV + (24 + p * 4 + h) * 128;
            float sc[3];
#pragma unroll
            for (int r = 0; r < 3; ++r) {
                sc[r] = -INFINITY;
                if (64 * r < nk) {
                    const int m = 64 * r + lane; const bool valid = m < nk;
                    const bf16_t* krow = c.proj + (size_t)(tok - ((valid ? m : 0) << dsh)) * NP + kcol;
                    float s = 0.f;
#pragma unroll 1
                    for (int cb = 0; cb < 4; ++cb) {
                        u32x4 kq[4], qq[4];
#pragma unroll
                        for (int j = 0; j < 4; ++j) { kq[j] = *((const u32x4*)krow + cb * 4 + j); qq[j] = *((const u32x4*)qrow + cb * 4 + j); }
#pragma unroll
                        for (int j = 0; j < 4; ++j) {
                            s += bflo(kq[j].x) * bflo(qq[j].x) + bfhi(kq[j].x) * bfhi(qq[j].x) + bflo(kq[j].y) * bflo(qq[j].y) + bfhi(kq[j].y) * bfhi(qq[j].y)
                               + bflo(kq[j].z) * bflo(qq[j].z) + bfhi(kq[j].z) * bfhi(qq[j].z) + bflo(kq[j].w) * bflo(qq[j].w) + bfhi(kq[j].w) * bfhi(qq[j].w); }
                    }
                    sc[r] = valid ? s * 0.08838834764831845f : -INFINITY;
                }
            }
            const float mx = wave_max(fmaxf(sc[0], fmaxf(sc[1], sc[2])));
            float pr[3];
#pragma unroll
            for (int r = 0; r < 3; ++r) pr[r] = __expf(sc[r] - mx);
            const float den = wave_sum(pr[0] + pr[1] + pr[2]);
            float o0 = 0.f, o1 = 0.f;
#pragma unroll
            for (int r = 0; r < 3; ++r) {
                const int cnt = nk - 64 * r < 64 ? nk - 64 * r : 64;
                if (cnt > 0) {
                const unsigned* vb = (const unsigned*)(c.proj + (size_t)(tok - ((64 * r) << dsh)) * NP + vcol) + lane;
#pragma unroll 4
                for (int mm = 0; mm < cnt; ++mm) {
                    const float pm = __int_as_float(__builtin_amdgcn_readlane(__float_as_int(pr[r]), mm));
                    const unsigned u = *(const unsigned*)((const char*)vb - (size_t)(mm << dsh) * NP * 2);
                    o0 += pm * bflo(u); o1 += pm * bfhi(u); }
                }
            }
            const float inv = 1.f / den, lse = mx + __logf(den);
            const float nml = fmaxf(ml, lse), sc_old = __expf(ml - nml), w = __expf(lse - nml);
            acc0 = acc0 * sc_old + w * o0 * inv; acc1 = acc1 * sc_old + w * o1 * inv; wsum = wsum * sc_old + w; ml = nml;
        }
        const float wi = 1.f / wsum;
        unsigned* op = (unsigned*)(c.proj + (size_t)tok * NP + C_QKV + h * 128) + lane;
        *op = pk2(acc0 * wi, acc1 * wi);
    }
}

typedef unsigned short u16x4 __attribute__((ext_vector_type(4)));
__device__ __forceinline__ unsigned offb(unsigned row, unsigned ch) { return 256u * row + 16u * (ch ^ (((row & 3u) << 2) | ((row >> 2) & 3u))); }
constexpr int ATT_UNITS_PER_SEQ = 3 * 4 * 16;
__device__ __forceinline__ void attn_unit(const Ctx& c, int unit, float* lse_buf) {
    const int tid = c.tid, lane = c.lane, w = c.wave;
    const int b = unit / ATT_UNITS_PER_SEQ, rem = unit % ATT_UNITS_PER_SEQ, p = rem / 64, h = (rem / 16) & 3, qb = rem & 15;
    const int dsh = 2 * p, dil = 1 << dsh, nblk = 16 >> dsh;
    const int r = qb / nblk, blk = qb % nblk;
    const size_t tok0 = (size_t)b * SEQ + r;
    const int qcol = C_QKV + (p * 4 + h) * 128, kcol = C_QKV + (12 + p * 4 + h) * 128, vcol = C_QKV + (24 + p * 4 + h) * 128;
    LAS unsigned char* sK = c.lds; LAS unsigned char* sV = c.lds + 65536;
    {
#pragma unroll
        for (int it = 0; it < 8; ++it) { const int q = w + 8 * it; const unsigned n = 64u * q + lane, row = n >> 4, cs = n & 15u, ch = cs ^ (((row & 3u) << 2) | ((row >> 2) & 3u));
            int srow = (blk - 1) * 128 + (int)row; if (srow < 0) srow += 128;
            const bf16_t* g = c.proj + (tok0 + ((size_t)srow << dsh)) * NP + kcol + ch * 8;
            __builtin_amdgcn_global_load_lds((const unsigned*)g, (LAS unsigned*)(sK + 1024 * q), 16, 0, 0); }
#pragma unroll
        for (int it = 0; it < 8; ++it) { const int q = w + 8 * it; const unsigned n = 64u * q + lane, row = n >> 4, cs = n & 15u, ch = cs ^ (((row & 3u) << 2) | ((row >> 2) & 3u));
            int srow = (blk - 1) * 128 + (int)row; if (srow < 0) srow += 128;
            const bf16_t* g = c.proj + (tok0 + ((size_t)srow << dsh)) * NP + vcol + ch * 8;
            __builtin_amdgcn_global_load_lds((const unsigned*)g, (LAS unsigned*)(sV + 1024 * q), 16, 0, 0); }
    }
    const int qq = lane & 15, g = lane >> 4, qi = 16 * w + qq;
    const size_t qtok = tok0 + ((size_t)(blk * 128 + qi) << dsh);
    bf16x8 qf[4];
#pragma unroll
    for (int s = 0; s < 4; ++s) qf[s] = *(const bf16x8*)(c.proj + qtok * NP + qcol + 32 * s + 8 * g);
    asm volatile("s_waitcnt vmcnt(0)" ::: "memory");
    __syncthreads();
    const int ks0 = w >> 1;
    f32x4 st[5][2];
    const unsigned krow_l = 8u * (qq >> 2) + (qq & 3u);
#pragma unroll
    for (int n = 0; n < 5; ++n)
#pragma unroll
        for (int T = 0; T < 2; ++T) { f32x4 a = {0.f, 0.f, 0.f, 0.f}; const unsigned key = 32u * (ks0 + n) + krow_l + 4u * T;
#pragma unroll
            for (int s = 0; s < 4; ++s) { const bf16x8 kf = *(const LAS bf16x8*)(sK + offb(key, 4 * s + g)); a = __builtin_amdgcn_mfma_f32_16x16x32_bf16(kf, qf[s], a, 0, 0, 0); }
            st[n][T] = a; }
    const float SC = 0.08838834764831845f * 1.4426950408889634f;
    float mx = -INFINITY;
#pragma unroll
    for (int n = 0; n < 5; ++n)
#pragma unroll
        for (int T = 0; T < 2; ++T)
#pragma unroll
            for (int i = 0; i < 4; ++i) { const int kj = 32 * (ks0 + n) + 8 * g + 4 * T + i; const bool ok = (kj >= qi) && (kj <= qi + 128) && (blk > 0 || kj >= 128);
                const float v = ok ? st[n][T][i] : -INFINITY; st[n][T][i] = v; mx = fmaxf(mx, v); }
    mx = fmaxf(mx, swz_xor<16>(mx));
    { const auto rr = __builtin_amdgcn_permlane32_swap(__float_as_uint(mx), __float_as_uint(mx), false, false); mx = fmaxf(__uint_as_float(rr[0]), __uint_as_float(rr[1])); }
    float sum = 0.f;
#pragma unroll
    for (int n = 0; n < 5; ++n)
#pragma unroll
        for (int T = 0; T < 2; ++T)
#pragma unroll
            for (int i = 0; i < 4; ++i) { const float e = __builtin_amdgcn_exp2f((st[n][T][i] - mx) * SC); st[n][T][i] = e; sum += e; }
    sum += swz_xor<16>(sum);
    { const auto rr = __builtin_amdgcn_permlane32_swap(__float_as_uint(sum), __float_as_uint(sum), false, false); sum = __uint_as_float(rr[0]) + __uint_as_float(rr[1]); }
    const float inv = 1.f / sum;
    f32x4 ot[8];
#pragma unroll
    for (int cc = 0; cc < 8; ++cc) ot[cc] = (f32x4){0.f, 0.f, 0.f, 0.f};
    const unsigned tq = (unsigned)qq >> 2, tp = (unsigned)qq & 3u;
    const unsigned vbase = (unsigned)(size_t)sV;
#pragma unroll
    for (int n = 0; n < 5; ++n) {
        u32x4 pw; pw.x = pg8::cvt_pk_bf16(st[n][0][0], st[n][0][1]); pw.y = pg8::cvt_pk_bf16(st[n][0][2], st[n][0][3]); pw.z = pg8::cvt_pk_bf16(st[n][1][0], st[n][1][1]); pw.w = pg8::cvt_pk_bf16(st[n][1][2], st[n][1][3]);
        const bf16x8 pf = __builtin_bit_cast(bf16x8, pw);
#pragma unroll
        for (int cc = 0; cc < 8; ++cc) {
            const unsigned a0 = vbase + offb(32u * (ks0 + n) + 8u * g + tq, 2 * cc + (tp >> 1)) + 8u * (tp & 1u);
            const unsigned a1 = vbase + offb(32u * (ks0 + n) + 8u * g + 4u + tq, 2 * cc + (tp >> 1)) + 8u * (tp & 1u);
            u16x4 v0, v1;
            asm volatile("ds_read_b64_tr_b16 %0, %2\n\tds_read_b64_tr_b16 %1, %3\n\ts_waitcnt lgkmcnt(0)" : "=&v"(v0), "=&v"(v1) : "v"(a0), "v"(a1) : "memory");
            bf16x8 vf; vf[0] = (short)v0[0]; vf[1] = (short)v0[1]; vf[2] = (short)v0[2]; vf[3] = (short)v0[3]; vf[4] = (short)v1[0]; vf[5] = (short)v1[1]; vf[6] = (short)v1[2]; vf[7] = (short)v1[3];
            ot[cc] = __builtin_amdgcn_mfma_f32_16x16x32_bf16(vf, pf, ot[cc], 0, 0, 0);
        }
    }
    bf16_t* orow = c.proj + qtok * NP + qcol;
#pragma unroll
    for (int cc = 0; cc < 8; ++cc) { u32x2 o; o.x = pg8::cvt_pk_bf16(ot[cc][0] * inv, ot[cc][1] * inv); o.y = pg8::cvt_pk_bf16(ot[cc][2] * inv, ot[cc][3] * inv); *(u32x2*)(orow + 16 * cc + 4 * g) = o; }
    if (g == 0) lse_buf[qtok * 12 + p * 4 + h] = mx * 0.08838834764831845f + __logf(sum);
    __syncthreads();
}

__device__ __forceinline__ void phase_attn_combine(const Ctx& c, const float* lse_buf) {
    const int gw = c.bid * NWAVES + c.wave, NGW = c.G * NWAVES, lane = c.lane;
    for (int tok = gw; tok < TC; tok += NGW) {
        const float* ls = lse_buf + (size_t)tok * 12;
        bf16_t* row = c.proj + (size_t)tok * NP + C_QKV;
#pragma unroll
        for (int h = 0; h < 4; ++h) {
            const float l0 = ls[h], l1 = ls[4 + h], l2 = ls[8 + h], ml = fmaxf(l0, fmaxf(l1, l2));
            const float w0 = __expf(l0 - ml), w1 = __expf(l1 - ml), w2 = __expf(l2 - ml), wi = 1.f / (w0 + w1 + w2);
            unsigned* p0 = (unsigned*)(row + h * 128) + lane;
            const unsigned u0 = *p0, u1 = *((const unsigned*)(row + (4 + h) * 128) + lane), u2 = *((const unsigned*)(row + (8 + h) * 128) + lane);
            *p0 = pk2((w0 * bflo(u0) + w1 * bflo(u1) + w2 * bflo(u2)) * wi, (w0 * bfhi(u0) + w1 * bfhi(u1) + w2 * bfhi(u2)) * wi);
        }
    }
}

__device__ __forceinline__ int crow(int reg, int hh) { return (reg & 3) + 8 * (reg >> 2) + 4 * hh; }
typedef float f32x16 __attribute__((ext_vector_type(16)));
__device__ __forceinline__ unsigned tr_addr32(unsigned lane, unsigned rowbase, unsigned cblk, unsigned t, bool perm) {
    const unsigned hh = lane >> 5, blk = (lane >> 4) & 1u, q = (lane & 15u) >> 2, p = lane & 3u;
    const unsigned row = rowbase + (perm ? 8u * t + 4u * hh : 8u * hh + 4u * t) + q;
    return offb(row, 4u * cblk + 2u * blk + (p >> 1)) + 8u * (p & 1u);
}
__device__ __forceinline__ bf16x8 tr_frag(unsigned a0, unsigned a1) {
    u16x4 v0, v1;
    asm volatile("ds_read_b64_tr_b16 %0, %2\n\tds_read_b64_tr_b16 %1, %3\n\ts_waitcnt lgkmcnt(0)" : "=&v"(v0), "=&v"(v1) : "v"(a0), "v"(a1) : "memory");
    bf16x8 f; f[0] = (short)v0[0]; f[1] = (short)v0[1]; f[2] = (short)v0[2]; f[3] = (short)v0[3]; f[4] = (short)v1[0]; f[5] = (short)v1[1]; f[6] = (short)v1[2]; f[7] = (short)v1[3];
    return f;
}
constexpr int GLA_QK = 0, GLA_KD = 16384, GLA_V = 32768, GLA_ST = 49152  , GLA_O = 86016  , GLA_SEG = 119808  , GLA_DEC = 121856  ;
static_assert(GLA_DEC + 256 <= RING_BYTES, "gla lds");
__device__ __forceinline__ void gla_unit(const Ctx& c, int unit, const float* gbias, const float* ogain) {
    const int tid = c.tid, lane = c.lane, w = c.wave;
    const int b = unit >> 2, h = unit & 3;
    LAS unsigned char* L = c.lds;
    const unsigned hh = lane >> 5, r31 = lane & 31;
    const int ti = w >> 2, tv = w & 3;
    f32x16 St;
#pragma unroll
    for (int i = 0; i < 16; ++i) St[i] = 0.f;
    for (int i = tid; i < 18432 / 4; i += NTHR) ((LAS unsigned*)(L + GLA_ST))[i] = 0u;
    const float bias_d = gbias[h * 64 + lane];
    const int i3 = tid >> 3, seg = tid & 7;
    float gn[16];
#pragma unroll
    for (int k = 0; k < 16; ++k) gn[k] = ogain[16 * seg + k];
    const size_t tokb = (size_t)b * SEQ;
    unsigned short pq[8], pk[8], pg[8];
#define GLA_PREFETCH(n) do { _Pragma("unroll") for (int rr = 0; rr < 8; ++rr) { const bf16_t* row = c.proj + (tokb + (n) * 64 + 8 * w + rr) * NP + h * 64 + lane; \
        pq[rr] = row[C_QA]; pk[rr] = row[C_KA]; pg[rr] = row[C_GP]; } } while (0)
#define GLA_VDMA(n) do { _Pragma("unroll") for (int it = 0; it < 2; ++it) { const int q = w + 8 * it; const unsigned nn = 64u * q + lane, row = nn >> 4, cs = nn & 15u, ch = cs ^ (((row & 3u) << 2) | ((row >> 2) & 3u)); \
        __builtin_amdgcn_global_load_lds((const unsigned*)(c.proj + (tokb + (n) * 64 + row) * NP + C_VA + h * 128 + ch * 8), (LAS unsigned*)(L + GLA_V + 1024 * q), 16, 0, 0); } } while (0)
    GLA_PREFETCH(0);
    GLA_VDMA(0);
    for (int n = 0; n < SEQ / 64; ++n) {
        LAS unsigned char* STr = L + GLA_ST + (n & 1) * 18432; LAS unsigned char* STw = L + GLA_ST + ((n + 1) & 1) * 18432;
        float cl[8], qv[8], kv[8];
        { float run = 0.f;
#pragma unroll
          for (int rr = 0; rr < 8; ++rr) { const float g = bf2f(pg[rr]) + bias_d; run += (fminf(g, 0.f) - log1pf(__expf(-fabsf(g)))) * (1.f / 16.f); cl[rr] = run; qv[rr] = bf2f(pq[rr]); kv[rr] = bf2f(pk[rr]); }
          ((LAS float*)(L + GLA_SEG))[w * 64 + lane] = run; }
        __syncthreads();
        { float pre = 0.f, tot = 0.f;
#pragma unroll
          for (int s = 0; s < 8; ++s) { const float v = ((LAS float*)(L + GLA_SEG))[s * 64 + lane]; tot += v; pre += (s < w) ? v : 0.f; }
          if (w == 0) ((LAS float*)(L + GLA_DEC))[lane] = __expf(tot);
#pragma unroll
          for (int rr = 0; rr < 8; ++rr) { const float cum = pre + cl[rr]; const unsigned row = 8 * w + rr;
              const float e = __expf(cum), ei = __expf(-cum), ed = __expf(tot - cum);
              const unsigned o1 = offb(row, lane >> 3) + (lane & 7) * 2, o2 = offb(row, 8 + (lane >> 3)) + (lane & 7) * 2;
              *(LAS unsigned short*)(L + GLA_QK + o1) = (unsigned short)f2bf(qv[rr] * e);
              *(LAS unsigned short*)(L + GLA_QK + o2) = (unsigned short)f2bf(kv[rr] * ei);
              *(LAS unsigned short*)(L + GLA_KD + o1) = (unsigned short)f2bf(kv[rr] * ed); } }
        asm volatile("s_waitcnt vmcnt(0)" ::: "memory");
        __syncthreads();
        const bf16_t* ogp = c.proj + (tokb + n * 64 + i3) * NP + C_OG + h * 128 + 16 * seg;
        const u32x4 og0 = *(const u32x4*)ogp, og1 = *((const u32x4*)ogp + 1);
        if (n + 1 < SEQ / 64) GLA_PREFETCH(n + 1);
        bf16x8 qdf[4];
#pragma unroll
        for (int s = 0; s < 4; ++s) qdf[s] = *(const LAS bf16x8*)(L + GLA_QK + offb(32 * ti + r31, 2 * s + hh));
        f32x16 Z;
#pragma unroll
        for (int i = 0; i < 16; ++i) Z[i] = 0.f;
#pragma unroll
        for (int s = 0; s < 4; ++s) { const bf16x8 sf = *(const LAS bf16x8*)(STr + (32 * tv + r31) * 144 + 32 * s + 16 * hh); Z = __builtin_amdgcn_mfma_f32_32x32x16_bf16(qdf[s], sf, Z, 0, 0, 0); }
#pragma unroll
        for (int tj = 0; tj < 2; ++tj) {
            if (tj <= ti) {
                f32x16 X;
#pragma unroll
                for (int i = 0; i < 16; ++i) X[i] = 0.f;
#pragma unroll
                for (int s = 0; s < 4; ++s) { const bf16x8 kf = *(const LAS bf16x8*)(L + GLA_QK + offb(32 * tj + r31, 8 + 2 * s + hh)); X = __builtin_amdgcn_mfma_f32_32x32x16_bf16(kf, qdf[s], X, 0, 0, 0); }
                const int ig = 32 * ti + (int)r31;
#pragma unroll
                for (int i = 0; i < 16; ++i) X[i] = (ig >= 32 * tj + crow(i, hh)) ? X[i] : 0.f;
#pragma unroll
                for (int s = 0; s < 2; ++s) {
                    u32x4 pw; pw.x = pg8::cvt_pk_bf16(X[8 * s + 0], X[8 * s + 1]); pw.y = pg8::cvt_pk_bf16(X[8 * s + 2], X[8 * s + 3]); pw.z = pg8::cvt_pk_bf16(X[8 * s + 4], X[8 * s + 5]); pw.w = pg8::cvt_pk_bf16(X[8 * s + 6], X[8 * s + 7]);
                    const unsigned vb = (unsigned)(size_t)(L + GLA_V);
                    const bf16x8 vf = tr_frag(vb + tr_addr32(lane, 32 * tj + 16 * s, tv, 0, true), vb + tr_addr32(lane, 32 * tj + 16 * s, tv, 1, true));
                    Z = __builtin_amdgcn_mfma_f32_32x32x16_bf16(__builtin_bit_cast(bf16x8, pw), vf, Z, 0, 0, 0);
                }
            }
        }
#pragma unroll
        for (int i = 0; i < 16; ++i) ((LAS float*)(L + GLA_O))[(32 * ti + crow(i, hh)) * 132 + 32 * tv + r31] = Z[i];
#pragma unroll
        for (int i = 0; i < 16; ++i) St[i] *= ((LAS float*)(L + GLA_DEC))[32 * ti + crow(i, hh)];
#pragma unroll
        for (int s = 0; s < 4; ++s) { const unsigned kb = (unsigned)(size_t)(L + GLA_KD), vb = (unsigned)(size_t)(L + GLA_V);
            const bf16x8 af = tr_frag(kb + tr_addr32(lane, 16 * s, ti, 0, false), kb + tr_addr32(lane, 16 * s, ti, 1, false));
            const bf16x8 bf = tr_frag(vb + tr_addr32(lane, 16 * s, tv, 0, false), vb + tr_addr32(lane, 16 * s, tv, 1, false));
            St = __builtin_amdgcn_mfma_f32_32x32x16_bf16(af, bf, St, 0, 0, 0); }
#pragma unroll
        for (int gq = 0; gq < 4; ++gq) { const float s0 = St[4 * gq], s1 = St[4 * gq + 1], s2 = St[4 * gq + 2], s3 = St[4 * gq + 3];
            u32x2 o; o.x = pk2(s0, s1); o.y = pk2(s2, s3);
            *(LAS u32x2*)(STw + (32 * tv + r31) * 144 + (32 * ti + 8 * gq + 4 * hh) * 2) = o; }
        __syncthreads();
        if (n + 1 < SEQ / 64) GLA_VDMA(n + 1);
        { const LAS f32x4* op = (const LAS f32x4*)(L + GLA_O + i3 * 528 + seg * 64);
          f32x4 o4[4]; float ss = 0.f;
#pragma unroll
          for (int k = 0; k < 4; ++k) { o4[k] = op[k]; ss += (o4[k].x * o4[k].x + o4[k].y * o4[k].y) + (o4[k].z * o4[k].z + o4[k].w * o4[k].w); }
          ss += swz_xor<1>(ss); ss += swz_xor<2>(ss); ss += swz_xor<4>(ss);
          const float rs = rsqrtf(ss * (1.f / 128.f) + RMS_EPS);
          const unsigned ogw[8] = {og0.x, og0.y, og0.z, og0.w, og1.x, og1.y, og1.z, og1.w};
          unsigned ow[8];
#pragma unroll
          for (int k = 0; k < 8; ++k) { const float g0 = bflo(ogw[k]), g1 = bfhi(ogw[k]);
              const float a0 = o4[k >> 1][(2 * k) & 3] * rs * gn[2 * k] * g0 * sigmoidf_(g0), a1 = o4[k >> 1][(2 * k + 1) & 3] * rs * gn[2 * k + 1] * g1 * sigmoidf_(g1);
              ow[k] = pk2(a0, a1); }
          u32x4 w0, w1; w0.x = ow[0]; w0.y = ow[1]; w0.z = ow[2]; w0.w = ow[3]; w1.x = ow[4]; w1.y = ow[5]; w1.z = ow[6]; w1.w = ow[7];
          bf16_t* dst = c.proj + (tokb + n * 64 + i3) * NP + C_OG + h * 128 + 16 * seg;
          *(u32x4*)dst = w0; *((u32x4*)dst + 1) = w1; }
    }
    asm volatile("s_waitcnt vmcnt(0)" ::: "memory");
    __syncthreads();
#undef GLA_PREFETCH
#undef GLA_VDMA
}

constexpr int LRU_X = 0  , LRU_R = 16384  , LRU_I = 32768, LRU_SP = 49152  , LRU_SH = 51200;
__device__ __forceinline__ void lru_unit(const Ctx& c, int unit, const float* convw, const float* convb, const float* wa_, const float* ba_, const float* wx_, const float* bx_, const float* lam_) {
    const int lane = c.lane, w = c.wave;
    const int b = unit >> 3, nb = unit & 7, ch = nb * 64 + lane;
    LAS unsigned char* L = c.lds;
    const unsigned hh = lane >> 5, r31 = lane & 31;
    const int gate = w >> 2, tt = (w >> 1) & 1, td = w & 1;
    bf16x8 wf[4];
    { const float* W = (gate ? wx_ : wa_) + (size_t)nb * 4096 + 32 * td + r31;
#pragma unroll
      for (int s = 0; s < 4; ++s) { float t8[8];
#pragma unroll
          for (int jj = 0; jj < 8; ++jj) t8[jj] = W[(16 * s + 8 * hh + jj) * 64];
          u32x4 pw; pw.x = pk2(t8[0], t8[1]); pw.y = pk2(t8[2], t8[3]); pw.z = pk2(t8[4], t8[5]); pw.w = pk2(t8[6], t8[7]); wf[s] = __builtin_bit_cast(bf16x8, pw); } }
    const float gbias = (gate ? bx_ : ba_)[nb * 64 + 32 * td + r31];
    const float cw0 = convw[ch], cw1 = convw[512 + ch], cw2 = convw[1024 + ch], cw3 = convw[1536 + ch], cb = convb[ch];
    const float lam = lam_[ch]; const float c8 = 8.f * (fmaxf(-lam, 0.f) + log1pf(__expf(-fabsf(lam))));
    const size_t tokb = (size_t)b * SEQ;
    unsigned short px[11], py[8];
#define LRU_PREFETCH(n) do { _Pragma("unroll") for (int rr = 0; rr < 11; ++rr) { const int t = (n) * 64 + 8 * w + rr - 3; px[rr] = t >= 0 ? c.proj[(tokb + t) * NP + C_XB + ch] : (unsigned short)0; } \
        _Pragma("unroll") for (int rr = 0; rr < 8; ++rr) py[rr] = c.proj[(tokb + (n) * 64 + 8 * w + rr) * NP + C_YB + ch]; } while (0)
    LRU_PREFETCH(0);
    float hcarry = 0.f;
    for (int n = 0; n < SEQ / 64; ++n) {
        float xc[8], yv[8];
        { float xr[11];
#pragma unroll
          for (int rr = 0; rr < 11; ++rr) xr[rr] = bf2f(px[rr]);
#pragma unroll
          for (int rr = 0; rr < 8; ++rr) { xc[rr] = cb + cw0 * xr[rr] + cw1 * xr[rr + 1] + cw2 * xr[rr + 2] + cw3 * xr[rr + 3]; yv[rr] = bf2f(py[rr]);
              *(LAS unsigned short*)(L + LRU_X + offb(8 * w + rr, lane >> 3) + (lane & 7) * 2) = (unsigned short)f2bf(xc[rr]); } }
        __syncthreads();
        if (n + 1 < SEQ / 64) LRU_PREFETCH(n + 1);
        { f32x16 Z;
#pragma unroll
          for (int i = 0; i < 16; ++i) Z[i] = 0.f;
#pragma unroll
          for (int s = 0; s < 4; ++s) { const bf16x8 af = *(const LAS bf16x8*)(L + LRU_X + offb(32 * tt + r31, 2 * s + hh)); Z = __builtin_amdgcn_mfma_f32_32x32x16_bf16(af, wf[s], Z, 0, 0, 0); }
          LAS float* dst = (LAS float*)(L + (gate ? LRU_I : LRU_R));
#pragma unroll
          for (int i = 0; i < 16; ++i) dst[(32 * tt + crow(i, hh)) * 64 + 32 * td + r31] = sigmoidf_(Z[i] + gbias); }
        __syncthreads();
        float hl[8], pc[8];
        { float hrun = 0.f, prun = 1.f;
#pragma unroll
          for (int rr = 0; rr < 8; ++rr) { const float r = ((const LAS float*)(L + LRU_R))[(8 * w + rr) * 64 + lane], ig = ((const LAS float*)(L + LRU_I))[(8 * w + rr) * 64 + lane];
              const float a = __expf(-c8 * r), u = sqrtf(fmaxf(1.f - a * a, 0.f)) * ig * xc[rr];
              hrun = a * hrun + u; prun *= a; hl[rr] = hrun; pc[rr] = prun; }
          ((LAS float*)(L + LRU_SP))[w * 64 + lane] = prun; ((LAS float*)(L + LRU_SH))[w * 64 + lane] = hrun; }
        __syncthreads();
        { float hin = hcarry, hall = hcarry;
#pragma unroll
          for (int s = 0; s < 8; ++s) { const float P = ((const LAS float*)(L + LRU_SP))[s * 64 + lane], H = ((const LAS float*)(L + LRU_SH))[s * 64 + lane];
              hall = P * hall + H; hin = (s < w) ? hall : hin; }
          hcarry = hall;
#pragma unroll
          for (int rr = 0; rr < 8; ++rr) { const float hv = hl[rr] + pc[rr] * hin;
              c.proj[(tokb + n * 64 + 8 * w + rr) * NP + C_YB + ch] = (bf16_t)f2bf(hv * gelu_tanh(yv[rr])); } }
    }
    __syncthreads();
#undef LRU_PREFETCH
}

constexpr int TPB = TC / 256;
__device__ __forceinline__ void phase_router(const Ctx& c, const float* gain, const float* rw, const float* rb, unsigned* gcnt) {
    LAS float* sRW = (LAS float*)c.lds;
    LAS unsigned* sRec = (LAS unsigned*)(c.lds + 65536);
    LAS unsigned* sCnt = (LAS unsigned*)(c.lds + MISC_OFF + 256);
    LAS unsigned* sBase = sCnt + 16;
    const int tid = c.tid, lane = c.lane;
    for (int idx = tid; idx < D * NE; idx += NTHR) sRW[(idx & 15) * D + (idx >> 4)] = rw[idx];
    if (tid < 16) sCnt[tid] = 0u;
    f32x4 g4[4];
#pragma unroll
    for (int j = 0; j < 4; ++j) g4[j] = *((const f32x4*)gain + 64 * j + lane);
    float rbv[16];
#pragma unroll
    for (int e = 0; e < 16; ++e) rbv[e] = rb[e];
    __syncthreads();
    for (int lt = c.wave; lt < TPB; lt += NWAVES) {
        const int tok = c.bid * TPB + lt;
        const f32x4* xr = (const f32x4*)(c.xo + (size_t)tok * D) + lane;
        f32x4 v[4]; float ss = 0.f;
#pragma unroll
        for (int j = 0; j < 4; ++j) { v[j] = xr[64 * j]; ss += (v[j].x * v[j].x + v[j].y * v[j].y) + (v[j].z * v[j].z + v[j].w * v[j].w); }
        const float rs = rsqrtf(wave_sum(ss) * (1.f / D) + RMS_EPS);
        u32x2* o = (u32x2*)(c.act + (size_t)tok * D) + lane;
#pragma unroll
        for (int j = 0; j < 4; ++j) { v[j] = v[j] * rs * g4[j]; u32x2 w; w.x = pk2(v[j].x, v[j].y); w.y = pk2(v[j].z, v[j].w); o[64 * j] = w; }
        float sc[16]; float mx = -INFINITY;
#pragma unroll
        for (int e = 0; e < 16; ++e) { float p = 0.f;
#pragma unroll
            for (int j = 0; j < 4; ++j) { const f32x4 w = *((const LAS f32x4*)(sRW + e * D) + 64 * j + lane); p += (v[j].x * w.x + v[j].y * w.y) + (v[j].z * w.z + v[j].w * w.w); }
            sc[e] = wave_sum(p) + rbv[e]; mx = fmaxf(mx, sc[e]); }
        float sum = 0.f;
#pragma unroll
        for (int e = 0; e < 16; ++e) { sc[e] = __expf(sc[e] - mx); sum += sc[e]; }
        const float isum = 1.f / sum;
#pragma unroll
        for (int e = 0; e < 16; ++e) sc[e] *= isum;
        int gsel = 0; float gbest = -1.f;
#pragma unroll
        for (int g = 0; g < 4; ++g) { const float a = sc[4 * g], b = sc[4 * g + 1], cc = sc[4 * g + 2], d = sc[4 * g + 3];
            const float hi1 = fmaxf(a, b), lo1 = fminf(a, b), hi2 = fmaxf(cc, d), lo2 = fminf(cc, d);
            const float top = fmaxf(hi1, hi2), second = fmaxf(fminf(hi1, hi2), fmaxf(lo1, lo2));
            const float gs = top + second; if (gs > gbest) { gbest = gs; gsel = g; } }
        float s4[4];
#pragma unroll
        for (int k = 0; k < 4; ++k) s4[k] = gsel == 0 ? sc[k] : gsel == 1 ? sc[4 + k] : gsel == 2 ? sc[8 + k] : sc[12 + k];
        int i0 = 0; float b0 = s4[0];
#pragma unroll
        for (int k = 1; k < 4; ++k) if (s4[k] > b0) { b0 = s4[k]; i0 = k; }
        int i1 = -1; float b1 = -1.f;
#pragma unroll
        for (int k = 0; k < 4; ++k) if (k != i0 && s4[k] > b1) { b1 = s4[k]; i1 = k; }
        const int e0 = 4 * gsel + i0, e1 = 4 * gsel + i1; const float wn = 1.f / (b0 + b1);
        if (lane == 0) { const unsigned l0 = atomicAdd((unsigned*)&sCnt[e0], 1u), l1 = atomicAdd((unsigned*)&sCnt[e1], 1u);
            sRec[lt * 6 + 0] = (unsigned)e0; sRec[lt * 6 + 1] = l0; sRec[lt * 6 + 2] = (unsigned)e1; sRec[lt * 6 + 3] = l1; sRec[lt * 6 + 4] = __float_as_uint(b0 * wn); sRec[lt * 6 + 5] = __float_as_uint(b1 * wn); }
    }
    __syncthreads();
    if (tid < 16) sBase[tid] = __hip_atomic_fetch_add(gcnt + tid, sCnt[tid], __ATOMIC_RELAXED, __HIP_MEMORY_SCOPE_AGENT);
    __syncthreads();
    if (tid < TPB) { const int tok = c.bid * TPB + tid; const unsigned e0 = sRec[tid * 6], e1 = sRec[tid * 6 + 2];
        const unsigned p0 = sBase[e0] + sRec[tid * 6 + 1], p1 = sBase[e1] + sRec[tid * 6 + 3];
        u32x4 r; r.x = (e0 << 20) | p0; r.y = (e1 << 20) | p1; r.z = sRec[tid * 6 + 4]; r.w = sRec[tid * 6 + 5];
        *(u32x4*)(c.rec + (size_t)tok * 4) = r;
        c.list[(size_t)e0 * TC + p0] = tok; c.list[(size_t)e1 * TC + p1] = tok; }
}

struct PlainOrder {
    int nM, nN, G, c; const char* A; const char* Bt; size_t a_tile, b_tile;
    __device__ __forceinline__ bool next(int i, pg8::Unit& u) const { u.g = 0; return pg8::static_tile(nM, nN, G, c, i, u.pm, u.pn); }
    __device__ __forceinline__ const char* aptr(const pg8::Unit& u) const { return A + (size_t)u.pm * a_tile; }
    __device__ __forceinline__ const char* bptr(const pg8::Unit& u) const { return Bt + (size_t)u.pn * b_tile; }
    __device__ __forceinline__ unsigned arow(const pg8::Unit&, int) const { return 0u; }
};
struct MergeOrder {
    int G, c; const char* proj; const char* wbr;
    __device__ __forceinline__ bool next(int i, pg8::Unit& u) const { u.g = i % 3; return pg8::static_tile(TC / 256, 4, G, c, i / 3, u.pm, u.pn); }
    __device__ __forceinline__ const char* aptr(const pg8::Unit& u) const { const int col = u.g == 0 ? C_OG : (u.g == 1 ? C_YB : C_QKV); return proj + ((size_t)u.pm * 256 * NP + col) * 2; }
    __device__ __forceinline__ const char* bptr(const pg8::Unit& u) const { return wbr + ((size_t)u.g * D * 512 + (size_t)u.pn * 256 * 512) * 2; }
    __device__ __forceinline__ unsigned arow(const pg8::Unit&, int) const { return 0u; }
};
template <bool UP> struct MoeOrder {
    int G, c; LAS const int* pt; LAS const int* lc; const char* A; const char* W; const int* list;
    __device__ __forceinline__ bool next(int i, pg8::Unit& u) const { const int L = i * G + c, tau = L >> 2; if (tau >= pt[NE]) return false;
        int e = 0;
#pragma unroll
        for (int k = 1; k < NE; ++k) e += (tau >= pt[k]) ? 1 : 0;
        u.pm = tau; u.pn = L & 3; u.g = e; return true; }
    __device__ __forceinline__ const char* aptr(const pg8::Unit& u) const { return UP ? A : A + (size_t)u.pm * 256 * FF * 2; }
    __device__ __forceinline__ const char* bptr(const pg8::Unit& u) const { return UP ? W + ((size_t)u.g * 1024 * D + (size_t)u.pn * 256 * D) * 2 : W + ((size_t)u.g * D * FF + (size_t)u.pn * 256 * FF) * 2; }
    __device__ __forceinline__ unsigned arow(const pg8::Unit& u, int r) const { int p = (u.pm - pt[u.g]) * 256 + r; const int n = lc[u.g]; p = p < n ? p : n - 1;
        return (unsigned)list[(size_t)u.g * TC + p] * (unsigned)(D * 2); }
};

struct EpiStoreBf16 {
    static constexpr bool PERM = true;
    bf16_t* O; int ldc;
    __device__ __forceinline__ void operator()(const f32x4 (&acc)[2][2][4][2], const pg8::Unit& u, int wr, int wc, int fr, int fq) const {
        const int row0 = u.pm * 256 + wr * 64 + fr, col0 = u.pn * 256 + wc * 32 + 8 * fq;
#pragma unroll
        for (int ai = 0; ai < 2; ++ai)
#pragma unroll
            for (int m = 0; m < 4; ++m) { bf16_t* rowp = O + (size_t)(row0 + ai * 128 + m * 16) * ldc + col0;
#pragma unroll
                for (int bj = 0; bj < 2; ++bj) { const f32x4 v0 = acc[ai][bj][m][0], v1 = acc[ai][bj][m][1];
                    u32x4 w; w.x = pg8::cvt_pk_bf16(v0[0], v0[1]); w.y = pg8::cvt_pk_bf16(v0[2], v0[3]); w.z = pg8::cvt_pk_bf16(v1[0], v1[1]); w.w = pg8::cvt_pk_bf16(v1[2], v1[3]);
                    *(u32x4*)(rowp + bj * 128) = w; } }
    }
};
struct EpiMerge {
    static constexpr bool PERM = true;
    const bf16_t* proj; bf16_t* mg;
    __device__ __forceinline__ void operator()(const f32x4 (&acc)[2][2][4][2], const pg8::Unit& u, int wr, int wc, int fr, int fq) const {
        const int row0 = u.pm * 256 + wr * 64 + fr, col0 = u.pn * 256 + wc * 32 + 8 * fq;
#pragma unroll
        for (int ai = 0; ai < 2; ++ai)
#pragma unroll
            for (int m = 0; m < 4; ++m) { const size_t row = (size_t)(row0 + ai * 128 + m * 16);
#pragma unroll
                for (int bj = 0; bj < 2; ++bj) { const int col = col0 + bj * 128;
                    const u32x4 gv = *(const u32x4*)(proj + row * NP + C_G + u.g * D + col);
                    const f32x4 v0 = acc[ai][bj][m][0], v1 = acc[ai][bj][m][1];
                    float r[8];
                    r[0] = v0[0] * sigmoidf_(bflo(gv.x)); r[1] = v0[1] * sigmoidf_(bfhi(gv.x)); r[2] = v0[2] * sigmoidf_(bflo(gv.y)); r[3] = v0[3] * sigmoidf_(bfhi(gv.y));
                    r[4] = v1[0] * sigmoidf_(bflo(gv.z)); r[5] = v1[1] * sigmoidf_(bfhi(gv.z)); r[6] = v1[2] * sigmoidf_(bflo(gv.w)); r[7] = v1[3] * sigmoidf_(bfhi(gv.w));
                    u32x4* mp = (u32x4*)(mg + row * D + col);
                    if (u.g > 0) { const u32x4 pv = *mp;
                        r[0] += bflo(pv.x); r[1] += bfhi(pv.x); r[2] += bflo(pv.y); r[3] += bfhi(pv.y); r[4] += bflo(pv.z); r[5] += bfhi(pv.z); r[6] += bflo(pv.w); r[7] += bfhi(pv.w); }
                    u32x4 w; w.x = pg8::cvt_pk_bf16(r[0], r[1]); w.y = pg8::cvt_pk_bf16(r[2], r[3]); w.z = pg8::cvt_pk_bf16(r[4], r[5]); w.w = pg8::cvt_pk_bf16(r[6], r[7]);
                    *mp = w; } }
    }
};
struct EpiResid {
    static constexpr bool PERM = false;
    const float* base; float* out;
    __device__ __forceinline__ void operator()(const f32x4 (&acc)[2][2][4][2], const pg8::Unit& u, int wr, int wc, int fr, int fq) const {
        const int row0 = u.pm * 256 + wr * 64 + fr, col0 = u.pn * 256 + wc * 32 + 4 * fq;
#pragma unroll
        for (int ai = 0; ai < 2; ++ai)
#pragma unroll
            for (int m = 0; m < 4; ++m) { const size_t off = (size_t)(row0 + ai * 128 + m * 16) * D + col0;
#pragma unroll
                for (int bj = 0; bj < 2; ++bj)
#pragma unroll
                    for (int n = 0; n < 2; ++n) { const f32x4 b = *(const f32x4*)(base + off + bj * 128 + n * 16); *(f32x4*)(out + off + bj * 128 + n * 16) = b + acc[ai][bj][m][n]; } }
    }
};
struct EpiSwiGLU {
    static constexpr bool PERM = false;
    bf16_t* hid;
    __device__ __forceinline__ void operator()(const f32x4 (&acc)[2][2][4][2], const pg8::Unit& u, int wr, int wc, int fr, int fq) const {
        const int row0 = u.pm * 256 + wr * 64 + fr, col0 = u.pn * 128 + wc * 16 + 4 * fq;
#pragma unroll
        for (int ai = 0; ai < 2; ++ai)
#pragma unroll
            for (int m = 0; m < 4; ++m) { bf16_t* rowp = hid + (size_t)(row0 + ai * 128 + m * 16) * FF + col0;
#pragma unroll
                for (int bj = 0; bj < 2; ++bj) { const f32x4 g = acc[ai][bj][m][0], up = acc[ai][bj][m][1];
                    u32x2 w; w.x = pg8::cvt_pk_bf16(g[0] * sigmoidf_(g[0]) * up[0], g[1] * sigmoidf_(g[1]) * up[1]); w.y = pg8::cvt_pk_bf16(g[2] * sigmoidf_(g[2]) * up[2], g[3] * sigmoidf_(g[3]) * up[3]);
                    *(u32x2*)(rowp + bj * 64) = w; } }
    }
};

constexpr int PH_PER_PASS = 10, N_PASS = NCH * DEPTH, PH_TOTAL = 1 + N_PASS * PH_PER_PASS + 1;
#ifndef MK_LAUNCH_PER_PHASE
#define MK_LAUNCH_PER_PHASE 0
#endif
#ifndef PHMASK
#define PHMASK 0xFFFF
#endif
#ifndef MIXM
#define MIXM 7
#endif
#define EN(j) (((PHMASK) >> (j)) & 1)
typedef const __attribute__((address_space(4))) char* kptr_t;
__device__ __forceinline__ const void* karg_ptr(kptr_t kp, int i) { return *(const void* const __attribute__((address_space(4)))*)(kp + 8 * i); }
__device__ __forceinline__ void make_ctx(Ctx& c, kptr_t& kp, int pass, int wave_s) {
    int t = wave_s * 64 + (int)__builtin_amdgcn_mbcnt_hi(~0u, __builtin_amdgcn_mbcnt_lo(~0u, 0u)); asm volatile("" : "+v"(t));
    kp = (kptr_t)__builtin_amdgcn_kernarg_segment_ptr(); asm volatile("" : "+s"(kp));
    c.tid = t; c.lane = t & 63; c.wave = __builtin_amdgcn_readfirstlane(t >> 6); c.bid = blockIdx.x; c.G = gridDim.x;
    unsigned char* ws = (unsigned char*)karg_ptr(kp, 25); float* out = (float*)karg_ptr(kp, 24);
    c.ctl = (unsigned*)(ws + WS_CTL);
    c.act = (bf16_t*)(ws + WS_ACT); c.proj = (bf16_t*)(ws + WS_PROJ); c.hid = (bf16_t*)(ws + WS_HID); c.ys = (bf16_t*)(ws + WS_YS);
    c.rec = (unsigned*)(ws + WS_REC); c.list = (int*)(ws + WS_LIST);
    const int chunk = pass / DEPTH, layer = pass % DEPTH;
    c.chunk = chunk; c.layer = layer; c.pass = pass;
    c.x_in = (const float*)karg_ptr(kp, 0) + (size_t)chunk * TC * D; c.xo = out + (size_t)chunk * TC * D;
    c.pos = (const int*)karg_ptr(kp, 1) + (size_t)chunk * TC;
    c.lw = ws + WS_W + (size_t)layer * LW_SIZE;
}
#define INP(i) ((const float*)karg_ptr(kp, (i)))
__global__ void __launch_bounds__(NTHR, 2) fwd(Args args) {
    extern __shared__ __attribute__((aligned(16))) unsigned char lds_raw[];
    Ctx c; kptr_t kp;
    c.lds = (LAS unsigned char*)lds_raw;
    const int wave_s = __builtin_amdgcn_readfirstlane((int)threadIdx.x >> 6);
    make_ctx(c, kp, 0, wave_s);
    volatile LAS unsigned* MISC = (volatile LAS unsigned*)(c.lds + MISC_OFF);
    LAS int* sPT = (LAS int*)(c.lds + MISC_OFF + 64);
    LAS int* sLC = (LAS int*)(c.lds + MISC_OFF + 160);
    for (int u = c.tid; u < 1024; u += NTHR) MISC[u] = 0u;
    __syncthreads();
    XcdBarrier bar; bar.bar = c.ctl + CW_BAR; bar.x = 0; bar.st = nullptr;
    if (!MK_LAUNCH_PER_PHASE) bar = xcd_barrier_post(c.ctl + CW_BAR, MISC, c.tid);
    const int lo = args.ph_lo, hi = args.ph_hi;
#define IN(k) (lo <= (k) && (k) < hi)
#define SEAM(k) do { if (IN(k) && IN((k) + 1)) { XcdBarrier _b = bar; kptr_t _k = (kptr_t)__builtin_amdgcn_kernarg_segment_ptr(); asm volatile("" : "+s"(_k)); _b.bar = (unsigned*)((unsigned char*)karg_ptr(_k, 25) + WS_CTL) + CW_BAR; { int _t = wave_s * 64 + (int)__builtin_amdgcn_mbcnt_hi(~0u, __builtin_amdgcn_mbcnt_lo(~0u, 0u)); xcd_barrier(_b, _t); } } } while (0)

    if (EN(0) && IN(0)) { Args a2;
#pragma unroll
        for (int i = 0; i < 24; ++i) a2.in[i] = karg_ptr(kp, i);
        a2.ws = (unsigned char*)karg_ptr(kp, 25); a2.out = nullptr; a2.ph_lo = 0; a2.ph_hi = 0;
        phase_prep(a2, c.lds, c.bid * NWAVES + c.wave, c.G * NWAVES, c.wave, c.lane, c.bid * NTHR + c.tid, c.G * NTHR); }
    SEAM(0);

    for (int pass = 0; pass < N_PASS; ++pass) {
        const int pb = 1 + pass * PH_PER_PASS;
        if (EN(1) && IN(pb + 0)) { make_ctx(c, kp, pass, wave_s);
            const float* g1 = INP(2) + c.layer * D;
            if (c.layer == 0) {
                if (c.chunk > 0) {
                    Ctx p = c; p.xo = c.xo - (size_t)TC * D;
                    moe_tables(c.ctl + CW_CNT + 64 * (pass - 1), sPT, sLC, c.tid);
                    phase_norm1<true, false, true>(p, nullptr, sPT);
                }
                phase_norm1<false, true, false>(c, g1, sPT);
            } else {
                moe_tables(c.ctl + CW_CNT + 64 * (pass - 1), sPT, sLC, c.tid);
                phase_norm1<true, true, true>(c, g1, sPT);
            }
        }
        SEAM(pb + 0);
        if (EN(2) && IN(pb + 1)) { make_ctx(c, kp, pass, wave_s);
            PlainOrder S{TC / 256, NP / 256, c.G, c.bid, (const char*)c.act, (const char*)(c.lw + LW_WIN), (size_t)256 * D * 2, (size_t)256 * D * 2};
            EpiStoreBf16 E{c.proj, NP};
            pg8::gemm_phase<EpiStoreBf16, PlainOrder, false>(c.lds, S, E, D, D, c.tid);
        }
        SEAM(pb + 1);
        if (EN(3) && IN(pb + 2)) { make_ctx(c, kp, pass, wave_s); phase_qkrope(c, INP(14) + c.layer * 128, INP(15) + c.layer * 128); }
        SEAM(pb + 2);
        if (EN(4) && IN(pb + 3)) { make_ctx(c, kp, pass, wave_s); const int layer = c.layer;
            float* lse = (float*)(c.ctl) + (WS_BRC / 4);
            if (c.bid < 4 * BC) gla_unit(c, c.bid, INP(5) + layer * 256, INP(6) + layer * 128);
            else if (c.bid < 12 * BC) lru_unit(c, c.bid - 4 * BC, INP(7) + layer * 4 * 512, INP(8) + layer * 512, INP(9) + layer * 8 * 64 * 64,
                                                INP(10) + layer * 512, INP(11) + layer * 8 * 64 * 64, INP(12) + layer * 512, INP(13) + layer * 512);
            unsigned* qh = c.ctl + CW_Q + 64 * pass;
            for (;;) {
                if (c.tid == 0) MISC[4] = __hip_atomic_fetch_add(qh, 1u, __ATOMIC_RELAXED, __HIP_MEMORY_SCOPE_AGENT);
                __syncthreads();
                const unsigned u = MISC[4];
                if (u >= (unsigned)(BC * ATT_UNITS_PER_SEQ)) break;
                attn_unit(c, (int)u, lse);
            }
        }
        SEAM(pb + 3);
        if (EN(11) && IN(pb + 4)) { make_ctx(c, kp, pass, wave_s); phase_attn_combine(c, (const float*)(c.ctl) + (WS_BRC / 4)); }
        SEAM(pb + 4);
        if (EN(5) && IN(pb + 5)) { make_ctx(c, kp, pass, wave_s);
            MergeOrder S{c.G, c.bid, (const char*)c.proj, (const char*)(c.lw + LW_WBR)};
            EpiMerge E{c.proj, c.act};
            pg8::gemm_phase<EpiMerge, MergeOrder, false>(c.lds, S, E, 512, NP, c.tid);
        }
        SEAM(pb + 5);
        if (EN(6) && IN(pb + 6)) { make_ctx(c, kp, pass, wave_s);
            PlainOrder S{TC / 256, D / 256, c.G, c.bid, (const char*)c.act, (const char*)(c.lw + LW_WOUT), (size_t)256 * D * 2, (size_t)256 * D * 2};
            EpiResid E{c.layer == 0 ? c.x_in : (const float*)c.xo, c.xo};
            pg8::gemm_phase<EpiResid, PlainOrder, false>(c.lds, S, E, D, D, c.tid);
        }
        SEAM(pb + 6);
        if (EN(7) && IN(pb + 7)) { make_ctx(c, kp, pass, wave_s); phase_router(c, INP(18) + c.layer * D, INP(19), INP(20), c.ctl + CW_CNT + 64 * pass); }
        SEAM(pb + 7);
        if (EN(8) && IN(pb + 8)) { make_ctx(c, kp, pass, wave_s);
            moe_tables(c.ctl + CW_CNT + 64 * pass, sPT, sLC, c.tid);
            MoeOrder<true> S{c.G, c.bid, sPT, sLC, (const char*)c.act, (const char*)(c.lw + LW_WGU), c.list};
            EpiSwiGLU E{c.hid};
            pg8::gemm_phase<EpiSwiGLU, MoeOrder<true>, true>(c.lds, S, E, D, D, c.tid);
        }
        SEAM(pb + 8);
        if (EN(9) && IN(pb + 9)) { make_ctx(c, kp, pass, wave_s);
            moe_tables(c.ctl + CW_CNT + 64 * pass, sPT, sLC, c.tid);
            MoeOrder<false> S{c.G, c.bid, sPT, sLC, (const char*)c.hid, (const char*)(c.lw + LW_WDN), c.list};
            EpiStoreBf16 E{c.ys, D};
            pg8::gemm_phase<EpiStoreBf16, MoeOrder<false>, false>(c.lds, S, E, FF, FF, c.tid);
        }
        SEAM(pb + 9);
    }
    if (EN(10) && IN(PH_TOTAL - 1)) { make_ctx(c, kp, N_PASS - 1, wave_s);
        moe_tables(c.ctl + CW_CNT + 64 * (N_PASS - 1), sPT, sLC, c.tid);
        phase_norm1<true, false, true>(c, nullptr, sPT);
    }
#undef IN
#undef SEAM
}

extern "C" void kernel_launch(void* const* d_in, const int* in_sizes, int n_in, void* d_out, int out_size, void* d_ws, size_t ws_size, hipStream_t stream) {
    static int grid = 0;
    if (grid == 0) {
        if (n_in != 24 || in_sizes[0] != BATCH * SEQ * D || out_size != BATCH * SEQ * D || ws_size < WS_END) { fprintf(stderr, "kernel_launch: unexpected shapes / workspace (%zu < %zu)\n", ws_size, (size_t)WS_END); grid = -1; return; }
        int dev = 0, cus = 0;
        if (hipGetDevice(&dev) != hipSuccess || hipDeviceGetAttribute(&cus, hipDeviceAttributeMultiprocessorCount, dev) != hipSuccess || cus < 256) { fprintf(stderr, "kernel_launch: needs a 256-CU device\n"); grid = -1; return; }
        if (hipFuncSetAttribute((const void*)fwd, hipFuncAttributeMaxDynamicSharedMemorySize, LDS_BYTES) != hipSuccess) { fprintf(stderr, "kernel_launch: hipFuncSetAttribute failed\n"); grid = -1; return; }
        int per_cu = 0;
        if (hipOccupancyMaxActiveBlocksPerMultiprocessor(&per_cu, (const void*)fwd, NTHR, LDS_BYTES) != hipSuccess || per_cu < 1) fprintf(stderr, "kernel_launch: occupancy query says %d\n", per_cu);
        (void)hipGetLastError();
        grid = 256;
    }
    if (grid < 0) return;
    if (hipMemsetAsync((char*)d_ws + WS_CTL, 0, CTL_ZERO_BYTES, stream) != hipSuccess) return;
    Args a{};
    for (int i = 0; i < 24; ++i) a.in[i] = d_in[i];
    a.out = (float*)d_out; a.ws = (unsigned char*)d_ws;
#if MK_LAUNCH_PER_PHASE
    for (int k = 0; k < PH_TOTAL; ++k) { a.ph_lo = k; a.ph_hi = k + 1; hipLaunchKernelGGL(fwd, dim3(grid), dim3(NTHR), LDS_BYTES, stream, a); }
#else
    a.ph_lo = 0; a.ph_hi = PH_TOTAL;
    hipLaunchKernelGGL(fwd, dim3(grid), dim3(NTHR), LDS_BYTES, stream, a);
#endif
}
```

```cpp
#include <hip/hip_runtime.h>
#include <cstdio>
#include <cstdint>

#define LAS __attribute__((address_space(3)))
#define GAS __attribute__((address_space(1)))
typedef unsigned short bf16_t;
typedef short bf16x8 __attribute__((ext_vector_type(8)));
typedef float f32x4 __attribute__((ext_vector_type(4)));
typedef float f32x2 __attribute__((ext_vector_type(2)));
typedef unsigned u32x4 __attribute__((ext_vector_type(4)));
typedef unsigned u32x2 __attribute__((ext_vector_type(2)));

namespace pg8 {
constexpr int BM = 256, BK = 64, HALF = 128, HTB = HALF * BK * 2, STAGE_BYTES = 8 * HTB, NXCD = 8, WGM = 8;
__host__ __device__ __forceinline__ int lds_byte(int r, int c) { const int st = (r >> 4) * 2 + (c >> 5), rr = r & 15, cc = c & 31, ob = rr * 64 + cc * 2; return st * 1024 + (ob ^ (((ob >> 9) & 1) << 5)); }
__host__ __device__ __forceinline__ void stage_rc(int b, int& R, int& C) { const int st = b / 1024, sb = b % 1024, swz = sb ^ (((sb >> 9) & 1) << 5); R = (st >> 1) * 16 + swz / 64; C = (st & 1) * 32 + (swz % 64) / 2; }
__host__ __device__ __forceinline__ int perm32(int rho) { const int n = rho >> 4, i = rho & 15; return 8 * (i >> 2) + 4 * n + (i & 3); }

struct Unit { int pm, pn, g; };

__device__ __forceinline__ bool static_tile(int nM, int nN, int G, int c, int i, int& pm, int& pn) {
    const int nwg = nM * nN; const long L = (long)i * G + c; if (L >= nwg) return false;
    int wgid = (int)L; { const int q = nwg / NXCD, r = nwg % NXCD, xcd = wgid % NXCD, off = wgid / NXCD; wgid = (xcd < r ? xcd * (q + 1) : r * (q + 1) + (xcd - r) * q) + off; }
    const int nig = WGM * nN, gid = wgid / nig, fm = gid * WGM, gsz = (nM - fm) < WGM ? (nM - fm) : WGM;
    pm = fm + ((wgid % nig) % gsz); pn = (wgid % nig) / gsz; return true;
}
typedef __bf16 bf16x2c_t __attribute__((ext_vector_type(2)));
__device__ __forceinline__ unsigned cvt_pk_bf16(float lo, float hi) { const f32x2 v = {lo, hi}; return __builtin_bit_cast(unsigned, __builtin_convertvector(v, bf16x2c_t)); }

template <class Epi, class Sched, bool GATHER>
__device__ __forceinline__ void gemm_phase(LAS unsigned char* lds, const Sched& S, const Epi& E, const int K, const int lda, int tid_) {
    asm volatile("" : "+v"(tid_));
    const int tid = tid_, wid = __builtin_amdgcn_readfirstlane(tid >> 6), lane = tid & 63, wr = wid >> 2, wc = wid & 3, fr = lane & 15, fq = lane >> 4;
    const int nt = K / BK;
    int sR[2], sC[2];
    unsigned voffB[2], voffA[2], vAc[2][2], vAn[2][2];
#pragma unroll
    for (int i = 0; i < 2; ++i) { int R, C; stage_rc(tid * 16 + i * 8192, R, C); sR[i] = R; sC[i] = C; const int Rb = Epi::PERM ? ((R & ~31) + perm32(R & 31)) : R;
        voffB[i] = (unsigned)(Rb * K + C) * 2u; voffA[i] = (unsigned)(R * lda + C) * 2u; }
    const size_t kstep = (size_t)(BK * 2);
    const size_t hstepB = (size_t)HALF * K * 2, hstepA = (size_t)HALF * lda * 2;
    const unsigned ldsw = (unsigned)wid * 1024u;
    const int aoff = lds_byte(wr * 64 + fr, fq * 8), boff = lds_byte(wc * 32 + fr, fq * 8);
#define PG8_SA(b, h) (((b) * 2 + (h)) * HTB)
#define PG8_SB(b, h) ((4 + (b) * 2 + (h)) * HTB)
#define PG8_STAGE(bufoff, gbase, voff) do { _Pragma("unroll") for (int _i = 0; _i < 2; ++_i) \
        __builtin_amdgcn_global_load_lds((const unsigned*)((const char*)(gbase) + (voff)[_i]), (LAS unsigned*)(lds + (bufoff) + ldsw + _i * 8192), 16, 0, 0); } while (0)
#define PG8_LDA(dst, b, h) do { _Pragma("unroll") for (int m = 0; m < 4; ++m) _Pragma("unroll") for (int k = 0; k < 2; ++k) dst[m][k] = *(const LAS bf16x8*)(lds + PG8_SA(b, h) + aoff + m * 2048 + k * 1024); } while (0)
#define PG8_LDB(dst, b, h) do { _Pragma("unroll") for (int n = 0; n < 2; ++n) _Pragma("unroll") for (int k = 0; k < 2; ++k) dst[n][k] = *(const LAS bf16x8*)(lds + PG8_SB(b, h) + boff + n * 2048 + k * 1024); } while (0)
#define PG8_MMA(ai, bj, At, Bt) do { __builtin_amdgcn_s_setprio(1); _Pragma("unroll") for (int m = 0; m < 4; ++m) _Pragma("unroll") for (int n = 0; n < 2; ++n) _Pragma("unroll") for (int k = 0; k < 2; ++k) \
        acc[ai][bj][m][n] = __builtin_amdgcn_mfma_f32_16x16x32_bf16(Bt[n][k], At[m][k], acc[ai][bj][m][n], 0, 0, 0); __builtin_amdgcn_s_setprio(0); } while (0)
#define PG8_WAIT_V(n) asm volatile("s_waitcnt vmcnt(" #n ")" ::: "memory")
#define PG8_WAIT_L(n) asm volatile("s_waitcnt lgkmcnt(" #n ")" ::: "memory")
#define PG8_BAR __builtin_amdgcn_s_barrier()
#define PG8_SCHED __builtin_amdgcn_sched_barrier(0)
#define PG8_AOFF(dst, u) do { if constexpr (GATHER) { _Pragma("unroll") for (int _h = 0; _h < 2; ++_h) _Pragma("unroll") for (int _i = 0; _i < 2; ++_i) \
        dst[_h][_i] = S.arow(u, _h * HALF + sR[_i]) + (unsigned)sC[_i] * 2u; } } while (0)
#define PG8_STAGE_A(bufoff, gptr, h, usenext) do { if constexpr (GATHER) { _Pragma("unroll") for (int _i = 0; _i < 2; ++_i) { const unsigned _vo = (usenext) ? vAn[h][_i] : vAc[h][_i]; \
        __builtin_amdgcn_global_load_lds((const unsigned*)((const char*)(gptr) + _vo), (LAS unsigned*)(lds + (bufoff) + ldsw + _i * 8192), 16, 0, 0); } } \
        else { PG8_STAGE(bufoff, (gptr) + (h) * hstepA, voffA); } } while (0)
    Unit cur, nxt; int ui = 0;
    if (!S.next(0, cur)) return;
    f32x4 acc[2][2][4][2];
#pragma unroll
    for (int a = 0; a < 2; ++a)
#pragma unroll
        for (int b = 0; b < 2; ++b)
#pragma unroll
            for (int m = 0; m < 4; ++m)
#pragma unroll
                for (int n = 0; n < 2; ++n) acc[a][b][m][n] = (f32x4){0.f, 0.f, 0.f, 0.f};
    bf16x8 At[4][2], B0[2][2], B1[2][2];
    const char* cA = S.aptr(cur); const char* cB = S.bptr(cur);
    PG8_AOFF(vAc, cur);
    PG8_STAGE(PG8_SB(0, 0), cB, voffB); PG8_STAGE(PG8_SB(0, 1), cB + hstepB, voffB); PG8_STAGE_A(PG8_SA(0, 0), cA, 0, false); PG8_STAGE_A(PG8_SA(0, 1), cA, 1, false);
    if (wr == 1) PG8_BAR;
    PG8_WAIT_V(2); PG8_BAR;
    PG8_STAGE(PG8_SB(1, 0), cB + kstep, voffB); PG8_STAGE_A(PG8_SA(1, 0), cA + kstep, 0, false); PG8_STAGE(PG8_SB(1, 1), cB + hstepB + kstep, voffB);
    PG8_WAIT_V(6); PG8_BAR;
    for (;;) {
        const bool has_next = S.next(ui + 1, nxt);
        const char* nA = has_next ? S.aptr(nxt) : cA; const char* nB = has_next ? S.bptr(nxt) : cB;
        if constexpr (GATHER) { if (has_next) { PG8_AOFF(vAn, nxt); } else {
#pragma unroll
            for (int h = 0; h < 2; ++h)
#pragma unroll
                for (int i = 0; i < 2; ++i) vAn[h][i] = vAc[h][i]; } }
        for (int t = 0; t < nt; t += 2) {
            const bool last = (t == nt - 2);
            const char* a1 = cA + (size_t)(t + 1) * kstep;
            const char* a2 = last ? nA : cA + (size_t)(t + 2) * kstep; const char* b2 = last ? nB : cB + (size_t)(t + 2) * kstep;
            const char* a3 = a2 + kstep; const char* b3 = b2 + kstep;
            PG8_LDB(B0, 0, 0); PG8_LDB(B1, 0, 1); PG8_SCHED; PG8_LDA(At, 0, 0); PG8_STAGE_A(PG8_SA(1, 1), a1, 1, false);
            PG8_WAIT_V(8); PG8_WAIT_L(0); PG8_BAR; PG8_MMA(0, 0, At, B0); PG8_MMA(0, 1, At, B1); PG8_BAR; PG8_SCHED;
            PG8_LDA(At, 0, 1); PG8_STAGE(PG8_SB(0, 0), b2, voffB); PG8_STAGE(PG8_SB(0, 1), b2 + hstepB, voffB); PG8_STAGE_A(PG8_SA(0, 0), a2, 0, last);
            PG8_WAIT_V(8); PG8_WAIT_L(0); PG8_BAR; PG8_MMA(1, 0, At, B0); PG8_MMA(1, 1, At, B1); PG8_BAR; PG8_SCHED;
            PG8_LDB(B0, 1, 0); PG8_LDB(B1, 1, 1); PG8_SCHED; PG8_LDA(At, 1, 0); PG8_STAGE_A(PG8_SA(0, 1), a2, 1, last);
            PG8_WAIT_V(8); PG8_WAIT_L(0); PG8_BAR; PG8_MMA(0, 0, At, B0); PG8_MMA(0, 1, At, B1); PG8_BAR; PG8_SCHED;
            PG8_LDA(At, 1, 1); PG8_STAGE(PG8_SB(1, 0), b3, voffB); PG8_STAGE(PG8_SB(1, 1), b3 + hstepB, voffB); PG8_STAGE_A(PG8_SA(1, 0), a3, 0, last);
            PG8_WAIT_V(8); PG8_WAIT_L(0); PG8_BAR; PG8_MMA(1, 0, At, B0); PG8_MMA(1, 1, At, B1); PG8_BAR; PG8_SCHED;
        }
        if (wr == 0) PG8_BAR;
#if defined(PROBE_MASK) && PROBE_MASK
        { const unsigned long long _t0 = __builtin_amdgcn_s_memrealtime();
          E(acc, cur, wr, wc, fr, fq);
          asm volatile("s_waitcnt vmcnt(0)" ::: "memory");
          if (blockIdx.x == PROBE_BLOCK && tid == 0 && ((volatile LAS unsigned*)(lds + 147456))[6]) ((LAS unsigned*)(lds + 147456 + 512))[13] += (unsigned)(__builtin_amdgcn_s_memrealtime() - _t0); }
#else
        E(acc, cur, wr, wc, fr, fq);
#endif
        if (!has_next) break;
#pragma unroll
        for (int a = 0; a < 2; ++a)
#pragma unroll
            for (int b = 0; b < 2; ++b)
#pragma unroll
                for (int m = 0; m < 4; ++m)
#pragma unroll
                    for (int n = 0; n < 2; ++n) acc[a][b][m][n] = (f32x4){0.f, 0.f, 0.f, 0.f};
        cur = nxt; cA = nA; cB = nB; ++ui;
        if constexpr (GATHER) {
#pragma unroll
        for (int h = 0; h < 2; ++h)
#pragma unroll
            for (int i = 0; i < 2; ++i) vAc[h][i] = vAn[h][i]; }
        if (wr == 1) PG8_BAR;
    }
    PG8_WAIT_V(0);
    PG8_BAR;
#undef PG8_SA
#undef PG8_SB
#undef PG8_STAGE
#undef PG8_LDA
#undef PG8_LDB
#undef PG8_MMA
#undef PG8_WAIT_V
#undef PG8_WAIT_L
#undef PG8_BAR
#undef PG8_SCHED
#undef PG8_AOFF
#undef PG8_STAGE_A
}
}

constexpr int D = 1024, BATCH = 32, SEQ = 2048, DEPTH = 2;
constexpr int NCH = 2, BC = BATCH / NCH, TC = BC * SEQ;
constexpr int NP = 10496;
constexpr int C_QA = 0, C_KA = 256, C_VA = 512, C_OG = 1024, C_GP = 1536, C_XB = 1792, C_YB = 2304, C_QKV = 2816, C_G = 7424;
constexpr int WIN_N = 10256;
constexpr int NE = 16, FF = 512;
constexpr int RP = 2 * TC + NE * 256;
constexpr float RMS_EPS = 1e-6f;
constexpr int NWAVES = 8, NTHR = 512;

constexpr size_t MiB = 1u << 20;
constexpr size_t WS_CTL = 0, CTL_ZERO_BYTES = 1 * MiB;
constexpr size_t WS_REC = 1 * MiB;
constexpr size_t WS_LIST = 2 * MiB;
constexpr size_t WS_W = 4 * MiB;
constexpr size_t LW_WIN = 0, LW_WBR = LW_WIN + (size_t)NP * D * 2, LW_WOUT = LW_WBR + (size_t)3 * D * 512 * 2, LW_WGU = LW_WOUT + (size_t)D * D * 2,
                 LW_WDN = LW_WGU + (size_t)NE * 1024 * D * 2, LW_SIZE = LW_WDN + (size_t)NE * D * FF * 2;
static_assert(LW_SIZE == 77070336, "layer weights");
constexpr size_t WS_ACT = 152 * MiB;
constexpr size_t WS_BRC = 216 * MiB;
constexpr size_t WS_PROJ = 248 * MiB;
constexpr size_t WS_HID = WS_PROJ;
constexpr size_t WS_YS = WS_PROJ + 72 * MiB;
constexpr size_t WS_BRX = WS_PROJ + 656 * MiB;
constexpr size_t WS_END = WS_BRX + 96 * MiB;
static_assert(WS_W + 2 * LW_SIZE <= WS_ACT && (size_t)TC * NP * 2 <= 656 * MiB && (size_t)RP * 512 * 2 <= 72 * MiB && WS_YS + (size_t)RP * 2048 <= WS_END, "ws map");
constexpr int CW_BAR = 4096;
constexpr int CW_CNT = 8192;
constexpr int CW_Q = 12288;

constexpr int RING_BYTES = 147456;
constexpr int MISC_OFF = RING_BYTES;
constexpr int LDS_BYTES = 155648;

#define LDS_WAIT() asm volatile("s_waitcnt lgkmcnt(0)" ::: "memory")
#define VM_WAIT() asm volatile("s_waitcnt vmcnt(0)" ::: "memory")
__device__ __forceinline__ float bf2f(unsigned short b) { return __uint_as_float(((unsigned)b) << 16); }
__device__ __forceinline__ float bflo(unsigned u) { return __uint_as_float(u << 16); }
__device__ __forceinline__ float bfhi(unsigned u) { return __uint_as_float(u & 0xffff0000u); }
typedef __bf16 bf16x2v_t __attribute__((ext_vector_type(2)));
__device__ __forceinline__ unsigned pk2(float lo, float hi) { const f32x2 v = {lo, hi}; return __builtin_bit_cast(unsigned, __builtin_convertvector(v, bf16x2v_t)); }
__device__ __forceinline__ unsigned f2bf(float f) { return pk2(f, 0.f) & 0xffffu; }
__device__ __forceinline__ float rcpf_(float x) { return __builtin_amdgcn_rcpf(x); }
__device__ __forceinline__ float rsqf_(float x) { return __builtin_amdgcn_rsqf(x); }
template <int O> __device__ __forceinline__ float swz_xor(float v) { return __int_as_float(__builtin_amdgcn_ds_swizzle(__float_as_int(v), (O << 10) | 0x1f)); }
__device__ __forceinline__ float wave_sum(float v) {
    v += swz_xor<1>(v); v += swz_xor<2>(v); v += swz_xor<4>(v); v += swz_xor<8>(v); v += swz_xor<16>(v);
    const auto r = __builtin_amdgcn_permlane32_swap(__float_as_uint(v), __float_as_uint(v), false, false);
    return __uint_as_float(r[0]) + __uint_as_float(r[1]);
}
__device__ __forceinline__ float wave_max(float v) {
    v = fmaxf(v, swz_xor<1>(v)); v = fmaxf(v, swz_xor<2>(v)); v = fmaxf(v, swz_xor<4>(v)); v = fmaxf(v, swz_xor<8>(v)); v = fmaxf(v, swz_xor<16>(v));
    const auto r = __builtin_amdgcn_permlane32_swap(__float_as_uint(v), __float_as_uint(v), false, false);
    return fmaxf(__uint_as_float(r[0]), __uint_as_float(r[1]));
}
__device__ __forceinline__ float sigmoidf_(float x) { return __builtin_amdgcn_rcpf(1.f + __expf(-x)); }

#define XB_TMO      128
#define XB_XCNT(j)  (256  + 64 * (j))
#define XB_XSUB(j)  (1280 + 64 * (j))
#define XB_XGEN(j)  (2304 + 64 * (j))
#define XB_TOP      3328
#define XB_TOPGEN   3392
#define XCD_BAR_WORDS 3456
#define XB_SPIN_CAP (1u << 21)
__device__ __forceinline__ unsigned xb_ld(unsigned* p)              { return __hip_atomic_load(p, __ATOMIC_RELAXED, __HIP_MEMORY_SCOPE_AGENT); }
__device__ __forceinline__ unsigned xb_add(unsigned* p, unsigned v) { return __hip_atomic_fetch_add(p, v, __ATOMIC_RELAXED, __HIP_MEMORY_SCOPE_AGENT); }
__device__ __forceinline__ unsigned xb_xcc_id() { return (unsigned)__builtin_amdgcn_s_getreg((3 << 11) | 20) & 0xFu; }
#define XB_SPIN(cond, bar) do { unsigned _sp = 0; while (cond) { __builtin_amdgcn_s_sleep(1); \
    if ((++_sp & 255u) == 0u) { if (xb_ld(&(bar)[XB_TMO])) break; if (_sp > XB_SPIN_CAP) { atomicAdd(&(bar)[XB_TMO], 1u); break; } } } } while (0)
struct XcdBarrier { unsigned* bar; unsigned x; volatile LAS unsigned* st; };
__device__ __forceinline__ XcdBarrier xcd_barrier_post(unsigned* bar, volatile LAS unsigned* st, int tid) {
    XcdBarrier b; b.bar = bar; b.x = xb_xcc_id(); b.st = st;
    if (tid == 0) (void)xb_add(&bar[XB_XCNT(b.x)], 1u);
    return b;
}
__device__ __forceinline__ void xcd_barrier_complete(unsigned* bar, unsigned x, unsigned& nloc, unsigned& nx) {
    const unsigned G = gridDim.x * gridDim.y * gridDim.z;
    unsigned sum, cnt, sp = 0u;
    for (;;) {
        sum = 0u; cnt = 0u;
#pragma unroll 1
        for (unsigned j = 0; j < 16; ++j) { const unsigned c = xb_ld(&bar[XB_XCNT(j)]); sum += c; cnt += (c > 0u) ? 1u : 0u; }
        if (sum == G) break;
        __builtin_amdgcn_s_sleep(1);
        if ((++sp & 255u) == 0u) { if (xb_ld(&bar[XB_TMO])) break; if (sp > XB_SPIN_CAP) { atomicAdd(&bar[XB_TMO], 1u); break; } }
    }
    const unsigned mine = xb_ld(&bar[XB_XCNT(x)]);
    nloc = mine > 0u ? mine : 1u; nx = cnt > 0u ? cnt : 1u;
}
__device__ __noinline__ void xcd_barrier(const XcdBarrier b, const int tid) {
    asm volatile("s_waitcnt vmcnt(0)" ::: "memory");
    __syncthreads();
    if (tid == 0) {
        unsigned* bar = b.bar;
        __builtin_amdgcn_s_waitcnt(0);
        unsigned nloc = b.st[0], nx = b.st[1];
        if (nloc == 0u) { xcd_barrier_complete(bar, b.x, nloc, nx); b.st[0] = nloc; b.st[1] = nx; }
        const unsigned old = xb_add(&bar[XB_XSUB(b.x)], 1u);
        const unsigned gen = old / nloc;
        if (old + 1u == (gen + 1u) * nloc) {
            __builtin_amdgcn_fence(__ATOMIC_RELEASE, "agent");
            asm volatile("s_waitcnt vmcnt(0)" ::: "memory");
            const unsigned og = xb_add(&bar[XB_TOP], 1u);
            const unsigned tg = og / nx;
            if (og + 1u == (tg + 1u) * nx) xb_add(&bar[XB_TOPGEN], 1u);
            else XB_SPIN(xb_ld(&bar[XB_TOPGEN]) == tg, bar);
            __builtin_amdgcn_fence(__ATOMIC_ACQUIRE, "agent");
            xb_add(&bar[XB_XGEN(b.x)], 1u);
            asm volatile("s_waitcnt vmcnt(0)" ::: "memory");
        } else {
            XB_SPIN(xb_ld(&bar[XB_XGEN(b.x)]) == gen, bar);
            __builtin_amdgcn_fence(__ATOMIC_ACQUIRE, "agent");
            asm volatile("s_waitcnt vmcnt(0)" ::: "memory");
        }
    }
    __syncthreads();
}

struct Args { const void* in[24]; float* out; unsigned char* ws; int ph_lo, ph_hi; };
struct Ctx {
    LAS unsigned char* lds;
    unsigned* ctl;
    int tid, lane, wave, bid, G;
    int chunk, layer, pass;
    const float* x_in; float* xo;
    const int* pos;
    const unsigned char* lw;
    bf16_t *act, *proj, *hid, *ys, *brx;
    unsigned* rec; int* list;
};

__device__ __forceinline__ void tr_item(const float* srcp, int Nsrc, float scale, bf16_t* WT, int K, int n0, int k0, LAS float* scr, int lane) {
#pragma unroll 8
    for (int i = 0; i < 32; ++i) { const int kk = 2 * i + (lane >> 5); scr[kk * 33 + (lane & 31)] = srcp[(size_t)(k0 + kk) * Nsrc] * scale; }
    LDS_WAIT(); asm volatile("" ::: "memory");
    const int c = lane & 7;
#pragma unroll
    for (int j = 0; j < 4; ++j) { const int n = (lane >> 3) + 8 * j; const LAS float* s = scr + (8 * c) * 33 + n;
        u32x4 o; o.x = pk2(s[0 * 33], s[1 * 33]); o.y = pk2(s[2 * 33], s[3 * 33]); o.z = pk2(s[4 * 33], s[5 * 33]); o.w = pk2(s[6 * 33], s[7 * 33]);
        *(u32x4*)(WT + (size_t)(n0 + n) * K + k0 + 8 * c) = o; }
    LDS_WAIT(); asm volatile("" ::: "memory");
}
constexpr int IT_WIN = (NP / 32) * 16, IT_WBR = 3 * 32 * 8, IT_WOUT = 32 * 16, IT_WGU = NE * 32 * 16, IT_WDN = NE * 32 * 8, IT_LAYER = IT_WIN + IT_WBR + IT_WOUT + IT_WGU + IT_WDN;
__device__ __forceinline__ void phase_prep(const Args& a, LAS unsigned char* lds, int gw, int NGW, int wave, int lane, int gtid, int NGT) {
    LAS float* scr = (LAS float*)(lds + wave * 16384);
    for (int it = gw; it < DEPTH * IT_LAYER; it += NGW) {
        const int l = it / IT_LAYER; int r = it % IT_LAYER;
        unsigned char* lw = a.ws + WS_W + (size_t)l * LW_SIZE;
        const int rl = lane & 31;
        if (r < IT_WIN) {
            const int g = r / 16, kb = r % 16;
            if (g >= C_GP / 32 && g < C_XB / 32) continue;
            const int n = 32 * g + rl; const int src = n < C_GP ? n : n - 240;
            const float* W = (const float*)a.in[3] + (size_t)l * D * WIN_N;
            tr_item(W + src, WIN_N, n < 256 ? 0.125f : 1.f, (bf16_t*)(lw + LW_WIN), D, 32 * g, 64 * kb, scr, lane);
            continue; }
        r -= IT_WIN;
        if (r < IT_WBR) {
            const int b = r / 256, g = (r % 256) / 8, kb = r % 8;
            const float* W = (const float*)a.in[16] + ((size_t)l * 3 + b) * 512 * D;
            tr_item(W + 32 * g + rl, D, 1.f, (bf16_t*)(lw + LW_WBR) + (size_t)b * D * 512, 512, 32 * g, 64 * kb, scr, lane);
            continue; }
        r -= IT_WBR;
        if (r < IT_WOUT) {
            const int g = r / 16, kb = r % 16;
            const float* W = (const float*)a.in[17] + (size_t)l * D * D;
            tr_item(W + 32 * g + rl, D, 1.f, (bf16_t*)(lw + LW_WOUT), D, 32 * g, 64 * kb, scr, lane);
            continue; }
        r -= IT_WOUT;
        if (r < IT_WGU) {
            const int e = r / 512, g = (r % 512) / 16, kb = r % 16;
            const float* Wg = (const float*)a.in[21] + ((size_t)l * NE + e) * D * FF;
            const float* Wu = (const float*)a.in[22] + ((size_t)l * NE + e) * D * FF;
            const float* sp = (rl < 16 ? Wg : Wu) + 16 * g + (rl & 15);
            tr_item(sp, FF, 1.f, (bf16_t*)(lw + LW_WGU) + (size_t)e * 1024 * D, D, 32 * g, 64 * kb, scr, lane);
            continue; }
        r -= IT_WGU;
        {
            const int e = r / 256, g = (r % 256) / 8, kb = r % 8;
            const float* W = (const float*)a.in[23] + ((size_t)l * NE + e) * FF * D;
            tr_item(W + 32 * g + rl, D, 1.f, (bf16_t*)(lw + LW_WDN) + (size_t)e * D * FF, FF, 32 * g, 64 * kb, scr, lane);
        }
    }
    for (int idx = gtid; idx < DEPTH * 256 * D; idx += NGT) {
        const int l = idx / (256 * D), j = (idx / D) % 256, k = idx % D;
        const float* W = (const float*)a.in[3] + (size_t)l * D * WIN_N + (size_t)k * WIN_N + 1536;
        const float* gu = (const float*)a.in[4] + (size_t)l * 16 * 256 + j;
        float s = 0.f;
#pragma unroll
        for (int r = 0; r < 16; ++r) s += W[r] * gu[r * 256];
        ((bf16_t*)(a.ws + WS_W + (size_t)l * LW_SIZE + LW_WIN))[(size_t)(C_GP + j) * D + k] = (bf16_t)f2bf(s);
    }
}

__device__ __forceinline__ void moe_tables(const unsigned* cnt, LAS int* pt, LAS int* lc, int tid) {
    if (tid == 0) { int s = 0;
        for (int e = 0; e < NE; ++e) { const int c = (int)__hip_atomic_load(cnt + e, __ATOMIC_RELAXED, __HIP_MEMORY_SCOPE_AGENT); pt[e] = s; lc[e] = c; s += (c + 255) >> 8; }
        pt[NE] = s; }
    __syncthreads();
}

template <bool COMBINE, bool NORM, bool SRC_OUT>
__device__ __forceinline__ void phase_norm1(const Ctx& c, const float* gain, LAS const int* pt) {
    const int gw = c.bid * NWAVES + c.wave, NGW = c.G * NWAVES, lane = c.lane;
    f32x4 g4[4];
    if (NORM) {
#pragma unroll
        for (int j = 0; j < 4; ++j) g4[j] = *((const f32x4*)gain + 64 * j + lane); }
    constexpr int NR = 2;
    static_assert(TC % (NR * 2048) == 0, "rows per wave");
    for (int tok0 = gw; tok0 < TC; tok0 += NR * NGW) {
        f32x4 v[NR][4]; u32x2 ya[NR][4], yb[NR][4]; float w0[NR], w1[NR];
#pragma unroll
        for (int r = 0; r < NR; ++r) { const int tok = tok0 + r * NGW;
            const f32x4* xr = (const f32x4*)((SRC_OUT ? (const float*)c.xo : c.x_in) + (size_t)tok * D) + lane;
#pragma unroll
            for (int j = 0; j < 4; ++j) v[r][j] = xr[64 * j];
            if (COMBINE) {
                const u32x4 rc = *(const u32x4*)(c.rec + (size_t)tok * 4);
                const int e0 = rc.x >> 20, e1 = rc.y >> 20;
                const size_t r0 = (size_t)pt[e0] * 256 + (rc.x & 0xfffffu), r1 = (size_t)pt[e1] * 256 + (rc.y & 0xfffffu);
                w0[r] = __uint_as_float(rc.z); w1[r] = __uint_as_float(rc.w);
                const u32x2* y0 = (const u32x2*)(c.ys + r0 * D) + lane; const u32x2* y1 = (const u32x2*)(c.ys + r1 * D) + lane;
#pragma unroll
                for (int j = 0; j < 4; ++j) { ya[r][j] = y0[64 * j]; yb[r][j] = y1[64 * j]; }
            } }
#pragma unroll
        for (int r = 0; r < NR; ++r) { const int tok = tok0 + r * NGW;
            if (COMBINE) {
#pragma unroll
                for (int j = 0; j < 4; ++j) { const u32x2 a = ya[r][j], b = yb[r][j];
                    v[r][j].x += w0[r] * bflo(a.x) + w1[r] * bflo(b.x); v[r][j].y += w0[r] * bfhi(a.x) + w1[r] * bfhi(b.x);
                    v[r][j].z += w0[r] * bflo(a.y) + w1[r] * bflo(b.y); v[r][j].w += w0[r] * bfhi(a.y) + w1[r] * bfhi(b.y); }
                f32x4* xw = (f32x4*)(c.xo + (size_t)tok * D) + lane;
#pragma unroll
                for (int j = 0; j < 4; ++j) xw[64 * j] = v[r][j];
            }
            if (NORM) {
                float ss = 0.f;
#pragma unroll
                for (int j = 0; j < 4; ++j) ss += (v[r][j].x * v[r][j].x + v[r][j].y * v[r][j].y) + (v[r][j].z * v[r][j].z + v[r][j].w * v[r][j].w);
                const float rs = rsqf_(wave_sum(ss) * (1.f / D) + RMS_EPS);
                u32x2* o = (u32x2*)(c.act + (size_t)tok * D) + lane;
#pragma unroll
                for (int j = 0; j < 4; ++j) { u32x2 w; w.x = pk2(v[r][j].x * rs * g4[j].x, v[r][j].y * rs * g4[j].y); w.y = pk2(v[r][j].z * rs * g4[j].z, v[r][j].w * rs * g4[j].w); o[64 * j] = w; }
            } }
    }
}

__constant__ double kInvFreq[16] = {1.0, 0.44036660267178046, 0.19392274474868576, 0.08539710028576561, 0.03760603093086393, 0.016560440080994446, 0.007292664737217109, 0.003211445994752591,
    0.001414213562373095, 0.000622772421914596, 0.0002742481756762073, 0.00012076973741146504, 5.318295896944988e-05, 2.341999896140934e-05, 1.031338537721246e-05, 4.5416704806078695e-06};
__device__ __forceinline__ void phase_rope_table(const int* pos, float* tab, int gtid, int NGT) {
    for (int idx = gtid; idx < BATCH * SEQ * 16; idx += NGT) { const int tok = idx >> 4, i = idx & 15;
        double a = (double)pos[tok] * kInvFreq[i] * 0.15915494309189535; a -= rint(a);
        tab[(size_t)tok * 32 + i] = __builtin_amdgcn_cosf((float)a); tab[(size_t)tok * 32 + 16 + i] = __builtin_amdgcn_sinf((float)a); }
}

__device__ __forceinline__ float logsigmoidf_(float g) { return fminf(g, 0.f) - log1pf(__expf(-fabsf(g))); }
__device__ __forceinline__ float gelu_tanh(float y) { const float u = 0.7978845608028654f * (y + 0.044715f * y * y * y); const float t = 1.f - 2.f * rcpf_(1.f + __expf(2.f * u)); return 0.5f * y * (1.f + t); }

__device__ __forceinline__ void gla_simple(const Ctx& c, int b, const float* gbias, const float* ogain) {
    LAS float* sQ = (LAS float*)c.lds; LAS float* sK = sQ + 16 * 256; LAS float* sA = sK + 16 * 256; LAS float* sO = sA + 16 * 256; LAS float* sV = sO + 16 * 512;
    const int tid = c.tid, h = tid >> 7, lane = c.lane;
    float S[64];
#pragma unroll
    for (int i = 0; i < 64; ++i) S[i] = 0.f;
    const float og0 = ogain[2 * lane], og1 = ogain[2 * lane + 1];
    for (int tc = 0; tc < SEQ / 16; ++tc) {
        const size_t tok0 = (size_t)b * SEQ + tc * 16;
        __syncthreads();
        for (int idx = tid; idx < 16 * 256; idx += NTHR) { const int s = idx >> 8, ci = idx & 255; const bf16_t* row = c.proj + (tok0 + s) * NP;
            sQ[idx] = bf2f(row[C_QA + ci]); sK[idx] = bf2f(row[C_KA + ci]);
            sA[idx] = __expf(logsigmoidf_(bf2f(row[C_GP + ci]) + gbias[ci]) * (1.f / 16.f)); }
#pragma unroll
        for (int s = 0; s < 16; ++s) sV[s * 512 + tid] = bf2f(c.proj[(tok0 + s) * NP + C_VA + tid]);
        __syncthreads();
        for (int s = 0; s < 16; ++s) {
            const float v = sV[s * 512 + tid]; float o = 0.f;
            const LAS f32x4* a4 = (const LAS f32x4*)(sA + s * 256 + h * 64); const LAS f32x4* k4 = (const LAS f32x4*)(sK + s * 256 + h * 64); const LAS f32x4* q4 = (const LAS f32x4*)(sQ + s * 256 + h * 64);
#pragma unroll
            for (int d = 0; d < 16; ++d) { const f32x4 a = a4[d], k = k4[d], q = q4[d];
                S[4 * d + 0] = S[4 * d + 0] * a.x + k.x * v; o += q.x * S[4 * d + 0];
                S[4 * d + 1] = S[4 * d + 1] * a.y + k.y * v; o += q.y * S[4 * d + 1];
                S[4 * d + 2] = S[4 * d + 2] * a.z + k.z * v; o += q.z * S[4 * d + 2];
                S[4 * d + 3] = S[4 * d + 3] * a.w + k.w * v; o += q.w * S[4 * d + 3]; }
            sO[s * 512 + tid] = o;
        }
        __syncthreads();
#pragma unroll 2
        for (int k = 0; k < 8; ++k) { const int rr = c.wave * 8 + k, s = rr >> 2, hh = rr & 3;
            const float o0 = sO[s * 512 + hh * 128 + 2 * lane], o1 = sO[s * 512 + hh * 128 + 2 * lane + 1];
            const float rs = rsqf_(wave_sum(o0 * o0 + o1 * o1) * (1.f / 128.f) + RMS_EPS);
            unsigned* pp = (unsigned*)(c.proj + (tok0 + s) * NP + C_OG + hh * 128) + lane;
            const unsigned u = *pp; const float g0 = bflo(u), g1 = bfhi(u);
            *pp = pk2(o0 * rs * og0 * g0 * sigmoidf_(g0), o1 * rs * og1 * g1 * sigmoidf_(g1)); }
    }
}

__device__ __forceinline__ void lru_simple(const Ctx& c, int b, const float* convw, const float* convb, const float* wa_, const float* ba_, const float* wx_, const float* bx_, const float* lam_) {
    const int ch = c.tid, n = c.wave, lane = c.lane;
    LAS float* sX = (LAS float*)(c.lds + n * 4096);
    const float* wap = wa_ + n * 4096 + lane; const float* wxp = wx_ + n * 4096 + lane;
    const float cw0 = convw[ch], cw1 = convw[512 + ch], cw2 = convw[1024 + ch], cw3 = convw[1536 + ch], cb = convb[ch], ba = ba_[ch], bx = bx_[ch];
    const float lam = lam_[ch]; const float c8 = 8.f * (fmaxf(-lam, 0.f) + log1pf(__expf(-fabsf(lam))));
    float xm1 = 0.f, xm2 = 0.f, xm3 = 0.f, hs = 0.f;
    for (int tc = 0; tc < SEQ / 16; ++tc) {
        const size_t tok0 = (size_t)b * SEQ + tc * 16;
        float xc[16], yv[16], ar[16], ai[16];
#pragma unroll
        for (int s = 0; s < 16; ++s) { xc[s] = bf2f(c.proj[(tok0 + s) * NP + C_XB + ch]); yv[s] = bf2f(c.proj[(tok0 + s) * NP + C_YB + ch]); }
#pragma unroll
        for (int s = 0; s < 16; ++s) { const float x = xc[s]; xc[s] = cb + cw0 * xm3 + cw1 * xm2 + cw2 * xm1 + cw3 * x; xm3 = xm2; xm2 = xm1; xm1 = x; sX[s * 64 + lane] = xc[s]; ar[s] = ba; ai[s] = bx; }
        LDS_WAIT(); asm volatile("" ::: "memory"); __builtin_amdgcn_wave_barrier();
#pragma unroll 2
        for (int k = 0; k < 64; ++k) { const float wa = wap[k * 64], wx = wxp[k * 64];
#pragma unroll
            for (int s = 0; s < 16; ++s) { const float x = sX[s * 64 + k]; ar[s] += x * wa; ai[s] += x * wx; } }
#pragma unroll
        for (int s = 0; s < 16; ++s) {
            const float r = sigmoidf_(ar[s]), ig = sigmoidf_(ai[s]);
            const float a = __expf(-c8 * r);
            const float u = sqrtf(fmaxf(1.f - a * a, 0.f)) * ig * xc[s];
            hs = a * hs + u;
            c.proj[(tok0 + s) * NP + C_YB + ch] = (bf16_t)f2bf(hs * gelu_tanh(yv[s]));
        }
        LDS_WAIT(); asm volatile("" ::: "memory"); __builtin_amdgcn_wave_barrier();
    }
}

__device__ __forceinline__ void attn_simple(const Ctx& c, int aw, int NAW) {
    const int lane = c.lane;
    for (int task = aw; task < TC * 4; task += NAW) {
        const int tok = task >> 2, h = task & 3, t = tok & (SEQ - 1);
        float ml = -INFINITY, wsum = 0.f, acc0 = 0.f, acc1 = 0.f;
#pragma unroll 1
        for (int p = 0; p < 3; ++p) {
            const int dsh = 2 * p, i = t >> dsh, nk = i + 1 < 129 ? i + 1 : 129;
            const bf16_t* qrow = c.proj + (size_t)tok * NP + C_QKV + (p * 4 + h) * 128;
            const int kcol = C_QKV + (12 + p * 4 + h) * 128, vcol = C_QKV + (24 + p * 4 + h) * 128;
            float sc[3];
#pragma unroll
            for (int r = 0; r < 3; ++r) {
                sc[r] = -INFINITY;
                if (64 * r < nk) {
                    const int m = 64 * r + lane; const bool valid = m < nk;
                    const bf16_t* krow = c.proj + (size_t)(tok - ((valid ? m : 0) << dsh)) * NP + kcol;
                    float s = 0.f;
#pragma unroll 1
                    for (int cb = 0; cb < 4; ++cb) {
                        u32x4 kq[4], qq[4];
#pragma unroll
                        for (int j = 0; j < 4; ++j) { kq[j] = *((const u32x4*)krow + cb * 4 + j); qq[j] = *((const u32x4*)qrow + cb * 4 + j); }
#pragma unroll
                        for (int j = 0; j < 4; ++j) {
                            s += bflo(kq[j].x) * bflo(qq[j].x) + bfhi(kq[j].x) * bfhi(qq[j].x) + bflo(kq[j].y) * bflo(qq[j].y) + bfhi(kq[j].y) * bfhi(qq[j].y)
                               + bflo(kq[j].z) * bflo(qq[j].z) + bfhi(kq[j].z) * bfhi(qq[j].z) + bflo(kq[j].w) * bflo(qq[j].w) + bfhi(kq[j].w) * bfhi(qq[j].w); }
                    }
                    sc[r] = valid ? s * 0.08838834764831845f : -INFINITY;
                }
            }
            const float mx = wave_max(fmaxf(sc[0], fmaxf(sc[1], sc[2])));
            float pr[3];
#pragma unroll
            for (int r = 0; r < 3; ++r) pr[r] = __expf(sc[r] - mx);
            const float den = wave_sum(pr[0] + pr[1] + pr[2]);
            float o0 = 0.f, o1 = 0.f;
#pragma unroll
            for (int r = 0; r < 3; ++r) {
                const int cnt = nk - 64 * r < 64 ? nk - 64 * r : 64;
                if (cnt > 0) {
                const unsigned* vb = (const unsigned*)(c.proj + (size_t)(tok - ((64 * r) << dsh)) * NP + vcol) + lane;
#pragma unroll 4
                for (int mm = 0; mm < cnt; ++mm) {
                    const float pm = __int_as_float(__builtin_amdgcn_readlane(__float_as_int(pr[r]), mm));
                    const unsigned u = *(const unsigned*)((const char*)vb - (size_t)(mm << dsh) * NP * 2);
                    o0 += pm * bflo(u); o1 += pm * bfhi(u); }
                }
            }
            const float inv = rcpf_(den), lse = mx + __logf(den);
            const float nml = fmaxf(ml, lse), sc_old = __expf(ml - nml), w = __expf(lse - nml);
            acc0 = acc0 * sc_old + w * o0 * inv; acc1 = acc1 * sc_old + w * o1 * inv; wsum = wsum * sc_old + w; ml = nml;
        }
        const float wi = rcpf_(wsum);
        unsigned* op = (unsigned*)(c.proj + (size_t)tok * NP + C_QKV + h * 128) + lane;
        *op = pk2(acc0 * wi, acc1 * wi);
    }
}

typedef unsigned short u16x4 __attribute__((ext_vector_type(4)));
__device__ __forceinline__ unsigned offb(unsigned row, unsigned ch) { return 256u * row + 16u * (ch ^ (((row & 3u) << 2) | ((row >> 2) & 3u))); }
constexpr int ATT_UNITS_PER_SEQ = 3 * 4 * 16;
__device__ __forceinline__ void attn_unit(const Ctx& c, int unit, float* lse_buf, const float* qgain, const float* kgain, const float* rope_tab  ) {
    const int tid = c.tid, lane = c.lane, w = c.wave;
    const int b = unit / ATT_UNITS_PER_SEQ, rem = unit % ATT_UNITS_PER_SEQ, p = rem / 64, h = (rem / 16) & 3, qb = rem & 15;
    const int dsh = 2 * p, nblk = 16 >> dsh;
    const int r = qb / nblk, blk = qb % nblk;
    const size_t tok0 = (size_t)b * SEQ + r;
    const int qcol = C_QKV + (p * 4 + h) * 128, kcol = C_QKV + (12 + p * 4 + h) * 128, vcol = C_QKV + (24 + p * 4 + h) * 128;
    LAS unsigned char* sK = c.lds; LAS unsigned char* sV = c.lds + 65536;
    const unsigned rrow = (unsigned)tid >> 1, rps = (unsigned)tid & 1u;
    f32x4 rc0, rc1, rs0, rs1;
    { int srow = (blk - 1) * 128 + (int)rrow; if (srow < 0) srow += 128;
      const float* rt = rope_tab + (tok0 + ((size_t)srow << dsh)) * 32 + 8 * rps;
      rc0 = *(const f32x4*)rt; rc1 = *(const f32x4*)(rt + 4); rs0 = *(const f32x4*)(rt + 16); rs1 = *(const f32x4*)(rt + 20); }
    asm volatile("" ::: "memory");
    const int it0 = blk == 0 ? 4 : 0;
#pragma unroll
    for (int it = 0; it < 8; ++it) if (it >= it0) { const int q = w + 8 * it; const unsigned n = 64u * q + lane, row = n >> 4, cs = n & 15u, ch = cs ^ (((row & 3u) << 2) | ((row >> 2) & 3u));
        const int srow = (blk - 1) * 128 + (int)row;
        const bf16_t* g = c.proj + (tok0 + ((size_t)srow << dsh)) * NP + kcol + ch * 8;
        __builtin_amdgcn_global_load_lds((const unsigned*)g, (LAS unsigned*)(sK + 1024 * q), 16, 0, 0); }
    asm volatile("" ::: "memory");
    const int qq = lane & 15, g = lane >> 4, qi = 16 * w + qq;
    const size_t qtok = tok0 + ((size_t)(blk * 128 + qi) << dsh);
    bf16x8 qf[4];
    {
        u32x4 qr[4];
#pragma unroll
        for (int s = 0; s < 4; ++s) qr[s] = *(const u32x4*)(c.proj + qtok * NP + qcol + 32 * s + 8 * g);
        const f32x4* rt = (const f32x4*)(rope_tab + qtok * 32 + 8 * (g & 1));
        const f32x4 c0 = rt[0], c1 = rt[1], s0 = rt[4], s1 = rt[5];
        float qv[4][8]; float ss = 0.f;
#pragma unroll
        for (int s = 0; s < 4; ++s) { const unsigned wv[4] = {qr[s].x, qr[s].y, qr[s].z, qr[s].w};
#pragma unroll
            for (int k = 0; k < 4; ++k) { qv[s][2 * k] = bflo(wv[k]); qv[s][2 * k + 1] = bfhi(wv[k]); ss += qv[s][2 * k] * qv[s][2 * k] + qv[s][2 * k + 1] * qv[s][2 * k + 1]; } }
        ss += swz_xor<16>(ss);
        { const auto rr = __builtin_amdgcn_permlane32_swap(__float_as_uint(ss), __float_as_uint(ss), false, false); ss = __uint_as_float(rr[0]) + __uint_as_float(rr[1]); }
        const float rs = rsqf_(ss * (1.f / 128.f) + RMS_EPS);
#pragma unroll
        for (int s = 0; s < 4; ++s) { const f32x4 g0 = *(const f32x4*)(qgain + 32 * s + 8 * g), g1 = *(const f32x4*)(qgain + 32 * s + 8 * g + 4);
            const float gg[8] = {g0.x, g0.y, g0.z, g0.w, g1.x, g1.y, g1.z, g1.w};
#pragma unroll
            for (int j = 0; j < 8; ++j) qv[s][j] *= rs * gg[j]; }
        { const float cs8[8] = {c0.x, c0.y, c0.z, c0.w, c1.x, c1.y, c1.z, c1.w}, sn8[8] = {s0.x, s0.y, s0.z, s0.w, s1.x, s1.y, s1.z, s1.w};
          const float sgn = (g & 2) ? 1.f : -1.f;
#pragma unroll
          for (int j = 0; j < 8; ++j) { const auto rr = __builtin_amdgcn_permlane32_swap(__float_as_uint(qv[0][j]), __float_as_uint(qv[0][j]), false, false);
              const float other = (g & 2) ? __uint_as_float(rr[0]) : __uint_as_float(rr[1]);
              qv[0][j] = qv[0][j] * cs8[j] + sgn * other * sn8[j]; } }
#pragma unroll
        for (int s = 0; s < 4; ++s) { u32x4 pw; pw.x = pk2(qv[s][0], qv[s][1]); pw.y = pk2(qv[s][2], qv[s][3]); pw.z = pk2(qv[s][4], qv[s][5]); pw.w = pk2(qv[s][6], qv[s][7]); qf[s] = __builtin_bit_cast(bf16x8, pw); }
    }
    asm volatile("" ::: "memory");
#pragma unroll
    for (int it = 0; it < 8; ++it) if (it >= it0) { const int q = w + 8 * it; const unsigned n = 64u * q + lane, row = n >> 4, cs = n & 15u, ch = cs ^ (((row & 3u) << 2) | ((row >> 2) & 3u));
        const int srow = (blk - 1) * 128 + (int)row;
        const bf16_t* g2 = c.proj + (tok0 + ((size_t)srow << dsh)) * NP + vcol + ch * 8;
        __builtin_amdgcn_global_load_lds((const unsigned*)g2, (LAS unsigned*)(sV + 1024 * q), 16, 0, 0); }
    if (blk == 0) asm volatile("s_waitcnt vmcnt(4)" ::: "memory"); else asm volatile("s_waitcnt vmcnt(8)" ::: "memory");
    __syncthreads();
    LAS float* sRS = (LAS float*)(c.lds + MISC_OFF + 2048);
    {
        const int c16 = tid & 15, grp = tid >> 4;
        const f32x4 kg0 = *(const f32x4*)(kgain + 8 * c16), kg1 = *(const f32x4*)(kgain + 8 * c16 + 4);
        const float kg[8] = {kg0.x, kg0.y, kg0.z, kg0.w, kg1.x, kg1.y, kg1.z, kg1.w};
#pragma unroll 4
        for (int it = it0; it < 8; ++it) { const unsigned row = 32u * it + grp;
            LAS u32x4* kp_ = (LAS u32x4*)(sK + offb(row, c16));
            const u32x4 kr = *kp_; const unsigned wv[4] = {kr.x, kr.y, kr.z, kr.w};
            float kv[8]; float ss = 0.f;
#pragma unroll
            for (int k = 0; k < 4; ++k) { kv[2 * k] = bflo(wv[k]); kv[2 * k + 1] = bfhi(wv[k]); ss += kv[2 * k] * kv[2 * k] + kv[2 * k + 1] * kv[2 * k + 1]; }
            ss += swz_xor<1>(ss); ss += swz_xor<2>(ss); ss += swz_xor<4>(ss); ss += swz_xor<8>(ss);
            const float rs = rsqf_(ss * (1.f / 128.f) + RMS_EPS);
            if (c16 == 0) sRS[row] = rs;
            if (c16 >= 4) { u32x4 ko; ko.x = pk2(kv[0] * rs * kg[0], kv[1] * rs * kg[1]); ko.y = pk2(kv[2] * rs * kg[2], kv[3] * rs * kg[3]); ko.z = pk2(kv[4] * rs * kg[4], kv[5] * rs * kg[5]); ko.w = pk2(kv[6] * rs * kg[6], kv[7] * rs * kg[7]); *kp_ = ko; } }
    }
    __syncthreads();
    {
        const f32x4 ga0 = *(const f32x4*)(kgain + 8 * rps), ga1 = *(const f32x4*)(kgain + 8 * rps + 4), gb0 = *(const f32x4*)(kgain + 16 + 8 * rps), gb1 = *(const f32x4*)(kgain + 20 + 8 * rps);
        const float ga[8] = {ga0.x, ga0.y, ga0.z, ga0.w, ga1.x, ga1.y, ga1.z, ga1.w}, gb[8] = {gb0.x, gb0.y, gb0.z, gb0.w, gb1.x, gb1.y, gb1.z, gb1.w};
        const float cs8[8] = {rc0.x, rc0.y, rc0.z, rc0.w, rc1.x, rc1.y, rc1.z, rc1.w}, sn8[8] = {rs0.x, rs0.y, rs0.z, rs0.w, rs1.x, rs1.y, rs1.z, rs1.w};
        if (blk > 0 || rrow >= 128u) {
        LAS u32x4* p1 = (LAS u32x4*)(sK + offb(rrow, rps)); LAS u32x4* p2 = (LAS u32x4*)(sK + offb(rrow, rps + 2));
        const u32x4 a = *p1, b2 = *p2; const float rs = sRS[rrow];
        const unsigned wa[4] = {a.x, a.y, a.z, a.w}, wb[4] = {b2.x, b2.y, b2.z, b2.w};
        float o1[8], o2[8];
#pragma unroll
        for (int k = 0; k < 4; ++k) {
#pragma unroll
            for (int e = 0; e < 2; ++e) { const int j = 2 * k + e; const float x1 = (e ? bfhi(wa[k]) : bflo(wa[k])) * rs * ga[j], x2 = (e ? bfhi(wb[k]) : bflo(wb[k])) * rs * gb[j];
                o1[j] = x1 * cs8[j] - x2 * sn8[j]; o2[j] = x2 * cs8[j] + x1 * sn8[j]; } }
        u32x4 w1, w2; w1.x = pk2(o1[0], o1[1]); w1.y = pk2(o1[2], o1[3]); w1.z = pk2(o1[4], o1[5]); w1.w = pk2(o1[6], o1[7]); w2.x = pk2(o2[0], o2[1]); w2.y = pk2(o2[2], o2[3]); w2.z = pk2(o2[4], o2[5]); w2.w = pk2(o2[6], o2[7]);
        *p1 = w1; *p2 = w2; }
    }
    asm volatile("s_waitcnt vmcnt(0)" ::: "memory");
    __syncthreads();
    const int ks0 = w >> 1, nskip = blk == 0 ? 4 : 0;
    f32x4 st[5][2];
    const unsigned krow_l = 8u * (qq >> 2) + (qq & 3u);
    LAS unsigned char* ka[2][4];
#pragma unroll
    for (int T = 0; T < 2; ++T)
#pragma unroll
        for (int s = 0; s < 4; ++s) ka[T][s] = sK + offb(32u * ks0 + krow_l + 4u * T, 4 * s + g);
#pragma unroll
    for (int n = 0; n < 5; ++n)
#pragma unroll
        for (int T = 0; T < 2; ++T) { f32x4 a = {0.f, 0.f, 0.f, 0.f};
            if (ks0 + n >= nskip) {
#pragma unroll
            for (int s = 0; s < 4; ++s) { const bf16x8 kf = *(const LAS bf16x8*)(ka[T][s] + 8192 * n); a = __builtin_amdgcn_mfma_f32_16x16x32_bf16(kf, qf[s], a, 0, 0, 0); } }
            st[n][T] = a; }
    const float SC = 0.08838834764831845f * 1.4426950408889634f;
    float mx = -INFINITY;
#pragma unroll
    for (int n = 0; n < 5; ++n)
#pragma unroll
        for (int T = 0; T < 2; ++T)
#pragma unroll
            for (int i = 0; i < 4; ++i) { const int kj = 32 * (ks0 + n) + 8 * g + 4 * T + i; const bool ok = (kj >= qi) && (kj <= qi + 128) && (blk > 0 || kj >= 128);
                const float v = ok ? st[n][T][i] : -INFINITY; st[n][T][i] = v; mx = fmaxf(mx, v); }
    mx = fmaxf(mx, swz_xor<16>(mx));
    { const auto rr = __builtin_amdgcn_permlane32_swap(__float_as_uint(mx), __float_as_uint(mx), false, false); mx = fmaxf(__uint_as_float(rr[0]), __uint_as_float(rr[1])); }
    float sum = 0.f;
#pragma unroll
    for (int n = 0; n < 5; ++n)
#pragma unroll
        for (int T = 0; T < 2; ++T)
#pragma unroll
            for (int i = 0; i < 4; ++i) { const float e = __builtin_amdgcn_exp2f((st[n][T][i] - mx) * SC); st[n][T][i] = e; sum += e; }
    sum += swz_xor<16>(sum);
    { const auto rr = __builtin_amdgcn_permlane32_swap(__float_as_uint(sum), __float_as_uint(sum), false, false); sum = __uint_as_float(rr[0]) + __uint_as_float(rr[1]); }
    const float inv = rcpf_(sum);
    f32x4 ot[8];
#pragma unroll
    for (int cc = 0; cc < 8; ++cc) ot[cc] = (f32x4){0.f, 0.f, 0.f, 0.f};
    const unsigned tq = (unsigned)qq >> 2, tp = (unsigned)qq & 3u;
    const unsigned vbase = (unsigned)(size_t)sV;
    unsigned va[2][8];
#pragma unroll
    for (int t = 0; t < 2; ++t)
#pragma unroll
        for (int cc = 0; cc < 8; ++cc) va[t][cc] = vbase + offb(32u * ks0 + 8u * g + 4u * t + tq, 2 * cc + (tp >> 1)) + 8u * (tp & 1u);
#pragma unroll
    for (int n = 0; n < 5; ++n) if (ks0 + n >= nskip) {
        u32x4 pw; pw.x = pg8::cvt_pk_bf16(st[n][0][0], st[n][0][1]); pw.y = pg8::cvt_pk_bf16(st[n][0][2], st[n][0][3]); pw.z = pg8::cvt_pk_bf16(st[n][1][0], st[n][1][1]); pw.w = pg8::cvt_pk_bf16(st[n][1][2], st[n][1][3]);
        const bf16x8 pf = __builtin_bit_cast(bf16x8, pw);
        u16x4 v0[8], v1[8];
        asm volatile("ds_read_b64_tr_b16 %0, %16 offset:%32\n\tds_read_b64_tr_b16 %8, %24 offset:%32\n\t"
                     "ds_read_b64_tr_b16 %1, %17 offset:%32\n\tds_read_b64_tr_b16 %9, %25 offset:%32\n\t"
                     "ds_read_b64_tr_b16 %2, %18 offset:%32\n\tds_read_b64_tr_b16 %10, %26 offset:%32\n\t"
                     "ds_read_b64_tr_b16 %3, %19 offset:%32\n\tds_read_b64_tr_b16 %11, %27 offset:%32\n\t"
                     "ds_read_b64_tr_b16 %4, %20 offset:%32\n\tds_read_b64_tr_b16 %12, %28 offset:%32\n\t"
                     "ds_read_b64_tr_b16 %5, %21 offset:%32\n\tds_read_b64_tr_b16 %13, %29 offset:%32\n\t"
                     "ds_read_b64_tr_b16 %6, %22 offset:%32\n\tds_read_b64_tr_b16 %14, %30 offset:%32\n\t"
                     "ds_read_b64_tr_b16 %7, %23 offset:%32\n\tds_read_b64_tr_b16 %15, %31 offset:%32\n\t"
                     "s_waitcnt lgkmcnt(0)"
                     : "=&v"(v0[0]), "=&v"(v0[1]), "=&v"(v0[2]), "=&v"(v0[3]), "=&v"(v0[4]), "=&v"(v0[5]), "=&v"(v0[6]), "=&v"(v0[7]),
                       "=&v"(v1[0]), "=&v"(v1[1]), "=&v"(v1[2]), "=&v"(v1[3]), "=&v"(v1[4]), "=&v"(v1[5]), "=&v"(v1[6]), "=&v"(v1[7])
                     : "v"(va[0][0]), "v"(va[0][1]), "v"(va[0][2]), "v"(va[0][3]), "v"(va[0][4]), "v"(va[0][5]), "v"(va[0][6]), "v"(va[0][7]),
                       "v"(va[1][0]), "v"(va[1][1]), "v"(va[1][2]), "v"(va[1][3]), "v"(va[1][4]), "v"(va[1][5]), "v"(va[1][6]), "v"(va[1][7]), "i"(8192 * n) : "memory");
#pragma unroll
        for (int cc = 0; cc < 8; ++cc) {
            bf16x8 vf; vf[0] = (short)v0[cc][0]; vf[1] = (short)v0[cc][1]; vf[2] = (short)v0[cc][2]; vf[3] = (short)v0[cc][3]; vf[4] = (short)v1[cc][0]; vf[5] = (short)v1[cc][1]; vf[6] = (short)v1[cc][2]; vf[7] = (short)v1[cc][3];
            ot[cc] = __builtin_amdgcn_mfma_f32_16x16x32_bf16(vf, pf, ot[cc], 0, 0, 0);
        }
    }
    bf16_t* orow = c.proj + qtok * NP + qcol;
#pragma unroll
    for (int cc = 0; cc < 8; ++cc) { u32x2 o; o.x = pg8::cvt_pk_bf16(ot[cc][0] * inv, ot[cc][1] * inv); o.y = pg8::cvt_pk_bf16(ot[cc][2] * inv, ot[cc][3] * inv); *(u32x2*)(orow + 16 * cc + 4 * g) = o; }
    if (g == 0) lse_buf[qtok * 12 + p * 4 + h] = mx * 0.08838834764831845f + __logf(sum);
    __syncthreads();
}

__device__ __forceinline__ void phase_attn_combine(const Ctx& c, const float* lse_buf) {
    const int gw = c.bid * NWAVES + c.wave, NGW = c.G * NWAVES, lane = c.lane;
    for (int tok = gw; tok < TC; tok += NGW) {
        const float* ls = lse_buf + (size_t)tok * 12;
        const bf16_t* row = c.proj + (size_t)tok * NP + C_QKV;
        unsigned u[3][4]; float l[12];
#pragma unroll
        for (int k = 0; k < 12; ++k) l[k] = ls[k];
#pragma unroll
        for (int p = 0; p < 3; ++p)
#pragma unroll
            for (int h = 0; h < 4; ++h) u[p][h] = *((const unsigned*)(row + (4 * p + h) * 128) + lane);
#pragma unroll
        for (int h = 0; h < 4; ++h) {
            const float l0 = l[h], l1 = l[4 + h], l2 = l[8 + h], ml = fmaxf(l0, fmaxf(l1, l2));
            const float w0 = __expf(l0 - ml), w1 = __expf(l1 - ml), w2 = __expf(l2 - ml), wi = rcpf_(w0 + w1 + w2);
            *((unsigned*)(c.brx + (size_t)2 * TC * 512 + (size_t)tok * 512 + h * 128) + lane) =
                pk2((w0 * bflo(u[0][h]) + w1 * bflo(u[1][h]) + w2 * bflo(u[2][h])) * wi, (w0 * bfhi(u[0][h]) + w1 * bfhi(u[1][h]) + w2 * bfhi(u[2][h])) * wi);
        }
    }
}

__device__ __forceinline__ int crow(int reg, int hh) { return (reg & 3) + 8 * (reg >> 2) + 4 * hh; }
typedef float f32x16 __attribute__((ext_vector_type(16)));
__device__ __forceinline__ unsigned tr_addr32(unsigned lane, unsigned rowbase, unsigned cblk, unsigned t, bool perm) {
    const unsigned hh = lane >> 5, blk = (lane >> 4) & 1u, q = (lane & 15u) >> 2, p = lane & 3u;
    const unsigned row = rowbase + (perm ? 8u * t + 4u * hh : 8u * hh + 4u * t) + q;
    return offb(row, 4u * cblk + 2u * blk + (p >> 1)) + 8u * (p & 1u);
}
__device__ __forceinline__ bf16x8 tr_frag(unsigned a0, unsigned a1) {
    u16x4 v0, v1;
    asm volatile("ds_read_b64_tr_b16 %0, %2\n\tds_read_b64_tr_b16 %1, %3\n\ts_waitcnt lgkmcnt(0)" : "=&v"(v0), "=&v"(v1) : "v"(a0), "v"(a1) : "memory");
    bf16x8 f; f[0] = (short)v0[0]; f[1] = (short)v0[1]; f[2] = (short)v0[2]; f[3] = (short)v0[3]; f[4] = (short)v1[0]; f[5] = (short)v1[1]; f[6] = (short)v1[2]; f[7] = (short)v1[3];
    return f;
}
__device__ __forceinline__ void tr_frag4(const unsigned (&a)[8], bf16x8 (&f)[4]) {
    u16x4 v[8];
    asm volatile("ds_read_b64_tr_b16 %0, %8\n\tds_read_b64_tr_b16 %1, %9\n\tds_read_b64_tr_b16 %2, %10\n\tds_read_b64_tr_b16 %3, %11\n\t"
                 "ds_read_b64_tr_b16 %4, %12\n\tds_read_b64_tr_b16 %5, %13\n\tds_read_b64_tr_b16 %6, %14\n\tds_read_b64_tr_b16 %7, %15\n\ts_waitcnt lgkmcnt(0)"
                 : "=&v"(v[0]), "=&v"(v[1]), "=&v"(v[2]), "=&v"(v[3]), "=&v"(v[4]), "=&v"(v[5]), "=&v"(v[6]), "=&v"(v[7])
                 : "v"(a[0]), "v"(a[1]), "v"(a[2]), "v"(a[3]), "v"(a[4]), "v"(a[5]), "v"(a[6]), "v"(a[7]) : "memory");
#pragma unroll
    for (int k = 0; k < 4; ++k) { f[k][0] = (short)v[2 * k][0]; f[k][1] = (short)v[2 * k][1]; f[k][2] = (short)v[2 * k][2]; f[k][3] = (short)v[2 * k][3];
        f[k][4] = (short)v[2 * k + 1][0]; f[k][5] = (short)v[2 * k + 1][1]; f[k][6] = (short)v[2 * k + 1][2]; f[k][7] = (short)v[2 * k + 1][3]; }
}
constexpr int GLA_QK = 0, GLA_KD = 16384, GLA_V = 32768  , GLA_ST = 65536  , GLA_O = 102400  , GLA_SEG = 136192  , GLA_DEC = 138240  ;
static_assert(GLA_DEC + 256 <= RING_BYTES, "gla lds");
__device__ __forceinline__ void gla_unit(const Ctx& c, int unit, const float* gbias, const float* ogain) {
    const int tid = c.tid, lane = c.lane, w = c.wave;
    const int b = unit >> 2, h = unit & 3;
    LAS unsigned char* L = c.lds;
    const unsigned hh = lane >> 5, r31 = lane & 31;
    const int ti = w >> 2, tv = w & 3;
    f32x16 St;
#pragma unroll
    for (int i = 0; i < 16; ++i) St[i] = 0.f;
    for (int i = tid; i < 18432 / 4; i += NTHR) ((LAS unsigned*)(L + GLA_ST))[i] = 0u;
    const float bias_d = gbias[h * 64 + lane];
    const int i3 = tid >> 3, seg = tid & 7;
    float gn[16];
#pragma unroll
    for (int k = 0; k < 16; ++k) gn[k] = ogain[16 * seg + k];
    const size_t tokb = (size_t)b * SEQ;
    unsigned short pq[8], pk[8], pg[8];
    u32x4 ogc0, ogc1, ogn0, ogn1;
#define GLA_PREFETCH(n) do { _Pragma("unroll") for (int rr = 0; rr < 8; ++rr) { const bf16_t* row = c.proj + (tokb + (n) * 64 + 8 * w + rr) * NP + h * 64 + lane; \
        pq[rr] = row[C_QA]; pk[rr] = row[C_KA]; pg[rr] = row[C_GP]; } } while (0)
#define GLA_OG(n, d0, d1) do { const bf16_t* ogp = c.proj + (tokb + (n) * 64 + i3) * NP + C_OG + h * 128 + 16 * seg; d0 = *(const u32x4*)ogp; d1 = *((const u32x4*)ogp + 1); } while (0)
#define GLA_VDMA(n) do { _Pragma("unroll") for (int it = 0; it < 2; ++it) { const int q = w + 8 * it; const unsigned nn = 64u * q + lane, row = nn >> 4, cs = nn & 15u, ch = cs ^ (((row & 3u) << 2) | ((row >> 2) & 3u)); \
        __builtin_amdgcn_global_load_lds((const unsigned*)(c.proj + (tokb + (n) * 64 + row) * NP + C_VA + h * 128 + ch * 8), (LAS unsigned*)(L + GLA_V + ((n) & 1) * 16384 + 1024 * q), 16, 0, 0); } } while (0)
#define CB() asm volatile("" ::: "memory")
    GLA_PREFETCH(0); CB(); GLA_OG(0, ogc0, ogc1); CB(); GLA_VDMA(0); CB(); GLA_VDMA(1); CB();
    for (int n = 0; n < SEQ / 64; ++n) {
        LAS unsigned char* STr = L + GLA_ST + (n & 1) * 18432; LAS unsigned char* STw = L + GLA_ST + ((n + 1) & 1) * 18432;
        LAS unsigned char* Vb = L + GLA_V + (n & 1) * 16384;
        float cl[8], qv[8], kv[8];
        { float run = 0.f;
#pragma unroll
          for (int rr = 0; rr < 8; ++rr) { const float g = bf2f(pg[rr]) + bias_d; run += (fminf(g, 0.f) - __logf(1.f + __expf(-fabsf(g)))) * (1.f / 16.f); cl[rr] = run; qv[rr] = bf2f(pq[rr]); kv[rr] = bf2f(pk[rr]); }
          ((LAS float*)(L + GLA_SEG))[w * 64 + lane] = run; }
        __syncthreads();
        { float pre = 0.f, tot = 0.f;
#pragma unroll
          for (int s = 0; s < 8; ++s) { const float v = ((LAS float*)(L + GLA_SEG))[s * 64 + lane]; tot += v; pre += (s < w) ? v : 0.f; }
          const float etot = __expf(tot);
          if (w == 0) ((LAS float*)(L + GLA_DEC))[lane] = etot;
#pragma unroll
          for (int rr = 0; rr < 8; ++rr) { const float cum = pre + cl[rr]; const unsigned row = 8 * w + rr;
              const float e = __expf(cum), ei = rcpf_(e), ed = etot * ei;
              const unsigned o1 = offb(row, lane >> 3) + (lane & 7) * 2, o2 = offb(row, 8 + (lane >> 3)) + (lane & 7) * 2;
              *(LAS unsigned short*)(L + GLA_QK + o1) = (unsigned short)f2bf(qv[rr] * e);
              *(LAS unsigned short*)(L + GLA_QK + o2) = (unsigned short)f2bf(kv[rr] * ei);
              *(LAS unsigned short*)(L + GLA_KD + o1) = (unsigned short)f2bf(kv[rr] * ed); } }
        if (n == 0) asm volatile("s_waitcnt vmcnt(2)" ::: "memory"); else asm volatile("s_waitcnt vmcnt(4)" ::: "memory");
        __syncthreads();
        CB();
        if (n + 1 < SEQ / 64) { GLA_OG(n + 1, ogn0, ogn1); CB(); GLA_PREFETCH(n + 1); }
        CB();
        bf16x8 qdf[4];
#pragma unroll
        for (int s = 0; s < 4; ++s) qdf[s] = *(const LAS bf16x8*)(L + GLA_QK + offb(32 * ti + r31, 2 * s + hh));
        f32x16 Z;
#pragma unroll
        for (int i = 0; i < 16; ++i) Z[i] = 0.f;
        { bf16x8 sf[4];
#pragma unroll
          for (int s = 0; s < 4; ++s) sf[s] = *(const LAS bf16x8*)(STr + (32 * tv + r31) * 144 + 32 * s + 16 * hh);
#pragma unroll
          for (int s = 0; s < 4; ++s) Z = __builtin_amdgcn_mfma_f32_32x32x16_bf16(qdf[s], sf[s], Z, 0, 0, 0); }
        const unsigned vb = (unsigned)(size_t)Vb;
#pragma unroll
        for (int tj = 0; tj < 2; ++tj) {
            if (tj <= ti) {
                bf16x8 kf[4];
#pragma unroll
                for (int s = 0; s < 4; ++s) kf[s] = *(const LAS bf16x8*)(L + GLA_QK + offb(32 * tj + r31, 8 + 2 * s + hh));
                unsigned va[8]; bf16x8 vf[4];
#pragma unroll
                for (int s = 0; s < 2; ++s) { va[2 * s] = vb + tr_addr32(lane, 32 * tj + 16 * s, tv, 0, true); va[2 * s + 1] = vb + tr_addr32(lane, 32 * tj + 16 * s, tv, 1, true);
                    va[4 + 2 * s] = va[2 * s]; va[5 + 2 * s] = va[2 * s + 1]; }
                tr_frag4(va, vf);
                f32x16 X;
#pragma unroll
                for (int i = 0; i < 16; ++i) X[i] = 0.f;
#pragma unroll
                for (int s = 0; s < 4; ++s) X = __builtin_amdgcn_mfma_f32_32x32x16_bf16(kf[s], qdf[s], X, 0, 0, 0);
                const int ig = 32 * ti + (int)r31;
#pragma unroll
                for (int i = 0; i < 16; ++i) X[i] = (ig >= 32 * tj + crow(i, hh)) ? X[i] : 0.f;
#pragma unroll
                for (int s = 0; s < 2; ++s) {
                    u32x4 pw; pw.x = pg8::cvt_pk_bf16(X[8 * s + 0], X[8 * s + 1]); pw.y = pg8::cvt_pk_bf16(X[8 * s + 2], X[8 * s + 3]); pw.z = pg8::cvt_pk_bf16(X[8 * s + 4], X[8 * s + 5]); pw.w = pg8::cvt_pk_bf16(X[8 * s + 6], X[8 * s + 7]);
                    Z = __builtin_amdgcn_mfma_f32_32x32x16_bf16(__builtin_bit_cast(bf16x8, pw), vf[s], Z, 0, 0, 0);
                }
            }
        }
#pragma unroll
        for (int i = 0; i < 16; ++i) ((LAS float*)(L + GLA_O))[(32 * ti + crow(i, hh)) * 132 + 32 * tv + r31] = Z[i];
        { const unsigned kb = (unsigned)(size_t)(L + GLA_KD);
          unsigned aa[8], ab[8]; bf16x8 af[4], bfr[4];
#pragma unroll
          for (int s = 0; s < 4; ++s) { aa[2 * s] = kb + tr_addr32(lane, 16 * s, ti, 0, false); aa[2 * s + 1] = kb + tr_addr32(lane, 16 * s, ti, 1, false);
              ab[2 * s] = vb + tr_addr32(lane, 16 * s, tv, 0, false); ab[2 * s + 1] = vb + tr_addr32(lane, 16 * s, tv, 1, false); }
          tr_frag4(aa, af); tr_frag4(ab, bfr);
#pragma unroll
          for (int i = 0; i < 16; ++i) St[i] *= ((LAS float*)(L + GLA_DEC))[32 * ti + crow(i, hh)];
#pragma unroll
          for (int s = 0; s < 4; ++s) St = __builtin_amdgcn_mfma_f32_32x32x16_bf16(af[s], bfr[s], St, 0, 0, 0); }
#pragma unroll
        for (int gq = 0; gq < 4; ++gq) { const float s0 = St[4 * gq], s1 = St[4 * gq + 1], s2 = St[4 * gq + 2], s3 = St[4 * gq + 3];
            u32x2 o; o.x = pk2(s0, s1); o.y = pk2(s2, s3);
            *(LAS u32x2*)(STw + (32 * tv + r31) * 144 + (32 * ti + 8 * gq + 4 * hh) * 2) = o; }
        __syncthreads();
        CB();
        if (n + 2 < SEQ / 64) GLA_VDMA(n + 2);
        CB();
        { const LAS f32x4* op = (const LAS f32x4*)(L + GLA_O + i3 * 528 + seg * 64);
          f32x4 o4[4]; float ss = 0.f;
#pragma unroll
          for (int k = 0; k < 4; ++k) { o4[k] = op[k]; ss += (o4[k].x * o4[k].x + o4[k].y * o4[k].y) + (o4[k].z * o4[k].z + o4[k].w * o4[k].w); }
          ss += swz_xor<1>(ss); ss += swz_xor<2>(ss); ss += swz_xor<4>(ss);
          const float rs = rsqf_(ss * (1.f / 128.f) + RMS_EPS);
          const unsigned ogw[8] = {ogc0.x, ogc0.y, ogc0.z, ogc0.w, ogc1.x, ogc1.y, ogc1.z, ogc1.w};
          unsigned ow[8];
#pragma unroll
          for (int k = 0; k < 8; ++k) { const float g0 = bflo(ogw[k]), g1 = bfhi(ogw[k]);
              const float a0 = o4[k >> 1][(2 * k) & 3] * rs * gn[2 * k] * g0 * sigmoidf_(g0), a1 = o4[k >> 1][(2 * k + 1) & 3] * rs * gn[2 * k + 1] * g1 * sigmoidf_(g1);
              ow[k] = pk2(a0, a1); }
          u32x4 w0, w1; w0.x = ow[0]; w0.y = ow[1]; w0.z = ow[2]; w0.w = ow[3]; w1.x = ow[4]; w1.y = ow[5]; w1.z = ow[6]; w1.w = ow[7];
          bf16_t* dst = c.brx + (tokb + n * 64 + i3) * 512 + h * 128 + 16 * seg;
          *(u32x4*)dst = w0; *((u32x4*)dst + 1) = w1; }
        CB();
        ogc0 = ogn0; ogc1 = ogn1;
    }
    asm volatile("s_waitcnt vmcnt(0)" ::: "memory");
    __syncthreads();
#undef GLA_PREFETCH
#undef GLA_OG
#undef GLA_VDMA
#undef CB
}

constexpr int LRU_X = 0  , LRU_R = 16384  , LRU_I = 32768, LRU_SP = 49152  , LRU_SH = 51200;
__device__ __forceinline__ void lru_unit(const Ctx& c, int unit, const float* convw, const float* convb, const float* wa_, const float* ba_, const float* wx_, const float* bx_, const float* lam_) {
    const int lane = c.lane, w = c.wave;
    const int b = unit >> 3, nb = unit & 7, ch = nb * 64 + lane;
    LAS unsigned char* L = c.lds;
    const unsigned hh = lane >> 5, r31 = lane & 31;
    const int gate = w >> 2, tt = (w >> 1) & 1, td = w & 1;
    bf16x8 wf[4];
    { const float* W = (gate ? wx_ : wa_) + (size_t)nb * 4096 + 32 * td + r31;
#pragma unroll
      for (int s = 0; s < 4; ++s) { float t8[8];
#pragma unroll
          for (int jj = 0; jj < 8; ++jj) t8[jj] = W[(16 * s + 8 * hh + jj) * 64];
          u32x4 pw; pw.x = pk2(t8[0], t8[1]); pw.y = pk2(t8[2], t8[3]); pw.z = pk2(t8[4], t8[5]); pw.w = pk2(t8[6], t8[7]); wf[s] = __builtin_bit_cast(bf16x8, pw); } }
    const float gbias = (gate ? bx_ : ba_)[nb * 64 + 32 * td + r31];
    const float cw0 = convw[ch], cw1 = convw[512 + ch], cw2 = convw[1024 + ch], cw3 = convw[1536 + ch], cb = convb[ch];
    const float lam = lam_[ch]; const float c8 = 8.f * (fmaxf(-lam, 0.f) + log1pf(__expf(-fabsf(lam))));
    const size_t tokb = (size_t)b * SEQ;
    unsigned short px[11], py[8];
#define LRU_PREFETCH(n) do { _Pragma("unroll") for (int rr = 0; rr < 11; ++rr) { const int t = (n) * 64 + 8 * w + rr - 3; px[rr] = t >= 0 ? c.proj[(tokb + t) * NP + C_XB + ch] : (unsigned short)0; } \
        _Pragma("unroll") for (int rr = 0; rr < 8; ++rr) py[rr] = c.proj[(tokb + (n) * 64 + 8 * w + rr) * NP + C_YB + ch]; } while (0)
    LRU_PREFETCH(0);
    float hcarry = 0.f;
    for (int n = 0; n < SEQ / 64; ++n) {
        float xc[8], yv[8];
        { float xr[11];
#pragma unroll
          for (int rr = 0; rr < 11; ++rr) xr[rr] = bf2f(px[rr]);
#pragma unroll
          for (int rr = 0; rr < 8; ++rr) { xc[rr] = cb + cw0 * xr[rr] + cw1 * xr[rr + 1] + cw2 * xr[rr + 2] + cw3 * xr[rr + 3]; yv[rr] = bf2f(py[rr]);
              *(LAS unsigned short*)(L + LRU_X + offb(8 * w + rr, lane >> 3) + (lane & 7) * 2) = (unsigned short)f2bf(xc[rr]); } }
        __syncthreads();
        if (n + 1 < SEQ / 64) LRU_PREFETCH(n + 1);
        { f32x16 Z;
#pragma unroll
          for (int i = 0; i < 16; ++i) Z[i] = 0.f;
#pragma unroll
          for (int s = 0; s < 4; ++s) { const bf16x8 af = *(const LAS bf16x8*)(L + LRU_X + offb(32 * tt + r31, 2 * s + hh)); Z = __builtin_amdgcn_mfma_f32_32x32x16_bf16(af, wf[s], Z, 0, 0, 0); }
          LAS float* dst = (LAS float*)(L + (gate ? LRU_I : LRU_R));
#pragma unroll
          for (int i = 0; i < 16; ++i) dst[(32 * tt + crow(i, hh)) * 64 + 32 * td + r31] = sigmoidf_(Z[i] + gbias); }
        __syncthreads();
        float hl[8], pc[8];
        { float hrun = 0.f, prun = 1.f;
#pragma unroll
          for (int rr = 0; rr < 8; ++rr) { const float r = ((const LAS float*)(L + LRU_R))[(8 * w + rr) * 64 + lane], ig = ((const LAS float*)(L + LRU_I))[(8 * w + rr) * 64 + lane];
              const float a = __expf(-c8 * r), u = sqrtf(fmaxf(1.f - a * a, 0.f)) * ig * xc[rr];
              hrun = a * hrun + u; prun *= a; hl[rr] = hrun; pc[rr] = prun; }
          ((LAS float*)(L + LRU_SP))[w * 64 + lane] = prun; ((LAS float*)(L + LRU_SH))[w * 64 + lane] = hrun; }
        __syncthreads();
        { float hin = hcarry, hall = hcarry;
#pragma unroll
          for (int s = 0; s < 8; ++s) { const float P = ((const LAS float*)(L + LRU_SP))[s * 64 + lane], H = ((const LAS float*)(L + LRU_SH))[s * 64 + lane];
              hall = P * hall + H; hin = (s < w) ? hall : hin; }
          hcarry = hall;
#pragma unroll
          for (int rr = 0; rr < 8; ++rr) { const float hv = hl[rr] + pc[rr] * hin;
              c.brx[(size_t)TC * 512 + (tokb + n * 64 + 8 * w + rr) * 512 + ch] = (bf16_t)f2bf(hv * gelu_tanh(yv[rr])); } }
    }
    __syncthreads();
#undef LRU_PREFETCH
}

constexpr int TPB = TC / 256;
__device__ __forceinline__ void phase_router(const Ctx& c, const float* gain, const float* rw, const float* rb, unsigned* gcnt) {
    LAS float* sRW = (LAS float*)c.lds;
    LAS unsigned* sRec = (LAS unsigned*)(c.lds + 65536);
    LAS unsigned* sCnt = (LAS unsigned*)(c.lds + MISC_OFF + 256);
    LAS unsigned* sBase = sCnt + 16;
    const int tid = c.tid, lane = c.lane;
    for (int idx = tid; idx < D * NE; idx += NTHR) sRW[(idx & 15) * D + (idx >> 4)] = rw[idx];
    if (tid < 16) sCnt[tid] = 0u;
    f32x4 g4[4];
#pragma unroll
    for (int j = 0; j < 4; ++j) g4[j] = *((const f32x4*)gain + 64 * j + lane);
    float rbv[16];
#pragma unroll
    for (int e = 0; e < 16; ++e) rbv[e] = rb[e];
    __syncthreads();
    for (int lt = c.wave; lt < TPB; lt += NWAVES) {
        const int tok = c.bid * TPB + lt;
        const f32x4* xr = (const f32x4*)(c.xo + (size_t)tok * D) + lane;
        f32x4 v[4]; float ss = 0.f;
#pragma unroll
        for (int j = 0; j < 4; ++j) { v[j] = xr[64 * j]; ss += (v[j].x * v[j].x + v[j].y * v[j].y) + (v[j].z * v[j].z + v[j].w * v[j].w); }
        const float rs = rsqf_(wave_sum(ss) * (1.f / D) + RMS_EPS);
        u32x2* o = (u32x2*)(c.act + (size_t)tok * D) + lane;
#pragma unroll
        for (int j = 0; j < 4; ++j) { v[j] = v[j] * rs * g4[j]; u32x2 w; w.x = pk2(v[j].x, v[j].y); w.y = pk2(v[j].z, v[j].w); o[64 * j] = w; }
        float sc[16]; float mx = -INFINITY;
#pragma unroll
        for (int e = 0; e < 16; ++e) { float p = 0.f;
#pragma unroll
            for (int j = 0; j < 4; ++j) { const f32x4 w = *((const LAS f32x4*)(sRW + e * D) + 64 * j + lane); p += (v[j].x * w.x + v[j].y * w.y) + (v[j].z * w.z + v[j].w * w.w); }
            sc[e] = wave_sum(p) + rbv[e]; mx = fmaxf(mx, sc[e]); }
        float sum = 0.f;
#pragma unroll
        for (int e = 0; e < 16; ++e) { sc[e] = __expf(sc[e] - mx); sum += sc[e]; }
        const float isum = rcpf_(sum);
#pragma unroll
        for (int e = 0; e < 16; ++e) sc[e] *= isum;
        int gsel = 0; float gbest = -1.f;
#pragma unroll
        for (int g = 0; g < 4; ++g) { const float a = sc[4 * g], b = sc[4 * g + 1], cc = sc[4 * g + 2], d = sc[4 * g + 3];
            const float hi1 = fmaxf(a, b), lo1 = fminf(a, b), hi2 = fmaxf(cc, d), lo2 = fminf(cc, d);
            const float top = fmaxf(hi1, hi2), second = fmaxf(fminf(hi1, hi2), fmaxf(lo1, lo2));
            const float gs = top + second; if (gs > gbest) { gbest = gs; gsel = g; } }
        float s4[4];
#pragma unroll
        for (int k = 0; k < 4; ++k) s4[k] = gsel == 0 ? sc[k] : gsel == 1 ? sc[4 + k] : gsel == 2 ? sc[8 + k] : sc[12 + k];
        int i0 = 0; float b0 = s4[0];
#pragma unroll
        for (int k = 1; k < 4; ++k) if (s4[k] > b0) { b0 = s4[k]; i0 = k; }
        int i1 = -1; float b1 = -1.f;
#pragma unroll
        for (int k = 0; k < 4; ++k) if (k != i0 && s4[k] > b1) { b1 = s4[k]; i1 = k; }
        const int e0 = 4 * gsel + i0, e1 = 4 * gsel + i1; const float wn = rcpf_(b0 + b1);
        if (lane == 0) { const unsigned l0 = atomicAdd((unsigned*)&sCnt[e0], 1u), l1 = atomicAdd((unsigned*)&sCnt[e1], 1u);
            sRec[lt * 6 + 0] = (unsigned)e0; sRec[lt * 6 + 1] = l0; sRec[lt * 6 + 2] = (unsigned)e1; sRec[lt * 6 + 3] = l1; sRec[lt * 6 + 4] = __float_as_uint(b0 * wn); sRec[lt * 6 + 5] = __float_as_uint(b1 * wn); }
    }
    __syncthreads();
    if (tid < 16) sBase[tid] = __hip_atomic_fetch_add(gcnt + tid, sCnt[tid], __ATOMIC_RELAXED, __HIP_MEMORY_SCOPE_AGENT);
    __syncthreads();
    if (tid < TPB) { const int tok = c.bid * TPB + tid; const unsigned e0 = sRec[tid * 6], e1 = sRec[tid * 6 + 2];
        const unsigned p0 = sBase[e0] + sRec[tid * 6 + 1], p1 = sBase[e1] + sRec[tid * 6 + 3];
        u32x4 r; r.x = (e0 << 20) | p0; r.y = (e1 << 20) | p1; r.z = sRec[tid * 6 + 4]; r.w = sRec[tid * 6 + 5];
        *(u32x4*)(c.rec + (size_t)tok * 4) = r;
        c.list[(size_t)e0 * TC + p0] = tok; c.list[(size_t)e1 * TC + p1] = tok; }
}

struct PlainOrder {
    int nM, nN, G, c; const char* A; const char* Bt; size_t a_tile, b_tile;
    __device__ __forceinline__ bool next(int i, pg8::Unit& u) const { u.g = 0; return pg8::static_tile(nM, nN, G, c, i, u.pm, u.pn); }
    __device__ __forceinline__ const char* aptr(const pg8::Unit& u) const { return A + (size_t)u.pm * a_tile; }
    __device__ __forceinline__ const char* bptr(const pg8::Unit& u) const { return Bt + (size_t)u.pn * b_tile; }
    __device__ __forceinline__ unsigned arow(const pg8::Unit&, int) const { return 0u; }
};
struct MergeOrder {
    int G, c; const char* brx; const char* wbr;
    __device__ __forceinline__ bool next(int i, pg8::Unit& u) const { u.g = i % 3; return pg8::static_tile(TC / 256, 4, G, c, i / 3, u.pm, u.pn); }
    __device__ __forceinline__ const char* aptr(const pg8::Unit& u) const { return brx + ((size_t)u.g * TC * 512 + (size_t)u.pm * 256 * 512) * 2; }
    __device__ __forceinline__ const char* bptr(const pg8::Unit& u) const { return wbr + ((size_t)u.g * D * 512 + (size_t)u.pn * 256 * 512) * 2; }
    __device__ __forceinline__ unsigned arow(const pg8::Unit&, int) const { return 0u; }
};
template <bool UP> struct MoeOrder {
    int G, c; LAS const int* pt; LAS const int* lc; const char* A; const char* W; const int* list;
    __device__ __forceinline__ bool next(int i, pg8::Unit& u) const { const int L = i * G + c, tau = L >> 2; if (tau >= pt[NE]) return false;
        int e = 0;
#pragma unroll
        for (int k = 1; k < NE; ++k) e += (tau >= pt[k]) ? 1 : 0;
        u.pm = tau; u.pn = L & 3; u.g = e; return true; }
    __device__ __forceinline__ const char* aptr(const pg8::Unit& u) const { return UP ? A : A + (size_t)u.pm * 256 * FF * 2; }
    __device__ __forceinline__ const char* bptr(const pg8::Unit& u) const { return UP ? W + ((size_t)u.g * 1024 * D + (size_t)u.pn * 256 * D) * 2 : W + ((size_t)u.g * D * FF + (size_t)u.pn * 256 * FF) * 2; }
    __device__ __forceinline__ unsigned arow(const pg8::Unit& u, int r) const { int p = (u.pm - pt[u.g]) * 256 + r; const int n = lc[u.g]; p = p < n ? p : n - 1;
        return (unsigned)list[(size_t)u.g * TC + p] * (unsigned)(D * 2); }
};

struct EpiStoreBf16 {
    static constexpr bool PERM = true;
    bf16_t* O; int ldc;
    __device__ __forceinline__ void operator()(const f32x4 (&acc)[2][2][4][2], const pg8::Unit& u, int wr, int wc, int fr, int fq) const {
        const int row0 = u.pm * 256 + wr * 64 + fr, col0 = u.pn * 256 + wc * 32 + 8 * fq;
#pragma unroll
        for (int ai = 0; ai < 2; ++ai)
#pragma unroll
            for (int m = 0; m < 4; ++m) { bf16_t* rowp = O + (size_t)(row0 + ai * 128 + m * 16) * ldc + col0;
#pragma unroll
                for (int bj = 0; bj < 2; ++bj) { const f32x4 v0 = acc[ai][bj][m][0], v1 = acc[ai][bj][m][1];
                    u32x4 w; w.x = pg8::cvt_pk_bf16(v0[0], v0[1]); w.y = pg8::cvt_pk_bf16(v0[2], v0[3]); w.z = pg8::cvt_pk_bf16(v1[0], v1[1]); w.w = pg8::cvt_pk_bf16(v1[2], v1[3]);
                    *(u32x4*)(rowp + bj * 128) = w; } }
    }
};
struct EpiMerge {
    static constexpr bool PERM = true;
    const bf16_t* proj; bf16_t* mg;
    __device__ __forceinline__ void operator()(const f32x4 (&acc)[2][2][4][2], const pg8::Unit& u, int wr, int wc, int fr, int fq) const {
        const int row0 = u.pm * 256 + wr * 64 + fr, col0 = u.pn * 256 + wc * 32 + 8 * fq;
#pragma unroll
        for (int ai = 0; ai < 2; ++ai) {
            u32x4 gv[4][2], pv[4][2];
#pragma unroll
            for (int m = 0; m < 4; ++m)
#pragma unroll
                for (int bj = 0; bj < 2; ++bj) { const size_t row = (size_t)(row0 + ai * 128 + m * 16); const int col = col0 + bj * 128;
                    gv[m][bj] = *(const u32x4*)(proj + row * NP + C_G + u.g * D + col);
                    if (u.g > 0) pv[m][bj] = *(const u32x4*)(mg + row * D + col); else pv[m][bj] = (u32x4){0u, 0u, 0u, 0u}; }
            asm volatile("" ::: "memory");
#pragma unroll
            for (int m = 0; m < 4; ++m)
#pragma unroll
                for (int bj = 0; bj < 2; ++bj) { const size_t row = (size_t)(row0 + ai * 128 + m * 16); const int col = col0 + bj * 128;
                    const u32x4 g = gv[m][bj], p = pv[m][bj];
                    const f32x4 v0 = acc[ai][bj][m][0], v1 = acc[ai][bj][m][1];
                    float r[8];
                    r[0] = v0[0] * sigmoidf_(bflo(g.x)) + bflo(p.x); r[1] = v0[1] * sigmoidf_(bfhi(g.x)) + bfhi(p.x); r[2] = v0[2] * sigmoidf_(bflo(g.y)) + bflo(p.y); r[3] = v0[3] * sigmoidf_(bfhi(g.y)) + bfhi(p.y);
                    r[4] = v1[0] * sigmoidf_(bflo(g.z)) + bflo(p.z); r[5] = v1[1] * sigmoidf_(bfhi(g.z)) + bfhi(p.z); r[6] = v1[2] * sigmoidf_(bflo(g.w)) + bflo(p.w); r[7] = v1[3] * sigmoidf_(bfhi(g.w)) + bfhi(p.w);
                    u32x4 w; w.x = pk2(r[0], r[1]); w.y = pk2(r[2], r[3]); w.z = pk2(r[4], r[5]); w.w = pk2(r[6], r[7]);
                    *(u32x4*)(mg + row * D + col) = w; }
        }
    }
};
struct EpiResid {
    static constexpr bool PERM = false;
    const float* base; float* out;
    __device__ __forceinline__ void operator()(const f32x4 (&acc)[2][2][4][2], const pg8::Unit& u, int wr, int wc, int fr, int fq) const {
        const int row0 = u.pm * 256 + wr * 64 + fr, col0 = u.pn * 256 + wc * 32 + 4 * fq;
#pragma unroll
        for (int ai = 0; ai < 2; ++ai) {
            f32x4 bv[4][2][2];
#pragma unroll
            for (int m = 0; m < 4; ++m) { const size_t off = (size_t)(row0 + ai * 128 + m * 16) * D + col0;
#pragma unroll
                for (int bj = 0; bj < 2; ++bj)
#pragma unroll
                    for (int n = 0; n < 2; ++n) bv[m][bj][n] = *(const f32x4*)(base + off + bj * 128 + n * 16); }
            asm volatile("" ::: "memory");
#pragma unroll
            for (int m = 0; m < 4; ++m) { const size_t off = (size_t)(row0 + ai * 128 + m * 16) * D + col0;
#pragma unroll
                for (int bj = 0; bj < 2; ++bj)
#pragma unroll
                    for (int n = 0; n < 2; ++n) *(f32x4*)(out + off + bj * 128 + n * 16) = bv[m][bj][n] + acc[ai][bj][m][n]; }
        }
    }
};
struct EpiSwiGLU {
    static constexpr bool PERM = false;
    bf16_t* hid;
    __device__ __forceinline__ void operator()(const f32x4 (&acc)[2][2][4][2], const pg8::Unit& u, int wr, int wc, int fr, int fq) const {
        const int row0 = u.pm * 256 + wr * 64 + fr, col0 = u.pn * 128 + wc * 16 + 4 * fq;
#pragma unroll
        for (int ai = 0; ai < 2; ++ai)
#pragma unroll
            for (int m = 0; m < 4; ++m) { bf16_t* rowp = hid + (size_t)(row0 + ai * 128 + m * 16) * FF + col0;
#pragma unroll
                for (int bj = 0; bj < 2; ++bj) { const f32x4 g = acc[ai][bj][m][0], up = acc[ai][bj][m][1];
                    u32x2 w; w.x = pg8::cvt_pk_bf16(g[0] * sigmoidf_(g[0]) * up[0], g[1] * sigmoidf_(g[1]) * up[1]); w.y = pg8::cvt_pk_bf16(g[2] * sigmoidf_(g[2]) * up[2], g[3] * sigmoidf_(g[3]) * up[3]);
                    *(u32x2*)(rowp + bj * 64) = w; } }
    }
};

constexpr int PH_PER_PASS = 9, N_PASS = NCH * DEPTH, PH_TOTAL = 1 + N_PASS * PH_PER_PASS + 1;
#ifndef MK_LAUNCH_PER_PHASE
#define MK_LAUNCH_PER_PHASE 0
#endif
#ifndef PHMASK
#define PHMASK 0xFFFF
#endif
#ifndef MIXM
#define MIXM 7
#endif
#define EN(j) (((PHMASK) >> (j)) & 1)
typedef const __attribute__((address_space(4))) char* kptr_t;
__device__ __forceinline__ const void* karg_ptr(kptr_t kp, int i) { return *(const void* const __attribute__((address_space(4)))*)(kp + 8 * i); }
__device__ __forceinline__ void make_ctx(Ctx& c, kptr_t& kp, int pass, int wave_s) {
    int t = wave_s * 64 + (int)__builtin_amdgcn_mbcnt_hi(~0u, __builtin_amdgcn_mbcnt_lo(~0u, 0u)); asm volatile("" : "+v"(t));
    kp = (kptr_t)__builtin_amdgcn_kernarg_segment_ptr(); asm volatile("" : "+s"(kp));
    c.tid = t; c.lane = t & 63; c.wave = __builtin_amdgcn_readfirstlane(t >> 6); c.bid = blockIdx.x; c.G = gridDim.x;
    unsigned char* ws = (unsigned char*)karg_ptr(kp, 25); float* out = (float*)karg_ptr(kp, 24);
    c.ctl = (unsigned*)(ws + WS_CTL);
    c.act = (bf16_t*)(ws + WS_ACT); c.proj = (bf16_t*)(ws + WS_PROJ); c.hid = (bf16_t*)(ws + WS_HID); c.ys = (bf16_t*)(ws + WS_YS);
    c.rec = (unsigned*)(ws + WS_REC); c.list = (int*)(ws + WS_LIST); c.brx = (bf16_t*)(ws + WS_BRX);
    const int chunk = pass / DEPTH, layer = pass % DEPTH;
    c.chunk = chunk; c.layer = layer; c.pass = pass;
    c.x_in = (const float*)karg_ptr(kp, 0) + (size_t)chunk * TC * D; c.xo = out + (size_t)chunk * TC * D;
    c.pos = (const int*)karg_ptr(kp, 1) + (size_t)chunk * TC;
    c.lw = ws + WS_W + (size_t)layer * LW_SIZE;
}
#define INP(i) ((const float*)karg_ptr(kp, (i)))
__global__ void __launch_bounds__(NTHR, 2) fwd(Args args) {
    extern __shared__ __attribute__((aligned(16))) unsigned char lds_raw[];
    Ctx c; kptr_t kp;
    c.lds = (LAS unsigned char*)lds_raw;
    const int wave_s = __builtin_amdgcn_readfirstlane((int)threadIdx.x >> 6);
    make_ctx(c, kp, 0, wave_s);
    volatile LAS unsigned* MISC = (volatile LAS unsigned*)(c.lds + MISC_OFF);
    LAS int* sPT = (LAS int*)(c.lds + MISC_OFF + 64);
    LAS int* sLC = (LAS int*)(c.lds + MISC_OFF + 160);
    for (int u = c.tid; u < 1024; u += NTHR) MISC[u] = 0u;
    __syncthreads();
    XcdBarrier bar; bar.bar = c.ctl + CW_BAR; bar.x = 0; bar.st = nullptr;
    if (!MK_LAUNCH_PER_PHASE) bar = xcd_barrier_post(c.ctl + CW_BAR, MISC, c.tid);
    const int lo = args.ph_lo, hi = args.ph_hi;
#define IN(k) (lo <= (k) && (k) < hi)
#ifndef PROBE_MASK
#define PROBE_MASK 0
#endif
#ifndef PROBE_BLOCK
#define PROBE_BLOCK 0
#endif
#ifndef PROBE_K
#define PROBE_K 4
#endif
    unsigned long long t_prev = 0; LAS unsigned* sAcc = (LAS unsigned*)(c.lds + MISC_OFF + 512);
    if (PROBE_MASK) { t_prev = __builtin_amdgcn_s_memrealtime(); }
#define STAMP(cls) do { if (PROBE_MASK) { const unsigned long long _n = __builtin_amdgcn_s_memrealtime(); if (blockIdx.x == PROBE_BLOCK && c.tid == 0) sAcc[(cls)] += (unsigned)(_n - t_prev); t_prev = _n; } } while (0)
#ifndef PROBE_GEMM_CLS
#define PROBE_GEMM_CLS -1
#endif
#define GEMM_FLAG(cls) do { if (PROBE_MASK) { if (c.tid == 0) MISC[6] = ((cls) == PROBE_GEMM_CLS) ? 1u : 0u; __syncthreads(); } } while (0)
#define SEAM(k) do { if (IN(k) && IN((k) + 1)) { XcdBarrier _b = bar; kptr_t _k = (kptr_t)__builtin_amdgcn_kernarg_segment_ptr(); asm volatile("" : "+s"(_k)); _b.bar = (unsigned*)((unsigned char*)karg_ptr(_k, 25) + WS_CTL) + CW_BAR; { int _t = wave_s * 64 + (int)__builtin_amdgcn_mbcnt_hi(~0u, __builtin_amdgcn_mbcnt_lo(~0u, 0u)); xcd_barrier(_b, _t); } } } while (0)

    if (EN(0) && IN(0)) { Args a2;
#pragma unroll
        for (int i = 0; i < 24; ++i) a2.in[i] = karg_ptr(kp, i);
        a2.ws = (unsigned char*)karg_ptr(kp, 25); a2.out = nullptr; a2.ph_lo = 0; a2.ph_hi = 0;
        phase_prep(a2, c.lds, c.bid * NWAVES + c.wave, c.G * NWAVES, c.wave, c.lane, c.bid * NTHR + c.tid, c.G * NTHR);
        phase_rope_table((const int*)karg_ptr(kp, 1), (float*)(c.ctl) + (WS_BRC + 4 * MiB) / 4, c.bid * NTHR + c.tid, c.G * NTHR); }
    SEAM(0); STAMP(0);

    for (int pass = 0; pass < N_PASS; ++pass) {
        const int pb = 1 + pass * PH_PER_PASS;
        if (EN(1) && IN(pb + 0)) { make_ctx(c, kp, pass, wave_s);
            const float* g1 = INP(2) + c.layer * D;
            if (c.layer == 0) {
                if (c.chunk > 0) {
                    Ctx p = c; p.xo = c.xo - (size_t)TC * D;
                    moe_tables(c.ctl + CW_CNT + 64 * (pass - 1), sPT, sLC, c.tid);
                    phase_norm1<true, false, true>(p, nullptr, sPT);
                }
                phase_norm1<false, true, false>(c, g1, sPT);
            } else {
                moe_tables(c.ctl + CW_CNT + 64 * (pass - 1), sPT, sLC, c.tid);
                phase_norm1<true, true, true>(c, g1, sPT);
            }
        }
        SEAM(pb + 0); STAMP(1);
        if (EN(2) && IN(pb + 1)) { make_ctx(c, kp, pass, wave_s);
            PlainOrder S{TC / 256, NP / 256, c.G, c.bid, (const char*)c.act, (const char*)(c.lw + LW_WIN), (size_t)256 * D * 2, (size_t)256 * D * 2};
            EpiStoreBf16 E{c.proj, NP};
            GEMM_FLAG(2);
            pg8::gemm_phase<EpiStoreBf16, PlainOrder, false>(c.lds, S, E, D, D, c.tid);
        }
        SEAM(pb + 1); STAMP(2);
        if (EN(4) && IN(pb + 2)) { make_ctx(c, kp, pass, wave_s); const int layer = c.layer;
            float* lse = (float*)(c.ctl) + (WS_BRC / 4);
            if ((MIXM & 1) && c.bid < 4 * BC) gla_unit(c, c.bid, INP(5) + layer * 256, INP(6) + layer * 128);
            else if ((MIXM & 2) && c.bid < 12 * BC) lru_unit(c, c.bid - 4 * BC, INP(7) + layer * 4 * 512, INP(8) + layer * 512, INP(9) + layer * 8 * 64 * 64,
                                                INP(10) + layer * 512, INP(11) + layer * 8 * 64 * 64, INP(12) + layer * 512, INP(13) + layer * 512);
            STAMP(12);
            unsigned* qh = c.ctl + CW_Q + 64 * pass;
            for (;;) {
                if (c.tid == 0) MISC[4] = __hip_atomic_fetch_add(qh, 1u, __ATOMIC_RELAXED, __HIP_MEMORY_SCOPE_AGENT);
                __syncthreads();
                const unsigned u = MISC[4];
                if (u >= (unsigned)(BC * ATT_UNITS_PER_SEQ)) break;
                if (MIXM & 4) attn_unit(c, (int)u, lse, INP(14) + layer * 128, INP(15) + layer * 128, (const float*)(c.ctl) + (WS_BRC + 4 * MiB) / 4 + (size_t)c.chunk * TC * 32);
            }
        }
        SEAM(pb + 2); STAMP(4);
        if (EN(11) && IN(pb + 3)) { make_ctx(c, kp, pass, wave_s); phase_attn_combine(c, (const float*)(c.ctl) + (WS_BRC / 4)); }
        SEAM(pb + 3); STAMP(11);
        if (EN(5) && IN(pb + 4)) { make_ctx(c, kp, pass, wave_s);
            MergeOrder S{c.G, c.bid, (const char*)c.brx, (const char*)(c.lw + LW_WBR)};
            EpiMerge E{c.proj, c.act};
            GEMM_FLAG(5);
            pg8::gemm_phase<EpiMerge, MergeOrder, false>(c.lds, S, E, 512, 512, c.tid);
        }
        SEAM(pb + 4); STAMP(5);
        if (EN(6) && IN(pb + 5)) { make_ctx(c, kp, pass, wave_s);
            PlainOrder S{TC / 256, D / 256, c.G, c.bid, (const char*)c.act, (const char*)(c.lw + LW_WOUT), (size_t)256 * D * 2, (size_t)256 * D * 2};
            EpiResid E{c.layer == 0 ? c.x_in : (const float*)c.xo, c.xo};
            GEMM_FLAG(6);
            pg8::gemm_phase<EpiResid, PlainOrder, false>(c.lds, S, E, D, D, c.tid);
        }
        SEAM(pb + 5); STAMP(6);
        if (EN(7) && IN(pb + 6)) { make_ctx(c, kp, pass, wave_s); phase_router(c, INP(18) + c.layer * D, INP(19), INP(20), c.ctl + CW_CNT + 64 * pass); }
        SEAM(pb + 6); STAMP(7);
        if (EN(8) && IN(pb + 7)) { make_ctx(c, kp, pass, wave_s);
            moe_tables(c.ctl + CW_CNT + 64 * pass, sPT, sLC, c.tid);
            MoeOrder<true> S{c.G, c.bid, sPT, sLC, (const char*)c.act, (const char*)(c.lw + LW_WGU), c.list};
            EpiSwiGLU E{c.hid};
            GEMM_FLAG(8);
            pg8::gemm_phase<EpiSwiGLU, MoeOrder<true>, true>(c.lds, S, E, D, D, c.tid);
        }
        SEAM(pb + 7); STAMP(8);
        if (EN(9) && IN(pb + 8)) { make_ctx(c, kp, pass, wave_s);
            moe_tables(c.ctl + CW_CNT + 64 * pass, sPT, sLC, c.tid);
            MoeOrder<false> S{c.G, c.bid, sPT, sLC, (const char*)c.hid, (const char*)(c.lw + LW_WDN), c.list};
            EpiStoreBf16 E{c.ys, D};
            GEMM_FLAG(9);
            pg8::gemm_phase<EpiStoreBf16, MoeOrder<false>, false>(c.lds, S, E, FF, FF, c.tid);
        }
        SEAM(pb + 8); STAMP(9);
    }
    if (EN(10) && IN(PH_TOTAL - 1)) { make_ctx(c, kp, N_PASS - 1, wave_s);
        moe_tables(c.ctl + CW_CNT + 64 * (N_PASS - 1), sPT, sLC, c.tid);
        phase_norm1<true, false, true>(c, nullptr, sPT);
    }
    if (PROBE_MASK) {
        make_ctx(c, kp, N_PASS - 1, wave_s);
        STAMP(10);
        if (blockIdx.x == PROBE_BLOCK && c.tid == 0) { unsigned sel = 0; for (int k = 0; k < 16; ++k) if ((PROBE_MASK >> k) & 1) sel += sAcc[k]; __hip_atomic_store(c.ctl + CW_Q + 64 * 8, sel, __ATOMIC_RELAXED, __HIP_MEMORY_SCOPE_AGENT); }
        { XcdBarrier _b = bar; _b.bar = c.ctl + CW_BAR; xcd_barrier(_b, c.tid); }
        const unsigned sel = __hip_atomic_load(c.ctl + CW_Q + 64 * 8, __ATOMIC_RELAXED, __HIP_MEMORY_SCOPE_AGENT);
        const unsigned long long t0 = __builtin_amdgcn_s_memrealtime();
        while (__builtin_amdgcn_s_memrealtime() - t0 < (unsigned long long)sel * PROBE_K) __builtin_amdgcn_s_sleep(8);
    }
#undef IN
#undef SEAM
}

extern "C" void kernel_launch(void* const* d_in, const int* in_sizes, int n_in, void* d_out, int out_size, void* d_ws, size_t ws_size, hipStream_t stream) {
    static int grid = 0;
    if (grid == 0) {
        if (n_in != 24 || in_sizes[0] != BATCH * SEQ * D || out_size != BATCH * SEQ * D || ws_size < WS_END) { fprintf(stderr, "kernel_launch: unexpected shapes / workspace (%zu < %zu)\n", ws_size, (size_t)WS_END); grid = -1; return; }
        int dev = 0, cus = 0;
        if (hipGetDevice(&dev) != hipSuccess || hipDeviceGetAttribute(&cus, hipDeviceAttributeMultiprocessorCount, dev) != hipSuccess || cus < 256) { fprintf(stderr, "kernel_launch: needs a 256-CU device\n"); grid = -1; return; }
        if (hipFuncSetAttribute((const void*)fwd, hipFuncAttributeMaxDynamicSharedMemorySize, LDS_BYTES) != hipSuccess) { fprintf(stderr, "kernel_launch: hipFuncSetAttribute failed\n"); grid = -1; return; }
        int per_cu = 0;
        if (hipOccupancyMaxActiveBlocksPerMultiprocessor(&per_cu, (const void*)fwd, NTHR, LDS_BYTES) != hipSuccess || per_cu < 1) fprintf(stderr, "kernel_launch: occupancy query says %d\n", per_cu);
        (void)hipGetLastError();
        grid = 256;
    }
    if (grid < 0) return;
    if (hipMemsetAsync((char*)d_ws + WS_CTL, 0, CTL_ZERO_BYTES, stream) != hipSuccess) return;
    Args a{};
    for (int i = 0; i < 24; ++i) a.in[i] = d_in[i];
    a.out = (float*)d_out; a.ws = (unsigned char*)d_ws;
#if MK_LAUNCH_PER_PHASE
    for (int k = 0; k < PH_TOTAL; ++k) { a.ph_lo = k; a.ph_hi = k + 1; hipLaunchKernelGGL(fwd, dim3(grid), dim3(NTHR), LDS_BYTES, stream, a); }
#else
    a.ph_lo = 0; a.ph_hi = PH_TOTAL;
    hipLaunchKernelGGL(fwd, dim3(grid), dim3(NTHR), LDS_BYTES, stream, a);
#endif
}
```

```cpp
#include <hip/hip_runtime.h>
#include <cstdio>
#include <cstdint>

#define LAS __attribute__((address_space(3)))
#define GAS __attribute__((address_space(1)))
typedef unsigned short bf16_t;
typedef short bf16x8 __attribute__((ext_vector_type(8)));
typedef float f32x4 __attribute__((ext_vector_type(4)));
typedef float f32x2 __attribute__((ext_vector_type(2)));
typedef unsigned u32x4 __attribute__((ext_vector_type(4)));
typedef unsigned u32x2 __attribute__((ext_vector_type(2)));

namespace pg8 {
constexpr int BM = 256, BK = 64, HALF = 128, HTB = HALF * BK * 2, STAGE_BYTES = 8 * HTB, NXCD = 8, WGM = 8;
__host__ __device__ __forceinline__ int lds_byte(int r, int c) { const int st = (r >> 4) * 2 + (c >> 5), rr = r & 15, cc = c & 31, ob = rr * 64 + cc * 2; return st * 1024 + (ob ^ (((ob >> 9) & 1) << 5)); }
__host__ __device__ __forceinline__ void stage_rc(int b, int& R, int& C) { const int st = b / 1024, sb = b % 1024, swz = sb ^ (((sb >> 9) & 1) << 5); R = (st >> 1) * 16 + swz / 64; C = (st & 1) * 32 + (swz % 64) / 2; }
__host__ __device__ __forceinline__ int perm32(int rho) { const int n = rho >> 4, i = rho & 15; return 8 * (i >> 2) + 4 * n + (i & 3); }

struct Unit { int pm, pn, g; };

__device__ __forceinline__ bool static_tile(int nM, int nN, int G, int c, int i, int& pm, int& pn) {
    const int nwg = nM * nN; const long L = (long)i * G + c; if (L >= nwg) return false;
    int wgid = (int)L; { const int q = nwg / NXCD, r = nwg % NXCD, xcd = wgid % NXCD, off = wgid / NXCD; wgid = (xcd < r ? xcd * (q + 1) : r * (q + 1) + (xcd - r) * q) + off; }
    const int nig = WGM * nN, gid = wgid / nig, fm = gid * WGM, gsz = (nM - fm) < WGM ? (nM - fm) : WGM;
    pm = fm + ((wgid % nig) % gsz); pn = (wgid % nig) / gsz; return true;
}
typedef __bf16 bf16x2c_t __attribute__((ext_vector_type(2)));
__device__ __forceinline__ unsigned cvt_pk_bf16(float lo, float hi) { const f32x2 v = {lo, hi}; return __builtin_bit_cast(unsigned, __builtin_convertvector(v, bf16x2c_t)); }

template <class Epi, class Sched, bool GATHER>
__device__ __forceinline__ void gemm_phase(LAS unsigned char* lds, const Sched& S, const Epi& E, const int K, const int lda, int tid_) {
    asm volatile("" : "+v"(tid_));
    const int tid = tid_, wid = __builtin_amdgcn_readfirstlane(tid >> 6), lane = tid & 63, wr = wid >> 2, wc = wid & 3, fr = lane & 15, fq = lane >> 4;
    const int nt = K / BK;
    int sR[2], sC[2];
    unsigned voffB[2], voffA[2], vAc[2][2], vAn[2][2];
#pragma unroll
    for (int i = 0; i < 2; ++i) { int R, C; stage_rc(tid * 16 + i * 8192, R, C); sR[i] = R; sC[i] = C; const int Rb = Epi::PERM ? ((R & ~31) + perm32(R & 31)) : R;
        voffB[i] = (unsigned)(Rb * K + C) * 2u; voffA[i] = (unsigned)(R * lda + C) * 2u; }
    const size_t kstep = (size_t)(BK * 2);
    const size_t hstepB = (size_t)HALF * K * 2, hstepA = (size_t)HALF * lda * 2;
    const unsigned ldsw = (unsigned)wid * 1024u;
    const int aoff = lds_byte(wr * 64 + fr, fq * 8), boff = lds_byte(wc * 32 + fr, fq * 8);
#define PG8_SA(b, h) (((b) * 2 + (h)) * HTB)
#define PG8_SB(b, h) ((4 + (b) * 2 + (h)) * HTB)
#define PG8_STAGE(bufoff, gbase, voff) do { _Pragma("unroll") for (int _i = 0; _i < 2; ++_i) \
        __builtin_amdgcn_global_load_lds((const unsigned*)((const char*)(gbase) + (voff)[_i]), (LAS unsigned*)(lds + (bufoff) + ldsw + _i * 8192), 16, 0, 0); } while (0)
#define PG8_LDA(dst, b, h) do { _Pragma("unroll") for (int m = 0; m < 4; ++m) _Pragma("unroll") for (int k = 0; k < 2; ++k) dst[m][k] = *(const LAS bf16x8*)(lds + PG8_SA(b, h) + aoff + m * 2048 + k * 1024); } while (0)
#define PG8_LDB(dst, b, h) do { _Pragma("unroll") for (int n = 0; n < 2; ++n) _Pragma("unroll") for (int k = 0; k < 2; ++k) dst[n][k] = *(const LAS bf16x8*)(lds + PG8_SB(b, h) + boff + n * 2048 + k * 1024); } while (0)
#define PG8_MMA(ai, bj, At, Bt) do { __builtin_amdgcn_s_setprio(1); _Pragma("unroll") for (int m = 0; m < 4; ++m) _Pragma("unroll") for (int n = 0; n < 2; ++n) _Pragma("unroll") for (int k = 0; k < 2; ++k) \
        acc[ai][bj][m][n] = __builtin_amdgcn_mfma_f32_16x16x32_bf16(Bt[n][k], At[m][k], acc[ai][bj][m][n], 0, 0, 0); __builtin_amdgcn_s_setprio(0); } while (0)
#define PG8_WAIT_V(n) asm volatile("s_waitcnt vmcnt(" #n ")" ::: "memory")
#define PG8_WAIT_L(n) asm volatile("s_waitcnt lgkmcnt(" #n ")" ::: "memory")
#define PG8_BAR __builtin_amdgcn_s_barrier()
#define PG8_SCHED __builtin_amdgcn_sched_barrier(0)
#define PG8_AOFF(dst, u) do { if constexpr (GATHER) { _Pragma("unroll") for (int _h = 0; _h < 2; ++_h) _Pragma("unroll") for (int _i = 0; _i < 2; ++_i) \
        dst[_h][_i] = S.arow(u, _h * HALF + sR[_i]) + (unsigned)sC[_i] * 2u; } } while (0)
#define PG8_STAGE_A(bufoff, gptr, h, usenext) do { if constexpr (GATHER) { _Pragma("unroll") for (int _i = 0; _i < 2; ++_i) { const unsigned _vo = (usenext) ? vAn[h][_i] : vAc[h][_i]; \
        __builtin_amdgcn_global_load_lds((const unsigned*)((const char*)(gptr) + _vo), (LAS unsigned*)(lds + (bufoff) + ldsw + _i * 8192), 16, 0, 0); } } \
        else { PG8_STAGE(bufoff, (gptr) + (h) * hstepA, voffA); } } while (0)
    Unit cur, nxt; int ui = 0;
    if (!S.next(0, cur)) return;
    f32x4 acc[2][2][4][2];
#pragma unroll
    for (int a = 0; a < 2; ++a)
#pragma unroll
        for (int b = 0; b < 2; ++b)
#pragma unroll
            for (int m = 0; m < 4; ++m)
#pragma unroll
                for (int n = 0; n < 2; ++n) acc[a][b][m][n] = (f32x4){0.f, 0.f, 0.f, 0.f};
    bf16x8 At[4][2], B0[2][2], B1[2][2];
    const char* cA = S.aptr(cur); const char* cB = S.bptr(cur);
    PG8_AOFF(vAc, cur);
    PG8_STAGE(PG8_SB(0, 0), cB, voffB); PG8_STAGE(PG8_SB(0, 1), cB + hstepB, voffB); PG8_STAGE_A(PG8_SA(0, 0), cA, 0, false); PG8_STAGE_A(PG8_SA(0, 1), cA, 1, false);
    if (wr == 1) PG8_BAR;
    PG8_WAIT_V(2); PG8_BAR;
    PG8_STAGE(PG8_SB(1, 0), cB + kstep, voffB); PG8_STAGE_A(PG8_SA(1, 0), cA + kstep, 0, false); PG8_STAGE(PG8_SB(1, 1), cB + hstepB + kstep, voffB);
    PG8_WAIT_V(6); PG8_BAR;
    for (;;) {
        const bool has_next = S.next(ui + 1, nxt);
        const char* nA = has_next ? S.aptr(nxt) : cA; const char* nB = has_next ? S.bptr(nxt) : cB;
        if constexpr (GATHER) { if (has_next) { PG8_AOFF(vAn, nxt); } else {
#pragma unroll
            for (int h = 0; h < 2; ++h)
#pragma unroll
                for (int i = 0; i < 2; ++i) vAn[h][i] = vAc[h][i]; } }
#if defined(PROBE_MASK) && PROBE_MASK
        const unsigned long long _tk0 = __builtin_amdgcn_s_memrealtime();
#endif
        for (int t = 0; t < nt; t += 2) {
            const bool last = (t == nt - 2);
            const char* a1 = cA + (size_t)(t + 1) * kstep;
            const char* a2 = last ? nA : cA + (size_t)(t + 2) * kstep; const char* b2 = last ? nB : cB + (size_t)(t + 2) * kstep;
            const char* a3 = a2 + kstep; const char* b3 = b2 + kstep;
            PG8_LDB(B0, 0, 0); PG8_LDB(B1, 0, 1); PG8_SCHED; PG8_LDA(At, 0, 0); PG8_STAGE_A(PG8_SA(1, 1), a1, 1, false);
            PG8_WAIT_V(8); PG8_WAIT_L(0); PG8_BAR; PG8_MMA(0, 0, At, B0); PG8_MMA(0, 1, At, B1); PG8_BAR; PG8_SCHED;
            PG8_LDA(At, 0, 1); PG8_STAGE(PG8_SB(0, 0), b2, voffB); PG8_STAGE(PG8_SB(0, 1), b2 + hstepB, voffB); PG8_STAGE_A(PG8_SA(0, 0), a2, 0, last);
            PG8_WAIT_V(8); PG8_WAIT_L(0); PG8_BAR; PG8_MMA(1, 0, At, B0); PG8_MMA(1, 1, At, B1); PG8_BAR; PG8_SCHED;
            PG8_LDB(B0, 1, 0); PG8_LDB(B1, 1, 1); PG8_SCHED; PG8_LDA(At, 1, 0); PG8_STAGE_A(PG8_SA(0, 1), a2, 1, last);
            PG8_WAIT_V(8); PG8_WAIT_L(0); PG8_BAR; PG8_MMA(0, 0, At, B0); PG8_MMA(0, 1, At, B1); PG8_BAR; PG8_SCHED;
            PG8_LDA(At, 1, 1); PG8_STAGE(PG8_SB(1, 0), b3, voffB); PG8_STAGE(PG8_SB(1, 1), b3 + hstepB, voffB); PG8_STAGE_A(PG8_SA(1, 0), a3, 0, last);
            PG8_WAIT_V(8); PG8_WAIT_L(0); PG8_BAR; PG8_MMA(1, 0, At, B0); PG8_MMA(1, 1, At, B1); PG8_BAR; PG8_SCHED;
        }
#if defined(PROBE_MASK) && PROBE_MASK
        if (blockIdx.x == PROBE_BLOCK && tid == 0 && ((volatile LAS unsigned*)(lds + 147456))[6]) ((LAS unsigned*)(lds + 147456 + 512))[14] += (unsigned)(__builtin_amdgcn_s_memrealtime() - _tk0);
#endif
        if (wr == 0) PG8_BAR;
#if defined(PROBE_MASK) && PROBE_MASK
        { const unsigned long long _t0 = __builtin_amdgcn_s_memrealtime();
          E(acc, cur, wr, wc, fr, fq);
          asm volatile("s_waitcnt vmcnt(0)" ::: "memory");
          if (blockIdx.x == PROBE_BLOCK && tid == 0 && ((volatile LAS unsigned*)(lds + 147456))[6]) ((LAS unsigned*)(lds + 147456 + 512))[13] += (unsigned)(__builtin_amdgcn_s_memrealtime() - _t0); }
#else
        E(acc, cur, wr, wc, fr, fq);
#endif
        if (!has_next) break;
#pragma unroll
        for (int a = 0; a < 2; ++a)
#pragma unroll
            for (int b = 0; b < 2; ++b)
#pragma unroll
                for (int m = 0; m < 4; ++m)
#pragma unroll
                    for (int n = 0; n < 2; ++n) acc[a][b][m][n] = (f32x4){0.f, 0.f, 0.f, 0.f};
        cur = nxt; cA = nA; cB = nB; ++ui;
        if constexpr (GATHER) {
#pragma unroll
        for (int h = 0; h < 2; ++h)
#pragma unroll
            for (int i = 0; i < 2; ++i) vAc[h][i] = vAn[h][i]; }
        if (wr == 1) PG8_BAR;
    }
    PG8_WAIT_V(0);
    PG8_BAR;
#undef PG8_SA
#undef PG8_SB
#undef PG8_STAGE
#undef PG8_LDA
#undef PG8_LDB
#undef PG8_MMA
#undef PG8_WAIT_V
#undef PG8_WAIT_L
#undef PG8_BAR
#undef PG8_SCHED
#undef PG8_AOFF
#undef PG8_STAGE_A
}
}

constexpr int D = 1024, BATCH = 32, SEQ = 2048, DEPTH = 2;
constexpr int NCH = 2, BC = BATCH / NCH, TC = BC * SEQ;
constexpr int NP = 10496;
constexpr int C_QA = 0, C_KA = 256, C_VA = 512, C_OG = 1024, C_GP = 1536, C_XB = 1792, C_YB = 2304, C_QKV = 2816, C_G = 7424;
constexpr int WIN_N = 10256;
constexpr int NE = 16, FF = 512;
constexpr int RP = 2 * TC + NE * 256;
constexpr float RMS_EPS = 1e-6f;
constexpr int NWAVES = 8, NTHR = 512;

constexpr size_t MiB = 1u << 20;
constexpr size_t WS_CTL = 0, CTL_ZERO_BYTES = 1 * MiB;
constexpr size_t WS_REC = 1 * MiB;
constexpr size_t WS_LIST = 2 * MiB;
constexpr size_t WS_W = 4 * MiB;
constexpr size_t LW_WIN = 0, LW_WBR = LW_WIN + (size_t)NP * D * 2, LW_WOUT = LW_WBR + (size_t)3 * D * 512 * 2, LW_WGU = LW_WOUT + (size_t)D * D * 2,
                 LW_WDN = LW_WGU + (size_t)NE * 1024 * D * 2, LW_SIZE = LW_WDN + (size_t)NE * D * FF * 2;
static_assert(LW_SIZE == 77070336, "layer weights");
constexpr size_t WS_ACT = 152 * MiB;
constexpr size_t WS_BRC = 216 * MiB;
constexpr size_t WS_PROJ = 248 * MiB;
constexpr size_t WS_HID = WS_PROJ;
constexpr size_t WS_YS = WS_PROJ + 72 * MiB;
constexpr size_t WS_BRX = WS_PROJ + 656 * MiB;
constexpr size_t WS_END = WS_BRX + 96 * MiB;
static_assert(WS_W + 2 * LW_SIZE <= WS_ACT && (size_t)TC * NP * 2 <= 656 * MiB && (size_t)RP * 512 * 2 <= 72 * MiB && WS_YS + (size_t)RP * 2048 <= WS_END, "ws map");
constexpr int CW_BAR = 4096;
constexpr int CW_CNT = 8192;
constexpr int CW_Q = 12288;

constexpr int RING_BYTES = 147456;
constexpr int MISC_OFF = RING_BYTES;
constexpr int LDS_BYTES = 155648;

#define LDS_WAIT() asm volatile("s_waitcnt lgkmcnt(0)" ::: "memory")
#define VM_WAIT() asm volatile("s_waitcnt vmcnt(0)" ::: "memory")
__device__ __forceinline__ float bf2f(unsigned short b) { return __uint_as_float(((unsigned)b) << 16); }
__device__ __forceinline__ float bflo(unsigned u) { return __uint_as_float(u << 16); }
__device__ __forceinline__ float bfhi(unsigned u) { return __uint_as_float(u & 0xffff0000u); }
typedef __bf16 bf16x2v_t __attribute__((ext_vector_type(2)));
__device__ __forceinline__ unsigned pk2(float lo, float hi) { const f32x2 v = {lo, hi}; return __builtin_bit_cast(unsigned, __builtin_convertvector(v, bf16x2v_t)); }
__device__ __forceinline__ unsigned f2bf(float f) { return pk2(f, 0.f) & 0xffffu; }
__device__ __forceinline__ float rcpf_(float x) { return __builtin_amdgcn_rcpf(x); }
__device__ __forceinline__ float rsqf_(float x) { return __builtin_amdgcn_rsqf(x); }
template <int O> __device__ __forceinline__ float swz_xor(float v) { return __int_as_float(__builtin_amdgcn_ds_swizzle(__float_as_int(v), (O << 10) | 0x1f)); }
__device__ __forceinline__ float wave_sum(float v) {
    v += swz_xor<1>(v); v += swz_xor<2>(v); v += swz_xor<4>(v); v += swz_xor<8>(v); v += swz_xor<16>(v);
    const auto r = __builtin_amdgcn_permlane32_swap(__float_as_uint(v), __float_as_uint(v), false, false);
    return __uint_as_float(r[0]) + __uint_as_float(r[1]);
}
__device__ __forceinline__ float wave_max(float v) {
    v = fmaxf(v, swz_xor<1>(v)); v = fmaxf(v, swz_xor<2>(v)); v = fmaxf(v, swz_xor<4>(v)); v = fmaxf(v, swz_xor<8>(v)); v = fmaxf(v, swz_xor<16>(v));
    const auto r = __builtin_amdgcn_permlane32_swap(__float_as_uint(v), __float_as_uint(v), false, false);
    return fmaxf(__uint_as_float(r[0]), __uint_as_float(r[1]));
}
__device__ __forceinline__ float sigmoidf_(float x) { return __builtin_amdgcn_rcpf(1.f + __expf(-x)); }

#define XB_TMO      128
#define XB_XCNT(j)  (256  + 64 * (j))
#define XB_XSUB(j)  (1280 + 64 * (j))
#define XB_XGEN(j)  (2304 + 64 * (j))
#define XB_TOP      3328
#define XB_TOPGEN   3392
#define XCD_BAR_WORDS 3456
#define XB_SPIN_CAP (1u << 21)
__device__ __forceinline__ unsigned xb_ld(unsigned* p)              { return __hip_atomic_load(p, __ATOMIC_RELAXED, __HIP_MEMORY_SCOPE_AGENT); }
__device__ __forceinline__ unsigned xb_add(unsigned* p, unsigned v) { return __hip_atomic_fetch_add(p, v, __ATOMIC_RELAXED, __HIP_MEMORY_SCOPE_AGENT); }
__device__ __forceinline__ unsigned xb_xcc_id() { return (unsigned)__builtin_amdgcn_s_getreg((3 << 11) | 20) & 0xFu; }
#define XB_SPIN(cond, bar) do { unsigned _sp = 0; while (cond) { __builtin_amdgcn_s_sleep(1); \
    if ((++_sp & 255u) == 0u) { if (xb_ld(&(bar)[XB_TMO])) break; if (_sp > XB_SPIN_CAP) { atomicAdd(&(bar)[XB_TMO], 1u); break; } } } } while (0)
struct XcdBarrier { unsigned* bar; unsigned x; volatile LAS unsigned* st; };
__device__ __forceinline__ XcdBarrier xcd_barrier_post(unsigned* bar, volatile LAS unsigned* st, int tid) {
    XcdBarrier b; b.bar = bar; b.x = xb_xcc_id(); b.st = st;
    if (tid == 0) (void)xb_add(&bar[XB_XCNT(b.x)], 1u);
    return b;
}
__device__ __forceinline__ void xcd_barrier_complete(unsigned* bar, unsigned x, unsigned& nloc, unsigned& nx) {
    const unsigned G = gridDim.x * gridDim.y * gridDim.z;
    unsigned sum, cnt, sp = 0u;
    for (;;) {
        sum = 0u; cnt = 0u;
#pragma unroll 1
        for (unsigned j = 0; j < 16; ++j) { const unsigned c = xb_ld(&bar[XB_XCNT(j)]); sum += c; cnt += (c > 0u) ? 1u : 0u; }
        if (sum == G) break;
        __builtin_amdgcn_s_sleep(1);
        if ((++sp & 255u) == 0u) { if (xb_ld(&bar[XB_TMO])) break; if (sp > XB_SPIN_CAP) { atomicAdd(&bar[XB_TMO], 1u); break; } }
    }
    const unsigned mine = xb_ld(&bar[XB_XCNT(x)]);
    nloc = mine > 0u ? mine : 1u; nx = cnt > 0u ? cnt : 1u;
}
__device__ __noinline__ void xcd_barrier(const XcdBarrier b, const int tid) {
    asm volatile("s_waitcnt vmcnt(0)" ::: "memory");
    __syncthreads();
    if (tid == 0) {
        unsigned* bar = b.bar;
        __builtin_amdgcn_s_waitcnt(0);
        unsigned nloc = b.st[0], nx = b.st[1];
        if (nloc == 0u) { xcd_barrier_complete(bar, b.x, nloc, nx); b.st[0] = nloc; b.st[1] = nx; }
        const unsigned old = xb_add(&bar[XB_XSUB(b.x)], 1u);
        const unsigned gen = old / nloc;
        if (old + 1u == (gen + 1u) * nloc) {
            __builtin_amdgcn_fence(__ATOMIC_RELEASE, "agent");
            asm volatile("s_waitcnt vmcnt(0)" ::: "memory");
            const unsigned og = xb_add(&bar[XB_TOP], 1u);
            const unsigned tg = og / nx;
            if (og + 1u == (tg + 1u) * nx) xb_add(&bar[XB_TOPGEN], 1u);
            else XB_SPIN(xb_ld(&bar[XB_TOPGEN]) == tg, bar);
            __builtin_amdgcn_fence(__ATOMIC_ACQUIRE, "agent");
            xb_add(&bar[XB_XGEN(b.x)], 1u);
            asm volatile("s_waitcnt vmcnt(0)" ::: "memory");
        } else {
            XB_SPIN(xb_ld(&bar[XB_XGEN(b.x)]) == gen, bar);
            __builtin_amdgcn_fence(__ATOMIC_ACQUIRE, "agent");
            asm volatile("s_waitcnt vmcnt(0)" ::: "memory");
        }
    }
    __syncthreads();
}

struct Args { const void* in[24]; float* out; unsigned char* ws; int ph_lo, ph_hi; };
struct Ctx {
    LAS unsigned char* lds;
    unsigned* ctl;
    int tid, lane, wave, bid, G;
    int chunk, layer, pass;
    const float* x_in; float* xo;
    const int* pos;
    const unsigned char* lw;
    bf16_t *act, *proj, *hid, *ys, *brx;
    unsigned* rec; int* list;
};

__device__ __forceinline__ void tr_item(const float* srcp, int Nsrc, float scale, bf16_t* WT, int K, int n0, int k0, LAS float* scr, int lane) {
#pragma unroll 8
    for (int i = 0; i < 32; ++i) { const int kk = 2 * i + (lane >> 5); scr[kk * 33 + (lane & 31)] = srcp[(size_t)(k0 + kk) * Nsrc] * scale; }
    LDS_WAIT(); asm volatile("" ::: "memory");
    const int c = lane & 7;
#pragma unroll
    for (int j = 0; j < 4; ++j) { const int n = (lane >> 3) + 8 * j; const LAS float* s = scr + (8 * c) * 33 + n;
        u32x4 o; o.x = pk2(s[0 * 33], s[1 * 33]); o.y = pk2(s[2 * 33], s[3 * 33]); o.z = pk2(s[4 * 33], s[5 * 33]); o.w = pk2(s[6 * 33], s[7 * 33]);
        *(u32x4*)(WT + (size_t)(n0 + n) * K + k0 + 8 * c) = o; }
    LDS_WAIT(); asm volatile("" ::: "memory");
}
constexpr int IT_WIN = (NP / 32) * 16, IT_WBR = 3 * 32 * 8, IT_WOUT = 32 * 16, IT_WGU = NE * 32 * 16, IT_WDN = NE * 32 * 8, IT_LAYER = IT_WIN + IT_WBR + IT_WOUT + IT_WGU + IT_WDN;
__device__ __forceinline__ void phase_prep(const Args& a, LAS unsigned char* lds, int gw, int NGW, int wave, int lane, int gtid, int NGT) {
    LAS float* scr = (LAS float*)(lds + wave * 16384);
    for (int it = gw; it < DEPTH * IT_LAYER; it += NGW) {
        const int l = it / IT_LAYER; int r = it % IT_LAYER;
        unsigned char* lw = a.ws + WS_W + (size_t)l * LW_SIZE;
        const int rl = lane & 31;
        if (r < IT_WIN) {
            const int g = r / 16, kb = r % 16;
            if (g >= C_GP / 32 && g < C_XB / 32) continue;
            const int n = 32 * g + rl; const int src = n < C_GP ? n : n - 240;
            const float* W = (const float*)a.in[3] + (size_t)l * D * WIN_N;
            tr_item(W + src, WIN_N, n < 256 ? 0.125f : 1.f, (bf16_t*)(lw + LW_WIN), D, 32 * g, 64 * kb, scr, lane);
            continue; }
        r -= IT_WIN;
        if (r < IT_WBR) {
            const int b = r / 256, g = (r % 256) / 8, kb = r % 8;
            const float* W = (const float*)a.in[16] + ((size_t)l * 3 + b) * 512 * D;
            tr_item(W + 32 * g + rl, D, 1.f, (bf16_t*)(lw + LW_WBR) + (size_t)b * D * 512, 512, 32 * g, 64 * kb, scr, lane);
            continue; }
        r -= IT_WBR;
        if (r < IT_WOUT) {
            const int g = r / 16, kb = r % 16;
            const float* W = (const float*)a.in[17] + (size_t)l * D * D;
            tr_item(W + 32 * g + rl, D, 1.f, (bf16_t*)(lw + LW_WOUT), D, 32 * g, 64 * kb, scr, lane);
            continue; }
        r -= IT_WOUT;
        if (r < IT_WGU) {
            const int e = r / 512, g = (r % 512) / 16, kb = r % 16;
            const float* Wg = (const float*)a.in[21] + ((size_t)l * NE + e) * D * FF;
            const float* Wu = (const float*)a.in[22] + ((size_t)l * NE + e) * D * FF;
            const float* sp = (rl < 16 ? Wg : Wu) + 16 * g + (rl & 15);
            tr_item(sp, FF, 1.f, (bf16_t*)(lw + LW_WGU) + (size_t)e * 1024 * D, D, 32 * g, 64 * kb, scr, lane);
            continue; }
        r -= IT_WGU;
        {
            const int e = r / 256, g = (r % 256) / 8, kb = r % 8;
            const float* W = (const float*)a.in[23] + ((size_t)l * NE + e) * FF * D;
            tr_item(W + 32 * g + rl, D, 1.f, (bf16_t*)(lw + LW_WDN) + (size_t)e * D * FF, FF, 32 * g, 64 * kb, scr, lane);
        }
    }
    for (int idx = gtid; idx < DEPTH * 256 * D; idx += NGT) {
        const int l = idx / (256 * D), j = (idx / D) % 256, k = idx % D;
        const float* W = (const float*)a.in[3] + (size_t)l * D * WIN_N + (size_t)k * WIN_N + 1536;
        const float* gu = (const float*)a.in[4] + (size_t)l * 16 * 256 + j;
        float s = 0.f;
#pragma unroll
        for (int r = 0; r < 16; ++r) s += W[r] * gu[r * 256];
        ((bf16_t*)(a.ws + WS_W + (size_t)l * LW_SIZE + LW_WIN))[(size_t)(C_GP + j) * D + k] = (bf16_t)f2bf(s);
    }
}

__device__ __forceinline__ void moe_tables(const unsigned* cnt, LAS int* pt, LAS int* lc, int tid) {
    if (tid == 0) { int s = 0;
        for (int e = 0; e < NE; ++e) { const int c = (int)__hip_atomic_load(cnt + e, __ATOMIC_RELAXED, __HIP_MEMORY_SCOPE_AGENT); pt[e] = s; lc[e] = c; s += (c + 255) >> 8; }
        pt[NE] = s; }
    __syncthreads();
}

template <bool COMBINE, bool NORM, bool SRC_OUT>
__device__ __forceinline__ void phase_norm1(const Ctx& c, const float* gain, LAS const int* pt) {
    const int gw = c.bid * NWAVES + c.wave, NGW = c.G * NWAVES, lane = c.lane;
    f32x4 g4[4];
    if (NORM) {
#pragma unroll
        for (int j = 0; j < 4; ++j) g4[j] = *((const f32x4*)gain + 64 * j + lane); }
    constexpr int NR = 4;
    static_assert(TC % (NR * 2048) == 0, "rows per wave");
    for (int tok0 = gw; tok0 < TC; tok0 += NR * NGW) {
        f32x4 v[NR][4]; u32x2 ya[NR][4], yb[NR][4]; float w0[NR], w1[NR];
#pragma unroll
        for (int r = 0; r < NR; ++r) { const int tok = tok0 + r * NGW;
            const f32x4* xr = (const f32x4*)((SRC_OUT ? (const float*)c.xo : c.x_in) + (size_t)tok * D) + lane;
#pragma unroll
            for (int j = 0; j < 4; ++j) v[r][j] = xr[64 * j];
            if (COMBINE) {
                const u32x4 rc = *(const u32x4*)(c.rec + (size_t)tok * 4);
                const int e0 = rc.x >> 20, e1 = rc.y >> 20;
                const size_t r0 = (size_t)pt[e0] * 256 + (rc.x & 0xfffffu), r1 = (size_t)pt[e1] * 256 + (rc.y & 0xfffffu);
                w0[r] = __uint_as_float(rc.z); w1[r] = __uint_as_float(rc.w);
                const u32x2* y0 = (const u32x2*)(c.ys + r0 * D) + lane; const u32x2* y1 = (const u32x2*)(c.ys + r1 * D) + lane;
#pragma unroll
                for (int j = 0; j < 4; ++j) { ya[r][j] = y0[64 * j]; yb[r][j] = y1[64 * j]; }
            } }
#pragma unroll
        for (int r = 0; r < NR; ++r) { const int tok = tok0 + r * NGW;
            if (COMBINE) {
#pragma unroll
                for (int j = 0; j < 4; ++j) { const u32x2 a = ya[r][j], b = yb[r][j];
                    v[r][j].x += w0[r] * bflo(a.x) + w1[r] * bflo(b.x); v[r][j].y += w0[r] * bfhi(a.x) + w1[r] * bfhi(b.x);
                    v[r][j].z += w0[r] * bflo(a.y) + w1[r] * bflo(b.y); v[r][j].w += w0[r] * bfhi(a.y) + w1[r] * bfhi(b.y); }
                f32x4* xw = (f32x4*)(c.xo + (size_t)tok * D) + lane;
#pragma unroll
                for (int j = 0; j < 4; ++j) xw[64 * j] = v[r][j];
            }
            if (NORM) {
                float ss = 0.f;
#pragma unroll
                for (int j = 0; j < 4; ++j) ss += (v[r][j].x * v[r][j].x + v[r][j].y * v[r][j].y) + (v[r][j].z * v[r][j].z + v[r][j].w * v[r][j].w);
                const float rs = rsqf_(wave_sum(ss) * (1.f / D) + RMS_EPS);
                u32x2* o = (u32x2*)(c.act + (size_t)tok * D) + lane;
#pragma unroll
                for (int j = 0; j < 4; ++j) { u32x2 w; w.x = pk2(v[r][j].x * rs * g4[j].x, v[r][j].y * rs * g4[j].y); w.y = pk2(v[r][j].z * rs * g4[j].z, v[r][j].w * rs * g4[j].w); o[64 * j] = w; }
            } }
    }
}

__constant__ double kInvFreq[16] = {1.0, 0.44036660267178046, 0.19392274474868576, 0.08539710028576561, 0.03760603093086393, 0.016560440080994446, 0.007292664737217109, 0.003211445994752591,
    0.001414213562373095, 0.000622772421914596, 0.0002742481756762073, 0.00012076973741146504, 5.318295896944988e-05, 2.341999896140934e-05, 1.031338537721246e-05, 4.5416704806078695e-06};
__device__ __forceinline__ void phase_rope_table(const int* pos, float* tab, int gtid, int NGT) {
    for (int idx = gtid; idx < BATCH * SEQ * 16; idx += NGT) { const int tok = idx >> 4, i = idx & 15;
        double a = (double)pos[tok] * kInvFreq[i] * 0.15915494309189535; a -= rint(a);
        tab[(size_t)tok * 32 + i] = __builtin_amdgcn_cosf((float)a); tab[(size_t)tok * 32 + 16 + i] = __builtin_amdgcn_sinf((float)a); }
}

__device__ __forceinline__ float logsigmoidf_(float g) { return fminf(g, 0.f) - log1pf(__expf(-fabsf(g))); }
__device__ __forceinline__ float gelu_tanh(float y) { const float u = 0.7978845608028654f * (y + 0.044715f * y * y * y); const float t = 1.f - 2.f * rcpf_(1.f + __expf(2.f * u)); return 0.5f * y * (1.f + t); }

__device__ __forceinline__ void gla_simple(const Ctx& c, int b, const float* gbias, const float* ogain) {
    LAS float* sQ = (LAS float*)c.lds; LAS float* sK = sQ + 16 * 256; LAS float* sA = sK + 16 * 256; LAS float* sO = sA + 16 * 256; LAS float* sV = sO + 16 * 512;
    const int tid = c.tid, h = tid >> 7, lane = c.lane;
    float S[64];
#pragma unroll
    for (int i = 0; i < 64; ++i) S[i] = 0.f;
    const float og0 = ogain[2 * lane], og1 = ogain[2 * lane + 1];
    for (int tc = 0; tc < SEQ / 16; ++tc) {
        const size_t tok0 = (size_t)b * SEQ + tc * 16;
        __syncthreads();
        for (int idx = tid; idx < 16 * 256; idx += NTHR) { const int s = idx >> 8, ci = idx & 255; const bf16_t* row = c.proj + (tok0 + s) * NP;
            sQ[idx] = bf2f(row[C_QA + ci]); sK[idx] = bf2f(row[C_KA + ci]);
            sA[idx] = __expf(logsigmoidf_(bf2f(row[C_GP + ci]) + gbias[ci]) * (1.f / 16.f)); }
#pragma unroll
        for (int s = 0; s < 16; ++s) sV[s * 512 + tid] = bf2f(c.proj[(tok0 + s) * NP + C_VA + tid]);
        __syncthreads();
        for (int s = 0; s < 16; ++s) {
            const float v = sV[s * 512 + tid]; float o = 0.f;
            const LAS f32x4* a4 = (const LAS f32x4*)(sA + s * 256 + h * 64); const LAS f32x4* k4 = (const LAS f32x4*)(sK + s * 256 + h * 64); const LAS f32x4* q4 = (const LAS f32x4*)(sQ + s * 256 + h * 64);
#pragma unroll
            for (int d = 0; d < 16; ++d) { const f32x4 a = a4[d], k = k4[d], q = q4[d];
                S[4 * d + 0] = S[4 * d + 0] * a.x + k.x * v; o += q.x * S[4 * d + 0];
                S[4 * d + 1] = S[4 * d + 1] * a.y + k.y * v; o += q.y * S[4 * d + 1];
                S[4 * d + 2] = S[4 * d + 2] * a.z + k.z * v; o += q.z * S[4 * d + 2];
                S[4 * d + 3] = S[4 * d + 3] * a.w + k.w * v; o += q.w * S[4 * d + 3]; }
            sO[s * 512 + tid] = o;
        }
        __syncthreads();
#pragma unroll 2
        for (int k = 0; k < 8; ++k) { const int rr = c.wave * 8 + k, s = rr >> 2, hh = rr & 3;
            const float o0 = sO[s * 512 + hh * 128 + 2 * lane], o1 = sO[s * 512 + hh * 128 + 2 * lane + 1];
            const float rs = rsqf_(wave_sum(o0 * o0 + o1 * o1) * (1.f / 128.f) + RMS_EPS);
            unsigned* pp = (unsigned*)(c.proj + (tok0 + s) * NP + C_OG + hh * 128) + lane;
            const unsigned u = *pp; const float g0 = bflo(u), g1 = bfhi(u);
            *pp = pk2(o0 * rs * og0 * g0 * sigmoidf_(g0), o1 * rs * og1 * g1 * sigmoidf_(g1)); }
    }
}

__device__ __forceinline__ void lru_simple(const Ctx& c, int b, const float* convw, const float* convb, const float* wa_, const float* ba_, const float* wx_, const float* bx_, const float* lam_) {
    const int ch = c.tid, n = c.wave, lane = c.lane;
    LAS float* sX = (LAS float*)(c.lds + n * 4096);
    const float* wap = wa_ + n * 4096 + lane; const float* wxp = wx_ + n * 4096 + lane;
    const float cw0 = convw[ch], cw1 = convw[512 + ch], cw2 = convw[1024 + ch], cw3 = convw[1536 + ch], cb = convb[ch], ba = ba_[ch], bx = bx_[ch];
    const float lam = lam_[ch]; const float c8 = 8.f * (fmaxf(-lam, 0.f) + log1pf(__expf(-fabsf(lam))));
    float xm1 = 0.f, xm2 = 0.f, xm3 = 0.f, hs = 0.f;
    for (int tc = 0; tc < SEQ / 16; ++tc) {
        const size_t tok0 = (size_t)b * SEQ + tc * 16;
        float xc[16], yv[16], ar[16], ai[16];
#pragma unroll
        for (int s = 0; s < 16; ++s) { xc[s] = bf2f(c.proj[(tok0 + s) * NP + C_XB + ch]); yv[s] = bf2f(c.proj[(tok0 + s) * NP + C_YB + ch]); }
#pragma unroll
        for (int s = 0; s < 16; ++s) { const float x = xc[s]; xc[s] = cb + cw0 * xm3 + cw1 * xm2 + cw2 * xm1 + cw3 * x; xm3 = xm2; xm2 = xm1; xm1 = x; sX[s * 64 + lane] = xc[s]; ar[s] = ba; ai[s] = bx; }
        LDS_WAIT(); asm volatile("" ::: "memory"); __builtin_amdgcn_wave_barrier();
#pragma unroll 2
        for (int k = 0; k < 64; ++k) { const float wa = wap[k * 64], wx = wxp[k * 64];
#pragma unroll
            for (int s = 0; s < 16; ++s) { const float x = sX[s * 64 + k]; ar[s] += x * wa; ai[s] += x * wx; } }
#pragma unroll
        for (int s = 0; s < 16; ++s) {
            const float r = sigmoidf_(ar[s]), ig = sigmoidf_(ai[s]);
            const float a = __expf(-c8 * r);
            const float u = sqrtf(fmaxf(1.f - a * a, 0.f)) * ig * xc[s];
            hs = a * hs + u;
            c.proj[(tok0 + s) * NP + C_YB + ch] = (bf16_t)f2bf(hs * gelu_tanh(yv[s]));
        }
        LDS_WAIT(); asm volatile("" ::: "memory"); __builtin_amdgcn_wave_barrier();
    }
}

__device__ __forceinline__ void attn_simple(const Ctx& c, int aw, int NAW) {
    const int lane = c.lane;
    for (int task = aw; task < TC * 4; task += NAW) {
        const int tok = task >> 2, h = task & 3, t = tok & (SEQ - 1);
        float ml = -INFINITY, wsum = 0.f, acc0 = 0.f, acc1 = 0.f;
#pragma unroll 1
        for (int p = 0; p < 3; ++p) {
            const int dsh = 2 * p, i = t >> dsh, nk = i + 1 < 129 ? i + 1 : 129;
            const bf16_t* qrow = c.proj + (size_t)tok * NP + C_QKV + (p * 4 + h) * 128;
            const int kcol = C_QKV + (12 + p * 4 + h) * 128, vcol = C_QKV + (24 + p * 4 + h) * 128;
            float sc[3];
#pragma unroll
            for (int r = 0; r < 3; ++r) {
                sc[r] = -INFINITY;
                if (64 * r < nk) {
                    const int m = 64 * r + lane; const bool valid = m < nk;
                    const bf16_t* krow = c.proj + (size_t)(tok - ((valid ? m : 0) << dsh)) * NP + kcol;
                    float s = 0.f;
#pragma unroll 1
                    for (int cb = 0; cb < 4; ++cb) {
                        u32x4 kq[4], qq[4];
#pragma unroll
                        for (int j = 0; j < 4; ++j) { kq[j] = *((const u32x4*)krow + cb * 4 + j); qq[j] = *((const u32x4*)qrow + cb * 4 + j); }
#pragma unroll
                        for (int j = 0; j < 4; ++j) {
                            s += bflo(kq[j].x) * bflo(qq[j].x) + bfhi(kq[j].x) * bfhi(qq[j].x) + bflo(kq[j].y) * bflo(qq[j].y) + bfhi(kq[j].y) * bfhi(qq[j].y)
                               + bflo(kq[j].z) * bflo(qq[j].z) + bfhi(kq[j].z) * bfhi(qq[j].z) + bflo(kq[j].w) * bflo(qq[j].w) + bfhi(kq[j].w) * bfhi(qq[j].w); }
                    }
                    sc[r] = valid ? s * 0.08838834764831845f : -INFINITY;
                }
            }
            const float mx = wave_max(fmaxf(sc[0], fmaxf(sc[1], sc[2])));
            float pr[3];
#pragma unroll
            for (int r = 0; r < 3; ++r) pr[r] = __expf(sc[r] - mx);
            const float den = wave_sum(pr[0] + pr[1] + pr[2]);
            float o0 = 0.f, o1 = 0.f;
#pragma unroll
            for (int r = 0; r < 3; ++r) {
                const int cnt = nk - 64 * r < 64 ? nk - 64 * r : 64;
                if (cnt > 0) {
                const unsigned* vb = (const unsigned*)(c.proj + (size_t)(tok - ((64 * r) << dsh)) * NP + vcol) + lane;
#pragma unroll 4
                for (int mm = 0; mm < cnt; ++mm) {
                    const float pm = __int_as_float(__builtin_amdgcn_readlane(__float_as_int(pr[r]), mm));
                    const unsigned u = *(const unsigned*)((const char*)vb - (size_t)(mm << dsh) * NP * 2);
                    o0 += pm * bflo(u); o1 += pm * bfhi(u); }
                }
            }
            const float inv = rcpf_(den), lse = mx + __logf(den);
            const float nml = fmaxf(ml, lse), sc_old = __expf(ml - nml), w = __expf(lse - nml);
            acc0 = acc0 * sc_old + w * o0 * inv; acc1 = acc1 * sc_old + w * o1 * inv; wsum = wsum * sc_old + w; ml = nml;
        }
        const float wi = rcpf_(wsum);
        unsigned* op = (unsigned*)(c.proj + (size_t)tok * NP + C_QKV + h * 128) + lane;
        *op = pk2(acc0 * wi, acc1 * wi);
    }
}

typedef unsigned short u16x4 __attribute__((ext_vector_type(4)));
__device__ __forceinline__ unsigned offb(unsigned row, unsigned ch) { return 256u * row + 16u * (ch ^ (((row & 3u) << 2) | ((row >> 2) & 3u))); }
constexpr int ATT_UNITS_PER_SEQ = 3 * 4 * 16;
struct AttU { int b, p, h, blk, dsh, it0; size_t tok0; int qcol, kcol, vcol; };
__device__ __forceinline__ AttU att_decode(int unit) {
    AttU a; a.b = unit / ATT_UNITS_PER_SEQ; const int rem = unit % ATT_UNITS_PER_SEQ; a.p = rem / 64; a.h = (rem / 16) & 3; const int qb = rem & 15;
    a.dsh = 2 * a.p; const int nblk = 16 >> a.dsh, r = qb / nblk; a.blk = qb % nblk; a.tok0 = (size_t)a.b * SEQ + r; a.it0 = a.blk == 0 ? 4 : 0;
    a.qcol = C_QKV + (a.p * 4 + a.h) * 128; a.kcol = C_QKV + (12 + a.p * 4 + a.h) * 128; a.vcol = C_QKV + (24 + a.p * 4 + a.h) * 128; return a;
}
#define ATT_DMA(U, col, dst) do { _Pragma("unroll") for (int it = 0; it < 8; ++it) if (it >= (U).it0) { const int q = w + 8 * it; const unsigned n = 64u * q + lane, row = n >> 4, cs = n & 15u, ch = cs ^ (((row & 3u) << 2) | ((row >> 2) & 3u)); \
        const int srow = ((U).blk - 1) * 128 + (int)row; \
        __builtin_amdgcn_global_load_lds((const unsigned*)(c.proj + ((U).tok0 + ((size_t)srow << (U).dsh)) * NP + (col) + ch * 8), (LAS unsigned*)((dst) + 1024 * q), 16, 0, 0); } } while (0)
#define ATT_LOADQ(U) do { const size_t qt = (U).tok0 + ((size_t)((U).blk * 128 + qi) << (U).dsh); \
        _Pragma("unroll") for (int s = 0; s < 4; ++s) qr[s] = *(const u32x4*)(c.proj + qt * NP + (U).qcol + 32 * s + 8 * g); \
        const f32x4* rt = (const f32x4*)(rope_tab + qt * 32 + 8 * (g & 1)); qc0 = rt[0]; qc1 = rt[1]; qs0 = rt[4]; qs1 = rt[5]; \
        int srow = ((U).blk - 1) * 128 + (int)rrow; if (srow < 0) srow += 128; \
        const float* rt2 = rope_tab + ((U).tok0 + ((size_t)srow << (U).dsh)) * 32 + 8 * rps; \
        rc0 = *(const f32x4*)rt2; rc1 = *(const f32x4*)(rt2 + 4); rs0 = *(const f32x4*)(rt2 + 16); rs1 = *(const f32x4*)(rt2 + 20); } while (0)
__device__ __forceinline__ void attn_loop(const Ctx& c, unsigned* qhead, volatile LAS unsigned* mbox, float* lse_buf, const float* qgain, const float* kgain, const float* rope_tab  ) {
    const int tid = c.tid, lane = c.lane, w = c.wave;
    const unsigned NU = (unsigned)(BC * ATT_UNITS_PER_SEQ);
    LAS unsigned char* sK = c.lds; LAS unsigned char* sV = c.lds + 65536;
    LAS float* sRS = (LAS float*)(c.lds + MISC_OFF + 2048);
    const int qq = lane & 15, g = lane >> 4, qi = 16 * w + qq;
    const unsigned rrow = (unsigned)tid >> 1, rps = (unsigned)tid & 1u;
#if defined(PROBE_MASK) && PROBE_MASK
    unsigned long long _ta = __builtin_amdgcn_s_memrealtime();
#define ATT_STAMP(k) do { const unsigned long long _tb = __builtin_amdgcn_s_memrealtime(); if (blockIdx.x == PROBE_BLOCK && tid == 0) ((LAS unsigned*)(c.lds + MISC_OFF + 512))[(k)] += (unsigned)(_tb - _ta); _ta = _tb; } while (0)
#else
#define ATT_STAMP(k) do {} while (0)
#endif
    LAS float* sGQ = (LAS float*)(c.lds + MISC_OFF + 3072); LAS float* sGK = sGQ + 128;
    if (tid < 128) sGQ[tid] = qgain[tid]; else if (tid < 256) sGK[tid - 128] = kgain[tid - 128];
    if (tid == 0) { mbox[0] = __hip_atomic_fetch_add(qhead, 1u, __ATOMIC_RELAXED, __HIP_MEMORY_SCOPE_AGENT); mbox[1] = __hip_atomic_fetch_add(qhead, 1u, __ATOMIC_RELAXED, __HIP_MEMORY_SCOPE_AGENT); }
    __syncthreads();
    unsigned ucur = mbox[0], unxt = mbox[1];
    if (ucur >= NU) return;
    AttU U = att_decode((int)ucur);
    u32x4 qr[4]; f32x4 qc0, qc1, qs0, qs1, rc0, rc1, rs0, rs1;
    __syncthreads();
    ATT_DMA(U, U.kcol, sK); asm volatile("" ::: "memory");
    ATT_LOADQ(U); asm volatile("" ::: "memory");
    ATT_DMA(U, U.vcol, sV); asm volatile("" ::: "memory");
    bool first = true; unsigned nq = 0u;
    for (;;) {
        const int blk = U.blk, dsh = U.dsh, it0 = U.it0;
        const size_t qtok = U.tok0 + ((size_t)(blk * 128 + qi) << dsh);
        bf16x8 qf[4];
        {
            float qv[4][8]; float ss = 0.f;
#pragma unroll
            for (int s = 0; s < 4; ++s) { const unsigned wv[4] = {qr[s].x, qr[s].y, qr[s].z, qr[s].w};
#pragma unroll
                for (int k = 0; k < 4; ++k) { qv[s][2 * k] = bflo(wv[k]); qv[s][2 * k + 1] = bfhi(wv[k]); ss += qv[s][2 * k] * qv[s][2 * k] + qv[s][2 * k + 1] * qv[s][2 * k + 1]; } }
            ss += swz_xor<16>(ss);
            { const auto rr = __builtin_amdgcn_permlane32_swap(__float_as_uint(ss), __float_as_uint(ss), false, false); ss = __uint_as_float(rr[0]) + __uint_as_float(rr[1]); }
            const float rs = rsqf_(ss * (1.f / 128.f) + RMS_EPS);
#pragma unroll
            for (int s = 0; s < 4; ++s) { const f32x4 g0 = *(const LAS f32x4*)(sGQ + 32 * s + 8 * g), g1 = *(const LAS f32x4*)(sGQ + 32 * s + 8 * g + 4);
                const float gg[8] = {g0.x, g0.y, g0.z, g0.w, g1.x, g1.y, g1.z, g1.w};
#pragma unroll
                for (int j = 0; j < 8; ++j) qv[s][j] *= rs * gg[j]; }
            { const float cs8[8] = {qc0.x, qc0.y, qc0.z, qc0.w, qc1.x, qc1.y, qc1.z, qc1.w}, sn8[8] = {qs0.x, qs0.y, qs0.z, qs0.w, qs1.x, qs1.y, qs1.z, qs1.w};
              const float sgn = (g & 2) ? 1.f : -1.f;
#pragma unroll
              for (int j = 0; j < 8; ++j) { const auto rr = __builtin_amdgcn_permlane32_swap(__float_as_uint(qv[0][j]), __float_as_uint(qv[0][j]), false, false);
                  const float other = (g & 2) ? __uint_as_float(rr[0]) : __uint_as_float(rr[1]);
                  qv[0][j] = qv[0][j] * cs8[j] + sgn * other * sn8[j]; } }
#pragma unroll
            for (int s = 0; s < 4; ++s) { u32x4 pw; pw.x = pk2(qv[s][0], qv[s][1]); pw.y = pk2(qv[s][2], qv[s][3]); pw.z = pk2(qv[s][4], qv[s][5]); pw.w = pk2(qv[s][6], qv[s][7]); qf[s] = __builtin_bit_cast(bf16x8, pw); }
        }
        const f32x4 kc0 = rc0, kc1 = rc1, ks0v = rs0, ks1v = rs1;
        if (first) { if (it0) asm volatile("s_waitcnt vmcnt(4)" ::: "memory"); else asm volatile("s_waitcnt vmcnt(8)" ::: "memory"); }
        else       { if (it0) asm volatile("s_waitcnt vmcnt(13)" ::: "memory"); else asm volatile("s_waitcnt vmcnt(17)" ::: "memory"); }
        first = false;
        __syncthreads();
        if (tid == 0) nq = __hip_atomic_fetch_add(qhead, 1u, __ATOMIC_RELAXED, __HIP_MEMORY_SCOPE_AGENT);
        ATT_STAMP(5);
        {
            const int c16 = tid & 15, grp = tid >> 4;
            const f32x4 kg0 = *(const LAS f32x4*)(sGK + 8 * c16), kg1 = *(const LAS f32x4*)(sGK + 8 * c16 + 4);
            const float kg[8] = {kg0.x, kg0.y, kg0.z, kg0.w, kg1.x, kg1.y, kg1.z, kg1.w};
#pragma unroll 4
            for (int it = it0; it < 8; ++it) { const unsigned row = 32u * it + grp;
                LAS u32x4* kp_ = (LAS u32x4*)(sK + offb(row, c16));
                const u32x4 kr = *kp_; const unsigned wv[4] = {kr.x, kr.y, kr.z, kr.w};
                float kv[8]; float ss = 0.f;
#pragma unroll
                for (int k = 0; k < 4; ++k) { kv[2 * k] = bflo(wv[k]); kv[2 * k + 1] = bfhi(wv[k]); ss += kv[2 * k] * kv[2 * k] + kv[2 * k + 1] * kv[2 * k + 1]; }
                ss += swz_xor<1>(ss); ss += swz_xor<2>(ss); ss += swz_xor<4>(ss); ss += swz_xor<8>(ss);
                const float rs = rsqf_(ss * (1.f / 128.f) + RMS_EPS);
                if (c16 == 0) sRS[row] = rs;
                if (c16 >= 4) { u32x4 ko; ko.x = pk2(kv[0] * rs * kg[0], kv[1] * rs * kg[1]); ko.y = pk2(kv[2] * rs * kg[2], kv[3] * rs * kg[3]); ko.z = pk2(kv[4] * rs * kg[4], kv[5] * rs * kg[5]); ko.w = pk2(kv[6] * rs * kg[6], kv[7] * rs * kg[7]); *kp_ = ko; } }
        }
        __syncthreads();
        {
            const f32x4 ga0 = *(const LAS f32x4*)(sGK + 8 * rps), ga1 = *(const LAS f32x4*)(sGK + 8 * rps + 4), gb0 = *(const LAS f32x4*)(sGK + 16 + 8 * rps), gb1 = *(const LAS f32x4*)(sGK + 20 + 8 * rps);
            const float ga[8] = {ga0.x, ga0.y, ga0.z, ga0.w, ga1.x, ga1.y, ga1.z, ga1.w}, gb[8] = {gb0.x, gb0.y, gb0.z, gb0.w, gb1.x, gb1.y, gb1.z, gb1.w};
            const float cs8[8] = {kc0.x, kc0.y, kc0.z, kc0.w, kc1.x, kc1.y, kc1.z, kc1.w}, sn8[8] = {ks0v.x, ks0v.y, ks0v.z, ks0v.w, ks1v.x, ks1v.y, ks1v.z, ks1v.w};
            if (blk > 0 || rrow >= 128u) {
            LAS u32x4* p1 = (LAS u32x4*)(sK + offb(rrow, rps)); LAS u32x4* p2 = (LAS u32x4*)(sK + offb(rrow, rps + 2));
            const u32x4 a = *p1, b2 = *p2; const float rs = sRS[rrow];
            const unsigned wa[4] = {a.x, a.y, a.z, a.w}, wb[4] = {b2.x, b2.y, b2.z, b2.w};
            float o1[8], o2[8];
#pragma unroll
            for (int k = 0; k < 4; ++k) {
#pragma unroll
                for (int e = 0; e < 2; ++e) { const int j = 2 * k + e; const float x1 = (e ? bfhi(wa[k]) : bflo(wa[k])) * rs * ga[j], x2 = (e ? bfhi(wb[k]) : bflo(wb[k])) * rs * gb[j];
                    o1[j] = x1 * cs8[j] - x2 * sn8[j]; o2[j] = x2 * cs8[j] + x1 * sn8[j]; } }
            u32x4 w1, w2; w1.x = pk2(o1[0], o1[1]); w1.y = pk2(o1[2], o1[3]); w1.z = pk2(o1[4], o1[5]); w1.w = pk2(o1[6], o1[7]); w2.x = pk2(o2[0], o2[1]); w2.y = pk2(o2[2], o2[3]); w2.z = pk2(o2[4], o2[5]); w2.w = pk2(o2[6], o2[7]);
            *p1 = w1; *p2 = w2; }
        }
        __syncthreads();
        ATT_STAMP(6);
        const int ks0 = w >> 1, nskip = blk == 0 ? 4 : 0;
        f32x4 st[5][2];
        const unsigned krow_l = 8u * (qq >> 2) + (qq & 3u);
        LAS unsigned char* ka[2][4];
#pragma unroll
        for (int T = 0; T < 2; ++T)
#pragma unroll
            for (int s = 0; s < 4; ++s) ka[T][s] = sK + offb(32u * ks0 + krow_l + 4u * T, 4 * s + g);
#pragma unroll
        for (int n = 0; n < 5; ++n)
#pragma unroll
            for (int T = 0; T < 2; ++T) { f32x4 a = {0.f, 0.f, 0.f, 0.f};
                if (ks0 + n >= nskip) {
#pragma unroll
                for (int s = 0; s < 4; ++s) { const bf16x8 kf = *(const LAS bf16x8*)(ka[T][s] + 8192 * n); a = __builtin_amdgcn_mfma_f32_16x16x32_bf16(kf, qf[s], a, 0, 0, 0); } }
                st[n][T] = a; }
        asm volatile("s_waitcnt vmcnt(0) lgkmcnt(0)" ::: "memory");
        if (tid == 0) mbox[0] = nq;
        __syncthreads();
        const bool has_next = unxt < NU;
        AttU UN = att_decode(has_next ? (int)unxt : 0);
        if (has_next) { ATT_DMA(UN, UN.kcol, sK); asm volatile("" ::: "memory"); ATT_LOADQ(UN); }
        asm volatile("" ::: "memory");
        const float SC = 0.08838834764831845f * 1.4426950408889634f;
        float mx = -INFINITY;
#pragma unroll
        for (int n = 0; n < 5; ++n)
#pragma unroll
            for (int T = 0; T < 2; ++T)
#pragma unroll
                for (int i = 0; i < 4; ++i) { const int kj = 32 * (ks0 + n) + 8 * g + 4 * T + i; const bool ok = (kj >= qi) && (kj <= qi + 128) && (blk > 0 || kj >= 128);
                    const float v = ok ? st[n][T][i] : -INFINITY; st[n][T][i] = v; mx = fmaxf(mx, v); }
        mx = fmaxf(mx, swz_xor<16>(mx));
        { const auto rr = __builtin_amdgcn_permlane32_swap(__float_as_uint(mx), __float_as_uint(mx), false, false); mx = fmaxf(__uint_as_float(rr[0]), __uint_as_float(rr[1])); }
        float sum = 0.f; const float mxs = mx * SC;
#pragma unroll
        for (int n = 0; n < 5; ++n)
#pragma unroll
            for (int T = 0; T < 2; ++T)
#pragma unroll
                for (int i = 0; i < 4; ++i) { const float e = __builtin_amdgcn_exp2f(__builtin_fmaf(st[n][T][i], SC, -mxs)); st[n][T][i] = e; sum += e; }
        sum += swz_xor<16>(sum);
        { const auto rr = __builtin_amdgcn_permlane32_swap(__float_as_uint(sum), __float_as_uint(sum), false, false); sum = __uint_as_float(rr[0]) + __uint_as_float(rr[1]); }
        const float inv = rcpf_(sum);
        ATT_STAMP(7);
        f32x4 ot[8];
#pragma unroll
        for (int cc = 0; cc < 8; ++cc) ot[cc] = (f32x4){0.f, 0.f, 0.f, 0.f};
        const unsigned tq = (unsigned)qq >> 2, tp = (unsigned)qq & 3u;
        const unsigned vbase = (unsigned)(size_t)sV;
        unsigned va[2][8];
#pragma unroll
        for (int t = 0; t < 2; ++t)
#pragma unroll
            for (int cc = 0; cc < 8; ++cc) va[t][cc] = vbase + offb(32u * ks0 + 8u * g + 4u * t + tq, 2 * cc + (tp >> 1)) + 8u * (tp & 1u);
#pragma unroll
        for (int n = 0; n < 5; ++n) if (ks0 + n >= nskip) {
            u32x4 pw; pw.x = pk2(st[n][0][0], st[n][0][1]); pw.y = pk2(st[n][0][2], st[n][0][3]); pw.z = pk2(st[n][1][0], st[n][1][1]); pw.w = pk2(st[n][1][2], st[n][1][3]);
            const bf16x8 pf = __builtin_bit_cast(bf16x8, pw);
            u16x4 v0[8], v1[8];
            asm volatile("ds_read_b64_tr_b16 %0, %16 offset:%32\n\tds_read_b64_tr_b16 %8, %24 offset:%32\n\t"
                         "ds_read_b64_tr_b16 %1, %17 offset:%32\n\tds_read_b64_tr_b16 %9, %25 offset:%32\n\t"
                         "ds_read_b64_tr_b16 %2, %18 offset:%32\n\tds_read_b64_tr_b16 %10, %26 offset:%32\n\t"
                         "ds_read_b64_tr_b16 %3, %19 offset:%32\n\tds_read_b64_tr_b16 %11, %27 offset:%32\n\t"
                         "ds_read_b64_tr_b16 %4, %20 offset:%32\n\tds_read_b64_tr_b16 %12, %28 offset:%32\n\t"
                         "ds_read_b64_tr_b16 %5, %21 offset:%32\n\tds_read_b64_tr_b16 %13, %29 offset:%32\n\t"
                         "ds_read_b64_tr_b16 %6, %22 offset:%32\n\tds_read_b64_tr_b16 %14, %30 offset:%32\n\t"
                         "ds_read_b64_tr_b16 %7, %23 offset:%32\n\tds_read_b64_tr_b16 %15, %31 offset:%32\n\t"
                         "s_waitcnt lgkmcnt(0)"
                         : "=&v"(v0[0]), "=&v"(v0[1]), "=&v"(v0[2]), "=&v"(v0[3]), "=&v"(v0[4]), "=&v"(v0[5]), "=&v"(v0[6]), "=&v"(v0[7]),
                           "=&v"(v1[0]), "=&v"(v1[1]), "=&v"(v1[2]), "=&v"(v1[3]), "=&v"(v1[4]), "=&v"(v1[5]), "=&v"(v1[6]), "=&v"(v1[7])
                         : "v"(va[0][0]), "v"(va[0][1]), "v"(va[0][2]), "v"(va[0][3]), "v"(va[0][4]), "v"(va[0][5]), "v"(va[0][6]), "v"(va[0][7]),
                           "v"(va[1][0]), "v"(va[1][1]), "v"(va[1][2]), "v"(va[1][3]), "v"(va[1][4]), "v"(va[1][5]), "v"(va[1][6]), "v"(va[1][7]), "i"(8192 * n) : "memory");
#pragma unroll
            for (int cc = 0; cc < 8; ++cc) {
                bf16x8 vf; vf[0] = (short)v0[cc][0]; vf[1] = (short)v0[cc][1]; vf[2] = (short)v0[cc][2]; vf[3] = (short)v0[cc][3]; vf[4] = (short)v1[cc][0]; vf[5] = (short)v1[cc][1]; vf[6] = (short)v1[cc][2]; vf[7] = (short)v1[cc][3];
                ot[cc] = __builtin_amdgcn_mfma_f32_16x16x32_bf16(vf, pf, ot[cc], 0, 0, 0);
            }
        }
        __syncthreads();
        asm volatile("" ::: "memory");
        if (has_next) ATT_DMA(UN, UN.vcol, sV);
        asm volatile("" ::: "memory");
        bf16_t* orow = c.proj + qtok * NP + U.qcol;
#pragma unroll
        for (int cc = 0; cc < 8; ++cc) { u32x2 o; o.x = pk2(ot[cc][0] * inv, ot[cc][1] * inv); o.y = pk2(ot[cc][2] * inv, ot[cc][3] * inv); *(u32x2*)(orow + 16 * cc + 4 * g) = o; }
        if (g == 0) lse_buf[qtok * 12 + U.p * 4 + U.h] = mx * 0.08838834764831845f + __logf(sum);
        ATT_STAMP(8);
        if (!has_next) break;
        U = UN; unxt = mbox[0];
    }
    asm volatile("s_waitcnt vmcnt(0)" ::: "memory");
    __syncthreads();
}
#undef ATT_STAMP
#undef ATT_DMA
#undef ATT_LOADQ

__device__ __forceinline__ void phase_attn_combine(const Ctx& c, const float* lse_buf) {
    const int gw = c.bid * NWAVES + c.wave, NGW = c.G * NWAVES, lane = c.lane;
    constexpr int NR = 2;
    for (int tok0 = gw; tok0 < TC; tok0 += NR * NGW) {
        unsigned u[NR][3][4]; float l[NR][12];
#pragma unroll
        for (int r = 0; r < NR; ++r) { const int tok = tok0 + r * NGW;
            const float* ls = lse_buf + (size_t)tok * 12; const bf16_t* row = c.proj + (size_t)tok * NP + C_QKV;
#pragma unroll
            for (int k = 0; k < 12; ++k) l[r][k] = ls[k];
#pragma unroll
            for (int p = 0; p < 3; ++p)
#pragma unroll
                for (int h = 0; h < 4; ++h) u[r][p][h] = *((const unsigned*)(row + (4 * p + h) * 128) + lane); }
#pragma unroll
        for (int r = 0; r < NR; ++r) { const int tok = tok0 + r * NGW;
#pragma unroll
            for (int h = 0; h < 4; ++h) {
                const float l0 = l[r][h], l1 = l[r][4 + h], l2 = l[r][8 + h], ml = fmaxf(l0, fmaxf(l1, l2));
                const float w0 = __expf(l0 - ml), w1 = __expf(l1 - ml), w2 = __expf(l2 - ml), wi = rcpf_(w0 + w1 + w2);
                *((unsigned*)(c.brx + (size_t)2 * TC * 512 + (size_t)tok * 512 + h * 128) + lane) =
                    pk2((w0 * bflo(u[r][0][h]) + w1 * bflo(u[r][1][h]) + w2 * bflo(u[r][2][h])) * wi, (w0 * bfhi(u[r][0][h]) + w1 * bfhi(u[r][1][h]) + w2 * bfhi(u[r][2][h])) * wi);
            } }
    }
}

__device__ __forceinline__ int crow(int reg, int hh) { return (reg & 3) + 8 * (reg >> 2) + 4 * hh; }
typedef float f32x16 __attribute__((ext_vector_type(16)));
__device__ __forceinline__ unsigned tr_addr32(unsigned lane, unsigned rowbase, unsigned cblk, unsigned t, bool perm) {
    const unsigned hh = lane >> 5, blk = (lane >> 4) & 1u, q = (lane & 15u) >> 2, p = lane & 3u;
    const unsigned row = rowbase + (perm ? 8u * t + 4u * hh : 8u * hh + 4u * t) + q;
    return offb(row, 4u * cblk + 2u * blk + (p >> 1)) + 8u * (p & 1u);
}
__device__ __forceinline__ bf16x8 tr_frag(unsigned a0, unsigned a1) {
    u16x4 v0, v1;
    asm volatile("ds_read_b64_tr_b16 %0, %2\n\tds_read_b64_tr_b16 %1, %3\n\ts_waitcnt lgkmcnt(0)" : "=&v"(v0), "=&v"(v1) : "v"(a0), "v"(a1) : "memory");
    bf16x8 f; f[0] = (short)v0[0]; f[1] = (short)v0[1]; f[2] = (short)v0[2]; f[3] = (short)v0[3]; f[4] = (short)v1[0]; f[5] = (short)v1[1]; f[6] = (short)v1[2]; f[7] = (short)v1[3];
    return f;
}
__device__ __forceinline__ void tr_frag4(const unsigned (&a)[8], bf16x8 (&f)[4]) {
    u16x4 v[8];
    asm volatile("ds_read_b64_tr_b16 %0, %8\n\tds_read_b64_tr_b16 %1, %9\n\tds_read_b64_tr_b16 %2, %10\n\tds_read_b64_tr_b16 %3, %11\n\t"
                 "ds_read_b64_tr_b16 %4, %12\n\tds_read_b64_tr_b16 %5, %13\n\tds_read_b64_tr_b16 %6, %14\n\tds_read_b64_tr_b16 %7, %15\n\ts_waitcnt lgkmcnt(0)"
                 : "=&v"(v[0]), "=&v"(v[1]), "=&v"(v[2]), "=&v"(v[3]), "=&v"(v[4]), "=&v"(v[5]), "=&v"(v[6]), "=&v"(v[7])
                 : "v"(a[0]), "v"(a[1]), "v"(a[2]), "v"(a[3]), "v"(a[4]), "v"(a[5]), "v"(a[6]), "v"(a[7]) : "memory");
#pragma unroll
    for (int k = 0; k < 4; ++k) { f[k][0] = (short)v[2 * k][0]; f[k][1] = (short)v[2 * k][1]; f[k][2] = (short)v[2 * k][2]; f[k][3] = (short)v[2 * k][3];
        f[k][4] = (short)v[2 * k + 1][0]; f[k][5] = (short)v[2 * k + 1][1]; f[k][6] = (short)v[2 * k + 1][2]; f[k][7] = (short)v[2 * k + 1][3]; }
}
constexpr int GLA_QK = 0, GLA_KD = 16384, GLA_V = 32768  , GLA_ST = 65536  , GLA_O = 102400  , GLA_SEG = 136192  , GLA_DEC = 138240  ;
static_assert(GLA_DEC + 256 <= RING_BYTES, "gla lds");
__device__ __forceinline__ void gla_unit(const Ctx& c, int unit, const float* gbias, const float* ogain) {
    const int tid = c.tid, lane = c.lane, w = c.wave;
    const int b = unit >> 2, h = unit & 3;
    LAS unsigned char* L = c.lds;
    const unsigned hh = lane >> 5, r31 = lane & 31;
    const int ti = w >> 2, tv = w & 3;
    f32x16 St;
#pragma unroll
    for (int i = 0; i < 16; ++i) St[i] = 0.f;
    for (int i = tid; i < 18432 / 4; i += NTHR) ((LAS unsigned*)(L + GLA_ST))[i] = 0u;
    const float bias_d = gbias[h * 64 + lane];
    const int i3 = tid >> 3, seg = tid & 7;
    float gn[16];
#pragma unroll
    for (int k = 0; k < 16; ++k) gn[k] = ogain[16 * seg + k];
    const size_t tokb = (size_t)b * SEQ;
    unsigned short pq[8], pk[8], pg[8];
    u32x4 ogc0, ogc1, ogn0, ogn1;
#define GLA_PREFETCH(n) do { _Pragma("unroll") for (int rr = 0; rr < 8; ++rr) { const bf16_t* row = c.proj + (tokb + (n) * 64 + 8 * w + rr) * NP + h * 64 + lane; \
        pq[rr] = row[C_QA]; pk[rr] = row[C_KA]; pg[rr] = row[C_GP]; } } while (0)
#define GLA_OG(n, d0, d1) do { const bf16_t* ogp = c.proj + (tokb + (n) * 64 + i3) * NP + C_OG + h * 128 + 16 * seg; d0 = *(const u32x4*)ogp; d1 = *((const u32x4*)ogp + 1); } while (0)
#define GLA_VDMA(n) do { _Pragma("unroll") for (int it = 0; it < 2; ++it) { const int q = w + 8 * it; const unsigned nn = 64u * q + lane, row = nn >> 4, cs = nn & 15u, ch = cs ^ (((row & 3u) << 2) | ((row >> 2) & 3u)); \
        __builtin_amdgcn_global_load_lds((const unsigned*)(c.proj + (tokb + (n) * 64 + row) * NP + C_VA + h * 128 + ch * 8), (LAS unsigned*)(L + GLA_V + ((n) & 1) * 16384 + 1024 * q), 16, 0, 0); } } while (0)
#define CB() asm volatile("" ::: "memory")
    GLA_PREFETCH(0); CB(); GLA_OG(0, ogc0, ogc1); CB(); GLA_VDMA(0); CB(); GLA_VDMA(1); CB();
    for (int n = 0; n < SEQ / 64; ++n) {
        LAS unsigned char* STr = L + GLA_ST + (n & 1) * 18432; LAS unsigned char* STw = L + GLA_ST + ((n + 1) & 1) * 18432;
        LAS unsigned char* Vb = L + GLA_V + (n & 1) * 16384;
        float cl[8], qv[8], kv[8];
        { float run = 0.f;
#pragma unroll
          for (int rr = 0; rr < 8; ++rr) { const float g = bf2f(pg[rr]) + bias_d; run += (fminf(g, 0.f) - __logf(1.f + __expf(-fabsf(g)))) * (1.f / 16.f); cl[rr] = run; qv[rr] = bf2f(pq[rr]); kv[rr] = bf2f(pk[rr]); }
          ((LAS float*)(L + GLA_SEG))[w * 64 + lane] = run; }
        __syncthreads();
        { float pre = 0.f, tot = 0.f;
#pragma unroll
          for (int s = 0; s < 8; ++s) { const float v = ((LAS float*)(L + GLA_SEG))[s * 64 + lane]; tot += v; pre += (s < w) ? v : 0.f; }
          const float etot = __expf(tot);
          if (w == 0) ((LAS float*)(L + GLA_DEC))[lane] = etot;
#pragma unroll
          for (int rr = 0; rr < 8; ++rr) { const float cum = pre + cl[rr]; const unsigned row = 8 * w + rr;
              const float e = __expf(cum), ei = rcpf_(e), ed = etot * ei;
              const unsigned o1 = offb(row, lane >> 3) + (lane & 7) * 2, o2 = offb(row, 8 + (lane >> 3)) + (lane & 7) * 2;
              *(LAS unsigned short*)(L + GLA_QK + o1) = (unsigned short)f2bf(qv[rr] * e);
              *(LAS unsigned short*)(L + GLA_QK + o2) = (unsigned short)f2bf(kv[rr] * ei);
              *(LAS unsigned short*)(L + GLA_KD + o1) = (unsigned short)f2bf(kv[rr] * ed); } }
        if (n == 0) asm volatile("s_waitcnt vmcnt(2)" ::: "memory"); else asm volatile("s_waitcnt vmcnt(4)" ::: "memory");
        __syncthreads();
        CB();
        if (n + 1 < SEQ / 64) { GLA_OG(n + 1, ogn0, ogn1); CB(); GLA_PREFETCH(n + 1); }
        CB();
        bf16x8 qdf[4];
#pragma unroll
        for (int s = 0; s < 4; ++s) qdf[s] = *(const LAS bf16x8*)(L + GLA_QK + offb(32 * ti + r31, 2 * s + hh));
        f32x16 Z;
#pragma unroll
        for (int i = 0; i < 16; ++i) Z[i] = 0.f;
        { bf16x8 sf[4];
#pragma unroll
          for (int s = 0; s < 4; ++s) sf[s] = *(const LAS bf16x8*)(STr + (32 * tv + r31) * 144 + 32 * s + 16 * hh);
#pragma unroll
          for (int s = 0; s < 4; ++s) Z = __builtin_amdgcn_mfma_f32_32x32x16_bf16(qdf[s], sf[s], Z, 0, 0, 0); }
        const unsigned vb = (unsigned)(size_t)Vb;
#pragma unroll
        for (int tj = 0; tj < 2; ++tj) {
            if (tj <= ti) {
                bf16x8 kf[4];
#pragma unroll
                for (int s = 0; s < 4; ++s) kf[s] = *(const LAS bf16x8*)(L + GLA_QK + offb(32 * tj + r31, 8 + 2 * s + hh));
                unsigned va[8]; bf16x8 vf[4];
#pragma unroll
                for (int s = 0; s < 2; ++s) { va[2 * s] = vb + tr_addr32(lane, 32 * tj + 16 * s, tv, 0, true); va[2 * s + 1] = vb + tr_addr32(lane, 32 * tj + 16 * s, tv, 1, true);
                    va[4 + 2 * s] = va[2 * s]; va[5 + 2 * s] = va[2 * s + 1]; }
                tr_frag4(va, vf);
                f32x16 X;
#pragma unroll
                for (int i = 0; i < 16; ++i) X[i] = 0.f;
#pragma unroll
                for (int s = 0; s < 4; ++s) X = __builtin_amdgcn_mfma_f32_32x32x16_bf16(kf[s], qdf[s], X, 0, 0, 0);
                const int ig = 32 * ti + (int)r31;
#pragma unroll
                for (int i = 0; i < 16; ++i) X[i] = (ig >= 32 * tj + crow(i, hh)) ? X[i] : 0.f;
#pragma unroll
                for (int s = 0; s < 2; ++s) {
                    u32x4 pw; pw.x = pg8::cvt_pk_bf16(X[8 * s + 0], X[8 * s + 1]); pw.y = pg8::cvt_pk_bf16(X[8 * s + 2], X[8 * s + 3]); pw.z = pg8::cvt_pk_bf16(X[8 * s + 4], X[8 * s + 5]); pw.w = pg8::cvt_pk_bf16(X[8 * s + 6], X[8 * s + 7]);
                    Z = __builtin_amdgcn_mfma_f32_32x32x16_bf16(__builtin_bit_cast(bf16x8, pw), vf[s], Z, 0, 0, 0);
                }
            }
        }
#pragma unroll
        for (int i = 0; i < 16; ++i) ((LAS float*)(L + GLA_O))[(32 * ti + crow(i, hh)) * 132 + 32 * tv + r31] = Z[i];
        { const unsigned kb = (unsigned)(size_t)(L + GLA_KD);
          unsigned aa[8], ab[8]; bf16x8 af[4], bfr[4];
#pragma unroll
          for (int s = 0; s < 4; ++s) { aa[2 * s] = kb + tr_addr32(lane, 16 * s, ti, 0, false); aa[2 * s + 1] = kb + tr_addr32(lane, 16 * s, ti, 1, false);
              ab[2 * s] = vb + tr_addr32(lane, 16 * s, tv, 0, false); ab[2 * s + 1] = vb + tr_addr32(lane, 16 * s, tv, 1, false); }
          tr_frag4(aa, af); tr_frag4(ab, bfr);
#pragma unroll
          for (int i = 0; i < 16; ++i) St[i] *= ((LAS float*)(L + GLA_DEC))[32 * ti + crow(i, hh)];
#pragma unroll
          for (int s = 0; s < 4; ++s) St = __builtin_amdgcn_mfma_f32_32x32x16_bf16(af[s], bfr[s], St, 0, 0, 0); }
#pragma unroll
        for (int gq = 0; gq < 4; ++gq) { const float s0 = St[4 * gq], s1 = St[4 * gq + 1], s2 = St[4 * gq + 2], s3 = St[4 * gq + 3];
            u32x2 o; o.x = pk2(s0, s1); o.y = pk2(s2, s3);
            *(LAS u32x2*)(STw + (32 * tv + r31) * 144 + (32 * ti + 8 * gq + 4 * hh) * 2) = o; }
        __syncthreads();
        CB();
        if (n + 2 < SEQ / 64) GLA_VDMA(n + 2);
        CB();
        { const LAS f32x4* op = (const LAS f32x4*)(L + GLA_O + i3 * 528 + seg * 64);
          f32x4 o4[4]; float ss = 0.f;
#pragma unroll
          for (int k = 0; k < 4; ++k) { o4[k] = op[k]; ss += (o4[k].x * o4[k].x + o4[k].y * o4[k].y) + (o4[k].z * o4[k].z + o4[k].w * o4[k].w); }
          ss += swz_xor<1>(ss); ss += swz_xor<2>(ss); ss += swz_xor<4>(ss);
          const float rs = rsqf_(ss * (1.f / 128.f) + RMS_EPS);
          const unsigned ogw[8] = {ogc0.x, ogc0.y, ogc0.z, ogc0.w, ogc1.x, ogc1.y, ogc1.z, ogc1.w};
          unsigned ow[8];
#pragma unroll
          for (int k = 0; k < 8; ++k) { const float g0 = bflo(ogw[k]), g1 = bfhi(ogw[k]);
              const float a0 = o4[k >> 1][(2 * k) & 3] * rs * gn[2 * k] * g0 * sigmoidf_(g0), a1 = o4[k >> 1][(2 * k + 1) & 3] * rs * gn[2 * k + 1] * g1 * sigmoidf_(g1);
              ow[k] = pk2(a0, a1); }
          u32x4 w0, w1; w0.x = ow[0]; w0.y = ow[1]; w0.z = ow[2]; w0.w = ow[3]; w1.x = ow[4]; w1.y = ow[5]; w1.z = ow[6]; w1.w = ow[7];
          bf16_t* dst = c.brx + (tokb + n * 64 + i3) * 512 + h * 128 + 16 * seg;
          *(u32x4*)dst = w0; *((u32x4*)dst + 1) = w1; }
        CB();
        ogc0 = ogn0; ogc1 = ogn1;
    }
    asm volatile("s_waitcnt vmcnt(0)" ::: "memory");
    __syncthreads();
#undef GLA_PREFETCH
#undef GLA_OG
#undef GLA_VDMA
#undef CB
}

constexpr int LRU_X = 0  , LRU_R = 16384  , LRU_I = 32768, LRU_SP = 49152  , LRU_SH = 51200;
__device__ __forceinline__ void lru_unit(const Ctx& c, int unit, const float* convw, const float* convb, const float* wa_, const float* ba_, const float* wx_, const float* bx_, const float* lam_) {
    const int lane = c.lane, w = c.wave;
    const int b = unit >> 3, nb = unit & 7, ch = nb * 64 + lane;
    LAS unsigned char* L = c.lds;
    const unsigned hh = lane >> 5, r31 = lane & 31;
    const int gate = w >> 2, tt = (w >> 1) & 1, td = w & 1;
    bf16x8 wf[4];
    { const float* W = (gate ? wx_ : wa_) + (size_t)nb * 4096 + 32 * td + r31;
#pragma unroll
      for (int s = 0; s < 4; ++s) { float t8[8];
#pragma unroll
          for (int jj = 0; jj < 8; ++jj) t8[jj] = W[(16 * s + 8 * hh + jj) * 64];
          u32x4 pw; pw.x = pk2(t8[0], t8[1]); pw.y = pk2(t8[2], t8[3]); pw.z = pk2(t8[4], t8[5]); pw.w = pk2(t8[6], t8[7]); wf[s] = __builtin_bit_cast(bf16x8, pw); } }
    const float gbias = (gate ? bx_ : ba_)[nb * 64 + 32 * td + r31];
    const float cw0 = convw[ch], cw1 = convw[512 + ch], cw2 = convw[1024 + ch], cw3 = convw[1536 + ch], cb = convb[ch];
    const float lam = lam_[ch]; const float c8 = 8.f * (fmaxf(-lam, 0.f) + log1pf(__expf(-fabsf(lam))));
    const size_t tokb = (size_t)b * SEQ;
    unsigned short px[11], py[8];
#define LRU_PREFETCH(n) do { _Pragma("unroll") for (int rr = 0; rr < 11; ++rr) { const int t = (n) * 64 + 8 * w + rr - 3; px[rr] = t >= 0 ? c.proj[(tokb + t) * NP + C_XB + ch] : (unsigned short)0; } \
        _Pragma("unroll") for (int rr = 0; rr < 8; ++rr) py[rr] = c.proj[(tokb + (n) * 64 + 8 * w + rr) * NP + C_YB + ch]; } while (0)
    LRU_PREFETCH(0);
    float hcarry = 0.f;
    for (int n = 0; n < SEQ / 64; ++n) {
        float xc[8], yv[8];
        { float xr[11];
#pragma unroll
          for (int rr = 0; rr < 11; ++rr) xr[rr] = bf2f(px[rr]);
#pragma unroll
          for (int rr = 0; rr < 8; ++rr) { xc[rr] = cb + cw0 * xr[rr] + cw1 * xr[rr + 1] + cw2 * xr[rr + 2] + cw3 * xr[rr + 3]; yv[rr] = bf2f(py[rr]);
              *(LAS unsigned short*)(L + LRU_X + offb(8 * w + rr, lane >> 3) + (lane & 7) * 2) = (unsigned short)f2bf(xc[rr]); } }
        __syncthreads();
        if (n + 1 < SEQ / 64) LRU_PREFETCH(n + 1);
        { f32x16 Z;
#pragma unroll
          for (int i = 0; i < 16; ++i) Z[i] = 0.f;
#pragma unroll
          for (int s = 0; s < 4; ++s) { const bf16x8 af = *(const LAS bf16x8*)(L + LRU_X + offb(32 * tt + r31, 2 * s + hh)); Z = __builtin_amdgcn_mfma_f32_32x32x16_bf16(af, wf[s], Z, 0, 0, 0); }
          LAS float* dst = (LAS float*)(L + (gate ? LRU_I : LRU_R));
#pragma unroll
          for (int i = 0; i < 16; ++i) dst[(32 * tt + crow(i, hh)) * 64 + 32 * td + r31] = sigmoidf_(Z[i] + gbias); }
        __syncthreads();
        float hl[8], pc[8];
        { float hrun = 0.f, prun = 1.f;
#pragma unroll
          for (int rr = 0; rr < 8; ++rr) { const float r = ((const LAS float*)(L + LRU_R))[(8 * w + rr) * 64 + lane], ig = ((const LAS float*)(L + LRU_I))[(8 * w + rr) * 64 + lane];
              const float a = __expf(-c8 * r), u = sqrtf(fmaxf(1.f - a * a, 0.f)) * ig * xc[rr];
              hrun = a * hrun + u; prun *= a; hl[rr] = hrun; pc[rr] = prun; }
          ((LAS float*)(L + LRU_SP))[w * 64 + lane] = prun; ((LAS float*)(L + LRU_SH))[w * 64 + lane] = hrun; }
        __syncthreads();
        { float hin = hcarry, hall = hcarry;
#pragma unroll
          for (int s = 0; s < 8; ++s) { const float P = ((const LAS float*)(L + LRU_SP))[s * 64 + lane], H = ((const LAS float*)(L + LRU_SH))[s * 64 + lane];
              hall = P * hall + H; hin = (s < w) ? hall : hin; }
          hcarry = hall;
#pragma unroll
          for (int rr = 0; rr < 8; ++rr) { const float hv = hl[rr] + pc[rr] * hin;
              c.brx[(size_t)TC * 512 + (tokb + n * 64 + 8 * w + rr) * 512 + ch] = (bf16_t)f2bf(hv * gelu_tanh(yv[rr])); } }
    }
    __syncthreads();
#undef LRU_PREFETCH
}

constexpr int TPB = TC / 256;
__device__ __forceinline__ void phase_router(const Ctx& c, const float* gain, const float* rw, const float* rb, unsigned* gcnt) {
    LAS float* sRW = (LAS float*)c.lds;
    LAS unsigned* sRec = (LAS unsigned*)(c.lds + 65536);
    LAS unsigned* sCnt = (LAS unsigned*)(c.lds + MISC_OFF + 256);
    LAS unsigned* sBase = sCnt + 16;
    const int tid = c.tid, lane = c.lane;
    for (int idx = tid; idx < D * NE; idx += NTHR) sRW[idx] = rw[(idx & 1023) * 16 + (idx >> 10)];
    if (tid < 16) sCnt[tid] = 0u;
    f32x4 g4[4];
#pragma unroll
    for (int j = 0; j < 4; ++j) g4[j] = *((const f32x4*)gain + 64 * j + lane);
    const float rbl = rb[(lane >> 2) & 15];
    const bool b2 = lane & 4, b3 = lane & 8, b4 = lane & 16;
    f32x4 vn[4];
    { const f32x4* xr = (const f32x4*)(c.xo + (size_t)(c.bid * TPB + c.wave) * D) + lane;
#pragma unroll
      for (int j = 0; j < 4; ++j) vn[j] = xr[64 * j]; }
    __syncthreads();
    for (int lt = c.wave; lt < TPB; lt += NWAVES) {
        const int tok = c.bid * TPB + lt;
        f32x4 v[4]; float ss = 0.f;
#pragma unroll
        for (int j = 0; j < 4; ++j) { v[j] = vn[j]; ss += (v[j].x * v[j].x + v[j].y * v[j].y) + (v[j].z * v[j].z + v[j].w * v[j].w); }
        if (lt + NWAVES < TPB) { const f32x4* xr = (const f32x4*)(c.xo + (size_t)(tok + NWAVES) * D) + lane;
#pragma unroll
            for (int j = 0; j < 4; ++j) vn[j] = xr[64 * j]; }
        const float rs = rsqf_(wave_sum(ss) * (1.f / D) + RMS_EPS);
        u32x2* o = (u32x2*)(c.act + (size_t)tok * D) + lane;
#pragma unroll
        for (int j = 0; j < 4; ++j) { v[j] = v[j] * rs * g4[j]; u32x2 w; w.x = pk2(v[j].x, v[j].y); w.y = pk2(v[j].z, v[j].w); o[64 * j] = w; }
        float p[16];
#pragma unroll
        for (int e = 0; e < 16; ++e) { float a = 0.f;
#pragma unroll
            for (int j = 0; j < 4; ++j) { const f32x4 w = *((const LAS f32x4*)(sRW + e * D) + 64 * j + lane); a += (v[j].x * w.x + v[j].y * w.y) + (v[j].z * w.z + v[j].w * w.w); }
            p[e] = a; }
        float s8[8];
#pragma unroll
        for (int e = 0; e < 8; ++e) { const auto r = __builtin_amdgcn_permlane32_swap(__float_as_uint(p[e]), __float_as_uint(p[e + 8]), false, false); s8[e] = __uint_as_float(r[0]) + __uint_as_float(r[1]); }
        float t4[4];
#pragma unroll
        for (int j = 0; j < 4; ++j) { const float send = b4 ? s8[j] : s8[j + 4], keep = b4 ? s8[j + 4] : s8[j]; t4[j] = keep + swz_xor<16>(send); }
        float u2[2];
#pragma unroll
        for (int j = 0; j < 2; ++j) { const float send = b3 ? t4[j] : t4[j + 2], keep = b3 ? t4[j + 2] : t4[j]; u2[j] = keep + swz_xor<8>(send); }
        float lg; { const float send = b2 ? u2[0] : u2[1], keep = b2 ? u2[1] : u2[0]; lg = keep + swz_xor<4>(send); }
        lg += swz_xor<2>(lg); lg += swz_xor<1>(lg);
        lg += rbl;
        float sc[16]; float mx = -INFINITY;
#pragma unroll
        for (int e = 0; e < 16; ++e) { sc[e] = __int_as_float(__builtin_amdgcn_readlane(__float_as_int(lg), 4 * e)); mx = fmaxf(mx, sc[e]); }
        float sum = 0.f;
#pragma unroll
        for (int e = 0; e < 16; ++e) { sc[e] = __expf(sc[e] - mx); sum += sc[e]; }
        const float isum = rcpf_(sum);
#pragma unroll
        for (int e = 0; e < 16; ++e) sc[e] *= isum;
        int gsel = 0; float gbest = -1.f;
#pragma unroll
        for (int g = 0; g < 4; ++g) { const float a = sc[4 * g], b = sc[4 * g + 1], cc = sc[4 * g + 2], d = sc[4 * g + 3];
            const float hi1 = fmaxf(a, b), lo1 = fminf(a, b), hi2 = fmaxf(cc, d), lo2 = fminf(cc, d);
            const float top = fmaxf(hi1, hi2), second = fmaxf(fminf(hi1, hi2), fmaxf(lo1, lo2));
            const float gs = top + second; if (gs > gbest) { gbest = gs; gsel = g; } }
        float s4[4];
#pragma unroll
        for (int k = 0; k < 4; ++k) s4[k] = gsel == 0 ? sc[k] : gsel == 1 ? sc[4 + k] : gsel == 2 ? sc[8 + k] : sc[12 + k];
        int i0 = 0; float b0 = s4[0];
#pragma unroll
        for (int k = 1; k < 4; ++k) if (s4[k] > b0) { b0 = s4[k]; i0 = k; }
        int i1 = -1; float b1 = -1.f;
#pragma unroll
        for (int k = 0; k < 4; ++k) if (k != i0 && s4[k] > b1) { b1 = s4[k]; i1 = k; }
        const int e0 = 4 * gsel + i0, e1 = 4 * gsel + i1; const float wn = rcpf_(b0 + b1);
        if (lane == 0) { const unsigned l0 = atomicAdd((unsigned*)&sCnt[e0], 1u), l1 = atomicAdd((unsigned*)&sCnt[e1], 1u);
            sRec[lt * 6 + 0] = (unsigned)e0; sRec[lt * 6 + 1] = l0; sRec[lt * 6 + 2] = (unsigned)e1; sRec[lt * 6 + 3] = l1; sRec[lt * 6 + 4] = __float_as_uint(b0 * wn); sRec[lt * 6 + 5] = __float_as_uint(b1 * wn); }
    }
    __syncthreads();
    if (tid < 16) sBase[tid] = __hip_atomic_fetch_add(gcnt + tid, sCnt[tid], __ATOMIC_RELAXED, __HIP_MEMORY_SCOPE_AGENT);
    __syncthreads();
    if (tid < TPB) { const int tok = c.bid * TPB + tid; const unsigned e0 = sRec[tid * 6], e1 = sRec[tid * 6 + 2];
        const unsigned p0 = sBase[e0] + sRec[tid * 6 + 1], p1 = sBase[e1] + sRec[tid * 6 + 3];
        u32x4 r; r.x = (e0 << 20) | p0; r.y = (e1 << 20) | p1; r.z = sRec[tid * 6 + 4]; r.w = sRec[tid * 6 + 5];
        *(u32x4*)(c.rec + (size_t)tok * 4) = r;
        c.list[(size_t)e0 * TC + p0] = tok; c.list[(size_t)e1 * TC + p1] = tok; }
}

struct PlainOrder {
    int nM, nN, G, c; const char* A; const char* Bt; size_t a_tile, b_tile; int r0, r1;
    __device__ __forceinline__ bool next(int i, pg8::Unit& u) const { u.g = 0; if (r0 + i >= r1) return false; return pg8::static_tile(nM, nN, G, c, r0 + i, u.pm, u.pn); }
    __device__ __forceinline__ const char* aptr(const pg8::Unit& u) const { return A + (size_t)u.pm * a_tile; }
    __device__ __forceinline__ const char* bptr(const pg8::Unit& u) const { return Bt + (size_t)u.pn * b_tile; }
    __device__ __forceinline__ unsigned arow(const pg8::Unit&, int) const { return 0u; }
};
struct MergeOrder {
    int G, c; const char* brx; const char* wbr;
    __device__ __forceinline__ bool next(int i, pg8::Unit& u) const { u.g = i % 3; return pg8::static_tile(TC / 256, 4, G, c, i / 3, u.pm, u.pn); }
    __device__ __forceinline__ const char* aptr(const pg8::Unit& u) const { return brx + ((size_t)u.g * TC * 512 + (size_t)u.pm * 256 * 512) * 2; }
    __device__ __forceinline__ const char* bptr(const pg8::Unit& u) const { return wbr + ((size_t)u.g * D * 512 + (size_t)u.pn * 256 * 512) * 2; }
    __device__ __forceinline__ unsigned arow(const pg8::Unit&, int) const { return 0u; }
};
template <bool UP> struct MoeOrder {
    int G, c; LAS const int* pt; LAS const int* lc; const char* A; const char* W; const int* list;
    __device__ __forceinline__ bool next(int i, pg8::Unit& u) const { const int L = i * G + c, tau = L >> 2; if (tau >= pt[NE]) return false;
        int e = 0;
#pragma unroll
        for (int k = 1; k < NE; ++k) e += (tau >= pt[k]) ? 1 : 0;
        u.pm = tau; u.pn = L & 3; u.g = e; return true; }
    __device__ __forceinline__ const char* aptr(const pg8::Unit& u) const { return UP ? A : A + (size_t)u.pm * 256 * FF * 2; }
    __device__ __forceinline__ const char* bptr(const pg8::Unit& u) const { return UP ? W + ((size_t)u.g * 1024 * D + (size_t)u.pn * 256 * D) * 2 : W + ((size_t)u.g * D * FF + (size_t)u.pn * 256 * FF) * 2; }
    __device__ __forceinline__ unsigned arow(const pg8::Unit& u, int r) const { int p = (u.pm - pt[u.g]) * 256 + r; const int n = lc[u.g]; p = p < n ? p : n - 1;
        return (unsigned)list[(size_t)u.g * TC + p] * (unsigned)(D * 2); }
};

struct EpiStoreBf16 {
    static constexpr bool PERM = true;
    bf16_t* O; int ldc;
    __device__ __forceinline__ void operator()(const f32x4 (&acc)[2][2][4][2], const pg8::Unit& u, int wr, int wc, int fr, int fq) const {
        const int row0 = u.pm * 256 + wr * 64 + fr, col0 = u.pn * 256 + wc * 32 + 8 * fq;
#pragma unroll
        for (int ai = 0; ai < 2; ++ai)
#pragma unroll
            for (int m = 0; m < 4; ++m) { bf16_t* rowp = O + (size_t)(row0 + ai * 128 + m * 16) * ldc + col0;
#pragma unroll
                for (int bj = 0; bj < 2; ++bj) { const f32x4 v0 = acc[ai][bj][m][0], v1 = acc[ai][bj][m][1];
                    u32x4 w; w.x = pg8::cvt_pk_bf16(v0[0], v0[1]); w.y = pg8::cvt_pk_bf16(v0[2], v0[3]); w.z = pg8::cvt_pk_bf16(v1[0], v1[1]); w.w = pg8::cvt_pk_bf16(v1[2], v1[3]);
                    *(u32x4*)(rowp + bj * 128) = w; } }
    }
};
struct EpiMerge {
    static constexpr bool PERM = true;
    const bf16_t* proj; bf16_t* mg;
    __device__ __forceinline__ void operator()(const f32x4 (&acc)[2][2][4][2], const pg8::Unit& u, int wr, int wc, int fr, int fq) const {
        const int row0 = u.pm * 256 + wr * 64 + fr, col0 = u.pn * 256 + wc * 32 + 8 * fq;
#pragma unroll
        for (int ai = 0; ai < 2; ++ai) {
            u32x4 gv[4][2], pv[4][2];
#pragma unroll
            for (int m = 0; m < 4; ++m)
#pragma unroll
                for (int bj = 0; bj < 2; ++bj) { const size_t row = (size_t)(row0 + ai * 128 + m * 16); const int col = col0 + bj * 128;
                    gv[m][bj] = *(const u32x4*)(proj + row * NP + C_G + u.g * D + col);
                    if (u.g > 0) pv[m][bj] = *(const u32x4*)(mg + row * D + col); else pv[m][bj] = (u32x4){0u, 0u, 0u, 0u}; }
            asm volatile("" ::: "memory");
#pragma unroll
            for (int m = 0; m < 4; ++m)
#pragma unroll
                for (int bj = 0; bj < 2; ++bj) { const size_t row = (size_t)(row0 + ai * 128 + m * 16); const int col = col0 + bj * 128;
                    const u32x4 g = gv[m][bj], p = pv[m][bj];
                    const f32x4 v0 = acc[ai][bj][m][0], v1 = acc[ai][bj][m][1];
                    float r[8];
                    r[0] = v0[0] * sigmoidf_(bflo(g.x)) + bflo(p.x); r[1] = v0[1] * sigmoidf_(bfhi(g.x)) + bfhi(p.x); r[2] = v0[2] * sigmoidf_(bflo(g.y)) + bflo(p.y); r[3] = v0[3] * sigmoidf_(bfhi(g.y)) + bfhi(p.y);
                    r[4] = v1[0] * sigmoidf_(bflo(g.z)) + bflo(p.z); r[5] = v1[1] * sigmoidf_(bfhi(g.z)) + bfhi(p.z); r[6] = v1[2] * sigmoidf_(bflo(g.w)) + bflo(p.w); r[7] = v1[3] * sigmoidf_(bfhi(g.w)) + bfhi(p.w);
                    u32x4 w; w.x = pk2(r[0], r[1]); w.y = pk2(r[2], r[3]); w.z = pk2(r[4], r[5]); w.w = pk2(r[6], r[7]);
                    *(u32x4*)(mg + row * D + col) = w; }
        }
    }
};
struct EpiResid {
    static constexpr bool PERM = false;
    const float* base; float* out;
    __device__ __forceinline__ void operator()(const f32x4 (&acc)[2][2][4][2], const pg8::Unit& u, int wr, int wc, int fr, int fq) const {
        const int row0 = u.pm * 256 + wr * 64 + fr, col0 = u.pn * 256 + wc * 32 + 4 * fq;
#pragma unroll
        for (int ai = 0; ai < 2; ++ai) {
            f32x4 bv[4][2][2];
#pragma unroll
            for (int m = 0; m < 4; ++m) { const size_t off = (size_t)(row0 + ai * 128 + m * 16) * D + col0;
#pragma unroll
                for (int bj = 0; bj < 2; ++bj)
#pragma unroll
                    for (int n = 0; n < 2; ++n) bv[m][bj][n] = *(const f32x4*)(base + off + bj * 128 + n * 16); }
            asm volatile("" ::: "memory");
#pragma unroll
            for (int m = 0; m < 4; ++m) { const size_t off = (size_t)(row0 + ai * 128 + m * 16) * D + col0;
#pragma unroll
                for (int bj = 0; bj < 2; ++bj)
#pragma unroll
                    for (int n = 0; n < 2; ++n) *(f32x4*)(out + off + bj * 128 + n * 16) = bv[m][bj][n] + acc[ai][bj][m][n]; }
        }
    }
};
struct EpiSwiGLU {
    static constexpr bool PERM = false;
    bf16_t* hid;
    __device__ __forceinline__ void operator()(const f32x4 (&acc)[2][2][4][2], const pg8::Unit& u, int wr, int wc, int fr, int fq) const {
        const int row0 = u.pm * 256 + wr * 64 + fr, col0 = u.pn * 128 + wc * 16 + 4 * fq;
#pragma unroll
        for (int ai = 0; ai < 2; ++ai)
#pragma unroll
            for (int m = 0; m < 4; ++m) { bf16_t* rowp = hid + (size_t)(row0 + ai * 128 + m * 16) * FF + col0;
#pragma unroll
                for (int bj = 0; bj < 2; ++bj) { const f32x4 g = acc[ai][bj][m][0], up = acc[ai][bj][m][1];
                    u32x2 w; w.x = pg8::cvt_pk_bf16(g[0] * sigmoidf_(g[0]) * up[0], g[1] * sigmoidf_(g[1]) * up[1]); w.y = pg8::cvt_pk_bf16(g[2] * sigmoidf_(g[2]) * up[2], g[3] * sigmoidf_(g[3]) * up[3]);
                    *(u32x2*)(rowp + bj * 64) = w; } }
    }
};

constexpr int PH_PER_PASS = 9, N_PASS = NCH * DEPTH, PH_TOTAL = 1 + N_PASS * PH_PER_PASS + 1;
#ifndef MK_LAUNCH_PER_PHASE
#define MK_LAUNCH_PER_PHASE 0
#endif
#ifndef PHMASK
#define PHMASK 0xFFFF
#endif
#ifndef MIXM
#define MIXM 7
#endif
#define EN(j) (((PHMASK) >> (j)) & 1)
typedef const __attribute__((address_space(4))) char* kptr_t;
__device__ __forceinline__ const void* karg_ptr(kptr_t kp, int i) { return *(const void* const __attribute__((address_space(4)))*)(kp + 8 * i); }
__device__ __forceinline__ void make_ctx(Ctx& c, kptr_t& kp, int pass, int wave_s) {
    int t = wave_s * 64 + (int)__builtin_amdgcn_mbcnt_hi(~0u, __builtin_amdgcn_mbcnt_lo(~0u, 0u)); asm volatile("" : "+v"(t));
    kp = (kptr_t)__builtin_amdgcn_kernarg_segment_ptr(); asm volatile("" : "+s"(kp));
    c.tid = t; c.lane = t & 63; c.wave = __builtin_amdgcn_readfirstlane(t >> 6); c.bid = blockIdx.x; c.G = gridDim.x;
    unsigned char* ws = (unsigned char*)karg_ptr(kp, 25); float* out = (float*)karg_ptr(kp, 24);
    c.ctl = (unsigned*)(ws + WS_CTL);
    c.act = (bf16_t*)(ws + WS_ACT); c.proj = (bf16_t*)(ws + WS_PROJ); c.hid = (bf16_t*)(ws + WS_HID); c.ys = (bf16_t*)(ws + WS_YS);
    c.rec = (unsigned*)(ws + WS_REC); c.list = (int*)(ws + WS_LIST); c.brx = (bf16_t*)(ws + WS_BRX);
    const int chunk = pass / DEPTH, layer = pass % DEPTH;
    c.chunk = chunk; c.layer = layer; c.pass = pass;
    c.x_in = (const float*)karg_ptr(kp, 0) + (size_t)chunk * TC * D; c.xo = out + (size_t)chunk * TC * D;
    c.pos = (const int*)karg_ptr(kp, 1) + (size_t)chunk * TC;
    c.lw = ws + WS_W + (size_t)layer * LW_SIZE;
}
#define INP(i) ((const float*)karg_ptr(kp, (i)))
__global__ void __launch_bounds__(NTHR, 2) fwd(Args args) {
    extern __shared__ __attribute__((aligned(16))) unsigned char lds_raw[];
    Ctx c; kptr_t kp;
    c.lds = (LAS unsigned char*)lds_raw;
    const int wave_s = __builtin_amdgcn_readfirstlane((int)threadIdx.x >> 6);
    make_ctx(c, kp, 0, wave_s);
    volatile LAS unsigned* MISC = (volatile LAS unsigned*)(c.lds + MISC_OFF);
    LAS int* sPT = (LAS int*)(c.lds + MISC_OFF + 64);
    LAS int* sLC = (LAS int*)(c.lds + MISC_OFF + 160);
    for (int u = c.tid; u < 1024; u += NTHR) MISC[u] = 0u;
    __syncthreads();
    XcdBarrier bar; bar.bar = c.ctl + CW_BAR; bar.x = 0; bar.st = nullptr;
    if (!MK_LAUNCH_PER_PHASE) bar = xcd_barrier_post(c.ctl + CW_BAR, MISC, c.tid);
    const int lo = args.ph_lo, hi = args.ph_hi;
#define IN(k) (lo <= (k) && (k) < hi)
#ifndef PROBE_MASK
#define PROBE_MASK 0
#endif
#ifndef PROJ_SLICE
#define PROJ_SLICE 21
#endif
#ifndef PROBE_CLK_CLS
#define PROBE_CLK_CLS 2
#endif
#ifndef PROBE_BLOCK
#define PROBE_BLOCK 0
#endif
#ifndef PROBE_K
#define PROBE_K 4
#endif
    unsigned long long t_prev = 0, c_prev = 0; LAS unsigned* sAcc = (LAS unsigned*)(c.lds + MISC_OFF + 512);
    if (PROBE_MASK) { t_prev = __builtin_amdgcn_s_memrealtime(); c_prev = (unsigned long long)clock64(); }
#define STAMP(cls) do { if (PROBE_MASK) { const unsigned long long _n = __builtin_amdgcn_s_memrealtime(); const unsigned long long _ck = (unsigned long long)clock64(); if (blockIdx.x == PROBE_BLOCK && c.tid == 0) { sAcc[(cls)] += (unsigned)(_n - t_prev); if ((cls) == PROBE_CLK_CLS) sAcc[15] += (unsigned)((_ck - c_prev) >> 4); } t_prev = _n; c_prev = _ck; } } while (0)
#ifndef PROBE_GEMM_CLS
#define PROBE_GEMM_CLS -1
#endif
#define GEMM_FLAG(cls) do { if (PROBE_MASK) { if (c.tid == 0) MISC[6] = ((cls) == PROBE_GEMM_CLS) ? 1u : 0u; __syncthreads(); } } while (0)
#define SEAM(k) do { if (IN(k) && IN((k) + 1)) { XcdBarrier _b = bar; kptr_t _k = (kptr_t)__builtin_amdgcn_kernarg_segment_ptr(); asm volatile("" : "+s"(_k)); _b.bar = (unsigned*)((unsigned char*)karg_ptr(_k, 25) + WS_CTL) + CW_BAR; { int _t = wave_s * 64 + (int)__builtin_amdgcn_mbcnt_hi(~0u, __builtin_amdgcn_mbcnt_lo(~0u, 0u)); xcd_barrier(_b, _t); } } } while (0)

    if (EN(0) && IN(0)) { Args a2;
#pragma unroll
        for (int i = 0; i < 24; ++i) a2.in[i] = karg_ptr(kp, i);
        a2.ws = (unsigned char*)karg_ptr(kp, 25); a2.out = nullptr; a2.ph_lo = 0; a2.ph_hi = 0;
        phase_prep(a2, c.lds, c.bid * NWAVES + c.wave, c.G * NWAVES, c.wave, c.lane, c.bid * NTHR + c.tid, c.G * NTHR);
        phase_rope_table((const int*)karg_ptr(kp, 1), (float*)(c.ctl) + (WS_BRC + 4 * MiB) / 4, c.bid * NTHR + c.tid, c.G * NTHR); }
    SEAM(0); STAMP(0);

    for (int pass = 0; pass < N_PASS; ++pass) {
        const int pb = 1 + pass * PH_PER_PASS;
        if (EN(1) && IN(pb + 0)) { make_ctx(c, kp, pass, wave_s);
            const float* g1 = INP(2) + c.layer * D;
            if (c.layer == 0) {
                if (c.chunk > 0) {
                    Ctx p = c; p.xo = c.xo - (size_t)TC * D;
                    moe_tables(c.ctl + CW_CNT + 64 * (pass - 1), sPT, sLC, c.tid);
                    phase_norm1<true, false, true>(p, nullptr, sPT);
                }
                phase_norm1<false, true, false>(c, g1, sPT);
            } else {
                moe_tables(c.ctl + CW_CNT + 64 * (pass - 1), sPT, sLC, c.tid);
                phase_norm1<true, true, true>(c, g1, sPT);
            }
        }
        SEAM(pb + 0); STAMP(1);
        if (EN(2) && IN(pb + 1)) { make_ctx(c, kp, pass, wave_s);
            EpiStoreBf16 E{c.proj, NP};
            GEMM_FLAG(2);
#pragma unroll 1
            for (int r0 = 0; r0 < 21; r0 += PROJ_SLICE) {
                PlainOrder S{TC / 256, NP / 256, c.G, c.bid, (const char*)c.act, (const char*)(c.lw + LW_WIN), (size_t)256 * D * 2, (size_t)256 * D * 2, r0, r0 + PROJ_SLICE};
                pg8::gemm_phase<EpiStoreBf16, PlainOrder, false>(c.lds, S, E, D, D, c.tid);
                if (r0 + PROJ_SLICE < 21) { XcdBarrier _b = bar; kptr_t _k = (kptr_t)__builtin_amdgcn_kernarg_segment_ptr(); asm volatile("" : "+s"(_k)); _b.bar = (unsigned*)((unsigned char*)karg_ptr(_k, 25) + WS_CTL) + CW_BAR; xcd_barrier(_b, c.tid); }
            }
        }
        SEAM(pb + 1); STAMP(2);
        if (EN(4) && IN(pb + 2)) { make_ctx(c, kp, pass, wave_s); const int layer = c.layer;
            float* lse = (float*)(c.ctl) + (WS_BRC / 4);
            if ((MIXM & 1) && c.bid < 4 * BC) gla_unit(c, c.bid, INP(5) + layer * 256, INP(6) + layer * 128);
            else if ((MIXM & 2) && c.bid < 12 * BC) lru_unit(c, c.bid - 4 * BC, INP(7) + layer * 4 * 512, INP(8) + layer * 512, INP(9) + layer * 8 * 64 * 64,
                                                INP(10) + layer * 512, INP(11) + layer * 8 * 64 * 64, INP(12) + layer * 512, INP(13) + layer * 512);
            STAMP(12);
            unsigned* qh = c.ctl + CW_Q + 64 * pass;
            if (MIXM & 4) attn_loop(c, qh, MISC + 4, lse, INP(14) + layer * 128, INP(15) + layer * 128, (const float*)(c.ctl) + (WS_BRC + 4 * MiB) / 4 + (size_t)c.chunk * TC * 32);
        }
        SEAM(pb + 2); STAMP(4);
        if (EN(11) && IN(pb + 3)) { make_ctx(c, kp, pass, wave_s); phase_attn_combine(c, (const float*)(c.ctl) + (WS_BRC / 4)); }
        SEAM(pb + 3); STAMP(11);
        if (EN(5) && IN(pb + 4)) { make_ctx(c, kp, pass, wave_s);
            MergeOrder S{c.G, c.bid, (const char*)c.brx, (const char*)(c.lw + LW_WBR)};
            EpiMerge E{c.proj, c.act};
            GEMM_FLAG(5);
            pg8::gemm_phase<EpiMerge, MergeOrder, false>(c.lds, S, E, 512, 512, c.tid);
        }
        SEAM(pb + 4); STAMP(5);
        if (EN(6) && IN(pb + 5)) { make_ctx(c, kp, pass, wave_s);
            PlainOrder S{TC / 256, D / 256, c.G, c.bid, (const char*)c.act, (const char*)(c.lw + LW_WOUT), (size_t)256 * D * 2, (size_t)256 * D * 2, 0, 1 << 20};
            EpiResid E{c.layer == 0 ? c.x_in : (const float*)c.xo, c.xo};
            GEMM_FLAG(6);
            pg8::gemm_phase<EpiResid, PlainOrder, false>(c.lds, S, E, D, D, c.tid);
        }
        SEAM(pb + 5); STAMP(6);
        if (EN(7) && IN(pb + 6)) { make_ctx(c, kp, pass, wave_s); phase_router(c, INP(18) + c.layer * D, INP(19), INP(20), c.ctl + CW_CNT + 64 * pass); }
        SEAM(pb + 6); STAMP(7);
        if (EN(8) && IN(pb + 7)) { make_ctx(c, kp, pass, wave_s);
            moe_tables(c.ctl + CW_CNT + 64 * pass, sPT, sLC, c.tid);
            MoeOrder<true> S{c.G, c.bid, sPT, sLC, (const char*)c.act, (const char*)(c.lw + LW_WGU), c.list};
            EpiSwiGLU E{c.hid};
            GEMM_FLAG(8);
            pg8::gemm_phase<EpiSwiGLU, MoeOrder<true>, true>(c.lds, S, E, D, D, c.tid);
        }
        SEAM(pb + 7); STAMP(8);
        if (EN(9) && IN(pb + 8)) { make_ctx(c, kp, pass, wave_s);
            moe_tables(c.ctl + CW_CNT + 64 * pass, sPT, sLC, c.tid);
            MoeOrder<false> S{c.G, c.bid, sPT, sLC, (const char*)c.hid, (const char*)(c.lw + LW_WDN), c.list};
            EpiStoreBf16 E{c.ys, D};
            GEMM_FLAG(9);
            pg8::gemm_phase<EpiStoreBf16, MoeOrder<false>, false>(c.lds, S, E, FF, FF, c.tid);
        }
        SEAM(pb + 8); STAMP(9);
    }
    if (EN(10) && IN(PH_TOTAL - 1)) { make_ctx(c, kp, N_PASS - 1, wave_s);
        moe_tables(c.ctl + CW_CNT + 64 * (N_PASS - 1), sPT, sLC, c.tid);
        phase_norm1<true, false, true>(c, nullptr, sPT);
    }
    if (PROBE_MASK) {
        make_ctx(c, kp, N_PASS - 1, wave_s);
        STAMP(10);
        if (blockIdx.x == PROBE_BLOCK && c.tid == 0) { unsigned sel = 0; for (int k = 0; k < 16; ++k) if ((PROBE_MASK >> k) & 1) sel += sAcc[k]; __hip_atomic_store(c.ctl + CW_Q + 64 * 8, sel, __ATOMIC_RELAXED, __HIP_MEMORY_SCOPE_AGENT); }
        { XcdBarrier _b = bar; _b.bar = c.ctl + CW_BAR; xcd_barrier(_b, c.tid); }
        const unsigned sel = __hip_atomic_load(c.ctl + CW_Q + 64 * 8, __ATOMIC_RELAXED, __HIP_MEMORY_SCOPE_AGENT);
        const unsigned long long t0 = __builtin_amdgcn_s_memrealtime();
        while (__builtin_amdgcn_s_memrealtime() - t0 < (unsigned long long)sel * PROBE_K) __builtin_amdgcn_s_sleep(8);
    }
#undef IN
#undef SEAM
}

extern "C" void kernel_launch(void* const* d_in, const int* in_sizes, int n_in, void* d_out, int out_size, void* d_ws, size_t ws_size, hipStream_t stream) {
    static int grid = 0;
    if (grid == 0) {
        if (n_in != 24 || in_sizes[0] != BATCH * SEQ * D || out_size != BATCH * SEQ * D || ws_size < WS_END) { fprintf(stderr, "kernel_launch: unexpected shapes / workspace (%zu < %zu)\n", ws_size, (size_t)WS_END); grid = -1; return; }
        int dev = 0, cus = 0;
        if (hipGetDevice(&dev) != hipSuccess || hipDeviceGetAttribute(&cus, hipDeviceAttributeMultiprocessorCount, dev) != hipSuccess || cus < 256) { fprintf(stderr, "kernel_launch: needs a 256-CU device\n"); grid = -1; return; }
        if (hipFuncSetAttribute((const void*)fwd, hipFuncAttributeMaxDynamicSharedMemorySize, LDS_BYTES) != hipSuccess) { fprintf(stderr, "kernel_launch: hipFuncSetAttribute failed\n"); grid = -1; return; }
        int per_cu = 0;
        if (hipOccupancyMaxActiveBlocksPerMultiprocessor(&per_cu, (const void*)fwd, NTHR, LDS_BYTES) != hipSuccess || per_cu < 1) fprintf(stderr, "kernel_launch: occupancy query says %d\n", per_cu);
        (void)hipGetLastError();
        grid = 256;
    }
    if (grid < 0) return;
    if (hipMemsetAsync((char*)d_ws + WS_CTL, 0, CTL_ZERO_BYTES, stream) != hipSuccess) return;
    Args a{};
    for (int i = 0; i < 24; ++i) a.in[i] = d_in[i];
    a.out = (float*)d_out; a.ws = (unsigned char*)d_ws;
#if MK_LAUNCH_PER_PHASE
    for (int k = 0; k < PH_TOTAL; ++k) { a.ph_lo = k; a.ph_hi = k + 1; hipLaunchKernelGGL(fwd, dim3(grid), dim3(NTHR), LDS_BYTES, stream, a); }
#else
    a.ph_lo = 0; a.ph_hi = PH_TOTAL;
    hipLaunchKernelGGL(fwd, dim3(grid), dim3(NTHR), LDS_BYTES, stream, a);
#endif
}
```

```cpp
#include <hip/hip_runtime.h>
#include <cstdio>
#include <cstdint>

#define LAS __attribute__((address_space(3)))
#define GAS __attribute__((address_space(1)))
typedef unsigned short bf16_t;
typedef short bf16x8 __attribute__((ext_vector_type(8)));
typedef float f32x4 __attribute__((ext_vector_type(4)));
typedef float f32x2 __attribute__((ext_vector_type(2)));
typedef unsigned u32x4 __attribute__((ext_vector_type(4)));
typedef unsigned u32x2 __attribute__((ext_vector_type(2)));

namespace pg8 {
constexpr int BM = 256, BK = 64, HALF = 128, HTB = HALF * BK * 2, STAGE_BYTES = 8 * HTB, NXCD = 8, WGM = 8;
__host__ __device__ __forceinline__ int lds_byte(int r, int c) { const int st = (r >> 4) * 2 + (c >> 5), rr = r & 15, cc = c & 31, ob = rr * 64 + cc * 2; return st * 1024 + (ob ^ (((ob >> 9) & 1) << 5)); }
__host__ __device__ __forceinline__ void stage_rc(int b, int& R, int& C) { const int st = b / 1024, sb = b % 1024, swz = sb ^ (((sb >> 9) & 1) << 5); R = (st >> 1) * 16 + swz / 64; C = (st & 1) * 32 + (swz % 64) / 2; }
__host__ __device__ __forceinline__ int perm32(int rho) { const int n = rho >> 4, i = rho & 15; return 8 * (i >> 2) + 4 * n + (i & 3); }

struct Unit { int pm, pn, g; };

__device__ __forceinline__ bool static_tile(int nM, int nN, int G, int c, int i, int& pm, int& pn) {
    const int nwg = nM * nN; const long L = (long)i * G + c; if (L >= nwg) return false;
    int wgid = (int)L; { const int q = nwg / NXCD, r = nwg % NXCD, xcd = wgid % NXCD, off = wgid / NXCD; wgid = (xcd < r ? xcd * (q + 1) : r * (q + 1) + (xcd - r) * q) + off; }
    const int nig = WGM * nN, gid = wgid / nig, fm = gid * WGM, gsz = (nM - fm) < WGM ? (nM - fm) : WGM;
    pm = fm + ((wgid % nig) % gsz); pn = (wgid % nig) / gsz; return true;
}
typedef __bf16 bf16x2c_t __attribute__((ext_vector_type(2)));
__device__ __forceinline__ unsigned cvt_pk_bf16(float lo, float hi) { const f32x2 v = {lo, hi}; return __builtin_bit_cast(unsigned, __builtin_convertvector(v, bf16x2c_t)); }

template <class Epi, class Sched, bool GATHER>
__device__ __forceinline__ void gemm_phase(LAS unsigned char* lds, const Sched& S, const Epi& E, const int K, const int lda, int tid_) {
    asm volatile("" : "+v"(tid_));
    const int tid = tid_, wid = __builtin_amdgcn_readfirstlane(tid >> 6), lane = tid & 63, wr = wid >> 2, wc = wid & 3, fr = lane & 15, fq = lane >> 4;
    const int nt = K / BK;
    int sR[2], sC[2];
    unsigned voffB[2], voffA[2], vAc[2][2], vAn[2][2];
#pragma unroll
    for (int i = 0; i < 2; ++i) { int R, C; stage_rc(tid * 16 + i * 8192, R, C); sR[i] = R; sC[i] = C; const int Rb = Epi::PERM ? ((R & ~31) + perm32(R & 31)) : R;
        voffB[i] = (unsigned)(Rb * K + C) * 2u; voffA[i] = (unsigned)(R * lda + C) * 2u; }
    const size_t kstep = (size_t)(BK * 2);
    const size_t hstepB = (size_t)HALF * K * 2, hstepA = (size_t)HALF * lda * 2;
    const unsigned ldsw = (unsigned)wid * 1024u;
    const int aoff = lds_byte(wr * 64 + fr, fq * 8), boff = lds_byte(wc * 32 + fr, fq * 8);
#define PG8_SA(b, h) (((b) * 2 + (h)) * HTB)
#define PG8_SB(b, h) ((4 + (b) * 2 + (h)) * HTB)
#define PG8_STAGE(bufoff, gbase, voff) do { _Pragma("unroll") for (int _i = 0; _i < 2; ++_i) \
        __builtin_amdgcn_global_load_lds((const unsigned*)((const char*)(gbase) + (voff)[_i]), (LAS unsigned*)(lds + (bufoff) + ldsw + _i * 8192), 16, 0, 0); } while (0)
#define PG8_LDA(dst, b, h) do { _Pragma("unroll") for (int m = 0; m < 4; ++m) _Pragma("unroll") for (int k = 0; k < 2; ++k) dst[m][k] = *(const LAS bf16x8*)(lds + PG8_SA(b, h) + aoff + m * 2048 + k * 1024); } while (0)
#define PG8_LDB(dst, b, h) do { _Pragma("unroll") for (int n = 0; n < 2; ++n) _Pragma("unroll") for (int k = 0; k < 2; ++k) dst[n][k] = *(const LAS bf16x8*)(lds + PG8_SB(b, h) + boff + n * 2048 + k * 1024); } while (0)
#define PG8_MMA(ai, bj, At, Bt) do { __builtin_amdgcn_s_setprio(1); _Pragma("unroll") for (int m = 0; m < 4; ++m) _Pragma("unroll") for (int n = 0; n < 2; ++n) _Pragma("unroll") for (int k = 0; k < 2; ++k) \
        acc[ai][bj][m][n] = __builtin_amdgcn_mfma_f32_16x16x32_bf16(Bt[n][k], At[m][k], acc[ai][bj][m][n], 0, 0, 0); __builtin_amdgcn_s_setprio(0); } while (0)
#define PG8_WAIT_V(n) asm volatile("s_waitcnt vmcnt(" #n ")" ::: "memory")
#define PG8_WAIT_L(n) asm volatile("s_waitcnt lgkmcnt(" #n ")" ::: "memory")
#define PG8_BAR __builtin_amdgcn_s_barrier()
#define PG8_SCHED __builtin_amdgcn_sched_barrier(0)
#define PG8_AOFF(dst, u) do { if constexpr (GATHER) { _Pragma("unroll") for (int _h = 0; _h < 2; ++_h) _Pragma("unroll") for (int _i = 0; _i < 2; ++_i) \
        dst[_h][_i] = S.arow(u, _h * HALF + sR[_i]) + (unsigned)sC[_i] * 2u; } } while (0)
#define PG8_STAGE_A(bufoff, gptr, h, usenext) do { if constexpr (GATHER) { _Pragma("unroll") for (int _i = 0; _i < 2; ++_i) { const unsigned _vo = (usenext) ? vAn[h][_i] : vAc[h][_i]; \
        __builtin_amdgcn_global_load_lds((const unsigned*)((const char*)(gptr) + _vo), (LAS unsigned*)(lds + (bufoff) + ldsw + _i * 8192), 16, 0, 0); } } \
        else { PG8_STAGE(bufoff, (gptr) + (h) * hstepA, voffA); } } while (0)
    Unit cur, nxt; int ui = 0;
    if (!S.next(0, cur)) return;
    f32x4 acc[2][2][4][2];
#pragma unroll
    for (int a = 0; a < 2; ++a)
#pragma unroll
        for (int b = 0; b < 2; ++b)
#pragma unroll
            for (int m = 0; m < 4; ++m)
#pragma unroll
                for (int n = 0; n < 2; ++n) acc[a][b][m][n] = (f32x4){0.f, 0.f, 0.f, 0.f};
    bf16x8 At[4][2], B0[2][2], B1[2][2];
    const char* cA = S.aptr(cur); const char* cB = S.bptr(cur);
    PG8_AOFF(vAc, cur);
    PG8_STAGE(PG8_SB(0, 0), cB, voffB); PG8_STAGE(PG8_SB(0, 1), cB + hstepB, voffB); PG8_STAGE_A(PG8_SA(0, 0), cA, 0, false); PG8_STAGE_A(PG8_SA(0, 1), cA, 1, false);
    if (wr == 1) PG8_BAR;
    PG8_WAIT_V(2); PG8_BAR;
    PG8_STAGE(PG8_SB(1, 0), cB + kstep, voffB); PG8_STAGE_A(PG8_SA(1, 0), cA + kstep, 0, false); PG8_STAGE(PG8_SB(1, 1), cB + hstepB + kstep, voffB);
    PG8_WAIT_V(6); PG8_BAR;
    for (;;) {
        const bool has_next = S.next(ui + 1, nxt);
        const char* nA = has_next ? S.aptr(nxt) : cA; const char* nB = has_next ? S.bptr(nxt) : cB;
        if constexpr (GATHER) { if (has_next) { PG8_AOFF(vAn, nxt); } else {
#pragma unroll
            for (int h = 0; h < 2; ++h)
#pragma unroll
                for (int i = 0; i < 2; ++i) vAn[h][i] = vAc[h][i]; } }
#if defined(PROBE_MASK) && PROBE_MASK
        const unsigned long long _tk0 = __builtin_amdgcn_s_memrealtime();
#endif
        for (int t = 0; t < nt; t += 2) {
            const bool last = (t == nt - 2);
            const char* a1 = cA + (size_t)(t + 1) * kstep;
            const char* a2 = last ? nA : cA + (size_t)(t + 2) * kstep; const char* b2 = last ? nB : cB + (size_t)(t + 2) * kstep;
            const char* a3 = a2 + kstep; const char* b3 = b2 + kstep;
            PG8_LDB(B0, 0, 0); PG8_LDB(B1, 0, 1); PG8_SCHED; PG8_LDA(At, 0, 0); PG8_STAGE_A(PG8_SA(1, 1), a1, 1, false);
            PG8_WAIT_V(8); PG8_WAIT_L(0); PG8_BAR; PG8_MMA(0, 0, At, B0); PG8_MMA(0, 1, At, B1); PG8_BAR; PG8_SCHED;
            PG8_LDA(At, 0, 1); PG8_STAGE(PG8_SB(0, 0), b2, voffB); PG8_STAGE(PG8_SB(0, 1), b2 + hstepB, voffB); PG8_STAGE_A(PG8_SA(0, 0), a2, 0, last);
            PG8_WAIT_V(8); PG8_WAIT_L(0); PG8_BAR; PG8_MMA(1, 0, At, B0); PG8_MMA(1, 1, At, B1); PG8_BAR; PG8_SCHED;
            PG8_LDB(B0, 1, 0); PG8_LDB(B1, 1, 1); PG8_SCHED; PG8_LDA(At, 1, 0); PG8_STAGE_A(PG8_SA(0, 1), a2, 1, last);
            PG8_WAIT_V(8); PG8_WAIT_L(0); PG8_BAR; PG8_MMA(0, 0, At, B0); PG8_MMA(0, 1, At, B1); PG8_BAR; PG8_SCHED;
            PG8_LDA(At, 1, 1); PG8_STAGE(PG8_SB(1, 0), b3, voffB); PG8_STAGE(PG8_SB(1, 1), b3 + hstepB, voffB); PG8_STAGE_A(PG8_SA(1, 0), a3, 0, last);
            PG8_WAIT_V(8); PG8_WAIT_L(0); PG8_BAR; PG8_MMA(1, 0, At, B0); PG8_MMA(1, 1, At, B1); PG8_BAR; PG8_SCHED;
        }
#if defined(PROBE_MASK) && PROBE_MASK
        if (blockIdx.x == PROBE_BLOCK && tid == 0 && ((volatile LAS unsigned*)(lds + 147456))[6]) ((LAS unsigned*)(lds + 147456 + 512))[14] += (unsigned)(__builtin_amdgcn_s_memrealtime() - _tk0);
#endif
        if (wr == 0) PG8_BAR;
#if defined(PROBE_MASK) && PROBE_MASK
        { const unsigned long long _t0 = __builtin_amdgcn_s_memrealtime();
          E(acc, cur, wr, wc, fr, fq);
          asm volatile("s_waitcnt vmcnt(0)" ::: "memory");
          if (blockIdx.x == PROBE_BLOCK && tid == 0 && ((volatile LAS unsigned*)(lds + 147456))[6]) ((LAS unsigned*)(lds + 147456 + 512))[13] += (unsigned)(__builtin_amdgcn_s_memrealtime() - _t0); }
#else
        E(acc, cur, wr, wc, fr, fq);
#endif
        if (!has_next) break;
#pragma unroll
        for (int a = 0; a < 2; ++a)
#pragma unroll
            for (int b = 0; b < 2; ++b)
#pragma unroll
                for (int m = 0; m < 4; ++m)
#pragma unroll
                    for (int n = 0; n < 2; ++n) acc[a][b][m][n] = (f32x4){0.f, 0.f, 0.f, 0.f};
        cur = nxt; cA = nA; cB = nB; ++ui;
        if constexpr (GATHER) {
#pragma unroll
        for (int h = 0; h < 2; ++h)
#pragma unroll
            for (int i = 0; i < 2; ++i) vAc[h][i] = vAn[h][i]; }
        if (wr == 1) PG8_BAR;
    }
    PG8_WAIT_V(0);
    PG8_BAR;
#undef PG8_SA
#undef PG8_SB
#undef PG8_STAGE
#undef PG8_LDA
#undef PG8_LDB
#undef PG8_MMA
#undef PG8_WAIT_V
#undef PG8_WAIT_L
#undef PG8_BAR
#undef PG8_SCHED
#undef PG8_AOFF
#undef PG8_STAGE_A
}
}

constexpr int D = 1024, BATCH = 32, SEQ = 2048, DEPTH = 2;
constexpr int NCH = 2, BC = BATCH / NCH, TC = BC * SEQ;
constexpr int TT = BATCH * SEQ;
constexpr int NP = 10496;
constexpr int C_QA = 0, C_KA = 256, C_VA = 512, C_OG = 1024, C_GP = 1536, C_XB = 1792, C_YB = 2304, C_QKV = 2816, C_G = 7424;
constexpr int WIN_N = 10256;
constexpr int NE = 16, FF = 512;
constexpr int RP = 2 * TT + NE * 256;
constexpr float RMS_EPS = 1e-6f;
constexpr int NWAVES = 8, NTHR = 512;

constexpr size_t MiB = 1u << 20;
constexpr size_t WS_CTL = 0, CTL_ZERO_BYTES = 1 * MiB;
constexpr size_t WS_REC = 1 * MiB;
constexpr size_t WS_LIST = 2 * MiB;
constexpr size_t WS_W = 6 * MiB;
constexpr size_t LW_WIN = 0, LW_WBR = LW_WIN + (size_t)NP * D * 2, LW_WOUT = LW_WBR + (size_t)3 * D * 512 * 2, LW_WGU = LW_WOUT + (size_t)D * D * 2,
                 LW_WDN = LW_WGU + (size_t)NE * 1024 * D * 2, LW_SIZE = LW_WDN + (size_t)NE * D * FF * 2;
static_assert(LW_SIZE == 77070336, "layer weights");
constexpr size_t WS_BRC = 154 * MiB;
constexpr size_t WS_ACT = 166 * MiB;
constexpr size_t WS_PROJ = 294 * MiB;
constexpr size_t WS_HID = WS_PROJ;
constexpr size_t WS_YS = WS_PROJ + 136 * MiB;
constexpr size_t WS_END = WS_PROJ + 656 * MiB;
static_assert(WS_W + 2 * LW_SIZE <= WS_BRC && WS_BRC + 12 * MiB <= WS_ACT && WS_ACT + (size_t)TT * D * 2 <= WS_PROJ && (size_t)TC * NP * 2 <= 656 * MiB && (size_t)RP * 512 * 2 <= 136 * MiB && WS_YS + (size_t)RP * 2048 <= WS_END, "ws map");
constexpr int CW_BAR = 4096;
constexpr int CW_CNT = 8192;
constexpr int CW_Q = 12288;

constexpr int RING_BYTES = 147456;
constexpr int MISC_OFF = RING_BYTES;
constexpr int LDS_BYTES = 155648;

#define LDS_WAIT() asm volatile("s_waitcnt lgkmcnt(0)" ::: "memory")
#define VM_WAIT() asm volatile("s_waitcnt vmcnt(0)" ::: "memory")
__device__ __forceinline__ float bf2f(unsigned short b) { return __uint_as_float(((unsigned)b) << 16); }
__device__ __forceinline__ float bflo(unsigned u) { return __uint_as_float(u << 16); }
__device__ __forceinline__ float bfhi(unsigned u) { return __uint_as_float(u & 0xffff0000u); }
typedef __bf16 bf16x2v_t __attribute__((ext_vector_type(2)));
__device__ __forceinline__ unsigned pk2(float lo, float hi) { const f32x2 v = {lo, hi}; return __builtin_bit_cast(unsigned, __builtin_convertvector(v, bf16x2v_t)); }
__device__ __forceinline__ unsigned f2bf(float f) { return pk2(f, 0.f) & 0xffffu; }
__device__ __forceinline__ float rcpf_(float x) { return __builtin_amdgcn_rcpf(x); }
__device__ __forceinline__ float rsqf_(float x) { return __builtin_amdgcn_rsqf(x); }
template <int O> __device__ __forceinline__ float swz_xor(float v) { return __int_as_float(__builtin_amdgcn_ds_swizzle(__float_as_int(v), (O << 10) | 0x1f)); }
__device__ __forceinline__ float wave_sum(float v) {
    v += swz_xor<1>(v); v += swz_xor<2>(v); v += swz_xor<4>(v); v += swz_xor<8>(v); v += swz_xor<16>(v);
    const auto r = __builtin_amdgcn_permlane32_swap(__float_as_uint(v), __float_as_uint(v), false, false);
    return __uint_as_float(r[0]) + __uint_as_float(r[1]);
}
__device__ __forceinline__ float wave_max(float v) {
    v = fmaxf(v, swz_xor<1>(v)); v = fmaxf(v, swz_xor<2>(v)); v = fmaxf(v, swz_xor<4>(v)); v = fmaxf(v, swz_xor<8>(v)); v = fmaxf(v, swz_xor<16>(v));
    const auto r = __builtin_amdgcn_permlane32_swap(__float_as_uint(v), __float_as_uint(v), false, false);
    return fmaxf(__uint_as_float(r[0]), __uint_as_float(r[1]));
}
__device__ __forceinline__ float sigmoidf_(float x) { return __builtin_amdgcn_rcpf(1.f + __expf(-x)); }

#define XB_TMO      128
#define XB_XCNT(j)  (256  + 64 * (j))
#define XB_XSUB(j)  (1280 + 64 * (j))
#define XB_XGEN(j)  (2304 + 64 * (j))
#define XB_TOP      3328
#define XB_TOPGEN   3392
#define XCD_BAR_WORDS 3456
#define XB_SPIN_CAP (1u << 21)
__device__ __forceinline__ unsigned xb_ld(unsigned* p)              { return __hip_atomic_load(p, __ATOMIC_RELAXED, __HIP_MEMORY_SCOPE_AGENT); }
__device__ __forceinline__ unsigned xb_add(unsigned* p, unsigned v) { return __hip_atomic_fetch_add(p, v, __ATOMIC_RELAXED, __HIP_MEMORY_SCOPE_AGENT); }
__device__ __forceinline__ unsigned xb_xcc_id() { return (unsigned)__builtin_amdgcn_s_getreg((3 << 11) | 20) & 0xFu; }
#define XB_SPIN(cond, bar) do { unsigned _sp = 0; while (cond) { __builtin_amdgcn_s_sleep(1); \
    if ((++_sp & 255u) == 0u) { if (xb_ld(&(bar)[XB_TMO])) break; if (_sp > XB_SPIN_CAP) { atomicAdd(&(bar)[XB_TMO], 1u); break; } } } } while (0)
struct XcdBarrier { unsigned* bar; unsigned x; volatile LAS unsigned* st; };
__device__ __forceinline__ XcdBarrier xcd_barrier_post(unsigned* bar, volatile LAS unsigned* st, int tid) {
    XcdBarrier b; b.bar = bar; b.x = xb_xcc_id(); b.st = st;
    if (tid == 0) (void)xb_add(&bar[XB_XCNT(b.x)], 1u);
    return b;
}
__device__ __forceinline__ void xcd_barrier_complete(unsigned* bar, unsigned x, unsigned& nloc, unsigned& nx) {
    const unsigned G = gridDim.x * gridDim.y * gridDim.z;
    unsigned sum, cnt, sp = 0u;
    for (;;) {
        sum = 0u; cnt = 0u;
#pragma unroll 1
        for (unsigned j = 0; j < 16; ++j) { const unsigned c = xb_ld(&bar[XB_XCNT(j)]); sum += c; cnt += (c > 0u) ? 1u : 0u; }
        if (sum == G) break;
        __builtin_amdgcn_s_sleep(1);
        if ((++sp & 255u) == 0u) { if (xb_ld(&bar[XB_TMO])) break; if (sp > XB_SPIN_CAP) { atomicAdd(&bar[XB_TMO], 1u); break; } }
    }
    const unsigned mine = xb_ld(&bar[XB_XCNT(x)]);
    nloc = mine > 0u ? mine : 1u; nx = cnt > 0u ? cnt : 1u;
}
__device__ __noinline__ void xcd_barrier(const XcdBarrier b, const int tid) {
    asm volatile("s_waitcnt vmcnt(0)" ::: "memory");
    __syncthreads();
    if (tid == 0) {
        unsigned* bar = b.bar;
        __builtin_amdgcn_s_waitcnt(0);
        unsigned nloc = b.st[0], nx = b.st[1];
        if (nloc == 0u) { xcd_barrier_complete(bar, b.x, nloc, nx); b.st[0] = nloc; b.st[1] = nx; }
        const unsigned old = xb_add(&bar[XB_XSUB(b.x)], 1u);
        const unsigned gen = old / nloc;
        if (old + 1u == (gen + 1u) * nloc) {
            __builtin_amdgcn_fence(__ATOMIC_RELEASE, "agent");
            asm volatile("s_waitcnt vmcnt(0)" ::: "memory");
            const unsigned og = xb_add(&bar[XB_TOP], 1u);
            const unsigned tg = og / nx;
            if (og + 1u == (tg + 1u) * nx) xb_add(&bar[XB_TOPGEN], 1u);
            else XB_SPIN(xb_ld(&bar[XB_TOPGEN]) == tg, bar);
            __builtin_amdgcn_fence(__ATOMIC_ACQUIRE, "agent");
            xb_add(&bar[XB_XGEN(b.x)], 1u);
            asm volatile("s_waitcnt vmcnt(0)" ::: "memory");
        } else {
            XB_SPIN(xb_ld(&bar[XB_XGEN(b.x)]) == gen, bar);
            __builtin_amdgcn_fence(__ATOMIC_ACQUIRE, "agent");
            asm volatile("s_waitcnt vmcnt(0)" ::: "memory");
        }
    }
    __syncthreads();
}

struct Args { const void* in[24]; float* out; unsigned char* ws; int ph_lo, ph_hi; };
struct Ctx {
    LAS unsigned char* lds;
    unsigned* ctl;
    int tid, lane, wave, bid, G;
    int chunk, layer, pass;
    const float* x_in; float* xo;
    const float* xinf; float* xof; bf16_t* actf;
    const int* pos;
    const unsigned char* lw;
    bf16_t *act, *proj, *hid, *ys;
    unsigned* rec; int* list;
};

__device__ __forceinline__ void tr_item(const float* srcp, int Nsrc, float scale, bf16_t* WT, int K, int n0, int k0, LAS float* scr, int lane) {
#pragma unroll 8
    for (int i = 0; i < 32; ++i) { const int kk = 2 * i + (lane >> 5); scr[kk * 33 + (lane & 31)] = srcp[(size_t)(k0 + kk) * Nsrc] * scale; }
    LDS_WAIT(); asm volatile("" ::: "memory");
    const int c = lane & 7;
#pragma unroll
    for (int j = 0; j < 4; ++j) { const int n = (lane >> 3) + 8 * j; const LAS float* s = scr + (8 * c) * 33 + n;
        u32x4 o; o.x = pk2(s[0 * 33], s[1 * 33]); o.y = pk2(s[2 * 33], s[3 * 33]); o.z = pk2(s[4 * 33], s[5 * 33]); o.w = pk2(s[6 * 33], s[7 * 33]);
        *(u32x4*)(WT + (size_t)(n0 + n) * K + k0 + 8 * c) = o; }
    LDS_WAIT(); asm volatile("" ::: "memory");
}
constexpr int IT_WIN = (NP / 32) * 16, IT_WBR = 3 * 32 * 8, IT_WOUT = 32 * 16, IT_WGU = NE * 32 * 16, IT_WDN = NE * 32 * 8, IT_LAYER = IT_WIN + IT_WBR + IT_WOUT + IT_WGU + IT_WDN;
__device__ __forceinline__ void phase_prep(const Args& a, LAS unsigned char* lds, int gw, int NGW, int wave, int lane, int gtid, int NGT) {
    LAS float* scr = (LAS float*)(lds + wave * 16384);
    for (int it = gw; it < DEPTH * IT_LAYER; it += NGW) {
        const int l = it / IT_LAYER; int r = it % IT_LAYER;
        unsigned char* lw = a.ws + WS_W + (size_t)l * LW_SIZE;
        const int rl = lane & 31;
        if (r < IT_WIN) {
            const int g = r / 16, kb = r % 16;
            if (g >= C_GP / 32 && g < C_XB / 32) continue;
            const int n = 32 * g + rl; const int src = n < C_GP ? n : n - 240;
            const float* W = (const float*)a.in[3] + (size_t)l * D * WIN_N;
            tr_item(W + src, WIN_N, n < 256 ? 0.125f : 1.f, (bf16_t*)(lw + LW_WIN), D, 32 * g, 64 * kb, scr, lane);
            continue; }
        r -= IT_WIN;
        if (r < IT_WBR) {
            const int b = r / 256, g = (r % 256) / 8, kb = r % 8;
            const float* W = (const float*)a.in[16] + ((size_t)l * 3 + b) * 512 * D;
            tr_item(W + 32 * g + rl, D, 1.f, (bf16_t*)(lw + LW_WBR) + (size_t)b * D * 512, 512, 32 * g, 64 * kb, scr, lane);
            continue; }
        r -= IT_WBR;
        if (r < IT_WOUT) {
            const int g = r / 16, kb = r % 16;
            const float* W = (const float*)a.in[17] + (size_t)l * D * D;
            tr_item(W + 32 * g + rl, D, 1.f, (bf16_t*)(lw + LW_WOUT), D, 32 * g, 64 * kb, scr, lane);
            continue; }
        r -= IT_WOUT;
        if (r < IT_WGU) {
            const int e = r / 512, g = (r % 512) / 16, kb = r % 16;
            const float* Wg = (const float*)a.in[21] + ((size_t)l * NE + e) * D * FF;
            const float* Wu = (const float*)a.in[22] + ((size_t)l * NE + e) * D * FF;
            const float* sp = (rl < 16 ? Wg : Wu) + 16 * g + (rl & 15);
            tr_item(sp, FF, 1.f, (bf16_t*)(lw + LW_WGU) + (size_t)e * 1024 * D, D, 32 * g, 64 * kb, scr, lane);
            continue; }
        r -= IT_WGU;
        {
            const int e = r / 256, g = (r % 256) / 8, kb = r % 8;
            const float* W = (const float*)a.in[23] + ((size_t)l * NE + e) * FF * D;
            tr_item(W + 32 * g + rl, D, 1.f, (bf16_t*)(lw + LW_WDN) + (size_t)e * D * FF, FF, 32 * g, 64 * kb, scr, lane);
        }
    }
    for (int idx = gtid; idx < DEPTH * 256 * D; idx += NGT) {
        const int l = idx / (256 * D), j = (idx / D) % 256, k = idx % D;
        const float* W = (const float*)a.in[3] + (size_t)l * D * WIN_N + (size_t)k * WIN_N + 1536;
        const float* gu = (const float*)a.in[4] + (size_t)l * 16 * 256 + j;
        float s = 0.f;
#pragma unroll
        for (int r = 0; r < 16; ++r) s += W[r] * gu[r * 256];
        ((bf16_t*)(a.ws + WS_W + (size_t)l * LW_SIZE + LW_WIN))[(size_t)(C_GP + j) * D + k] = (bf16_t)f2bf(s);
    }
}

__device__ __forceinline__ void moe_tables(const unsigned* cnt, LAS int* pt, LAS int* lc, int tid) {
    if (tid == 0) { int s = 0;
        for (int e = 0; e < NE; ++e) { const int c = (int)__hip_atomic_load(cnt + e, __ATOMIC_RELAXED, __HIP_MEMORY_SCOPE_AGENT); pt[e] = s; lc[e] = c; s += (c + 255) >> 8; }
        pt[NE] = s; }
    __syncthreads();
}

template <bool COMBINE, bool NORM, bool SRC_OUT>
__device__ __forceinline__ void phase_norm1(const Ctx& c, const float* gain, LAS const int* pt) {
    const int gw = c.bid * NWAVES + c.wave, NGW = c.G * NWAVES, lane = c.lane;
    f32x4 g4[4];
    if (NORM) {
#pragma unroll
        for (int j = 0; j < 4; ++j) g4[j] = *((const f32x4*)gain + 64 * j + lane); }
    constexpr int NR = 4;
    static_assert(TT % (NR * 2048) == 0, "rows per wave");
    for (int tok0 = gw; tok0 < TT; tok0 += NR * NGW) {
        f32x4 v[NR][4]; u32x2 ya[NR][4], yb[NR][4]; float w0[NR], w1[NR];
#pragma unroll
        for (int r = 0; r < NR; ++r) { const int tok = tok0 + r * NGW;
            const f32x4* xr = (const f32x4*)((SRC_OUT ? (const float*)c.xof : c.xinf) + (size_t)tok * D) + lane;
#pragma unroll
            for (int j = 0; j < 4; ++j) v[r][j] = xr[64 * j];
            if (COMBINE) {
                const u32x4 rc = *(const u32x4*)(c.rec + (size_t)tok * 4);
                const int e0 = rc.x >> 20, e1 = rc.y >> 20;
                const size_t r0 = (size_t)pt[e0] * 256 + (rc.x & 0xfffffu), r1 = (size_t)pt[e1] * 256 + (rc.y & 0xfffffu);
                w0[r] = __uint_as_float(rc.z); w1[r] = __uint_as_float(rc.w);
                const u32x2* y0 = (const u32x2*)(c.ys + r0 * D) + lane; const u32x2* y1 = (const u32x2*)(c.ys + r1 * D) + lane;
#pragma unroll
                for (int j = 0; j < 4; ++j) { ya[r][j] = y0[64 * j]; yb[r][j] = y1[64 * j]; }
            } }
#pragma unroll
        for (int r = 0; r < NR; ++r) { const int tok = tok0 + r * NGW;
            if (COMBINE) {
#pragma unroll
                for (int j = 0; j < 4; ++j) { const u32x2 a = ya[r][j], b = yb[r][j];
                    v[r][j].x += w0[r] * bflo(a.x) + w1[r] * bflo(b.x); v[r][j].y += w0[r] * bfhi(a.x) + w1[r] * bfhi(b.x);
                    v[r][j].z += w0[r] * bflo(a.y) + w1[r] * bflo(b.y); v[r][j].w += w0[r] * bfhi(a.y) + w1[r] * bfhi(b.y); }
                f32x4* xw = (f32x4*)(c.xof + (size_t)tok * D) + lane;
#pragma unroll
                for (int j = 0; j < 4; ++j) xw[64 * j] = v[r][j];
            }
            if (NORM) {
                float ss = 0.f;
#pragma unroll
                for (int j = 0; j < 4; ++j) ss += (v[r][j].x * v[r][j].x + v[r][j].y * v[r][j].y) + (v[r][j].z * v[r][j].z + v[r][j].w * v[r][j].w);
                const float rs = rsqf_(wave_sum(ss) * (1.f / D) + RMS_EPS);
                u32x2* o = (u32x2*)(c.actf + (size_t)tok * D) + lane;
#pragma unroll
                for (int j = 0; j < 4; ++j) { u32x2 w; w.x = pk2(v[r][j].x * rs * g4[j].x, v[r][j].y * rs * g4[j].y); w.y = pk2(v[r][j].z * rs * g4[j].z, v[r][j].w * rs * g4[j].w); o[64 * j] = w; }
            } }
    }
}

__constant__ double kInvFreq[16] = {1.0, 0.44036660267178046, 0.19392274474868576, 0.08539710028576561, 0.03760603093086393, 0.016560440080994446, 0.007292664737217109, 0.003211445994752591,
    0.001414213562373095, 0.000622772421914596, 0.0002742481756762073, 0.00012076973741146504, 5.318295896944988e-05, 2.341999896140934e-05, 1.031338537721246e-05, 4.5416704806078695e-06};
__device__ __forceinline__ void phase_rope_table(const int* pos, float* tab, int gtid, int NGT) {
    for (int idx = gtid; idx < BATCH * SEQ * 16; idx += NGT) { const int tok = idx >> 4, i = idx & 15;
        double a = (double)pos[tok] * kInvFreq[i] * 0.15915494309189535; a -= rint(a);
        tab[(size_t)tok * 32 + i] = __builtin_amdgcn_cosf((float)a); tab[(size_t)tok * 32 + 16 + i] = __builtin_amdgcn_sinf((float)a); }
}

__device__ __forceinline__ float logsigmoidf_(float g) { return fminf(g, 0.f) - log1pf(__expf(-fabsf(g))); }
__device__ __forceinline__ float gelu_tanh(float y) { const float u = 0.7978845608028654f * (y + 0.044715f * y * y * y); const float t = 1.f - 2.f * rcpf_(1.f + __expf(2.f * u)); return 0.5f * y * (1.f + t); }

__device__ __forceinline__ void gla_simple(const Ctx& c, int b, const float* gbias, const float* ogain) {
    LAS float* sQ = (LAS float*)c.lds; LAS float* sK = sQ + 16 * 256; LAS float* sA = sK + 16 * 256; LAS float* sO = sA + 16 * 256; LAS float* sV = sO + 16 * 512;
    const int tid = c.tid, h = tid >> 7, lane = c.lane;
    float S[64];
#pragma unroll
    for (int i = 0; i < 64; ++i) S[i] = 0.f;
    const float og0 = ogain[2 * lane], og1 = ogain[2 * lane + 1];
    for (int tc = 0; tc < SEQ / 16; ++tc) {
        const size_t tok0 = (size_t)b * SEQ + tc * 16;
        __syncthreads();
        for (int idx = tid; idx < 16 * 256; idx += NTHR) { const int s = idx >> 8, ci = idx & 255; const bf16_t* row = c.proj + (tok0 + s) * NP;
            sQ[idx] = bf2f(row[C_QA + ci]); sK[idx] = bf2f(row[C_KA + ci]);
            sA[idx] = __expf(logsigmoidf_(bf2f(row[C_GP + ci]) + gbias[ci]) * (1.f / 16.f)); }
#pragma unroll
        for (int s = 0; s < 16; ++s) sV[s * 512 + tid] = bf2f(c.proj[(tok0 + s) * NP + C_VA + tid]);
        __syncthreads();
        for (int s = 0; s < 16; ++s) {
            const float v = sV[s * 512 + tid]; float o = 0.f;
            const LAS f32x4* a4 = (const LAS f32x4*)(sA + s * 256 + h * 64); const LAS f32x4* k4 = (const LAS f32x4*)(sK + s * 256 + h * 64); const LAS f32x4* q4 = (const LAS f32x4*)(sQ + s * 256 + h * 64);
#pragma unroll
            for (int d = 0; d < 16; ++d) { const f32x4 a = a4[d], k = k4[d], q = q4[d];
                S[4 * d + 0] = S[4 * d + 0] * a.x + k.x * v; o += q.x * S[4 * d + 0];
                S[4 * d + 1] = S[4 * d + 1] * a.y + k.y * v; o += q.y * S[4 * d + 1];
                S[4 * d + 2] = S[4 * d + 2] * a.z + k.z * v; o += q.z * S[4 * d + 2];
                S[4 * d + 3] = S[4 * d + 3] * a.w + k.w * v; o += q.w * S[4 * d + 3]; }
            sO[s * 512 + tid] = o;
        }
        __syncthreads();
#pragma unroll 2
        for (int k = 0; k < 8; ++k) { const int rr = c.wave * 8 + k, s = rr >> 2, hh = rr & 3;
            const float o0 = sO[s * 512 + hh * 128 + 2 * lane], o1 = sO[s * 512 + hh * 128 + 2 * lane + 1];
            const float rs = rsqf_(wave_sum(o0 * o0 + o1 * o1) * (1.f / 128.f) + RMS_EPS);
            unsigned* pp = (unsigned*)(c.proj + (tok0 + s) * NP + C_OG + hh * 128) + lane;
            const unsigned u = *pp; const float g0 = bflo(u), g1 = bfhi(u);
            *pp = pk2(o0 * rs * og0 * g0 * sigmoidf_(g0), o1 * rs * og1 * g1 * sigmoidf_(g1)); }
    }
}

__device__ __forceinline__ void lru_simple(const Ctx& c, int b, const float* convw, const float* convb, const float* wa_, const float* ba_, const float* wx_, const float* bx_, const float* lam_) {
    const int ch = c.tid, n = c.wave, lane = c.lane;
    LAS float* sX = (LAS float*)(c.lds + n * 4096);
    const float* wap = wa_ + n * 4096 + lane; const float* wxp = wx_ + n * 4096 + lane;
    const float cw0 = convw[ch], cw1 = convw[512 + ch], cw2 = convw[1024 + ch], cw3 = convw[1536 + ch], cb = convb[ch], ba = ba_[ch], bx = bx_[ch];
    const float lam = lam_[ch]; const float c8 = 8.f * (fmaxf(-lam, 0.f) + log1pf(__expf(-fabsf(lam))));
    float xm1 = 0.f, xm2 = 0.f, xm3 = 0.f, hs = 0.f;
    for (int tc = 0; tc < SEQ / 16; ++tc) {
        const size_t tok0 = (size_t)b * SEQ + tc * 16;
        float xc[16], yv[16], ar[16], ai[16];
#pragma unroll
        for (int s = 0; s < 16; ++s) { xc[s] = bf2f(c.proj[(tok0 + s) * NP + C_XB + ch]); yv[s] = bf2f(c.proj[(tok0 + s) * NP + C_YB + ch]); }
#pragma unroll
        for (int s = 0; s < 16; ++s) { const float x = xc[s]; xc[s] = cb + cw0 * xm3 + cw1 * xm2 + cw2 * xm1 + cw3 * x; xm3 = xm2; xm2 = xm1; xm1 = x; sX[s * 64 + lane] = xc[s]; ar[s] = ba; ai[s] = bx; }
        LDS_WAIT(); asm volatile("" ::: "memory"); __builtin_amdgcn_wave_barrier();
#pragma unroll 2
        for (int k = 0; k < 64; ++k) { const float wa = wap[k * 64], wx = wxp[k * 64];
#pragma unroll
            for (int s = 0; s < 16; ++s) { const float x = sX[s * 64 + k]; ar[s] += x * wa; ai[s] += x * wx; } }
#pragma unroll
        for (int s = 0; s < 16; ++s) {
            const float r = sigmoidf_(ar[s]), ig = sigmoidf_(ai[s]);
            const float a = __expf(-c8 * r);
            const float u = sqrtf(fmaxf(1.f - a * a, 0.f)) * ig * xc[s];
            hs = a * hs + u;
            c.proj[(tok0 + s) * NP + C_YB + ch] = (bf16_t)f2bf(hs * gelu_tanh(yv[s]));
        }
        LDS_WAIT(); asm volatile("" ::: "memory"); __builtin_amdgcn_wave_barrier();
    }
}

__device__ __forceinline__ void attn_simple(const Ctx& c, int aw, int NAW) {
    const int lane = c.lane;
    for (int task = aw; task < TC * 4; task += NAW) {
        const int tok = task >> 2, h = task & 3, t = tok & (SEQ - 1);
        float ml = -INFINITY, wsum = 0.f, acc0 = 0.f, acc1 = 0.f;
#pragma unroll 1
        for (int p = 0; p < 3; ++p) {
            const int dsh = 2 * p, i = t >> dsh, nk = i + 1 < 129 ? i + 1 : 129;
            const bf16_t* qrow = c.proj + (size_t)tok * NP + C_QKV + (p * 4 + h) * 128;
            const int kcol = C_QKV + (12 + p * 4 + h) * 128, vcol = C_QKV + (24 + p * 4 + h) * 128;
            float sc[3];
#pragma unroll
            for (int r = 0; r < 3; ++r) {
                sc[r] = -INFINITY;
                if (64 * r < nk) {
                    const int m = 64 * r + lane; const bool valid = m < nk;
                    const bf16_t* krow = c.proj + (size_t)(tok - ((valid ? m : 0) << dsh)) * NP + kcol;
                    float s = 0.f;
#pragma unroll 1
                    for (int cb = 0; cb < 4; ++cb) {
                        u32x4 kq[4], qq[4];
#pragma unroll
                        for (int j = 0; j < 4; ++j) { kq[j] = *((const u32x4*)krow + cb * 4 + j); qq[j] = *((const u32x4*)qrow + cb * 4 + j); }
#pragma unroll
                        for (int j = 0; j < 4; ++j) {
                            s += bflo(kq[j].x) * bflo(qq[j].x) + bfhi(kq[j].x) * bfhi(qq[j].x) + bflo(kq[j].y) * bflo(qq[j].y) + bfhi(kq[j].y) * bfhi(qq[j].y)
                               + bflo(kq[j].z) * bflo(qq[j].z) + bfhi(kq[j].z) * bfhi(qq[j].z) + bflo(kq[j].w) * bflo(qq[j].w) + bfhi(kq[j].w) * bfhi(qq[j].w); }
                    }
                    sc[r] = valid ? s * 0.08838834764831845f : -INFINITY;
                }
            }
            const float mx = wave_max(fmaxf(sc[0], fmaxf(sc[1], sc[2])));
            float pr[3];
#pragma unroll
            for (int r = 0; r < 3; ++r) pr[r] = __expf(sc[r] - mx);
            const float den = wave_sum(pr[0] + pr[1] + pr[2]);
            float o0 = 0.f, o1 = 0.f;
#pragma unroll
            for (int r = 0; r < 3; ++r) {
                const int cnt = nk - 64 * r < 64 ? nk - 64 * r : 64;
                if (cnt > 0) {
                const unsigned* vb = (const unsigned*)(c.proj + (size_t)(tok - ((64 * r) << dsh)) * NP + vcol) + lane;
#pragma unroll 4
                for (int mm = 0; mm < cnt; ++mm) {
                    const float pm = __int_as_float(__builtin_amdgcn_readlane(__float_as_int(pr[r]), mm));
                    const unsigned u = *(const unsigned*)((const char*)vb - (size_t)(mm << dsh) * NP * 2);
                    o0 += pm * bflo(u); o1 += pm * bfhi(u); }
                }
            }
            const float inv = rcpf_(den), lse = mx + __logf(den);
            const float nml = fmaxf(ml, lse), sc_old = __expf(ml - nml), w = __expf(lse - nml);
            acc0 = acc0 * sc_old + w * o0 * inv; acc1 = acc1 * sc_old + w * o1 * inv; wsum = wsum * sc_old + w; ml = nml;
        }
        const float wi = rcpf_(wsum);
        unsigned* op = (unsigned*)(c.proj + (size_t)tok * NP + C_QKV + h * 128) + lane;
        *op = pk2(acc0 * wi, acc1 * wi);
    }
}

typedef unsigned short u16x4 __attribute__((ext_vector_type(4)));
__device__ __forceinline__ unsigned offb(unsigned row, unsigned ch) { return 256u * row + 16u * (ch ^ (((row & 3u) << 2) | ((row >> 2) & 3u))); }
constexpr int ATT_UNITS_PER_SEQ = 3 * 4 * 16;
struct AttU { int b, p, h, blk, dsh, it0; size_t tok0; int qcol, kcol, vcol; };
__device__ __forceinline__ AttU att_decode(int unit) {
    AttU a; a.b = unit / ATT_UNITS_PER_SEQ; const int rem = unit % ATT_UNITS_PER_SEQ; a.p = rem / 64; a.h = (rem / 16) & 3; const int qb = rem & 15;
    a.dsh = 2 * a.p; const int nblk = 16 >> a.dsh, r = qb / nblk; a.blk = qb % nblk; a.tok0 = (size_t)a.b * SEQ + r; a.it0 = a.blk == 0 ? 4 : 0;
    a.qcol = C_QKV + (a.p * 4 + a.h) * 128; a.kcol = C_QKV + (12 + a.p * 4 + a.h) * 128; a.vcol = C_QKV + (24 + a.p * 4 + a.h) * 128; return a;
}
#define ATT_DMA(U, col, dst) do { _Pragma("unroll") for (int it = 0; it < 8; ++it) if (it >= (U).it0) { const int q = w + 8 * it; const unsigned n = 64u * q + lane, row = n >> 4, cs = n & 15u, ch = cs ^ (((row & 3u) << 2) | ((row >> 2) & 3u)); \
        const int srow = ((U).blk - 1) * 128 + (int)row; \
        __builtin_amdgcn_global_load_lds((const unsigned*)(c.proj + ((U).tok0 + ((size_t)srow << (U).dsh)) * NP + (col) + ch * 8), (LAS unsigned*)((dst) + 1024 * q), 16, 0, 0); } } while (0)
#define ATT_LOADQ(U) do { const size_t qt = (U).tok0 + ((size_t)((U).blk * 128 + qi) << (U).dsh); \
        _Pragma("unroll") for (int s = 0; s < 4; ++s) qr[s] = *(const u32x4*)(c.proj + qt * NP + (U).qcol + 32 * s + 8 * g); \
        const f32x4* rt = (const f32x4*)(rope_tab + qt * 32 + 8 * (g & 1)); qc0 = rt[0]; qc1 = rt[1]; qs0 = rt[4]; qs1 = rt[5]; \
        int srow = ((U).blk - 1) * 128 + (int)rrow; if (srow < 0) srow += 128; \
        const float* rt2 = rope_tab + ((U).tok0 + ((size_t)srow << (U).dsh)) * 32 + 8 * rps; \
        rc0 = *(const f32x4*)rt2; rc1 = *(const f32x4*)(rt2 + 4); rs0 = *(const f32x4*)(rt2 + 16); rs1 = *(const f32x4*)(rt2 + 20); } while (0)
__device__ __forceinline__ void attn_loop(const Ctx& c, unsigned* qhead, volatile LAS unsigned* mbox, float* lse_buf, const float* qgain, const float* kgain, const float* rope_tab  ) {
    const int tid = c.tid, lane = c.lane, w = c.wave;
    const unsigned NU = (unsigned)(BC * ATT_UNITS_PER_SEQ);
    LAS unsigned char* sK = c.lds; LAS unsigned char* sV = c.lds + 65536;
    LAS float* sRS = (LAS float*)(c.lds + MISC_OFF + 2048);
    const int qq = lane & 15, g = lane >> 4, qi = 16 * w + qq;
    const unsigned rrow = (unsigned)tid >> 1, rps = (unsigned)tid & 1u;
#if defined(PROBE_MASK) && PROBE_MASK
    unsigned long long _ta = __builtin_amdgcn_s_memrealtime();
#define ATT_STAMP(k) do { const unsigned long long _tb = __builtin_amdgcn_s_memrealtime(); if (blockIdx.x == PROBE_BLOCK && tid == 0) ((LAS unsigned*)(c.lds + MISC_OFF + 512))[(k)] += (unsigned)(_tb - _ta); _ta = _tb; } while (0)
#else
#define ATT_STAMP(k) do {} while (0)
#endif
    LAS float* sGQ = (LAS float*)(c.lds + MISC_OFF + 3072); LAS float* sGK = sGQ + 128;
    if (tid < 128) sGQ[tid] = qgain[tid]; else if (tid < 256) sGK[tid - 128] = kgain[tid - 128];
    if (tid == 0) { mbox[0] = __hip_atomic_fetch_add(qhead, 1u, __ATOMIC_RELAXED, __HIP_MEMORY_SCOPE_AGENT); mbox[1] = __hip_atomic_fetch_add(qhead, 1u, __ATOMIC_RELAXED, __HIP_MEMORY_SCOPE_AGENT); }
    __syncthreads();
    unsigned ucur = mbox[0], unxt = mbox[1];
    if (ucur >= NU) return;
    AttU U = att_decode((int)ucur);
    u32x4 qr[4]; f32x4 qc0, qc1, qs0, qs1, rc0, rc1, rs0, rs1;
    __syncthreads();
    ATT_DMA(U, U.kcol, sK); asm volatile("" ::: "memory");
    ATT_LOADQ(U); asm volatile("" ::: "memory");
    ATT_DMA(U, U.vcol, sV); asm volatile("" ::: "memory");
    bool first = true; unsigned nq = 0u;
    for (;;) {
        const int blk = U.blk, dsh = U.dsh, it0 = U.it0;
        const size_t qtok = U.tok0 + ((size_t)(blk * 128 + qi) << dsh);
        bf16x8 qf[4];
        {
            float qv[4][8]; float ss = 0.f;
#pragma unroll
            for (int s = 0; s < 4; ++s) { const unsigned wv[4] = {qr[s].x, qr[s].y, qr[s].z, qr[s].w};
#pragma unroll
                for (int k = 0; k < 4; ++k) { qv[s][2 * k] = bflo(wv[k]); qv[s][2 * k + 1] = bfhi(wv[k]); ss += qv[s][2 * k] * qv[s][2 * k] + qv[s][2 * k + 1] * qv[s][2 * k + 1]; } }
            ss += swz_xor<16>(ss);
            { const auto rr = __builtin_amdgcn_permlane32_swap(__float_as_uint(ss), __float_as_uint(ss), false, false); ss = __uint_as_float(rr[0]) + __uint_as_float(rr[1]); }
            const float rs = rsqf_(ss * (1.f / 128.f) + RMS_EPS);
#pragma unroll
            for (int s = 0; s < 4; ++s) { const f32x4 g0 = *(const LAS f32x4*)(sGQ + 32 * s + 8 * g), g1 = *(const LAS f32x4*)(sGQ + 32 * s + 8 * g + 4);
                const float gg[8] = {g0.x, g0.y, g0.z, g0.w, g1.x, g1.y, g1.z, g1.w};
#pragma unroll
                for (int j = 0; j < 8; ++j) qv[s][j] *= rs * gg[j]; }
            { const float cs8[8] = {qc0.x, qc0.y, qc0.z, qc0.w, qc1.x, qc1.y, qc1.z, qc1.w}, sn8[8] = {qs0.x, qs0.y, qs0.z, qs0.w, qs1.x, qs1.y, qs1.z, qs1.w};
              const float sgn = (g & 2) ? 1.f : -1.f;
#pragma unroll
              for (int j = 0; j < 8; ++j) { const auto rr = __builtin_amdgcn_permlane32_swap(__float_as_uint(qv[0][j]), __float_as_uint(qv[0][j]), false, false);
                  const float other = (g & 2) ? __uint_as_float(rr[0]) : __uint_as_float(rr[1]);
                  qv[0][j] = qv[0][j] * cs8[j] + sgn * other * sn8[j]; } }
#pragma unroll
            for (int s = 0; s < 4; ++s) { u32x4 pw; pw.x = pk2(qv[s][0], qv[s][1]); pw.y = pk2(qv[s][2], qv[s][3]); pw.z = pk2(qv[s][4], qv[s][5]); pw.w = pk2(qv[s][6], qv[s][7]); qf[s] = __builtin_bit_cast(bf16x8, pw); }
        }
        const f32x4 kc0 = rc0, kc1 = rc1, ks0v = rs0, ks1v = rs1;
        if (first) { if (it0) asm volatile("s_waitcnt vmcnt(4)" ::: "memory"); else asm volatile("s_waitcnt vmcnt(8)" ::: "memory"); }
        else       { if (it0) asm volatile("s_waitcnt vmcnt(13)" ::: "memory"); else asm volatile("s_waitcnt vmcnt(17)" ::: "memory"); }
        first = false;
        __syncthreads();
        if (tid == 0) nq = __hip_atomic_fetch_add(qhead, 1u, __ATOMIC_RELAXED, __HIP_MEMORY_SCOPE_AGENT);
        ATT_STAMP(5);
        {
            const int c16 = tid & 15, grp = tid >> 4;
            const f32x4 kg0 = *(const LAS f32x4*)(sGK + 8 * c16), kg1 = *(const LAS f32x4*)(sGK + 8 * c16 + 4);
            const float kg[8] = {kg0.x, kg0.y, kg0.z, kg0.w, kg1.x, kg1.y, kg1.z, kg1.w};
#pragma unroll 4
            for (int it = it0; it < 8; ++it) { const unsigned row = 32u * it + grp;
                LAS u32x4* kp_ = (LAS u32x4*)(sK + offb(row, c16));
                const u32x4 kr = *kp_; const unsigned wv[4] = {kr.x, kr.y, kr.z, kr.w};
                float kv[8]; float ss = 0.f;
#pragma unroll
                for (int k = 0; k < 4; ++k) { kv[2 * k] = bflo(wv[k]); kv[2 * k + 1] = bfhi(wv[k]); ss += kv[2 * k] * kv[2 * k] + kv[2 * k + 1] * kv[2 * k + 1]; }
                ss += swz_xor<1>(ss); ss += swz_xor<2>(ss); ss += swz_xor<4>(ss); ss += swz_xor<8>(ss);
                const float rs = rsqf_(ss * (1.f / 128.f) + RMS_EPS);
                if (c16 == 0) sRS[row] = rs;
                if (c16 >= 4) { u32x4 ko; ko.x = pk2(kv[0] * rs * kg[0], kv[1] * rs * kg[1]); ko.y = pk2(kv[2] * rs * kg[2], kv[3] * rs * kg[3]); ko.z = pk2(kv[4] * rs * kg[4], kv[5] * rs * kg[5]); ko.w = pk2(kv[6] * rs * kg[6], kv[7] * rs * kg[7]); *kp_ = ko; } }
        }
        __syncthreads();
        {
            const f32x4 ga0 = *(const LAS f32x4*)(sGK + 8 * rps), ga1 = *(const LAS f32x4*)(sGK + 8 * rps + 4), gb0 = *(const LAS f32x4*)(sGK + 16 + 8 * rps), gb1 = *(const LAS f32x4*)(sGK + 20 + 8 * rps);
            const float ga[8] = {ga0.x, ga0.y, ga0.z, ga0.w, ga1.x, ga1.y, ga1.z, ga1.w}, gb[8] = {gb0.x, gb0.y, gb0.z, gb0.w, gb1.x, gb1.y, gb1.z, gb1.w};
            const float cs8[8] = {kc0.x, kc0.y, kc0.z, kc0.w, kc1.x, kc1.y, kc1.z, kc1.w}, sn8[8] = {ks0v.x, ks0v.y, ks0v.z, ks0v.w, ks1v.x, ks1v.y, ks1v.z, ks1v.w};
            if (blk > 0 || rrow >= 128u) {
            LAS u32x4* p1 = (LAS u32x4*)(sK + offb(rrow, rps)); LAS u32x4* p2 = (LAS u32x4*)(sK + offb(rrow, rps + 2));
            const u32x4 a = *p1, b2 = *p2; const float rs = sRS[rrow];
            const unsigned wa[4] = {a.x, a.y, a.z, a.w}, wb[4] = {b2.x, b2.y, b2.z, b2.w};
            float o1[8], o2[8];
#pragma unroll
            for (int k = 0; k < 4; ++k) {
#pragma unroll
                for (int e = 0; e < 2; ++e) { const int j = 2 * k + e; const float x1 = (e ? bfhi(wa[k]) : bflo(wa[k])) * rs * ga[j], x2 = (e ? bfhi(wb[k]) : bflo(wb[k])) * rs * gb[j];
                    o1[j] = x1 * cs8[j] - x2 * sn8[j]; o2[j] = x2 * cs8[j] + x1 * sn8[j]; } }
            u32x4 w1, w2; w1.x = pk2(o1[0], o1[1]); w1.y = pk2(o1[2], o1[3]); w1.z = pk2(o1[4], o1[5]); w1.w = pk2(o1[6], o1[7]); w2.x = pk2(o2[0], o2[1]); w2.y = pk2(o2[2], o2[3]); w2.z = pk2(o2[4], o2[5]); w2.w = pk2(o2[6], o2[7]);
            *p1 = w1; *p2 = w2; }
        }
        __syncthreads();
        ATT_STAMP(6);
        const int ks0 = w >> 1, nskip = blk == 0 ? 4 : 0;
        f32x4 st[5][2];
        const unsigned krow_l = 8u * (qq >> 2) + (qq & 3u);
        LAS unsigned char* ka[2][4];
#pragma unroll
        for (int T = 0; T < 2; ++T)
#pragma unroll
            for (int s = 0; s < 4; ++s) ka[T][s] = sK + offb(32u * ks0 + krow_l + 4u * T, 4 * s + g);
#pragma unroll
        for (int n = 0; n < 5; ++n)
#pragma unroll
            for (int T = 0; T < 2; ++T) { f32x4 a = {0.f, 0.f, 0.f, 0.f};
                if (ks0 + n >= nskip) {
#pragma unroll
                for (int s = 0; s < 4; ++s) { const bf16x8 kf = *(const LAS bf16x8*)(ka[T][s] + 8192 * n); a = __builtin_amdgcn_mfma_f32_16x16x32_bf16(kf, qf[s], a, 0, 0, 0); } }
                st[n][T] = a; }
        asm volatile("s_waitcnt vmcnt(0) lgkmcnt(0)" ::: "memory");
        if (tid == 0) mbox[0] = nq;
        __syncthreads();
        const bool has_next = unxt < NU;
        AttU UN = att_decode(has_next ? (int)unxt : 0);
        if (has_next) { ATT_DMA(UN, UN.kcol, sK); asm volatile("" ::: "memory"); ATT_LOADQ(UN); }
        asm volatile("" ::: "memory");
        const float SC = 0.08838834764831845f * 1.4426950408889634f;
        float mx = -INFINITY;
#pragma unroll
        for (int n = 0; n < 5; ++n)
#pragma unroll
            for (int T = 0; T < 2; ++T)
#pragma unroll
                for (int i = 0; i < 4; ++i) { const int kj = 32 * (ks0 + n) + 8 * g + 4 * T + i; const bool ok = (kj >= qi) && (kj <= qi + 128) && (blk > 0 || kj >= 128);
                    const float v = ok ? st[n][T][i] : -INFINITY; st[n][T][i] = v; mx = fmaxf(mx, v); }
        mx = fmaxf(mx, swz_xor<16>(mx));
        { const auto rr = __builtin_amdgcn_permlane32_swap(__float_as_uint(mx), __float_as_uint(mx), false, false); mx = fmaxf(__uint_as_float(rr[0]), __uint_as_float(rr[1])); }
        float sum = 0.f; const float mxs = mx * SC;
#pragma unroll
        for (int n = 0; n < 5; ++n)
#pragma unroll
            for (int T = 0; T < 2; ++T)
#pragma unroll
                for (int i = 0; i < 4; ++i) { const float e = __builtin_amdgcn_exp2f(__builtin_fmaf(st[n][T][i], SC, -mxs)); st[n][T][i] = e; sum += e; }
        sum += swz_xor<16>(sum);
        { const auto rr = __builtin_amdgcn_permlane32_swap(__float_as_uint(sum), __float_as_uint(sum), false, false); sum = __uint_as_float(rr[0]) + __uint_as_float(rr[1]); }
        const float inv = rcpf_(sum);
        ATT_STAMP(7);
        f32x4 ot[8];
#pragma unroll
        for (int cc = 0; cc < 8; ++cc) ot[cc] = (f32x4){0.f, 0.f, 0.f, 0.f};
        const unsigned tq = (unsigned)qq >> 2, tp = (unsigned)qq & 3u;
        const unsigned vbase = (unsigned)(size_t)sV;
        unsigned va[2][8];
#pragma unroll
        for (int t = 0; t < 2; ++t)
#pragma unroll
            for (int cc = 0; cc < 8; ++cc) va[t][cc] = vbase + offb(32u * ks0 + 8u * g + 4u * t + tq, 2 * cc + (tp >> 1)) + 8u * (tp & 1u);
#pragma unroll
        for (int n = 0; n < 5; ++n) if (ks0 + n >= nskip) {
            u32x4 pw; pw.x = pk2(st[n][0][0], st[n][0][1]); pw.y = pk2(st[n][0][2], st[n][0][3]); pw.z = pk2(st[n][1][0], st[n][1][1]); pw.w = pk2(st[n][1][2], st[n][1][3]);
            const bf16x8 pf = __builtin_bit_cast(bf16x8, pw);
            u16x4 v0[8], v1[8];
            asm volatile("ds_read_b64_tr_b16 %0, %16 offset:%32\n\tds_read_b64_tr_b16 %8, %24 offset:%32\n\t"
                         "ds_read_b64_tr_b16 %1, %17 offset:%32\n\tds_read_b64_tr_b16 %9, %25 offset:%32\n\t"
                         "ds_read_b64_tr_b16 %2, %18 offset:%32\n\tds_read_b64_tr_b16 %10, %26 offset:%32\n\t"
                         "ds_read_b64_tr_b16 %3, %19 offset:%32\n\tds_read_b64_tr_b16 %11, %27 offset:%32\n\t"
                         "ds_read_b64_tr_b16 %4, %20 offset:%32\n\tds_read_b64_tr_b16 %12, %28 offset:%32\n\t"
                         "ds_read_b64_tr_b16 %5, %21 offset:%32\n\tds_read_b64_tr_b16 %13, %29 offset:%32\n\t"
                         "ds_read_b64_tr_b16 %6, %22 offset:%32\n\tds_read_b64_tr_b16 %14, %30 offset:%32\n\t"
                         "ds_read_b64_tr_b16 %7, %23 offset:%32\n\tds_read_b64_tr_b16 %15, %31 offset:%32\n\t"
                         "s_waitcnt lgkmcnt(0)"
                         : "=&v"(v0[0]), "=&v"(v0[1]), "=&v"(v0[2]), "=&v"(v0[3]), "=&v"(v0[4]), "=&v"(v0[5]), "=&v"(v0[6]), "=&v"(v0[7]),
                           "=&v"(v1[0]), "=&v"(v1[1]), "=&v"(v1[2]), "=&v"(v1[3]), "=&v"(v1[4]), "=&v"(v1[5]), "=&v"(v1[6]), "=&v"(v1[7])
                         : "v"(va[0][0]), "v"(va[0][1]), "v"(va[0][2]), "v"(va[0][3]), "v"(va[0][4]), "v"(va[0][5]), "v"(va[0][6]), "v"(va[0][7]),
                           "v"(va[1][0]), "v"(va[1][1]), "v"(va[1][2]), "v"(va[1][3]), "v"(va[1][4]), "v"(va[1][5]), "v"(va[1][6]), "v"(va[1][7]), "i"(8192 * n) : "memory");
#pragma unroll
            for (int cc = 0; cc < 8; ++cc) {
                bf16x8 vf; vf[0] = (short)v0[cc][0]; vf[1] = (short)v0[cc][1]; vf[2] = (short)v0[cc][2]; vf[3] = (short)v0[cc][3]; vf[4] = (short)v1[cc][0]; vf[5] = (short)v1[cc][1]; vf[6] = (short)v1[cc][2]; vf[7] = (short)v1[cc][3];
                ot[cc] = __builtin_amdgcn_mfma_f32_16x16x32_bf16(vf, pf, ot[cc], 0, 0, 0);
            }
        }
        __syncthreads();
        asm volatile("" ::: "memory");
        if (has_next) ATT_DMA(UN, UN.vcol, sV);
        asm volatile("" ::: "memory");
        bf16_t* orow = c.proj + qtok * NP + U.qcol;
#pragma unroll
        for (int cc = 0; cc < 8; ++cc) { u32x2 o; o.x = pk2(ot[cc][0] * inv, ot[cc][1] * inv); o.y = pk2(ot[cc][2] * inv, ot[cc][3] * inv); *(u32x2*)(orow + 16 * cc + 4 * g) = o; }
        if (g == 0) lse_buf[qtok * 12 + U.p * 4 + U.h] = mx * 0.08838834764831845f + __logf(sum);
        ATT_STAMP(8);
        if (!has_next) break;
        U = UN; unxt = mbox[0];
    }
    asm volatile("s_waitcnt vmcnt(0)" ::: "memory");
    __syncthreads();
}
#undef ATT_STAMP
#undef ATT_DMA
#undef ATT_LOADQ

__device__ __forceinline__ void phase_attn_combine(const Ctx& c, const float* lse_buf) {
    const int gw = c.bid * NWAVES + c.wave, NGW = c.G * NWAVES, lane = c.lane;
    constexpr int NR = 2;
    for (int tok0 = gw; tok0 < TC; tok0 += NR * NGW) {
        unsigned u[NR][3][4]; float l[NR][12];
#pragma unroll
        for (int r = 0; r < NR; ++r) { const int tok = tok0 + r * NGW;
            const float* ls = lse_buf + (size_t)tok * 12; const bf16_t* row = c.proj + (size_t)tok * NP + C_QKV;
#pragma unroll
            for (int k = 0; k < 12; ++k) l[r][k] = ls[k];
#pragma unroll
            for (int p = 0; p < 3; ++p)
#pragma unroll
                for (int h = 0; h < 4; ++h) u[r][p][h] = *((const unsigned*)(row + (4 * p + h) * 128) + lane); }
#pragma unroll
        for (int r = 0; r < NR; ++r) { const int tok = tok0 + r * NGW;
#pragma unroll
            for (int h = 0; h < 4; ++h) {
                const float l0 = l[r][h], l1 = l[r][4 + h], l2 = l[r][8 + h], ml = fmaxf(l0, fmaxf(l1, l2));
                const float w0 = __expf(l0 - ml), w1 = __expf(l1 - ml), w2 = __expf(l2 - ml), wi = rcpf_(w0 + w1 + w2);
                *((unsigned*)(c.proj + (size_t)tok * NP + C_QKV + h * 128) + lane) =
                    pk2((w0 * bflo(u[r][0][h]) + w1 * bflo(u[r][1][h]) + w2 * bflo(u[r][2][h])) * wi, (w0 * bfhi(u[r][0][h]) + w1 * bfhi(u[r][1][h]) + w2 * bfhi(u[r][2][h])) * wi);
            } }
    }
}

__device__ __forceinline__ int crow(int reg, int hh) { return (reg & 3) + 8 * (reg >> 2) + 4 * hh; }
typedef float f32x16 __attribute__((ext_vector_type(16)));
__device__ __forceinline__ unsigned tr_addr32(unsigned lane, unsigned rowbase, unsigned cblk, unsigned t, bool perm) {
    const unsigned hh = lane >> 5, blk = (lane >> 4) & 1u, q = (lane & 15u) >> 2, p = lane & 3u;
    const unsigned row = rowbase + (perm ? 8u * t + 4u * hh : 8u * hh + 4u * t) + q;
    return offb(row, 4u * cblk + 2u * blk + (p >> 1)) + 8u * (p & 1u);
}
__device__ __forceinline__ bf16x8 tr_frag(unsigned a0, unsigned a1) {
    u16x4 v0, v1;
    asm volatile("ds_read_b64_tr_b16 %0, %2\n\tds_read_b64_tr_b16 %1, %3\n\ts_waitcnt lgkmcnt(0)" : "=&v"(v0), "=&v"(v1) : "v"(a0), "v"(a1) : "memory");
    bf16x8 f; f[0] = (short)v0[0]; f[1] = (short)v0[1]; f[2] = (short)v0[2]; f[3] = (short)v0[3]; f[4] = (short)v1[0]; f[5] = (short)v1[1]; f[6] = (short)v1[2]; f[7] = (short)v1[3];
    return f;
}
__device__ __forceinline__ void tr_frag4(const unsigned (&a)[8], bf16x8 (&f)[4]) {
    u16x4 v[8];
    asm volatile("ds_read_b64_tr_b16 %0, %8\n\tds_read_b64_tr_b16 %1, %9\n\tds_read_b64_tr_b16 %2, %10\n\tds_read_b64_tr_b16 %3, %11\n\t"
                 "ds_read_b64_tr_b16 %4, %12\n\tds_read_b64_tr_b16 %5, %13\n\tds_read_b64_tr_b16 %6, %14\n\tds_read_b64_tr_b16 %7, %15\n\ts_waitcnt lgkmcnt(0)"
                 : "=&v"(v[0]), "=&v"(v[1]), "=&v"(v[2]), "=&v"(v[3]), "=&v"(v[4]), "=&v"(v[5]), "=&v"(v[6]), "=&v"(v[7])
                 : "v"(a[0]), "v"(a[1]), "v"(a[2]), "v"(a[3]), "v"(a[4]), "v"(a[5]), "v"(a[6]), "v"(a[7]) : "memory");
#pragma unroll
    for (int k = 0; k < 4; ++k) { f[k][0] = (short)v[2 * k][0]; f[k][1] = (short)v[2 * k][1]; f[k][2] = (short)v[2 * k][2]; f[k][3] = (short)v[2 * k][3];
        f[k][4] = (short)v[2 * k + 1][0]; f[k][5] = (short)v[2 * k + 1][1]; f[k][6] = (short)v[2 * k + 1][2]; f[k][7] = (short)v[2 * k + 1][3]; }
}
constexpr int GLA_QK = 0, GLA_KD = 16384, GLA_V = 32768  , GLA_ST = 65536  , GLA_O = 102400  , GLA_SEG = 136192  , GLA_DEC = 138240  ;
static_assert(GLA_DEC + 256 <= RING_BYTES, "gla lds");
__device__ __forceinline__ void gla_unit(const Ctx& c, int unit, const float* gbias, const float* ogain) {
    const int tid = c.tid, lane = c.lane, w = c.wave;
    const int b = unit >> 2, h = unit & 3;
    LAS unsigned char* L = c.lds;
    const unsigned hh = lane >> 5, r31 = lane & 31;
    const int ti = w >> 2, tv = w & 3;
    f32x16 St;
#pragma unroll
    for (int i = 0; i < 16; ++i) St[i] = 0.f;
    for (int i = tid; i < 18432 / 4; i += NTHR) ((LAS unsigned*)(L + GLA_ST))[i] = 0u;
    const float bias_d = gbias[h * 64 + lane];
    const int i3 = tid >> 3, seg = tid & 7;
    float gn[16];
#pragma unroll
    for (int k = 0; k < 16; ++k) gn[k] = ogain[16 * seg + k];
    const size_t tokb = (size_t)b * SEQ;
    unsigned short pq[8], pk[8], pg[8];
    u32x4 ogc0, ogc1, ogn0, ogn1;
#define GLA_PREFETCH(n) do { _Pragma("unroll") for (int rr = 0; rr < 8; ++rr) { const bf16_t* row = c.proj + (tokb + (n) * 64 + 8 * w + rr) * NP + h * 64 + lane; \
        pq[rr] = row[C_QA]; pk[rr] = row[C_KA]; pg[rr] = row[C_GP]; } } while (0)
#define GLA_OG(n, d0, d1) do { const bf16_t* ogp = c.proj + (tokb + (n) * 64 + i3) * NP + C_OG + h * 128 + 16 * seg; d0 = *(const u32x4*)ogp; d1 = *((const u32x4*)ogp + 1); } while (0)
#define GLA_VDMA(n) do { _Pragma("unroll") for (int it = 0; it < 2; ++it) { const int q = w + 8 * it; const unsigned nn = 64u * q + lane, row = nn >> 4, cs = nn & 15u, ch = cs ^ (((row & 3u) << 2) | ((row >> 2) & 3u)); \
        __builtin_amdgcn_global_load_lds((const unsigned*)(c.proj + (tokb + (n) * 64 + row) * NP + C_VA + h * 128 + ch * 8), (LAS unsigned*)(L + GLA_V + ((n) & 1) * 16384 + 1024 * q), 16, 0, 0); } } while (0)
#define CB() asm volatile("" ::: "memory")
    GLA_PREFETCH(0); CB(); GLA_OG(0, ogc0, ogc1); CB(); GLA_VDMA(0); CB(); GLA_VDMA(1); CB();
    for (int n = 0; n < SEQ / 64; ++n) {
        LAS unsigned char* STr = L + GLA_ST + (n & 1) * 18432; LAS unsigned char* STw = L + GLA_ST + ((n + 1) & 1) * 18432;
        LAS unsigned char* Vb = L + GLA_V + (n & 1) * 16384;
        float cl[8], qv[8], kv[8];
        { float run = 0.f;
#pragma unroll
          for (int rr = 0; rr < 8; ++rr) { const float g = bf2f(pg[rr]) + bias_d; run += (fminf(g, 0.f) - __logf(1.f + __expf(-fabsf(g)))) * (1.f / 16.f); cl[rr] = run; qv[rr] = bf2f(pq[rr]); kv[rr] = bf2f(pk[rr]); }
          ((LAS float*)(L + GLA_SEG))[w * 64 + lane] = run; }
        __syncthreads();
        { float pre = 0.f, tot = 0.f;
#pragma unroll
          for (int s = 0; s < 8; ++s) { const float v = ((LAS float*)(L + GLA_SEG))[s * 64 + lane]; tot += v; pre += (s < w) ? v : 0.f; }
          const float etot = __expf(tot);
          if (w == 0) ((LAS float*)(L + GLA_DEC))[lane] = etot;
#pragma unroll
          for (int rr = 0; rr < 8; ++rr) { const float cum = pre + cl[rr]; const unsigned row = 8 * w + rr;
              const float e = __expf(cum), ei = rcpf_(e), ed = etot * ei;
              const unsigned o1 = offb(row, lane >> 3) + (lane & 7) * 2, o2 = offb(row, 8 + (lane >> 3)) + (lane & 7) * 2;
              *(LAS unsigned short*)(L + GLA_QK + o1) = (unsigned short)f2bf(qv[rr] * e);
              *(LAS unsigned short*)(L + GLA_QK + o2) = (unsigned short)f2bf(kv[rr] * ei);
              *(LAS unsigned short*)(L + GLA_KD + o1) = (unsigned short)f2bf(kv[rr] * ed); } }
        if (n == 0) asm volatile("s_waitcnt vmcnt(2)" ::: "memory"); else asm volatile("s_waitcnt vmcnt(4)" ::: "memory");
        __syncthreads();
        CB();
        if (n + 1 < SEQ / 64) { GLA_OG(n + 1, ogn0, ogn1); CB(); GLA_PREFETCH(n + 1); }
        CB();
        bf16x8 qdf[4];
#pragma unroll
        for (int s = 0; s < 4; ++s) qdf[s] = *(const LAS bf16x8*)(L + GLA_QK + offb(32 * ti + r31, 2 * s + hh));
        f32x16 Z;
#pragma unroll
        for (int i = 0; i < 16; ++i) Z[i] = 0.f;
        { bf16x8 sf[4];
#pragma unroll
          for (int s = 0; s < 4; ++s) sf[s] = *(const LAS bf16x8*)(STr + (32 * tv + r31) * 144 + 32 * s + 16 * hh);
#pragma unroll
          for (int s = 0; s < 4; ++s) Z = __builtin_amdgcn_mfma_f32_32x32x16_bf16(qdf[s], sf[s], Z, 0, 0, 0); }
        const unsigned vb = (unsigned)(size_t)Vb;
#pragma unroll
        for (int tj = 0; tj < 2; ++tj) {
            if (tj <= ti) {
                bf16x8 kf[4];
#pragma unroll
                for (int s = 0; s < 4; ++s) kf[s] = *(const LAS bf16x8*)(L + GLA_QK + offb(32 * tj + r31, 8 + 2 * s + hh));
                unsigned va[8]; bf16x8 vf[4];
#pragma unroll
                for (int s = 0; s < 2; ++s) { va[2 * s] = vb + tr_addr32(lane, 32 * tj + 16 * s, tv, 0, true); va[2 * s + 1] = vb + tr_addr32(lane, 32 * tj + 16 * s, tv, 1, true);
                    va[4 + 2 * s] = va[2 * s]; va[5 + 2 * s] = va[2 * s + 1]; }
                tr_frag4(va, vf);
                f32x16 X;
#pragma unroll
                for (int i = 0; i < 16; ++i) X[i] = 0.f;
#pragma unroll
                for (int s = 0; s < 4; ++s) X = __builtin_amdgcn_mfma_f32_32x32x16_bf16(kf[s], qdf[s], X, 0, 0, 0);
                const int ig = 32 * ti + (int)r31;
#pragma unroll
                for (int i = 0; i < 16; ++i) X[i] = (ig >= 32 * tj + crow(i, hh)) ? X[i] : 0.f;
#pragma unroll
                for (int s = 0; s < 2; ++s) {
                    u32x4 pw; pw.x = pg8::cvt_pk_bf16(X[8 * s + 0], X[8 * s + 1]); pw.y = pg8::cvt_pk_bf16(X[8 * s + 2], X[8 * s + 3]); pw.z = pg8::cvt_pk_bf16(X[8 * s + 4], X[8 * s + 5]); pw.w = pg8::cvt_pk_bf16(X[8 * s + 6], X[8 * s + 7]);
                    Z = __builtin_amdgcn_mfma_f32_32x32x16_bf16(__builtin_bit_cast(bf16x8, pw), vf[s], Z, 0, 0, 0);
                }
            }
        }
#pragma unroll
        for (int i = 0; i < 16; ++i) ((LAS float*)(L + GLA_O))[(32 * ti + crow(i, hh)) * 132 + 32 * tv + r31] = Z[i];
        { const unsigned kb = (unsigned)(size_t)(L + GLA_KD);
          unsigned aa[8], ab[8]; bf16x8 af[4], bfr[4];
#pragma unroll
          for (int s = 0; s < 4; ++s) { aa[2 * s] = kb + tr_addr32(lane, 16 * s, ti, 0, false); aa[2 * s + 1] = kb + tr_addr32(lane, 16 * s, ti, 1, false);
              ab[2 * s] = vb + tr_addr32(lane, 16 * s, tv, 0, false); ab[2 * s + 1] = vb + tr_addr32(lane, 16 * s, tv, 1, false); }
          tr_frag4(aa, af); tr_frag4(ab, bfr);
#pragma unroll
          for (int i = 0; i < 16; ++i) St[i] *= ((LAS float*)(L + GLA_DEC))[32 * ti + crow(i, hh)];
#pragma unroll
          for (int s = 0; s < 4; ++s) St = __builtin_amdgcn_mfma_f32_32x32x16_bf16(af[s], bfr[s], St, 0, 0, 0); }
#pragma unroll
        for (int gq = 0; gq < 4; ++gq) { const float s0 = St[4 * gq], s1 = St[4 * gq + 1], s2 = St[4 * gq + 2], s3 = St[4 * gq + 3];
            u32x2 o; o.x = pk2(s0, s1); o.y = pk2(s2, s3);
            *(LAS u32x2*)(STw + (32 * tv + r31) * 144 + (32 * ti + 8 * gq + 4 * hh) * 2) = o; }
        __syncthreads();
        CB();
        if (n + 2 < SEQ / 64) GLA_VDMA(n + 2);
        CB();
        { const LAS f32x4* op = (const LAS f32x4*)(L + GLA_O + i3 * 528 + seg * 64);
          f32x4 o4[4]; float ss = 0.f;
#pragma unroll
          for (int k = 0; k < 4; ++k) { o4[k] = op[k]; ss += (o4[k].x * o4[k].x + o4[k].y * o4[k].y) + (o4[k].z * o4[k].z + o4[k].w * o4[k].w); }
          ss += swz_xor<1>(ss); ss += swz_xor<2>(ss); ss += swz_xor<4>(ss);
          const float rs = rsqf_(ss * (1.f / 128.f) + RMS_EPS);
          const unsigned ogw[8] = {ogc0.x, ogc0.y, ogc0.z, ogc0.w, ogc1.x, ogc1.y, ogc1.z, ogc1.w};
          unsigned ow[8];
#pragma unroll
          for (int k = 0; k < 8; ++k) { const float g0 = bflo(ogw[k]), g1 = bfhi(ogw[k]);
              const float a0 = o4[k >> 1][(2 * k) & 3] * rs * gn[2 * k] * g0 * sigmoidf_(g0), a1 = o4[k >> 1][(2 * k + 1) & 3] * rs * gn[2 * k + 1] * g1 * sigmoidf_(g1);
              ow[k] = pk2(a0, a1); }
          u32x4 w0, w1; w0.x = ow[0]; w0.y = ow[1]; w0.z = ow[2]; w0.w = ow[3]; w1.x = ow[4]; w1.y = ow[5]; w1.z = ow[6]; w1.w = ow[7];
          bf16_t* dst = c.proj + (tokb + n * 64 + i3) * NP + C_OG + h * 128 + 16 * seg;
          *(u32x4*)dst = w0; *((u32x4*)dst + 1) = w1; }
        CB();
        ogc0 = ogn0; ogc1 = ogn1;
    }
    asm volatile("s_waitcnt vmcnt(0)" ::: "memory");
    __syncthreads();
#undef GLA_PREFETCH
#undef GLA_OG
#undef GLA_VDMA
#undef CB
}

constexpr int LRU_X = 0  , LRU_R = 16384  , LRU_I = 32768, LRU_SP = 49152  , LRU_SH = 51200;
__device__ __forceinline__ void lru_unit(const Ctx& c, int unit, const float* convw, const float* convb, const float* wa_, const float* ba_, const float* wx_, const float* bx_, const float* lam_) {
    const int lane = c.lane, w = c.wave;
    const int b = unit >> 3, nb = unit & 7, ch = nb * 64 + lane;
    LAS unsigned char* L = c.lds;
    const unsigned hh = lane >> 5, r31 = lane & 31;
    const int gate = w >> 2, tt = (w >> 1) & 1, td = w & 1;
    bf16x8 wf[4];
    { const float* W = (gate ? wx_ : wa_) + (size_t)nb * 4096 + 32 * td + r31;
#pragma unroll
      for (int s = 0; s < 4; ++s) { float t8[8];
#pragma unroll
          for (int jj = 0; jj < 8; ++jj) t8[jj] = W[(16 * s + 8 * hh + jj) * 64];
          u32x4 pw; pw.x = pk2(t8[0], t8[1]); pw.y = pk2(t8[2], t8[3]); pw.z = pk2(t8[4], t8[5]); pw.w = pk2(t8[6], t8[7]); wf[s] = __builtin_bit_cast(bf16x8, pw); } }
    const float gbias = (gate ? bx_ : ba_)[nb * 64 + 32 * td + r31];
    const float cw0 = convw[ch], cw1 = convw[512 + ch], cw2 = convw[1024 + ch], cw3 = convw[1536 + ch], cb = convb[ch];
    const float lam = lam_[ch]; const float c8 = 8.f * (fmaxf(-lam, 0.f) + log1pf(__expf(-fabsf(lam))));
    const size_t tokb = (size_t)b * SEQ;
    unsigned short px[11], py[8];
#define LRU_PREFETCH(n) do { _Pragma("unroll") for (int rr = 0; rr < 11; ++rr) { const int t = (n) * 64 + 8 * w + rr - 3; px[rr] = t >= 0 ? c.proj[(tokb + t) * NP + C_XB + ch] : (unsigned short)0; } \
        _Pragma("unroll") for (int rr = 0; rr < 8; ++rr) py[rr] = c.proj[(tokb + (n) * 64 + 8 * w + rr) * NP + C_YB + ch]; } while (0)
    LRU_PREFETCH(0);
    float hcarry = 0.f;
    for (int n = 0; n < SEQ / 64; ++n) {
        float xc[8], yv[8];
        { float xr[11];
#pragma unroll
          for (int rr = 0; rr < 11; ++rr) xr[rr] = bf2f(px[rr]);
#pragma unroll
          for (int rr = 0; rr < 8; ++rr) { xc[rr] = cb + cw0 * xr[rr] + cw1 * xr[rr + 1] + cw2 * xr[rr + 2] + cw3 * xr[rr + 3]; yv[rr] = bf2f(py[rr]);
              *(LAS unsigned short*)(L + LRU_X + offb(8 * w + rr, lane >> 3) + (lane & 7) * 2) = (unsigned short)f2bf(xc[rr]); } }
        __syncthreads();
        if (n + 1 < SEQ / 64) LRU_PREFETCH(n + 1);
        { f32x16 Z;
#pragma unroll
          for (int i = 0; i < 16; ++i) Z[i] = 0.f;
#pragma unroll
          for (int s = 0; s < 4; ++s) { const bf16x8 af = *(const LAS bf16x8*)(L + LRU_X + offb(32 * tt + r31, 2 * s + hh)); Z = __builtin_amdgcn_mfma_f32_32x32x16_bf16(af, wf[s], Z, 0, 0, 0); }
          LAS float* dst = (LAS float*)(L + (gate ? LRU_I : LRU_R));
#pragma unroll
          for (int i = 0; i < 16; ++i) dst[(32 * tt + crow(i, hh)) * 64 + 32 * td + r31] = sigmoidf_(Z[i] + gbias); }
        __syncthreads();
        float hl[8], pc[8];
        { float hrun = 0.f, prun = 1.f;
#pragma unroll
          for (int rr = 0; rr < 8; ++rr) { const float r = ((const LAS float*)(L + LRU_R))[(8 * w + rr) * 64 + lane], ig = ((const LAS float*)(L + LRU_I))[(8 * w + rr) * 64 + lane];
              const float a = __expf(-c8 * r), u = sqrtf(fmaxf(1.f - a * a, 0.f)) * ig * xc[rr];
              hrun = a * hrun + u; prun *= a; hl[rr] = hrun; pc[rr] = prun; }
          ((LAS float*)(L + LRU_SP))[w * 64 + lane] = prun; ((LAS float*)(L + LRU_SH))[w * 64 + lane] = hrun; }
        __syncthreads();
        { float hin = hcarry, hall = hcarry;
#pragma unroll
          for (int s = 0; s < 8; ++s) { const float P = ((const LAS float*)(L + LRU_SP))[s * 64 + lane], H = ((const LAS float*)(L + LRU_SH))[s * 64 + lane];
              hall = P * hall + H; hin = (s < w) ? hall : hin; }
          hcarry = hall;
#pragma unroll
          for (int rr = 0; rr < 8; ++rr) { const float hv = hl[rr] + pc[rr] * hin;
              c.proj[(tokb + n * 64 + 8 * w + rr) * NP + C_YB + ch] = (bf16_t)f2bf(hv * gelu_tanh(yv[rr])); } }
    }
    __syncthreads();
#undef LRU_PREFETCH
}

constexpr int TPB = TT / 256;
constexpr int RW_STRIDE = 1032;
__device__ __forceinline__ void phase_router(const Ctx& c, const float* gain, const float* rw, const float* rb, unsigned* gcnt) {
    LAS bf16_t* sWh = (LAS bf16_t*)c.lds;
    LAS bf16_t* sWl = sWh + 16 * RW_STRIDE;
    LAS float* sGn = (LAS float*)(c.lds + 69632);
    LAS unsigned* sRec = (LAS unsigned*)(c.lds + 73728);
    LAS unsigned* sCnt = (LAS unsigned*)(c.lds + MISC_OFF + 256);
    LAS unsigned* sBase = sCnt + 16;
    const int tid = c.tid, lane = c.lane, w = c.wave;
    for (int idx = tid; idx < D * NE; idx += NTHR) { const int e = idx >> 10, k = idx & 1023; const float v = rw[k * 16 + e] * gain[k];
        const unsigned hi = f2bf(v); const float lo = v - bflo(hi); sWh[e * RW_STRIDE + k] = (bf16_t)hi; sWl[e * RW_STRIDE + k] = (bf16_t)f2bf(lo); }
    for (int idx = tid; idx < D; idx += NTHR) sGn[idx] = gain[idx];
    if (tid < 16) sCnt[tid] = 0u;
    __syncthreads();
    const int t = lane & 15, g = lane >> 4;
#pragma unroll 1
    for (int sub = 0; sub < TPB / 128; ++sub) {
    const int lt = sub * 128 + w * 16 + t, tok = c.bid * TPB + lt;
    const float* xrow = c.xof + (size_t)tok * D + 8 * g;
    f32x4 acc = {0.f, 0.f, 0.f, 0.f}; float ss = 0.f;
    f32x4 xn[8];
#pragma unroll
    for (int j = 0; j < 4; ++j) { xn[2 * j] = *(const f32x4*)(xrow + 32 * j); xn[2 * j + 1] = *(const f32x4*)(xrow + 32 * j + 4); }
#pragma unroll 1
    for (int s4 = 0; s4 < 8; ++s4) {
        f32x4 xc[8];
#pragma unroll
        for (int j = 0; j < 8; ++j) xc[j] = xn[j];
        if (s4 + 1 < 8) {
#pragma unroll
            for (int j = 0; j < 4; ++j) { xn[2 * j] = *(const f32x4*)(xrow + 32 * (4 * s4 + 4 + j)); xn[2 * j + 1] = *(const f32x4*)(xrow + 32 * (4 * s4 + 4 + j) + 4); } }
#pragma unroll
        for (int j = 0; j < 4; ++j) { const int s = 4 * s4 + j;
            const f32x4 x0 = xc[2 * j], x1 = xc[2 * j + 1];
            const float xv[8] = {x0.x, x0.y, x0.z, x0.w, x1.x, x1.y, x1.z, x1.w};
            unsigned hw[4], lw[4];
#pragma unroll
            for (int k = 0; k < 4; ++k) { const float a = xv[2 * k], b = xv[2 * k + 1]; ss += a * a + b * b; const unsigned h2 = pk2(a, b); hw[k] = h2; lw[k] = pk2(a - bflo(h2), b - bfhi(h2)); }
            u32x4 bhv, blv; bhv.x = hw[0]; bhv.y = hw[1]; bhv.z = hw[2]; bhv.w = hw[3]; blv.x = lw[0]; blv.y = lw[1]; blv.z = lw[2]; blv.w = lw[3];
            const bf16x8 bh = __builtin_bit_cast(bf16x8, bhv), bl = __builtin_bit_cast(bf16x8, blv);
            const bf16x8 ah = *(const LAS bf16x8*)(sWh + t * RW_STRIDE + 32 * s + 8 * g), al = *(const LAS bf16x8*)(sWl + t * RW_STRIDE + 32 * s + 8 * g);
            acc = __builtin_amdgcn_mfma_f32_16x16x32_bf16(ah, bh, acc, 0, 0, 0);
            acc = __builtin_amdgcn_mfma_f32_16x16x32_bf16(al, bh, acc, 0, 0, 0);
            acc = __builtin_amdgcn_mfma_f32_16x16x32_bf16(ah, bl, acc, 0, 0, 0); }
    }
    ss += swz_xor<16>(ss);
    { const auto r = __builtin_amdgcn_permlane32_swap(__float_as_uint(ss), __float_as_uint(ss), false, false); ss = __uint_as_float(r[0]) + __uint_as_float(r[1]); }
    const float rs = rsqf_(ss * (1.f / D) + RMS_EPS);
    float sc[4]; float mx = -INFINITY;
#pragma unroll
    for (int i = 0; i < 4; ++i) { sc[i] = acc[i] * rs + rb[4 * g + i]; mx = fmaxf(mx, sc[i]); }
    mx = fmaxf(mx, swz_xor<16>(mx));
    { const auto r = __builtin_amdgcn_permlane32_swap(__float_as_uint(mx), __float_as_uint(mx), false, false); mx = fmaxf(__uint_as_float(r[0]), __uint_as_float(r[1])); }
    float sum = 0.f;
#pragma unroll
    for (int i = 0; i < 4; ++i) { sc[i] = __expf(sc[i] - mx); sum += sc[i]; }
    sum += swz_xor<16>(sum);
    { const auto r = __builtin_amdgcn_permlane32_swap(__float_as_uint(sum), __float_as_uint(sum), false, false); sum = __uint_as_float(r[0]) + __uint_as_float(r[1]); }
    const float isum = rcpf_(sum);
#pragma unroll
    for (int i = 0; i < 4; ++i) sc[i] *= isum;
    float gs;
    { const float hi1 = fmaxf(sc[0], sc[1]), lo1 = fminf(sc[0], sc[1]), hi2 = fmaxf(sc[2], sc[3]), lo2 = fminf(sc[2], sc[3]);
      gs = fmaxf(hi1, hi2) + fmaxf(fminf(hi1, hi2), fmaxf(lo1, lo2)); }
    const float g1 = swz_xor<16>(gs);
    float g2, g3;
    { const auto r = __builtin_amdgcn_permlane32_swap(__float_as_uint(gs), __float_as_uint(gs), false, false); g2 = (g & 2) ? __uint_as_float(r[0]) : __uint_as_float(r[1]); }
    { const auto r = __builtin_amdgcn_permlane32_swap(__float_as_uint(g1), __float_as_uint(g1), false, false); g3 = (g & 2) ? __uint_as_float(r[0]) : __uint_as_float(r[1]); }
    const bool win = ((gs > g1) || (gs == g1 && g < (g ^ 1))) && ((gs > g2) || (gs == g2 && g < (g ^ 2))) && ((gs > g3) || (gs == g3 && g < (g ^ 3)));
    if (win) {
        int i0 = 0; float b0 = sc[0];
#pragma unroll
        for (int k = 1; k < 4; ++k) if (sc[k] > b0) { b0 = sc[k]; i0 = k; }
        int i1 = -1; float b1 = -1.f;
#pragma unroll
        for (int k = 0; k < 4; ++k) if (k != i0 && sc[k] > b1) { b1 = sc[k]; i1 = k; }
        const int e0 = 4 * g + i0, e1 = 4 * g + i1; const float wn = rcpf_(b0 + b1);
        const unsigned l0 = atomicAdd((unsigned*)&sCnt[e0], 1u), l1 = atomicAdd((unsigned*)&sCnt[e1], 1u);
        sRec[lt * 6 + 0] = (unsigned)e0; sRec[lt * 6 + 1] = l0; sRec[lt * 6 + 2] = (unsigned)e1; sRec[lt * 6 + 3] = l1; sRec[lt * 6 + 4] = __float_as_uint(b0 * wn); sRec[lt * 6 + 5] = __float_as_uint(b1 * wn);
    }
    { bf16_t* hrow = c.actf + (size_t)tok * D + 8 * g;
#pragma unroll 1
      for (int s4 = 0; s4 < 8; ++s4) { f32x4 xx[8];
#pragma unroll
          for (int j = 0; j < 4; ++j) { xx[2 * j] = *(const f32x4*)(xrow + 32 * (4 * s4 + j)); xx[2 * j + 1] = *(const f32x4*)(xrow + 32 * (4 * s4 + j) + 4); }
#pragma unroll
          for (int j = 0; j < 4; ++j) { const int s = 4 * s4 + j; const f32x4 x0 = xx[2 * j], x1 = xx[2 * j + 1];
              const f32x4 q0 = *(const LAS f32x4*)(sGn + 32 * s + 8 * g), q1 = *(const LAS f32x4*)(sGn + 32 * s + 8 * g + 4);
              u32x4 o; o.x = pk2(x0.x * rs * q0.x, x0.y * rs * q0.y); o.y = pk2(x0.z * rs * q0.z, x0.w * rs * q0.w); o.z = pk2(x1.x * rs * q1.x, x1.y * rs * q1.y); o.w = pk2(x1.z * rs * q1.z, x1.w * rs * q1.w);
              *(u32x4*)(hrow + 32 * s) = o; } } }
    }
    __syncthreads();
    if (tid < 16) sBase[tid] = __hip_atomic_fetch_add(gcnt + tid, sCnt[tid], __ATOMIC_RELAXED, __HIP_MEMORY_SCOPE_AGENT);
    __syncthreads();
    if (tid < TPB) { const int tk = c.bid * TPB + tid; const unsigned e0 = sRec[tid * 6], e1 = sRec[tid * 6 + 2];
        const unsigned p0 = sBase[e0] + sRec[tid * 6 + 1], p1 = sBase[e1] + sRec[tid * 6 + 3];
        u32x4 r; r.x = (e0 << 20) | p0; r.y = (e1 << 20) | p1; r.z = sRec[tid * 6 + 4]; r.w = sRec[tid * 6 + 5];
        *(u32x4*)(c.rec + (size_t)tk * 4) = r;
        c.list[(size_t)e0 * TT + p0] = tk; c.list[(size_t)e1 * TT + p1] = tk; }
}

struct PlainOrder {
    int nM, nN, G, c; const char* A; const char* Bt; size_t a_tile, b_tile; int r0, r1;
    __device__ __forceinline__ bool next(int i, pg8::Unit& u) const { u.g = 0; if (r0 + i >= r1) return false; return pg8::static_tile(nM, nN, G, c, r0 + i, u.pm, u.pn); }
    __device__ __forceinline__ const char* aptr(const pg8::Unit& u) const { return A + (size_t)u.pm * a_tile; }
    __device__ __forceinline__ const char* bptr(const pg8::Unit& u) const { return Bt + (size_t)u.pn * b_tile; }
    __device__ __forceinline__ unsigned arow(const pg8::Unit&, int) const { return 0u; }
};
struct MergeOrder {
    int G, c; const char* proj; const char* wbr;
    __device__ __forceinline__ bool next(int i, pg8::Unit& u) const { u.g = i % 3; return pg8::static_tile(TC / 256, 4, G, c, i / 3, u.pm, u.pn); }
    __device__ __forceinline__ const char* aptr(const pg8::Unit& u) const { const int col = u.g == 0 ? C_OG : (u.g == 1 ? C_YB : C_QKV); return proj + ((size_t)u.pm * 256 * NP + col) * 2; }
    __device__ __forceinline__ const char* bptr(const pg8::Unit& u) const { return wbr + ((size_t)u.g * D * 512 + (size_t)u.pn * 256 * 512) * 2; }
    __device__ __forceinline__ unsigned arow(const pg8::Unit&, int) const { return 0u; }
};
template <bool UP> struct MoeOrder {
    int G, c; LAS const int* pt; LAS const int* lc; const char* A; const char* W; const int* list;
    __device__ __forceinline__ bool next(int i, pg8::Unit& u) const { const int L = i * G + c, tau = L >> 2; if (tau >= pt[NE]) return false;
        int e = 0;
#pragma unroll
        for (int k = 1; k < NE; ++k) e += (tau >= pt[k]) ? 1 : 0;
        u.pm = tau; u.pn = L & 3; u.g = e; return true; }
    __device__ __forceinline__ const char* aptr(const pg8::Unit& u) const { return UP ? A : A + (size_t)u.pm * 256 * FF * 2; }
    __device__ __forceinline__ const char* bptr(const pg8::Unit& u) const { return UP ? W + ((size_t)u.g * 1024 * D + (size_t)u.pn * 256 * D) * 2 : W + ((size_t)u.g * D * FF + (size_t)u.pn * 256 * FF) * 2; }
    __device__ __forceinline__ unsigned arow(const pg8::Unit& u, int r) const { int p = (u.pm - pt[u.g]) * 256 + r; const int n = lc[u.g]; p = p < n ? p : n - 1;
        return (unsigned)list[(size_t)u.g * TT + p] * (unsigned)(D * 2); }
};

struct EpiStoreBf16 {
    static constexpr bool PERM = true;
    bf16_t* O; int ldc;
    __device__ __forceinline__ void operator()(const f32x4 (&acc)[2][2][4][2], const pg8::Unit& u, int wr, int wc, int fr, int fq) const {
        const int row0 = u.pm * 256 + wr * 64 + fr, col0 = u.pn * 256 + wc * 32 + 8 * fq;
#pragma unroll
        for (int ai = 0; ai < 2; ++ai)
#pragma unroll
            for (int m = 0; m < 4; ++m) { bf16_t* rowp = O + (size_t)(row0 + ai * 128 + m * 16) * ldc + col0;
#pragma unroll
                for (int bj = 0; bj < 2; ++bj) { const f32x4 v0 = acc[ai][bj][m][0], v1 = acc[ai][bj][m][1];
                    u32x4 w; w.x = pg8::cvt_pk_bf16(v0[0], v0[1]); w.y = pg8::cvt_pk_bf16(v0[2], v0[3]); w.z = pg8::cvt_pk_bf16(v1[0], v1[1]); w.w = pg8::cvt_pk_bf16(v1[2], v1[3]);
                    *(u32x4*)(rowp + bj * 128) = w; } }
    }
};
struct EpiMerge {
    static constexpr bool PERM = true;
    const bf16_t* proj; bf16_t* mg;
    __device__ __forceinline__ void operator()(const f32x4 (&acc)[2][2][4][2], const pg8::Unit& u, int wr, int wc, int fr, int fq) const {
        const int row0 = u.pm * 256 + wr * 64 + fr, col0 = u.pn * 256 + wc * 32 + 8 * fq;
#pragma unroll
        for (int ai = 0; ai < 2; ++ai) {
            u32x4 gv[4][2], pv[4][2];
#pragma unroll
            for (int m = 0; m < 4; ++m)
#pragma unroll
                for (int bj = 0; bj < 2; ++bj) { const size_t row = (size_t)(row0 + ai * 128 + m * 16); const int col = col0 + bj * 128;
                    gv[m][bj] = *(const u32x4*)(proj + row * NP + C_G + u.g * D + col);
                    if (u.g > 0) pv[m][bj] = *(const u32x4*)(mg + row * D + col); else pv[m][bj] = (u32x4){0u, 0u, 0u, 0u}; }
            asm volatile("" ::: "memory");
#pragma unroll
            for (int m = 0; m < 4; ++m)
#pragma unroll
                for (int bj = 0; bj < 2; ++bj) { const size_t row = (size_t)(row0 + ai * 128 + m * 16); const int col = col0 + bj * 128;
                    const u32x4 g = gv[m][bj], p = pv[m][bj];
                    const f32x4 v0 = acc[ai][bj][m][0], v1 = acc[ai][bj][m][1];
                    float r[8];
                    r[0] = v0[0] * sigmoidf_(bflo(g.x)) + bflo(p.x); r[1] = v0[1] * sigmoidf_(bfhi(g.x)) + bfhi(p.x); r[2] = v0[2] * sigmoidf_(bflo(g.y)) + bflo(p.y); r[3] = v0[3] * sigmoidf_(bfhi(g.y)) + bfhi(p.y);
                    r[4] = v1[0] * sigmoidf_(bflo(g.z)) + bflo(p.z); r[5] = v1[1] * sigmoidf_(bfhi(g.z)) + bfhi(p.z); r[6] = v1[2] * sigmoidf_(bflo(g.w)) + bflo(p.w); r[7] = v1[3] * sigmoidf_(bfhi(g.w)) + bfhi(p.w);
                    u32x4 w; w.x = pk2(r[0], r[1]); w.y = pk2(r[2], r[3]); w.z = pk2(r[4], r[5]); w.w = pk2(r[6], r[7]);
                    *(u32x4*)(mg + row * D + col) = w; }
        }
    }
};
struct EpiResid {
    static constexpr bool PERM = false;
    const float* base; float* out;
    __device__ __forceinline__ void operator()(const f32x4 (&acc)[2][2][4][2], const pg8::Unit& u, int wr, int wc, int fr, int fq) const {
        const int row0 = u.pm * 256 + wr * 64 + fr, col0 = u.pn * 256 + wc * 32 + 4 * fq;
#pragma unroll
        for (int ai = 0; ai < 2; ++ai) {
            f32x4 bv[4][2][2];
#pragma unroll
            for (int m = 0; m < 4; ++m) { const size_t off = (size_t)(row0 + ai * 128 + m * 16) * D + col0;
#pragma unroll
                for (int bj = 0; bj < 2; ++bj)
#pragma unroll
                    for (int n = 0; n < 2; ++n) bv[m][bj][n] = *(const f32x4*)(base + off + bj * 128 + n * 16); }
            asm volatile("" ::: "memory");
#pragma unroll
            for (int m = 0; m < 4; ++m) { const size_t off = (size_t)(row0 + ai * 128 + m * 16) * D + col0;
#pragma unroll
                for (int bj = 0; bj < 2; ++bj)
#pragma unroll
                    for (int n = 0; n < 2; ++n) *(f32x4*)(out + off + bj * 128 + n * 16) = bv[m][bj][n] + acc[ai][bj][m][n]; }
        }
    }
};
struct EpiSwiGLU {
    static constexpr bool PERM = false;
    bf16_t* hid;
    __device__ __forceinline__ void operator()(const f32x4 (&acc)[2][2][4][2], const pg8::Unit& u, int wr, int wc, int fr, int fq) const {
        const int row0 = u.pm * 256 + wr * 64 + fr, col0 = u.pn * 128 + wc * 16 + 4 * fq;
#pragma unroll
        for (int ai = 0; ai < 2; ++ai)
#pragma unroll
            for (int m = 0; m < 4; ++m) { bf16_t* rowp = hid + (size_t)(row0 + ai * 128 + m * 16) * FF + col0;
#pragma unroll
                for (int bj = 0; bj < 2; ++bj) { const f32x4 g = acc[ai][bj][m][0], up = acc[ai][bj][m][1];
                    u32x2 w; w.x = pg8::cvt_pk_bf16(g[0] * sigmoidf_(g[0]) * up[0], g[1] * sigmoidf_(g[1]) * up[1]); w.y = pg8::cvt_pk_bf16(g[2] * sigmoidf_(g[2]) * up[2], g[3] * sigmoidf_(g[3]) * up[3]);
                    *(u32x2*)(rowp + bj * 64) = w; } }
    }
};

constexpr int PH_PER_LAYER = 1 + NCH * 5 + 3, PH_TOTAL = 1 + DEPTH * PH_PER_LAYER + 1;
#ifndef MK_LAUNCH_PER_PHASE
#define MK_LAUNCH_PER_PHASE 0
#endif
#ifndef PHMASK
#define PHMASK 0xFFFF
#endif
#ifndef MIXM
#define MIXM 7
#endif
#define EN(j) (((PHMASK) >> (j)) & 1)
typedef const __attribute__((address_space(4))) char* kptr_t;
__device__ __forceinline__ const void* karg_ptr(kptr_t kp, int i) { return *(const void* const __attribute__((address_space(4)))*)(kp + 8 * i); }
__device__ __forceinline__ void make_ctx(Ctx& c, kptr_t& kp, int layer, int chunk, int wave_s) {
    int t = wave_s * 64 + (int)__builtin_amdgcn_mbcnt_hi(~0u, __builtin_amdgcn_mbcnt_lo(~0u, 0u)); asm volatile("" : "+v"(t));
    kp = (kptr_t)__builtin_amdgcn_kernarg_segment_ptr(); asm volatile("" : "+s"(kp));
    c.tid = t; c.lane = t & 63; c.wave = __builtin_amdgcn_readfirstlane(t >> 6); c.bid = blockIdx.x; c.G = gridDim.x;
    unsigned char* ws = (unsigned char*)karg_ptr(kp, 25); float* out = (float*)karg_ptr(kp, 24);
    c.ctl = (unsigned*)(ws + WS_CTL);
    c.actf = (bf16_t*)(ws + WS_ACT); c.act = c.actf + (size_t)chunk * TC * D; c.proj = (bf16_t*)(ws + WS_PROJ); c.hid = (bf16_t*)(ws + WS_HID); c.ys = (bf16_t*)(ws + WS_YS);
    c.rec = (unsigned*)(ws + WS_REC); c.list = (int*)(ws + WS_LIST);
    c.chunk = chunk; c.layer = layer; c.pass = layer * NCH + chunk;
    c.xinf = (const float*)karg_ptr(kp, 0); c.xof = out;
    c.x_in = c.xinf + (size_t)chunk * TC * D; c.xo = out + (size_t)chunk * TC * D;
    c.pos = (const int*)karg_ptr(kp, 1) + (size_t)chunk * TC;
    c.lw = ws + WS_W + (size_t)layer * LW_SIZE;
}
#define INP(i) ((const float*)karg_ptr(kp, (i)))
__global__ void __launch_bounds__(NTHR, 2) fwd(Args args) {
    extern __shared__ __attribute__((aligned(16))) unsigned char lds_raw[];
    Ctx c; kptr_t kp;
    c.lds = (LAS unsigned char*)lds_raw;
    const int wave_s = __builtin_amdgcn_readfirstlane((int)threadIdx.x >> 6);
    make_ctx(c, kp, 0, 0, wave_s);
    volatile LAS unsigned* MISC = (volatile LAS unsigned*)(c.lds + MISC_OFF);
    LAS int* sPT = (LAS int*)(c.lds + MISC_OFF + 64);
    LAS int* sLC = (LAS int*)(c.lds + MISC_OFF + 160);
    for (int u = c.tid; u < 1024; u += NTHR) MISC[u] = 0u;
    __syncthreads();
    XcdBarrier bar; bar.bar = c.ctl + CW_BAR; bar.x = 0; bar.st = nullptr;
    if (!MK_LAUNCH_PER_PHASE) bar = xcd_barrier_post(c.ctl + CW_BAR, MISC, c.tid);
    const int lo = args.ph_lo, hi = args.ph_hi;
#define IN(k) (lo <= (k) && (k) < hi)
#ifndef PROBE_MASK
#define PROBE_MASK 0
#endif
#ifndef PROBE_CLK_CLS
#define PROBE_CLK_CLS 2
#endif
#ifndef PROBE_BLOCK
#define PROBE_BLOCK 0
#endif
#ifndef PROBE_K
#define PROBE_K 4
#endif
    unsigned long long t_prev = 0, c_prev = 0; LAS unsigned* sAcc = (LAS unsigned*)(c.lds + MISC_OFF + 512);
    if (PROBE_MASK) { t_prev = __builtin_amdgcn_s_memrealtime(); c_prev = (unsigned long long)clock64(); }
#define STAMP(cls) do { if (PROBE_MASK) { const unsigned long long _n = __builtin_amdgcn_s_memrealtime(); const unsigned long long _ck = (unsigned long long)clock64(); if (blockIdx.x == PROBE_BLOCK && c.tid == 0) { sAcc[(cls)] += (unsigned)(_n - t_prev); if ((cls) == PROBE_CLK_CLS) sAcc[15] += (unsigned)((_ck - c_prev) >> 4); } t_prev = _n; c_prev = _ck; } } while (0)
#ifndef PROBE_GEMM_CLS
#define PROBE_GEMM_CLS -1
#endif
#define GEMM_FLAG(cls) do { if (PROBE_MASK) { if (c.tid == 0) MISC[6] = ((cls) == PROBE_GEMM_CLS) ? 1u : 0u; __syncthreads(); } } while (0)
#define SEAM(k) do { if (IN(k) && IN((k) + 1)) { XcdBarrier _b = bar; kptr_t _k = (kptr_t)__builtin_amdgcn_kernarg_segment_ptr(); asm volatile("" : "+s"(_k)); _b.bar = (unsigned*)((unsigned char*)karg_ptr(_k, 25) + WS_CTL) + CW_BAR; { int _t = wave_s * 64 + (int)__builtin_amdgcn_mbcnt_hi(~0u, __builtin_amdgcn_mbcnt_lo(~0u, 0u)); xcd_barrier(_b, _t); } } } while (0)

    if (EN(0) && IN(0)) { Args a2;
#pragma unroll
        for (int i = 0; i < 24; ++i) a2.in[i] = karg_ptr(kp, i);
        a2.ws = (unsigned char*)karg_ptr(kp, 25); a2.out = nullptr; a2.ph_lo = 0; a2.ph_hi = 0;
        phase_prep(a2, c.lds, c.bid * NWAVES + c.wave, c.G * NWAVES, c.wave, c.lane, c.bid * NTHR + c.tid, c.G * NTHR);
        phase_rope_table((const int*)karg_ptr(kp, 1), (float*)(c.ctl) + (WS_BRC + 4 * MiB) / 4, c.bid * NTHR + c.tid, c.G * NTHR); }
    SEAM(0); STAMP(0);

    for (int layer = 0; layer < DEPTH; ++layer) {
        const int pl = 1 + layer * PH_PER_LAYER;
        if (EN(1) && IN(pl)) { make_ctx(c, kp, layer, 0, wave_s);
            const float* g1 = INP(2) + layer * D;
            if (layer == 0) phase_norm1<false, true, false>(c, g1, sPT);
            else { moe_tables(c.ctl + CW_CNT + 64 * (layer - 1), sPT, sLC, c.tid); phase_norm1<true, true, true>(c, g1, sPT); }
        }
        SEAM(pl); STAMP(1);
        for (int chunk = 0; chunk < NCH; ++chunk) {
            const int pb = pl + 1 + chunk * 5;
            if (EN(2) && IN(pb + 0)) { make_ctx(c, kp, layer, chunk, wave_s);
                EpiStoreBf16 E{c.proj, NP};
                GEMM_FLAG(2);
                PlainOrder S{TC / 256, NP / 256, c.G, c.bid, (const char*)c.act, (const char*)(c.lw + LW_WIN), (size_t)256 * D * 2, (size_t)256 * D * 2, 0, 1 << 20};
                pg8::gemm_phase<EpiStoreBf16, PlainOrder, false>(c.lds, S, E, D, D, c.tid);
            }
            SEAM(pb + 0); STAMP(2);
            if (EN(4) && IN(pb + 1)) { make_ctx(c, kp, layer, chunk, wave_s);
                float* lse = (float*)(c.ctl) + (WS_BRC / 4);
                if ((MIXM & 1) && c.bid < 4 * BC) gla_unit(c, c.bid, INP(5) + layer * 256, INP(6) + layer * 128);
                else if ((MIXM & 2) && c.bid < 12 * BC) lru_unit(c, c.bid - 4 * BC, INP(7) + layer * 4 * 512, INP(8) + layer * 512, INP(9) + layer * 8 * 64 * 64,
                                                    INP(10) + layer * 512, INP(11) + layer * 8 * 64 * 64, INP(12) + layer * 512, INP(13) + layer * 512);
                STAMP(12);
                unsigned* qh = c.ctl + CW_Q + 64 * c.pass;
                if (MIXM & 4) attn_loop(c, qh, MISC + 4, lse, INP(14) + layer * 128, INP(15) + layer * 128, (const float*)(c.ctl) + (WS_BRC + 4 * MiB) / 4 + (size_t)chunk * TC * 32);
            }
            SEAM(pb + 1); STAMP(4);
            if (EN(11) && IN(pb + 2)) { make_ctx(c, kp, layer, chunk, wave_s); phase_attn_combine(c, (const float*)(c.ctl) + (WS_BRC / 4)); }
            SEAM(pb + 2); STAMP(11);
            if (EN(5) && IN(pb + 3)) { make_ctx(c, kp, layer, chunk, wave_s);
                MergeOrder S{c.G, c.bid, (const char*)c.proj, (const char*)(c.lw + LW_WBR)};
                EpiMerge E{c.proj, c.act};
                GEMM_FLAG(5);
                pg8::gemm_phase<EpiMerge, MergeOrder, false>(c.lds, S, E, 512, NP, c.tid);
            }
            SEAM(pb + 3); STAMP(5);
            if (EN(6) && IN(pb + 4)) { make_ctx(c, kp, layer, chunk, wave_s);
                PlainOrder S{TC / 256, D / 256, c.G, c.bid, (const char*)c.act, (const char*)(c.lw + LW_WOUT), (size_t)256 * D * 2, (size_t)256 * D * 2, 0, 1 << 20};
                EpiResid E{layer == 0 ? c.x_in : (const float*)c.xo, c.xo};
                GEMM_FLAG(6);
                pg8::gemm_phase<EpiResid, PlainOrder, false>(c.lds, S, E, D, D, c.tid);
            }
            SEAM(pb + 4); STAMP(6);
        }
        const int pm = pl + 1 + NCH * 5;
        if (EN(7) && IN(pm + 0)) { make_ctx(c, kp, layer, 0, wave_s); phase_router(c, INP(18) + layer * D, INP(19), INP(20), c.ctl + CW_CNT + 64 * layer); }
        SEAM(pm + 0); STAMP(7);
        if (EN(8) && IN(pm + 1)) { make_ctx(c, kp, layer, 0, wave_s);
            moe_tables(c.ctl + CW_CNT + 64 * layer, sPT, sLC, c.tid);
            MoeOrder<true> S{c.G, c.bid, sPT, sLC, (const char*)c.actf, (const char*)(c.lw + LW_WGU), c.list};
            EpiSwiGLU E{c.hid};
            GEMM_FLAG(8);
            pg8::gemm_phase<EpiSwiGLU, MoeOrder<true>, true>(c.lds, S, E, D, D, c.tid);
        }
        SEAM(pm + 1); STAMP(8);
        if (EN(9) && IN(pm + 2)) { make_ctx(c, kp, layer, 0, wave_s);
            moe_tables(c.ctl + CW_CNT + 64 * layer, sPT, sLC, c.tid);
            MoeOrder<false> S{c.G, c.bid, sPT, sLC, (const char*)c.hid, (const char*)(c.lw + LW_WDN), c.list};
            EpiStoreBf16 E{c.ys, D};
            GEMM_FLAG(9);
            pg8::gemm_phase<EpiStoreBf16, MoeOrder<false>, false>(c.lds, S, E, FF, FF, c.tid);
        }
        SEAM(pm + 2); STAMP(9);
    }
    if (EN(10) && IN(PH_TOTAL - 1)) { make_ctx(c, kp, DEPTH - 1, 0, wave_s);
        moe_tables(c.ctl + CW_CNT + 64 * (DEPTH - 1), sPT, sLC, c.tid);
        phase_norm1<true, false, true>(c, nullptr, sPT);
    }
    if (PROBE_MASK) {
        make_ctx(c, kp, DEPTH - 1, 0, wave_s);
        STAMP(10);
        if (blockIdx.x == PROBE_BLOCK && c.tid == 0) { unsigned sel = 0; for (int k = 0; k < 16; ++k) if ((PROBE_MASK >> k) & 1) sel += sAcc[k]; __hip_atomic_store(c.ctl + CW_Q + 64 * 8, sel, __ATOMIC_RELAXED, __HIP_MEMORY_SCOPE_AGENT); }
        { XcdBarrier _b = bar; _b.bar = c.ctl + CW_BAR; xcd_barrier(_b, c.tid); }
        const unsigned sel = __hip_atomic_load(c.ctl + CW_Q + 64 * 8, __ATOMIC_RELAXED, __HIP_MEMORY_SCOPE_AGENT);
        const unsigned long long t0 = __builtin_amdgcn_s_memrealtime();
        while (__builtin_amdgcn_s_memrealtime() - t0 < (unsigned long long)sel * PROBE_K) __builtin_amdgcn_s_sleep(8);
    }
#undef IN
#undef SEAM
}

extern "C" void kernel_launch(void* const* d_in, const int* in_sizes, int n_in, void* d_out, int out_size, void* d_ws, size_t ws_size, hipStream_t stream) {
    static int grid = 0;
    if (grid == 0) {
        if (n_in != 24 || in_sizes[0] != BATCH * SEQ * D || out_size != BATCH * SEQ * D || ws_size < WS_END) { fprintf(stderr, "kernel_launch: unexpected shapes / workspace (%zu < %zu)\n", ws_size, (size_t)WS_END); grid = -1; return; }
        int dev = 0, cus = 0;
        if (hipGetDevice(&dev) != hipSuccess || hipDeviceGetAttribute(&cus, hipDeviceAttributeMultiprocessorCount, dev) != hipSuccess || cus < 256) { fprintf(stderr, "kernel_launch: needs a 256-CU device\n"); grid = -1; return; }
        if (hipFuncSetAttribute((const void*)fwd, hipFuncAttributeMaxDynamicSharedMemorySize, LDS_BYTES) != hipSuccess) { fprintf(stderr, "kernel_launch: hipFuncSetAttribute failed\n"); grid = -1; return; }
        int per_cu = 0;
        if (hipOccupancyMaxActiveBlocksPerMultiprocessor(&per_cu, (const void*)fwd, NTHR, LDS_BYTES) != hipSuccess || per_cu < 1) fprintf(stderr, "kernel_launch: occupancy query says %d\n", per_cu);
        (void)hipGetLastError();
        grid = 256;
    }
    if (grid < 0) return;
    if (hipMemsetAsync((char*)d_ws + WS_CTL, 0, CTL_ZERO_BYTES, stream) != hipSuccess) return;
    Args a{};
    for (int i = 0; i < 24; ++i) a.in[i] = d_in[i];
    a.out = (float*)d_out; a.ws = (unsigned char*)d_ws;
#if MK_LAUNCH_PER_PHASE
    for (int k = 0; k < PH_TOTAL; ++k) { a.ph_lo = k; a.ph_hi = k + 1; hipLaunchKernelGGL(fwd, dim3(grid), dim3(NTHR), LDS_BYTES, stream, a); }
#else
    a.ph_lo = 0; a.ph_hi = PH_TOTAL;
    hipLaunchKernelGGL(fwd, dim3(grid), dim3(NTHR), LDS_BYTES, stream, a);
#endif
}
```

```cpp
#include <hip/hip_runtime.h>
#include <cstdio>
#include <cstdint>

#define LAS __attribute__((address_space(3)))
#define GAS __attribute__((address_space(1)))
typedef unsigned short bf16_t;
typedef short bf16x8 __attribute__((ext_vector_type(8)));
typedef float f32x4 __attribute__((ext_vector_type(4)));
typedef float f32x2 __attribute__((ext_vector_type(2)));
typedef unsigned u32x4 __attribute__((ext_vector_type(4)));
typedef unsigned u32x2 __attribute__((ext_vector_type(2)));

namespace pg8 {
constexpr int BM = 256, BK = 64, HALF = 128, HTB = HALF * BK * 2, STAGE_BYTES = 8 * HTB, NXCD = 8, WGM = 8;
__host__ __device__ __forceinline__ int lds_byte(int r, int c) { const int st = (r >> 4) * 2 + (c >> 5), rr = r & 15, cc = c & 31, ob = rr * 64 + cc * 2; return st * 1024 + (ob ^ (((ob >> 9) & 1) << 5)); }
__host__ __device__ __forceinline__ void stage_rc(int b, int& R, int& C) { const int st = b / 1024, sb = b % 1024, swz = sb ^ (((sb >> 9) & 1) << 5); R = (st >> 1) * 16 + swz / 64; C = (st & 1) * 32 + (swz % 64) / 2; }
__host__ __device__ __forceinline__ int perm32(int rho) { const int n = rho >> 4, i = rho & 15; return 8 * (i >> 2) + 4 * n + (i & 3); }

struct Unit { int pm, pn, g; };

__device__ __forceinline__ bool static_tile(int nM, int nN, int G, int c, int i, int& pm, int& pn) {
    const int nwg = nM * nN; const long L = (long)i * G + c; if (L >= nwg) return false;
    int wgid = (int)L; { const int q = nwg / NXCD, r = nwg % NXCD, xcd = wgid % NXCD, off = wgid / NXCD; wgid = (xcd < r ? xcd * (q + 1) : r * (q + 1) + (xcd - r) * q) + off; }
    const int nig = WGM * nN, gid = wgid / nig, fm = gid * WGM, gsz = (nM - fm) < WGM ? (nM - fm) : WGM;
    pm = fm + ((wgid % nig) % gsz); pn = (wgid % nig) / gsz; return true;
}
typedef __bf16 bf16x2c_t __attribute__((ext_vector_type(2)));
__device__ __forceinline__ unsigned cvt_pk_bf16(float lo, float hi) { const f32x2 v = {lo, hi}; return __builtin_bit_cast(unsigned, __builtin_convertvector(v, bf16x2c_t)); }

template <class Epi, class Sched, bool GATHER>
__device__ __forceinline__ void gemm_phase(LAS unsigned char* lds, const Sched& S, const Epi& E, const int K, const int lda, int tid_) {
    asm volatile("" : "+v"(tid_));
    const int tid = tid_, wid = __builtin_amdgcn_readfirstlane(tid >> 6), lane = tid & 63, wr = wid >> 2, wc = wid & 3, fr = lane & 15, fq = lane >> 4;
    const int nt = K / BK;
    int sR[2], sC[2];
    unsigned voffB[2], voffA[2], vAc[2][2], vAn[2][2];
#pragma unroll
    for (int i = 0; i < 2; ++i) { int R, C; stage_rc(tid * 16 + i * 8192, R, C); sR[i] = R; sC[i] = C; const int Rb = Epi::PERM ? ((R & ~31) + perm32(R & 31)) : R;
        voffB[i] = (unsigned)(Rb * K + C) * 2u; voffA[i] = (unsigned)(R * lda + C) * 2u; }
    const size_t kstep = (size_t)(BK * 2);
    const size_t hstepB = (size_t)HALF * K * 2, hstepA = (size_t)HALF * lda * 2;
    const unsigned ldsw = (unsigned)wid * 1024u;
    const int aoff = lds_byte(wr * 64 + fr, fq * 8), boff = lds_byte(wc * 32 + fr, fq * 8);
#define PG8_SA(b, h) (((b) * 2 + (h)) * HTB)
#define PG8_SB(b, h) ((4 + (b) * 2 + (h)) * HTB)
#define PG8_STAGE(bufoff, gbase, voff) do { _Pragma("unroll") for (int _i = 0; _i < 2; ++_i) \
        __builtin_amdgcn_global_load_lds((const unsigned*)((const char*)(gbase) + (voff)[_i]), (LAS unsigned*)(lds + (bufoff) + ldsw + _i * 8192), 16, 0, 0); } while (0)
#define PG8_LDA(dst, b, h) do { _Pragma("unroll") for (int m = 0; m < 4; ++m) _Pragma("unroll") for (int k = 0; k < 2; ++k) dst[m][k] = *(const LAS bf16x8*)(lds + PG8_SA(b, h) + aoff + m * 2048 + k * 1024); } while (0)
#define PG8_LDB(dst, b, h) do { _Pragma("unroll") for (int n = 0; n < 2; ++n) _Pragma("unroll") for (int k = 0; k < 2; ++k) dst[n][k] = *(const LAS bf16x8*)(lds + PG8_SB(b, h) + boff + n * 2048 + k * 1024); } while (0)
#define PG8_MMA(ai, bj, At, Bt) do { __builtin_amdgcn_s_setprio(1); _Pragma("unroll") for (int m = 0; m < 4; ++m) _Pragma("unroll") for (int n = 0; n < 2; ++n) _Pragma("unroll") for (int k = 0; k < 2; ++k) \
        acc[ai][bj][m][n] = __builtin_amdgcn_mfma_f32_16x16x32_bf16(Bt[n][k], At[m][k], acc[ai][bj][m][n], 0, 0, 0); __builtin_amdgcn_s_setprio(0); } while (0)
#define PG8_WAIT_V(n) asm volatile("s_waitcnt vmcnt(" #n ")" ::: "memory")
#define PG8_WAIT_L(n) asm volatile("s_waitcnt lgkmcnt(" #n ")" ::: "memory")
#define PG8_BAR __builtin_amdgcn_s_barrier()
#define PG8_SCHED __builtin_amdgcn_sched_barrier(0)
#define PG8_AOFF(dst, u) do { if constexpr (GATHER) { _Pragma("unroll") for (int _h = 0; _h < 2; ++_h) _Pragma("unroll") for (int _i = 0; _i < 2; ++_i) \
        dst[_h][_i] = S.arow(u, _h * HALF + sR[_i]) + (unsigned)sC[_i] * 2u; } } while (0)
#define PG8_STAGE_A(bufoff, gptr, h, usenext) do { if constexpr (GATHER) { _Pragma("unroll") for (int _i = 0; _i < 2; ++_i) { const unsigned _vo = (usenext) ? vAn[h][_i] : vAc[h][_i]; \
        __builtin_amdgcn_global_load_lds((const unsigned*)((const char*)(gptr) + _vo), (LAS unsigned*)(lds + (bufoff) + ldsw + _i * 8192), 16, 0, 0); } } \
        else { PG8_STAGE(bufoff, (gptr) + (h) * hstepA, voffA); } } while (0)
    Unit cur, nxt; int ui = 0;
    if (!S.next(0, cur)) return;
    f32x4 acc[2][2][4][2];
#pragma unroll
    for (int a = 0; a < 2; ++a)
#pragma unroll
        for (int b = 0; b < 2; ++b)
#pragma unroll
            for (int m = 0; m < 4; ++m)
#pragma unroll
                for (int n = 0; n < 2; ++n) acc[a][b][m][n] = (f32x4){0.f, 0.f, 0.f, 0.f};
    bf16x8 At[4][2], B0[2][2], B1[2][2];
    const char* cA = S.aptr(cur); const char* cB = S.bptr(cur);
    PG8_AOFF(vAc, cur);
    PG8_STAGE(PG8_SB(0, 0), cB, voffB); PG8_STAGE(PG8_SB(0, 1), cB + hstepB, voffB); PG8_STAGE_A(PG8_SA(0, 0), cA, 0, false); PG8_STAGE_A(PG8_SA(0, 1), cA, 1, false);
    if (wr == 1) PG8_BAR;
    PG8_WAIT_V(2); PG8_BAR;
    PG8_STAGE(PG8_SB(1, 0), cB + kstep, voffB); PG8_STAGE_A(PG8_SA(1, 0), cA + kstep, 0, false); PG8_STAGE(PG8_SB(1, 1), cB + hstepB + kstep, voffB);
    PG8_WAIT_V(6); PG8_BAR;
    for (;;) {
        const bool has_next = S.next(ui + 1, nxt);
        const char* nA = has_next ? S.aptr(nxt) : cA; const char* nB = has_next ? S.bptr(nxt) : cB;
        if constexpr (GATHER) { if (has_next) { PG8_AOFF(vAn, nxt); } else {
#pragma unroll
            for (int h = 0; h < 2; ++h)
#pragma unroll
                for (int i = 0; i < 2; ++i) vAn[h][i] = vAc[h][i]; } }
#if defined(PROBE_MASK) && PROBE_MASK
        const unsigned long long _tk0 = __builtin_amdgcn_s_memrealtime();
#endif
        for (int t = 0; t < nt; t += 2) {
            const bool last = (t == nt - 2);
            const char* a1 = cA + (size_t)(t + 1) * kstep;
            const char* a2 = last ? nA : cA + (size_t)(t + 2) * kstep; const char* b2 = last ? nB : cB + (size_t)(t + 2) * kstep;
            const char* a3 = a2 + kstep; const char* b3 = b2 + kstep;
            PG8_LDB(B0, 0, 0); PG8_LDB(B1, 0, 1); PG8_SCHED; PG8_LDA(At, 0, 0); PG8_STAGE_A(PG8_SA(1, 1), a1, 1, false);
            PG8_WAIT_V(8); PG8_WAIT_L(0); PG8_BAR; PG8_MMA(0, 0, At, B0); PG8_MMA(0, 1, At, B1); PG8_BAR; PG8_SCHED;
            PG8_LDA(At, 0, 1); PG8_STAGE(PG8_SB(0, 0), b2, voffB); PG8_STAGE(PG8_SB(0, 1), b2 + hstepB, voffB); PG8_STAGE_A(PG8_SA(0, 0), a2, 0, last);
            PG8_WAIT_V(8); PG8_WAIT_L(0); PG8_BAR; PG8_MMA(1, 0, At, B0); PG8_MMA(1, 1, At, B1); PG8_BAR; PG8_SCHED;
            PG8_LDB(B0, 1, 0); PG8_LDB(B1, 1, 1); PG8_SCHED; PG8_LDA(At, 1, 0); PG8_STAGE_A(PG8_SA(0, 1), a2, 1, last);
            PG8_WAIT_V(8); PG8_WAIT_L(0); PG8_BAR; PG8_MMA(0, 0, At, B0); PG8_MMA(0, 1, At, B1); PG8_BAR; PG8_SCHED;
            PG8_LDA(At, 1, 1); PG8_STAGE(PG8_SB(1, 0), b3, voffB); PG8_STAGE(PG8_SB(1, 1), b3 + hstepB, voffB); PG8_STAGE_A(PG8_SA(1, 0), a3, 0, last);
            PG8_WAIT_V(8); PG8_WAIT_L(0); PG8_BAR; PG8_MMA(1, 0, At, B0); PG8_MMA(1, 1, At, B1); PG8_BAR; PG8_SCHED;
        }
#if defined(PROBE_MASK) && PROBE_MASK
        if (blockIdx.x == PROBE_BLOCK && tid == 0 && ((volatile LAS unsigned*)(lds + 147456))[6]) ((LAS unsigned*)(lds + 147456 + 512))[14] += (unsigned)(__builtin_amdgcn_s_memrealtime() - _tk0);
#endif
        if (wr == 0) PG8_BAR;
#if defined(PROBE_MASK) && PROBE_MASK
        { const unsigned long long _t0 = __builtin_amdgcn_s_memrealtime();
          E(acc, cur, wr, wc, fr, fq);
          asm volatile("s_waitcnt vmcnt(0)" ::: "memory");
          if (blockIdx.x == PROBE_BLOCK && tid == 0 && ((volatile LAS unsigned*)(lds + 147456))[6]) ((LAS unsigned*)(lds + 147456 + 512))[13] += (unsigned)(__builtin_amdgcn_s_memrealtime() - _t0); }
#else
        E(acc, cur, wr, wc, fr, fq);
#endif
        if (!has_next) break;
#pragma unroll
        for (int a = 0; a < 2; ++a)
#pragma unroll
            for (int b = 0; b < 2; ++b)
#pragma unroll
                for (int m = 0; m < 4; ++m)
#pragma unroll
                    for (int n = 0; n < 2; ++n) acc[a][b][m][n] = (f32x4){0.f, 0.f, 0.f, 0.f};
        cur = nxt; cA = nA; cB = nB; ++ui;
        if constexpr (GATHER) {
#pragma unroll
        for (int h = 0; h < 2; ++h)
#pragma unroll
            for (int i = 0; i < 2; ++i) vAc[h][i] = vAn[h][i]; }
        if (wr == 1) PG8_BAR;
    }
    PG8_WAIT_V(0);
    PG8_BAR;
#undef PG8_SA
#undef PG8_SB
#undef PG8_STAGE
#undef PG8_LDA
#undef PG8_LDB
#undef PG8_MMA
#undef PG8_WAIT_V
#undef PG8_WAIT_L
#undef PG8_BAR
#undef PG8_SCHED
#undef PG8_AOFF
#undef PG8_STAGE_A
}
}

constexpr int D = 1024, BATCH = 32, SEQ = 2048, DEPTH = 2;
constexpr int NCH = 2, BC = BATCH / NCH, TC = BC * SEQ;
constexpr int TT = BATCH * SEQ;
constexpr int NP = 10496;
constexpr int C_QA = 0, C_KA = 256, C_VA = 512, C_OG = 1024, C_GP = 1536, C_XB = 1792, C_YB = 2304, C_QKV = 2816, C_G = 7424;
constexpr int WIN_N = 10256;
constexpr int NE = 16, FF = 512;
constexpr int RP = 2 * TT + NE * 256;
constexpr float RMS_EPS = 1e-6f;
constexpr int NWAVES = 8, NTHR = 512;

constexpr size_t MiB = 1u << 20;
constexpr size_t WS_CTL = 0, CTL_ZERO_BYTES = 1 * MiB;
constexpr size_t WS_REC = 1 * MiB;
constexpr size_t WS_LIST = 2 * MiB;
constexpr size_t WS_W = 6 * MiB;
constexpr size_t LW_WIN = 0, LW_WBR = LW_WIN + (size_t)NP * D * 2, LW_WOUT = LW_WBR + (size_t)3 * D * 512 * 2, LW_WGU = LW_WOUT + (size_t)D * D * 2,
                 LW_WDN = LW_WGU + (size_t)NE * 1024 * D * 2, LW_SIZE = LW_WDN + (size_t)NE * D * FF * 2;
static_assert(LW_SIZE == 77070336, "layer weights");
constexpr size_t WS_BRC = 154 * MiB;
constexpr size_t WS_ACT = 166 * MiB;
constexpr size_t WS_PROJ = 294 * MiB;
constexpr size_t WS_HID = WS_PROJ;
constexpr size_t WS_YS = WS_PROJ + 136 * MiB;
constexpr size_t WS_END = WS_PROJ + 656 * MiB;
static_assert(WS_W + 2 * LW_SIZE <= WS_BRC && WS_BRC + 12 * MiB <= WS_ACT && WS_ACT + (size_t)TT * D * 2 <= WS_PROJ && (size_t)TC * NP * 2 <= 656 * MiB && (size_t)RP * 512 * 2 <= 136 * MiB && WS_YS + (size_t)RP * 2048 <= WS_END, "ws map");
constexpr int CW_BAR = 4096;
constexpr int CW_CNT = 8192;
constexpr int CW_Q = 12288;

constexpr int RING_BYTES = 147456;
constexpr int MISC_OFF = RING_BYTES;
constexpr int LDS_BYTES = 155648;

#define LDS_WAIT() asm volatile("s_waitcnt lgkmcnt(0)" ::: "memory")
#define VM_WAIT() asm volatile("s_waitcnt vmcnt(0)" ::: "memory")
__device__ __forceinline__ float bf2f(unsigned short b) { return __uint_as_float(((unsigned)b) << 16); }
__device__ __forceinline__ float bflo(unsigned u) { return __uint_as_float(u << 16); }
__device__ __forceinline__ float bfhi(unsigned u) { return __uint_as_float(u & 0xffff0000u); }
typedef __bf16 bf16x2v_t __attribute__((ext_vector_type(2)));
__device__ __forceinline__ unsigned pk2(float lo, float hi) { const f32x2 v = {lo, hi}; return __builtin_bit_cast(unsigned, __builtin_convertvector(v, bf16x2v_t)); }
__device__ __forceinline__ unsigned f2bf(float f) { return pk2(f, 0.f) & 0xffffu; }
__device__ __forceinline__ float rcpf_(float x) { return __builtin_amdgcn_rcpf(x); }
__device__ __forceinline__ float rsqf_(float x) { return __builtin_amdgcn_rsqf(x); }
template <int O> __device__ __forceinline__ float swz_xor(float v) { return __int_as_float(__builtin_amdgcn_ds_swizzle(__float_as_int(v), (O << 10) | 0x1f)); }
__device__ __forceinline__ float wave_sum(float v) {
    v += swz_xor<1>(v); v += swz_xor<2>(v); v += swz_xor<4>(v); v += swz_xor<8>(v); v += swz_xor<16>(v);
    const auto r = __builtin_amdgcn_permlane32_swap(__float_as_uint(v), __float_as_uint(v), false, false);
    return __uint_as_float(r[0]) + __uint_as_float(r[1]);
}
__device__ __forceinline__ float wave_max(float v) {
    v = fmaxf(v, swz_xor<1>(v)); v = fmaxf(v, swz_xor<2>(v)); v = fmaxf(v, swz_xor<4>(v)); v = fmaxf(v, swz_xor<8>(v)); v = fmaxf(v, swz_xor<16>(v));
    const auto r = __builtin_amdgcn_permlane32_swap(__float_as_uint(v), __float_as_uint(v), false, false);
    return fmaxf(__uint_as_float(r[0]), __uint_as_float(r[1]));
}
__device__ __forceinline__ float sigmoidf_(float x) { return __builtin_amdgcn_rcpf(1.f + __expf(-x)); }

#define XB_TMO      128
#define XB_XCNT(j)  (256  + 64 * (j))
#define XB_XSUB(j)  (1280 + 64 * (j))
#define XB_XGEN(j)  (2304 + 64 * (j))
#define XB_TOP      3328
#define XB_TOPGEN   3392
#define XCD_BAR_WORDS 3456
#define XB_SPIN_CAP (1u << 21)
__device__ __forceinline__ unsigned xb_ld(unsigned* p)              { return __hip_atomic_load(p, __ATOMIC_RELAXED, __HIP_MEMORY_SCOPE_AGENT); }
__device__ __forceinline__ unsigned xb_add(unsigned* p, unsigned v) { return __hip_atomic_fetch_add(p, v, __ATOMIC_RELAXED, __HIP_MEMORY_SCOPE_AGENT); }
__device__ __forceinline__ unsigned xb_xcc_id() { return (unsigned)__builtin_amdgcn_s_getreg((3 << 11) | 20) & 0xFu; }
#define XB_SPIN(cond, bar) do { unsigned _sp = 0; while (cond) { __builtin_amdgcn_s_sleep(1); \
    if ((++_sp & 255u) == 0u) { if (xb_ld(&(bar)[XB_TMO])) break; if (_sp > XB_SPIN_CAP) { atomicAdd(&(bar)[XB_TMO], 1u); break; } } } } while (0)
struct XcdBarrier { unsigned* bar; unsigned x; volatile LAS unsigned* st; };
__device__ __forceinline__ XcdBarrier xcd_barrier_post(unsigned* bar, volatile LAS unsigned* st, int tid) {
    XcdBarrier b; b.bar = bar; b.x = xb_xcc_id(); b.st = st;
    if (tid == 0) (void)xb_add(&bar[XB_XCNT(b.x)], 1u);
    return b;
}
__device__ __forceinline__ void xcd_barrier_complete(unsigned* bar, unsigned x, unsigned& nloc, unsigned& nx) {
    const unsigned G = gridDim.x * gridDim.y * gridDim.z;
    unsigned sum, cnt, sp = 0u;
    for (;;) {
        sum = 0u; cnt = 0u;
#pragma unroll 1
        for (unsigned j = 0; j < 16; ++j) { const unsigned c = xb_ld(&bar[XB_XCNT(j)]); sum += c; cnt += (c > 0u) ? 1u : 0u; }
        if (sum == G) break;
        __builtin_amdgcn_s_sleep(1);
        if ((++sp & 255u) == 0u) { if (xb_ld(&bar[XB_TMO])) break; if (sp > XB_SPIN_CAP) { atomicAdd(&bar[XB_TMO], 1u); break; } }
    }
    const unsigned mine = xb_ld(&bar[XB_XCNT(x)]);
    nloc = mine > 0u ? mine : 1u; nx = cnt > 0u ? cnt : 1u;
}
__device__ __noinline__ void xcd_barrier(const XcdBarrier b, const int tid) {
    asm volatile("s_waitcnt vmcnt(0)" ::: "memory");
    __syncthreads();
    if (tid == 0) {
        unsigned* bar = b.bar;
        __builtin_amdgcn_s_waitcnt(0);
        unsigned nloc = b.st[0], nx = b.st[1];
        if (nloc == 0u) { xcd_barrier_complete(bar, b.x, nloc, nx); b.st[0] = nloc; b.st[1] = nx; }
        const unsigned old = xb_add(&bar[XB_XSUB(b.x)], 1u);
        const unsigned gen = old / nloc;
        if (old + 1u == (gen + 1u) * nloc) {
            __builtin_amdgcn_fence(__ATOMIC_RELEASE, "agent");
            asm volatile("s_waitcnt vmcnt(0)" ::: "memory");
            const unsigned og = xb_add(&bar[XB_TOP], 1u);
            const unsigned tg = og / nx;
            if (og + 1u == (tg + 1u) * nx) xb_add(&bar[XB_TOPGEN], 1u);
            else XB_SPIN(xb_ld(&bar[XB_TOPGEN]) == tg, bar);
            __builtin_amdgcn_fence(__ATOMIC_ACQUIRE, "agent");
            xb_add(&bar[XB_XGEN(b.x)], 1u);
            asm volatile("s_waitcnt vmcnt(0)" ::: "memory");
        } else {
            XB_SPIN(xb_ld(&bar[XB_XGEN(b.x)]) == gen, bar);
            __builtin_amdgcn_fence(__ATOMIC_ACQUIRE, "agent");
            asm volatile("s_waitcnt vmcnt(0)" ::: "memory");
        }
    }
    __syncthreads();
}

struct Args { const void* in[24]; float* out; unsigned char* ws; int ph_lo, ph_hi; };
struct Ctx {
    LAS unsigned char* lds;
    unsigned* ctl;
    int tid, lane, wave, bid, G;
    int chunk, layer, pass;
    const float* x_in; float* xo;
    const float* xinf; float* xof; bf16_t* actf;
    const int* pos;
    const unsigned char* lw;
    bf16_t *act, *proj, *hid, *ys;
    unsigned* rec; int* list;
};

template <class DMap>
__device__ __forceinline__ void tr_item64(const float* srcA, const float* srcB, int Nsrc, float scale, bf16_t* WT, int K, int n0, int k0, LAS float* scr, int lane, DMap dmap) {
    const int r4 = lane >> 4, c16 = lane & 15;
    const float* src = (c16 < 8 ? srcA + 4 * c16 : srcB + 4 * (c16 - 8));
    f32x4 v[16];
#pragma unroll
    for (int i = 0; i < 16; ++i) v[i] = *(const f32x4*)(src + (size_t)(k0 + 4 * i + r4) * Nsrc);
#pragma unroll
    for (int i = 0; i < 16; ++i) { LAS float* d = scr + (4 * i + r4) * 65 + 4 * c16; d[0] = v[i].x * scale; d[1] = v[i].y * scale; d[2] = v[i].z * scale; d[3] = v[i].w * scale; }
    LDS_WAIT(); asm volatile("" ::: "memory");
    const int kc = lane & 7;
#pragma unroll
    for (int j = 0; j < 8; ++j) { const int r = (lane >> 3) + 8 * j; const LAS float* q = scr + (8 * kc) * 65 + dmap(r);
        u32x4 o; o.x = pk2(q[0 * 65], q[1 * 65]); o.y = pk2(q[2 * 65], q[3 * 65]); o.z = pk2(q[4 * 65], q[5 * 65]); o.w = pk2(q[6 * 65], q[7 * 65]);
        *(u32x4*)(WT + (size_t)(n0 + r) * K + k0 + 8 * kc) = o; }
    LDS_WAIT(); asm volatile("" ::: "memory");
}
struct DMapId { __device__ __forceinline__ int operator()(int r) const { return r; } };
struct DMapGU { __device__ __forceinline__ int operator()(int r) const { return ((r >> 4) & 1) * 32 + (r >> 5) * 16 + (r & 15); } };
constexpr int IT_WIN = (NP / 64) * 16, IT_WBR = 3 * 16 * 8, IT_WOUT = 16 * 16, IT_WGU = NE * 16 * 16, IT_WDN = NE * 16 * 8, IT_LAYER = IT_WIN + IT_WBR + IT_WOUT + IT_WGU + IT_WDN;
__device__ __forceinline__ void phase_prep(const Args& a, LAS unsigned char* lds, int gw, int NGW, int wave, int lane, int gtid, int NGT) {
    LAS float* scr = (LAS float*)(lds + wave * 17408);
    for (int it = gw; it < DEPTH * IT_LAYER; it += NGW) {
        const int l = it / IT_LAYER; int r = it % IT_LAYER;
        unsigned char* lw = a.ws + WS_W + (size_t)l * LW_SIZE;
        if (r < IT_WIN) {
            const int g = r / 16, kb = r % 16;
            if (g >= C_GP / 64 && g < C_XB / 64) continue;
            const int n0 = 64 * g, src = n0 < C_GP ? n0 : n0 - 240;
            const float* W = (const float*)a.in[3] + (size_t)l * D * WIN_N + src;
            tr_item64(W, W + 32, WIN_N, n0 < 256 ? 0.125f : 1.f, (bf16_t*)(lw + LW_WIN), D, n0, 64 * kb, scr, lane, DMapId());
            continue; }
        r -= IT_WIN;
        if (r < IT_WBR) {
            const int b = r / 128, g = (r % 128) / 8, kb = r % 8;
            const float* W = (const float*)a.in[16] + ((size_t)l * 3 + b) * 512 * D + 64 * g;
            tr_item64(W, W + 32, D, 1.f, (bf16_t*)(lw + LW_WBR) + (size_t)b * D * 512, 512, 64 * g, 64 * kb, scr, lane, DMapId());
            continue; }
        r -= IT_WBR;
        if (r < IT_WOUT) {
            const int g = r / 16, kb = r % 16;
            const float* W = (const float*)a.in[17] + (size_t)l * D * D + 64 * g;
            tr_item64(W, W + 32, D, 1.f, (bf16_t*)(lw + LW_WOUT), D, 64 * g, 64 * kb, scr, lane, DMapId());
            continue; }
        r -= IT_WOUT;
        if (r < IT_WGU) {
            const int e = r / 256, g = (r % 256) / 16, kb = r % 16;
            const float* Wg = (const float*)a.in[21] + ((size_t)l * NE + e) * D * FF + 32 * g;
            const float* Wu = (const float*)a.in[22] + ((size_t)l * NE + e) * D * FF + 32 * g;
            tr_item64(Wg, Wu, FF, 1.f, (bf16_t*)(lw + LW_WGU) + (size_t)e * 1024 * D, D, 64 * g, 64 * kb, scr, lane, DMapGU());
            continue; }
        r -= IT_WGU;
        {
            const int e = r / 128, g = (r % 128) / 8, kb = r % 8;
            const float* W = (const float*)a.in[23] + ((size_t)l * NE + e) * FF * D + 64 * g;
            tr_item64(W, W + 32, D, 1.f, (bf16_t*)(lw + LW_WDN) + (size_t)e * D * FF, FF, 64 * g, 64 * kb, scr, lane, DMapId());
        }
    }
    for (int idx = gtid; idx < DEPTH * 256 * D; idx += NGT) {
        const int l = idx / (256 * D), j = (idx / D) % 256, k = idx % D;
        const float* W = (const float*)a.in[3] + (size_t)l * D * WIN_N + (size_t)k * WIN_N + 1536;
        const float* gu = (const float*)a.in[4] + (size_t)l * 16 * 256 + j;
        float s = 0.f;
#pragma unroll
        for (int r = 0; r < 16; ++r) s += W[r] * gu[r * 256];
        ((bf16_t*)(a.ws + WS_W + (size_t)l * LW_SIZE + LW_WIN))[(size_t)(C_GP + j) * D + k] = (bf16_t)f2bf(s);
    }
}

__device__ __forceinline__ void moe_tables(const unsigned* cnt, LAS int* pt, LAS int* lc, int tid) {
    if (tid == 0) { int s = 0;
        for (int e = 0; e < NE; ++e) { const int c = (int)__hip_atomic_load(cnt + e, __ATOMIC_RELAXED, __HIP_MEMORY_SCOPE_AGENT); pt[e] = s; lc[e] = c; s += (c + 255) >> 8; }
        pt[NE] = s; }
    __syncthreads();
}

template <bool COMBINE, bool NORM, bool SRC_OUT>
__device__ __forceinline__ void phase_norm1(const Ctx& c, const float* gain, LAS const int* pt) {
    const int gw = c.bid * NWAVES + c.wave, NGW = c.G * NWAVES, lane = c.lane;
    f32x4 g4[4];
    if (NORM) {
#pragma unroll
        for (int j = 0; j < 4; ++j) g4[j] = *((const f32x4*)gain + 64 * j + lane); }
    constexpr int NR = 4;
    static_assert(TT % (NR * 2048) == 0, "rows per wave");
    for (int tok0 = gw; tok0 < TT; tok0 += NR * NGW) {
        f32x4 v[NR][4]; u32x2 ya[NR][4], yb[NR][4]; float w0[NR], w1[NR];
#pragma unroll
        for (int r = 0; r < NR; ++r) { const int tok = tok0 + r * NGW;
            const f32x4* xr = (const f32x4*)((SRC_OUT ? (const float*)c.xof : c.xinf) + (size_t)tok * D) + lane;
#pragma unroll
            for (int j = 0; j < 4; ++j) v[r][j] = xr[64 * j];
            if (COMBINE) {
                const u32x4 rc = *(const u32x4*)(c.rec + (size_t)tok * 4);
                const int e0 = rc.x >> 20, e1 = rc.y >> 20;
                const size_t r0 = (size_t)pt[e0] * 256 + (rc.x & 0xfffffu), r1 = (size_t)pt[e1] * 256 + (rc.y & 0xfffffu);
                w0[r] = __uint_as_float(rc.z); w1[r] = __uint_as_float(rc.w);
                const u32x2* y0 = (const u32x2*)(c.ys + r0 * D) + lane; const u32x2* y1 = (const u32x2*)(c.ys + r1 * D) + lane;
#pragma unroll
                for (int j = 0; j < 4; ++j) { ya[r][j] = y0[64 * j]; yb[r][j] = y1[64 * j]; }
            } }
#pragma unroll
        for (int r = 0; r < NR; ++r) { const int tok = tok0 + r * NGW;
            if (COMBINE) {
#pragma unroll
                for (int j = 0; j < 4; ++j) { const u32x2 a = ya[r][j], b = yb[r][j];
                    v[r][j].x += w0[r] * bflo(a.x) + w1[r] * bflo(b.x); v[r][j].y += w0[r] * bfhi(a.x) + w1[r] * bfhi(b.x);
                    v[r][j].z += w0[r] * bflo(a.y) + w1[r] * bflo(b.y); v[r][j].w += w0[r] * bfhi(a.y) + w1[r] * bfhi(b.y); }
                f32x4* xw = (f32x4*)(c.xof + (size_t)tok * D) + lane;
#pragma unroll
                for (int j = 0; j < 4; ++j) xw[64 * j] = v[r][j];
            }
            if (NORM) {
                float ss = 0.f;
#pragma unroll
                for (int j = 0; j < 4; ++j) ss += (v[r][j].x * v[r][j].x + v[r][j].y * v[r][j].y) + (v[r][j].z * v[r][j].z + v[r][j].w * v[r][j].w);
                const float rs = rsqf_(wave_sum(ss) * (1.f / D) + RMS_EPS);
                u32x2* o = (u32x2*)(c.actf + (size_t)tok * D) + lane;
#pragma unroll
                for (int j = 0; j < 4; ++j) { u32x2 w; w.x = pk2(v[r][j].x * rs * g4[j].x, v[r][j].y * rs * g4[j].y); w.y = pk2(v[r][j].z * rs * g4[j].z, v[r][j].w * rs * g4[j].w); o[64 * j] = w; }
            } }
    }
}

__constant__ double kInvFreq[16] = {1.0, 0.44036660267178046, 0.19392274474868576, 0.08539710028576561, 0.03760603093086393, 0.016560440080994446, 0.007292664737217109, 0.003211445994752591,
    0.001414213562373095, 0.000622772421914596, 0.0002742481756762073, 0.00012076973741146504, 5.318295896944988e-05, 2.341999896140934e-05, 1.031338537721246e-05, 4.5416704806078695e-06};
__device__ __forceinline__ void phase_rope_table(const int* pos, float* tab, int gtid, int NGT) {
    for (int idx = gtid; idx < BATCH * SEQ * 16; idx += NGT) { const int tok = idx >> 4, i = idx & 15;
        double a = (double)pos[tok] * kInvFreq[i] * 0.15915494309189535; a -= rint(a);
        tab[(size_t)tok * 32 + i] = __builtin_amdgcn_cosf((float)a); tab[(size_t)tok * 32 + 16 + i] = __builtin_amdgcn_sinf((float)a); }
}

__device__ __forceinline__ float logsigmoidf_(float g) { return fminf(g, 0.f) - log1pf(__expf(-fabsf(g))); }
__device__ __forceinline__ float gelu_tanh(float y) { const float u2 = 1.5957691216057308f * (y + 0.044715f * y * y * y); return y * __builtin_amdgcn_rcpf(1.f + __expf(-u2)); }

__device__ __forceinline__ void gla_simple(const Ctx& c, int b, const float* gbias, const float* ogain) {
    LAS float* sQ = (LAS float*)c.lds; LAS float* sK = sQ + 16 * 256; LAS float* sA = sK + 16 * 256; LAS float* sO = sA + 16 * 256; LAS float* sV = sO + 16 * 512;
    const int tid = c.tid, h = tid >> 7, lane = c.lane;
    float S[64];
#pragma unroll
    for (int i = 0; i < 64; ++i) S[i] = 0.f;
    const float og0 = ogain[2 * lane], og1 = ogain[2 * lane + 1];
    for (int tc = 0; tc < SEQ / 16; ++tc) {
        const size_t tok0 = (size_t)b * SEQ + tc * 16;
        __syncthreads();
        for (int idx = tid; idx < 16 * 256; idx += NTHR) { const int s = idx >> 8, ci = idx & 255; const bf16_t* row = c.proj + (tok0 + s) * NP;
            sQ[idx] = bf2f(row[C_QA + ci]); sK[idx] = bf2f(row[C_KA + ci]);
            sA[idx] = __expf(logsigmoidf_(bf2f(row[C_GP + ci]) + gbias[ci]) * (1.f / 16.f)); }
#pragma unroll
        for (int s = 0; s < 16; ++s) sV[s * 512 + tid] = bf2f(c.proj[(tok0 + s) * NP + C_VA + tid]);
        __syncthreads();
        for (int s = 0; s < 16; ++s) {
            const float v = sV[s * 512 + tid]; float o = 0.f;
            const LAS f32x4* a4 = (const LAS f32x4*)(sA + s * 256 + h * 64); const LAS f32x4* k4 = (const LAS f32x4*)(sK + s * 256 + h * 64); const LAS f32x4* q4 = (const LAS f32x4*)(sQ + s * 256 + h * 64);
#pragma unroll
            for (int d = 0; d < 16; ++d) { const f32x4 a = a4[d], k = k4[d], q = q4[d];
                S[4 * d + 0] = S[4 * d + 0] * a.x + k.x * v; o += q.x * S[4 * d + 0];
                S[4 * d + 1] = S[4 * d + 1] * a.y + k.y * v; o += q.y * S[4 * d + 1];
                S[4 * d + 2] = S[4 * d + 2] * a.z + k.z * v; o += q.z * S[4 * d + 2];
                S[4 * d + 3] = S[4 * d + 3] * a.w + k.w * v; o += q.w * S[4 * d + 3]; }
            sO[s * 512 + tid] = o;
        }
        __syncthreads();
#pragma unroll 2
        for (int k = 0; k < 8; ++k) { const int rr = c.wave * 8 + k, s = rr >> 2, hh = rr & 3;
            const float o0 = sO[s * 512 + hh * 128 + 2 * lane], o1 = sO[s * 512 + hh * 128 + 2 * lane + 1];
            const float rs = rsqf_(wave_sum(o0 * o0 + o1 * o1) * (1.f / 128.f) + RMS_EPS);
            unsigned* pp = (unsigned*)(c.proj + (tok0 + s) * NP + C_OG + hh * 128) + lane;
            const unsigned u = *pp; const float g0 = bflo(u), g1 = bfhi(u);
            *pp = pk2(o0 * rs * og0 * g0 * sigmoidf_(g0), o1 * rs * og1 * g1 * sigmoidf_(g1)); }
    }
}

__device__ __forceinline__ void lru_simple(const Ctx& c, int b, const float* convw, const float* convb, const float* wa_, const float* ba_, const float* wx_, const float* bx_, const float* lam_) {
    const int ch = c.tid, n = c.wave, lane = c.lane;
    LAS float* sX = (LAS float*)(c.lds + n * 4096);
    const float* wap = wa_ + n * 4096 + lane; const float* wxp = wx_ + n * 4096 + lane;
    const float cw0 = convw[ch], cw1 = convw[512 + ch], cw2 = convw[1024 + ch], cw3 = convw[1536 + ch], cb = convb[ch], ba = ba_[ch], bx = bx_[ch];
    const float lam = lam_[ch]; const float c8 = 8.f * (fmaxf(-lam, 0.f) + log1pf(__expf(-fabsf(lam))));
    float xm1 = 0.f, xm2 = 0.f, xm3 = 0.f, hs = 0.f;
    for (int tc = 0; tc < SEQ / 16; ++tc) {
        const size_t tok0 = (size_t)b * SEQ + tc * 16;
        float xc[16], yv[16], ar[16], ai[16];
#pragma unroll
        for (int s = 0; s < 16; ++s) { xc[s] = bf2f(c.proj[(tok0 + s) * NP + C_XB + ch]); yv[s] = bf2f(c.proj[(tok0 + s) * NP + C_YB + ch]); }
#pragma unroll
        for (int s = 0; s < 16; ++s) { const float x = xc[s]; xc[s] = cb + cw0 * xm3 + cw1 * xm2 + cw2 * xm1 + cw3 * x; xm3 = xm2; xm2 = xm1; xm1 = x; sX[s * 64 + lane] = xc[s]; ar[s] = ba; ai[s] = bx; }
        LDS_WAIT(); asm volatile("" ::: "memory"); __builtin_amdgcn_wave_barrier();
#pragma unroll 2
        for (int k = 0; k < 64; ++k) { const float wa = wap[k * 64], wx = wxp[k * 64];
#pragma unroll
            for (int s = 0; s < 16; ++s) { const float x = sX[s * 64 + k]; ar[s] += x * wa; ai[s] += x * wx; } }
#pragma unroll
        for (int s = 0; s < 16; ++s) {
            const float r = sigmoidf_(ar[s]), ig = sigmoidf_(ai[s]);
            const float a = __expf(-c8 * r);
            const float u = sqrtf(fmaxf(1.f - a * a, 0.f)) * ig * xc[s];
            hs = a * hs + u;
            c.proj[(tok0 + s) * NP + C_YB + ch] = (bf16_t)f2bf(hs * gelu_tanh(yv[s]));
        }
        LDS_WAIT(); asm volatile("" ::: "memory"); __builtin_amdgcn_wave_barrier();
    }
}

__device__ __forceinline__ void attn_simple(const Ctx& c, int aw, int NAW) {
    const int lane = c.lane;
    for (int task = aw; task < TC * 4; task += NAW) {
        const int tok = task >> 2, h = task & 3, t = tok & (SEQ - 1);
        float ml = -INFINITY, wsum = 0.f, acc0 = 0.f, acc1 = 0.f;
#pragma unroll 1
        for (int p = 0; p < 3; ++p) {
            const int dsh = 2 * p, i = t >> dsh, nk = i + 1 < 129 ? i + 1 : 129;
            const bf16_t* qrow = c.proj + (size_t)tok * NP + C_QKV + (p * 4 + h) * 128;
            const int kcol = C_QKV + (12 + p * 4 + h) * 128, vcol = C_QKV + (24 + p * 4 + h) * 128;
            float sc[3];
#pragma unroll
            for (int r = 0; r < 3; ++r) {
                sc[r] = -INFINITY;
                if (64 * r < nk) {
                    const int m = 64 * r + lane; const bool valid = m < nk;
                    const bf16_t* krow = c.proj + (size_t)(tok - ((valid ? m : 0) << dsh)) * NP + kcol;
                    float s = 0.f;
#pragma unroll 1
                    for (int cb = 0; cb < 4; ++cb) {
                        u32x4 kq[4], qq[4];
#pragma unroll
                        for (int j = 0; j < 4; ++j) { kq[j] = *((const u32x4*)krow + cb * 4 + j); qq[j] = *((const u32x4*)qrow + cb * 4 + j); }
#pragma unroll
                        for (int j = 0; j < 4; ++j) {
                            s += bflo(kq[j].x) * bflo(qq[j].x) + bfhi(kq[j].x) * bfhi(qq[j].x) + bflo(kq[j].y) * bflo(qq[j].y) + bfhi(kq[j].y) * bfhi(qq[j].y)
                               + bflo(kq[j].z) * bflo(qq[j].z) + bfhi(kq[j].z) * bfhi(qq[j].z) + bflo(kq[j].w) * bflo(qq[j].w) + bfhi(kq[j].w) * bfhi(qq[j].w); }
                    }
                    sc[r] = valid ? s * 0.08838834764831845f : -INFINITY;
                }
            }
            const float mx = wave_max(fmaxf(sc[0], fmaxf(sc[1], sc[2])));
            float pr[3];
#pragma unroll
            for (int r = 0; r < 3; ++r) pr[r] = __expf(sc[r] - mx);
            const float den = wave_sum(pr[0] + pr[1] + pr[2]);
            float o0 = 0.f, o1 = 0.f;
#pragma unroll
            for (int r = 0; r < 3; ++r) {
                const int cnt = nk - 64 * r < 64 ? nk - 64 * r : 64;
                if (cnt > 0) {
                const unsigned* vb = (const unsigned*)(c.proj + (size_t)(tok - ((64 * r) << dsh)) * NP + vcol) + lane;
#pragma unroll 4
                for (int mm = 0; mm < cnt; ++mm) {
                    const float pm = __int_as_float(__builtin_amdgcn_readlane(__float_as_int(pr[r]), mm));
                    const unsigned u = *(const unsigned*)((const char*)vb - (size_t)(mm << dsh) * NP * 2);
                    o0 += pm * bflo(u); o1 += pm * bfhi(u); }
                }
            }
            const float inv = rcpf_(den), lse = mx + __logf(den);
            const float nml = fmaxf(ml, lse), sc_old = __expf(ml - nml), w = __expf(lse - nml);
            acc0 = acc0 * sc_old + w * o0 * inv; acc1 = acc1 * sc_old + w * o1 * inv; wsum = wsum * sc_old + w; ml = nml;
        }
        const float wi = rcpf_(wsum);
        unsigned* op = (unsigned*)(c.proj + (size_t)tok * NP + C_QKV + h * 128) + lane;
        *op = pk2(acc0 * wi, acc1 * wi);
    }
}

typedef unsigned short u16x4 __attribute__((ext_vector_type(4)));
__device__ __forceinline__ unsigned offb(unsigned row, unsigned ch) { return 256u * row + 16u * (ch ^ (((row & 3u) << 2) | ((row >> 2) & 3u))); }
constexpr int ATT_UNITS_PER_SEQ = 3 * 4 * 16;
struct AttU { int b, p, h, blk, dsh, it0; size_t tok0; int qcol, kcol, vcol; };
__device__ __forceinline__ AttU att_decode(int unit) {
    AttU a; a.b = unit / ATT_UNITS_PER_SEQ; const int rem = unit % ATT_UNITS_PER_SEQ; a.p = rem / 64; a.h = (rem / 16) & 3; const int qb = rem & 15;
    a.dsh = 2 * a.p; const int nblk = 16 >> a.dsh, r = qb / nblk; a.blk = qb % nblk; a.tok0 = (size_t)a.b * SEQ + r; a.it0 = a.blk == 0 ? 4 : 0;
    a.qcol = C_QKV + (a.p * 4 + a.h) * 128; a.kcol = C_QKV + (12 + a.p * 4 + a.h) * 128; a.vcol = C_QKV + (24 + a.p * 4 + a.h) * 128; return a;
}
#define ATT_DMA(U, col, dst) do { _Pragma("unroll") for (int it = 0; it < 8; ++it) if (it >= (U).it0) { const int q = w + 8 * it; const unsigned n = 64u * q + lane, row = n >> 4, cs = n & 15u, ch = cs ^ (((row & 3u) << 2) | ((row >> 2) & 3u)); \
        const int srow = ((U).blk - 1) * 128 + (int)row; \
        __builtin_amdgcn_global_load_lds((const unsigned*)(c.proj + ((U).tok0 + ((size_t)srow << (U).dsh)) * NP + (col) + ch * 8), (LAS unsigned*)((dst) + 1024 * q), 16, 0, 0); } } while (0)
#define ATT_LOADQ(U) do { const size_t qt = (U).tok0 + ((size_t)((U).blk * 128 + qi) << (U).dsh); \
        _Pragma("unroll") for (int s = 0; s < 4; ++s) qr[s] = *(const u32x4*)(c.proj + qt * NP + (U).qcol + 32 * s + 8 * g); \
        const f32x4* rt = (const f32x4*)(rope_tab + qt * 32 + 8 * (g & 1)); qc0 = rt[0]; qc1 = rt[1]; qs0 = rt[4]; qs1 = rt[5]; \
        int srow = ((U).blk - 1) * 128 + (int)rrow; if (srow < 0) srow += 128; \
        const float* rt2 = rope_tab + ((U).tok0 + ((size_t)srow << (U).dsh)) * 32 + 8 * rps; \
        rc0 = *(const f32x4*)rt2; rc1 = *(const f32x4*)(rt2 + 4); rs0 = *(const f32x4*)(rt2 + 16); rs1 = *(const f32x4*)(rt2 + 20); } while (0)
__device__ __forceinline__ void attn_loop(const Ctx& c, unsigned* qhead, volatile LAS unsigned* mbox, float* lse_buf, const float* qgain, const float* kgain, const float* rope_tab  ) {
    const int tid = c.tid, lane = c.lane, w = c.wave;
    const unsigned NU = (unsigned)(BC * ATT_UNITS_PER_SEQ);
    LAS unsigned char* sK = c.lds; LAS unsigned char* sV = c.lds + 65536;
    LAS float* sRS = (LAS float*)(c.lds + MISC_OFF + 2048);
    const int qq = lane & 15, g = lane >> 4, qi = 16 * w + qq;
    const unsigned rrow = (unsigned)tid >> 1, rps = (unsigned)tid & 1u;
#if defined(PROBE_MASK) && PROBE_MASK
    unsigned long long _ta = __builtin_amdgcn_s_memrealtime();
#define ATT_STAMP(k) do { const unsigned long long _tb = __builtin_amdgcn_s_memrealtime(); if (blockIdx.x == PROBE_BLOCK && tid == 0) ((LAS unsigned*)(c.lds + MISC_OFF + 512))[(k)] += (unsigned)(_tb - _ta); _ta = _tb; } while (0)
#else
#define ATT_STAMP(k) do {} while (0)
#endif
    LAS float* sGQ = (LAS float*)(c.lds + MISC_OFF + 3072); LAS float* sGK = sGQ + 128;
    if (tid < 128) sGQ[tid] = qgain[tid]; else if (tid < 256) sGK[tid - 128] = kgain[tid - 128];
    if (tid == 0) { mbox[0] = __hip_atomic_fetch_add(qhead, 1u, __ATOMIC_RELAXED, __HIP_MEMORY_SCOPE_AGENT); mbox[1] = __hip_atomic_fetch_add(qhead, 1u, __ATOMIC_RELAXED, __HIP_MEMORY_SCOPE_AGENT); }
    __syncthreads();
    unsigned ucur = mbox[0], unxt = mbox[1];
    if (ucur >= NU) return;
    AttU U = att_decode((int)ucur);
    u32x4 qr[4]; f32x4 qc0, qc1, qs0, qs1, rc0, rc1, rs0, rs1;
    __syncthreads();
    ATT_DMA(U, U.kcol, sK); asm volatile("" ::: "memory");
    ATT_LOADQ(U); asm volatile("" ::: "memory");
    ATT_DMA(U, U.vcol, sV); asm volatile("" ::: "memory");
    bool first = true; unsigned nq = 0u;
    for (;;) {
        const int blk = U.blk, dsh = U.dsh, it0 = U.it0;
        const size_t qtok = U.tok0 + ((size_t)(blk * 128 + qi) << dsh);
        bf16x8 qf[4];
        {
            float qv[4][8]; float ss = 0.f;
#pragma unroll
            for (int s = 0; s < 4; ++s) { const unsigned wv[4] = {qr[s].x, qr[s].y, qr[s].z, qr[s].w};
#pragma unroll
                for (int k = 0; k < 4; ++k) { qv[s][2 * k] = bflo(wv[k]); qv[s][2 * k + 1] = bfhi(wv[k]); ss += qv[s][2 * k] * qv[s][2 * k] + qv[s][2 * k + 1] * qv[s][2 * k + 1]; } }
            ss += swz_xor<16>(ss);
            { const auto rr = __builtin_amdgcn_permlane32_swap(__float_as_uint(ss), __float_as_uint(ss), false, false); ss = __uint_as_float(rr[0]) + __uint_as_float(rr[1]); }
            const float rs = rsqf_(ss * (1.f / 128.f) + RMS_EPS);
#pragma unroll
            for (int s = 0; s < 4; ++s) { const f32x4 g0 = *(const LAS f32x4*)(sGQ + 32 * s + 8 * g), g1 = *(const LAS f32x4*)(sGQ + 32 * s + 8 * g + 4);
                const float gg[8] = {g0.x, g0.y, g0.z, g0.w, g1.x, g1.y, g1.z, g1.w};
#pragma unroll
                for (int j = 0; j < 8; ++j) qv[s][j] *= rs * gg[j]; }
            { const float cs8[8] = {qc0.x, qc0.y, qc0.z, qc0.w, qc1.x, qc1.y, qc1.z, qc1.w}, sn8[8] = {qs0.x, qs0.y, qs0.z, qs0.w, qs1.x, qs1.y, qs1.z, qs1.w};
              const float sgn = (g & 2) ? 1.f : -1.f;
#pragma unroll
              for (int j = 0; j < 8; ++j) { const auto rr = __builtin_amdgcn_permlane32_swap(__float_as_uint(qv[0][j]), __float_as_uint(qv[0][j]), false, false);
                  const float other = (g & 2) ? __uint_as_float(rr[0]) : __uint_as_float(rr[1]);
                  qv[0][j] = qv[0][j] * cs8[j] + sgn * other * sn8[j]; } }
#pragma unroll
            for (int s = 0; s < 4; ++s) { u32x4 pw; pw.x = pk2(qv[s][0], qv[s][1]); pw.y = pk2(qv[s][2], qv[s][3]); pw.z = pk2(qv[s][4], qv[s][5]); pw.w = pk2(qv[s][6], qv[s][7]); qf[s] = __builtin_bit_cast(bf16x8, pw); }
        }
        const f32x4 kc0 = rc0, kc1 = rc1, ks0v = rs0, ks1v = rs1;
        if (first) { if (it0) asm volatile("s_waitcnt vmcnt(4)" ::: "memory"); else asm volatile("s_waitcnt vmcnt(8)" ::: "memory"); }
        else       { if (it0) asm volatile("s_waitcnt vmcnt(13)" ::: "memory"); else asm volatile("s_waitcnt vmcnt(17)" ::: "memory"); }
        first = false;
        __syncthreads();
        if (tid == 0) nq = __hip_atomic_fetch_add(qhead, 1u, __ATOMIC_RELAXED, __HIP_MEMORY_SCOPE_AGENT);
        ATT_STAMP(5);
        {
            const int c16 = tid & 15, grp = tid >> 4;
            const f32x4 kg0 = *(const LAS f32x4*)(sGK + 8 * c16), kg1 = *(const LAS f32x4*)(sGK + 8 * c16 + 4);
            const float kg[8] = {kg0.x, kg0.y, kg0.z, kg0.w, kg1.x, kg1.y, kg1.z, kg1.w};
#pragma unroll 4
            for (int it = it0; it < 8; ++it) { const unsigned row = 32u * it + grp;
                LAS u32x4* kp_ = (LAS u32x4*)(sK + offb(row, c16));
                const u32x4 kr = *kp_; const unsigned wv[4] = {kr.x, kr.y, kr.z, kr.w};
                float kv[8]; float ss = 0.f;
#pragma unroll
                for (int k = 0; k < 4; ++k) { kv[2 * k] = bflo(wv[k]); kv[2 * k + 1] = bfhi(wv[k]); ss += kv[2 * k] * kv[2 * k] + kv[2 * k + 1] * kv[2 * k + 1]; }
                ss += swz_xor<1>(ss); ss += swz_xor<2>(ss); ss += swz_xor<4>(ss); ss += swz_xor<8>(ss);
                const float rs = rsqf_(ss * (1.f / 128.f) + RMS_EPS);
                if (c16 == 0) sRS[row] = rs;
                if (c16 >= 4) { u32x4 ko; ko.x = pk2(kv[0] * rs * kg[0], kv[1] * rs * kg[1]); ko.y = pk2(kv[2] * rs * kg[2], kv[3] * rs * kg[3]); ko.z = pk2(kv[4] * rs * kg[4], kv[5] * rs * kg[5]); ko.w = pk2(kv[6] * rs * kg[6], kv[7] * rs * kg[7]); *kp_ = ko; } }
        }
        __syncthreads();
        {
            const f32x4 ga0 = *(const LAS f32x4*)(sGK + 8 * rps), ga1 = *(const LAS f32x4*)(sGK + 8 * rps + 4), gb0 = *(const LAS f32x4*)(sGK + 16 + 8 * rps), gb1 = *(const LAS f32x4*)(sGK + 20 + 8 * rps);
            const float ga[8] = {ga0.x, ga0.y, ga0.z, ga0.w, ga1.x, ga1.y, ga1.z, ga1.w}, gb[8] = {gb0.x, gb0.y, gb0.z, gb0.w, gb1.x, gb1.y, gb1.z, gb1.w};
            const float cs8[8] = {kc0.x, kc0.y, kc0.z, kc0.w, kc1.x, kc1.y, kc1.z, kc1.w}, sn8[8] = {ks0v.x, ks0v.y, ks0v.z, ks0v.w, ks1v.x, ks1v.y, ks1v.z, ks1v.w};
            if (blk > 0 || rrow >= 128u) {
            LAS u32x4* p1 = (LAS u32x4*)(sK + offb(rrow, rps)); LAS u32x4* p2 = (LAS u32x4*)(sK + offb(rrow, rps + 2));
            const u32x4 a = *p1, b2 = *p2; const float rs = sRS[rrow];
            const unsigned wa[4] = {a.x, a.y, a.z, a.w}, wb[4] = {b2.x, b2.y, b2.z, b2.w};
            float o1[8], o2[8];
#pragma unroll
            for (int k = 0; k < 4; ++k) {
#pragma unroll
                for (int e = 0; e < 2; ++e) { const int j = 2 * k + e; const float x1 = (e ? bfhi(wa[k]) : bflo(wa[k])) * rs * ga[j], x2 = (e ? bfhi(wb[k]) : bflo(wb[k])) * rs * gb[j];
                    o1[j] = x1 * cs8[j] - x2 * sn8[j]; o2[j] = x2 * cs8[j] + x1 * sn8[j]; } }
            u32x4 w1, w2; w1.x = pk2(o1[0], o1[1]); w1.y = pk2(o1[2], o1[3]); w1.z = pk2(o1[4], o1[5]); w1.w = pk2(o1[6], o1[7]); w2.x = pk2(o2[0], o2[1]); w2.y = pk2(o2[2], o2[3]); w2.z = pk2(o2[4], o2[5]); w2.w = pk2(o2[6], o2[7]);
            *p1 = w1; *p2 = w2; }
        }
        __syncthreads();
        ATT_STAMP(6);
        const int ks0 = w >> 1, nskip = blk == 0 ? 4 : 0;
        f32x4 st[5][2];
        const unsigned krow_l = 8u * (qq >> 2) + (qq & 3u);
        LAS unsigned char* ka[2][4];
#pragma unroll
        for (int T = 0; T < 2; ++T)
#pragma unroll
            for (int s = 0; s < 4; ++s) ka[T][s] = sK + offb(32u * ks0 + krow_l + 4u * T, 4 * s + g);
#pragma unroll
        for (int n = 0; n < 5; ++n)
#pragma unroll
            for (int T = 0; T < 2; ++T) { f32x4 a = {0.f, 0.f, 0.f, 0.f};
                if (ks0 + n >= nskip) {
#pragma unroll
                for (int s = 0; s < 4; ++s) { const bf16x8 kf = *(const LAS bf16x8*)(ka[T][s] + 8192 * n); a = __builtin_amdgcn_mfma_f32_16x16x32_bf16(kf, qf[s], a, 0, 0, 0); } }
                st[n][T] = a; }
        asm volatile("s_waitcnt vmcnt(0) lgkmcnt(0)" ::: "memory");
        if (tid == 0) mbox[0] = nq;
        __syncthreads();
        const bool has_next = unxt < NU;
        AttU UN = att_decode(has_next ? (int)unxt : 0);
        if (has_next) { ATT_DMA(UN, UN.kcol, sK); asm volatile("" ::: "memory"); ATT_LOADQ(UN); }
        asm volatile("" ::: "memory");
        const float SC = 0.08838834764831845f * 1.4426950408889634f;
        float mx = -INFINITY;
#pragma unroll
        for (int n = 0; n < 5; ++n)
#pragma unroll
            for (int T = 0; T < 2; ++T)
#pragma unroll
                for (int i = 0; i < 4; ++i) { const int kj = 32 * (ks0 + n) + 8 * g + 4 * T + i;
                    bool ok = true;
                    if (n == 0) ok = kj >= qi;
                    if (n == 4) ok = kj <= qi + 128;
                    if (blk == 0) ok = ok && (kj >= 128);
                    const float v = ok ? st[n][T][i] : -INFINITY; st[n][T][i] = v; mx = fmaxf(mx, v); }
        mx = fmaxf(mx, swz_xor<16>(mx));
        { const auto rr = __builtin_amdgcn_permlane32_swap(__float_as_uint(mx), __float_as_uint(mx), false, false); mx = fmaxf(__uint_as_float(rr[0]), __uint_as_float(rr[1])); }
        float sum = 0.f; const float mxs = mx * SC;
#pragma unroll
        for (int n = 0; n < 5; ++n)
#pragma unroll
            for (int T = 0; T < 2; ++T)
#pragma unroll
                for (int i = 0; i < 4; ++i) { const float e = __builtin_amdgcn_exp2f(__builtin_fmaf(st[n][T][i], SC, -mxs)); st[n][T][i] = e; sum += e; }
        sum += swz_xor<16>(sum);
        { const auto rr = __builtin_amdgcn_permlane32_swap(__float_as_uint(sum), __float_as_uint(sum), false, false); sum = __uint_as_float(rr[0]) + __uint_as_float(rr[1]); }
        const float inv = rcpf_(sum);
        ATT_STAMP(7);
        f32x4 ot[8];
#pragma unroll
        for (int cc = 0; cc < 8; ++cc) ot[cc] = (f32x4){0.f, 0.f, 0.f, 0.f};
        const unsigned tq = (unsigned)qq >> 2, tp = (unsigned)qq & 3u;
        const unsigned vbase = (unsigned)(size_t)sV;
        unsigned va[2][8];
#pragma unroll
        for (int t = 0; t < 2; ++t)
#pragma unroll
            for (int cc = 0; cc < 8; ++cc) va[t][cc] = vbase + offb(32u * ks0 + 8u * g + 4u * t + tq, 2 * cc + (tp >> 1)) + 8u * (tp & 1u);
#pragma unroll
        for (int n = 0; n < 5; ++n) if (ks0 + n >= nskip) {
            u32x4 pw; pw.x = pk2(st[n][0][0], st[n][0][1]); pw.y = pk2(st[n][0][2], st[n][0][3]); pw.z = pk2(st[n][1][0], st[n][1][1]); pw.w = pk2(st[n][1][2], st[n][1][3]);
            const bf16x8 pf = __builtin_bit_cast(bf16x8, pw);
            u16x4 v0[8], v1[8];
            asm volatile("ds_read_b64_tr_b16 %0, %16 offset:%32\n\tds_read_b64_tr_b16 %8, %24 offset:%32\n\t"
                         "ds_read_b64_tr_b16 %1, %17 offset:%32\n\tds_read_b64_tr_b16 %9, %25 offset:%32\n\t"
                         "ds_read_b64_tr_b16 %2, %18 offset:%32\n\tds_read_b64_tr_b16 %10, %26 offset:%32\n\t"
                         "ds_read_b64_tr_b16 %3, %19 offset:%32\n\tds_read_b64_tr_b16 %11, %27 offset:%32\n\t"
                         "ds_read_b64_tr_b16 %4, %20 offset:%32\n\tds_read_b64_tr_b16 %12, %28 offset:%32\n\t"
                         "ds_read_b64_tr_b16 %5, %21 offset:%32\n\tds_read_b64_tr_b16 %13, %29 offset:%32\n\t"
                         "ds_read_b64_tr_b16 %6, %22 offset:%32\n\tds_read_b64_tr_b16 %14, %30 offset:%32\n\t"
                         "ds_read_b64_tr_b16 %7, %23 offset:%32\n\tds_read_b64_tr_b16 %15, %31 offset:%32\n\t"
                         "s_waitcnt lgkmcnt(0)"
                         : "=&v"(v0[0]), "=&v"(v0[1]), "=&v"(v0[2]), "=&v"(v0[3]), "=&v"(v0[4]), "=&v"(v0[5]), "=&v"(v0[6]), "=&v"(v0[7]),
                           "=&v"(v1[0]), "=&v"(v1[1]), "=&v"(v1[2]), "=&v"(v1[3]), "=&v"(v1[4]), "=&v"(v1[5]), "=&v"(v1[6]), "=&v"(v1[7])
                         : "v"(va[0][0]), "v"(va[0][1]), "v"(va[0][2]), "v"(va[0][3]), "v"(va[0][4]), "v"(va[0][5]), "v"(va[0][6]), "v"(va[0][7]),
                           "v"(va[1][0]), "v"(va[1][1]), "v"(va[1][2]), "v"(va[1][3]), "v"(va[1][4]), "v"(va[1][5]), "v"(va[1][6]), "v"(va[1][7]), "i"(8192 * n) : "memory");
#pragma unroll
            for (int cc = 0; cc < 8; ++cc) {
                bf16x8 vf; vf[0] = (short)v0[cc][0]; vf[1] = (short)v0[cc][1]; vf[2] = (short)v0[cc][2]; vf[3] = (short)v0[cc][3]; vf[4] = (short)v1[cc][0]; vf[5] = (short)v1[cc][1]; vf[6] = (short)v1[cc][2]; vf[7] = (short)v1[cc][3];
                ot[cc] = __builtin_amdgcn_mfma_f32_16x16x32_bf16(vf, pf, ot[cc], 0, 0, 0);
            }
        }
        __syncthreads();
        asm volatile("" ::: "memory");
        if (has_next) ATT_DMA(UN, UN.vcol, sV);
        asm volatile("" ::: "memory");
        bf16_t* orow = c.proj + qtok * NP + U.qcol;
#pragma unroll
        for (int cc = 0; cc < 8; ++cc) { u32x2 o; o.x = pk2(ot[cc][0] * inv, ot[cc][1] * inv); o.y = pk2(ot[cc][2] * inv, ot[cc][3] * inv); *(u32x2*)(orow + 16 * cc + 4 * g) = o; }
        if (g == 0) lse_buf[qtok * 12 + U.p * 4 + U.h] = mx * 0.08838834764831845f + __logf(sum);
        ATT_STAMP(8);
        if (!has_next) break;
        U = UN; unxt = mbox[0];
    }
    asm volatile("s_waitcnt vmcnt(0)" ::: "memory");
    __syncthreads();
}
#undef ATT_STAMP
#undef ATT_DMA
#undef ATT_LOADQ

__device__ __forceinline__ void phase_attn_combine(const Ctx& c, const float* lse_buf) {
    const int gw = c.bid * NWAVES + c.wave, NGW = c.G * NWAVES, lane = c.lane;
    constexpr int NR = 2;
    for (int tok0 = gw; tok0 < TC; tok0 += NR * NGW) {
        unsigned u[NR][3][4]; float l[NR][12];
#pragma unroll
        for (int r = 0; r < NR; ++r) { const int tok = tok0 + r * NGW;
            const float* ls = lse_buf + (size_t)tok * 12; const bf16_t* row = c.proj + (size_t)tok * NP + C_QKV;
#pragma unroll
            for (int k = 0; k < 12; ++k) l[r][k] = ls[k];
#pragma unroll
            for (int p = 0; p < 3; ++p)
#pragma unroll
                for (int h = 0; h < 4; ++h) u[r][p][h] = *((const unsigned*)(row + (4 * p + h) * 128) + lane); }
#pragma unroll
        for (int r = 0; r < NR; ++r) { const int tok = tok0 + r * NGW;
#pragma unroll
            for (int h = 0; h < 4; ++h) {
                const float l0 = l[r][h], l1 = l[r][4 + h], l2 = l[r][8 + h], ml = fmaxf(l0, fmaxf(l1, l2));
                const float w0 = __expf(l0 - ml), w1 = __expf(l1 - ml), w2 = __expf(l2 - ml), wi = rcpf_(w0 + w1 + w2);
                *((unsigned*)(c.proj + (size_t)tok * NP + C_QKV + h * 128) + lane) =
                    pk2((w0 * bflo(u[r][0][h]) + w1 * bflo(u[r][1][h]) + w2 * bflo(u[r][2][h])) * wi, (w0 * bfhi(u[r][0][h]) + w1 * bfhi(u[r][1][h]) + w2 * bfhi(u[r][2][h])) * wi);
            } }
    }
}

__device__ __forceinline__ int crow(int reg, int hh) { return (reg & 3) + 8 * (reg >> 2) + 4 * hh; }
typedef float f32x16 __attribute__((ext_vector_type(16)));
__device__ __forceinline__ unsigned tr_addr32(unsigned lane, unsigned rowbase, unsigned cblk, unsigned t, bool perm) {
    const unsigned hh = lane >> 5, blk = (lane >> 4) & 1u, q = (lane & 15u) >> 2, p = lane & 3u;
    const unsigned row = rowbase + (perm ? 8u * t + 4u * hh : 8u * hh + 4u * t) + q;
    return offb(row, 4u * cblk + 2u * blk + (p >> 1)) + 8u * (p & 1u);
}
__device__ __forceinline__ bf16x8 tr_frag(unsigned a0, unsigned a1) {
    u16x4 v0, v1;
    asm volatile("ds_read_b64_tr_b16 %0, %2\n\tds_read_b64_tr_b16 %1, %3\n\ts_waitcnt lgkmcnt(0)" : "=&v"(v0), "=&v"(v1) : "v"(a0), "v"(a1) : "memory");
    bf16x8 f; f[0] = (short)v0[0]; f[1] = (short)v0[1]; f[2] = (short)v0[2]; f[3] = (short)v0[3]; f[4] = (short)v1[0]; f[5] = (short)v1[1]; f[6] = (short)v1[2]; f[7] = (short)v1[3];
    return f;
}
__device__ __forceinline__ void tr_frag4(const unsigned (&a)[8], bf16x8 (&f)[4]) {
    u16x4 v[8];
    asm volatile("ds_read_b64_tr_b16 %0, %8\n\tds_read_b64_tr_b16 %1, %9\n\tds_read_b64_tr_b16 %2, %10\n\tds_read_b64_tr_b16 %3, %11\n\t"
                 "ds_read_b64_tr_b16 %4, %12\n\tds_read_b64_tr_b16 %5, %13\n\tds_read_b64_tr_b16 %6, %14\n\tds_read_b64_tr_b16 %7, %15\n\ts_waitcnt lgkmcnt(0)"
                 : "=&v"(v[0]), "=&v"(v[1]), "=&v"(v[2]), "=&v"(v[3]), "=&v"(v[4]), "=&v"(v[5]), "=&v"(v[6]), "=&v"(v[7])
                 : "v"(a[0]), "v"(a[1]), "v"(a[2]), "v"(a[3]), "v"(a[4]), "v"(a[5]), "v"(a[6]), "v"(a[7]) : "memory");
#pragma unroll
    for (int k = 0; k < 4; ++k) { f[k][0] = (short)v[2 * k][0]; f[k][1] = (short)v[2 * k][1]; f[k][2] = (short)v[2 * k][2]; f[k][3] = (short)v[2 * k][3];
        f[k][4] = (short)v[2 * k + 1][0]; f[k][5] = (short)v[2 * k + 1][1]; f[k][6] = (short)v[2 * k + 1][2]; f[k][7] = (short)v[2 * k + 1][3]; }
}
constexpr int GLA_QK = 0, GLA_KD = 16384, GLA_V = 32768  , GLA_ST = 65536  , GLA_O = 102400  , GLA_SEG = 136192  , GLA_DEC = 138240  ;
static_assert(GLA_DEC + 256 <= RING_BYTES, "gla lds");
__device__ __forceinline__ void gla_unit(const Ctx& c, int unit, const float* gbias, const float* ogain) {
    const int tid = c.tid, lane = c.lane, w = c.wave;
    const int b = unit >> 2, h = unit & 3;
    LAS unsigned char* L = c.lds;
    const unsigned hh = lane >> 5, r31 = lane & 31;
    const int ti = w >> 2, tv = w & 3;
    f32x16 St;
#pragma unroll
    for (int i = 0; i < 16; ++i) St[i] = 0.f;
    for (int i = tid; i < 18432 / 4; i += NTHR) ((LAS unsigned*)(L + GLA_ST))[i] = 0u;
    const float bias_d = gbias[h * 64 + lane];
    const int i3 = tid >> 3, seg = tid & 7;
    float gn[16];
#pragma unroll
    for (int k = 0; k < 16; ++k) gn[k] = ogain[16 * seg + k];
    const size_t tokb = (size_t)b * SEQ;
    unsigned short pq[8], pk[8], pg[8];
    u32x4 ogc0, ogc1, ogn0, ogn1;
#define GLA_PREFETCH(n) do { _Pragma("unroll") for (int rr = 0; rr < 8; ++rr) { const bf16_t* row = c.proj + (tokb + (n) * 64 + 8 * w + rr) * NP + h * 64 + lane; \
        pq[rr] = row[C_QA]; pk[rr] = row[C_KA]; pg[rr] = row[C_GP]; } } while (0)
#define GLA_OG(n, d0, d1) do { const bf16_t* ogp = c.proj + (tokb + (n) * 64 + i3) * NP + C_OG + h * 128 + 16 * seg; d0 = *(const u32x4*)ogp; d1 = *((const u32x4*)ogp + 1); } while (0)
#define GLA_VDMA(n) do { _Pragma("unroll") for (int it = 0; it < 2; ++it) { const int q = w + 8 * it; const unsigned nn = 64u * q + lane, row = nn >> 4, cs = nn & 15u, ch = cs ^ (((row & 3u) << 2) | ((row >> 2) & 3u)); \
        __builtin_amdgcn_global_load_lds((const unsigned*)(c.proj + (tokb + (n) * 64 + row) * NP + C_VA + h * 128 + ch * 8), (LAS unsigned*)(L + GLA_V + ((n) & 1) * 16384 + 1024 * q), 16, 0, 0); } } while (0)
#define CB() asm volatile("" ::: "memory")
    GLA_PREFETCH(0); CB(); GLA_OG(0, ogc0, ogc1); CB(); GLA_VDMA(0); CB(); GLA_VDMA(1); CB();
    for (int n = 0; n < SEQ / 64; ++n) {
        LAS unsigned char* STr = L + GLA_ST + (n & 1) * 18432; LAS unsigned char* STw = L + GLA_ST + ((n + 1) & 1) * 18432;
        LAS unsigned char* Vb = L + GLA_V + (n & 1) * 16384;
        float cl[8], qv[8], kv[8];
        { float run = 0.f;
#pragma unroll
          for (int rr = 0; rr < 8; ++rr) { const float g = bf2f(pg[rr]) + bias_d; run += (fminf(g, 0.f) - __logf(1.f + __expf(-fabsf(g)))) * (1.f / 16.f); cl[rr] = run; qv[rr] = bf2f(pq[rr]); kv[rr] = bf2f(pk[rr]); }
          ((LAS float*)(L + GLA_SEG))[w * 64 + lane] = run; }
        __syncthreads();
        { float pre = 0.f, tot = 0.f;
#pragma unroll
          for (int s = 0; s < 8; ++s) { const float v = ((LAS float*)(L + GLA_SEG))[s * 64 + lane]; tot += v; pre += (s < w) ? v : 0.f; }
          const float etot = __expf(tot);
          if (w == 0) ((LAS float*)(L + GLA_DEC))[lane] = etot;
#pragma unroll
          for (int rr = 0; rr < 8; ++rr) { const float cum = pre + cl[rr]; const unsigned row = 8 * w + rr;
              const float e = __expf(cum), ei = rcpf_(e), ed = etot * ei;
              const unsigned o1 = offb(row, lane >> 3) + (lane & 7) * 2, o2 = offb(row, 8 + (lane >> 3)) + (lane & 7) * 2;
              *(LAS unsigned short*)(L + GLA_QK + o1) = (unsigned short)f2bf(qv[rr] * e);
              *(LAS unsigned short*)(L + GLA_QK + o2) = (unsigned short)f2bf(kv[rr] * ei);
              *(LAS unsigned short*)(L + GLA_KD + o1) = (unsigned short)f2bf(kv[rr] * ed); } }
        if (n == 0) asm volatile("s_waitcnt vmcnt(2)" ::: "memory"); else asm volatile("s_waitcnt vmcnt(4)" ::: "memory");
        __syncthreads();
        CB();
        if (n + 1 < SEQ / 64) { GLA_OG(n + 1, ogn0, ogn1); CB(); GLA_PREFETCH(n + 1); }
        CB();
        bf16x8 qdf[4];
#pragma unroll
        for (int s = 0; s < 4; ++s) qdf[s] = *(const LAS bf16x8*)(L + GLA_QK + offb(32 * ti + r31, 2 * s + hh));
        f32x16 Z;
#pragma unroll
        for (int i = 0; i < 16; ++i) Z[i] = 0.f;
        { bf16x8 sf[4];
#pragma unroll
          for (int s = 0; s < 4; ++s) sf[s] = *(const LAS bf16x8*)(STr + (32 * tv + r31) * 144 + 32 * s + 16 * hh);
#pragma unroll
          for (int s = 0; s < 4; ++s) Z = __builtin_amdgcn_mfma_f32_32x32x16_bf16(qdf[s], sf[s], Z, 0, 0, 0); }
        const unsigned vb = (unsigned)(size_t)Vb;
#pragma unroll
        for (int tj = 0; tj < 2; ++tj) {
            if (tj <= ti) {
                bf16x8 kf[4];
#pragma unroll
                for (int s = 0; s < 4; ++s) kf[s] = *(const LAS bf16x8*)(L + GLA_QK + offb(32 * tj + r31, 8 + 2 * s + hh));
                unsigned va[8]; bf16x8 vf[4];
#pragma unroll
                for (int s = 0; s < 2; ++s) { va[2 * s] = vb + tr_addr32(lane, 32 * tj + 16 * s, tv, 0, true); va[2 * s + 1] = vb + tr_addr32(lane, 32 * tj + 16 * s, tv, 1, true);
                    va[4 + 2 * s] = va[2 * s]; va[5 + 2 * s] = va[2 * s + 1]; }
                tr_frag4(va, vf);
                f32x16 X;
#pragma unroll
                for (int i = 0; i < 16; ++i) X[i] = 0.f;
#pragma unroll
                for (int s = 0; s < 4; ++s) X = __builtin_amdgcn_mfma_f32_32x32x16_bf16(kf[s], qdf[s], X, 0, 0, 0);
                const int ig = 32 * ti + (int)r31;
#pragma unroll
                for (int i = 0; i < 16; ++i) X[i] = (ig >= 32 * tj + crow(i, hh)) ? X[i] : 0.f;
#pragma unroll
                for (int s = 0; s < 2; ++s) {
                    u32x4 pw; pw.x = pg8::cvt_pk_bf16(X[8 * s + 0], X[8 * s + 1]); pw.y = pg8::cvt_pk_bf16(X[8 * s + 2], X[8 * s + 3]); pw.z = pg8::cvt_pk_bf16(X[8 * s + 4], X[8 * s + 5]); pw.w = pg8::cvt_pk_bf16(X[8 * s + 6], X[8 * s + 7]);
                    Z = __builtin_amdgcn_mfma_f32_32x32x16_bf16(__builtin_bit_cast(bf16x8, pw), vf[s], Z, 0, 0, 0);
                }
            }
        }
#pragma unroll
        for (int i = 0; i < 16; ++i) ((LAS float*)(L + GLA_O))[(32 * ti + crow(i, hh)) * 132 + 32 * tv + r31] = Z[i];
        { const unsigned kb = (unsigned)(size_t)(L + GLA_KD);
          unsigned aa[8], ab[8]; bf16x8 af[4], bfr[4];
#pragma unroll
          for (int s = 0; s < 4; ++s) { aa[2 * s] = kb + tr_addr32(lane, 16 * s, ti, 0, false); aa[2 * s + 1] = kb + tr_addr32(lane, 16 * s, ti, 1, false);
              ab[2 * s] = vb + tr_addr32(lane, 16 * s, tv, 0, false); ab[2 * s + 1] = vb + tr_addr32(lane, 16 * s, tv, 1, false); }
          tr_frag4(aa, af); tr_frag4(ab, bfr);
#pragma unroll
          for (int i = 0; i < 16; ++i) St[i] *= ((LAS float*)(L + GLA_DEC))[32 * ti + crow(i, hh)];
#pragma unroll
          for (int s = 0; s < 4; ++s) St = __builtin_amdgcn_mfma_f32_32x32x16_bf16(af[s], bfr[s], St, 0, 0, 0); }
#pragma unroll
        for (int gq = 0; gq < 4; ++gq) { const float s0 = St[4 * gq], s1 = St[4 * gq + 1], s2 = St[4 * gq + 2], s3 = St[4 * gq + 3];
            u32x2 o; o.x = pk2(s0, s1); o.y = pk2(s2, s3);
            *(LAS u32x2*)(STw + (32 * tv + r31) * 144 + (32 * ti + 8 * gq + 4 * hh) * 2) = o; }
        __syncthreads();
        CB();
        if (n + 2 < SEQ / 64) GLA_VDMA(n + 2);
        CB();
        { const LAS f32x4* op = (const LAS f32x4*)(L + GLA_O + i3 * 528 + seg * 64);
          f32x4 o4[4]; float ss = 0.f;
#pragma unroll
          for (int k = 0; k < 4; ++k) { o4[k] = op[k]; ss += (o4[k].x * o4[k].x + o4[k].y * o4[k].y) + (o4[k].z * o4[k].z + o4[k].w * o4[k].w); }
          ss += swz_xor<1>(ss); ss += swz_xor<2>(ss); ss += swz_xor<4>(ss);
          const float rs = rsqf_(ss * (1.f / 128.f) + RMS_EPS);
          const unsigned ogw[8] = {ogc0.x, ogc0.y, ogc0.z, ogc0.w, ogc1.x, ogc1.y, ogc1.z, ogc1.w};
          unsigned ow[8];
#pragma unroll
          for (int k = 0; k < 8; ++k) { const float g0 = bflo(ogw[k]), g1 = bfhi(ogw[k]);
              const float a0 = o4[k >> 1][(2 * k) & 3] * rs * gn[2 * k] * g0 * sigmoidf_(g0), a1 = o4[k >> 1][(2 * k + 1) & 3] * rs * gn[2 * k + 1] * g1 * sigmoidf_(g1);
              ow[k] = pk2(a0, a1); }
          u32x4 w0, w1; w0.x = ow[0]; w0.y = ow[1]; w0.z = ow[2]; w0.w = ow[3]; w1.x = ow[4]; w1.y = ow[5]; w1.z = ow[6]; w1.w = ow[7];
          bf16_t* dst = c.proj + (tokb + n * 64 + i3) * NP + C_OG + h * 128 + 16 * seg;
          *(u32x4*)dst = w0; *((u32x4*)dst + 1) = w1; }
        CB();
        ogc0 = ogn0; ogc1 = ogn1;
    }
    asm volatile("s_waitcnt vmcnt(0)" ::: "memory");
    __syncthreads();
#undef GLA_PREFETCH
#undef GLA_OG
#undef GLA_VDMA
#undef CB
}

constexpr int LRU_X = 0  , LRU_R = 16384  , LRU_I = 32768, LRU_SP = 49152  , LRU_SH = 51200;
__device__ __forceinline__ void lru_unit(const Ctx& c, int unit, const float* convw, const float* convb, const float* wa_, const float* ba_, const float* wx_, const float* bx_, const float* lam_) {
    const int lane = c.lane, w = c.wave;
    const int b = unit >> 3, nb = unit & 7, ch = nb * 64 + lane;
    LAS unsigned char* L = c.lds;
    const unsigned hh = lane >> 5, r31 = lane & 31;
    const int gate = w >> 2, tt = (w >> 1) & 1, td = w & 1;
    bf16x8 wf[4];
    { const float* W = (gate ? wx_ : wa_) + (size_t)nb * 4096 + 32 * td + r31;
#pragma unroll
      for (int s = 0; s < 4; ++s) { float t8[8];
#pragma unroll
          for (int jj = 0; jj < 8; ++jj) t8[jj] = W[(16 * s + 8 * hh + jj) * 64];
          u32x4 pw; pw.x = pk2(t8[0], t8[1]); pw.y = pk2(t8[2], t8[3]); pw.z = pk2(t8[4], t8[5]); pw.w = pk2(t8[6], t8[7]); wf[s] = __builtin_bit_cast(bf16x8, pw); } }
    const float gbias = (gate ? bx_ : ba_)[nb * 64 + 32 * td + r31];
    const float cw0 = convw[ch], cw1 = convw[512 + ch], cw2 = convw[1024 + ch], cw3 = convw[1536 + ch], cb = convb[ch];
    const float lam = lam_[ch]; const float c8 = 8.f * (fmaxf(-lam, 0.f) + log1pf(__expf(-fabsf(lam))));
    const size_t tokb = (size_t)b * SEQ;
    unsigned short px[11], py[8];
#define LRU_PREFETCH(n) do { _Pragma("unroll") for (int rr = 0; rr < 11; ++rr) { const int t = (n) * 64 + 8 * w + rr - 3; px[rr] = t >= 0 ? c.proj[(tokb + t) * NP + C_XB + ch] : (unsigned short)0; } \
        _Pragma("unroll") for (int rr = 0; rr < 8; ++rr) py[rr] = c.proj[(tokb + (n) * 64 + 8 * w + rr) * NP + C_YB + ch]; } while (0)
    LRU_PREFETCH(0);
    float hcarry = 0.f;
    for (int n = 0; n < SEQ / 64; ++n) {
        float xc[8], yv[8];
        { float xr[11];
#pragma unroll
          for (int rr = 0; rr < 11; ++rr) xr[rr] = bf2f(px[rr]);
#pragma unroll
          for (int rr = 0; rr < 8; ++rr) { xc[rr] = cb + cw0 * xr[rr] + cw1 * xr[rr + 1] + cw2 * xr[rr + 2] + cw3 * xr[rr + 3]; yv[rr] = bf2f(py[rr]);
              *(LAS unsigned short*)(L + LRU_X + offb(8 * w + rr, lane >> 3) + (lane & 7) * 2) = (unsigned short)f2bf(xc[rr]); } }
        __syncthreads();
        if (n + 1 < SEQ / 64) LRU_PREFETCH(n + 1);
        { f32x16 Z;
#pragma unroll
          for (int i = 0; i < 16; ++i) Z[i] = 0.f;
#pragma unroll
          for (int s = 0; s < 4; ++s) { const bf16x8 af = *(const LAS bf16x8*)(L + LRU_X + offb(32 * tt + r31, 2 * s + hh)); Z = __builtin_amdgcn_mfma_f32_32x32x16_bf16(af, wf[s], Z, 0, 0, 0); }
          LAS float* dst = (LAS float*)(L + (gate ? LRU_I : LRU_R));
#pragma unroll
          for (int i = 0; i < 16; ++i) dst[(32 * tt + crow(i, hh)) * 64 + 32 * td + r31] = sigmoidf_(Z[i] + gbias); }
        __syncthreads();
        float hl[8], pc[8];
        { float hrun = 0.f, prun = 1.f;
#pragma unroll
          for (int rr = 0; rr < 8; ++rr) { const float r = ((const LAS float*)(L + LRU_R))[(8 * w + rr) * 64 + lane], ig = ((const LAS float*)(L + LRU_I))[(8 * w + rr) * 64 + lane];
              const float a = __expf(-c8 * r), u = __builtin_amdgcn_sqrtf(fmaxf(1.f - a * a, 0.f)) * ig * xc[rr];
              hrun = a * hrun + u; prun *= a; hl[rr] = hrun; pc[rr] = prun; }
          ((LAS float*)(L + LRU_SP))[w * 64 + lane] = prun; ((LAS float*)(L + LRU_SH))[w * 64 + lane] = hrun; }
        __syncthreads();
        { float hin = hcarry, hall = hcarry;
#pragma unroll
          for (int s = 0; s < 8; ++s) { const float P = ((const LAS float*)(L + LRU_SP))[s * 64 + lane], H = ((const LAS float*)(L + LRU_SH))[s * 64 + lane];
              hall = P * hall + H; hin = (s < w) ? hall : hin; }
          hcarry = hall;
#pragma unroll
          for (int rr = 0; rr < 8; ++rr) { const float hv = hl[rr] + pc[rr] * hin;
              c.proj[(tokb + n * 64 + 8 * w + rr) * NP + C_YB + ch] = (bf16_t)f2bf(hv * gelu_tanh(yv[rr])); } }
    }
    __syncthreads();
#undef LRU_PREFETCH
}

constexpr int TPB = TT / 256;
constexpr int RW_STRIDE = 1032;
__device__ __forceinline__ void phase_router(const Ctx& c, const float* gain, const float* rw, const float* rb, unsigned* gcnt) {
    LAS bf16_t* sWh = (LAS bf16_t*)c.lds;
    LAS bf16_t* sWl = sWh + 16 * RW_STRIDE;
    LAS float* sGn = (LAS float*)(c.lds + 69632);
    LAS unsigned* sRec = (LAS unsigned*)(c.lds + 73728);
    LAS unsigned* sCnt = (LAS unsigned*)(c.lds + MISC_OFF + 256);
    LAS unsigned* sBase = sCnt + 16;
    const int tid = c.tid, lane = c.lane, w = c.wave;
    for (int idx = tid; idx < D * NE; idx += NTHR) { const int e = idx >> 10, k = idx & 1023; const float v = rw[k * 16 + e] * gain[k];
        const unsigned hi = f2bf(v); const float lo = v - bflo(hi); sWh[e * RW_STRIDE + k] = (bf16_t)hi; sWl[e * RW_STRIDE + k] = (bf16_t)f2bf(lo); }
    for (int idx = tid; idx < D; idx += NTHR) sGn[idx] = gain[idx];
    if (tid < 16) sCnt[tid] = 0u;
    __syncthreads();
    const int t = lane & 15, g = lane >> 4;
#pragma unroll 1
    for (int sub = 0; sub < TPB / 128; ++sub) {
    const int lt = sub * 128 + w * 16 + t, tok = c.bid * TPB + lt;
    const float* xrow = c.xof + (size_t)tok * D + 8 * g;
    f32x4 acc = {0.f, 0.f, 0.f, 0.f}; float ss = 0.f;
    f32x4 xn[8];
#pragma unroll
    for (int j = 0; j < 4; ++j) { xn[2 * j] = *(const f32x4*)(xrow + 32 * j); xn[2 * j + 1] = *(const f32x4*)(xrow + 32 * j + 4); }
#pragma unroll 1
    for (int s4 = 0; s4 < 8; ++s4) {
        f32x4 xc[8];
#pragma unroll
        for (int j = 0; j < 8; ++j) xc[j] = xn[j];
        if (s4 + 1 < 8) {
#pragma unroll
            for (int j = 0; j < 4; ++j) { xn[2 * j] = *(const f32x4*)(xrow + 32 * (4 * s4 + 4 + j)); xn[2 * j + 1] = *(const f32x4*)(xrow + 32 * (4 * s4 + 4 + j) + 4); } }
#pragma unroll
        for (int j = 0; j < 4; ++j) { const int s = 4 * s4 + j;
            const f32x4 x0 = xc[2 * j], x1 = xc[2 * j + 1];
            const float xv[8] = {x0.x, x0.y, x0.z, x0.w, x1.x, x1.y, x1.z, x1.w};
            unsigned hw[4], lw[4];
#pragma unroll
            for (int k = 0; k < 4; ++k) { const float a = xv[2 * k], b = xv[2 * k + 1]; ss += a * a + b * b; const unsigned h2 = pk2(a, b); hw[k] = h2; lw[k] = pk2(a - bflo(h2), b - bfhi(h2)); }
            u32x4 bhv, blv; bhv.x = hw[0]; bhv.y = hw[1]; bhv.z = hw[2]; bhv.w = hw[3]; blv.x = lw[0]; blv.y = lw[1]; blv.z = lw[2]; blv.w = lw[3];
            const bf16x8 bh = __builtin_bit_cast(bf16x8, bhv), bl = __builtin_bit_cast(bf16x8, blv);
            const bf16x8 ah = *(const LAS bf16x8*)(sWh + t * RW_STRIDE + 32 * s + 8 * g), al = *(const LAS bf16x8*)(sWl + t * RW_STRIDE + 32 * s + 8 * g);
            acc = __builtin_amdgcn_mfma_f32_16x16x32_bf16(ah, bh, acc, 0, 0, 0);
            acc = __builtin_amdgcn_mfma_f32_16x16x32_bf16(al, bh, acc, 0, 0, 0);
            acc = __builtin_amdgcn_mfma_f32_16x16x32_bf16(ah, bl, acc, 0, 0, 0); }
    }
    ss += swz_xor<16>(ss);
    { const auto r = __builtin_amdgcn_permlane32_swap(__float_as_uint(ss), __float_as_uint(ss), false, false); ss = __uint_as_float(r[0]) + __uint_as_float(r[1]); }
    const float rs = rsqf_(ss * (1.f / D) + RMS_EPS);
    float sc[4]; float mx = -INFINITY;
#pragma unroll
    for (int i = 0; i < 4; ++i) { sc[i] = acc[i] * rs + rb[4 * g + i]; mx = fmaxf(mx, sc[i]); }
    mx = fmaxf(mx, swz_xor<16>(mx));
    { const auto r = __builtin_amdgcn_permlane32_swap(__float_as_uint(mx), __float_as_uint(mx), false, false); mx = fmaxf(__uint_as_float(r[0]), __uint_as_float(r[1])); }
    float sum = 0.f;
#pragma unroll
    for (int i = 0; i < 4; ++i) { sc[i] = __expf(sc[i] - mx); sum += sc[i]; }
    sum += swz_xor<16>(sum);
    { const auto r = __builtin_amdgcn_permlane32_swap(__float_as_uint(sum), __float_as_uint(sum), false, false); sum = __uint_as_float(r[0]) + __uint_as_float(r[1]); }
    const float isum = rcpf_(sum);
#pragma unroll
    for (int i = 0; i < 4; ++i) sc[i] *= isum;
    float gs;
    { const float hi1 = fmaxf(sc[0], sc[1]), lo1 = fminf(sc[0], sc[1]), hi2 = fmaxf(sc[2], sc[3]), lo2 = fminf(sc[2], sc[3]);
      gs = fmaxf(hi1, hi2) + fmaxf(fminf(hi1, hi2), fmaxf(lo1, lo2)); }
    const float g1 = swz_xor<16>(gs);
    float g2, g3;
    { const auto r = __builtin_amdgcn_permlane32_swap(__float_as_uint(gs), __float_as_uint(gs), false, false); g2 = (g & 2) ? __uint_as_float(r[0]) : __uint_as_float(r[1]); }
    { const auto r = __builtin_amdgcn_permlane32_swap(__float_as_uint(g1), __float_as_uint(g1), false, false); g3 = (g & 2) ? __uint_as_float(r[0]) : __uint_as_float(r[1]); }
    const bool win = ((gs > g1) || (gs == g1 && g < (g ^ 1))) && ((gs > g2) || (gs == g2 && g < (g ^ 2))) && ((gs > g3) || (gs == g3 && g < (g ^ 3)));
    if (win) {
        int i0 = 0; float b0 = sc[0];
#pragma unroll
        for (int k = 1; k < 4; ++k) if (sc[k] > b0) { b0 = sc[k]; i0 = k; }
        int i1 = -1; float b1 = -1.f;
#pragma unroll
        for (int k = 0; k < 4; ++k) if (k != i0 && sc[k] > b1) { b1 = sc[k]; i1 = k; }
        const int e0 = 4 * g + i0, e1 = 4 * g + i1; const float wn = rcpf_(b0 + b1);
        const unsigned l0 = atomicAdd((unsigned*)&sCnt[e0], 1u), l1 = atomicAdd((unsigned*)&sCnt[e1], 1u);
        sRec[lt * 6 + 0] = (unsigned)e0; sRec[lt * 6 + 1] = l0; sRec[lt * 6 + 2] = (unsigned)e1; sRec[lt * 6 + 3] = l1; sRec[lt * 6 + 4] = __float_as_uint(b0 * wn); sRec[lt * 6 + 5] = __float_as_uint(b1 * wn);
    }
    { bf16_t* hrow = c.actf + (size_t)tok * D + 8 * g;
#pragma unroll 1
      for (int s4 = 0; s4 < 8; ++s4) { f32x4 xx[8];
#pragma unroll
          for (int j = 0; j < 4; ++j) { xx[2 * j] = *(const f32x4*)(xrow + 32 * (4 * s4 + j)); xx[2 * j + 1] = *(const f32x4*)(xrow + 32 * (4 * s4 + j) + 4); }
#pragma unroll
          for (int j = 0; j < 4; ++j) { const int s = 4 * s4 + j; const f32x4 x0 = xx[2 * j], x1 = xx[2 * j + 1];
              const f32x4 q0 = *(const LAS f32x4*)(sGn + 32 * s + 8 * g), q1 = *(const LAS f32x4*)(sGn + 32 * s + 8 * g + 4);
              u32x4 o; o.x = pk2(x0.x * rs * q0.x, x0.y * rs * q0.y); o.y = pk2(x0.z * rs * q0.z, x0.w * rs * q0.w); o.z = pk2(x1.x * rs * q1.x, x1.y * rs * q1.y); o.w = pk2(x1.z * rs * q1.z, x1.w * rs * q1.w);
              *(u32x4*)(hrow + 32 * s) = o; } } }
    }
    __syncthreads();
    if (tid < 16) sBase[tid] = __hip_atomic_fetch_add(gcnt + tid, sCnt[tid], __ATOMIC_RELAXED, __HIP_MEMORY_SCOPE_AGENT);
    __syncthreads();
    if (tid < TPB) { const int tk = c.bid * TPB + tid; const unsigned e0 = sRec[tid * 6], e1 = sRec[tid * 6 + 2];
        const unsigned p0 = sBase[e0] + sRec[tid * 6 + 1], p1 = sBase[e1] + sRec[tid * 6 + 3];
        u32x4 r; r.x = (e0 << 20) | p0; r.y = (e1 << 20) | p1; r.z = sRec[tid * 6 + 4]; r.w = sRec[tid * 6 + 5];
        *(u32x4*)(c.rec + (size_t)tk * 4) = r;
        c.list[(size_t)e0 * TT + p0] = tk; c.list[(size_t)e1 * TT + p1] = tk; }
}

struct PlainOrder {
    int nM, nN, G, c; const char* A; const char* Bt; size_t a_tile, b_tile; int r0, r1;
    __device__ __forceinline__ bool next(int i, pg8::Unit& u) const { u.g = 0; if (r0 + i >= r1) return false; return pg8::static_tile(nM, nN, G, c, r0 + i, u.pm, u.pn); }
    __device__ __forceinline__ const char* aptr(const pg8::Unit& u) const { return A + (size_t)u.pm * a_tile; }
    __device__ __forceinline__ const char* bptr(const pg8::Unit& u) const { return Bt + (size_t)u.pn * b_tile; }
    __device__ __forceinline__ unsigned arow(const pg8::Unit&, int) const { return 0u; }
};
struct MergeOrder {
    int G, c; const char* proj; const char* wbr;
    __device__ __forceinline__ bool next(int i, pg8::Unit& u) const { u.g = i % 3; return pg8::static_tile(TC / 256, 4, G, c, i / 3, u.pm, u.pn); }
    __device__ __forceinline__ const char* aptr(const pg8::Unit& u) const { const int col = u.g == 0 ? C_OG : (u.g == 1 ? C_YB : C_QKV); return proj + ((size_t)u.pm * 256 * NP + col) * 2; }
    __device__ __forceinline__ const char* bptr(const pg8::Unit& u) const { return wbr + ((size_t)u.g * D * 512 + (size_t)u.pn * 256 * 512) * 2; }
    __device__ __forceinline__ unsigned arow(const pg8::Unit&, int) const { return 0u; }
};
template <bool UP> struct MoeOrder {
    int G, c; LAS const int* pt; LAS const int* lc; const char* A; const char* W; const int* list;
    __device__ __forceinline__ bool next(int i, pg8::Unit& u) const { const int x = c & 7, j = c >> 3, tau = (G >> 2) * i + 8 * x + (j >> 2); if (tau >= pt[NE]) return false;
        const int L = j;
        int e = 0;
#pragma unroll
        for (int k = 1; k < NE; ++k) e += (tau >= pt[k]) ? 1 : 0;
        u.pm = tau; u.pn = L & 3; u.g = e; return true; }
    __device__ __forceinline__ const char* aptr(const pg8::Unit& u) const { return UP ? A : A + (size_t)u.pm * 256 * FF * 2; }
    __device__ __forceinline__ const char* bptr(const pg8::Unit& u) const { return UP ? W + ((size_t)u.g * 1024 * D + (size_t)u.pn * 256 * D) * 2 : W + ((size_t)u.g * D * FF + (size_t)u.pn * 256 * FF) * 2; }
    __device__ __forceinline__ unsigned arow(const pg8::Unit& u, int r) const { int p = (u.pm - pt[u.g]) * 256 + r; const int n = lc[u.g]; p = p < n ? p : n - 1;
        return (unsigned)list[(size_t)u.g * TT + p] * (unsigned)(D * 2); }
};

struct EpiStoreBf16 {
    static constexpr bool PERM = true;
    bf16_t* O; int ldc;
    __device__ __forceinline__ void operator()(const f32x4 (&acc)[2][2][4][2], const pg8::Unit& u, int wr, int wc, int fr, int fq) const {
        const int row0 = u.pm * 256 + wr * 64 + fr, col0 = u.pn * 256 + wc * 32 + 8 * fq;
#pragma unroll
        for (int ai = 0; ai < 2; ++ai)
#pragma unroll
            for (int m = 0; m < 4; ++m) { bf16_t* rowp = O + (size_t)(row0 + ai * 128 + m * 16) * ldc + col0;
#pragma unroll
                for (int bj = 0; bj < 2; ++bj) { const f32x4 v0 = acc[ai][bj][m][0], v1 = acc[ai][bj][m][1];
                    u32x4 w; w.x = pg8::cvt_pk_bf16(v0[0], v0[1]); w.y = pg8::cvt_pk_bf16(v0[2], v0[3]); w.z = pg8::cvt_pk_bf16(v1[0], v1[1]); w.w = pg8::cvt_pk_bf16(v1[2], v1[3]);
                    *(u32x4*)(rowp + bj * 128) = w; } }
    }
};
struct EpiMerge {
    static constexpr bool PERM = true;
    const bf16_t* proj; bf16_t* mg;
    __device__ __forceinline__ void operator()(const f32x4 (&acc)[2][2][4][2], const pg8::Unit& u, int wr, int wc, int fr, int fq) const {
        const int row0 = u.pm * 256 + wr * 64 + fr, col0 = u.pn * 256 + wc * 32 + 8 * fq;
#pragma unroll
        for (int ai = 0; ai < 2; ++ai) {
            u32x4 gv[4][2], pv[4][2];
#pragma unroll
            for (int m = 0; m < 4; ++m)
#pragma unroll
                for (int bj = 0; bj < 2; ++bj) { const size_t row = (size_t)(row0 + ai * 128 + m * 16); const int col = col0 + bj * 128;
                    gv[m][bj] = *(const u32x4*)(proj + row * NP + C_G + u.g * D + col);
                    if (u.g > 0) pv[m][bj] = *(const u32x4*)(mg + row * D + col); else pv[m][bj] = (u32x4){0u, 0u, 0u, 0u}; }
            asm volatile("" ::: "memory");
#pragma unroll
            for (int m = 0; m < 4; ++m)
#pragma unroll
                for (int bj = 0; bj < 2; ++bj) { const size_t row = (size_t)(row0 + ai * 128 + m * 16); const int col = col0 + bj * 128;
                    const u32x4 g = gv[m][bj], p = pv[m][bj];
                    const f32x4 v0 = acc[ai][bj][m][0], v1 = acc[ai][bj][m][1];
                    float r[8];
                    r[0] = v0[0] * sigmoidf_(bflo(g.x)) + bflo(p.x); r[1] = v0[1] * sigmoidf_(bfhi(g.x)) + bfhi(p.x); r[2] = v0[2] * sigmoidf_(bflo(g.y)) + bflo(p.y); r[3] = v0[3] * sigmoidf_(bfhi(g.y)) + bfhi(p.y);
                    r[4] = v1[0] * sigmoidf_(bflo(g.z)) + bflo(p.z); r[5] = v1[1] * sigmoidf_(bfhi(g.z)) + bfhi(p.z); r[6] = v1[2] * sigmoidf_(bflo(g.w)) + bflo(p.w); r[7] = v1[3] * sigmoidf_(bfhi(g.w)) + bfhi(p.w);
                    u32x4 w; w.x = pk2(r[0], r[1]); w.y = pk2(r[2], r[3]); w.z = pk2(r[4], r[5]); w.w = pk2(r[6], r[7]);
                    *(u32x4*)(mg + row * D + col) = w; }
        }
    }
};
struct EpiResid {
    static constexpr bool PERM = false;
    const float* base; float* out;
    __device__ __forceinline__ void operator()(const f32x4 (&acc)[2][2][4][2], const pg8::Unit& u, int wr, int wc, int fr, int fq) const {
        const int row0 = u.pm * 256 + wr * 64 + fr, col0 = u.pn * 256 + wc * 32 + 4 * fq;
#pragma unroll
        for (int ai = 0; ai < 2; ++ai) {
            f32x4 bv[4][2][2];
#pragma unroll
            for (int m = 0; m < 4; ++m) { const size_t off = (size_t)(row0 + ai * 128 + m * 16) * D + col0;
#pragma unroll
                for (int bj = 0; bj < 2; ++bj)
#pragma unroll
                    for (int n = 0; n < 2; ++n) bv[m][bj][n] = *(const f32x4*)(base + off + bj * 128 + n * 16); }
            asm volatile("" ::: "memory");
#pragma unroll
            for (int m = 0; m < 4; ++m) { const size_t off = (size_t)(row0 + ai * 128 + m * 16) * D + col0;
#pragma unroll
                for (int bj = 0; bj < 2; ++bj)
#pragma unroll
                    for (int n = 0; n < 2; ++n) *(f32x4*)(out + off + bj * 128 + n * 16) = bv[m][bj][n] + acc[ai][bj][m][n]; }
        }
    }
};
struct EpiSwiGLU {
    static constexpr bool PERM = false;
    bf16_t* hid;
    __device__ __forceinline__ void operator()(const f32x4 (&acc)[2][2][4][2], const pg8::Unit& u, int wr, int wc, int fr, int fq) const {
        const int row0 = u.pm * 256 + wr * 64 + fr, col0 = u.pn * 128 + wc * 16 + 4 * fq;
#pragma unroll
        for (int ai = 0; ai < 2; ++ai)
#pragma unroll
            for (int m = 0; m < 4; ++m) { bf16_t* rowp = hid + (size_t)(row0 + ai * 128 + m * 16) * FF + col0;
#pragma unroll
                for (int bj = 0; bj < 2; ++bj) { const f32x4 g = acc[ai][bj][m][0], up = acc[ai][bj][m][1];
                    u32x2 w; w.x = pg8::cvt_pk_bf16(g[0] * sigmoidf_(g[0]) * up[0], g[1] * sigmoidf_(g[1]) * up[1]); w.y = pg8::cvt_pk_bf16(g[2] * sigmoidf_(g[2]) * up[2], g[3] * sigmoidf_(g[3]) * up[3]);
                    *(u32x2*)(rowp + bj * 64) = w; } }
    }
};

constexpr int PH_PER_LAYER = 1 + NCH * 5 + 3, PH_TOTAL = 1 + DEPTH * PH_PER_LAYER + 1;
#ifndef MK_LAUNCH_PER_PHASE
#define MK_LAUNCH_PER_PHASE 0
#endif
#ifndef PHMASK
#define PHMASK 0xFFFF
#endif
#ifndef MIXM
#define MIXM 7
#endif
#define EN(j) (((PHMASK) >> (j)) & 1)
typedef const __attribute__((address_space(4))) char* kptr_t;
__device__ __forceinline__ const void* karg_ptr(kptr_t kp, int i) { return *(const void* const __attribute__((address_space(4)))*)(kp + 8 * i); }
__device__ __forceinline__ void make_ctx(Ctx& c, kptr_t& kp, int layer, int chunk, int wave_s) {
    int t = wave_s * 64 + (int)__builtin_amdgcn_mbcnt_hi(~0u, __builtin_amdgcn_mbcnt_lo(~0u, 0u)); asm volatile("" : "+v"(t));
    kp = (kptr_t)__builtin_amdgcn_kernarg_segment_ptr(); asm volatile("" : "+s"(kp));
    c.tid = t; c.lane = t & 63; c.wave = __builtin_amdgcn_readfirstlane(t >> 6); c.bid = blockIdx.x; c.G = gridDim.x;
    unsigned char* ws = (unsigned char*)karg_ptr(kp, 25); float* out = (float*)karg_ptr(kp, 24);
    c.ctl = (unsigned*)(ws + WS_CTL);
    c.actf = (bf16_t*)(ws + WS_ACT); c.act = c.actf + (size_t)chunk * TC * D; c.proj = (bf16_t*)(ws + WS_PROJ); c.hid = (bf16_t*)(ws + WS_HID); c.ys = (bf16_t*)(ws + WS_YS);
    c.rec = (unsigned*)(ws + WS_REC); c.list = (int*)(ws + WS_LIST);
    c.chunk = chunk; c.layer = layer; c.pass = layer * NCH + chunk;
    c.xinf = (const float*)karg_ptr(kp, 0); c.xof = out;
    c.x_in = c.xinf + (size_t)chunk * TC * D; c.xo = out + (size_t)chunk * TC * D;
    c.pos = (const int*)karg_ptr(kp, 1) + (size_t)chunk * TC;
    c.lw = ws + WS_W + (size_t)layer * LW_SIZE;
}
#define INP(i) ((const float*)karg_ptr(kp, (i)))
__global__ void __launch_bounds__(NTHR, 2) fwd(Args args) {
    extern __shared__ __attribute__((aligned(16))) unsigned char lds_raw[];
    Ctx c; kptr_t kp;
    c.lds = (LAS unsigned char*)lds_raw;
    const int wave_s = __builtin_amdgcn_readfirstlane((int)threadIdx.x >> 6);
    make_ctx(c, kp, 0, 0, wave_s);
    volatile LAS unsigned* MISC = (volatile LAS unsigned*)(c.lds + MISC_OFF);
    LAS int* sPT = (LAS int*)(c.lds + MISC_OFF + 64);
    LAS int* sLC = (LAS int*)(c.lds + MISC_OFF + 160);
    for (int u = c.tid; u < 1024; u += NTHR) MISC[u] = 0u;
    __syncthreads();
    XcdBarrier bar; bar.bar = c.ctl + CW_BAR; bar.x = 0; bar.st = nullptr;
    if (!MK_LAUNCH_PER_PHASE) bar = xcd_barrier_post(c.ctl + CW_BAR, MISC, c.tid);
    const int lo = args.ph_lo, hi = args.ph_hi;
#define IN(k) (lo <= (k) && (k) < hi)
#ifndef PROBE_MASK
#define PROBE_MASK 0
#endif
#ifndef PROBE_CLK_CLS
#define PROBE_CLK_CLS 2
#endif
#ifndef PROBE_BLOCK
#define PROBE_BLOCK 0
#endif
#ifndef PROBE_K
#define PROBE_K 4
#endif
    unsigned long long t_prev = 0, c_prev = 0; LAS unsigned* sAcc = (LAS unsigned*)(c.lds + MISC_OFF + 512);
    if (PROBE_MASK) { t_prev = __builtin_amdgcn_s_memrealtime(); c_prev = (unsigned long long)clock64(); }
#define STAMP(cls) do { if (PROBE_MASK) { const unsigned long long _n = __builtin_amdgcn_s_memrealtime(); const unsigned long long _ck = (unsigned long long)clock64(); if (blockIdx.x == PROBE_BLOCK && c.tid == 0) { sAcc[(cls)] += (unsigned)(_n - t_prev); if ((cls) == PROBE_CLK_CLS) sAcc[15] += (unsigned)((_ck - c_prev) >> 4); } t_prev = _n; c_prev = _ck; } } while (0)
#ifndef PROBE_GEMM_CLS
#define PROBE_GEMM_CLS -1
#endif
#define GEMM_FLAG(cls) do { if (PROBE_MASK) { if (c.tid == 0) MISC[6] = ((cls) == PROBE_GEMM_CLS) ? 1u : 0u; __syncthreads(); } } while (0)
#define SEAM(k) do { if (IN(k) && IN((k) + 1)) { XcdBarrier _b = bar; kptr_t _k = (kptr_t)__builtin_amdgcn_kernarg_segment_ptr(); asm volatile("" : "+s"(_k)); _b.bar = (unsigned*)((unsigned char*)karg_ptr(_k, 25) + WS_CTL) + CW_BAR; { int _t = wave_s * 64 + (int)__builtin_amdgcn_mbcnt_hi(~0u, __builtin_amdgcn_mbcnt_lo(~0u, 0u)); const unsigned long long _b0 = PROBE_MASK ? __builtin_amdgcn_s_memrealtime() : 0ull; xcd_barrier(_b, _t); if (PROBE_MASK && blockIdx.x == PROBE_BLOCK && _t == 0) sAcc[13] += (unsigned)(__builtin_amdgcn_s_memrealtime() - _b0); } } } while (0)

    if (EN(0) && IN(0)) { Args a2;
#pragma unroll
        for (int i = 0; i < 24; ++i) a2.in[i] = karg_ptr(kp, i);
        a2.ws = (unsigned char*)karg_ptr(kp, 25); a2.out = nullptr; a2.ph_lo = 0; a2.ph_hi = 0;
        phase_prep(a2, c.lds, c.bid * NWAVES + c.wave, c.G * NWAVES, c.wave, c.lane, c.bid * NTHR + c.tid, c.G * NTHR);
        phase_rope_table((const int*)karg_ptr(kp, 1), (float*)(c.ctl) + (WS_BRC + 4 * MiB) / 4, c.bid * NTHR + c.tid, c.G * NTHR); }
    SEAM(0); STAMP(0);

    for (int layer = 0; layer < DEPTH; ++layer) {
        const int pl = 1 + layer * PH_PER_LAYER;
        if (EN(1) && IN(pl)) { make_ctx(c, kp, layer, 0, wave_s);
            const float* g1 = INP(2) + layer * D;
            if (layer == 0) phase_norm1<false, true, false>(c, g1, sPT);
            else { moe_tables(c.ctl + CW_CNT + 64 * (layer - 1), sPT, sLC, c.tid); phase_norm1<true, true, true>(c, g1, sPT); }
        }
        SEAM(pl); STAMP(1);
        for (int chunk = 0; chunk < NCH; ++chunk) {
            const int pb = pl + 1 + chunk * 5;
            if (EN(2) && IN(pb + 0)) { make_ctx(c, kp, layer, chunk, wave_s);
                EpiStoreBf16 E{c.proj, NP};
                GEMM_FLAG(2);
                PlainOrder S{TC / 256, NP / 256, c.G, c.bid, (const char*)c.act, (const char*)(c.lw + LW_WIN), (size_t)256 * D * 2, (size_t)256 * D * 2, 0, 1 << 20};
                pg8::gemm_phase<EpiStoreBf16, PlainOrder, false>(c.lds, S, E, D, D, c.tid);
            }
            SEAM(pb + 0); STAMP(2);
            if (EN(4) && IN(pb + 1)) { make_ctx(c, kp, layer, chunk, wave_s);
                float* lse = (float*)(c.ctl) + (WS_BRC / 4);
                if ((MIXM & 1) && c.bid < 4 * BC) gla_unit(c, c.bid, INP(5) + layer * 256, INP(6) + layer * 128);
                else if ((MIXM & 2) && c.bid < 12 * BC) lru_unit(c, c.bid - 4 * BC, INP(7) + layer * 4 * 512, INP(8) + layer * 512, INP(9) + layer * 8 * 64 * 64,
                                                    INP(10) + layer * 512, INP(11) + layer * 8 * 64 * 64, INP(12) + layer * 512, INP(13) + layer * 512);
                STAMP(12);
                unsigned* qh = c.ctl + CW_Q + 64 * c.pass;
                if (MIXM & 4) attn_loop(c, qh, MISC + 4, lse, INP(14) + layer * 128, INP(15) + layer * 128, (const float*)(c.ctl) + (WS_BRC + 4 * MiB) / 4 + (size_t)chunk * TC * 32);
            }
            SEAM(pb + 1); STAMP(4);
            if (EN(11) && IN(pb + 2)) { make_ctx(c, kp, layer, chunk, wave_s); phase_attn_combine(c, (const float*)(c.ctl) + (WS_BRC / 4)); }
            SEAM(pb + 2); STAMP(11);
            if (EN(5) && IN(pb + 3)) { make_ctx(c, kp, layer, chunk, wave_s);
                MergeOrder S{c.G, c.bid, (const char*)c.proj, (const char*)(c.lw + LW_WBR)};
                EpiMerge E{c.proj, c.act};
                GEMM_FLAG(5);
                pg8::gemm_phase<EpiMerge, MergeOrder, false>(c.lds, S, E, 512, NP, c.tid);
            }
            SEAM(pb + 3); STAMP(5);
            if (EN(6) && IN(pb + 4)) { make_ctx(c, kp, layer, chunk, wave_s);
                PlainOrder S{TC / 256, D / 256, c.G, c.bid, (const char*)c.act, (const char*)(c.lw + LW_WOUT), (size_t)256 * D * 2, (size_t)256 * D * 2, 0, 1 << 20};
                EpiResid E{layer == 0 ? c.x_in : (const float*)c.xo, c.xo};
                GEMM_FLAG(6);
                pg8::gemm_phase<EpiResid, PlainOrder, false>(c.lds, S, E, D, D, c.tid);
            }
            SEAM(pb + 4); STAMP(6);
        }
        const int pm = pl + 1 + NCH * 5;
        if (EN(7) && IN(pm + 0)) { make_ctx(c, kp, layer, 0, wave_s); phase_router(c, INP(18) + layer * D, INP(19), INP(20), c.ctl + CW_CNT + 64 * layer); }
        SEAM(pm + 0); STAMP(7);
        if (EN(8) && IN(pm + 1)) { make_ctx(c, kp, layer, 0, wave_s);
            moe_tables(c.ctl + CW_CNT + 64 * layer, sPT, sLC, c.tid);
            MoeOrder<true> S{c.G, c.bid, sPT, sLC, (const char*)c.actf, (const char*)(c.lw + LW_WGU), c.list};
            EpiSwiGLU E{c.hid};
            GEMM_FLAG(8);
            pg8::gemm_phase<EpiSwiGLU, MoeOrder<true>, true>(c.lds, S, E, D, D, c.tid);
        }
        SEAM(pm + 1); STAMP(8);
        if (EN(9) && IN(pm + 2)) { make_ctx(c, kp, layer, 0, wave_s);
            moe_tables(c.ctl + CW_CNT + 64 * layer, sPT, sLC, c.tid);
            MoeOrder<false> S{c.G, c.bid, sPT, sLC, (const char*)c.hid, (const char*)(c.lw + LW_WDN), c.list};
            EpiStoreBf16 E{c.ys, D};
            GEMM_FLAG(9);
            pg8::gemm_phase<EpiStoreBf16, MoeOrder<false>, false>(c.lds, S, E, FF, FF, c.tid);
        }
        SEAM(pm + 2); STAMP(9);
    }
    if (EN(10) && IN(PH_TOTAL - 1)) { make_ctx(c, kp, DEPTH - 1, 0, wave_s);
        moe_tables(c.ctl + CW_CNT + 64 * (DEPTH - 1), sPT, sLC, c.tid);
        phase_norm1<true, false, true>(c, nullptr, sPT);
    }
    if (PROBE_MASK) {
        make_ctx(c, kp, DEPTH - 1, 0, wave_s);
        STAMP(10);
        if (blockIdx.x == PROBE_BLOCK && c.tid == 0) { unsigned sel = 0; for (int k = 0; k < 16; ++k) if ((PROBE_MASK >> k) & 1) sel += sAcc[k]; __hip_atomic_store(c.ctl + CW_Q + 64 * 8, sel, __ATOMIC_RELAXED, __HIP_MEMORY_SCOPE_AGENT); }
        { XcdBarrier _b = bar; _b.bar = c.ctl + CW_BAR; xcd_barrier(_b, c.tid); }
        const unsigned sel = __hip_atomic_load(c.ctl + CW_Q + 64 * 8, __ATOMIC_RELAXED, __HIP_MEMORY_SCOPE_AGENT);
        const unsigned long long t0 = __builtin_amdgcn_s_memrealtime();
        while (__builtin_amdgcn_s_memrealtime() - t0 < (unsigned long long)sel * PROBE_K) __builtin_amdgcn_s_sleep(8);
    }
#undef IN
#undef SEAM
}

extern "C" void kernel_launch(void* const* d_in, const int* in_sizes, int n_in, void* d_out, int out_size, void* d_ws, size_t ws_size, hipStream_t stream) {
    static int grid = 0;
    if (grid == 0) {
        if (n_in != 24 || in_sizes[0] != BATCH * SEQ * D || out_size != BATCH * SEQ * D || ws_size < WS_END) { fprintf(stderr, "kernel_launch: unexpected shapes / workspace (%zu < %zu)\n", ws_size, (size_t)WS_END); grid = -1; return; }
        int dev = 0, cus = 0;
        if (hipGetDevice(&dev) != hipSuccess || hipDeviceGetAttribute(&cus, hipDeviceAttributeMultiprocessorCount, dev) != hipSuccess || cus < 256) { fprintf(stderr, "kernel_launch: needs a 256-CU device\n"); grid = -1; return; }
        if (hipFuncSetAttribute((const void*)fwd, hipFuncAttributeMaxDynamicSharedMemorySize, LDS_BYTES) != hipSuccess) { fprintf(stderr, "kernel_launch: hipFuncSetAttribute failed\n"); grid = -1; return; }
        int per_cu = 0;
        if (hipOccupancyMaxActiveBlocksPerMultiprocessor(&per_cu, (const void*)fwd, NTHR, LDS_BYTES) != hipSuccess || per_cu < 1) fprintf(stderr, "kernel_launch: occupancy query says %d\n", per_cu);
        (void)hipGetLastError();
        grid = 256;
    }
    if (grid < 0) return;
    if (hipMemsetAsync((char*)d_ws + WS_CTL, 0, CTL_ZERO_BYTES, stream) != hipSuccess) return;
    Args a{};
    for (int i = 0; i < 24; ++i) a.in[i] = d_in[i];
    a.out = (float*)d_out; a.ws = (unsigned char*)d_ws;
#if MK_LAUNCH_PER_PHASE
    for (int k = 0; k < PH_TOTAL; ++k) { a.ph_lo = k; a.ph_hi = k + 1; hipLaunchKernelGGL(fwd, dim3(grid), dim3(NTHR), LDS_BYTES, stream, a); }
#else
    a.ph_lo = 0; a.ph_hi = PH_TOTAL;
    hipLaunchKernelGGL(fwd, dim3(grid), dim3(NTHR), LDS_BYTES, stream, a);
#endif
}
```

```cpp
#include <hip/hip_runtime.h>
#include <cstdio>
#include <cstdint>

#define LAS __attribute__((address_space(3)))
#define GAS __attribute__((address_space(1)))
typedef unsigned short bf16_t;
typedef short bf16x8 __attribute__((ext_vector_type(8)));
typedef float f32x4 __attribute__((ext_vector_type(4)));
typedef float f32x2 __attribute__((ext_vector_type(2)));
typedef unsigned u32x4 __attribute__((ext_vector_type(4)));
typedef unsigned u32x2 __attribute__((ext_vector_type(2)));

namespace pg8 {
constexpr int BM = 256, BK = 64, HALF = 128, HTB = HALF * BK * 2, STAGE_BYTES = 8 * HTB, NXCD = 8, WGM = 8;
__host__ __device__ __forceinline__ int lds_byte(int r, int c) { const int st = (r >> 4) * 2 + (c >> 5), rr = r & 15, cc = c & 31, ob = rr * 64 + cc * 2; return st * 1024 + (ob ^ (((ob >> 9) & 1) << 5)); }
__host__ __device__ __forceinline__ void stage_rc(int b, int& R, int& C) { const int st = b / 1024, sb = b % 1024, swz = sb ^ (((sb >> 9) & 1) << 5); R = (st >> 1) * 16 + swz / 64; C = (st & 1) * 32 + (swz % 64) / 2; }
__host__ __device__ __forceinline__ int perm32(int rho) { const int n = rho >> 4, i = rho & 15; return 8 * (i >> 2) + 4 * n + (i & 3); }

struct Unit { int pm, pn, g; };

__device__ __forceinline__ bool static_tile(int nM, int nN, int G, int c, int i, int& pm, int& pn) {
    const int nwg = nM * nN; const long L = (long)i * G + c; if (L >= nwg) return false;
    int wgid = (int)L; { const int q = nwg / NXCD, r = nwg % NXCD, xcd = wgid % NXCD, off = wgid / NXCD; wgid = (xcd < r ? xcd * (q + 1) : r * (q + 1) + (xcd - r) * q) + off; }
    const int nig = WGM * nN, gid = wgid / nig, fm = gid * WGM, gsz = (nM - fm) < WGM ? (nM - fm) : WGM;
    pm = fm + ((wgid % nig) % gsz); pn = (wgid % nig) / gsz; return true;
}
typedef __bf16 bf16x2c_t __attribute__((ext_vector_type(2)));
__device__ __forceinline__ unsigned cvt_pk_bf16(float lo, float hi) { const f32x2 v = {lo, hi}; return __builtin_bit_cast(unsigned, __builtin_convertvector(v, bf16x2c_t)); }

template <class Epi, class Sched, bool GATHER>
__device__ __forceinline__ void gemm_phase(LAS unsigned char* lds, const Sched& S, const Epi& E, const int K, const int lda, int tid_) {
    asm volatile("" : "+v"(tid_));
    const int tid = tid_, wid = __builtin_amdgcn_readfirstlane(tid >> 6), lane = tid & 63, wr = wid >> 2, wc = wid & 3, fr = lane & 15, fq = lane >> 4;
    const int nt = K / BK;
    int sR[2], sC[2];
    unsigned voffB[2], voffA[2], vAc[2][2], vAn[2][2];
#pragma unroll
    for (int i = 0; i < 2; ++i) { int R, C; stage_rc(tid * 16 + i * 8192, R, C); sR[i] = R; sC[i] = C; const int Rb = Epi::PERM ? ((R & ~31) + perm32(R & 31)) : R;
        voffB[i] = (unsigned)(Rb * K + C) * 2u; voffA[i] = (unsigned)(R * lda + C) * 2u; }
    const size_t kstep = (size_t)(BK * 2);
    const size_t hstepB = (size_t)HALF * K * 2, hstepA = (size_t)HALF * lda * 2;
    const unsigned ldsw = (unsigned)wid * 1024u;
    const int aoff = lds_byte(wr * 64 + fr, fq * 8), boff = lds_byte(wc * 32 + fr, fq * 8);
#define PG8_SA(b, h) (((b) * 2 + (h)) * HTB)
#define PG8_SB(b, h) ((4 + (b) * 2 + (h)) * HTB)
#define PG8_STAGE(bufoff, gbase, voff) do { _Pragma("unroll") for (int _i = 0; _i < 2; ++_i) \
        __builtin_amdgcn_global_load_lds((const unsigned*)((const char*)(gbase) + (voff)[_i]), (LAS unsigned*)(lds + (bufoff) + ldsw + _i * 8192), 16, 0, 0); } while (0)
#define PG8_LDA(dst, b, h) do { _Pragma("unroll") for (int m = 0; m < 4; ++m) _Pragma("unroll") for (int k = 0; k < 2; ++k) dst[m][k] = *(const LAS bf16x8*)(lds + PG8_SA(b, h) + aoff + m * 2048 + k * 1024); } while (0)
#define PG8_LDB(dst, b, h) do { _Pragma("unroll") for (int n = 0; n < 2; ++n) _Pragma("unroll") for (int k = 0; k < 2; ++k) dst[n][k] = *(const LAS bf16x8*)(lds + PG8_SB(b, h) + boff + n * 2048 + k * 1024); } while (0)
#define PG8_MMA(ai, bj, At, Bt) do { __builtin_amdgcn_s_setprio(1); _Pragma("unroll") for (int m = 0; m < 4; ++m) _Pragma("unroll") for (int n = 0; n < 2; ++n) _Pragma("unroll") for (int k = 0; k < 2; ++k) \
        acc[ai][bj][m][n] = __builtin_amdgcn_mfma_f32_16x16x32_bf16(Bt[n][k], At[m][k], acc[ai][bj][m][n], 0, 0, 0); __builtin_amdgcn_s_setprio(0); } while (0)
#define PG8_WAIT_V(n) asm volatile("s_waitcnt vmcnt(" #n ")" ::: "memory")
#define PG8_WAIT_L(n) asm volatile("s_waitcnt lgkmcnt(" #n ")" ::: "memory")
#define PG8_BAR __builtin_amdgcn_s_barrier()
#define PG8_SCHED __builtin_amdgcn_sched_barrier(0)
#define PG8_AOFF(dst, u) do { if constexpr (GATHER) { _Pragma("unroll") for (int _h = 0; _h < 2; ++_h) _Pragma("unroll") for (int _i = 0; _i < 2; ++_i) \
        dst[_h][_i] = S.arow(u, _h * HALF + sR[_i]) + (unsigned)sC[_i] * 2u; } } while (0)
#define PG8_STAGE_A(bufoff, gptr, h, usenext) do { if constexpr (GATHER) { _Pragma("unroll") for (int _i = 0; _i < 2; ++_i) { const unsigned _vo = (usenext) ? vAn[h][_i] : vAc[h][_i]; \
        __builtin_amdgcn_global_load_lds((const unsigned*)((const char*)(gptr) + _vo), (LAS unsigned*)(lds + (bufoff) + ldsw + _i * 8192), 16, 0, 0); } } \
        else { PG8_STAGE(bufoff, (gptr) + (h) * hstepA, voffA); } } while (0)
    Unit cur, nxt; int ui = 0;
    if (!S.next(0, cur)) return;
    f32x4 acc[2][2][4][2];
#pragma unroll
    for (int a = 0; a < 2; ++a)
#pragma unroll
        for (int b = 0; b < 2; ++b)
#pragma unroll
            for (int m = 0; m < 4; ++m)
#pragma unroll
                for (int n = 0; n < 2; ++n) acc[a][b][m][n] = (f32x4){0.f, 0.f, 0.f, 0.f};
    bf16x8 At[4][2], B0[2][2], B1[2][2];
    const char* cA = S.aptr(cur); const char* cB = S.bptr(cur);
    PG8_AOFF(vAc, cur);
    PG8_STAGE(PG8_SB(0, 0), cB, voffB); PG8_STAGE(PG8_SB(0, 1), cB + hstepB, voffB); PG8_STAGE_A(PG8_SA(0, 0), cA, 0, false); PG8_STAGE_A(PG8_SA(0, 1), cA, 1, false);
    if (wr == 1) PG8_BAR;
    PG8_WAIT_V(2); PG8_BAR;
    PG8_STAGE(PG8_SB(1, 0), cB + kstep, voffB); PG8_STAGE_A(PG8_SA(1, 0), cA + kstep, 0, false); PG8_STAGE(PG8_SB(1, 1), cB + hstepB + kstep, voffB);
    PG8_WAIT_V(6); PG8_BAR;
    for (;;) {
        const bool has_next = S.next(ui + 1, nxt);
        const char* nA = has_next ? S.aptr(nxt) : cA; const char* nB = has_next ? S.bptr(nxt) : cB;
        if constexpr (GATHER) { if (has_next) { PG8_AOFF(vAn, nxt); } else {
#pragma unroll
            for (int h = 0; h < 2; ++h)
#pragma unroll
                for (int i = 0; i < 2; ++i) vAn[h][i] = vAc[h][i]; } }
#if defined(PROBE_MASK) && PROBE_MASK
        const unsigned long long _tk0 = __builtin_amdgcn_s_memrealtime();
#endif
        for (int t = 0; t < nt; t += 2) {
            const bool last = (t == nt - 2);
            const char* a1 = cA + (size_t)(t + 1) * kstep;
            const char* a2 = last ? nA : cA + (size_t)(t + 2) * kstep; const char* b2 = last ? nB : cB + (size_t)(t + 2) * kstep;
            const char* a3 = a2 + kstep; const char* b3 = b2 + kstep;
            PG8_LDB(B0, 0, 0); PG8_LDB(B1, 0, 1); PG8_SCHED; PG8_LDA(At, 0, 0); PG8_STAGE_A(PG8_SA(1, 1), a1, 1, false);
            PG8_WAIT_V(8); PG8_WAIT_L(0); PG8_BAR; PG8_MMA(0, 0, At, B0); PG8_MMA(0, 1, At, B1); PG8_BAR; PG8_SCHED;
            PG8_LDA(At, 0, 1); PG8_STAGE(PG8_SB(0, 0), b2, voffB); PG8_STAGE(PG8_SB(0, 1), b2 + hstepB, voffB); PG8_STAGE_A(PG8_SA(0, 0), a2, 0, last);
            PG8_WAIT_V(8); PG8_WAIT_L(0); PG8_BAR; PG8_MMA(1, 0, At, B0); PG8_MMA(1, 1, At, B1); PG8_BAR; PG8_SCHED;
            PG8_LDB(B0, 1, 0); PG8_LDB(B1, 1, 1); PG8_SCHED; PG8_LDA(At, 1, 0); PG8_STAGE_A(PG8_SA(0, 1), a2, 1, last);
            PG8_WAIT_V(8); PG8_WAIT_L(0); PG8_BAR; PG8_MMA(0, 0, At, B0); PG8_MMA(0, 1, At, B1); PG8_BAR; PG8_SCHED;
            PG8_LDA(At, 1, 1); PG8_STAGE(PG8_SB(1, 0), b3, voffB); PG8_STAGE(PG8_SB(1, 1), b3 + hstepB, voffB); PG8_STAGE_A(PG8_SA(1, 0), a3, 0, last);
            PG8_WAIT_V(8); PG8_WAIT_L(0); PG8_BAR; PG8_MMA(1, 0, At, B0); PG8_MMA(1, 1, At, B1); PG8_BAR; PG8_SCHED;
        }
#if defined(PROBE_MASK) && PROBE_MASK
        if (blockIdx.x == PROBE_BLOCK && tid == 0 && ((volatile LAS unsigned*)(lds + 147456))[6]) ((LAS unsigned*)(lds + 147456 + 512))[14] += (unsigned)(__builtin_amdgcn_s_memrealtime() - _tk0);
#endif
        if (wr == 0) PG8_BAR;
#if defined(PROBE_MASK) && PROBE_MASK
        { const unsigned long long _t0 = __builtin_amdgcn_s_memrealtime();
          E(acc, cur, wr, wc, fr, fq);
          asm volatile("s_waitcnt vmcnt(0)" ::: "memory");
          if (blockIdx.x == PROBE_BLOCK && tid == 0 && ((volatile LAS unsigned*)(lds + 147456))[6]) ((LAS unsigned*)(lds + 147456 + 512))[13] += (unsigned)(__builtin_amdgcn_s_memrealtime() - _t0); }
#else
        E(acc, cur, wr, wc, fr, fq);
#endif
        if (!has_next) break;
#pragma unroll
        for (int a = 0; a < 2; ++a)
#pragma unroll
            for (int b = 0; b < 2; ++b)
#pragma unroll
                for (int m = 0; m < 4; ++m)
#pragma unroll
                    for (int n = 0; n < 2; ++n) acc[a][b][m][n] = (f32x4){0.f, 0.f, 0.f, 0.f};
        cur = nxt; cA = nA; cB = nB; ++ui;
        if constexpr (GATHER) {
#pragma unroll
        for (int h = 0; h < 2; ++h)
#pragma unroll
            for (int i = 0; i < 2; ++i) vAc[h][i] = vAn[h][i]; }
        if (wr == 1) PG8_BAR;
    }
    PG8_WAIT_V(0);
    PG8_BAR;
#undef PG8_SA
#undef PG8_SB
#undef PG8_STAGE
#undef PG8_LDA
#undef PG8_LDB
#undef PG8_MMA
#undef PG8_WAIT_V
#undef PG8_WAIT_L
#undef PG8_BAR
#undef PG8_SCHED
#undef PG8_AOFF
#undef PG8_STAGE_A
}
}

constexpr int D = 1024, BATCH = 32, SEQ = 2048, DEPTH = 2;
constexpr int NCH = 2, BC = BATCH / NCH, TC = BC * SEQ;
constexpr int TT = BATCH * SEQ;
constexpr int NP = 10496;
constexpr int C_QA = 0, C_KA = 256, C_VA = 512, C_OG = 1024, C_GP = 1536, C_XB = 1792, C_YB = 2304, C_QKV = 2816, C_G = 7424;
constexpr int WIN_N = 10256;
constexpr int NE = 16, FF = 512;
constexpr int RP = 2 * TT + NE * 256;
constexpr float RMS_EPS = 1e-6f;
constexpr int NWAVES = 8, NTHR = 512;

constexpr size_t MiB = 1u << 20;
constexpr size_t WS_CTL = 0, CTL_ZERO_BYTES = 1 * MiB;
constexpr size_t WS_REC = 1 * MiB;
constexpr size_t WS_LIST = 2 * MiB;
constexpr size_t WS_W = 6 * MiB;
constexpr size_t LW_WIN = 0, LW_WBR = LW_WIN + (size_t)NP * D * 2, LW_WOUT = LW_WBR + (size_t)3 * D * 512 * 2, LW_WGU = LW_WOUT + (size_t)D * D * 2,
                 LW_WDN = LW_WGU + (size_t)NE * 1024 * D * 2, LW_SIZE = LW_WDN + (size_t)NE * D * FF * 2;
static_assert(LW_SIZE == 77070336, "layer weights");
constexpr size_t WS_BRC = 154 * MiB;
constexpr size_t WS_ACT = 166 * MiB;
constexpr size_t WS_PROJ = 294 * MiB;
constexpr size_t WS_HID = WS_PROJ;
constexpr size_t WS_YS = WS_PROJ + 136 * MiB;
constexpr size_t WS_RSL = WS_PROJ + 656 * MiB;
constexpr size_t WS_END = WS_RSL + 4 * MiB;
static_assert(WS_W + 2 * LW_SIZE <= WS_BRC && WS_BRC + 12 * MiB <= WS_ACT && WS_ACT + (size_t)TT * D * 2 <= WS_PROJ && (size_t)TC * NP * 2 <= 656 * MiB && (size_t)RP * 512 * 2 <= 136 * MiB && WS_YS + (size_t)RP * 2048 <= WS_RSL, "ws map");
constexpr int CW_BAR = 4096;
constexpr int CW_CNT = 8192;
constexpr int CW_Q = 12288;

constexpr int RING_BYTES = 147456;
constexpr int MISC_OFF = RING_BYTES;
constexpr int LDS_BYTES = 155648;

#define LDS_WAIT() asm volatile("s_waitcnt lgkmcnt(0)" ::: "memory")
#define VM_WAIT() asm volatile("s_waitcnt vmcnt(0)" ::: "memory")
__device__ __forceinline__ float bf2f(unsigned short b) { return __uint_as_float(((unsigned)b) << 16); }
__device__ __forceinline__ float bflo(unsigned u) { return __uint_as_float(u << 16); }
__device__ __forceinline__ float bfhi(unsigned u) { return __uint_as_float(u & 0xffff0000u); }
typedef __bf16 bf16x2v_t __attribute__((ext_vector_type(2)));
__device__ __forceinline__ unsigned pk2(float lo, float hi) { const f32x2 v = {lo, hi}; return __builtin_bit_cast(unsigned, __builtin_convertvector(v, bf16x2v_t)); }
__device__ __forceinline__ unsigned f2bf(float f) { return pk2(f, 0.f) & 0xffffu; }
__device__ __forceinline__ float rcpf_(float x) { return __builtin_amdgcn_rcpf(x); }
__device__ __forceinline__ float rsqf_(float x) { return __builtin_amdgcn_rsqf(x); }
template <int O> __device__ __forceinline__ float swz_xor(float v) { return __int_as_float(__builtin_amdgcn_ds_swizzle(__float_as_int(v), (O << 10) | 0x1f)); }
__device__ __forceinline__ float wave_sum(float v) {
    v += swz_xor<1>(v); v += swz_xor<2>(v); v += swz_xor<4>(v); v += swz_xor<8>(v); v += swz_xor<16>(v);
    const auto r = __builtin_amdgcn_permlane32_swap(__float_as_uint(v), __float_as_uint(v), false, false);
    return __uint_as_float(r[0]) + __uint_as_float(r[1]);
}
__device__ __forceinline__ float wave_max(float v) {
    v = fmaxf(v, swz_xor<1>(v)); v = fmaxf(v, swz_xor<2>(v)); v = fmaxf(v, swz_xor<4>(v)); v = fmaxf(v, swz_xor<8>(v)); v = fmaxf(v, swz_xor<16>(v));
    const auto r = __builtin_amdgcn_permlane32_swap(__float_as_uint(v), __float_as_uint(v), false, false);
    return fmaxf(__uint_as_float(r[0]), __uint_as_float(r[1]));
}
__device__ __forceinline__ float sigmoidf_(float x) { return __builtin_amdgcn_rcpf(1.f + __expf(-x)); }

#define XB_TMO      128
#define XB_XCNT(j)  (256  + 64 * (j))
#define XB_XSUB(j)  (1280 + 64 * (j))
#define XB_XGEN(j)  (2304 + 64 * (j))
#define XB_TOP      3328
#define XB_TOPGEN   3392
#define XCD_BAR_WORDS 3456
#define XB_SPIN_CAP (1u << 21)
__device__ __forceinline__ unsigned xb_ld(unsigned* p)              { return __hip_atomic_load(p, __ATOMIC_RELAXED, __HIP_MEMORY_SCOPE_AGENT); }
__device__ __forceinline__ unsigned xb_add(unsigned* p, unsigned v) { return __hip_atomic_fetch_add(p, v, __ATOMIC_RELAXED, __HIP_MEMORY_SCOPE_AGENT); }
__device__ __forceinline__ unsigned xb_xcc_id() { return (unsigned)__builtin_amdgcn_s_getreg((3 << 11) | 20) & 0xFu; }
#define XB_SPIN(cond, bar) do { unsigned _sp = 0; while (cond) { __builtin_amdgcn_s_sleep(1); \
    if ((++_sp & 255u) == 0u) { if (xb_ld(&(bar)[XB_TMO])) break; if (_sp > XB_SPIN_CAP) { atomicAdd(&(bar)[XB_TMO], 1u); break; } } } } while (0)
struct XcdBarrier { unsigned* bar; unsigned x; volatile LAS unsigned* st; };
__device__ __forceinline__ XcdBarrier xcd_barrier_post(unsigned* bar, volatile LAS unsigned* st, int tid) {
    XcdBarrier b; b.bar = bar; b.x = xb_xcc_id(); b.st = st;
    if (tid == 0) (void)xb_add(&bar[XB_XCNT(b.x)], 1u);
    return b;
}
__device__ __forceinline__ void xcd_barrier_complete(unsigned* bar, unsigned x, unsigned& nloc, unsigned& nx) {
    const unsigned G = gridDim.x * gridDim.y * gridDim.z;
    unsigned sum, cnt, sp = 0u;
    for (;;) {
        sum = 0u; cnt = 0u;
#pragma unroll 1
        for (unsigned j = 0; j < 16; ++j) { const unsigned c = xb_ld(&bar[XB_XCNT(j)]); sum += c; cnt += (c > 0u) ? 1u : 0u; }
        if (sum == G) break;
        __builtin_amdgcn_s_sleep(1);
        if ((++sp & 255u) == 0u) { if (xb_ld(&bar[XB_TMO])) break; if (sp > XB_SPIN_CAP) { atomicAdd(&bar[XB_TMO], 1u); break; } }
    }
    const unsigned mine = xb_ld(&bar[XB_XCNT(x)]);
    nloc = mine > 0u ? mine : 1u; nx = cnt > 0u ? cnt : 1u;
}
__device__ __noinline__ void xcd_barrier(const XcdBarrier b, const int tid) {
    asm volatile("s_waitcnt vmcnt(0)" ::: "memory");
    __syncthreads();
    if (tid == 0) {
        unsigned* bar = b.bar;
        __builtin_amdgcn_s_waitcnt(0);
        unsigned nloc = b.st[0], nx = b.st[1];
        if (nloc == 0u) { xcd_barrier_complete(bar, b.x, nloc, nx); b.st[0] = nloc; b.st[1] = nx; }
        const unsigned old = xb_add(&bar[XB_XSUB(b.x)], 1u);
        const unsigned gen = old / nloc;
        if (old + 1u == (gen + 1u) * nloc) {
            __builtin_amdgcn_fence(__ATOMIC_RELEASE, "agent");
            asm volatile("s_waitcnt vmcnt(0)" ::: "memory");
            const unsigned og = xb_add(&bar[XB_TOP], 1u);
            const unsigned tg = og / nx;
            if (og + 1u == (tg + 1u) * nx) xb_add(&bar[XB_TOPGEN], 1u);
            else XB_SPIN(xb_ld(&bar[XB_TOPGEN]) == tg, bar);
            __builtin_amdgcn_fence(__ATOMIC_ACQUIRE, "agent");
            xb_add(&bar[XB_XGEN(b.x)], 1u);
            asm volatile("s_waitcnt vmcnt(0)" ::: "memory");
        } else {
            XB_SPIN(xb_ld(&bar[XB_XGEN(b.x)]) == gen, bar);
            __builtin_amdgcn_fence(__ATOMIC_ACQUIRE, "agent");
            asm volatile("s_waitcnt vmcnt(0)" ::: "memory");
        }
    }
    __syncthreads();
}

struct Args { const void* in[24]; float* out; unsigned char* ws; int ph_lo, ph_hi; };
struct Ctx {
    LAS unsigned char* lds;
    unsigned* ctl;
    int tid, lane, wave, bid, G;
    int chunk, layer, pass;
    const float* x_in; float* xo;
    const float* xinf; float* xof; bf16_t* actf;
    const int* pos;
    const unsigned char* lw;
    bf16_t *act, *proj, *hid, *ys;
    unsigned* rec; int* list; float* rsl;
};

template <class DMap>
__device__ __forceinline__ void tr_item64(const float* srcA, const float* srcB, int Nsrc, float scale, bf16_t* WT, int K, int n0, int k0, LAS float* scr, int lane, DMap dmap) {
    const int r4 = lane >> 4, c16 = lane & 15;
    const float* src = (c16 < 8 ? srcA + 4 * c16 : srcB + 4 * (c16 - 8));
    f32x4 v[16];
#pragma unroll
    for (int i = 0; i < 16; ++i) v[i] = *(const f32x4*)(src + (size_t)(k0 + 4 * i + r4) * Nsrc);
#pragma unroll
    for (int i = 0; i < 16; ++i) { LAS float* d = scr + (4 * i + r4) * 65 + 4 * c16; d[0] = v[i].x * scale; d[1] = v[i].y * scale; d[2] = v[i].z * scale; d[3] = v[i].w * scale; }
    LDS_WAIT(); asm volatile("" ::: "memory");
    const int kc = lane & 7;
#pragma unroll
    for (int j = 0; j < 8; ++j) { const int r = (lane >> 3) + 8 * j; const LAS float* q = scr + (8 * kc) * 65 + dmap(r);
        u32x4 o; o.x = pk2(q[0 * 65], q[1 * 65]); o.y = pk2(q[2 * 65], q[3 * 65]); o.z = pk2(q[4 * 65], q[5 * 65]); o.w = pk2(q[6 * 65], q[7 * 65]);
        *(u32x4*)(WT + (size_t)(n0 + r) * K + k0 + 8 * kc) = o; }
    LDS_WAIT(); asm volatile("" ::: "memory");
}
struct DMapId { __device__ __forceinline__ int operator()(int r) const { return r; } };
struct DMapGU { __device__ __forceinline__ int operator()(int r) const { return ((r >> 4) & 1) * 32 + (r >> 5) * 16 + (r & 15); } };
constexpr int IT_WIN = (NP / 64) * 16, IT_WBR = 3 * 16 * 8, IT_WOUT = 16 * 16, IT_WGU = NE * 16 * 16, IT_WDN = NE * 16 * 8, IT_LAYER = IT_WIN + IT_WBR + IT_WOUT + IT_WGU + IT_WDN;
__device__ __forceinline__ void phase_prep(const Args& a, LAS unsigned char* lds, int gw, int NGW, int wave, int lane, int gtid, int NGT) {
    LAS float* scr = (LAS float*)(lds + wave * 17408);
    for (int it = gw; it < DEPTH * IT_LAYER; it += NGW) {
        const int l = it / IT_LAYER; int r = it % IT_LAYER;
        unsigned char* lw = a.ws + WS_W + (size_t)l * LW_SIZE;
        if (r < IT_WIN) {
            const int g = r / 16, kb = r % 16;
            if (g >= C_GP / 64 && g < C_XB / 64) continue;
            const int n0 = 64 * g, src = n0 < C_GP ? n0 : n0 - 240;
            const float* W = (const float*)a.in[3] + (size_t)l * D * WIN_N + src;
            tr_item64(W, W + 32, WIN_N, n0 < 256 ? 0.125f : 1.f, (bf16_t*)(lw + LW_WIN), D, n0, 64 * kb, scr, lane, DMapId());
            continue; }
        r -= IT_WIN;
        if (r < IT_WBR) {
            const int b = r / 128, g = (r % 128) / 8, kb = r % 8;
            const float* W = (const float*)a.in[16] + ((size_t)l * 3 + b) * 512 * D + 64 * g;
            tr_item64(W, W + 32, D, 1.f, (bf16_t*)(lw + LW_WBR) + (size_t)b * D * 512, 512, 64 * g, 64 * kb, scr, lane, DMapId());
            continue; }
        r -= IT_WBR;
        if (r < IT_WOUT) {
            const int g = r / 16, kb = r % 16;
            const float* W = (const float*)a.in[17] + (size_t)l * D * D + 64 * g;
            tr_item64(W, W + 32, D, 1.f, (bf16_t*)(lw + LW_WOUT), D, 64 * g, 64 * kb, scr, lane, DMapId());
            continue; }
        r -= IT_WOUT;
        if (r < IT_WGU) {
            const int e = r / 256, g = (r % 256) / 16, kb = r % 16;
            const float* Wg = (const float*)a.in[21] + ((size_t)l * NE + e) * D * FF + 32 * g;
            const float* Wu = (const float*)a.in[22] + ((size_t)l * NE + e) * D * FF + 32 * g;
            tr_item64(Wg, Wu, FF, 1.f, (bf16_t*)(lw + LW_WGU) + (size_t)e * 1024 * D, D, 64 * g, 64 * kb, scr, lane, DMapGU());
            continue; }
        r -= IT_WGU;
        {
            const int e = r / 128, g = (r % 128) / 8, kb = r % 8;
            const float* W = (const float*)a.in[23] + ((size_t)l * NE + e) * FF * D + 64 * g;
            tr_item64(W, W + 32, D, 1.f, (bf16_t*)(lw + LW_WDN) + (size_t)e * D * FF, FF, 64 * g, 64 * kb, scr, lane, DMapId());
        }
    }
    for (int idx = gtid; idx < DEPTH * 256 * D; idx += NGT) {
        const int l = idx / (256 * D), j = (idx / D) % 256, k = idx % D;
        const float* W = (const float*)a.in[3] + (size_t)l * D * WIN_N + (size_t)k * WIN_N + 1536;
        const float* gu = (const float*)a.in[4] + (size_t)l * 16 * 256 + j;
        float s = 0.f;
#pragma unroll
        for (int r = 0; r < 16; ++r) s += W[r] * gu[r * 256];
        ((bf16_t*)(a.ws + WS_W + (size_t)l * LW_SIZE + LW_WIN))[(size_t)(C_GP + j) * D + k] = (bf16_t)f2bf(s);
    }
}

__device__ __forceinline__ void moe_tables(const unsigned* cnt, LAS int* pt, LAS int* lc, int tid) {
    if (tid == 0) { int s = 0;
        for (int e = 0; e < NE; ++e) { const int c = (int)__hip_atomic_load(cnt + e, __ATOMIC_RELAXED, __HIP_MEMORY_SCOPE_AGENT); pt[e] = s; lc[e] = c; s += (c + 255) >> 8; }
        pt[NE] = s; }
    __syncthreads();
}

template <bool COMBINE, bool NORM, bool SRC_OUT>
__device__ __forceinline__ void phase_norm1(const Ctx& c, const float* gain, LAS const int* pt) {
    const int gw = c.bid * NWAVES + c.wave, NGW = c.G * NWAVES, lane = c.lane;
    f32x4 g4[4];
    if (NORM) {
#pragma unroll
        for (int j = 0; j < 4; ++j) g4[j] = *((const f32x4*)gain + 64 * j + lane); }
    constexpr int NR = 4;
    static_assert(TT % (NR * 2048) == 0, "rows per wave");
    for (int tok0 = gw; tok0 < TT; tok0 += NR * NGW) {
        f32x4 v[NR][4]; u32x2 ya[NR][4], yb[NR][4]; float w0[NR], w1[NR];
#pragma unroll
        for (int r = 0; r < NR; ++r) { const int tok = tok0 + r * NGW;
            const f32x4* xr = (const f32x4*)((SRC_OUT ? (const float*)c.xof : c.xinf) + (size_t)tok * D) + lane;
#pragma unroll
            for (int j = 0; j < 4; ++j) v[r][j] = xr[64 * j];
            if (COMBINE) {
                const u32x4 rc = *(const u32x4*)(c.rec + (size_t)tok * 4);
                const int e0 = rc.x >> 20, e1 = rc.y >> 20;
                const size_t r0 = (size_t)pt[e0] * 256 + (rc.x & 0xfffffu), r1 = (size_t)pt[e1] * 256 + (rc.y & 0xfffffu);
                w0[r] = __uint_as_float(rc.z); w1[r] = __uint_as_float(rc.w);
                const u32x2* y0 = (const u32x2*)(c.ys + r0 * D) + lane; const u32x2* y1 = (const u32x2*)(c.ys + r1 * D) + lane;
#pragma unroll
                for (int j = 0; j < 4; ++j) { ya[r][j] = y0[64 * j]; yb[r][j] = y1[64 * j]; }
            } }
#pragma unroll
        for (int r = 0; r < NR; ++r) { const int tok = tok0 + r * NGW;
            if (COMBINE) {
#pragma unroll
                for (int j = 0; j < 4; ++j) { const u32x2 a = ya[r][j], b = yb[r][j];
                    v[r][j].x += w0[r] * bflo(a.x) + w1[r] * bflo(b.x); v[r][j].y += w0[r] * bfhi(a.x) + w1[r] * bfhi(b.x);
                    v[r][j].z += w0[r] * bflo(a.y) + w1[r] * bflo(b.y); v[r][j].w += w0[r] * bfhi(a.y) + w1[r] * bfhi(b.y); }
                f32x4* xw = (f32x4*)(c.xof + (size_t)tok * D) + lane;
#pragma unroll
                for (int j = 0; j < 4; ++j) xw[64 * j] = v[r][j];
            }
            if (NORM) {
                float ss = 0.f;
#pragma unroll
                for (int j = 0; j < 4; ++j) ss += (v[r][j].x * v[r][j].x + v[r][j].y * v[r][j].y) + (v[r][j].z * v[r][j].z + v[r][j].w * v[r][j].w);
                const float rs = rsqf_(wave_sum(ss) * (1.f / D) + RMS_EPS);
                u32x2* o = (u32x2*)(c.actf + (size_t)tok * D) + lane;
#pragma unroll
                for (int j = 0; j < 4; ++j) { u32x2 w; w.x = pk2(v[r][j].x * rs * g4[j].x, v[r][j].y * rs * g4[j].y); w.y = pk2(v[r][j].z * rs * g4[j].z, v[r][j].w * rs * g4[j].w); o[64 * j] = w; }
            } }
    }
}

__constant__ double kInvFreq[16] = {1.0, 0.44036660267178046, 0.19392274474868576, 0.08539710028576561, 0.03760603093086393, 0.016560440080994446, 0.007292664737217109, 0.003211445994752591,
    0.001414213562373095, 0.000622772421914596, 0.0002742481756762073, 0.00012076973741146504, 5.318295896944988e-05, 2.341999896140934e-05, 1.031338537721246e-05, 4.5416704806078695e-06};
__device__ __forceinline__ void phase_rope_table(const int* pos, float* tab, int gtid, int NGT) {
    for (int idx = gtid; idx < BATCH * SEQ * 16; idx += NGT) { const int tok = idx >> 4, i = idx & 15;
        double a = (double)pos[tok] * kInvFreq[i] * 0.15915494309189535; a -= rint(a);
        tab[(size_t)tok * 32 + i] = __builtin_amdgcn_cosf((float)a); tab[(size_t)tok * 32 + 16 + i] = __builtin_amdgcn_sinf((float)a); }
}

__device__ __forceinline__ float logsigmoidf_(float g) { return fminf(g, 0.f) - log1pf(__expf(-fabsf(g))); }
__device__ __forceinline__ float gelu_tanh(float y) { const float u2 = 1.5957691216057308f * (y + 0.044715f * y * y * y); return y * __builtin_amdgcn_rcpf(1.f + __expf(-u2)); }


typedef unsigned short u16x4 __attribute__((ext_vector_type(4)));
__device__ __forceinline__ unsigned offb(unsigned row, unsigned ch) { return 256u * row + 16u * (ch ^ (((row & 3u) << 2) | ((row >> 2) & 3u))); }
constexpr int ATT_UNITS_PER_SEQ = 3 * 4 * 16;
struct AttU { int b, p, h, blk, dsh, it0; size_t tok0; int qcol, kcol, vcol; };
__device__ __forceinline__ AttU att_decode(int unit) {
    AttU a; a.b = unit / ATT_UNITS_PER_SEQ; const int rem = unit % ATT_UNITS_PER_SEQ; a.p = rem / 64; a.h = (rem / 16) & 3; const int qb = rem & 15;
    a.dsh = 2 * a.p; const int nblk = 16 >> a.dsh, r = qb / nblk; a.blk = qb % nblk; a.tok0 = (size_t)a.b * SEQ + r; a.it0 = a.blk == 0 ? 4 : 0;
    a.qcol = C_QKV + (a.p * 4 + a.h) * 128; a.kcol = C_QKV + (12 + a.p * 4 + a.h) * 128; a.vcol = C_QKV + (24 + a.p * 4 + a.h) * 128; return a;
}
#define ATT_DMA(U, col, dst) do { _Pragma("unroll") for (int it = 0; it < 8; ++it) if (it >= (U).it0) { const int q = w + 8 * it; const unsigned n = 64u * q + lane, row = n >> 4, cs = n & 15u, ch = cs ^ (((row & 3u) << 2) | ((row >> 2) & 3u)); \
        const int srow = ((U).blk - 1) * 128 + (int)row; \
        __builtin_amdgcn_global_load_lds((const unsigned*)(c.proj + ((U).tok0 + ((size_t)srow << (U).dsh)) * NP + (col) + ch * 8), (LAS unsigned*)((dst) + 1024 * q), 16, 0, 0); } } while (0)
#define ATT_LOADQ(U) do { const size_t qt = (U).tok0 + ((size_t)((U).blk * 128 + qi) << (U).dsh); \
        _Pragma("unroll") for (int s = 0; s < 4; ++s) qr[s] = *(const u32x4*)(c.proj + qt * NP + (U).qcol + 32 * s + 8 * g); \
        const f32x4* rt = (const f32x4*)(rope_tab + qt * 32 + 8 * (g & 1)); qc0 = rt[0]; qc1 = rt[1]; qs0 = rt[4]; qs1 = rt[5]; \
        int srow = ((U).blk - 1) * 128 + (int)rrow; if (srow < 0) srow += 128; \
        const float* rt2 = rope_tab + ((U).tok0 + ((size_t)srow << (U).dsh)) * 32 + 8 * rps; \
        rc0 = *(const f32x4*)rt2; rc1 = *(const f32x4*)(rt2 + 4); rs0 = *(const f32x4*)(rt2 + 16); rs1 = *(const f32x4*)(rt2 + 20); } while (0)
__device__ __forceinline__ void attn_loop(const Ctx& c, unsigned* qhead, volatile LAS unsigned* mbox, float* lse_buf, const float* qgain, const float* kgain, const float* rope_tab  ) {
    const int tid = c.tid, lane = c.lane, w = c.wave;
    const unsigned NU = (unsigned)(BC * ATT_UNITS_PER_SEQ);
    LAS unsigned char* sK = c.lds; LAS unsigned char* sV = c.lds + 65536;
    LAS float* sRS = (LAS float*)(c.lds + MISC_OFF + 2048);
    const int qq = lane & 15, g = lane >> 4, qi = 16 * w + qq;
    const unsigned rrow = (unsigned)tid >> 1, rps = (unsigned)tid & 1u;
#if defined(PROBE_MASK) && PROBE_MASK
    unsigned long long _ta = __builtin_amdgcn_s_memrealtime();
#define ATT_STAMP(k) do { const unsigned long long _tb = __builtin_amdgcn_s_memrealtime(); if (blockIdx.x == PROBE_BLOCK && tid == 0) ((LAS unsigned*)(c.lds + MISC_OFF + 512))[(k)] += (unsigned)(_tb - _ta); _ta = _tb; } while (0)
#else
#define ATT_STAMP(k) do {} while (0)
#endif
    LAS float* sGQ = (LAS float*)(c.lds + MISC_OFF + 3072); LAS float* sGK = sGQ + 128;
    if (tid < 128) sGQ[tid] = qgain[tid]; else if (tid < 256) sGK[tid - 128] = kgain[tid - 128];
    if (tid == 0) { mbox[0] = __hip_atomic_fetch_add(qhead, 1u, __ATOMIC_RELAXED, __HIP_MEMORY_SCOPE_AGENT); mbox[1] = __hip_atomic_fetch_add(qhead, 1u, __ATOMIC_RELAXED, __HIP_MEMORY_SCOPE_AGENT); }
    __syncthreads();
    unsigned ucur = mbox[0], unxt = mbox[1];
    if (ucur >= NU) return;
    AttU U = att_decode((int)ucur);
    u32x4 qr[4]; f32x4 qc0, qc1, qs0, qs1, rc0, rc1, rs0, rs1;
    __syncthreads();
    ATT_DMA(U, U.kcol, sK); asm volatile("" ::: "memory");
    ATT_LOADQ(U); asm volatile("" ::: "memory");
    ATT_DMA(U, U.vcol, sV); asm volatile("" ::: "memory");
    bool first = true; unsigned nq = 0u;
    for (;;) {
        const int blk = U.blk, dsh = U.dsh, it0 = U.it0;
        const size_t qtok = U.tok0 + ((size_t)(blk * 128 + qi) << dsh);
        bf16x8 qf[4];
        {
            float qv[4][8]; float ss = 0.f;
#pragma unroll
            for (int s = 0; s < 4; ++s) { const unsigned wv[4] = {qr[s].x, qr[s].y, qr[s].z, qr[s].w};
#pragma unroll
                for (int k = 0; k < 4; ++k) { qv[s][2 * k] = bflo(wv[k]); qv[s][2 * k + 1] = bfhi(wv[k]); ss += qv[s][2 * k] * qv[s][2 * k] + qv[s][2 * k + 1] * qv[s][2 * k + 1]; } }
            ss += swz_xor<16>(ss);
            { const auto rr = __builtin_amdgcn_permlane32_swap(__float_as_uint(ss), __float_as_uint(ss), false, false); ss = __uint_as_float(rr[0]) + __uint_as_float(rr[1]); }
            const float rs = rsqf_(ss * (1.f / 128.f) + RMS_EPS);
#pragma unroll
            for (int s = 0; s < 4; ++s) { const f32x4 g0 = *(const LAS f32x4*)(sGQ + 32 * s + 8 * g), g1 = *(const LAS f32x4*)(sGQ + 32 * s + 8 * g + 4);
                const float gg[8] = {g0.x, g0.y, g0.z, g0.w, g1.x, g1.y, g1.z, g1.w};
#pragma unroll
                for (int j = 0; j < 8; ++j) qv[s][j] *= rs * gg[j]; }
            { const float cs8[8] = {qc0.x, qc0.y, qc0.z, qc0.w, qc1.x, qc1.y, qc1.z, qc1.w}, sn8[8] = {qs0.x, qs0.y, qs0.z, qs0.w, qs1.x, qs1.y, qs1.z, qs1.w};
              const float sgn = (g & 2) ? 1.f : -1.f;
#pragma unroll
              for (int j = 0; j < 8; ++j) { const auto rr = __builtin_amdgcn_permlane32_swap(__float_as_uint(qv[0][j]), __float_as_uint(qv[0][j]), false, false);
                  const float other = (g & 2) ? __uint_as_float(rr[0]) : __uint_as_float(rr[1]);
                  qv[0][j] = qv[0][j] * cs8[j] + sgn * other * sn8[j]; } }
#pragma unroll
            for (int s = 0; s < 4; ++s) { u32x4 pw; pw.x = pk2(qv[s][0], qv[s][1]); pw.y = pk2(qv[s][2], qv[s][3]); pw.z = pk2(qv[s][4], qv[s][5]); pw.w = pk2(qv[s][6], qv[s][7]); qf[s] = __builtin_bit_cast(bf16x8, pw); }
        }
        const f32x4 kc0 = rc0, kc1 = rc1, ks0v = rs0, ks1v = rs1;
        if (first) { if (it0) asm volatile("s_waitcnt vmcnt(4)" ::: "memory"); else asm volatile("s_waitcnt vmcnt(8)" ::: "memory"); }
        else       { if (it0) asm volatile("s_waitcnt vmcnt(13)" ::: "memory"); else asm volatile("s_waitcnt vmcnt(17)" ::: "memory"); }
        first = false;
        __syncthreads();
        if (tid == 0) nq = __hip_atomic_fetch_add(qhead, 1u, __ATOMIC_RELAXED, __HIP_MEMORY_SCOPE_AGENT);
        ATT_STAMP(5);
        {
            const int c16 = tid & 15, grp = tid >> 4;
            const f32x4 kg0 = *(const LAS f32x4*)(sGK + 8 * c16), kg1 = *(const LAS f32x4*)(sGK + 8 * c16 + 4);
            const float kg[8] = {kg0.x, kg0.y, kg0.z, kg0.w, kg1.x, kg1.y, kg1.z, kg1.w};
#pragma unroll 4
            for (int it = it0; it < 8; ++it) { const unsigned row = 32u * it + grp;
                LAS u32x4* kp_ = (LAS u32x4*)(sK + offb(row, c16));
                const u32x4 kr = *kp_; const unsigned wv[4] = {kr.x, kr.y, kr.z, kr.w};
                float kv[8]; float ss = 0.f;
#pragma unroll
                for (int k = 0; k < 4; ++k) { kv[2 * k] = bflo(wv[k]); kv[2 * k + 1] = bfhi(wv[k]); ss += kv[2 * k] * kv[2 * k] + kv[2 * k + 1] * kv[2 * k + 1]; }
                ss += swz_xor<1>(ss); ss += swz_xor<2>(ss); ss += swz_xor<4>(ss); ss += swz_xor<8>(ss);
                const float rs = rsqf_(ss * (1.f / 128.f) + RMS_EPS);
                if (c16 == 0) sRS[row] = rs;
                if (c16 >= 4) { u32x4 ko; ko.x = pk2(kv[0] * rs * kg[0], kv[1] * rs * kg[1]); ko.y = pk2(kv[2] * rs * kg[2], kv[3] * rs * kg[3]); ko.z = pk2(kv[4] * rs * kg[4], kv[5] * rs * kg[5]); ko.w = pk2(kv[6] * rs * kg[6], kv[7] * rs * kg[7]); *kp_ = ko; } }
        }
        __syncthreads();
        {
            const f32x4 ga0 = *(const LAS f32x4*)(sGK + 8 * rps), ga1 = *(const LAS f32x4*)(sGK + 8 * rps + 4), gb0 = *(const LAS f32x4*)(sGK + 16 + 8 * rps), gb1 = *(const LAS f32x4*)(sGK + 20 + 8 * rps);
            const float ga[8] = {ga0.x, ga0.y, ga0.z, ga0.w, ga1.x, ga1.y, ga1.z, ga1.w}, gb[8] = {gb0.x, gb0.y, gb0.z, gb0.w, gb1.x, gb1.y, gb1.z, gb1.w};
            const float cs8[8] = {kc0.x, kc0.y, kc0.z, kc0.w, kc1.x, kc1.y, kc1.z, kc1.w}, sn8[8] = {ks0v.x, ks0v.y, ks0v.z, ks0v.w, ks1v.x, ks1v.y, ks1v.z, ks1v.w};
            if (blk > 0 || rrow >= 128u) {
            LAS u32x4* p1 = (LAS u32x4*)(sK + offb(rrow, rps)); LAS u32x4* p2 = (LAS u32x4*)(sK + offb(rrow, rps + 2));
            const u32x4 a = *p1, b2 = *p2; const float rs = sRS[rrow];
            const unsigned wa[4] = {a.x, a.y, a.z, a.w}, wb[4] = {b2.x, b2.y, b2.z, b2.w};
            float o1[8], o2[8];
#pragma unroll
            for (int k = 0; k < 4; ++k) {
#pragma unroll
                for (int e = 0; e < 2; ++e) { const int j = 2 * k + e; const float x1 = (e ? bfhi(wa[k]) : bflo(wa[k])) * rs * ga[j], x2 = (e ? bfhi(wb[k]) : bflo(wb[k])) * rs * gb[j];
                    o1[j] = x1 * cs8[j] - x2 * sn8[j]; o2[j] = x2 * cs8[j] + x1 * sn8[j]; } }
            u32x4 w1, w2; w1.x = pk2(o1[0], o1[1]); w1.y = pk2(o1[2], o1[3]); w1.z = pk2(o1[4], o1[5]); w1.w = pk2(o1[6], o1[7]); w2.x = pk2(o2[0], o2[1]); w2.y = pk2(o2[2], o2[3]); w2.z = pk2(o2[4], o2[5]); w2.w = pk2(o2[6], o2[7]);
            *p1 = w1; *p2 = w2; }
        }
        __syncthreads();
        ATT_STAMP(6);
        const int ks0 = w >> 1, nskip = blk == 0 ? 4 : 0;
        f32x4 st[5][2];
        const unsigned krow_l = 8u * (qq >> 2) + (qq & 3u);
        LAS unsigned char* ka[2][4];
#pragma unroll
        for (int T = 0; T < 2; ++T)
#pragma unroll
            for (int s = 0; s < 4; ++s) ka[T][s] = sK + offb(32u * ks0 + krow_l + 4u * T, 4 * s + g);
#pragma unroll
        for (int n = 0; n < 5; ++n)
#pragma unroll
            for (int T = 0; T < 2; ++T) { f32x4 a = {0.f, 0.f, 0.f, 0.f};
                if (ks0 + n >= nskip) {
#pragma unroll
                for (int s = 0; s < 4; ++s) { const bf16x8 kf = *(const LAS bf16x8*)(ka[T][s] + 8192 * n); a = __builtin_amdgcn_mfma_f32_16x16x32_bf16(kf, qf[s], a, 0, 0, 0); } }
                st[n][T] = a; }
        asm volatile("s_waitcnt vmcnt(0) lgkmcnt(0)" ::: "memory");
        if (tid == 0) mbox[0] = nq;
        __syncthreads();
        const bool has_next = unxt < NU;
        AttU UN = att_decode(has_next ? (int)unxt : 0);
        if (has_next) { ATT_DMA(UN, UN.kcol, sK); asm volatile("" ::: "memory"); ATT_LOADQ(UN); }
        asm volatile("" ::: "memory");
        const float SC = 0.08838834764831845f * 1.4426950408889634f;
        float mx = -INFINITY;
#pragma unroll
        for (int n = 0; n < 5; ++n)
#pragma unroll
            for (int T = 0; T < 2; ++T)
#pragma unroll
                for (int i = 0; i < 4; ++i) { const int kj = 32 * (ks0 + n) + 8 * g + 4 * T + i;
                    bool ok = true;
                    if (n == 0) ok = kj >= qi;
                    if (n == 4) ok = kj <= qi + 128;
                    if (blk == 0) ok = ok && (kj >= 128);
                    const float v = ok ? st[n][T][i] : -INFINITY; st[n][T][i] = v; mx = fmaxf(mx, v); }
        mx = fmaxf(mx, swz_xor<16>(mx));
        { const auto rr = __builtin_amdgcn_permlane32_swap(__float_as_uint(mx), __float_as_uint(mx), false, false); mx = fmaxf(__uint_as_float(rr[0]), __uint_as_float(rr[1])); }
        float sum = 0.f; const float mxs = mx * SC;
#pragma unroll
        for (int n = 0; n < 5; ++n)
#pragma unroll
            for (int T = 0; T < 2; ++T)
#pragma unroll
                for (int i = 0; i < 4; ++i) { const float e = __builtin_amdgcn_exp2f(__builtin_fmaf(st[n][T][i], SC, -mxs)); st[n][T][i] = e; sum += e; }
        sum += swz_xor<16>(sum);
        { const auto rr = __builtin_amdgcn_permlane32_swap(__float_as_uint(sum), __float_as_uint(sum), false, false); sum = __uint_as_float(rr[0]) + __uint_as_float(rr[1]); }
        const float inv = rcpf_(sum);
        ATT_STAMP(7);
        f32x4 ot[8];
#pragma unroll
        for (int cc = 0; cc < 8; ++cc) ot[cc] = (f32x4){0.f, 0.f, 0.f, 0.f};
        const unsigned tq = (unsigned)qq >> 2, tp = (unsigned)qq & 3u;
        const unsigned vbase = (unsigned)(size_t)sV;
        unsigned va[2][8];
#pragma unroll
        for (int t = 0; t < 2; ++t)
#pragma unroll
            for (int cc = 0; cc < 8; ++cc) va[t][cc] = vbase + offb(32u * ks0 + 8u * g + 4u * t + tq, 2 * cc + (tp >> 1)) + 8u * (tp & 1u);
#pragma unroll
        for (int n = 0; n < 5; ++n) if (ks0 + n >= nskip) {
            u32x4 pw; pw.x = pk2(st[n][0][0], st[n][0][1]); pw.y = pk2(st[n][0][2], st[n][0][3]); pw.z = pk2(st[n][1][0], st[n][1][1]); pw.w = pk2(st[n][1][2], st[n][1][3]);
            const bf16x8 pf = __builtin_bit_cast(bf16x8, pw);
            u16x4 v0[8], v1[8];
            asm volatile("ds_read_b64_tr_b16 %0, %16 offset:%32\n\tds_read_b64_tr_b16 %8, %24 offset:%32\n\t"
                         "ds_read_b64_tr_b16 %1, %17 offset:%32\n\tds_read_b64_tr_b16 %9, %25 offset:%32\n\t"
                         "ds_read_b64_tr_b16 %2, %18 offset:%32\n\tds_read_b64_tr_b16 %10, %26 offset:%32\n\t"
                         "ds_read_b64_tr_b16 %3, %19 offset:%32\n\tds_read_b64_tr_b16 %11, %27 offset:%32\n\t"
                         "ds_read_b64_tr_b16 %4, %20 offset:%32\n\tds_read_b64_tr_b16 %12, %28 offset:%32\n\t"
                         "ds_read_b64_tr_b16 %5, %21 offset:%32\n\tds_read_b64_tr_b16 %13, %29 offset:%32\n\t"
                         "ds_read_b64_tr_b16 %6, %22 offset:%32\n\tds_read_b64_tr_b16 %14, %30 offset:%32\n\t"
                         "ds_read_b64_tr_b16 %7, %23 offset:%32\n\tds_read_b64_tr_b16 %15, %31 offset:%32\n\t"
                         "s_waitcnt lgkmcnt(0)"
                         : "=&v"(v0[0]), "=&v"(v0[1]), "=&v"(v0[2]), "=&v"(v0[3]), "=&v"(v0[4]), "=&v"(v0[5]), "=&v"(v0[6]), "=&v"(v0[7]),
                           "=&v"(v1[0]), "=&v"(v1[1]), "=&v"(v1[2]), "=&v"(v1[3]), "=&v"(v1[4]), "=&v"(v1[5]), "=&v"(v1[6]), "=&v"(v1[7])
                         : "v"(va[0][0]), "v"(va[0][1]), "v"(va[0][2]), "v"(va[0][3]), "v"(va[0][4]), "v"(va[0][5]), "v"(va[0][6]), "v"(va[0][7]),
                           "v"(va[1][0]), "v"(va[1][1]), "v"(va[1][2]), "v"(va[1][3]), "v"(va[1][4]), "v"(va[1][5]), "v"(va[1][6]), "v"(va[1][7]), "i"(8192 * n) : "memory");
#pragma unroll
            for (int cc = 0; cc < 8; ++cc) {
                bf16x8 vf; vf[0] = (short)v0[cc][0]; vf[1] = (short)v0[cc][1]; vf[2] = (short)v0[cc][2]; vf[3] = (short)v0[cc][3]; vf[4] = (short)v1[cc][0]; vf[5] = (short)v1[cc][1]; vf[6] = (short)v1[cc][2]; vf[7] = (short)v1[cc][3];
                ot[cc] = __builtin_amdgcn_mfma_f32_16x16x32_bf16(vf, pf, ot[cc], 0, 0, 0);
            }
        }
        __syncthreads();
        asm volatile("" ::: "memory");
        if (has_next) ATT_DMA(UN, UN.vcol, sV);
        asm volatile("" ::: "memory");
        bf16_t* orow = c.proj + qtok * NP + U.qcol;
#pragma unroll
        for (int cc = 0; cc < 8; ++cc) { u32x2 o; o.x = pk2(ot[cc][0] * inv, ot[cc][1] * inv); o.y = pk2(ot[cc][2] * inv, ot[cc][3] * inv); *(u32x2*)(orow + 16 * cc + 4 * g) = o; }
        if (g == 0) lse_buf[qtok * 12 + U.p * 4 + U.h] = mx * 0.08838834764831845f + __logf(sum);
        ATT_STAMP(8);
        if (!has_next) break;
        U = UN; unxt = mbox[0];
    }
    asm volatile("s_waitcnt vmcnt(0)" ::: "memory");
    __syncthreads();
}
#undef ATT_STAMP
#undef ATT_DMA
#undef ATT_LOADQ

__device__ __forceinline__ void phase_attn_combine(const Ctx& c, const float* lse_buf) {
    const int gw = c.bid * NWAVES + c.wave, NGW = c.G * NWAVES, lane = c.lane;
    constexpr int NR = 2;
    for (int tok0 = gw; tok0 < TC; tok0 += NR * NGW) {
        unsigned u[NR][3][4]; float l[NR][12];
#pragma unroll
        for (int r = 0; r < NR; ++r) { const int tok = tok0 + r * NGW;
            const float* ls = lse_buf + (size_t)tok * 12; const bf16_t* row = c.proj + (size_t)tok * NP + C_QKV;
#pragma unroll
            for (int k = 0; k < 12; ++k) l[r][k] = ls[k];
#pragma unroll
            for (int p = 0; p < 3; ++p)
#pragma unroll
                for (int h = 0; h < 4; ++h) u[r][p][h] = *((const unsigned*)(row + (4 * p + h) * 128) + lane); }
#pragma unroll
        for (int r = 0; r < NR; ++r) { const int tok = tok0 + r * NGW;
#pragma unroll
            for (int h = 0; h < 4; ++h) {
                const float l0 = l[r][h], l1 = l[r][4 + h], l2 = l[r][8 + h], ml = fmaxf(l0, fmaxf(l1, l2));
                const float w0 = __expf(l0 - ml), w1 = __expf(l1 - ml), w2 = __expf(l2 - ml), wi = rcpf_(w0 + w1 + w2);
                *((unsigned*)(c.proj + (size_t)tok * NP + C_QKV + h * 128) + lane) =
                    pk2((w0 * bflo(u[r][0][h]) + w1 * bflo(u[r][1][h]) + w2 * bflo(u[r][2][h])) * wi, (w0 * bfhi(u[r][0][h]) + w1 * bfhi(u[r][1][h]) + w2 * bfhi(u[r][2][h])) * wi);
            } }
    }
}

__device__ __forceinline__ int crow(int reg, int hh) { return (reg & 3) + 8 * (reg >> 2) + 4 * hh; }
typedef float f32x16 __attribute__((ext_vector_type(16)));
__device__ __forceinline__ unsigned tr_addr32(unsigned lane, unsigned rowbase, unsigned cblk, unsigned t, bool perm) {
    const unsigned hh = lane >> 5, blk = (lane >> 4) & 1u, q = (lane & 15u) >> 2, p = lane & 3u;
    const unsigned row = rowbase + (perm ? 8u * t + 4u * hh : 8u * hh + 4u * t) + q;
    return offb(row, 4u * cblk + 2u * blk + (p >> 1)) + 8u * (p & 1u);
}
__device__ __forceinline__ bf16x8 tr_frag(unsigned a0, unsigned a1) {
    u16x4 v0, v1;
    asm volatile("ds_read_b64_tr_b16 %0, %2\n\tds_read_b64_tr_b16 %1, %3\n\ts_waitcnt lgkmcnt(0)" : "=&v"(v0), "=&v"(v1) : "v"(a0), "v"(a1) : "memory");
    bf16x8 f; f[0] = (short)v0[0]; f[1] = (short)v0[1]; f[2] = (short)v0[2]; f[3] = (short)v0[3]; f[4] = (short)v1[0]; f[5] = (short)v1[1]; f[6] = (short)v1[2]; f[7] = (short)v1[3];
    return f;
}
__device__ __forceinline__ void tr_frag4(const unsigned (&a)[8], bf16x8 (&f)[4]) {
    u16x4 v[8];
    asm volatile("ds_read_b64_tr_b16 %0, %8\n\tds_read_b64_tr_b16 %1, %9\n\tds_read_b64_tr_b16 %2, %10\n\tds_read_b64_tr_b16 %3, %11\n\t"
                 "ds_read_b64_tr_b16 %4, %12\n\tds_read_b64_tr_b16 %5, %13\n\tds_read_b64_tr_b16 %6, %14\n\tds_read_b64_tr_b16 %7, %15\n\ts_waitcnt lgkmcnt(0)"
                 : "=&v"(v[0]), "=&v"(v[1]), "=&v"(v[2]), "=&v"(v[3]), "=&v"(v[4]), "=&v"(v[5]), "=&v"(v[6]), "=&v"(v[7])
                 : "v"(a[0]), "v"(a[1]), "v"(a[2]), "v"(a[3]), "v"(a[4]), "v"(a[5]), "v"(a[6]), "v"(a[7]) : "memory");
#pragma unroll
    for (int k = 0; k < 4; ++k) { f[k][0] = (short)v[2 * k][0]; f[k][1] = (short)v[2 * k][1]; f[k][2] = (short)v[2 * k][2]; f[k][3] = (short)v[2 * k][3];
        f[k][4] = (short)v[2 * k + 1][0]; f[k][5] = (short)v[2 * k + 1][1]; f[k][6] = (short)v[2 * k + 1][2]; f[k][7] = (short)v[2 * k + 1][3]; }
}
constexpr int GLA_QK = 0, GLA_KD = 16384, GLA_V = 32768  , GLA_ST = 65536  , GLA_O = 102400  , GLA_SEG = 136192  , GLA_DEC = 138240  ;
static_assert(GLA_DEC + 256 <= RING_BYTES, "gla lds");
__device__ __forceinline__ void gla_unit(const Ctx& c, int unit, const float* gbias, const float* ogain) {
    const int tid = c.tid, lane = c.lane, w = c.wave;
    const int b = unit >> 2, h = unit & 3;
    LAS unsigned char* L = c.lds;
    const unsigned hh = lane >> 5, r31 = lane & 31;
    const int ti = w >> 2, tv = w & 3;
    f32x16 St;
#pragma unroll
    for (int i = 0; i < 16; ++i) St[i] = 0.f;
    for (int i = tid; i < 18432 / 4; i += NTHR) ((LAS unsigned*)(L + GLA_ST))[i] = 0u;
    const float bias_d = gbias[h * 64 + lane];
    const int i3 = tid >> 3, seg = tid & 7;
    float gn[16];
#pragma unroll
    for (int k = 0; k < 16; ++k) gn[k] = ogain[16 * seg + k];
    const size_t tokb = (size_t)b * SEQ;
    unsigned short pq[8], pk[8], pg[8];
    u32x4 ogc0, ogc1, ogn0, ogn1;
#define GLA_PREFETCH(n) do { _Pragma("unroll") for (int rr = 0; rr < 8; ++rr) { const bf16_t* row = c.proj + (tokb + (n) * 64 + 8 * w + rr) * NP + h * 64 + lane; \
        pq[rr] = row[C_QA]; pk[rr] = row[C_KA]; pg[rr] = row[C_GP]; } } while (0)
#define GLA_OG(n, d0, d1) do { const bf16_t* ogp = c.proj + (tokb + (n) * 64 + i3) * NP + C_OG + h * 128 + 16 * seg; d0 = *(const u32x4*)ogp; d1 = *((const u32x4*)ogp + 1); } while (0)
#define GLA_VDMA(n) do { _Pragma("unroll") for (int it = 0; it < 2; ++it) { const int q = w + 8 * it; const unsigned nn = 64u * q + lane, row = nn >> 4, cs = nn & 15u, ch = cs ^ (((row & 3u) << 2) | ((row >> 2) & 3u)); \
        __builtin_amdgcn_global_load_lds((const unsigned*)(c.proj + (tokb + (n) * 64 + row) * NP + C_VA + h * 128 + ch * 8), (LAS unsigned*)(L + GLA_V + ((n) & 1) * 16384 + 1024 * q), 16, 0, 0); } } while (0)
#define CB() asm volatile("" ::: "memory")
    GLA_PREFETCH(0); CB(); GLA_OG(0, ogc0, ogc1); CB(); GLA_VDMA(0); CB(); GLA_VDMA(1); CB();
    for (int n = 0; n < SEQ / 64; ++n) {
        LAS unsigned char* STr = L + GLA_ST + (n & 1) * 18432; LAS unsigned char* STw = L + GLA_ST + ((n + 1) & 1) * 18432;
        LAS unsigned char* Vb = L + GLA_V + (n & 1) * 16384;
        float cl[8], qv[8], kv[8];
        { float run = 0.f;
#pragma unroll
          for (int rr = 0; rr < 8; ++rr) { const float g = bf2f(pg[rr]) + bias_d; run += (fminf(g, 0.f) - __logf(1.f + __expf(-fabsf(g)))) * (1.f / 16.f); cl[rr] = run; qv[rr] = bf2f(pq[rr]); kv[rr] = bf2f(pk[rr]); }
          ((LAS float*)(L + GLA_SEG))[w * 64 + lane] = run; }
        __syncthreads();
        { float pre = 0.f, tot = 0.f;
#pragma unroll
          for (int s = 0; s < 8; ++s) { const float v = ((LAS float*)(L + GLA_SEG))[s * 64 + lane]; tot += v; pre += (s < w) ? v : 0.f; }
          const float etot = __expf(tot);
          if (w == 0) ((LAS float*)(L + GLA_DEC))[lane] = etot;
#pragma unroll
          for (int rr = 0; rr < 8; ++rr) { const float cum = pre + cl[rr]; const unsigned row = 8 * w + rr;
              const float e = __expf(cum), ei = rcpf_(e), ed = etot * ei;
              const unsigned o1 = offb(row, lane >> 3) + (lane & 7) * 2, o2 = offb(row, 8 + (lane >> 3)) + (lane & 7) * 2;
              *(LAS unsigned short*)(L + GLA_QK + o1) = (unsigned short)f2bf(qv[rr] * e);
              *(LAS unsigned short*)(L + GLA_QK + o2) = (unsigned short)f2bf(kv[rr] * ei);
              *(LAS unsigned short*)(L + GLA_KD + o1) = (unsigned short)f2bf(kv[rr] * ed); } }
        if (n == 0) asm volatile("s_waitcnt vmcnt(2)" ::: "memory"); else asm volatile("s_waitcnt vmcnt(4)" ::: "memory");
        __syncthreads();
        CB();
        if (n + 1 < SEQ / 64) { GLA_OG(n + 1, ogn0, ogn1); CB(); GLA_PREFETCH(n + 1); }
        CB();
        bf16x8 qdf[4];
#pragma unroll
        for (int s = 0; s < 4; ++s) qdf[s] = *(const LAS bf16x8*)(L + GLA_QK + offb(32 * ti + r31, 2 * s + hh));
        f32x16 Z;
#pragma unroll
        for (int i = 0; i < 16; ++i) Z[i] = 0.f;
        { bf16x8 sf[4];
#pragma unroll
          for (int s = 0; s < 4; ++s) sf[s] = *(const LAS bf16x8*)(STr + (32 * tv + r31) * 144 + 32 * s + 16 * hh);
#pragma unroll
          for (int s = 0; s < 4; ++s) Z = __builtin_amdgcn_mfma_f32_32x32x16_bf16(qdf[s], sf[s], Z, 0, 0, 0); }
        const unsigned vb = (unsigned)(size_t)Vb;
#pragma unroll
        for (int tj = 0; tj < 2; ++tj) {
            if (tj <= ti) {
                bf16x8 kf[4];
#pragma unroll
                for (int s = 0; s < 4; ++s) kf[s] = *(const LAS bf16x8*)(L + GLA_QK + offb(32 * tj + r31, 8 + 2 * s + hh));
                unsigned va[8]; bf16x8 vf[4];
#pragma unroll
                for (int s = 0; s < 2; ++s) { va[2 * s] = vb + tr_addr32(lane, 32 * tj + 16 * s, tv, 0, true); va[2 * s + 1] = vb + tr_addr32(lane, 32 * tj + 16 * s, tv, 1, true);
                    va[4 + 2 * s] = va[2 * s]; va[5 + 2 * s] = va[2 * s + 1]; }
                tr_frag4(va, vf);
                f32x16 X;
#pragma unroll
                for (int i = 0; i < 16; ++i) X[i] = 0.f;
#pragma unroll
                for (int s = 0; s < 4; ++s) X = __builtin_amdgcn_mfma_f32_32x32x16_bf16(kf[s], qdf[s], X, 0, 0, 0);
                const int ig = 32 * ti + (int)r31;
#pragma unroll
                for (int i = 0; i < 16; ++i) X[i] = (ig >= 32 * tj + crow(i, hh)) ? X[i] : 0.f;
#pragma unroll
                for (int s = 0; s < 2; ++s) {
                    u32x4 pw; pw.x = pg8::cvt_pk_bf16(X[8 * s + 0], X[8 * s + 1]); pw.y = pg8::cvt_pk_bf16(X[8 * s + 2], X[8 * s + 3]); pw.z = pg8::cvt_pk_bf16(X[8 * s + 4], X[8 * s + 5]); pw.w = pg8::cvt_pk_bf16(X[8 * s + 6], X[8 * s + 7]);
                    Z = __builtin_amdgcn_mfma_f32_32x32x16_bf16(__builtin_bit_cast(bf16x8, pw), vf[s], Z, 0, 0, 0);
                }
            }
        }
#pragma unroll
        for (int i = 0; i < 16; ++i) ((LAS float*)(L + GLA_O))[(32 * ti + crow(i, hh)) * 132 + 32 * tv + r31] = Z[i];
        { const unsigned kb = (unsigned)(size_t)(L + GLA_KD);
          unsigned aa[8], ab[8]; bf16x8 af[4], bfr[4];
#pragma unroll
          for (int s = 0; s < 4; ++s) { aa[2 * s] = kb + tr_addr32(lane, 16 * s, ti, 0, false); aa[2 * s + 1] = kb + tr_addr32(lane, 16 * s, ti, 1, false);
              ab[2 * s] = vb + tr_addr32(lane, 16 * s, tv, 0, false); ab[2 * s + 1] = vb + tr_addr32(lane, 16 * s, tv, 1, false); }
          tr_frag4(aa, af); tr_frag4(ab, bfr);
#pragma unroll
          for (int i = 0; i < 16; ++i) St[i] *= ((LAS float*)(L + GLA_DEC))[32 * ti + crow(i, hh)];
#pragma unroll
          for (int s = 0; s < 4; ++s) St = __builtin_amdgcn_mfma_f32_32x32x16_bf16(af[s], bfr[s], St, 0, 0, 0); }
#pragma unroll
        for (int gq = 0; gq < 4; ++gq) { const float s0 = St[4 * gq], s1 = St[4 * gq + 1], s2 = St[4 * gq + 2], s3 = St[4 * gq + 3];
            u32x2 o; o.x = pk2(s0, s1); o.y = pk2(s2, s3);
            *(LAS u32x2*)(STw + (32 * tv + r31) * 144 + (32 * ti + 8 * gq + 4 * hh) * 2) = o; }
        __syncthreads();
        CB();
        if (n + 2 < SEQ / 64) GLA_VDMA(n + 2);
        CB();
        { const LAS f32x4* op = (const LAS f32x4*)(L + GLA_O + i3 * 528 + seg * 64);
          f32x4 o4[4]; float ss = 0.f;
#pragma unroll
          for (int k = 0; k < 4; ++k) { o4[k] = op[k]; ss += (o4[k].x * o4[k].x + o4[k].y * o4[k].y) + (o4[k].z * o4[k].z + o4[k].w * o4[k].w); }
          ss += swz_xor<1>(ss); ss += swz_xor<2>(ss); ss += swz_xor<4>(ss);
          const float rs = rsqf_(ss * (1.f / 128.f) + RMS_EPS);
          const unsigned ogw[8] = {ogc0.x, ogc0.y, ogc0.z, ogc0.w, ogc1.x, ogc1.y, ogc1.z, ogc1.w};
          unsigned ow[8];
#pragma unroll
          for (int k = 0; k < 8; ++k) { const float g0 = bflo(ogw[k]), g1 = bfhi(ogw[k]);
              const float a0 = o4[k >> 1][(2 * k) & 3] * rs * gn[2 * k] * g0 * sigmoidf_(g0), a1 = o4[k >> 1][(2 * k + 1) & 3] * rs * gn[2 * k + 1] * g1 * sigmoidf_(g1);
              ow[k] = pk2(a0, a1); }
          u32x4 w0, w1; w0.x = ow[0]; w0.y = ow[1]; w0.z = ow[2]; w0.w = ow[3]; w1.x = ow[4]; w1.y = ow[5]; w1.z = ow[6]; w1.w = ow[7];
          bf16_t* dst = c.proj + (tokb + n * 64 + i3) * NP + C_OG + h * 128 + 16 * seg;
          *(u32x4*)dst = w0; *((u32x4*)dst + 1) = w1; }
        CB();
        ogc0 = ogn0; ogc1 = ogn1;
    }
    asm volatile("s_waitcnt vmcnt(0)" ::: "memory");
    __syncthreads();
#undef GLA_PREFETCH
#undef GLA_OG
#undef GLA_VDMA
#undef CB
}

constexpr int LRU_X = 0  , LRU_R = 16384  , LRU_I = 32768, LRU_SP = 49152  , LRU_SH = 51200;
__device__ __forceinline__ void lru_unit(const Ctx& c, int unit, const float* convw, const float* convb, const float* wa_, const float* ba_, const float* wx_, const float* bx_, const float* lam_) {
    const int lane = c.lane, w = c.wave;
    const int b = unit >> 3, nb = unit & 7, ch = nb * 64 + lane;
    LAS unsigned char* L = c.lds;
    const unsigned hh = lane >> 5, r31 = lane & 31;
    const int gate = w >> 2, tt = (w >> 1) & 1, td = w & 1;
    bf16x8 wf[4];
    { const float* W = (gate ? wx_ : wa_) + (size_t)nb * 4096 + 32 * td + r31;
#pragma unroll
      for (int s = 0; s < 4; ++s) { float t8[8];
#pragma unroll
          for (int jj = 0; jj < 8; ++jj) t8[jj] = W[(16 * s + 8 * hh + jj) * 64];
          u32x4 pw; pw.x = pk2(t8[0], t8[1]); pw.y = pk2(t8[2], t8[3]); pw.z = pk2(t8[4], t8[5]); pw.w = pk2(t8[6], t8[7]); wf[s] = __builtin_bit_cast(bf16x8, pw); } }
    const float gbias = (gate ? bx_ : ba_)[nb * 64 + 32 * td + r31];
    const float cw0 = convw[ch], cw1 = convw[512 + ch], cw2 = convw[1024 + ch], cw3 = convw[1536 + ch], cb = convb[ch];
    const float lam = lam_[ch]; const float c8 = 8.f * (fmaxf(-lam, 0.f) + log1pf(__expf(-fabsf(lam))));
    const size_t tokb = (size_t)b * SEQ;
    unsigned short px[11], py[8];
#define LRU_PREFETCH(n) do { _Pragma("unroll") for (int rr = 0; rr < 11; ++rr) { const int t = (n) * 64 + 8 * w + rr - 3; px[rr] = t >= 0 ? c.proj[(tokb + t) * NP + C_XB + ch] : (unsigned short)0; } \
        _Pragma("unroll") for (int rr = 0; rr < 8; ++rr) py[rr] = c.proj[(tokb + (n) * 64 + 8 * w + rr) * NP + C_YB + ch]; } while (0)
    LRU_PREFETCH(0);
    float hcarry = 0.f;
    for (int n = 0; n < SEQ / 64; ++n) {
        float xc[8], yv[8];
        { float xr[11];
#pragma unroll
          for (int rr = 0; rr < 11; ++rr) xr[rr] = bf2f(px[rr]);
#pragma unroll
          for (int rr = 0; rr < 8; ++rr) { xc[rr] = cb + cw0 * xr[rr] + cw1 * xr[rr + 1] + cw2 * xr[rr + 2] + cw3 * xr[rr + 3]; yv[rr] = bf2f(py[rr]);
              *(LAS unsigned short*)(L + LRU_X + offb(8 * w + rr, lane >> 3) + (lane & 7) * 2) = (unsigned short)f2bf(xc[rr]); } }
        __syncthreads();
        if (n + 1 < SEQ / 64) LRU_PREFETCH(n + 1);
        { f32x16 Z;
#pragma unroll
          for (int i = 0; i < 16; ++i) Z[i] = 0.f;
#pragma unroll
          for (int s = 0; s < 4; ++s) { const bf16x8 af = *(const LAS bf16x8*)(L + LRU_X + offb(32 * tt + r31, 2 * s + hh)); Z = __builtin_amdgcn_mfma_f32_32x32x16_bf16(af, wf[s], Z, 0, 0, 0); }
          LAS float* dst = (LAS float*)(L + (gate ? LRU_I : LRU_R));
#pragma unroll
          for (int i = 0; i < 16; ++i) dst[(32 * tt + crow(i, hh)) * 64 + 32 * td + r31] = sigmoidf_(Z[i] + gbias); }
        __syncthreads();
        float hl[8], pc[8];
        { float hrun = 0.f, prun = 1.f;
#pragma unroll
          for (int rr = 0; rr < 8; ++rr) { const float r = ((const LAS float*)(L + LRU_R))[(8 * w + rr) * 64 + lane], ig = ((const LAS float*)(L + LRU_I))[(8 * w + rr) * 64 + lane];
              const float a = __expf(-c8 * r), u = __builtin_amdgcn_sqrtf(fmaxf(1.f - a * a, 0.f)) * ig * xc[rr];
              hrun = a * hrun + u; prun *= a; hl[rr] = hrun; pc[rr] = prun; }
          ((LAS float*)(L + LRU_SP))[w * 64 + lane] = prun; ((LAS float*)(L + LRU_SH))[w * 64 + lane] = hrun; }
        __syncthreads();
        { float hin = hcarry, hall = hcarry;
#pragma unroll
          for (int s = 0; s < 8; ++s) { const float P = ((const LAS float*)(L + LRU_SP))[s * 64 + lane], H = ((const LAS float*)(L + LRU_SH))[s * 64 + lane];
              hall = P * hall + H; hin = (s < w) ? hall : hin; }
          hcarry = hall;
#pragma unroll
          for (int rr = 0; rr < 8; ++rr) { const float hv = hl[rr] + pc[rr] * hin;
              c.proj[(tokb + n * 64 + 8 * w + rr) * NP + C_YB + ch] = (bf16_t)f2bf(hv * gelu_tanh(yv[rr])); } }
    }
    __syncthreads();
#undef LRU_PREFETCH
}

constexpr int TPB = TT / 256;
constexpr int RW_STRIDE = 1032;
__device__ __forceinline__ void phase_router(const Ctx& c, const float* gain, const float* rw, const float* rb, unsigned* gcnt) {
    LAS bf16_t* sWh = (LAS bf16_t*)c.lds;
    LAS bf16_t* sWl = sWh + 16 * RW_STRIDE;
    LAS float* sGn = (LAS float*)(c.lds + 69632);
    LAS unsigned* sRec = (LAS unsigned*)(c.lds + 73728);
    LAS unsigned* sCnt = (LAS unsigned*)(c.lds + MISC_OFF + 256);
    LAS unsigned* sBase = sCnt + 16;
    const int tid = c.tid, lane = c.lane, w = c.wave;
    for (int idx = tid; idx < D * NE; idx += NTHR) { const int e = idx >> 10, k = idx & 1023; const float v = rw[k * 16 + e] * gain[k];
        const unsigned hi = f2bf(v); const float lo = v - bflo(hi); sWh[e * RW_STRIDE + k] = (bf16_t)hi; sWl[e * RW_STRIDE + k] = (bf16_t)f2bf(lo); }
    for (int idx = tid; idx < D; idx += NTHR) sGn[idx] = gain[idx];
    if (tid < 16) sCnt[tid] = 0u;
    __syncthreads();
    const int t = lane & 15, g = lane >> 4;
#pragma unroll 1
    for (int sub = 0; sub < TPB / 128; ++sub) {
    const int lt = sub * 128 + w * 16 + t, tok = c.bid * TPB + lt;
    const float* xrow = c.xof + (size_t)tok * D + 8 * g; bf16_t* hrow = c.actf + (size_t)tok * D + 8 * g;
    f32x4 acc = {0.f, 0.f, 0.f, 0.f}; float ss = 0.f;
    f32x4 xn[8];
#pragma unroll
    for (int j = 0; j < 4; ++j) { xn[2 * j] = *(const f32x4*)(xrow + 32 * j); xn[2 * j + 1] = *(const f32x4*)(xrow + 32 * j + 4); }
#pragma unroll 1
    for (int s4 = 0; s4 < 8; ++s4) {
        f32x4 xc[8];
#pragma unroll
        for (int j = 0; j < 8; ++j) xc[j] = xn[j];
        if (s4 + 1 < 8) {
#pragma unroll
            for (int j = 0; j < 4; ++j) { xn[2 * j] = *(const f32x4*)(xrow + 32 * (4 * s4 + 4 + j)); xn[2 * j + 1] = *(const f32x4*)(xrow + 32 * (4 * s4 + 4 + j) + 4); } }
#pragma unroll
        for (int j = 0; j < 4; ++j) { const int s = 4 * s4 + j;
            const f32x4 x0 = xc[2 * j], x1 = xc[2 * j + 1];
            const float xv[8] = {x0.x, x0.y, x0.z, x0.w, x1.x, x1.y, x1.z, x1.w};
            { const f32x4 q0 = *(const LAS f32x4*)(sGn + 32 * s + 8 * g), q1 = *(const LAS f32x4*)(sGn + 32 * s + 8 * g + 4);
              u32x4 o; o.x = pk2(x0.x * q0.x, x0.y * q0.y); o.y = pk2(x0.z * q0.z, x0.w * q0.w); o.z = pk2(x1.x * q1.x, x1.y * q1.y); o.w = pk2(x1.z * q1.z, x1.w * q1.w);
              *(u32x4*)(hrow + 32 * s) = o; }
            unsigned hw[4], lw[4];
#pragma unroll
            for (int k = 0; k < 4; ++k) { const float a = xv[2 * k], b = xv[2 * k + 1]; ss += a * a + b * b; const unsigned h2 = pk2(a, b); hw[k] = h2; lw[k] = pk2(a - bflo(h2), b - bfhi(h2)); }
            u32x4 bhv, blv; bhv.x = hw[0]; bhv.y = hw[1]; bhv.z = hw[2]; bhv.w = hw[3]; blv.x = lw[0]; blv.y = lw[1]; blv.z = lw[2]; blv.w = lw[3];
            const bf16x8 bh = __builtin_bit_cast(bf16x8, bhv), bl = __builtin_bit_cast(bf16x8, blv);
            const bf16x8 ah = *(const LAS bf16x8*)(sWh + t * RW_STRIDE + 32 * s + 8 * g), al = *(const LAS bf16x8*)(sWl + t * RW_STRIDE + 32 * s + 8 * g);
            acc = __builtin_amdgcn_mfma_f32_16x16x32_bf16(ah, bh, acc, 0, 0, 0);
            acc = __builtin_amdgcn_mfma_f32_16x16x32_bf16(al, bh, acc, 0, 0, 0);
            acc = __builtin_amdgcn_mfma_f32_16x16x32_bf16(ah, bl, acc, 0, 0, 0); }
    }
    ss += swz_xor<16>(ss);
    { const auto r = __builtin_amdgcn_permlane32_swap(__float_as_uint(ss), __float_as_uint(ss), false, false); ss = __uint_as_float(r[0]) + __uint_as_float(r[1]); }
    const float rs = rsqf_(ss * (1.f / D) + RMS_EPS);
    float sc[4]; float mx = -INFINITY;
#pragma unroll
    for (int i = 0; i < 4; ++i) { sc[i] = acc[i] * rs + rb[4 * g + i]; mx = fmaxf(mx, sc[i]); }
    mx = fmaxf(mx, swz_xor<16>(mx));
    { const auto r = __builtin_amdgcn_permlane32_swap(__float_as_uint(mx), __float_as_uint(mx), false, false); mx = fmaxf(__uint_as_float(r[0]), __uint_as_float(r[1])); }
    float sum = 0.f;
#pragma unroll
    for (int i = 0; i < 4; ++i) { sc[i] = __expf(sc[i] - mx); sum += sc[i]; }
    sum += swz_xor<16>(sum);
    { const auto r = __builtin_amdgcn_permlane32_swap(__float_as_uint(sum), __float_as_uint(sum), false, false); sum = __uint_as_float(r[0]) + __uint_as_float(r[1]); }
    const float isum = rcpf_(sum);
#pragma unroll
    for (int i = 0; i < 4; ++i) sc[i] *= isum;
    float gs;
    { const float hi1 = fmaxf(sc[0], sc[1]), lo1 = fminf(sc[0], sc[1]), hi2 = fmaxf(sc[2], sc[3]), lo2 = fminf(sc[2], sc[3]);
      gs = fmaxf(hi1, hi2) + fmaxf(fminf(hi1, hi2), fmaxf(lo1, lo2)); }
    const float g1 = swz_xor<16>(gs);
    float g2, g3;
    { const auto r = __builtin_amdgcn_permlane32_swap(__float_as_uint(gs), __float_as_uint(gs), false, false); g2 = (g & 2) ? __uint_as_float(r[0]) : __uint_as_float(r[1]); }
    { const auto r = __builtin_amdgcn_permlane32_swap(__float_as_uint(g1), __float_as_uint(g1), false, false); g3 = (g & 2) ? __uint_as_float(r[0]) : __uint_as_float(r[1]); }
    const bool win = ((gs > g1) || (gs == g1 && g < (g ^ 1))) && ((gs > g2) || (gs == g2 && g < (g ^ 2))) && ((gs > g3) || (gs == g3 && g < (g ^ 3)));
    if (win) {
        int i0 = 0; float b0 = sc[0];
#pragma unroll
        for (int k = 1; k < 4; ++k) if (sc[k] > b0) { b0 = sc[k]; i0 = k; }
        int i1 = -1; float b1 = -1.f;
#pragma unroll
        for (int k = 0; k < 4; ++k) if (k != i0 && sc[k] > b1) { b1 = sc[k]; i1 = k; }
        const int e0 = 4 * g + i0, e1 = 4 * g + i1; const float wn = rcpf_(b0 + b1);
        const unsigned l0 = atomicAdd((unsigned*)&sCnt[e0], 1u), l1 = atomicAdd((unsigned*)&sCnt[e1], 1u);
        sRec[lt * 8 + 0] = (unsigned)e0; sRec[lt * 8 + 1] = l0; sRec[lt * 8 + 2] = (unsigned)e1; sRec[lt * 8 + 3] = l1; sRec[lt * 8 + 4] = __float_as_uint(b0 * wn); sRec[lt * 8 + 5] = __float_as_uint(b1 * wn); sRec[lt * 8 + 6] = __float_as_uint(rs);
    }
    }
    __syncthreads();
    if (tid < 16) sBase[tid] = __hip_atomic_fetch_add(gcnt + tid, sCnt[tid], __ATOMIC_RELAXED, __HIP_MEMORY_SCOPE_AGENT);
    __syncthreads();
    if (tid < TPB) { const int tk = c.bid * TPB + tid; const unsigned e0 = sRec[tid * 8], e1 = sRec[tid * 8 + 2];
        const unsigned p0 = sBase[e0] + sRec[tid * 8 + 1], p1 = sBase[e1] + sRec[tid * 8 + 3];
        u32x4 r; r.x = (e0 << 20) | p0; r.y = (e1 << 20) | p1; r.z = sRec[tid * 8 + 4]; r.w = sRec[tid * 8 + 5];
        *(u32x4*)(c.rec + (size_t)tk * 4) = r;
        const float rsv = __uint_as_float(sRec[tid * 8 + 6]);
        c.list[(size_t)e0 * TT + p0] = tk; c.list[(size_t)e1 * TT + p1] = tk; c.rsl[(size_t)e0 * TT + p0] = rsv; c.rsl[(size_t)e1 * TT + p1] = rsv; }
}

struct PlainOrder {
    int nM, nN, G, c; const char* A; const char* Bt; size_t a_tile, b_tile; int r0, r1;
    __device__ __forceinline__ bool next(int i, pg8::Unit& u) const { u.g = 0; if (r0 + i >= r1) return false; return pg8::static_tile(nM, nN, G, c, r0 + i, u.pm, u.pn); }
    __device__ __forceinline__ const char* aptr(const pg8::Unit& u) const { return A + (size_t)u.pm * a_tile; }
    __device__ __forceinline__ const char* bptr(const pg8::Unit& u) const { return Bt + (size_t)u.pn * b_tile; }
    __device__ __forceinline__ unsigned arow(const pg8::Unit&, int) const { return 0u; }
};
struct MergeOrder {
    int G, c; const char* proj; const char* wbr;
    __device__ __forceinline__ bool next(int i, pg8::Unit& u) const { u.g = i % 3; return pg8::static_tile(TC / 256, 4, G, c, i / 3, u.pm, u.pn); }
    __device__ __forceinline__ const char* aptr(const pg8::Unit& u) const { const int col = u.g == 0 ? C_OG : (u.g == 1 ? C_YB : C_QKV); return proj + ((size_t)u.pm * 256 * NP + col) * 2; }
    __device__ __forceinline__ const char* bptr(const pg8::Unit& u) const { return wbr + ((size_t)u.g * D * 512 + (size_t)u.pn * 256 * 512) * 2; }
    __device__ __forceinline__ unsigned arow(const pg8::Unit&, int) const { return 0u; }
};
template <bool UP> struct MoeOrder {
    int G, c; LAS const int* pt; LAS const int* lc; const char* A; const char* W; const int* list;
    __device__ __forceinline__ bool next(int i, pg8::Unit& u) const { const int x = c & 7, j = c >> 3, tau = (G >> 2) * i + 8 * x + (j >> 2); if (tau >= pt[NE]) return false;
        const int L = j;
        int e = 0;
#pragma unroll
        for (int k = 1; k < NE; ++k) e += (tau >= pt[k]) ? 1 : 0;
        u.pm = tau; u.pn = L & 3; u.g = e; return true; }
    __device__ __forceinline__ const char* aptr(const pg8::Unit& u) const { return UP ? A : A + (size_t)u.pm * 256 * FF * 2; }
    __device__ __forceinline__ const char* bptr(const pg8::Unit& u) const { return UP ? W + ((size_t)u.g * 1024 * D + (size_t)u.pn * 256 * D) * 2 : W + ((size_t)u.g * D * FF + (size_t)u.pn * 256 * FF) * 2; }
    __device__ __forceinline__ unsigned arow(const pg8::Unit& u, int r) const { int p = (u.pm - pt[u.g]) * 256 + r; const int n = lc[u.g]; p = p < n ? p : n - 1;
        return (unsigned)list[(size_t)u.g * TT + p] * (unsigned)(D * 2); }
};

struct EpiStoreBf16 {
    static constexpr bool PERM = true;
    bf16_t* O; int ldc;
    __device__ __forceinline__ void operator()(const f32x4 (&acc)[2][2][4][2], const pg8::Unit& u, int wr, int wc, int fr, int fq) const {
        const int row0 = u.pm * 256 + wr * 64 + fr, col0 = u.pn * 256 + wc * 32 + 8 * fq;
#pragma unroll
        for (int ai = 0; ai < 2; ++ai)
#pragma unroll
            for (int m = 0; m < 4; ++m) { bf16_t* rowp = O + (size_t)(row0 + ai * 128 + m * 16) * ldc + col0;
#pragma unroll
                for (int bj = 0; bj < 2; ++bj) { const f32x4 v0 = acc[ai][bj][m][0], v1 = acc[ai][bj][m][1];
                    u32x4 w; w.x = pg8::cvt_pk_bf16(v0[0], v0[1]); w.y = pg8::cvt_pk_bf16(v0[2], v0[3]); w.z = pg8::cvt_pk_bf16(v1[0], v1[1]); w.w = pg8::cvt_pk_bf16(v1[2], v1[3]);
                    *(u32x4*)(rowp + bj * 128) = w; } }
    }
};
struct EpiMerge {
    static constexpr bool PERM = true;
    const bf16_t* proj; bf16_t* mg;
    __device__ __forceinline__ void operator()(const f32x4 (&acc)[2][2][4][2], const pg8::Unit& u, int wr, int wc, int fr, int fq) const {
        const int row0 = u.pm * 256 + wr * 64 + fr, col0 = u.pn * 256 + wc * 32 + 8 * fq;
#pragma unroll
        for (int ai = 0; ai < 2; ++ai) {
            u32x4 gv[4][2], pv[4][2];
#pragma unroll
            for (int m = 0; m < 4; ++m)
#pragma unroll
                for (int bj = 0; bj < 2; ++bj) { const size_t row = (size_t)(row0 + ai * 128 + m * 16); const int col = col0 + bj * 128;
                    gv[m][bj] = *(const u32x4*)(proj + row * NP + C_G + u.g * D + col);
                    if (u.g > 0) pv[m][bj] = *(const u32x4*)(mg + row * D + col); else pv[m][bj] = (u32x4){0u, 0u, 0u, 0u}; }
            asm volatile("" ::: "memory");
#pragma unroll
            for (int m = 0; m < 4; ++m)
#pragma unroll
                for (int bj = 0; bj < 2; ++bj) { const size_t row = (size_t)(row0 + ai * 128 + m * 16); const int col = col0 + bj * 128;
                    const u32x4 g = gv[m][bj], p = pv[m][bj];
                    const f32x4 v0 = acc[ai][bj][m][0], v1 = acc[ai][bj][m][1];
                    float r[8];
                    r[0] = v0[0] * sigmoidf_(bflo(g.x)) + bflo(p.x); r[1] = v0[1] * sigmoidf_(bfhi(g.x)) + bfhi(p.x); r[2] = v0[2] * sigmoidf_(bflo(g.y)) + bflo(p.y); r[3] = v0[3] * sigmoidf_(bfhi(g.y)) + bfhi(p.y);
                    r[4] = v1[0] * sigmoidf_(bflo(g.z)) + bflo(p.z); r[5] = v1[1] * sigmoidf_(bfhi(g.z)) + bfhi(p.z); r[6] = v1[2] * sigmoidf_(bflo(g.w)) + bflo(p.w); r[7] = v1[3] * sigmoidf_(bfhi(g.w)) + bfhi(p.w);
                    u32x4 w; w.x = pk2(r[0], r[1]); w.y = pk2(r[2], r[3]); w.z = pk2(r[4], r[5]); w.w = pk2(r[6], r[7]);
                    *(u32x4*)(mg + row * D + col) = w; }
        }
    }
};
struct EpiResid {
    static constexpr bool PERM = false;
    const float* base; float* out;
    __device__ __forceinline__ void operator()(const f32x4 (&acc)[2][2][4][2], const pg8::Unit& u, int wr, int wc, int fr, int fq) const {
        const int row0 = u.pm * 256 + wr * 64 + fr, col0 = u.pn * 256 + wc * 32 + 4 * fq;
#pragma unroll
        for (int ai = 0; ai < 2; ++ai) {
            f32x4 bv[4][2][2];
#pragma unroll
            for (int m = 0; m < 4; ++m) { const size_t off = (size_t)(row0 + ai * 128 + m * 16) * D + col0;
#pragma unroll
                for (int bj = 0; bj < 2; ++bj)
#pragma unroll
                    for (int n = 0; n < 2; ++n) bv[m][bj][n] = *(const f32x4*)(base + off + bj * 128 + n * 16); }
            asm volatile("" ::: "memory");
#pragma unroll
            for (int m = 0; m < 4; ++m) { const size_t off = (size_t)(row0 + ai * 128 + m * 16) * D + col0;
#pragma unroll
                for (int bj = 0; bj < 2; ++bj)
#pragma unroll
                    for (int n = 0; n < 2; ++n) *(f32x4*)(out + off + bj * 128 + n * 16) = bv[m][bj][n] + acc[ai][bj][m][n]; }
        }
    }
};
struct EpiSwiGLU {
    static constexpr bool PERM = false;
    bf16_t* hid; const float* rsl; LAS const int* pt; LAS const int* lc;
    __device__ __forceinline__ void operator()(const f32x4 (&acc)[2][2][4][2], const pg8::Unit& u, int wr, int wc, int fr, int fq) const {
        const int row0 = u.pm * 256 + wr * 64 + fr, col0 = u.pn * 128 + wc * 16 + 4 * fq;
        const int pbase = (u.pm - pt[u.g]) * 256 + wr * 64 + fr, nrow = lc[u.g];
        float rsv[2][4];
#pragma unroll
        for (int ai = 0; ai < 2; ++ai)
#pragma unroll
            for (int m = 0; m < 4; ++m) { int p = pbase + ai * 128 + m * 16; p = p < nrow ? p : nrow - 1; rsv[ai][m] = rsl[(size_t)u.g * TT + p]; }
#pragma unroll
        for (int ai = 0; ai < 2; ++ai)
#pragma unroll
            for (int m = 0; m < 4; ++m) { bf16_t* rowp = hid + (size_t)(row0 + ai * 128 + m * 16) * FF + col0; const float rs = rsv[ai][m];
#pragma unroll
                for (int bj = 0; bj < 2; ++bj) { const f32x4 g = acc[ai][bj][m][0] * rs, up = acc[ai][bj][m][1] * rs;
                    u32x2 w; w.x = pk2(g[0] * sigmoidf_(g[0]) * up[0], g[1] * sigmoidf_(g[1]) * up[1]); w.y = pk2(g[2] * sigmoidf_(g[2]) * up[2], g[3] * sigmoidf_(g[3]) * up[3]);
                    *(u32x2*)(rowp + bj * 64) = w; } }
    }
};

constexpr int PH_PER_LAYER = 1 + NCH * 4 + 4, PH_TOTAL = 1 + DEPTH * PH_PER_LAYER + 1;
#ifndef MK_LAUNCH_PER_PHASE
#define MK_LAUNCH_PER_PHASE 0
#endif
#ifndef PHMASK
#define PHMASK 0xFFFF
#endif
#ifndef MIXM
#define MIXM 7
#endif
#define EN(j) (((PHMASK) >> (j)) & 1)
typedef const __attribute__((address_space(4))) char* kptr_t;
__device__ __forceinline__ const void* karg_ptr(kptr_t kp, int i) { return *(const void* const __attribute__((address_space(4)))*)(kp + 8 * i); }
__device__ __forceinline__ void make_ctx(Ctx& c, kptr_t& kp, int layer, int chunk, int wave_s) {
    int t = wave_s * 64 + (int)__builtin_amdgcn_mbcnt_hi(~0u, __builtin_amdgcn_mbcnt_lo(~0u, 0u)); asm volatile("" : "+v"(t));
    kp = (kptr_t)__builtin_amdgcn_kernarg_segment_ptr(); asm volatile("" : "+s"(kp));
    c.tid = t; c.lane = t & 63; c.wave = __builtin_amdgcn_readfirstlane(t >> 6); c.bid = blockIdx.x; c.G = gridDim.x;
    unsigned char* ws = (unsigned char*)karg_ptr(kp, 25); float* out = (float*)karg_ptr(kp, 24);
    c.ctl = (unsigned*)(ws + WS_CTL);
    c.actf = (bf16_t*)(ws + WS_ACT); c.act = c.actf + (size_t)chunk * TC * D; c.proj = (bf16_t*)(ws + WS_PROJ); c.hid = (bf16_t*)(ws + WS_HID); c.ys = (bf16_t*)(ws + WS_YS);
    c.rec = (unsigned*)(ws + WS_REC); c.list = (int*)(ws + WS_LIST); c.rsl = (float*)(ws + WS_RSL);
    c.chunk = chunk; c.layer = layer; c.pass = layer * NCH + chunk;
    c.xinf = (const float*)karg_ptr(kp, 0); c.xof = out;
    c.x_in = c.xinf + (size_t)chunk * TC * D; c.xo = out + (size_t)chunk * TC * D;
    c.pos = (const int*)karg_ptr(kp, 1) + (size_t)chunk * TC;
    c.lw = ws + WS_W + (size_t)layer * LW_SIZE;
}
#define INP(i) ((const float*)karg_ptr(kp, (i)))
__global__ void __launch_bounds__(NTHR, 2) fwd(Args args) {
    extern __shared__ __attribute__((aligned(16))) unsigned char lds_raw[];
    Ctx c; kptr_t kp;
    c.lds = (LAS unsigned char*)lds_raw;
    const int wave_s = __builtin_amdgcn_readfirstlane((int)threadIdx.x >> 6);
    make_ctx(c, kp, 0, 0, wave_s);
    volatile LAS unsigned* MISC = (volatile LAS unsigned*)(c.lds + MISC_OFF);
    LAS int* sPT = (LAS int*)(c.lds + MISC_OFF + 64);
    LAS int* sLC = (LAS int*)(c.lds + MISC_OFF + 160);
    for (int u = c.tid; u < 1024; u += NTHR) MISC[u] = 0u;
    __syncthreads();
    XcdBarrier bar; bar.bar = c.ctl + CW_BAR; bar.x = 0; bar.st = nullptr;
    if (!MK_LAUNCH_PER_PHASE) bar = xcd_barrier_post(c.ctl + CW_BAR, MISC, c.tid);
    const int lo = args.ph_lo, hi = args.ph_hi;
#define IN(k) (lo <= (k) && (k) < hi)
#ifndef PROBE_MASK
#define PROBE_MASK 0
#endif
#ifndef PROBE_CLK_CLS
#define PROBE_CLK_CLS 2
#endif
#ifndef PROBE_BLOCK
#define PROBE_BLOCK 0
#endif
#ifndef PROBE_K
#define PROBE_K 4
#endif
    unsigned long long t_prev = 0, c_prev = 0; LAS unsigned* sAcc = (LAS unsigned*)(c.lds + MISC_OFF + 512);
    if (PROBE_MASK) { t_prev = __builtin_amdgcn_s_memrealtime(); c_prev = (unsigned long long)clock64(); }
#define STAMP(cls) do { if (PROBE_MASK) { const unsigned long long _n = __builtin_amdgcn_s_memrealtime(); const unsigned long long _ck = (unsigned long long)clock64(); if (blockIdx.x == PROBE_BLOCK && c.tid == 0) { sAcc[(cls)] += (unsigned)(_n - t_prev); if ((cls) == PROBE_CLK_CLS) sAcc[15] += (unsigned)((_ck - c_prev) >> 4); } t_prev = _n; c_prev = _ck; } } while (0)
#ifndef PROBE_GEMM_CLS
#define PROBE_GEMM_CLS -1
#endif
#define GEMM_FLAG(cls) do { if (PROBE_MASK) { if (c.tid == 0) MISC[6] = ((cls) == PROBE_GEMM_CLS) ? 1u : 0u; __syncthreads(); } } while (0)
#define SEAM(k) do { if (IN(k) && IN((k) + 1)) { XcdBarrier _b = bar; kptr_t _k = (kptr_t)__builtin_amdgcn_kernarg_segment_ptr(); asm volatile("" : "+s"(_k)); _b.bar = (unsigned*)((unsigned char*)karg_ptr(_k, 25) + WS_CTL) + CW_BAR; { int _t = wave_s * 64 + (int)__builtin_amdgcn_mbcnt_hi(~0u, __builtin_amdgcn_mbcnt_lo(~0u, 0u)); const unsigned long long _b0 = PROBE_MASK ? __builtin_amdgcn_s_memrealtime() : 0ull; xcd_barrier(_b, _t); if (PROBE_MASK && blockIdx.x == PROBE_BLOCK && _t == 0) sAcc[13] += (unsigned)(__builtin_amdgcn_s_memrealtime() - _b0); } } } while (0)

    if (EN(0) && IN(0)) { Args a2;
#pragma unroll
        for (int i = 0; i < 24; ++i) a2.in[i] = karg_ptr(kp, i);
        a2.ws = (unsigned char*)karg_ptr(kp, 25); a2.out = nullptr; a2.ph_lo = 0; a2.ph_hi = 0;
        phase_prep(a2, c.lds, c.bid * NWAVES + c.wave, c.G * NWAVES, c.wave, c.lane, c.bid * NTHR + c.tid, c.G * NTHR);
        phase_rope_table((const int*)karg_ptr(kp, 1), (float*)(c.ctl) + (WS_BRC + 4 * MiB) / 4, c.bid * NTHR + c.tid, c.G * NTHR); }
    SEAM(0); STAMP(0);

    for (int layer = 0; layer < DEPTH; ++layer) {
        const int pl = 1 + layer * PH_PER_LAYER;
        if (EN(1) && IN(pl)) { make_ctx(c, kp, layer, 0, wave_s);
            const float* g1 = INP(2) + layer * D;
            if (layer == 0) phase_norm1<false, true, false>(c, g1, sPT);
            else { moe_tables(c.ctl + CW_CNT + 64 * (layer - 1), sPT, sLC, c.tid); phase_norm1<true, true, true>(c, g1, sPT); }
        }
        SEAM(pl); STAMP(1);
        for (int chunk = 0; chunk < NCH; ++chunk) {
            const int pb = pl + 1 + chunk * 4;
            if (EN(2) && IN(pb + 0)) { make_ctx(c, kp, layer, chunk, wave_s);
                EpiStoreBf16 E{c.proj, NP};
                GEMM_FLAG(2);
                PlainOrder S{TC / 256, NP / 256, c.G, c.bid, (const char*)c.act, (const char*)(c.lw + LW_WIN), (size_t)256 * D * 2, (size_t)256 * D * 2, 0, 1 << 20};
                pg8::gemm_phase<EpiStoreBf16, PlainOrder, false>(c.lds, S, E, D, D, c.tid);
            }
            SEAM(pb + 0); STAMP(2);
            if (EN(4) && IN(pb + 1)) { make_ctx(c, kp, layer, chunk, wave_s);
                float* lse = (float*)(c.ctl) + (WS_BRC / 4);
                if ((MIXM & 1) && c.bid < 4 * BC) gla_unit(c, c.bid, INP(5) + layer * 256, INP(6) + layer * 128);
                else if ((MIXM & 2) && c.bid < 12 * BC) lru_unit(c, c.bid - 4 * BC, INP(7) + layer * 4 * 512, INP(8) + layer * 512, INP(9) + layer * 8 * 64 * 64,
                                                    INP(10) + layer * 512, INP(11) + layer * 8 * 64 * 64, INP(12) + layer * 512, INP(13) + layer * 512);
                STAMP(12);
                unsigned* qh = c.ctl + CW_Q + 64 * c.pass;
                if (MIXM & 4) attn_loop(c, qh, MISC + 4, lse, INP(14) + layer * 128, INP(15) + layer * 128, (const float*)(c.ctl) + (WS_BRC + 4 * MiB) / 4 + (size_t)chunk * TC * 32);
            }
            SEAM(pb + 1); STAMP(4);
            if (EN(11) && IN(pb + 2)) { make_ctx(c, kp, layer, chunk, wave_s); phase_attn_combine(c, (const float*)(c.ctl) + (WS_BRC / 4)); }
            SEAM(pb + 2); STAMP(11);
            if (EN(5) && IN(pb + 3)) { make_ctx(c, kp, layer, chunk, wave_s);
                MergeOrder S{c.G, c.bid, (const char*)c.proj, (const char*)(c.lw + LW_WBR)};
                EpiMerge E{c.proj, c.act};
                GEMM_FLAG(5);
                pg8::gemm_phase<EpiMerge, MergeOrder, false>(c.lds, S, E, 512, NP, c.tid);
            }
            SEAM(pb + 3); STAMP(5);
        }
        const int pm = pl + 2 + NCH * 4;
        if (EN(6) && IN(pm - 1)) { make_ctx(c, kp, layer, 0, wave_s);
            PlainOrder S{TT / 256, D / 256, c.G, c.bid, (const char*)c.actf, (const char*)(c.lw + LW_WOUT), (size_t)256 * D * 2, (size_t)256 * D * 2, 0, 1 << 20};
            EpiResid E{layer == 0 ? c.xinf : (const float*)c.xof, c.xof};
            GEMM_FLAG(6);
            pg8::gemm_phase<EpiResid, PlainOrder, false>(c.lds, S, E, D, D, c.tid);
        }
        SEAM(pm - 1); STAMP(6);
        if (EN(7) && IN(pm + 0)) { make_ctx(c, kp, layer, 0, wave_s); phase_router(c, INP(18) + layer * D, INP(19), INP(20), c.ctl + CW_CNT + 64 * layer); }
        SEAM(pm + 0); STAMP(7);
        if (EN(8) && IN(pm + 1)) { make_ctx(c, kp, layer, 0, wave_s);
            moe_tables(c.ctl + CW_CNT + 64 * layer, sPT, sLC, c.tid);
            MoeOrder<true> S{c.G, c.bid, sPT, sLC, (const char*)c.actf, (const char*)(c.lw + LW_WGU), c.list};
            EpiSwiGLU E{c.hid, c.rsl, sPT, sLC};
            GEMM_FLAG(8);
            pg8::gemm_phase<EpiSwiGLU, MoeOrder<true>, true>(c.lds, S, E, D, D, c.tid);
        }
        SEAM(pm + 1); STAMP(8);
        if (EN(9) && IN(pm + 2)) { make_ctx(c, kp, layer, 0, wave_s);
            moe_tables(c.ctl + CW_CNT + 64 * layer, sPT, sLC, c.tid);
            MoeOrder<false> S{c.G, c.bid, sPT, sLC, (const char*)c.hid, (const char*)(c.lw + LW_WDN), c.list};
            EpiStoreBf16 E{c.ys, D};
            GEMM_FLAG(9);
            pg8::gemm_phase<EpiStoreBf16, MoeOrder<false>, false>(c.lds, S, E, FF, FF, c.tid);
        }
        SEAM(pm + 2); STAMP(9);
    }
    if (EN(10) && IN(PH_TOTAL - 1)) { make_ctx(c, kp, DEPTH - 1, 0, wave_s);
        moe_tables(c.ctl + CW_CNT + 64 * (DEPTH - 1), sPT, sLC, c.tid);
        phase_norm1<true, false, true>(c, nullptr, sPT);
    }
    if (PROBE_MASK) {
        make_ctx(c, kp, DEPTH - 1, 0, wave_s);
        STAMP(10);
        if (blockIdx.x == PROBE_BLOCK && c.tid == 0) { unsigned sel = 0; for (int k = 0; k < 16; ++k) if ((PROBE_MASK >> k) & 1) sel += sAcc[k]; __hip_atomic_store(c.ctl + CW_Q + 64 * 8, sel, __ATOMIC_RELAXED, __HIP_MEMORY_SCOPE_AGENT); }
        { XcdBarrier _b = bar; _b.bar = c.ctl + CW_BAR; xcd_barrier(_b, c.tid); }
        const unsigned sel = __hip_atomic_load(c.ctl + CW_Q + 64 * 8, __ATOMIC_RELAXED, __HIP_MEMORY_SCOPE_AGENT);
        const unsigned long long t0 = __builtin_amdgcn_s_memrealtime();
        while (__builtin_amdgcn_s_memrealtime() - t0 < (unsigned long long)sel * PROBE_K) __builtin_amdgcn_s_sleep(8);
    }
#undef IN
#undef SEAM
}

extern "C" void kernel_launch(void* const* d_in, const int* in_sizes, int n_in, void* d_out, int out_size, void* d_ws, size_t ws_size, hipStream_t stream) {
    static int grid = 0;
    if (grid == 0) {
        if (n_in != 24 || in_sizes[0] != BATCH * SEQ * D || out_size != BATCH * SEQ * D || ws_size < WS_END) { fprintf(stderr, "kernel_launch: unexpected shapes / workspace (%zu < %zu)\n", ws_size, (size_t)WS_END); grid = -1; return; }
        int dev = 0, cus = 0;
        if (hipGetDevice(&dev) != hipSuccess || hipDeviceGetAttribute(&cus, hipDeviceAttributeMultiprocessorCount, dev) != hipSuccess || cus < 256) { fprintf(stderr, "kernel_launch: needs a 256-CU device\n"); grid = -1; return; }
        if (hipFuncSetAttribute((const void*)fwd, hipFuncAttributeMaxDynamicSharedMemorySize, LDS_BYTES) != hipSuccess) { fprintf(stderr, "kernel_launch: hipFuncSetAttribute failed\n"); grid = -1; return; }
        int per_cu = 0;
        if (hipOccupancyMaxActiveBlocksPerMultiprocessor(&per_cu, (const void*)fwd, NTHR, LDS_BYTES) != hipSuccess || per_cu < 1) fprintf(stderr, "kernel_launch: occupancy query says %d\n", per_cu);
        (void)hipGetLastError();
        grid = 256;
    }
    if (grid < 0) return;
    if (hipMemsetAsync((char*)d_ws + WS_CTL, 0, CTL_ZERO_BYTES, stream) != hipSuccess) return;
    Args a{};
    for (int i = 0; i < 24; ++i) a.in[i] = d_in[i];
    a.out = (float*)d_out; a.ws = (unsigned char*)d_ws;
#if MK_LAUNCH_PER_PHASE
    for (int k = 0; k < PH_TOTAL; ++k) { a.ph_lo = k; a.ph_hi = k + 1; hipLaunchKernelGGL(fwd, dim3(grid), dim3(NTHR), LDS_BYTES, stream, a); }
#else
    a.ph_lo = 0; a.ph_hi = PH_TOTAL;
    hipLaunchKernelGGL(fwd, dim3(grid), dim3(NTHR), LDS_BYTES, stream, a);
#endif
}
```

```cpp
#include <hip/hip_runtime.h>
#include <cstdio>
#include <cstdint>

#define LAS __attribute__((address_space(3)))
#define GAS __attribute__((address_space(1)))
typedef unsigned short bf16_t;
typedef short bf16x8 __attribute__((ext_vector_type(8)));
typedef float f32x4 __attribute__((ext_vector_type(4)));
typedef float f32x2 __attribute__((ext_vector_type(2)));
typedef unsigned u32x4 __attribute__((ext_vector_type(4)));
typedef unsigned u32x2 __attribute__((ext_vector_type(2)));
typedef int i32x4 __attribute__((ext_vector_type(4)));

namespace pg8 {
constexpr int BM = 256, BK = 64, HALF = 128, HTB = HALF * BK * 2, STAGE_BYTES = 8 * HTB, NXCD = 8, WGM = 8;
__host__ __device__ __forceinline__ int lds_byte(int r, int c) { const int st = (r >> 4) * 2 + (c >> 5), rr = r & 15, cc = c & 31, ob = rr * 64 + cc * 2; return st * 1024 + (ob ^ (((ob >> 9) & 1) << 5)); }
__host__ __device__ __forceinline__ void stage_rc(int b, int& R, int& C) { const int st = b / 1024, sb = b % 1024, swz = sb ^ (((sb >> 9) & 1) << 5); R = (st >> 1) * 16 + swz / 64; C = (st & 1) * 32 + (swz % 64) / 2; }
__host__ __device__ __forceinline__ int perm32(int rho) { const int n = rho >> 4, i = rho & 15; return 8 * (i >> 2) + 4 * n + (i & 3); }

struct Unit { int pm, pn, g; };

__device__ __forceinline__ bool static_tile(int nM, int nN, int G, int c, int i, int& pm, int& pn) {
    const int nwg = nM * nN; const long L = (long)i * G + c; if (L >= nwg) return false;
    int wgid = (int)L; { const int q = nwg / NXCD, r = nwg % NXCD, xcd = wgid % NXCD, off = wgid / NXCD; wgid = (xcd < r ? xcd * (q + 1) : r * (q + 1) + (xcd - r) * q) + off; }
    const int nig = WGM * nN, gid = wgid / nig, fm = gid * WGM, gsz = (nM - fm) < WGM ? (nM - fm) : WGM;
    pm = fm + ((wgid % nig) % gsz); pn = (wgid % nig) / gsz; return true;
}
typedef __bf16 bf16x2c_t __attribute__((ext_vector_type(2)));
__device__ __forceinline__ unsigned cvt_pk_bf16(float lo, float hi) { const f32x2 v = {lo, hi}; return __builtin_bit_cast(unsigned, __builtin_convertvector(v, bf16x2c_t)); }

template <bool I8> struct AccT { typedef f32x4 t; };
template <> struct AccT<true> { typedef i32x4 t; };
template <class Epi, class Sched, bool GATHER, bool I8 = false>
__device__ __forceinline__ void gemm_phase(LAS unsigned char* lds, const Sched& S, const Epi& E, const int K, const int lda, int tid_) {
    asm volatile("" : "+v"(tid_));
    const int tid = tid_, wid = __builtin_amdgcn_readfirstlane(tid >> 6), lane = tid & 63, wr = wid >> 2, wc = wid & 3, fr = lane & 15, fq = lane >> 4;
    const int nt = K / BK;
    int sR[2], sC[2];
    unsigned voffB[2], voffA[2], vAc[2][2], vAn[2][2];
#pragma unroll
    for (int i = 0; i < 2; ++i) { int R, C; stage_rc(tid * 16 + i * 8192, R, C); sR[i] = R; sC[i] = C; const int Rb = Epi::PERM ? ((R & ~31) + perm32(R & 31)) : R;
        voffB[i] = (unsigned)(Rb * K + C) * 2u; voffA[i] = (unsigned)(R * lda + C) * 2u; }
    const size_t kstep = (size_t)(BK * 2);
    const size_t hstepB = (size_t)HALF * K * 2, hstepA = (size_t)HALF * lda * 2;
    const unsigned ldsw = (unsigned)wid * 1024u;
    const int aoff = lds_byte(wr * 64 + fr, fq * 8), boff = lds_byte(wc * 32 + fr, fq * 8);
#define PG8_SA(b, h) (((b) * 2 + (h)) * HTB)
#define PG8_SB(b, h) ((4 + (b) * 2 + (h)) * HTB)
#define PG8_STAGE(bufoff, gbase, voff) do { _Pragma("unroll") for (int _i = 0; _i < 2; ++_i) \
        __builtin_amdgcn_global_load_lds((const unsigned*)((const char*)(gbase) + (voff)[_i]), (LAS unsigned*)(lds + (bufoff) + ldsw + _i * 8192), 16, 0, 0); } while (0)
#define PG8_LDA(dst, b, h) do { _Pragma("unroll") for (int m = 0; m < 4; ++m) _Pragma("unroll") for (int k = 0; k < 2; ++k) dst[m][k] = *(const LAS bf16x8*)(lds + PG8_SA(b, h) + aoff + m * 2048 + k * 1024); } while (0)
#define PG8_LDB(dst, b, h) do { _Pragma("unroll") for (int n = 0; n < 2; ++n) _Pragma("unroll") for (int k = 0; k < 2; ++k) dst[n][k] = *(const LAS bf16x8*)(lds + PG8_SB(b, h) + boff + n * 2048 + k * 1024); } while (0)
#define PG8_MMA(ai, bj, At, Bt) do { __builtin_amdgcn_s_setprio(1); _Pragma("unroll") for (int m = 0; m < 4; ++m) _Pragma("unroll") for (int n = 0; n < 2; ++n) _Pragma("unroll") for (int k = 0; k < 2; ++k) \
        { if constexpr (I8) acc[ai][bj][m][n] = __builtin_amdgcn_mfma_i32_16x16x64_i8(__builtin_bit_cast(i32x4, Bt[n][k]), __builtin_bit_cast(i32x4, At[m][k]), acc[ai][bj][m][n], 0, 0, 0); \
          else acc[ai][bj][m][n] = __builtin_amdgcn_mfma_f32_16x16x32_bf16(Bt[n][k], At[m][k], acc[ai][bj][m][n], 0, 0, 0); } __builtin_amdgcn_s_setprio(0); } while (0)
#define PG8_WAIT_V(n) asm volatile("s_waitcnt vmcnt(" #n ")" ::: "memory")
#define PG8_WAIT_L(n) asm volatile("s_waitcnt lgkmcnt(" #n ")" ::: "memory")
#define PG8_BAR __builtin_amdgcn_s_barrier()
#define PG8_SCHED __builtin_amdgcn_sched_barrier(0)
#define PG8_AOFF(dst, u) do { if constexpr (GATHER) { _Pragma("unroll") for (int _h = 0; _h < 2; ++_h) _Pragma("unroll") for (int _i = 0; _i < 2; ++_i) \
        dst[_h][_i] = S.arow(u, _h * HALF + sR[_i]) + (unsigned)sC[_i] * 2u; } } while (0)
#define PG8_STAGE_A(bufoff, gptr, h, usenext) do { if constexpr (GATHER) { _Pragma("unroll") for (int _i = 0; _i < 2; ++_i) { const unsigned _vo = (usenext) ? vAn[h][_i] : vAc[h][_i]; \
        __builtin_amdgcn_global_load_lds((const unsigned*)((const char*)(gptr) + _vo), (LAS unsigned*)(lds + (bufoff) + ldsw + _i * 8192), 16, 0, 0); } } \
        else { PG8_STAGE(bufoff, (gptr) + (h) * hstepA, voffA); } } while (0)
    Unit cur, nxt; int ui = 0;
    if (!S.next(0, cur)) return;
    typedef typename AccT<I8>::t acc_t;
    acc_t acc[2][2][4][2];
#pragma unroll
    for (int a = 0; a < 2; ++a)
#pragma unroll
        for (int b = 0; b < 2; ++b)
#pragma unroll
            for (int m = 0; m < 4; ++m)
#pragma unroll
                for (int n = 0; n < 2; ++n) acc[a][b][m][n] = (acc_t){0, 0, 0, 0};
    bf16x8 At[4][2], B0[2][2], B1[2][2];
    const char* cA = S.aptr(cur); const char* cB = S.bptr(cur);
    PG8_AOFF(vAc, cur);
    PG8_STAGE(PG8_SB(0, 0), cB, voffB); PG8_STAGE(PG8_SB(0, 1), cB + hstepB, voffB); PG8_STAGE_A(PG8_SA(0, 0), cA, 0, false); PG8_STAGE_A(PG8_SA(0, 1), cA, 1, false);
    if (wr == 1) PG8_BAR;
    PG8_WAIT_V(2); PG8_BAR;
    PG8_STAGE(PG8_SB(1, 0), cB + kstep, voffB); PG8_STAGE_A(PG8_SA(1, 0), cA + kstep, 0, false); PG8_STAGE(PG8_SB(1, 1), cB + hstepB + kstep, voffB);
    PG8_WAIT_V(6); PG8_BAR;
    for (;;) {
        const bool has_next = S.next(ui + 1, nxt);
        const char* nA = has_next ? S.aptr(nxt) : cA; const char* nB = has_next ? S.bptr(nxt) : cB;
        if constexpr (GATHER) { if (has_next) { PG8_AOFF(vAn, nxt); } else {
#pragma unroll
            for (int h = 0; h < 2; ++h)
#pragma unroll
                for (int i = 0; i < 2; ++i) vAn[h][i] = vAc[h][i]; } }
#if defined(PROBE_MASK) && PROBE_MASK
        const unsigned long long _tk0 = __builtin_amdgcn_s_memrealtime();
#endif
        for (int t = 0; t < nt; t += 2) {
            const bool last = (t == nt - 2);
            const char* a1 = cA + (size_t)(t + 1) * kstep;
            const char* a2 = last ? nA : cA + (size_t)(t + 2) * kstep; const char* b2 = last ? nB : cB + (size_t)(t + 2) * kstep;
            const char* a3 = a2 + kstep; const char* b3 = b2 + kstep;
            PG8_LDB(B0, 0, 0); PG8_LDB(B1, 0, 1); PG8_SCHED; PG8_LDA(At, 0, 0); PG8_STAGE_A(PG8_SA(1, 1), a1, 1, false);
            PG8_WAIT_V(8); PG8_WAIT_L(0); PG8_BAR; PG8_MMA(0, 0, At, B0); PG8_MMA(0, 1, At, B1); PG8_BAR; PG8_SCHED;
            PG8_LDA(At, 0, 1); PG8_STAGE(PG8_SB(0, 0), b2, voffB); PG8_STAGE(PG8_SB(0, 1), b2 + hstepB, voffB); PG8_STAGE_A(PG8_SA(0, 0), a2, 0, last);
            PG8_WAIT_V(8); PG8_WAIT_L(0); PG8_BAR; PG8_MMA(1, 0, At, B0); PG8_MMA(1, 1, At, B1); PG8_BAR; PG8_SCHED;
            PG8_LDB(B0, 1, 0); PG8_LDB(B1, 1, 1); PG8_SCHED; PG8_LDA(At, 1, 0); PG8_STAGE_A(PG8_SA(0, 1), a2, 1, last);
            PG8_WAIT_V(8); PG8_WAIT_L(0); PG8_BAR; PG8_MMA(0, 0, At, B0); PG8_MMA(0, 1, At, B1); PG8_BAR; PG8_SCHED;
            PG8_LDA(At, 1, 1); PG8_STAGE(PG8_SB(1, 0), b3, voffB); PG8_STAGE(PG8_SB(1, 1), b3 + hstepB, voffB); PG8_STAGE_A(PG8_SA(1, 0), a3, 0, last);
            PG8_WAIT_V(8); PG8_WAIT_L(0); PG8_BAR; PG8_MMA(1, 0, At, B0); PG8_MMA(1, 1, At, B1); PG8_BAR; PG8_SCHED;
        }
#if defined(PROBE_MASK) && PROBE_MASK
        if (blockIdx.x == PROBE_BLOCK && tid == 0 && ((volatile LAS unsigned*)(lds + 147456))[6]) ((LAS unsigned*)(lds + 147456 + 512))[14] += (unsigned)(__builtin_amdgcn_s_memrealtime() - _tk0);
#endif
        if (wr == 0) PG8_BAR;
#if defined(PROBE_MASK) && PROBE_MASK
        { const unsigned long long _t0 = __builtin_amdgcn_s_memrealtime();
          E(acc, cur, wr, wc, fr, fq);
          asm volatile("s_waitcnt vmcnt(0)" ::: "memory");
          if (blockIdx.x == PROBE_BLOCK && tid == 0 && ((volatile LAS unsigned*)(lds + 147456))[6]) ((LAS unsigned*)(lds + 147456 + 512))[13] += (unsigned)(__builtin_amdgcn_s_memrealtime() - _t0); }
#else
        E(acc, cur, wr, wc, fr, fq);
#endif
        if (!has_next) break;
#pragma unroll
        for (int a = 0; a < 2; ++a)
#pragma unroll
            for (int b = 0; b < 2; ++b)
#pragma unroll
                for (int m = 0; m < 4; ++m)
#pragma unroll
                    for (int n = 0; n < 2; ++n) acc[a][b][m][n] = (acc_t){0, 0, 0, 0};
        cur = nxt; cA = nA; cB = nB; ++ui;
        if constexpr (GATHER) {
#pragma unroll
        for (int h = 0; h < 2; ++h)
#pragma unroll
            for (int i = 0; i < 2; ++i) vAc[h][i] = vAn[h][i]; }
        if (wr == 1) PG8_BAR;
    }
    PG8_WAIT_V(0);
    PG8_BAR;
#undef PG8_SA
#undef PG8_SB
#undef PG8_STAGE
#undef PG8_LDA
#undef PG8_LDB
#undef PG8_MMA
#undef PG8_WAIT_V
#undef PG8_WAIT_L
#undef PG8_BAR
#undef PG8_SCHED
#undef PG8_AOFF
#undef PG8_STAGE_A
}
}

constexpr int D = 1024, BATCH = 32, SEQ = 2048, DEPTH = 2;
constexpr int NCH = 2, BC = BATCH / NCH, TC = BC * SEQ;
constexpr int TT = BATCH * SEQ;
constexpr int NP = 10496;
constexpr int C_QA = 0, C_KA = 256, C_VA = 512, C_OG = 1024, C_GP = 1536, C_XB = 1792, C_YB = 2304, C_QKV = 2816, C_G = 7424;
constexpr int WIN_N = 10256;
constexpr int NE = 16, FF = 512;
constexpr int RP = 2 * TT + NE * 256;
constexpr float RMS_EPS = 1e-6f;
constexpr int NWAVES = 8, NTHR = 512;

constexpr size_t MiB = 1u << 20;
constexpr size_t WS_CTL = 0, CTL_ZERO_BYTES = 1 * MiB;
constexpr size_t WS_REC = 1 * MiB;
constexpr size_t WS_LIST = 2 * MiB;
constexpr size_t WS_W = 6 * MiB;
constexpr size_t LW_WIN = 0, LW_WBR = LW_WIN + (size_t)NP * D * 2, LW_WOUT = LW_WBR + (size_t)3 * D * 512 * 2, LW_WGU = LW_WOUT + (size_t)D * D * 2,
                 LW_WDN = LW_WGU + (size_t)NE * 1024 * D * 2, LW_SIZE = LW_WDN + (size_t)NE * D * FF * 2;
static_assert(LW_SIZE == 77070336, "layer weights");
constexpr size_t WS_BRC = 154 * MiB;
constexpr size_t WS_SA = WS_BRC + 2 * MiB;
constexpr size_t WS_ACT = 166 * MiB;
constexpr size_t WS_PROJ = 294 * MiB;
constexpr size_t WS_HID = WS_PROJ;
constexpr size_t WS_YS = WS_PROJ + 136 * MiB;
constexpr size_t WS_XB = WS_PROJ + 400 * MiB;
constexpr size_t WS_RSL = WS_PROJ + 656 * MiB;
constexpr size_t WS_END = WS_RSL + 4 * MiB;
static_assert(WS_W + 2 * LW_SIZE <= WS_BRC && WS_BRC + 12 * MiB <= WS_ACT && WS_ACT + (size_t)TT * D * 2 <= WS_PROJ && (size_t)TC * NP * 2 <= 656 * MiB && (size_t)RP * 512 * 2 <= 136 * MiB && WS_YS + (size_t)RP * 2048 <= WS_XB && WS_XB + (size_t)TT * D * 2 <= WS_RSL, "ws map");
constexpr int CW_BAR = 4096;
constexpr int CW_CNT = 8192;
constexpr int CW_Q = 12288;
constexpr int CW_CMAX2 = 65536 + 2 * NP;
constexpr int CW_CMAX = 65536;

constexpr int RING_BYTES = 147456;
constexpr int MISC_OFF = RING_BYTES;
constexpr int LDS_BYTES = 155648;

#define LDS_WAIT() asm volatile("s_waitcnt lgkmcnt(0)" ::: "memory")
#define VM_WAIT() asm volatile("s_waitcnt vmcnt(0)" ::: "memory")
__device__ __forceinline__ float bf2f(unsigned short b) { return __uint_as_float(((unsigned)b) << 16); }
__device__ __forceinline__ float bflo(unsigned u) { return __uint_as_float(u << 16); }
__device__ __forceinline__ float bfhi(unsigned u) { return __uint_as_float(u & 0xffff0000u); }
typedef __bf16 bf16x2v_t __attribute__((ext_vector_type(2)));
__device__ __forceinline__ unsigned pk2(float lo, float hi) { const f32x2 v = {lo, hi}; return __builtin_bit_cast(unsigned, __builtin_convertvector(v, bf16x2v_t)); }
__device__ __forceinline__ unsigned f2bf(float f) { return pk2(f, 0.f) & 0xffffu; }
__device__ __forceinline__ float rcpf_(float x) { return __builtin_amdgcn_rcpf(x); }
__device__ __forceinline__ float rsqf_(float x) { return __builtin_amdgcn_rsqf(x); }
template <int O> __device__ __forceinline__ float swz_xor(float v) { return __int_as_float(__builtin_amdgcn_ds_swizzle(__float_as_int(v), (O << 10) | 0x1f)); }
__device__ __forceinline__ float wave_sum(float v) {
    v += swz_xor<1>(v); v += swz_xor<2>(v); v += swz_xor<4>(v); v += swz_xor<8>(v); v += swz_xor<16>(v);
    const auto r = __builtin_amdgcn_permlane32_swap(__float_as_uint(v), __float_as_uint(v), false, false);
    return __uint_as_float(r[0]) + __uint_as_float(r[1]);
}
__device__ __forceinline__ float wave_max(float v) {
    v = fmaxf(v, swz_xor<1>(v)); v = fmaxf(v, swz_xor<2>(v)); v = fmaxf(v, swz_xor<4>(v)); v = fmaxf(v, swz_xor<8>(v)); v = fmaxf(v, swz_xor<16>(v));
    const auto r = __builtin_amdgcn_permlane32_swap(__float_as_uint(v), __float_as_uint(v), false, false);
    return fmaxf(__uint_as_float(r[0]), __uint_as_float(r[1]));
}
__device__ __forceinline__ float sigmoidf_(float x) { return __builtin_amdgcn_rcpf(1.f + __expf(-x)); }

#define XB_TMO      128
#define XB_XCNT(j)  (256  + 64 * (j))
#define XB_XSUB(j)  (1280 + 64 * (j))
#define XB_XGEN(j)  (2304 + 64 * (j))
#define XB_TOP      3328
#define XB_TOPGEN   3392
#define XCD_BAR_WORDS 3456
#define XB_SPIN_CAP (1u << 21)
__device__ __forceinline__ unsigned xb_ld(unsigned* p)              { return __hip_atomic_load(p, __ATOMIC_RELAXED, __HIP_MEMORY_SCOPE_AGENT); }
__device__ __forceinline__ unsigned xb_add(unsigned* p, unsigned v) { return __hip_atomic_fetch_add(p, v, __ATOMIC_RELAXED, __HIP_MEMORY_SCOPE_AGENT); }
__device__ __forceinline__ unsigned xb_xcc_id() { return (unsigned)__builtin_amdgcn_s_getreg((3 << 11) | 20) & 0xFu; }
#define XB_SPIN(cond, bar) do { unsigned _sp = 0; while (cond) { __builtin_amdgcn_s_sleep(1); \
    if ((++_sp & 255u) == 0u) { if (xb_ld(&(bar)[XB_TMO])) break; if (_sp > XB_SPIN_CAP) { atomicAdd(&(bar)[XB_TMO], 1u); break; } } } } while (0)
struct XcdBarrier { unsigned* bar; unsigned x; volatile LAS unsigned* st; };
__device__ __forceinline__ XcdBarrier xcd_barrier_post(unsigned* bar, volatile LAS unsigned* st, int tid) {
    XcdBarrier b; b.bar = bar; b.x = xb_xcc_id(); b.st = st;
    if (tid == 0) (void)xb_add(&bar[XB_XCNT(b.x)], 1u);
    return b;
}
__device__ __forceinline__ void xcd_barrier_complete(unsigned* bar, unsigned x, unsigned& nloc, unsigned& nx) {
    const unsigned G = gridDim.x * gridDim.y * gridDim.z;
    unsigned sum, cnt, sp = 0u;
    for (;;) {
        sum = 0u; cnt = 0u;
#pragma unroll 1
        for (unsigned j = 0; j < 16; ++j) { const unsigned c = xb_ld(&bar[XB_XCNT(j)]); sum += c; cnt += (c > 0u) ? 1u : 0u; }
        if (sum == G) break;
        __builtin_amdgcn_s_sleep(1);
        if ((++sp & 255u) == 0u) { if (xb_ld(&bar[XB_TMO])) break; if (sp > XB_SPIN_CAP) { atomicAdd(&bar[XB_TMO], 1u); break; } }
    }
    const unsigned mine = xb_ld(&bar[XB_XCNT(x)]);
    nloc = mine > 0u ? mine : 1u; nx = cnt > 0u ? cnt : 1u;
}
__device__ __noinline__ void xcd_barrier(const XcdBarrier b, const int tid) {
    asm volatile("s_waitcnt vmcnt(0)" ::: "memory");
    __syncthreads();
    if (tid == 0) {
        unsigned* bar = b.bar;
        __builtin_amdgcn_s_waitcnt(0);
        unsigned nloc = b.st[0], nx = b.st[1];
        if (nloc == 0u) { xcd_barrier_complete(bar, b.x, nloc, nx); b.st[0] = nloc; b.st[1] = nx; }
        const unsigned old = xb_add(&bar[XB_XSUB(b.x)], 1u);
        const unsigned gen = old / nloc;
        if (old + 1u == (gen + 1u) * nloc) {
            __builtin_amdgcn_fence(__ATOMIC_RELEASE, "agent");
            asm volatile("s_waitcnt vmcnt(0)" ::: "memory");
            const unsigned og = xb_add(&bar[XB_TOP], 1u);
            const unsigned tg = og / nx;
            if (og + 1u == (tg + 1u) * nx) xb_add(&bar[XB_TOPGEN], 1u);
            else XB_SPIN(xb_ld(&bar[XB_TOPGEN]) == tg, bar);
            __builtin_amdgcn_fence(__ATOMIC_ACQUIRE, "agent");
            xb_add(&bar[XB_XGEN(b.x)], 1u);
            asm volatile("s_waitcnt vmcnt(0)" ::: "memory");
        } else {
            XB_SPIN(xb_ld(&bar[XB_XGEN(b.x)]) == gen, bar);
            __builtin_amdgcn_fence(__ATOMIC_ACQUIRE, "agent");
            asm volatile("s_waitcnt vmcnt(0)" ::: "memory");
        }
    }
    __syncthreads();
}

struct Args { const void* in[24]; float* out; unsigned char* ws; int ph_lo, ph_hi; };
struct Ctx {
    LAS unsigned char* lds;
    unsigned* ctl;
    int tid, lane, wave, bid, G;
    int chunk, layer, pass;
    const float* x_in; float* xo;
    const float* xinf; float* xof; bf16_t* actf;
    float* sa;
    bf16_t* xb; bf16_t* x2;
    const int* pos;
    const unsigned char* lw;
    bf16_t *act, *proj, *hid, *ys;
    unsigned* rec; int* list; float* rsl;
};

template <class DMap>
__device__ __forceinline__ void tr_item64(const float* srcA, const float* srcB, int Nsrc, float scale, bf16_t* WT, int K, int n0, int k0, LAS float* scr, int lane, DMap dmap) {
    const int r4 = lane >> 4, c16 = lane & 15;
    const float* src = (c16 < 8 ? srcA + 4 * c16 : srcB + 4 * (c16 - 8));
    f32x4 v[16];
#pragma unroll
    for (int i = 0; i < 16; ++i) v[i] = *(const f32x4*)(src + (size_t)(k0 + 4 * i + r4) * Nsrc);
#pragma unroll
    for (int i = 0; i < 16; ++i) { LAS float* d = scr + (4 * i + r4) * 65 + 4 * c16; d[0] = v[i].x * scale; d[1] = v[i].y * scale; d[2] = v[i].z * scale; d[3] = v[i].w * scale; }
    LDS_WAIT(); asm volatile("" ::: "memory");
    const int kc = lane & 7;
#pragma unroll
    for (int j = 0; j < 8; ++j) { const int r = (lane >> 3) + 8 * j; const LAS float* q = scr + (8 * kc) * 65 + dmap(r);
        u32x4 o; o.x = pk2(q[0 * 65], q[1 * 65]); o.y = pk2(q[2 * 65], q[3 * 65]); o.z = pk2(q[4 * 65], q[5 * 65]); o.w = pk2(q[6 * 65], q[7 * 65]);
        *(u32x4*)(WT + (size_t)(n0 + r) * K + k0 + 8 * kc) = o; }
    LDS_WAIT(); asm volatile("" ::: "memory");
}
struct DMapId { __device__ __forceinline__ int operator()(int r) const { return r; } };
struct DMapGU { __device__ __forceinline__ int operator()(int r) const { return ((r >> 4) & 1) * 32 + (r >> 5) * 16 + (r & 15); } };
template <class DMap>
__device__ __forceinline__ void tr_item64q(const float* srcA, const float* srcB, int Nsrc, float scale, signed char* WTq, int K, int n0, int k0, LAS float* scr, int lane, const unsigned* cmax, DMap dmap) {
    const int r4 = lane >> 4, c16 = lane & 15;
    const float* src = (c16 < 8 ? srcA + 4 * c16 : srcB + 4 * (c16 - 8));
    f32x4 v[16];
#pragma unroll
    for (int i = 0; i < 16; ++i) v[i] = *(const f32x4*)(src + (size_t)(k0 + 4 * i + r4) * Nsrc);
#pragma unroll
    for (int i = 0; i < 16; ++i) { LAS float* d = scr + (4 * i + r4) * 65 + 4 * c16; d[0] = v[i].x * scale; d[1] = v[i].y * scale; d[2] = v[i].z * scale; d[3] = v[i].w * scale; }
    LDS_WAIT(); asm volatile("" ::: "memory");
    const int kc = lane & 3;
#pragma unroll
    for (int j = 0; j < 4; ++j) { const int r = (lane >> 2) + 16 * j; const LAS float* q = scr + (16 * kc) * 65 + dmap(r);
        const float mx = __uint_as_float(cmax[n0 + r]); const float inv = mx > 0.f ? 127.f / mx : 0.f;
        unsigned w[4];
#pragma unroll
        for (int k = 0; k < 4; ++k) { const int q0 = (int)__builtin_rintf(q[(4 * k + 0) * 65] * inv), q1 = (int)__builtin_rintf(q[(4 * k + 1) * 65] * inv), q2 = (int)__builtin_rintf(q[(4 * k + 2) * 65] * inv), q3 = (int)__builtin_rintf(q[(4 * k + 3) * 65] * inv);
            w[k] = (unsigned)(q0 & 0xff) | ((unsigned)(q1 & 0xff) << 8) | ((unsigned)(q2 & 0xff) << 16) | ((unsigned)(q3 & 0xff) << 24); }
        u32x4 o; o.x = w[0]; o.y = w[1]; o.z = w[2]; o.w = w[3];
        *(u32x4*)(WTq + (size_t)(n0 + r) * K + k0 + 16 * kc) = o; }
    LDS_WAIT(); asm volatile("" ::: "memory");
}
__device__ __forceinline__ void cmax_item64(const float* srcA, int Nsrc, float scale, int n0, int k0, int lane, unsigned* cmax) {
    const int r4 = lane >> 4, c16 = lane & 15;
    const float* src = srcA + 4 * c16;
    f32x4 m = {0.f, 0.f, 0.f, 0.f};
#pragma unroll
    for (int i = 0; i < 16; ++i) { const f32x4 v = *(const f32x4*)(src + (size_t)(k0 + 4 * i + r4) * Nsrc);
        m.x = fmaxf(m.x, fabsf(v.x)); m.y = fmaxf(m.y, fabsf(v.y)); m.z = fmaxf(m.z, fabsf(v.z)); m.w = fmaxf(m.w, fabsf(v.w)); }
    m.x = fmaxf(m.x, swz_xor<16>(m.x)); m.y = fmaxf(m.y, swz_xor<16>(m.y)); m.z = fmaxf(m.z, swz_xor<16>(m.z)); m.w = fmaxf(m.w, swz_xor<16>(m.w));
    const float mv[4] = {m.x, m.y, m.z, m.w};
#pragma unroll
    for (int k = 0; k < 4; ++k) { const auto r = __builtin_amdgcn_permlane32_swap(__float_as_uint(mv[k]), __float_as_uint(mv[k]), false, false);
        const float t = fmaxf(__uint_as_float(r[0]), __uint_as_float(r[1])) * scale;
        if (lane < 16) atomicMax(cmax + n0 + 4 * c16 + k, __float_as_uint(t)); }
}
constexpr int IT_WIN = (NP / 64) * 16, IT_WBR = 3 * 16 * 8, IT_WOUT = 16 * 16, IT_WGU = NE * 16 * 16, IT_WDN = NE * 16 * 8, IT_LAYER = IT_WIN + IT_WBR + IT_WOUT + IT_WGU + IT_WDN;
__device__ __forceinline__ void cmax_item64gu(const float* src0, int Nsrc, int col0, int isup, int k0, int lane, unsigned* cmax) {
    const int r4 = lane >> 4, c16 = lane & 15;
    const float* src = src0 + col0 + 4 * c16;
    f32x4 m = {0.f, 0.f, 0.f, 0.f};
#pragma unroll
    for (int i = 0; i < 16; ++i) { const f32x4 v = *(const f32x4*)(src + (size_t)(k0 + 4 * i + r4) * Nsrc);
        m.x = fmaxf(m.x, fabsf(v.x)); m.y = fmaxf(m.y, fabsf(v.y)); m.z = fmaxf(m.z, fabsf(v.z)); m.w = fmaxf(m.w, fabsf(v.w)); }
    m.x = fmaxf(m.x, swz_xor<16>(m.x)); m.y = fmaxf(m.y, swz_xor<16>(m.y)); m.z = fmaxf(m.z, swz_xor<16>(m.z)); m.w = fmaxf(m.w, swz_xor<16>(m.w));
    const float mv[4] = {m.x, m.y, m.z, m.w};
#pragma unroll
    for (int k = 0; k < 4; ++k) { const auto r = __builtin_amdgcn_permlane32_swap(__float_as_uint(mv[k]), __float_as_uint(mv[k]), false, false);
        const float t = fmaxf(__uint_as_float(r[0]), __uint_as_float(r[1])); const int j = col0 + 4 * c16 + k;
        if (lane < 16) atomicMax(cmax + 32 * (j >> 4) + 16 * isup + (j & 15), __float_as_uint(t)); }
}
__device__ __forceinline__ void phase_prep_a(const Args& a, float* tmpf, unsigned* cmaxb, int gw, int NGW, int lane, int gtid, int NGT) {
    constexpr int IT = (WIN_N / 64) * 16;
    for (int it = gw; it < DEPTH * IT; it += NGW) {
        const int l = it / IT, r = it % IT, gsrc = r / 16, kb = r % 16;
        int src = 64 * gsrc; if (src >= 1536) src += 16;
        const int n0 = src < 1536 ? src : src + 240;
        const float* W = (const float*)a.in[3] + (size_t)l * D * WIN_N + src;
        cmax_item64(W, WIN_N, n0 < 256 ? 0.125f : 1.f, n0, 64 * kb, lane, cmaxb + (size_t)l * NP);
    }
    constexpr int ITG = NE * 2 * 8 * 16;
    for (int it = gw; it < DEPTH * ITG; it += NGW) {
        const int l = it / ITG, r = it % ITG, e = r / 256, isup = (r / 128) & 1, cg = (r / 16) & 7, kb = r % 16;
        const float* W = (isup ? (const float*)a.in[22] : (const float*)a.in[21]) + ((size_t)l * NE + e) * D * FF;
        cmax_item64gu(W, FF, 64 * cg, isup, 64 * kb, lane, cmaxb + (CW_CMAX2 - CW_CMAX) + ((size_t)l * NE + e) * 1024);
    }
    for (int idx = gtid; idx < DEPTH * 256 * D; idx += NGT) {
        const int l = idx / (256 * D), j = (idx / D) % 256, k = idx % D;
        const float* W = (const float*)a.in[3] + (size_t)l * D * WIN_N + (size_t)k * WIN_N + 1536;
        const float* gu = (const float*)a.in[4] + (size_t)l * 16 * 256 + j;
        float s = 0.f;
#pragma unroll
        for (int r = 0; r < 16; ++r) s += W[r] * gu[r * 256];
        tmpf[idx] = s;
        float m = fabsf(s); m = wave_max(m);
        if (lane == 0) atomicMax(cmaxb + (size_t)l * NP + C_GP + j, __float_as_uint(m));
    }
}
__device__ __forceinline__ void phase_prep(const Args& a, const float* tmpf, const unsigned* cmaxb, LAS unsigned char* lds, int gw, int NGW, int wave, int lane, int gtid, int NGT) {
    LAS float* scr = (LAS float*)(lds + wave * 17408);
    for (int it = gw; it < DEPTH * IT_LAYER; it += NGW) {
        const int l = it / IT_LAYER; int r = it % IT_LAYER;
        unsigned char* lw = a.ws + WS_W + (size_t)l * LW_SIZE;
        if (r < IT_WIN) {
            const int g = r / 16, kb = r % 16;
            if (g >= C_GP / 64 && g < C_XB / 64) continue;
            const int n0 = 64 * g, src = n0 < C_GP ? n0 : n0 - 240;
            const float* W = (const float*)a.in[3] + (size_t)l * D * WIN_N + src;
            tr_item64q(W, W + 32, WIN_N, n0 < 256 ? 0.125f : 1.f, (signed char*)(lw + LW_WIN), D, n0, 64 * kb, scr, lane, cmaxb + (size_t)l * NP, DMapId());
            continue; }
        r -= IT_WIN;
        if (r < IT_WBR) {
            const int b = r / 128, g = (r % 128) / 8, kb = r % 8;
            const float* W = (const float*)a.in[16] + ((size_t)l * 3 + b) * 512 * D + 64 * g;
            tr_item64(W, W + 32, D, 1.f, (bf16_t*)(lw + LW_WBR) + (size_t)b * D * 512, 512, 64 * g, 64 * kb, scr, lane, DMapId());
            continue; }
        r -= IT_WBR;
        if (r < IT_WOUT) {
            const int g = r / 16, kb = r % 16;
            const float* W = (const float*)a.in[17] + (size_t)l * D * D + 64 * g;
            tr_item64(W, W + 32, D, 1.f, (bf16_t*)(lw + LW_WOUT), D, 64 * g, 64 * kb, scr, lane, DMapId());
            continue; }
        r -= IT_WOUT;
        if (r < IT_WGU) {
            const int e = r / 256, g = (r % 256) / 16, kb = r % 16;
            const float* Wg = (const float*)a.in[21] + ((size_t)l * NE + e) * D * FF + 32 * g;
            const float* Wu = (const float*)a.in[22] + ((size_t)l * NE + e) * D * FF + 32 * g;
            tr_item64q(Wg, Wu, FF, 1.f, (signed char*)(lw + LW_WGU) + (size_t)e * 1024 * D, D, 64 * g, 64 * kb, scr, lane, cmaxb + (CW_CMAX2 - CW_CMAX) + ((size_t)l * NE + e) * 1024, DMapGU());
            continue; }
        r -= IT_WGU;
        {
            const int e = r / 128, g = (r % 128) / 8, kb = r % 8;
            const float* W = (const float*)a.in[23] + ((size_t)l * NE + e) * FF * D + 64 * g;
            tr_item64(W, W + 32, D, 1.f, (bf16_t*)(lw + LW_WDN) + (size_t)e * D * FF, FF, 64 * g, 64 * kb, scr, lane, DMapId());
        }
    }
    for (int idx = gtid; idx < DEPTH * 256 * (D / 16); idx += NGT) {
        const int l = idx / (256 * (D / 16)), j = (idx / (D / 16)) % 256, k16 = idx % (D / 16);
        const float mx = __uint_as_float(cmaxb[(size_t)l * NP + C_GP + j]); const float inv = mx > 0.f ? 127.f / mx : 0.f;
        const f32x4* t = (const f32x4*)(tmpf + ((size_t)l * 256 + j) * D + 16 * k16);
        unsigned w[4];
#pragma unroll
        for (int k = 0; k < 4; ++k) { const f32x4 v = t[k]; const int q0 = (int)__builtin_rintf(v.x * inv), q1 = (int)__builtin_rintf(v.y * inv), q2 = (int)__builtin_rintf(v.z * inv), q3 = (int)__builtin_rintf(v.w * inv);
            w[k] = (unsigned)(q0 & 0xff) | ((unsigned)(q1 & 0xff) << 8) | ((unsigned)(q2 & 0xff) << 16) | ((unsigned)(q3 & 0xff) << 24); }
        u32x4 o; o.x = w[0]; o.y = w[1]; o.z = w[2]; o.w = w[3];
        *(u32x4*)((signed char*)(a.ws + WS_W + (size_t)l * LW_SIZE + LW_WIN) + (size_t)(C_GP + j) * D + 16 * k16) = o;
    }
}

__device__ __forceinline__ void moe_tables(const unsigned* cnt, LAS int* pt, LAS int* lc, int tid) {
    if (tid == 0) { int s = 0;
        for (int e = 0; e < NE; ++e) { const int c = (int)__hip_atomic_load(cnt + e, __ATOMIC_RELAXED, __HIP_MEMORY_SCOPE_AGENT); pt[e] = s; lc[e] = c; s += (c + 255) >> 8; }
        pt[NE] = s; }
    __syncthreads();
}

template <bool COMBINE, bool NORM, bool SRC_BF16>
__device__ __forceinline__ void phase_norm1(const Ctx& c, const float* gain, LAS const int* pt) {
    const int gw = c.bid * NWAVES + c.wave, NGW = c.G * NWAVES, lane = c.lane;
    f32x4 g4[4];
    if (NORM) {
#pragma unroll
        for (int j = 0; j < 4; ++j) g4[j] = *((const f32x4*)gain + 64 * j + lane); }
    constexpr int NR = 4;
    static_assert(TT % (NR * 2048) == 0, "rows per wave");
    for (int tok0 = gw; tok0 < TT; tok0 += NR * NGW) {
        f32x4 v[NR][4]; u32x2 xs[NR][4]; u32x2 ya[NR][4], yb[NR][4]; float w0[NR], w1[NR];
#pragma unroll
        for (int r = 0; r < NR; ++r) { const int tok = tok0 + r * NGW;
            if (SRC_BF16) { const u32x2* xr = (const u32x2*)(c.xb + (size_t)tok * D) + lane;
#pragma unroll
                for (int j = 0; j < 4; ++j) xs[r][j] = xr[64 * j]; }
            else { const f32x4* xr = (const f32x4*)(c.xinf + (size_t)tok * D) + lane;
#pragma unroll
                for (int j = 0; j < 4; ++j) v[r][j] = xr[64 * j]; }
            if (COMBINE) {
                const u32x4 rc = *(const u32x4*)(c.rec + (size_t)tok * 4);
                const int e0 = rc.x >> 20, e1 = rc.y >> 20;
                const size_t r0 = (size_t)pt[e0] * 256 + (rc.x & 0xfffffu), r1 = (size_t)pt[e1] * 256 + (rc.y & 0xfffffu);
                w0[r] = __uint_as_float(rc.z); w1[r] = __uint_as_float(rc.w);
                const u32x2* y0 = (const u32x2*)(c.ys + r0 * D) + lane; const u32x2* y1 = (const u32x2*)(c.ys + r1 * D) + lane;
#pragma unroll
                for (int j = 0; j < 4; ++j) { ya[r][j] = y0[64 * j]; yb[r][j] = y1[64 * j]; }
            } }
#pragma unroll
        for (int r = 0; r < NR; ++r) { const int tok = tok0 + r * NGW;
            if (SRC_BF16) {
#pragma unroll
                for (int j = 0; j < 4; ++j) { v[r][j].x = bflo(xs[r][j].x); v[r][j].y = bfhi(xs[r][j].x); v[r][j].z = bflo(xs[r][j].y); v[r][j].w = bfhi(xs[r][j].y); } }
            if (COMBINE) {
#pragma unroll
                for (int j = 0; j < 4; ++j) { const u32x2 a = ya[r][j], b = yb[r][j];
                    v[r][j].x += w0[r] * bflo(a.x) + w1[r] * bflo(b.x); v[r][j].y += w0[r] * bfhi(a.x) + w1[r] * bfhi(b.x);
                    v[r][j].z += w0[r] * bflo(a.y) + w1[r] * bflo(b.y); v[r][j].w += w0[r] * bfhi(a.y) + w1[r] * bfhi(b.y); }
                if (NORM) { u32x2* xw = (u32x2*)(c.x2 + (size_t)tok * D) + lane;
#pragma unroll
                    for (int j = 0; j < 4; ++j) { u32x2 w; w.x = pk2(v[r][j].x, v[r][j].y); w.y = pk2(v[r][j].z, v[r][j].w); xw[64 * j] = w; } }
                else { f32x4* xw = (f32x4*)(c.xof + (size_t)tok * D) + lane;
#pragma unroll
                    for (int j = 0; j < 4; ++j) __builtin_nontemporal_store(v[r][j], xw + 64 * j); }
            }
            if (NORM) {
                float ss = 0.f;
#pragma unroll
                for (int j = 0; j < 4; ++j) ss += (v[r][j].x * v[r][j].x + v[r][j].y * v[r][j].y) + (v[r][j].z * v[r][j].z + v[r][j].w * v[r][j].w);
                const float rs = rsqf_(wave_sum(ss) * (1.f / D) + RMS_EPS);
                float am = 0.f;
#pragma unroll
                for (int j = 0; j < 4; ++j) { v[r][j] = v[r][j] * rs * g4[j]; am = fmaxf(am, fmaxf(fmaxf(fabsf(v[r][j].x), fabsf(v[r][j].y)), fmaxf(fabsf(v[r][j].z), fabsf(v[r][j].w)))); }
                am = wave_max(am);
                const float inv = am > 0.f ? 127.f / am : 0.f;
                if (lane == 0) c.sa[tok] = am * (1.f / 127.f);
                unsigned* o = (unsigned*)((signed char*)c.actf + ((size_t)(tok / TC) * TC * 2 + (size_t)(tok % TC)) * D) + lane;
#pragma unroll
                for (int j = 0; j < 4; ++j) { const int q0 = (int)__builtin_rintf(v[r][j].x * inv), q1 = (int)__builtin_rintf(v[r][j].y * inv), q2 = (int)__builtin_rintf(v[r][j].z * inv), q3 = (int)__builtin_rintf(v[r][j].w * inv);
                    o[64 * j] = (unsigned)(q0 & 0xff) | ((unsigned)(q1 & 0xff) << 8) | ((unsigned)(q2 & 0xff) << 16) | ((unsigned)(q3 & 0xff) << 24); }
            } }
    }
}

__constant__ double kInvFreq[16] = {1.0, 0.44036660267178046, 0.19392274474868576, 0.08539710028576561, 0.03760603093086393, 0.016560440080994446, 0.007292664737217109, 0.003211445994752591,
    0.001414213562373095, 0.000622772421914596, 0.0002742481756762073, 0.00012076973741146504, 5.318295896944988e-05, 2.341999896140934e-05, 1.031338537721246e-05, 4.5416704806078695e-06};
__device__ __forceinline__ void phase_rope_table(const int* pos, float* tab, int gtid, int NGT) {
    for (int idx = gtid; idx < BATCH * SEQ * 16; idx += NGT) { const int tok = idx >> 4, i = idx & 15;
        double a = (double)pos[tok] * kInvFreq[i] * 0.15915494309189535; a -= rint(a);
        tab[(size_t)tok * 32 + i] = __builtin_amdgcn_cosf((float)a); tab[(size_t)tok * 32 + 16 + i] = __builtin_amdgcn_sinf((float)a); }
}

__device__ __forceinline__ float logsigmoidf_(float g) { return fminf(g, 0.f) - log1pf(__expf(-fabsf(g))); }
__device__ __forceinline__ float gelu_tanh(float y) { const float u2 = 1.5957691216057308f * (y + 0.044715f * y * y * y); return y * __builtin_amdgcn_rcpf(1.f + __expf(-u2)); }


typedef unsigned short u16x4 __attribute__((ext_vector_type(4)));
__device__ __forceinline__ unsigned offb(unsigned row, unsigned ch) { return 256u * row + 16u * (ch ^ (((row & 3u) << 2) | ((row >> 2) & 3u))); }
constexpr int ATT_UNITS_PER_SEQ = 3 * 4 * 16;
struct AttU { int b, p, h, blk, dsh, it0; size_t tok0; int qcol, kcol, vcol; };
__device__ __forceinline__ AttU att_decode(int unit) {
    AttU a; a.b = unit / ATT_UNITS_PER_SEQ; const int rem = unit % ATT_UNITS_PER_SEQ; a.p = rem / 64; a.h = (rem / 16) & 3; const int qb = rem & 15;
    a.dsh = 2 * a.p; const int nblk = 16 >> a.dsh, r = qb / nblk; a.blk = qb % nblk; a.tok0 = (size_t)a.b * SEQ + r; a.it0 = a.blk == 0 ? 4 : 0;
    a.qcol = C_QKV + (a.p * 4 + a.h) * 128; a.kcol = C_QKV + (12 + a.p * 4 + a.h) * 128; a.vcol = C_QKV + (24 + a.p * 4 + a.h) * 128; return a;
}
#define ATT_DMA(U, col, dst) do { const unsigned _ch = ((unsigned)lane & 15u) ^ ((((unsigned)lane >> 4) << 2) | ((unsigned)w & 3u)); \
        const int _srow0 = ((U).blk - 1) * 128 + 4 * w + (lane >> 4); \
        const bf16_t* _p0 = c.proj + ((long)(U).tok0 + (long)_srow0 * (long)(1 << (U).dsh)) * NP + (col) + _ch * 8; const size_t _st = ((size_t)32 << (U).dsh) * NP; \
        _Pragma("unroll") for (int it = 0; it < 8; ++it) if (it >= (U).it0) \
            __builtin_amdgcn_global_load_lds((const unsigned*)(_p0 + it * _st), (LAS unsigned*)((dst) + 1024 * (w + 8 * it)), 16, 0, 0); } while (0)
#define ATT_LOADQ(U) do { const size_t qt = (U).tok0 + ((size_t)((U).blk * 128 + qi) << (U).dsh); \
        _Pragma("unroll") for (int s = 0; s < 4; ++s) qr[s] = *(const u32x4*)(c.proj + qt * NP + (U).qcol + 32 * s + 8 * g); \
        const f32x4* rt = (const f32x4*)(rope_tab + qt * 32 + 8 * (g & 1)); qc0 = rt[0]; qc1 = rt[1]; qs0 = rt[4]; qs1 = rt[5]; \
        int srow = ((U).blk - 1) * 128 + (int)rrow; if (srow < 0) srow += 128; \
        const float* rt2 = rope_tab + ((U).tok0 + ((size_t)srow << (U).dsh)) * 32 + 8 * rps; \
        rc0 = *(const f32x4*)rt2; rc1 = *(const f32x4*)(rt2 + 4); rs0 = *(const f32x4*)(rt2 + 16); rs1 = *(const f32x4*)(rt2 + 20); } while (0)
__device__ __forceinline__ void attn_loop(const Ctx& c, unsigned* qhead, volatile LAS unsigned* mbox, float* lse_buf, const float* qgain, const float* kgain, const float* rope_tab  ) {
    const int tid = c.tid, lane = c.lane, w = c.wave;
    const unsigned NU = (unsigned)(BC * ATT_UNITS_PER_SEQ);
    LAS unsigned char* sK = c.lds; LAS unsigned char* sV = c.lds + 65536;
    LAS float* sRS = (LAS float*)(c.lds + MISC_OFF + 2048);
    const int qq = lane & 15, g = lane >> 4, qi = 16 * w + qq;
    const unsigned rrow = (unsigned)tid >> 1, rps = (unsigned)tid & 1u;
#if defined(PROBE_MASK) && PROBE_MASK
    unsigned long long _ta = __builtin_amdgcn_s_memrealtime();
#define ATT_STAMP(k) do { const unsigned long long _tb = __builtin_amdgcn_s_memrealtime(); if (blockIdx.x == PROBE_BLOCK && tid == 0) ((LAS unsigned*)(c.lds + MISC_OFF + 512))[(k)] += (unsigned)(_tb - _ta); _ta = _tb; } while (0)
#else
#define ATT_STAMP(k) do {} while (0)
#endif
    LAS float* sGQ = (LAS float*)(c.lds + MISC_OFF + 3072); LAS float* sGK = sGQ + 128;
    if (tid < 128) sGQ[tid] = qgain[tid]; else if (tid < 256) sGK[tid - 128] = kgain[tid - 128];
    if (tid == 0) { mbox[0] = __hip_atomic_fetch_add(qhead, 1u, __ATOMIC_RELAXED, __HIP_MEMORY_SCOPE_AGENT); mbox[1] = __hip_atomic_fetch_add(qhead, 1u, __ATOMIC_RELAXED, __HIP_MEMORY_SCOPE_AGENT); }
    __syncthreads();
    unsigned ucur = mbox[0], unxt = mbox[1];
    if (ucur >= NU) return;
    AttU U = att_decode((int)ucur);
    u32x4 qr[4]; f32x4 qc0, qc1, qs0, qs1, rc0, rc1, rs0, rs1;
    __syncthreads();
    ATT_DMA(U, U.kcol, sK); asm volatile("" ::: "memory");
    ATT_LOADQ(U); asm volatile("" ::: "memory");
    ATT_DMA(U, U.vcol, sV); asm volatile("" ::: "memory");
    bool first = true; unsigned nq = 0u;
    for (;;) {
        const int blk = U.blk, dsh = U.dsh, it0 = U.it0;
        const size_t qtok = U.tok0 + ((size_t)(blk * 128 + qi) << dsh);
        bf16x8 qf[4];
        {
            float qv[4][8]; float ss = 0.f;
#pragma unroll
            for (int s = 0; s < 4; ++s) { const unsigned wv[4] = {qr[s].x, qr[s].y, qr[s].z, qr[s].w};
#pragma unroll
                for (int k = 0; k < 4; ++k) { qv[s][2 * k] = bflo(wv[k]); qv[s][2 * k + 1] = bfhi(wv[k]); ss += qv[s][2 * k] * qv[s][2 * k] + qv[s][2 * k + 1] * qv[s][2 * k + 1]; } }
            ss += swz_xor<16>(ss);
            { const auto rr = __builtin_amdgcn_permlane32_swap(__float_as_uint(ss), __float_as_uint(ss), false, false); ss = __uint_as_float(rr[0]) + __uint_as_float(rr[1]); }
            const float rs = rsqf_(ss * (1.f / 128.f) + RMS_EPS);
#pragma unroll
            for (int s = 0; s < 4; ++s) { const f32x4 g0 = *(const LAS f32x4*)(sGQ + 32 * s + 8 * g), g1 = *(const LAS f32x4*)(sGQ + 32 * s + 8 * g + 4);
                const float gg[8] = {g0.x, g0.y, g0.z, g0.w, g1.x, g1.y, g1.z, g1.w};
#pragma unroll
                for (int j = 0; j < 8; ++j) qv[s][j] *= rs * gg[j]; }
            { const float cs8[8] = {qc0.x, qc0.y, qc0.z, qc0.w, qc1.x, qc1.y, qc1.z, qc1.w}, sn8[8] = {qs0.x, qs0.y, qs0.z, qs0.w, qs1.x, qs1.y, qs1.z, qs1.w};
              const float sgn = (g & 2) ? 1.f : -1.f;
#pragma unroll
              for (int j = 0; j < 8; ++j) { const auto rr = __builtin_amdgcn_permlane32_swap(__float_as_uint(qv[0][j]), __float_as_uint(qv[0][j]), false, false);
                  const float other = (g & 2) ? __uint_as_float(rr[0]) : __uint_as_float(rr[1]);
                  qv[0][j] = qv[0][j] * cs8[j] + sgn * other * sn8[j]; } }
#pragma unroll
            for (int s = 0; s < 4; ++s) { u32x4 pw; pw.x = pk2(qv[s][0], qv[s][1]); pw.y = pk2(qv[s][2], qv[s][3]); pw.z = pk2(qv[s][4], qv[s][5]); pw.w = pk2(qv[s][6], qv[s][7]); qf[s] = __builtin_bit_cast(bf16x8, pw); }
        }
        const f32x4 kc0 = rc0, kc1 = rc1, ks0v = rs0, ks1v = rs1;
        if (first) { if (it0) asm volatile("s_waitcnt vmcnt(4)" ::: "memory"); else asm volatile("s_waitcnt vmcnt(8)" ::: "memory"); }
        else       { if (it0) asm volatile("s_waitcnt vmcnt(13)" ::: "memory"); else asm volatile("s_waitcnt vmcnt(17)" ::: "memory"); }
        first = false;
        __syncthreads();
        if (tid == 0) nq = __hip_atomic_fetch_add(qhead, 1u, __ATOMIC_RELAXED, __HIP_MEMORY_SCOPE_AGENT);
        ATT_STAMP(5);
        {
            const int c16 = tid & 15, grp = tid >> 4;
            const f32x4 kg0 = *(const LAS f32x4*)(sGK + 8 * c16), kg1 = *(const LAS f32x4*)(sGK + 8 * c16 + 4);
            const float kg[8] = {kg0.x, kg0.y, kg0.z, kg0.w, kg1.x, kg1.y, kg1.z, kg1.w};
#pragma unroll 4
            for (int it = it0; it < 8; ++it) { const unsigned row = 32u * it + grp;
                LAS u32x4* kp_ = (LAS u32x4*)(sK + offb(row, c16));
                const u32x4 kr = *kp_; const unsigned wv[4] = {kr.x, kr.y, kr.z, kr.w};
                float kv[8]; float ss = 0.f;
#pragma unroll
                for (int k = 0; k < 4; ++k) { kv[2 * k] = bflo(wv[k]); kv[2 * k + 1] = bfhi(wv[k]); ss += kv[2 * k] * kv[2 * k] + kv[2 * k + 1] * kv[2 * k + 1]; }
                ss += swz_xor<1>(ss); ss += swz_xor<2>(ss); ss += swz_xor<4>(ss); ss += swz_xor<8>(ss);
                const float rs = rsqf_(ss * (1.f / 128.f) + RMS_EPS);
                if (c16 == 0) sRS[row] = rs;
                if (c16 >= 4) { u32x4 ko; ko.x = pk2(kv[0] * rs * kg[0], kv[1] * rs * kg[1]); ko.y = pk2(kv[2] * rs * kg[2], kv[3] * rs * kg[3]); ko.z = pk2(kv[4] * rs * kg[4], kv[5] * rs * kg[5]); ko.w = pk2(kv[6] * rs * kg[6], kv[7] * rs * kg[7]); *kp_ = ko; } }
        }
        __syncthreads();
        {
            const f32x4 ga0 = *(const LAS f32x4*)(sGK + 8 * rps), ga1 = *(const LAS f32x4*)(sGK + 8 * rps + 4), gb0 = *(const LAS f32x4*)(sGK + 16 + 8 * rps), gb1 = *(const LAS f32x4*)(sGK + 20 + 8 * rps);
            const float ga[8] = {ga0.x, ga0.y, ga0.z, ga0.w, ga1.x, ga1.y, ga1.z, ga1.w}, gb[8] = {gb0.x, gb0.y, gb0.z, gb0.w, gb1.x, gb1.y, gb1.z, gb1.w};
            const float cs8[8] = {kc0.x, kc0.y, kc0.z, kc0.w, kc1.x, kc1.y, kc1.z, kc1.w}, sn8[8] = {ks0v.x, ks0v.y, ks0v.z, ks0v.w, ks1v.x, ks1v.y, ks1v.z, ks1v.w};
            if (blk > 0 || rrow >= 128u) {
            LAS u32x4* p1 = (LAS u32x4*)(sK + offb(rrow, rps)); LAS u32x4* p2 = (LAS u32x4*)(sK + offb(rrow, rps + 2));
            const u32x4 a = *p1, b2 = *p2; const float rs = sRS[rrow];
            const unsigned wa[4] = {a.x, a.y, a.z, a.w}, wb[4] = {b2.x, b2.y, b2.z, b2.w};
            float o1[8], o2[8];
#pragma unroll
            for (int k = 0; k < 4; ++k) {
#pragma unroll
                for (int e = 0; e < 2; ++e) { const int j = 2 * k + e; const float x1 = (e ? bfhi(wa[k]) : bflo(wa[k])) * rs * ga[j], x2 = (e ? bfhi(wb[k]) : bflo(wb[k])) * rs * gb[j];
                    o1[j] = x1 * cs8[j] - x2 * sn8[j]; o2[j] = x2 * cs8[j] + x1 * sn8[j]; } }
            u32x4 w1, w2; w1.x = pk2(o1[0], o1[1]); w1.y = pk2(o1[2], o1[3]); w1.z = pk2(o1[4], o1[5]); w1.w = pk2(o1[6], o1[7]); w2.x = pk2(o2[0], o2[1]); w2.y = pk2(o2[2], o2[3]); w2.z = pk2(o2[4], o2[5]); w2.w = pk2(o2[6], o2[7]);
            *p1 = w1; *p2 = w2; }
        }
        __syncthreads();
        ATT_STAMP(6);
        const int ks0 = w >> 1, nskip = blk == 0 ? 4 : 0;
        f32x4 st[5][2];
        const unsigned krow_l = 8u * (qq >> 2) + (qq & 3u);
        LAS unsigned char* ka[2][4];
#pragma unroll
        for (int T = 0; T < 2; ++T)
#pragma unroll
            for (int s = 0; s < 4; ++s) ka[T][s] = sK + offb(32u * ks0 + krow_l + 4u * T, 4 * s + g);
#pragma unroll
        for (int n = 0; n < 5; ++n)
#pragma unroll
            for (int T = 0; T < 2; ++T) { f32x4 a = {0.f, 0.f, 0.f, 0.f};
                if (ks0 + n >= nskip) {
#pragma unroll
                for (int s = 0; s < 4; ++s) { const bf16x8 kf = *(const LAS bf16x8*)(ka[T][s] + 8192 * n); a = __builtin_amdgcn_mfma_f32_16x16x32_bf16(kf, qf[s], a, 0, 0, 0); } }
                st[n][T] = a; }
        asm volatile("s_waitcnt vmcnt(0) lgkmcnt(0)" ::: "memory");
        if (tid == 0) mbox[0] = nq;
        __syncthreads();
        const bool has_next = unxt < NU;
        AttU UN = att_decode(has_next ? (int)unxt : 0);
        if (has_next) { ATT_DMA(UN, UN.kcol, sK); asm volatile("" ::: "memory"); ATT_LOADQ(UN); }
        asm volatile("" ::: "memory");
        const float SC = 0.08838834764831845f * 1.4426950408889634f;
        float mx = -INFINITY;
#pragma unroll
        for (int n = 0; n < 5; ++n)
#pragma unroll
            for (int T = 0; T < 2; ++T)
#pragma unroll
                for (int i = 0; i < 4; ++i) { const int kj = 32 * (ks0 + n) + 8 * g + 4 * T + i;
                    bool ok = true;
                    if (n == 0) ok = kj >= qi;
                    if (n == 4) ok = kj <= qi + 128;
                    if (blk == 0) ok = ok && (kj >= 128);
                    const float v = ok ? st[n][T][i] : -INFINITY; st[n][T][i] = v; mx = fmaxf(mx, v); }
        mx = fmaxf(mx, swz_xor<16>(mx));
        { const auto rr = __builtin_amdgcn_permlane32_swap(__float_as_uint(mx), __float_as_uint(mx), false, false); mx = fmaxf(__uint_as_float(rr[0]), __uint_as_float(rr[1])); }
        float sum = 0.f; const float mxs = mx * SC;
#pragma unroll
        for (int n = 0; n < 5; ++n)
#pragma unroll
            for (int T = 0; T < 2; ++T)
#pragma unroll
                for (int i = 0; i < 4; ++i) { const float e = __builtin_amdgcn_exp2f(__builtin_fmaf(st[n][T][i], SC, -mxs)); st[n][T][i] = e; sum += e; }
        sum += swz_xor<16>(sum);
        { const auto rr = __builtin_amdgcn_permlane32_swap(__float_as_uint(sum), __float_as_uint(sum), false, false); sum = __uint_as_float(rr[0]) + __uint_as_float(rr[1]); }
        const float inv = rcpf_(sum);
        ATT_STAMP(7);
        f32x4 ot[8];
#pragma unroll
        for (int cc = 0; cc < 8; ++cc) ot[cc] = (f32x4){0.f, 0.f, 0.f, 0.f};
        const unsigned tq = (unsigned)qq >> 2, tp = (unsigned)qq & 3u;
        const unsigned vbase = (unsigned)(size_t)sV;
        unsigned va[2][8];
#pragma unroll
        for (int t = 0; t < 2; ++t)
#pragma unroll
            for (int cc = 0; cc < 8; ++cc) va[t][cc] = vbase + offb(32u * ks0 + 8u * g + 4u * t + tq, 2 * cc + (tp >> 1)) + 8u * (tp & 1u);
#pragma unroll
        for (int n = 0; n < 5; ++n) if (ks0 + n >= nskip) {
            u32x4 pw; pw.x = pk2(st[n][0][0], st[n][0][1]); pw.y = pk2(st[n][0][2], st[n][0][3]); pw.z = pk2(st[n][1][0], st[n][1][1]); pw.w = pk2(st[n][1][2], st[n][1][3]);
            const bf16x8 pf = __builtin_bit_cast(bf16x8, pw);
            u16x4 v0[8], v1[8];
            asm volatile("ds_read_b64_tr_b16 %0, %16 offset:%32\n\tds_read_b64_tr_b16 %8, %24 offset:%32\n\t"
                         "ds_read_b64_tr_b16 %1, %17 offset:%32\n\tds_read_b64_tr_b16 %9, %25 offset:%32\n\t"
                         "ds_read_b64_tr_b16 %2, %18 offset:%32\n\tds_read_b64_tr_b16 %10, %26 offset:%32\n\t"
                         "ds_read_b64_tr_b16 %3, %19 offset:%32\n\tds_read_b64_tr_b16 %11, %27 offset:%32\n\t"
                         "ds_read_b64_tr_b16 %4, %20 offset:%32\n\tds_read_b64_tr_b16 %12, %28 offset:%32\n\t"
                         "ds_read_b64_tr_b16 %5, %21 offset:%32\n\tds_read_b64_tr_b16 %13, %29 offset:%32\n\t"
                         "ds_read_b64_tr_b16 %6, %22 offset:%32\n\tds_read_b64_tr_b16 %14, %30 offset:%32\n\t"
                         "ds_read_b64_tr_b16 %7, %23 offset:%32\n\tds_read_b64_tr_b16 %15, %31 offset:%32\n\t"
                         "s_waitcnt lgkmcnt(0)"
                         : "=&v"(v0[0]), "=&v"(v0[1]), "=&v"(v0[2]), "=&v"(v0[3]), "=&v"(v0[4]), "=&v"(v0[5]), "=&v"(v0[6]), "=&v"(v0[7]),
                           "=&v"(v1[0]), "=&v"(v1[1]), "=&v"(v1[2]), "=&v"(v1[3]), "=&v"(v1[4]), "=&v"(v1[5]), "=&v"(v1[6]), "=&v"(v1[7])
                         : "v"(va[0][0]), "v"(va[0][1]), "v"(va[0][2]), "v"(va[0][3]), "v"(va[0][4]), "v"(va[0][5]), "v"(va[0][6]), "v"(va[0][7]),
                           "v"(va[1][0]), "v"(va[1][1]), "v"(va[1][2]), "v"(va[1][3]), "v"(va[1][4]), "v"(va[1][5]), "v"(va[1][6]), "v"(va[1][7]), "i"(8192 * n) : "memory");
#pragma unroll
            for (int cc = 0; cc < 8; ++cc) {
                bf16x8 vf; vf[0] = (short)v0[cc][0]; vf[1] = (short)v0[cc][1]; vf[2] = (short)v0[cc][2]; vf[3] = (short)v0[cc][3]; vf[4] = (short)v1[cc][0]; vf[5] = (short)v1[cc][1]; vf[6] = (short)v1[cc][2]; vf[7] = (short)v1[cc][3];
                ot[cc] = __builtin_amdgcn_mfma_f32_16x16x32_bf16(vf, pf, ot[cc], 0, 0, 0);
            }
        }
        __syncthreads();
        asm volatile("" ::: "memory");
        if (has_next) ATT_DMA(UN, UN.vcol, sV);
        asm volatile("" ::: "memory");
        bf16_t* orow = c.proj + qtok * NP + U.qcol;
#pragma unroll
        for (int cc = 0; cc < 8; ++cc) { u32x2 o; o.x = pk2(ot[cc][0] * inv, ot[cc][1] * inv); o.y = pk2(ot[cc][2] * inv, ot[cc][3] * inv); *(u32x2*)(orow + 16 * cc + 4 * g) = o; }
        if (g == 0) lse_buf[qtok * 12 + U.p * 4 + U.h] = mx * 0.08838834764831845f + __logf(sum);
        ATT_STAMP(8);
        if (!has_next) break;
        U = UN; unxt = mbox[0];
    }
    asm volatile("s_waitcnt vmcnt(0)" ::: "memory");
    __syncthreads();
}
#undef ATT_STAMP
#undef ATT_DMA
#undef ATT_LOADQ

__device__ __forceinline__ void phase_attn_combine(const Ctx& c, const float* lse_buf) {
    const int gw = c.bid * NWAVES + c.wave, NGW = c.G * NWAVES, lane = c.lane;
    constexpr int NR = 2;
    for (int tok0 = gw; tok0 < TC; tok0 += NR * NGW) {
        unsigned u[NR][3][4]; float l[NR][12];
#pragma unroll
        for (int r = 0; r < NR; ++r) { const int tok = tok0 + r * NGW;
            const float* ls = lse_buf + (size_t)tok * 12; const bf16_t* row = c.proj + (size_t)tok * NP + C_QKV;
#pragma unroll
            for (int k = 0; k < 12; ++k) l[r][k] = ls[k];
#pragma unroll
            for (int p = 0; p < 3; ++p)
#pragma unroll
                for (int h = 0; h < 4; ++h) u[r][p][h] = *((const unsigned*)(row + (4 * p + h) * 128) + lane); }
#pragma unroll
        for (int r = 0; r < NR; ++r) { const int tok = tok0 + r * NGW;
#pragma unroll
            for (int h = 0; h < 4; ++h) {
                const float l0 = l[r][h], l1 = l[r][4 + h], l2 = l[r][8 + h], ml = fmaxf(l0, fmaxf(l1, l2));
                const float w0 = __expf(l0 - ml), w1 = __expf(l1 - ml), w2 = __expf(l2 - ml), wi = rcpf_(w0 + w1 + w2);
                *((unsigned*)(c.proj + (size_t)tok * NP + C_QKV + h * 128) + lane) =
                    pk2((w0 * bflo(u[r][0][h]) + w1 * bflo(u[r][1][h]) + w2 * bflo(u[r][2][h])) * wi, (w0 * bfhi(u[r][0][h]) + w1 * bfhi(u[r][1][h]) + w2 * bfhi(u[r][2][h])) * wi);
            } }
    }
}

__device__ __forceinline__ int crow(int reg, int hh) { return (reg & 3) + 8 * (reg >> 2) + 4 * hh; }
typedef float f32x16 __attribute__((ext_vector_type(16)));
__device__ __forceinline__ unsigned tr_addr32(unsigned lane, unsigned rowbase, unsigned cblk, unsigned t, bool perm) {
    const unsigned hh = lane >> 5, blk = (lane >> 4) & 1u, q = (lane & 15u) >> 2, p = lane & 3u;
    const unsigned row = rowbase + (perm ? 8u * t + 4u * hh : 8u * hh + 4u * t) + q;
    return offb(row, 4u * cblk + 2u * blk + (p >> 1)) + 8u * (p & 1u);
}
__device__ __forceinline__ bf16x8 tr_frag(unsigned a0, unsigned a1) {
    u16x4 v0, v1;
    asm volatile("ds_read_b64_tr_b16 %0, %2\n\tds_read_b64_tr_b16 %1, %3\n\ts_waitcnt lgkmcnt(0)" : "=&v"(v0), "=&v"(v1) : "v"(a0), "v"(a1) : "memory");
    bf16x8 f; f[0] = (short)v0[0]; f[1] = (short)v0[1]; f[2] = (short)v0[2]; f[3] = (short)v0[3]; f[4] = (short)v1[0]; f[5] = (short)v1[1]; f[6] = (short)v1[2]; f[7] = (short)v1[3];
    return f;
}
__device__ __forceinline__ void tr_frag4(const unsigned (&a)[8], bf16x8 (&f)[4]) {
    u16x4 v[8];
    asm volatile("ds_read_b64_tr_b16 %0, %8\n\tds_read_b64_tr_b16 %1, %9\n\tds_read_b64_tr_b16 %2, %10\n\tds_read_b64_tr_b16 %3, %11\n\t"
                 "ds_read_b64_tr_b16 %4, %12\n\tds_read_b64_tr_b16 %5, %13\n\tds_read_b64_tr_b16 %6, %14\n\tds_read_b64_tr_b16 %7, %15\n\ts_waitcnt lgkmcnt(0)"
                 : "=&v"(v[0]), "=&v"(v[1]), "=&v"(v[2]), "=&v"(v[3]), "=&v"(v[4]), "=&v"(v[5]), "=&v"(v[6]), "=&v"(v[7])
                 : "v"(a[0]), "v"(a[1]), "v"(a[2]), "v"(a[3]), "v"(a[4]), "v"(a[5]), "v"(a[6]), "v"(a[7]) : "memory");
#pragma unroll
    for (int k = 0; k < 4; ++k) { f[k][0] = (short)v[2 * k][0]; f[k][1] = (short)v[2 * k][1]; f[k][2] = (short)v[2 * k][2]; f[k][3] = (short)v[2 * k][3];
        f[k][4] = (short)v[2 * k + 1][0]; f[k][5] = (short)v[2 * k + 1][1]; f[k][6] = (short)v[2 * k + 1][2]; f[k][7] = (short)v[2 * k + 1][3]; }
}
constexpr int GLA_QK = 0, GLA_KD = 16384, GLA_V = 32768  , GLA_ST = 65536  , GLA_O = 102400  , GLA_SEG = 136192  , GLA_DEC = 138240  ;
static_assert(GLA_DEC + 256 <= RING_BYTES, "gla lds");
__device__ __forceinline__ void gla_unit(const Ctx& c, int unit, const float* gbias, const float* ogain) {
    const int tid = c.tid, lane = c.lane, w = c.wave;
    const int b = unit >> 2, h = unit & 3;
    LAS unsigned char* L = c.lds;
    const unsigned hh = lane >> 5, r31 = lane & 31;
    const int ti = w >> 2, tv = w & 3;
    f32x16 St;
#pragma unroll
    for (int i = 0; i < 16; ++i) St[i] = 0.f;
    for (int i = tid; i < 18432 / 4; i += NTHR) ((LAS unsigned*)(L + GLA_ST))[i] = 0u;
    const float bias_d = gbias[h * 64 + lane];
    const int i3 = tid >> 3, seg = tid & 7;
    float gn[16];
#pragma unroll
    for (int k = 0; k < 16; ++k) gn[k] = ogain[16 * seg + k];
    const size_t tokb = (size_t)b * SEQ;
    unsigned short pq[8], pk[8], pg[8];
    u32x4 ogc0, ogc1, ogn0, ogn1;
#define GLA_PREFETCH(n) do { _Pragma("unroll") for (int rr = 0; rr < 8; ++rr) { const bf16_t* row = c.proj + (tokb + (n) * 64 + 8 * w + rr) * NP + h * 64 + lane; \
        pq[rr] = row[C_QA]; pk[rr] = row[C_KA]; pg[rr] = row[C_GP]; } } while (0)
#define GLA_OG(n, d0, d1) do { const bf16_t* ogp = c.proj + (tokb + (n) * 64 + i3) * NP + C_OG + h * 128 + 16 * seg; d0 = *(const u32x4*)ogp; d1 = *((const u32x4*)ogp + 1); } while (0)
#define GLA_VDMA(n) do { _Pragma("unroll") for (int it = 0; it < 2; ++it) { const int q = w + 8 * it; const unsigned nn = 64u * q + lane, row = nn >> 4, cs = nn & 15u, ch = cs ^ (((row & 3u) << 2) | ((row >> 2) & 3u)); \
        __builtin_amdgcn_global_load_lds((const unsigned*)(c.proj + (tokb + (n) * 64 + row) * NP + C_VA + h * 128 + ch * 8), (LAS unsigned*)(L + GLA_V + ((n) & 1) * 16384 + 1024 * q), 16, 0, 0); } } while (0)
#define CB() asm volatile("" ::: "memory")
    GLA_PREFETCH(0); CB(); GLA_OG(0, ogc0, ogc1); CB(); GLA_VDMA(0); CB(); GLA_VDMA(1); CB();
    for (int n = 0; n < SEQ / 64; ++n) {
        LAS unsigned char* STr = L + GLA_ST + (n & 1) * 18432; LAS unsigned char* STw = L + GLA_ST + ((n + 1) & 1) * 18432;
        LAS unsigned char* Vb = L + GLA_V + (n & 1) * 16384;
        float cl[8], qv[8], kv[8];
        { float run = 0.f;
#pragma unroll
          for (int rr = 0; rr < 8; ++rr) { const float g = bf2f(pg[rr]) + bias_d; run += (fminf(g, 0.f) - __logf(1.f + __expf(-fabsf(g)))) * (1.f / 16.f); cl[rr] = run; qv[rr] = bf2f(pq[rr]); kv[rr] = bf2f(pk[rr]); }
          ((LAS float*)(L + GLA_SEG))[w * 64 + lane] = run; }
        __syncthreads();
        { float pre = 0.f, tot = 0.f;
#pragma unroll
          for (int s = 0; s < 8; ++s) { const float v = ((LAS float*)(L + GLA_SEG))[s * 64 + lane]; tot += v; pre += (s < w) ? v : 0.f; }
          const float etot = __expf(tot);
          if (w == 0) ((LAS float*)(L + GLA_DEC))[lane] = etot;
#pragma unroll
          for (int rr = 0; rr < 8; ++rr) { const float cum = pre + cl[rr]; const unsigned row = 8 * w + rr;
              const float e = __expf(cum), ei = rcpf_(e), ed = etot * ei;
              const unsigned o1 = offb(row, lane >> 3) + (lane & 7) * 2, o2 = offb(row, 8 + (lane >> 3)) + (lane & 7) * 2;
              *(LAS unsigned short*)(L + GLA_QK + o1) = (unsigned short)f2bf(qv[rr] * e);
              *(LAS unsigned short*)(L + GLA_QK + o2) = (unsigned short)f2bf(kv[rr] * ei);
              *(LAS unsigned short*)(L + GLA_KD + o1) = (unsigned short)f2bf(kv[rr] * ed); } }
        if (n == 0) asm volatile("s_waitcnt vmcnt(2)" ::: "memory"); else asm volatile("s_waitcnt vmcnt(4)" ::: "memory");
        __syncthreads();
        CB();
        if (n + 1 < SEQ / 64) { GLA_OG(n + 1, ogn0, ogn1); CB(); GLA_PREFETCH(n + 1); }
        CB();
        bf16x8 qdf[4];
#pragma unroll
        for (int s = 0; s < 4; ++s) qdf[s] = *(const LAS bf16x8*)(L + GLA_QK + offb(32 * ti + r31, 2 * s + hh));
        f32x16 Z;
#pragma unroll
        for (int i = 0; i < 16; ++i) Z[i] = 0.f;
        { bf16x8 sf[4];
#pragma unroll
          for (int s = 0; s < 4; ++s) sf[s] = *(const LAS bf16x8*)(STr + (32 * tv + r31) * 144 + 32 * s + 16 * hh);
#pragma unroll
          for (int s = 0; s < 4; ++s) Z = __builtin_amdgcn_mfma_f32_32x32x16_bf16(qdf[s], sf[s], Z, 0, 0, 0); }
        const unsigned vb = (unsigned)(size_t)Vb;
#pragma unroll
        for (int tj = 0; tj < 2; ++tj) {
            if (tj <= ti) {
                bf16x8 kf[4];
#pragma unroll
                for (int s = 0; s < 4; ++s) kf[s] = *(const LAS bf16x8*)(L + GLA_QK + offb(32 * tj + r31, 8 + 2 * s + hh));
                unsigned va[8]; bf16x8 vf[4];
#pragma unroll
                for (int s = 0; s < 2; ++s) { va[2 * s] = vb + tr_addr32(lane, 32 * tj + 16 * s, tv, 0, true); va[2 * s + 1] = vb + tr_addr32(lane, 32 * tj + 16 * s, tv, 1, true);
                    va[4 + 2 * s] = va[2 * s]; va[5 + 2 * s] = va[2 * s + 1]; }
                tr_frag4(va, vf);
                f32x16 X;
#pragma unroll
                for (int i = 0; i < 16; ++i) X[i] = 0.f;
#pragma unroll
                for (int s = 0; s < 4; ++s) X = __builtin_amdgcn_mfma_f32_32x32x16_bf16(kf[s], qdf[s], X, 0, 0, 0);
                const int ig = 32 * ti + (int)r31;
#pragma unroll
                for (int i = 0; i < 16; ++i) X[i] = (ig >= 32 * tj + crow(i, hh)) ? X[i] : 0.f;
#pragma unroll
                for (int s = 0; s < 2; ++s) {
                    u32x4 pw; pw.x = pg8::cvt_pk_bf16(X[8 * s + 0], X[8 * s + 1]); pw.y = pg8::cvt_pk_bf16(X[8 * s + 2], X[8 * s + 3]); pw.z = pg8::cvt_pk_bf16(X[8 * s + 4], X[8 * s + 5]); pw.w = pg8::cvt_pk_bf16(X[8 * s + 6], X[8 * s + 7]);
                    Z = __builtin_amdgcn_mfma_f32_32x32x16_bf16(__builtin_bit_cast(bf16x8, pw), vf[s], Z, 0, 0, 0);
                }
            }
        }
#pragma unroll
        for (int i = 0; i < 16; ++i) ((LAS float*)(L + GLA_O))[(32 * ti + crow(i, hh)) * 132 + 32 * tv + r31] = Z[i];
        { const unsigned kb = (unsigned)(size_t)(L + GLA_KD);
          unsigned aa[8], ab[8]; bf16x8 af[4], bfr[4];
#pragma unroll
          for (int s = 0; s < 4; ++s) { aa[2 * s] = kb + tr_addr32(lane, 16 * s, ti, 0, false); aa[2 * s + 1] = kb + tr_addr32(lane, 16 * s, ti, 1, false);
              ab[2 * s] = vb + tr_addr32(lane, 16 * s, tv, 0, false); ab[2 * s + 1] = vb + tr_addr32(lane, 16 * s, tv, 1, false); }
          tr_frag4(aa, af); tr_frag4(ab, bfr);
#pragma unroll
          for (int i = 0; i < 16; ++i) St[i] *= ((LAS float*)(L + GLA_DEC))[32 * ti + crow(i, hh)];
#pragma unroll
          for (int s = 0; s < 4; ++s) St = __builtin_amdgcn_mfma_f32_32x32x16_bf16(af[s], bfr[s], St, 0, 0, 0); }
#pragma unroll
        for (int gq = 0; gq < 4; ++gq) { const float s0 = St[4 * gq], s1 = St[4 * gq + 1], s2 = St[4 * gq + 2], s3 = St[4 * gq + 3];
            u32x2 o; o.x = pk2(s0, s1); o.y = pk2(s2, s3);
            *(LAS u32x2*)(STw + (32 * tv + r31) * 144 + (32 * ti + 8 * gq + 4 * hh) * 2) = o; }
        __syncthreads();
        CB();
        if (n + 2 < SEQ / 64) GLA_VDMA(n + 2);
        CB();
        { const LAS f32x4* op = (const LAS f32x4*)(L + GLA_O + i3 * 528 + seg * 64);
          f32x4 o4[4]; float ss = 0.f;
#pragma unroll
          for (int k = 0; k < 4; ++k) { o4[k] = op[k]; ss += (o4[k].x * o4[k].x + o4[k].y * o4[k].y) + (o4[k].z * o4[k].z + o4[k].w * o4[k].w); }
          ss += swz_xor<1>(ss); ss += swz_xor<2>(ss); ss += swz_xor<4>(ss);
          const float rs = rsqf_(ss * (1.f / 128.f) + RMS_EPS);
          const unsigned ogw[8] = {ogc0.x, ogc0.y, ogc0.z, ogc0.w, ogc1.x, ogc1.y, ogc1.z, ogc1.w};
          unsigned ow[8];
#pragma unroll
          for (int k = 0; k < 8; ++k) { const float g0 = bflo(ogw[k]), g1 = bfhi(ogw[k]);
              const float a0 = o4[k >> 1][(2 * k) & 3] * rs * gn[2 * k] * g0 * sigmoidf_(g0), a1 = o4[k >> 1][(2 * k + 1) & 3] * rs * gn[2 * k + 1] * g1 * sigmoidf_(g1);
              ow[k] = pk2(a0, a1); }
          u32x4 w0, w1; w0.x = ow[0]; w0.y = ow[1]; w0.z = ow[2]; w0.w = ow[3]; w1.x = ow[4]; w1.y = ow[5]; w1.z = ow[6]; w1.w = ow[7];
          bf16_t* dst = c.proj + (tokb + n * 64 + i3) * NP + C_OG + h * 128 + 16 * seg;
          *(u32x4*)dst = w0; *((u32x4*)dst + 1) = w1; }
        CB();
        ogc0 = ogn0; ogc1 = ogn1;
    }
    asm volatile("s_waitcnt vmcnt(0)" ::: "memory");
    __syncthreads();
#undef GLA_PREFETCH
#undef GLA_OG
#undef GLA_VDMA
#undef CB
}

constexpr int LRU_X = 0  , LRU_R = 16384  , LRU_I = 32768, LRU_SP = 49152  , LRU_SH = 51200;
__device__ __forceinline__ void lru_unit(const Ctx& c, int unit, const float* convw, const float* convb, const float* wa_, const float* ba_, const float* wx_, const float* bx_, const float* lam_) {
    const int lane = c.lane, w = c.wave;
    const int b = unit >> 3, nb = unit & 7, ch = nb * 64 + lane;
    LAS unsigned char* L = c.lds;
    const unsigned hh = lane >> 5, r31 = lane & 31;
    const int gate = w >> 2, tt = (w >> 1) & 1, td = w & 1;
    bf16x8 wf[4];
    { const float* W = (gate ? wx_ : wa_) + (size_t)nb * 4096 + 32 * td + r31;
#pragma unroll
      for (int s = 0; s < 4; ++s) { float t8[8];
#pragma unroll
          for (int jj = 0; jj < 8; ++jj) t8[jj] = W[(16 * s + 8 * hh + jj) * 64];
          u32x4 pw; pw.x = pk2(t8[0], t8[1]); pw.y = pk2(t8[2], t8[3]); pw.z = pk2(t8[4], t8[5]); pw.w = pk2(t8[6], t8[7]); wf[s] = __builtin_bit_cast(bf16x8, pw); } }
    const float gbias = (gate ? bx_ : ba_)[nb * 64 + 32 * td + r31];
    const float cw0 = convw[ch], cw1 = convw[512 + ch], cw2 = convw[1024 + ch], cw3 = convw[1536 + ch], cb = convb[ch];
    const float lam = lam_[ch]; const float c8 = 8.f * (fmaxf(-lam, 0.f) + log1pf(__expf(-fabsf(lam))));
    const size_t tokb = (size_t)b * SEQ;
    unsigned short px[11], py[8];
#define LRU_PREFETCH(n) do { _Pragma("unroll") for (int rr = 0; rr < 11; ++rr) { const int t = (n) * 64 + 8 * w + rr - 3; px[rr] = t >= 0 ? c.proj[(tokb + t) * NP + C_XB + ch] : (unsigned short)0; } \
        _Pragma("unroll") for (int rr = 0; rr < 8; ++rr) py[rr] = c.proj[(tokb + (n) * 64 + 8 * w + rr) * NP + C_YB + ch]; } while (0)
    LRU_PREFETCH(0);
    float hcarry = 0.f;
    for (int n = 0; n < SEQ / 64; ++n) {
        float xc[8], yv[8];
        { float xr[11];
#pragma unroll
          for (int rr = 0; rr < 11; ++rr) xr[rr] = bf2f(px[rr]);
#pragma unroll
          for (int rr = 0; rr < 8; ++rr) { xc[rr] = cb + cw0 * xr[rr] + cw1 * xr[rr + 1] + cw2 * xr[rr + 2] + cw3 * xr[rr + 3]; yv[rr] = bf2f(py[rr]);
              *(LAS unsigned short*)(L + LRU_X + offb(8 * w + rr, lane >> 3) + (lane & 7) * 2) = (unsigned short)f2bf(xc[rr]); } }
        __syncthreads();
        if (n + 1 < SEQ / 64) LRU_PREFETCH(n + 1);
        { f32x16 Z;
#pragma unroll
          for (int i = 0; i < 16; ++i) Z[i] = 0.f;
#pragma unroll
          for (int s = 0; s < 4; ++s) { const bf16x8 af = *(const LAS bf16x8*)(L + LRU_X + offb(32 * tt + r31, 2 * s + hh)); Z = __builtin_amdgcn_mfma_f32_32x32x16_bf16(af, wf[s], Z, 0, 0, 0); }
          LAS float* dst = (LAS float*)(L + (gate ? LRU_I : LRU_R));
#pragma unroll
          for (int i = 0; i < 16; ++i) dst[(32 * tt + crow(i, hh)) * 64 + 32 * td + r31] = sigmoidf_(Z[i] + gbias); }
        __syncthreads();
        float hl[8], pc[8];
        { float hrun = 0.f, prun = 1.f;
#pragma unroll
          for (int rr = 0; rr < 8; ++rr) { const float r = ((const LAS float*)(L + LRU_R))[(8 * w + rr) * 64 + lane], ig = ((const LAS float*)(L + LRU_I))[(8 * w + rr) * 64 + lane];
              const float a = __expf(-c8 * r), u = __builtin_amdgcn_sqrtf(fmaxf(1.f - a * a, 0.f)) * ig * xc[rr];
              hrun = a * hrun + u; prun *= a; hl[rr] = hrun; pc[rr] = prun; }
          ((LAS float*)(L + LRU_SP))[w * 64 + lane] = prun; ((LAS float*)(L + LRU_SH))[w * 64 + lane] = hrun; }
        __syncthreads();
        { float hin = hcarry, hall = hcarry;
#pragma unroll
          for (int s = 0; s < 8; ++s) { const float P = ((const LAS float*)(L + LRU_SP))[s * 64 + lane], H = ((const LAS float*)(L + LRU_SH))[s * 64 + lane];
              hall = P * hall + H; hin = (s < w) ? hall : hin; }
          hcarry = hall;
#pragma unroll
          for (int rr = 0; rr < 8; ++rr) { const float hv = hl[rr] + pc[rr] * hin;
              c.proj[(tokb + n * 64 + 8 * w + rr) * NP + C_YB + ch] = (bf16_t)f2bf(hv * gelu_tanh(yv[rr])); } }
    }
    __syncthreads();
#undef LRU_PREFETCH
}

constexpr int TPB = TT / 256;
constexpr int RW_STRIDE = 1032;
__device__ __forceinline__ void phase_router(const Ctx& c, const float* gain, const float* rw, const float* rb, unsigned* gcnt) {
    LAS bf16_t* sWh = (LAS bf16_t*)c.lds;
    LAS bf16_t* sWl = sWh + 16 * RW_STRIDE;
    LAS float* sGn = (LAS float*)(c.lds + 69632);
    LAS unsigned* sRec = (LAS unsigned*)(c.lds + 73728);
    LAS unsigned* sCnt = (LAS unsigned*)(c.lds + MISC_OFF + 256);
    LAS unsigned* sBase = sCnt + 16;
    const int tid = c.tid, lane = c.lane, w = c.wave;
    for (int idx = tid; idx < D * NE; idx += NTHR) { const int e = idx >> 10, k = idx & 1023; const float v = rw[k * 16 + e] * gain[k];
        const unsigned hi = f2bf(v); const float lo = v - bflo(hi); sWh[e * RW_STRIDE + k] = (bf16_t)hi; sWl[e * RW_STRIDE + k] = (bf16_t)f2bf(lo); }
    for (int idx = tid; idx < D; idx += NTHR) sGn[idx] = gain[idx];
    if (tid < 16) sCnt[tid] = 0u;
    __syncthreads();
    const int t = lane & 15, g = lane >> 4;
#pragma unroll 1
    for (int sub = 0; sub < TPB / 128; ++sub) {
    const int lt = sub * 128 + w * 16 + t, tok = c.bid * TPB + lt;
    const bf16_t* xrow = c.xb + (size_t)tok * D + 8 * g; signed char* hrow = (signed char*)c.actf + (size_t)tok * D + 8 * g;
    f32x4 acc = {0.f, 0.f, 0.f, 0.f}; float ss = 0.f, am = 0.f;
    u32x4 xn[4];
#pragma unroll
    for (int j = 0; j < 4; ++j) xn[j] = *(const u32x4*)(xrow + 32 * j);
#pragma unroll 1
    for (int s4 = 0; s4 < 8; ++s4) {
        u32x4 xc[4];
#pragma unroll
        for (int j = 0; j < 4; ++j) xc[j] = xn[j];
        if (s4 + 1 < 8) {
#pragma unroll
            for (int j = 0; j < 4; ++j) xn[j] = *(const u32x4*)(xrow + 32 * (4 * s4 + 4 + j)); }
#pragma unroll
        for (int j = 0; j < 4; ++j) { const int s = 4 * s4 + j;
            const unsigned xw[4] = {xc[j].x, xc[j].y, xc[j].z, xc[j].w};
            float xv[8];
#pragma unroll
            for (int k = 0; k < 4; ++k) { xv[2 * k] = bflo(xw[k]); xv[2 * k + 1] = bfhi(xw[k]); }
            { const f32x4 q0 = *(const LAS f32x4*)(sGn + 32 * s + 8 * g), q1 = *(const LAS f32x4*)(sGn + 32 * s + 8 * g + 4);
              am = fmaxf(am, fmaxf(fmaxf(fmaxf(fabsf(xv[0] * q0.x), fabsf(xv[1] * q0.y)), fmaxf(fabsf(xv[2] * q0.z), fabsf(xv[3] * q0.w))), fmaxf(fmaxf(fabsf(xv[4] * q1.x), fabsf(xv[5] * q1.y)), fmaxf(fabsf(xv[6] * q1.z), fabsf(xv[7] * q1.w))))); }
            const bf16x8 bh = __builtin_bit_cast(bf16x8, xc[j]);
#pragma unroll
            for (int k = 0; k < 8; ++k) ss += xv[k] * xv[k];
            const bf16x8 ah = *(const LAS bf16x8*)(sWh + t * RW_STRIDE + 32 * s + 8 * g), al = *(const LAS bf16x8*)(sWl + t * RW_STRIDE + 32 * s + 8 * g);
            acc = __builtin_amdgcn_mfma_f32_16x16x32_bf16(ah, bh, acc, 0, 0, 0);
            acc = __builtin_amdgcn_mfma_f32_16x16x32_bf16(al, bh, acc, 0, 0, 0); }
    }
    ss += swz_xor<16>(ss);
    { const auto r = __builtin_amdgcn_permlane32_swap(__float_as_uint(ss), __float_as_uint(ss), false, false); ss = __uint_as_float(r[0]) + __uint_as_float(r[1]); }
    const float rs = rsqf_(ss * (1.f / D) + RMS_EPS);
    am = fmaxf(am, swz_xor<16>(am));
    { const auto r = __builtin_amdgcn_permlane32_swap(__float_as_uint(am), __float_as_uint(am), false, false); am = fmaxf(__uint_as_float(r[0]), __uint_as_float(r[1])); }
    const float qinv = am > 0.f ? 127.f / am : 0.f, qs = am * (1.f / 127.f);
    float sc[4]; float mx = -INFINITY;
#pragma unroll
    for (int i = 0; i < 4; ++i) { sc[i] = acc[i] * rs + rb[4 * g + i]; mx = fmaxf(mx, sc[i]); }
    mx = fmaxf(mx, swz_xor<16>(mx));
    { const auto r = __builtin_amdgcn_permlane32_swap(__float_as_uint(mx), __float_as_uint(mx), false, false); mx = fmaxf(__uint_as_float(r[0]), __uint_as_float(r[1])); }
    float sum = 0.f;
#pragma unroll
    for (int i = 0; i < 4; ++i) { sc[i] = __expf(sc[i] - mx); sum += sc[i]; }
    sum += swz_xor<16>(sum);
    { const auto r = __builtin_amdgcn_permlane32_swap(__float_as_uint(sum), __float_as_uint(sum), false, false); sum = __uint_as_float(r[0]) + __uint_as_float(r[1]); }
    const float isum = rcpf_(sum);
#pragma unroll
    for (int i = 0; i < 4; ++i) sc[i] *= isum;
    float gs;
    { const float hi1 = fmaxf(sc[0], sc[1]), lo1 = fminf(sc[0], sc[1]), hi2 = fmaxf(sc[2], sc[3]), lo2 = fminf(sc[2], sc[3]);
      gs = fmaxf(hi1, hi2) + fmaxf(fminf(hi1, hi2), fmaxf(lo1, lo2)); }
    const float g1 = swz_xor<16>(gs);
    float g2, g3;
    { const auto r = __builtin_amdgcn_permlane32_swap(__float_as_uint(gs), __float_as_uint(gs), false, false); g2 = (g & 2) ? __uint_as_float(r[0]) : __uint_as_float(r[1]); }
    { const auto r = __builtin_amdgcn_permlane32_swap(__float_as_uint(g1), __float_as_uint(g1), false, false); g3 = (g & 2) ? __uint_as_float(r[0]) : __uint_as_float(r[1]); }
    const bool win = ((gs > g1) || (gs == g1 && g < (g ^ 1))) && ((gs > g2) || (gs == g2 && g < (g ^ 2))) && ((gs > g3) || (gs == g3 && g < (g ^ 3)));
    if (win) {
        int i0 = 0; float b0 = sc[0];
#pragma unroll
        for (int k = 1; k < 4; ++k) if (sc[k] > b0) { b0 = sc[k]; i0 = k; }
        int i1 = -1; float b1 = -1.f;
#pragma unroll
        for (int k = 0; k < 4; ++k) if (k != i0 && sc[k] > b1) { b1 = sc[k]; i1 = k; }
        const int e0 = 4 * g + i0, e1 = 4 * g + i1; const float wn = rcpf_(b0 + b1);
        const unsigned l0 = atomicAdd((unsigned*)&sCnt[e0], 1u), l1 = atomicAdd((unsigned*)&sCnt[e1], 1u);
        sRec[lt * 8 + 0] = (unsigned)e0; sRec[lt * 8 + 1] = l0; sRec[lt * 8 + 2] = (unsigned)e1; sRec[lt * 8 + 3] = l1; sRec[lt * 8 + 4] = __float_as_uint(b0 * wn); sRec[lt * 8 + 5] = __float_as_uint(b1 * wn); sRec[lt * 8 + 6] = __float_as_uint(rs * qs);
    }
#pragma unroll 1
    for (int s4 = 0; s4 < 8; ++s4) { u32x4 xx[4];
#pragma unroll
        for (int j = 0; j < 4; ++j) xx[j] = *(const u32x4*)(xrow + 32 * (4 * s4 + j));
#pragma unroll
        for (int j = 0; j < 4; ++j) { const int s = 4 * s4 + j; const unsigned xw[4] = {xx[j].x, xx[j].y, xx[j].z, xx[j].w};
            const f32x4 q0 = *(const LAS f32x4*)(sGn + 32 * s + 8 * g), q1 = *(const LAS f32x4*)(sGn + 32 * s + 8 * g + 4);
            const int i0 = (int)__builtin_rintf(bflo(xw[0]) * q0.x * qinv), i1 = (int)__builtin_rintf(bfhi(xw[0]) * q0.y * qinv), i2 = (int)__builtin_rintf(bflo(xw[1]) * q0.z * qinv), i3 = (int)__builtin_rintf(bfhi(xw[1]) * q0.w * qinv);
            const int i4 = (int)__builtin_rintf(bflo(xw[2]) * q1.x * qinv), i5 = (int)__builtin_rintf(bfhi(xw[2]) * q1.y * qinv), i6 = (int)__builtin_rintf(bflo(xw[3]) * q1.z * qinv), i7 = (int)__builtin_rintf(bfhi(xw[3]) * q1.w * qinv);
            u32x2 o; o.x = (unsigned)(i0 & 0xff) | ((unsigned)(i1 & 0xff) << 8) | ((unsigned)(i2 & 0xff) << 16) | ((unsigned)(i3 & 0xff) << 24);
            o.y = (unsigned)(i4 & 0xff) | ((unsigned)(i5 & 0xff) << 8) | ((unsigned)(i6 & 0xff) << 16) | ((unsigned)(i7 & 0xff) << 24);
            *(u32x2*)(hrow + 32 * s) = o; } }
    }
    __syncthreads();
    if (tid < 16) sBase[tid] = __hip_atomic_fetch_add(gcnt + tid, sCnt[tid], __ATOMIC_RELAXED, __HIP_MEMORY_SCOPE_AGENT);
    __syncthreads();
    if (tid < TPB) { const int tk = c.bid * TPB + tid; const unsigned e0 = sRec[tid * 8], e1 = sRec[tid * 8 + 2];
        const unsigned p0 = sBase[e0] + sRec[tid * 8 + 1], p1 = sBase[e1] + sRec[tid * 8 + 3];
        u32x4 r; r.x = (e0 << 20) | p0; r.y = (e1 << 20) | p1; r.z = sRec[tid * 8 + 4]; r.w = sRec[tid * 8 + 5];
        *(u32x4*)(c.rec + (size_t)tk * 4) = r;
        const float rsv = __uint_as_float(sRec[tid * 8 + 6]);
        c.list[(size_t)e0 * TT + p0] = tk; c.list[(size_t)e1 * TT + p1] = tk; c.rsl[(size_t)e0 * TT + p0] = rsv; c.rsl[(size_t)e1 * TT + p1] = rsv; }
}

struct PlainOrder {
    int nM, nN, G, c; const char* A; const char* Bt; size_t a_tile, b_tile; int r0, r1;
    __device__ __forceinline__ bool next(int i, pg8::Unit& u) const { u.g = 0; if (r0 + i >= r1) return false; return pg8::static_tile(nM, nN, G, c, r0 + i, u.pm, u.pn); }
    __device__ __forceinline__ const char* aptr(const pg8::Unit& u) const { return A + (size_t)u.pm * a_tile; }
    __device__ __forceinline__ const char* bptr(const pg8::Unit& u) const { return Bt + (size_t)u.pn * b_tile; }
    __device__ __forceinline__ unsigned arow(const pg8::Unit&, int) const { return 0u; }
};
struct MergeOrder {
    int G, c; const char* proj; const char* wbr;
    __device__ __forceinline__ bool next(int i, pg8::Unit& u) const { u.g = i % 3; return pg8::static_tile(TC / 256, 4, G, c, i / 3, u.pm, u.pn); }
    __device__ __forceinline__ const char* aptr(const pg8::Unit& u) const { const int col = u.g == 0 ? C_OG : (u.g == 1 ? C_YB : C_QKV); return proj + ((size_t)u.pm * 256 * NP + col) * 2; }
    __device__ __forceinline__ const char* bptr(const pg8::Unit& u) const { return wbr + ((size_t)u.g * D * 512 + (size_t)u.pn * 256 * 512) * 2; }
    __device__ __forceinline__ unsigned arow(const pg8::Unit&, int) const { return 0u; }
};
template <bool UP> struct MoeOrder {
    int G, c; LAS const int* pt; LAS const int* lc; const char* A; const char* W; const int* list;
    __device__ __forceinline__ bool next(int i, pg8::Unit& u) const { const int x = c & 7, j = c >> 3, tau = (G >> 2) * i + 8 * x + (j >> 2); if (tau >= pt[NE]) return false;
        int e = 0;
#pragma unroll
        for (int k = 1; k < NE; ++k) e += (tau >= pt[k]) ? 1 : 0;
        u.pm = tau; u.pn = j & 3; u.g = e; return true; }
    __device__ __forceinline__ const char* aptr(const pg8::Unit& u) const { return UP ? A : A + (size_t)u.pm * 256 * FF * 2; }
    __device__ __forceinline__ const char* bptr(const pg8::Unit& u) const { return UP ? W + ((size_t)u.g * 1024 + (size_t)u.pn * 256) * D : W + ((size_t)u.g * D + (size_t)u.pn * 256) * FF * 2; }
    __device__ __forceinline__ unsigned arow(const pg8::Unit& u, int r) const { int p = (u.pm - pt[u.g]) * 256 + r; const int n = lc[u.g]; p = p < n ? p : n - 1;
        return (unsigned)list[(size_t)u.g * TT + p] * (unsigned)D; }
};

struct EpiStoreBf16 {
    static constexpr bool PERM = true;
    bf16_t* O; int ldc;
    __device__ __forceinline__ void operator()(const f32x4 (&acc)[2][2][4][2], const pg8::Unit& u, int wr, int wc, int fr, int fq) const {
        const int row0 = u.pm * 256 + wr * 64 + fr, col0 = u.pn * 256 + wc * 32 + 8 * fq;
#pragma unroll
        for (int ai = 0; ai < 2; ++ai)
#pragma unroll
            for (int m = 0; m < 4; ++m) { bf16_t* rowp = O + (size_t)(row0 + ai * 128 + m * 16) * ldc + col0;
#pragma unroll
                for (int bj = 0; bj < 2; ++bj) { const f32x4 v0 = acc[ai][bj][m][0], v1 = acc[ai][bj][m][1];
                    u32x4 w; w.x = pg8::cvt_pk_bf16(v0[0], v0[1]); w.y = pg8::cvt_pk_bf16(v0[2], v0[3]); w.z = pg8::cvt_pk_bf16(v1[0], v1[1]); w.w = pg8::cvt_pk_bf16(v1[2], v1[3]);
                    __builtin_nontemporal_store(w, (u32x4*)(rowp + bj * 128)); } }
    }
};
struct EpiProj {
    static constexpr bool PERM = true;
    bf16_t* O; const float* sa  ; const unsigned* cmax  ;
    __device__ __forceinline__ void operator()(const i32x4 (&acc)[2][2][4][2], const pg8::Unit& u, int wr, int wc, int fr, int fq) const {
        const int row0 = u.pm * 256 + wr * 64 + fr, col0 = u.pn * 256 + wc * 32 + 8 * fq;
        f32x4 sb0[2], sb1[2];
#pragma unroll
        for (int bj = 0; bj < 2; ++bj) { const u32x4 m0 = *(const u32x4*)(cmax + col0 + bj * 128), m1 = *(const u32x4*)(cmax + col0 + bj * 128 + 4); const float k = 1.f / 127.f;
            sb0[bj] = (f32x4){__uint_as_float(m0.x) * k, __uint_as_float(m0.y) * k, __uint_as_float(m0.z) * k, __uint_as_float(m0.w) * k};
            sb1[bj] = (f32x4){__uint_as_float(m1.x) * k, __uint_as_float(m1.y) * k, __uint_as_float(m1.z) * k, __uint_as_float(m1.w) * k}; }
        float sar[2][4];
#pragma unroll
        for (int ai = 0; ai < 2; ++ai)
#pragma unroll
            for (int m = 0; m < 4; ++m) sar[ai][m] = sa[row0 + ai * 128 + m * 16];
        if (u.pn * 256 >= C_G) {
#pragma unroll
            for (int ai = 0; ai < 2; ++ai)
#pragma unroll
                for (int m = 0; m < 4; ++m) { unsigned char* rowp = (unsigned char*)(O + (size_t)(row0 + ai * 128 + m * 16) * NP + C_G) + (col0 - C_G);
#pragma unroll
                    for (int bj = 0; bj < 2; ++bj) { const i32x4 a0 = acc[ai][bj][m][0], a1 = acc[ai][bj][m][1]; const f32x4 s0 = sb0[bj] * sar[ai][m], s1 = sb1[bj] * sar[ai][m];
                        unsigned q[8];
#pragma unroll
                        for (int k = 0; k < 4; ++k) { q[k] = (unsigned)(sigmoidf_((float)a0[k] * s0[k]) * 255.f + 0.5f); q[4 + k] = (unsigned)(sigmoidf_((float)a1[k] * s1[k]) * 255.f + 0.5f); }
                        u32x2 w; w.x = q[0] | (q[1] << 8) | (q[2] << 16) | (q[3] << 24); w.y = q[4] | (q[5] << 8) | (q[6] << 16) | (q[7] << 24);
                        __builtin_nontemporal_store(w, (u32x2*)(rowp + bj * 128)); } }
        } else {
#pragma unroll
            for (int ai = 0; ai < 2; ++ai)
#pragma unroll
                for (int m = 0; m < 4; ++m) { bf16_t* rowp = O + (size_t)(row0 + ai * 128 + m * 16) * NP + col0;
#pragma unroll
                    for (int bj = 0; bj < 2; ++bj) { const i32x4 a0 = acc[ai][bj][m][0], a1 = acc[ai][bj][m][1]; const f32x4 s0 = sb0[bj] * sar[ai][m], s1 = sb1[bj] * sar[ai][m];
                        u32x4 w; w.x = pk2((float)a0[0] * s0[0], (float)a0[1] * s0[1]); w.y = pk2((float)a0[2] * s0[2], (float)a0[3] * s0[3]); w.z = pk2((float)a1[0] * s1[0], (float)a1[1] * s1[1]); w.w = pk2((float)a1[2] * s1[2], (float)a1[3] * s1[3]);
                        __builtin_nontemporal_store(w, (u32x4*)(rowp + bj * 128)); } }
        }
    }
};
struct EpiMerge {
    static constexpr bool PERM = true;
    const bf16_t* proj; bf16_t* mg;
    __device__ __forceinline__ void operator()(const f32x4 (&acc)[2][2][4][2], const pg8::Unit& u, int wr, int wc, int fr, int fq) const {
        const int row0 = u.pm * 256 + wr * 64 + fr, col0 = u.pn * 256 + wc * 32 + 8 * fq;
#pragma unroll
        for (int ai = 0; ai < 2; ++ai) {
            u32x2 gv[4][2]; u32x4 pv[4][2];
#pragma unroll
            for (int m = 0; m < 4; ++m)
#pragma unroll
                for (int bj = 0; bj < 2; ++bj) { const size_t row = (size_t)(row0 + ai * 128 + m * 16); const int col = col0 + bj * 128;
                    gv[m][bj] = *(const u32x2*)((const unsigned char*)(proj + row * NP + C_G) + u.g * D + col);
                    if (u.g > 0) pv[m][bj] = *(const u32x4*)(mg + row * D + col); else pv[m][bj] = (u32x4){0u, 0u, 0u, 0u}; }
            asm volatile("" ::: "memory");
#pragma unroll
            for (int m = 0; m < 4; ++m)
#pragma unroll
                for (int bj = 0; bj < 2; ++bj) { const size_t row = (size_t)(row0 + ai * 128 + m * 16); const int col = col0 + bj * 128;
                    const u32x2 g = gv[m][bj]; const u32x4 p = pv[m][bj];
                    const f32x4 v0 = acc[ai][bj][m][0], v1 = acc[ai][bj][m][1];
                    const float k255 = 1.f / 255.f;
                    float r[8];
                    r[0] = v0[0] * ((float)(g.x & 0xffu) * k255) + bflo(p.x); r[1] = v0[1] * ((float)((g.x >> 8) & 0xffu) * k255) + bfhi(p.x);
                    r[2] = v0[2] * ((float)((g.x >> 16) & 0xffu) * k255) + bflo(p.y); r[3] = v0[3] * ((float)(g.x >> 24) * k255) + bfhi(p.y);
                    r[4] = v1[0] * ((float)(g.y & 0xffu) * k255) + bflo(p.z); r[5] = v1[1] * ((float)((g.y >> 8) & 0xffu) * k255) + bfhi(p.z);
                    r[6] = v1[2] * ((float)((g.y >> 16) & 0xffu) * k255) + bflo(p.w); r[7] = v1[3] * ((float)(g.y >> 24) * k255) + bfhi(p.w);
                    u32x4 w; w.x = pk2(r[0], r[1]); w.y = pk2(r[2], r[3]); w.z = pk2(r[4], r[5]); w.w = pk2(r[6], r[7]);
                    *(u32x4*)(mg + row * D + col) = w; }
        }
    }
};
template <bool BASE_BF16> struct EpiResid {
    static constexpr bool PERM = true;
    const void* base; bf16_t* out;
    __device__ __forceinline__ void operator()(const f32x4 (&acc)[2][2][4][2], const pg8::Unit& u, int wr, int wc, int fr, int fq) const {
        const int row0 = u.pm * 256 + wr * 64 + fr, col0 = u.pn * 256 + wc * 32 + 8 * fq;
#pragma unroll
        for (int ai = 0; ai < 2; ++ai) {
            f32x4 b0[4][2], b1[4][2];
#pragma unroll
            for (int m = 0; m < 4; ++m) { const size_t off = (size_t)(row0 + ai * 128 + m * 16) * D + col0;
#pragma unroll
                for (int bj = 0; bj < 2; ++bj) {
                    if (BASE_BF16) { const u32x4 w = *(const u32x4*)((const bf16_t*)base + off + bj * 128);
                        b0[m][bj] = (f32x4){bflo(w.x), bfhi(w.x), bflo(w.y), bfhi(w.y)}; b1[m][bj] = (f32x4){bflo(w.z), bfhi(w.z), bflo(w.w), bfhi(w.w)}; }
                    else { b0[m][bj] = *(const f32x4*)((const float*)base + off + bj * 128); b1[m][bj] = *(const f32x4*)((const float*)base + off + bj * 128 + 4); } } }
            asm volatile("" ::: "memory");
#pragma unroll
            for (int m = 0; m < 4; ++m) { const size_t off = (size_t)(row0 + ai * 128 + m * 16) * D + col0;
#pragma unroll
                for (int bj = 0; bj < 2; ++bj) { const f32x4 v0 = b0[m][bj] + acc[ai][bj][m][0], v1 = b1[m][bj] + acc[ai][bj][m][1];
                    u32x4 w; w.x = pk2(v0[0], v0[1]); w.y = pk2(v0[2], v0[3]); w.z = pk2(v1[0], v1[1]); w.w = pk2(v1[2], v1[3]);
                    *(u32x4*)(out + off + bj * 128) = w; } }
        }
    }
};
struct EpiSwiGLU {
    static constexpr bool PERM = false;
    bf16_t* hid; const float* rsl; LAS const int* pt; LAS const int* lc; const unsigned* cmax  ;
    __device__ __forceinline__ void operator()(const i32x4 (&acc)[2][2][4][2], const pg8::Unit& u, int wr, int wc, int fr, int fq) const {
        const int row0 = u.pm * 256 + wr * 64 + fr, col0 = u.pn * 128 + wc * 16 + 4 * fq;
        const int pbase = (u.pm - pt[u.g]) * 256 + wr * 64 + fr, nrow = lc[u.g];
        float rsv[2][4]; f32x4 sg[2], su[2];
#pragma unroll
        for (int ai = 0; ai < 2; ++ai)
#pragma unroll
            for (int m = 0; m < 4; ++m) { int p = pbase + ai * 128 + m * 16; p = p < nrow ? p : nrow - 1; rsv[ai][m] = rsl[(size_t)u.g * TT + p]; }
#pragma unroll
        for (int bj = 0; bj < 2; ++bj) { const unsigned* cm = cmax + (size_t)u.g * 1024 + u.pn * 256 + bj * 128 + wc * 32 + 4 * fq; const u32x4 a = *(const u32x4*)cm, b = *(const u32x4*)(cm + 16); const float k = 1.f / 127.f;
            sg[bj] = (f32x4){__uint_as_float(a.x) * k, __uint_as_float(a.y) * k, __uint_as_float(a.z) * k, __uint_as_float(a.w) * k};
            su[bj] = (f32x4){__uint_as_float(b.x) * k, __uint_as_float(b.y) * k, __uint_as_float(b.z) * k, __uint_as_float(b.w) * k}; }
#pragma unroll
        for (int ai = 0; ai < 2; ++ai)
#pragma unroll
            for (int m = 0; m < 4; ++m) { bf16_t* rowp = hid + (size_t)(row0 + ai * 128 + m * 16) * FF + col0; const float rs = rsv[ai][m];
#pragma unroll
                for (int bj = 0; bj < 2; ++bj) { const i32x4 ag = acc[ai][bj][m][0], au = acc[ai][bj][m][1]; float g[4], up[4];
#pragma unroll
                    for (int k = 0; k < 4; ++k) { g[k] = (float)ag[k] * (sg[bj][k] * rs); up[k] = (float)au[k] * (su[bj][k] * rs); }
                    u32x2 w; w.x = pk2(g[0] * sigmoidf_(g[0]) * up[0], g[1] * sigmoidf_(g[1]) * up[1]); w.y = pk2(g[2] * sigmoidf_(g[2]) * up[2], g[3] * sigmoidf_(g[3]) * up[3]);
                    *(u32x2*)(rowp + bj * 64) = w; } }
    }
};

constexpr int PH_PER_LAYER = 1 + NCH * 4 + 4, PH_TOTAL = 1 + DEPTH * PH_PER_LAYER + 1;
#ifndef MK_LAUNCH_PER_PHASE
#define MK_LAUNCH_PER_PHASE 0
#endif
#ifndef PHMASK
#define PHMASK 0xFFFF
#endif
#ifndef MIXM
#define MIXM 7
#endif
#define EN(j) (((PHMASK) >> (j)) & 1)
typedef const __attribute__((address_space(4))) char* kptr_t;
__device__ __forceinline__ const void* karg_ptr(kptr_t kp, int i) { return *(const void* const __attribute__((address_space(4)))*)(kp + 8 * i); }
__device__ __forceinline__ void make_ctx(Ctx& c, kptr_t& kp, int layer, int chunk, int wave_s) {
    int t = wave_s * 64 + (int)__builtin_amdgcn_mbcnt_hi(~0u, __builtin_amdgcn_mbcnt_lo(~0u, 0u)); asm volatile("" : "+v"(t));
    kp = (kptr_t)__builtin_amdgcn_kernarg_segment_ptr(); asm volatile("" : "+s"(kp));
    c.tid = t; c.lane = t & 63; c.wave = __builtin_amdgcn_readfirstlane(t >> 6); c.bid = blockIdx.x; c.G = gridDim.x;
    unsigned char* ws = (unsigned char*)karg_ptr(kp, 25); float* out = (float*)karg_ptr(kp, 24);
    c.ctl = (unsigned*)(ws + WS_CTL);
    c.actf = (bf16_t*)(ws + WS_ACT); c.act = c.actf + (size_t)chunk * TC * D; c.proj = (bf16_t*)(ws + WS_PROJ); c.hid = (bf16_t*)(ws + WS_HID); c.ys = (bf16_t*)(ws + WS_YS);
    c.rec = (unsigned*)(ws + WS_REC); c.list = (int*)(ws + WS_LIST); c.rsl = (float*)(ws + WS_RSL);
    c.chunk = chunk; c.layer = layer; c.pass = layer * NCH + chunk;
    c.xinf = (const float*)karg_ptr(kp, 0); c.xof = out; c.xb = (bf16_t*)(ws + WS_XB); c.x2 = (bf16_t*)out; c.sa = (float*)(ws + WS_SA);
    c.x_in = c.xinf + (size_t)chunk * TC * D; c.xo = out + (size_t)chunk * TC * D;
    c.pos = (const int*)karg_ptr(kp, 1) + (size_t)chunk * TC;
    c.lw = ws + WS_W + (size_t)layer * LW_SIZE;
}
#define INP(i) ((const float*)karg_ptr(kp, (i)))
__global__ void __launch_bounds__(NTHR, 2) fwd(Args args) {
    extern __shared__ __attribute__((aligned(16))) unsigned char lds_raw[];
    Ctx c; kptr_t kp;
    c.lds = (LAS unsigned char*)lds_raw;
    const int wave_s = __builtin_amdgcn_readfirstlane((int)threadIdx.x >> 6);
    make_ctx(c, kp, 0, 0, wave_s);
    volatile LAS unsigned* MISC = (volatile LAS unsigned*)(c.lds + MISC_OFF);
    LAS int* sPT = (LAS int*)(c.lds + MISC_OFF + 64);
    LAS int* sLC = (LAS int*)(c.lds + MISC_OFF + 160);
    for (int u = c.tid; u < 1024; u += NTHR) MISC[u] = 0u;
    __syncthreads();
    XcdBarrier bar; bar.bar = c.ctl + CW_BAR; bar.x = 0; bar.st = nullptr;
    if (!MK_LAUNCH_PER_PHASE) bar = xcd_barrier_post(c.ctl + CW_BAR, MISC, c.tid);
    const int lo = args.ph_lo, hi = args.ph_hi;
#define IN(k) (lo <= (k) && (k) < hi)
#ifndef PROBE_MASK
#define PROBE_MASK 0
#endif
#ifndef PROBE_CLK_CLS
#define PROBE_CLK_CLS 2
#endif
#ifndef PROBE_BLOCK
#define PROBE_BLOCK 0
#endif
#ifndef PROBE_K
#define PROBE_K 4
#endif
    unsigned long long t_prev = 0, c_prev = 0; LAS unsigned* sAcc = (LAS unsigned*)(c.lds + MISC_OFF + 512);
    if (PROBE_MASK) { t_prev = __builtin_amdgcn_s_memrealtime(); c_prev = (unsigned long long)clock64(); }
#define STAMP(cls) do { if (PROBE_MASK) { const unsigned long long _n = __builtin_amdgcn_s_memrealtime(); const unsigned long long _ck = (unsigned long long)clock64(); if (blockIdx.x == PROBE_BLOCK && c.tid == 0) { sAcc[(cls)] += (unsigned)(_n - t_prev); if ((cls) == PROBE_CLK_CLS) sAcc[15] += (unsigned)((_ck - c_prev) >> 4); } t_prev = _n; c_prev = _ck; } } while (0)
#ifndef PROBE_GEMM_CLS
#define PROBE_GEMM_CLS -1
#endif
#define GEMM_FLAG(cls) do { if (PROBE_MASK) { if (c.tid == 0) MISC[6] = ((cls) == PROBE_GEMM_CLS) ? 1u : 0u; __syncthreads(); } } while (0)
#define SEAM(k) do { if (IN(k) && IN((k) + 1)) { XcdBarrier _b = bar; kptr_t _k = (kptr_t)__builtin_amdgcn_kernarg_segment_ptr(); asm volatile("" : "+s"(_k)); _b.bar = (unsigned*)((unsigned char*)karg_ptr(_k, 25) + WS_CTL) + CW_BAR; { int _t = wave_s * 64 + (int)__builtin_amdgcn_mbcnt_hi(~0u, __builtin_amdgcn_mbcnt_lo(~0u, 0u)); const unsigned long long _b0 = PROBE_MASK ? __builtin_amdgcn_s_memrealtime() : 0ull; xcd_barrier(_b, _t); if (PROBE_MASK && blockIdx.x == PROBE_BLOCK && _t == 0) sAcc[13] += (unsigned)(__builtin_amdgcn_s_memrealtime() - _b0); } } } while (0)

    if (EN(0) && IN(0)) { Args a2;
#pragma unroll
        for (int i = 0; i < 24; ++i) a2.in[i] = karg_ptr(kp, i);
        a2.ws = (unsigned char*)karg_ptr(kp, 25); a2.out = nullptr; a2.ph_lo = 0; a2.ph_hi = 0;
        float* tmpf = (float*)(a2.ws + WS_XB); unsigned* cmaxb = c.ctl + CW_CMAX;
        phase_prep_a(a2, tmpf, cmaxb, c.bid * NWAVES + c.wave, c.G * NWAVES, c.lane, c.bid * NTHR + c.tid, c.G * NTHR);
        { XcdBarrier _b = bar; _b.bar = c.ctl + CW_BAR; xcd_barrier(_b, c.tid); }
        phase_prep(a2, tmpf, cmaxb, c.lds, c.bid * NWAVES + c.wave, c.G * NWAVES, c.wave, c.lane, c.bid * NTHR + c.tid, c.G * NTHR);
        phase_rope_table((const int*)karg_ptr(kp, 1), (float*)(c.ctl) + (WS_BRC + 4 * MiB) / 4, c.bid * NTHR + c.tid, c.G * NTHR); }
    SEAM(0); STAMP(0);

    for (int layer = 0; layer < DEPTH; ++layer) {
        const int pl = 1 + layer * PH_PER_LAYER;
        if (EN(1) && IN(pl)) { make_ctx(c, kp, layer, 0, wave_s);
            const float* g1 = INP(2) + layer * D;
            if (layer == 0) phase_norm1<false, true, false>(c, g1, sPT);
            else { moe_tables(c.ctl + CW_CNT + 64 * (layer - 1), sPT, sLC, c.tid); phase_norm1<true, true, true>(c, g1, sPT); }
        }
        SEAM(pl); STAMP(1);
        for (int chunk = 0; chunk < NCH; ++chunk) {
            const int pb = pl + 1 + chunk * 4;
            if (EN(2) && IN(pb + 0)) { make_ctx(c, kp, layer, chunk, wave_s);
                EpiProj E{c.proj, c.sa + (size_t)chunk * TC, c.ctl + CW_CMAX + (size_t)layer * NP};
                GEMM_FLAG(2);
                PlainOrder S{TC / 256, NP / 256, c.G, c.bid, (const char*)c.act, (const char*)(c.lw + LW_WIN), (size_t)256 * D, (size_t)256 * D, 0, 1 << 20};
                pg8::gemm_phase<EpiProj, PlainOrder, false, true>(c.lds, S, E, D / 2, D / 2, c.tid);
            }
            SEAM(pb + 0); STAMP(2);
            if (EN(4) && IN(pb + 1)) { make_ctx(c, kp, layer, chunk, wave_s);
                float* lse = (float*)(c.ctl) + (WS_BRC / 4);
                if ((MIXM & 1) && c.bid < 4 * BC) gla_unit(c, c.bid, INP(5) + layer * 256, INP(6) + layer * 128);
                else if ((MIXM & 2) && c.bid < 12 * BC) lru_unit(c, c.bid - 4 * BC, INP(7) + layer * 4 * 512, INP(8) + layer * 512, INP(9) + layer * 8 * 64 * 64,
                                                    INP(10) + layer * 512, INP(11) + layer * 8 * 64 * 64, INP(12) + layer * 512, INP(13) + layer * 512);
                STAMP(12);
                unsigned* qh = c.ctl + CW_Q + 64 * c.pass;
                if (MIXM & 4) attn_loop(c, qh, MISC + 4, lse, INP(14) + layer * 128, INP(15) + layer * 128, (const float*)(c.ctl) + (WS_BRC + 4 * MiB) / 4 + (size_t)chunk * TC * 32);
            }
            SEAM(pb + 1); STAMP(4);
            if (EN(11) && IN(pb + 2)) { make_ctx(c, kp, layer, chunk, wave_s); phase_attn_combine(c, (const float*)(c.ctl) + (WS_BRC / 4)); }
            SEAM(pb + 2); STAMP(11);
            if (EN(5) && IN(pb + 3)) { make_ctx(c, kp, layer, chunk, wave_s);
                MergeOrder S{c.G, c.bid, (const char*)c.proj, (const char*)(c.lw + LW_WBR)};
                EpiMerge E{c.proj, c.act};
                GEMM_FLAG(5);
                pg8::gemm_phase<EpiMerge, MergeOrder, false>(c.lds, S, E, 512, NP, c.tid);
            }
            SEAM(pb + 3); STAMP(5);
        }
        const int pm = pl + 2 + NCH * 4;
        if (EN(6) && IN(pm - 1)) { make_ctx(c, kp, layer, 0, wave_s);
            PlainOrder S{TT / 256, D / 256, c.G, c.bid, (const char*)c.actf, (const char*)(c.lw + LW_WOUT), (size_t)256 * D * 2, (size_t)256 * D * 2, 0, 1 << 20};
            GEMM_FLAG(6);
            if (layer == 0) { EpiResid<false> E{(const void*)c.xinf, c.xb}; pg8::gemm_phase<EpiResid<false>, PlainOrder, false>(c.lds, S, E, D, D, c.tid); }
            else            { EpiResid<true>  E{(const void*)c.x2,  c.xb}; pg8::gemm_phase<EpiResid<true>,  PlainOrder, false>(c.lds, S, E, D, D, c.tid); }
        }
        SEAM(pm - 1); STAMP(6);
        if (EN(7) && IN(pm + 0)) { make_ctx(c, kp, layer, 0, wave_s); phase_router(c, INP(18) + layer * D, INP(19), INP(20), c.ctl + CW_CNT + 64 * layer); }
        SEAM(pm + 0); STAMP(7);
        if (EN(8) && IN(pm + 1)) { make_ctx(c, kp, layer, 0, wave_s);
            moe_tables(c.ctl + CW_CNT + 64 * layer, sPT, sLC, c.tid);
            MoeOrder<true> S{c.G, c.bid, sPT, sLC, (const char*)c.actf, (const char*)(c.lw + LW_WGU), c.list};
            EpiSwiGLU E{c.hid, c.rsl, sPT, sLC, c.ctl + CW_CMAX2 + (size_t)layer * NE * 1024};
            GEMM_FLAG(8);
            pg8::gemm_phase<EpiSwiGLU, MoeOrder<true>, true, true>(c.lds, S, E, D / 2, D / 2, c.tid);
        }
        SEAM(pm + 1); STAMP(8);
        if (EN(9) && IN(pm + 2)) { make_ctx(c, kp, layer, 0, wave_s);
            moe_tables(c.ctl + CW_CNT + 64 * layer, sPT, sLC, c.tid);
            MoeOrder<false> S{c.G, c.bid, sPT, sLC, (const char*)c.hid, (const char*)(c.lw + LW_WDN), c.list};
            EpiStoreBf16 E{c.ys, D};
            GEMM_FLAG(9);
            pg8::gemm_phase<EpiStoreBf16, MoeOrder<false>, false>(c.lds, S, E, FF, FF, c.tid);
        }
        SEAM(pm + 2); STAMP(9);
    }
    if (EN(10) && IN(PH_TOTAL - 1)) { make_ctx(c, kp, DEPTH - 1, 0, wave_s);
        moe_tables(c.ctl + CW_CNT + 64 * (DEPTH - 1), sPT, sLC, c.tid);
        phase_norm1<true, false, true>(c, nullptr, sPT);
    }
    if (PROBE_MASK) {
        make_ctx(c, kp, DEPTH - 1, 0, wave_s);
        STAMP(10);
        if (blockIdx.x == PROBE_BLOCK && c.tid == 0) { unsigned sel = 0; for (int k = 0; k < 16; ++k) if ((PROBE_MASK >> k) & 1) sel += sAcc[k]; __hip_atomic_store(c.ctl + CW_Q + 64 * 8, sel, __ATOMIC_RELAXED, __HIP_MEMORY_SCOPE_AGENT); }
        { XcdBarrier _b = bar; _b.bar = c.ctl + CW_BAR; xcd_barrier(_b, c.tid); }
        const unsigned sel = __hip_atomic_load(c.ctl + CW_Q + 64 * 8, __ATOMIC_RELAXED, __HIP_MEMORY_SCOPE_AGENT);
        const unsigned long long t0 = __builtin_amdgcn_s_memrealtime();
        while (__builtin_amdgcn_s_memrealtime() - t0 < (unsigned long long)sel * PROBE_K) __builtin_amdgcn_s_sleep(8);
    }
#undef IN
#undef SEAM
}

extern "C" void kernel_launch(void* const* d_in, const int* in_sizes, int n_in, void* d_out, int out_size, void* d_ws, size_t ws_size, hipStream_t stream) {
    static int grid = 0;
    if (grid == 0) {
        if (n_in != 24 || in_sizes[0] != BATCH * SEQ * D || out_size != BATCH * SEQ * D || ws_size < WS_END) { fprintf(stderr, "kernel_launch: unexpected shapes / workspace (%zu < %zu)\n", ws_size, (size_t)WS_END); grid = -1; return; }
        int dev = 0, cus = 0;
        if (hipGetDevice(&dev) != hipSuccess || hipDeviceGetAttribute(&cus, hipDeviceAttributeMultiprocessorCount, dev) != hipSuccess || cus < 256) { fprintf(stderr, "kernel_launch: needs a 256-CU device\n"); grid = -1; return; }
        if (hipFuncSetAttribute((const void*)fwd, hipFuncAttributeMaxDynamicSharedMemorySize, LDS_BYTES) != hipSuccess) { fprintf(stderr, "kernel_launch: hipFuncSetAttribute failed\n"); grid = -1; return; }
        int per_cu = 0;
        if (hipOccupancyMaxActiveBlocksPerMultiprocessor(&per_cu, (const void*)fwd, NTHR, LDS_BYTES) != hipSuccess || per_cu < 1) fprintf(stderr, "kernel_launch: occupancy query says %d\n", per_cu);
        (void)hipGetLastError();
        grid = 256;
    }
    if (grid < 0) return;
    if (hipMemsetAsync((char*)d_ws + WS_CTL, 0, CTL_ZERO_BYTES, stream) != hipSuccess) return;
    Args a{};
    for (int i = 0; i < 24; ++i) a.in[i] = d_in[i];
    a.out = (float*)d_out; a.ws = (unsigned char*)d_ws;
#if MK_LAUNCH_PER_PHASE
    for (int k = 0; k < PH_TOTAL; ++k) { a.ph_lo = k; a.ph_hi = k + 1; hipLaunchKernelGGL(fwd, dim3(grid), dim3(NTHR), LDS_BYTES, stream, a); }
#else
    a.ph_lo = 0; a.ph_hi = PH_TOTAL;
    hipLaunchKernelGGL(fwd, dim3(grid), dim3(NTHR), LDS_BYTES, stream, a);
#endif
}
```

```cpp
#include <hip/hip_runtime.h>
#include <cstdio>
#include <cstdint>

#define LAS __attribute__((address_space(3)))
#define GAS __attribute__((address_space(1)))
typedef unsigned short bf16_t;
typedef short bf16x8 __attribute__((ext_vector_type(8)));
typedef float f32x4 __attribute__((ext_vector_type(4)));
typedef float f32x2 __attribute__((ext_vector_type(2)));
typedef unsigned u32x4 __attribute__((ext_vector_type(4)));
typedef unsigned u32x2 __attribute__((ext_vector_type(2)));
typedef int i32x4 __attribute__((ext_vector_type(4)));

namespace pg8 {
constexpr int BM = 256, BK = 64, HALF = 128, HTB = HALF * BK * 2, STAGE_BYTES = 8 * HTB, NXCD = 8, WGM = 8;
__host__ __device__ __forceinline__ int lds_byte(int r, int c) { const int st = (r >> 4) * 2 + (c >> 5), rr = r & 15, cc = c & 31, ob = rr * 64 + cc * 2; return st * 1024 + (ob ^ (((ob >> 9) & 1) << 5)); }
__host__ __device__ __forceinline__ void stage_rc(int b, int& R, int& C) { const int st = b / 1024, sb = b % 1024, swz = sb ^ (((sb >> 9) & 1) << 5); R = (st >> 1) * 16 + swz / 64; C = (st & 1) * 32 + (swz % 64) / 2; }
__host__ __device__ __forceinline__ int perm32(int rho) { const int n = rho >> 4, i = rho & 15; return 8 * (i >> 2) + 4 * n + (i & 3); }

struct Unit { int pm, pn, g; };

__device__ __forceinline__ bool static_tile(int nM, int nN, int G, int c, int i, int& pm, int& pn) {
    const int nwg = nM * nN; const long L = (long)i * G + c; if (L >= nwg) return false;
    int wgid = (int)L; { const int q = nwg / NXCD, r = nwg % NXCD, xcd = wgid % NXCD, off = wgid / NXCD; wgid = (xcd < r ? xcd * (q + 1) : r * (q + 1) + (xcd - r) * q) + off; }
    const int nig = WGM * nN, gid = wgid / nig, fm = gid * WGM, gsz = (nM - fm) < WGM ? (nM - fm) : WGM;
    pm = fm + ((wgid % nig) % gsz); pn = (wgid % nig) / gsz; return true;
}
typedef __bf16 bf16x2c_t __attribute__((ext_vector_type(2)));
__device__ __forceinline__ unsigned cvt_pk_bf16(float lo, float hi) { const f32x2 v = {lo, hi}; return __builtin_bit_cast(unsigned, __builtin_convertvector(v, bf16x2c_t)); }

template <bool I8> struct AccT { typedef f32x4 t; };
template <> struct AccT<true> { typedef i32x4 t; };
template <class Epi, class Sched, bool GATHER, bool I8 = false>
__device__ __forceinline__ void gemm_phase(LAS unsigned char* lds, const Sched& S, const Epi& E, const int K, const int lda, int tid_) {
    asm volatile("" : "+v"(tid_));
    const int tid = tid_, wid = __builtin_amdgcn_readfirstlane(tid >> 6), lane = tid & 63, wr = wid >> 2, wc = wid & 3, fr = lane & 15, fq = lane >> 4;
    const int nt = K / BK;
    int sR[2], sC[2];
    unsigned voffB[2], voffA[2], vAc[2][2], vAn[2][2];
#pragma unroll
    for (int i = 0; i < 2; ++i) { int R, C; stage_rc(tid * 16 + i * 8192, R, C); sR[i] = R; sC[i] = C; const int Rb = Epi::PERM ? ((R & ~31) + perm32(R & 31)) : R;
        voffB[i] = (unsigned)(Rb * K + C) * 2u; voffA[i] = (unsigned)(R * lda + C) * 2u; }
    const size_t kstep = (size_t)(BK * 2);
    const size_t hstepB = (size_t)HALF * K * 2, hstepA = (size_t)HALF * lda * 2;
    const unsigned ldsw = (unsigned)wid * 1024u;
    const int aoff = lds_byte(wr * 64 + fr, fq * 8), boff = lds_byte(wc * 32 + fr, fq * 8);
#define PG8_SA(b, h) (((b) * 2 + (h)) * HTB)
#define PG8_SB(b, h) ((4 + (b) * 2 + (h)) * HTB)
#define PG8_STAGE(bufoff, gbase, voff) do { _Pragma("unroll") for (int _i = 0; _i < 2; ++_i) \
        __builtin_amdgcn_global_load_lds((const unsigned*)((const char*)(gbase) + (voff)[_i]), (LAS unsigned*)(lds + (bufoff) + ldsw + _i * 8192), 16, 0, 0); } while (0)
#define PG8_LDA(dst, b, h) do { _Pragma("unroll") for (int m = 0; m < 4; ++m) _Pragma("unroll") for (int k = 0; k < 2; ++k) dst[m][k] = *(const LAS bf16x8*)(lds + PG8_SA(b, h) + aoff + m * 2048 + k * 1024); } while (0)
#define PG8_LDB(dst, b, h) do { _Pragma("unroll") for (int n = 0; n < 2; ++n) _Pragma("unroll") for (int k = 0; k < 2; ++k) dst[n][k] = *(const LAS bf16x8*)(lds + PG8_SB(b, h) + boff + n * 2048 + k * 1024); } while (0)
#define PG8_MMA(ai, bj, At, Bt) do { __builtin_amdgcn_s_setprio(1); _Pragma("unroll") for (int m = 0; m < 4; ++m) _Pragma("unroll") for (int n = 0; n < 2; ++n) _Pragma("unroll") for (int k = 0; k < 2; ++k) \
        { if constexpr (I8) acc[ai][bj][m][n] = __builtin_amdgcn_mfma_i32_16x16x64_i8(__builtin_bit_cast(i32x4, Bt[n][k]), __builtin_bit_cast(i32x4, At[m][k]), acc[ai][bj][m][n], 0, 0, 0); \
          else acc[ai][bj][m][n] = __builtin_amdgcn_mfma_f32_16x16x32_bf16(Bt[n][k], At[m][k], acc[ai][bj][m][n], 0, 0, 0); } __builtin_amdgcn_s_setprio(0); } while (0)
#define PG8_WAIT_V(n) asm volatile("s_waitcnt vmcnt(" #n ")" ::: "memory")
#define PG8_WAIT_L(n) asm volatile("s_waitcnt lgkmcnt(" #n ")" ::: "memory")
#define PG8_BAR __builtin_amdgcn_s_barrier()
#define PG8_SCHED __builtin_amdgcn_sched_barrier(0)
#define PG8_AOFF(dst, u) do { if constexpr (GATHER) { _Pragma("unroll") for (int _h = 0; _h < 2; ++_h) _Pragma("unroll") for (int _i = 0; _i < 2; ++_i) \
        dst[_h][_i] = S.arow(u, _h * HALF + sR[_i]) + (unsigned)sC[_i] * 2u; } } while (0)
#define PG8_STAGE_A(bufoff, gptr, h, usenext) do { if constexpr (GATHER) { _Pragma("unroll") for (int _i = 0; _i < 2; ++_i) { const unsigned _vo = (usenext) ? vAn[h][_i] : vAc[h][_i]; \
        __builtin_amdgcn_global_load_lds((const unsigned*)((const char*)(gptr) + _vo), (LAS unsigned*)(lds + (bufoff) + ldsw + _i * 8192), 16, 0, 0); } } \
        else { PG8_STAGE(bufoff, (gptr) + (h) * hstepA, voffA); } } while (0)
    Unit cur, nxt; int ui = 0;
    if (!S.next(0, cur)) return;
    typedef typename AccT<I8>::t acc_t;
    acc_t acc[2][2][4][2];
#pragma unroll
    for (int a = 0; a < 2; ++a)
#pragma unroll
        for (int b = 0; b < 2; ++b)
#pragma unroll
            for (int m = 0; m < 4; ++m)
#pragma unroll
                for (int n = 0; n < 2; ++n) acc[a][b][m][n] = (acc_t){0, 0, 0, 0};
    bf16x8 At[4][2], B0[2][2], B1[2][2];
    const char* cA = S.aptr(cur); const char* cB = S.bptr(cur);
    PG8_AOFF(vAc, cur);
    PG8_STAGE(PG8_SB(0, 0), cB, voffB); PG8_STAGE(PG8_SB(0, 1), cB + hstepB, voffB); PG8_STAGE_A(PG8_SA(0, 0), cA, 0, false); PG8_STAGE_A(PG8_SA(0, 1), cA, 1, false);
    if (wr == 1) PG8_BAR;
    PG8_WAIT_V(2); PG8_BAR;
    PG8_STAGE(PG8_SB(1, 0), cB + kstep, voffB); PG8_STAGE_A(PG8_SA(1, 0), cA + kstep, 0, false); PG8_STAGE(PG8_SB(1, 1), cB + hstepB + kstep, voffB);
    PG8_WAIT_V(6); PG8_BAR;
    for (;;) {
        const bool has_next = S.next(ui + 1, nxt);
        const char* nA = has_next ? S.aptr(nxt) : cA; const char* nB = has_next ? S.bptr(nxt) : cB;
        if constexpr (GATHER) { if (has_next) { PG8_AOFF(vAn, nxt); } else {
#pragma unroll
            for (int h = 0; h < 2; ++h)
#pragma unroll
                for (int i = 0; i < 2; ++i) vAn[h][i] = vAc[h][i]; } }
#if defined(PROBE_MASK) && PROBE_MASK
        const unsigned long long _tk0 = __builtin_amdgcn_s_memrealtime();
#endif
        for (int t = 0; t < nt; t += 2) {
            const bool last = (t == nt - 2);
            const char* a1 = cA + (size_t)(t + 1) * kstep;
            const char* a2 = last ? nA : cA + (size_t)(t + 2) * kstep; const char* b2 = last ? nB : cB + (size_t)(t + 2) * kstep;
            const char* a3 = a2 + kstep; const char* b3 = b2 + kstep;
            PG8_LDB(B0, 0, 0); PG8_LDB(B1, 0, 1); PG8_SCHED; PG8_LDA(At, 0, 0); PG8_STAGE_A(PG8_SA(1, 1), a1, 1, false);
            PG8_WAIT_V(8); PG8_WAIT_L(0); PG8_BAR; PG8_MMA(0, 0, At, B0); PG8_MMA(0, 1, At, B1); PG8_BAR; PG8_SCHED;
            PG8_LDA(At, 0, 1); PG8_STAGE(PG8_SB(0, 0), b2, voffB); PG8_STAGE(PG8_SB(0, 1), b2 + hstepB, voffB); PG8_STAGE_A(PG8_SA(0, 0), a2, 0, last);
            PG8_WAIT_V(8); PG8_WAIT_L(0); PG8_BAR; PG8_MMA(1, 0, At, B0); PG8_MMA(1, 1, At, B1); PG8_BAR; PG8_SCHED;
            PG8_LDB(B0, 1, 0); PG8_LDB(B1, 1, 1); PG8_SCHED; PG8_LDA(At, 1, 0); PG8_STAGE_A(PG8_SA(0, 1), a2, 1, last);
            PG8_WAIT_V(8); PG8_WAIT_L(0); PG8_BAR; PG8_MMA(0, 0, At, B0); PG8_MMA(0, 1, At, B1); PG8_BAR; PG8_SCHED;
            PG8_LDA(At, 1, 1); PG8_STAGE(PG8_SB(1, 0), b3, voffB); PG8_STAGE(PG8_SB(1, 1), b3 + hstepB, voffB); PG8_STAGE_A(PG8_SA(1, 0), a3, 0, last);
            PG8_WAIT_V(8); PG8_WAIT_L(0); PG8_BAR; PG8_MMA(1, 0, At, B0); PG8_MMA(1, 1, At, B1); PG8_BAR; PG8_SCHED;
        }
#if defined(PROBE_MASK) && PROBE_MASK
        if (blockIdx.x == PROBE_BLOCK && tid == 0 && ((volatile LAS unsigned*)(lds + 147456))[6]) ((LAS unsigned*)(lds + 147456 + 512))[14] += (unsigned)(__builtin_amdgcn_s_memrealtime() - _tk0);
#endif
        if (wr == 0) PG8_BAR;
#if defined(PROBE_MASK) && PROBE_MASK
        { const unsigned long long _t0 = __builtin_amdgcn_s_memrealtime();
          E(acc, cur, wr, wc, fr, fq);
          asm volatile("s_waitcnt vmcnt(0)" ::: "memory");
          if (blockIdx.x == PROBE_BLOCK && tid == 0 && ((volatile LAS unsigned*)(lds + 147456))[6]) ((LAS unsigned*)(lds + 147456 + 512))[13] += (unsigned)(__builtin_amdgcn_s_memrealtime() - _t0); }
#else
        E(acc, cur, wr, wc, fr, fq);
#endif
        if (!has_next) break;
#pragma unroll
        for (int a = 0; a < 2; ++a)
#pragma unroll
            for (int b = 0; b < 2; ++b)
#pragma unroll
                for (int m = 0; m < 4; ++m)
#pragma unroll
                    for (int n = 0; n < 2; ++n) acc[a][b][m][n] = (acc_t){0, 0, 0, 0};
        cur = nxt; cA = nA; cB = nB; ++ui;
        if constexpr (GATHER) {
#pragma unroll
        for (int h = 0; h < 2; ++h)
#pragma unroll
            for (int i = 0; i < 2; ++i) vAc[h][i] = vAn[h][i]; }
        if (wr == 1) PG8_BAR;
    }
    PG8_WAIT_V(0);
    PG8_BAR;
#undef PG8_SA
#undef PG8_SB
#undef PG8_STAGE
#undef PG8_LDA
#undef PG8_LDB
#undef PG8_MMA
#undef PG8_WAIT_V
#undef PG8_WAIT_L
#undef PG8_BAR
#undef PG8_SCHED
#undef PG8_AOFF
#undef PG8_STAGE_A
}
}

constexpr int D = 1024, BATCH = 32, SEQ = 2048, DEPTH = 2;
constexpr int NCH = 2, BC = BATCH / NCH, TC = BC * SEQ;
constexpr int TT = BATCH * SEQ;
constexpr int NP = 10496;
constexpr int C_QA = 0, C_KA = 256, C_VA = 512, C_OG = 1024, C_GP = 1536, C_XB = 1792, C_YB = 2304, C_QKV = 2816, C_G = 7424;
constexpr int WIN_N = 10256;
constexpr int NE = 16, FF = 512;
constexpr int RP = 2 * TT + NE * 256;
constexpr float RMS_EPS = 1e-6f;
constexpr int NWAVES = 8, NTHR = 512;

constexpr size_t MiB = 1u << 20;
constexpr size_t WS_CTL = 0, CTL_ZERO_BYTES = 1 * MiB;
constexpr size_t WS_REC = 1 * MiB;
constexpr size_t WS_LIST = 2 * MiB;
constexpr size_t WS_W = 6 * MiB;
constexpr size_t LW_WIN = 0, LW_WBR = LW_WIN + (size_t)NP * D * 2, LW_WOUT = LW_WBR + (size_t)3 * D * 512 * 2, LW_WGU = LW_WOUT + (size_t)D * D * 2,
                 LW_WDN = LW_WGU + (size_t)NE * 1024 * D * 2, LW_SIZE = LW_WDN + (size_t)NE * D * FF * 2;
static_assert(LW_SIZE == 77070336, "layer weights");
constexpr size_t WS_BRC = 154 * MiB;
constexpr size_t WS_SA = WS_BRC + 2 * MiB;
constexpr size_t WS_SBR = WS_BRC + 3 * MiB;
constexpr size_t WS_ACT = 166 * MiB;
constexpr size_t WS_PROJ = 294 * MiB;
constexpr size_t WS_HID = WS_PROJ;
constexpr size_t WS_YS = WS_PROJ + 136 * MiB;
constexpr size_t WS_XB = WS_PROJ + 400 * MiB;
constexpr size_t WS_RSL = WS_PROJ + 656 * MiB;
constexpr size_t WS_END = WS_RSL + 4 * MiB;
static_assert(WS_W + 2 * LW_SIZE <= WS_BRC && WS_BRC + 12 * MiB <= WS_ACT && WS_ACT + (size_t)TT * D * 2 <= WS_PROJ && (size_t)TC * NP * 2 <= 656 * MiB && (size_t)RP * 512 * 2 <= 136 * MiB && WS_YS + (size_t)RP * 2048 <= WS_XB && WS_XB + (size_t)TT * D * 2 <= WS_RSL, "ws map");
constexpr int CW_BAR = 4096;
constexpr int CW_CNT = 8192;
constexpr int CW_Q = 12288;
constexpr int CW_CMAX3 = 65536 + 2 * NP + 2 * NE * 1024;
constexpr int CW_CMAX2 = 65536 + 2 * NP;
constexpr int CW_CMAX = 65536;

constexpr int RING_BYTES = 147456;
constexpr int MISC_OFF = RING_BYTES;
constexpr int LDS_BYTES = 155648;

#define LDS_WAIT() asm volatile("s_waitcnt lgkmcnt(0)" ::: "memory")
#define VM_WAIT() asm volatile("s_waitcnt vmcnt(0)" ::: "memory")
__device__ __forceinline__ float bf2f(unsigned short b) { return __uint_as_float(((unsigned)b) << 16); }
__device__ __forceinline__ float bflo(unsigned u) { return __uint_as_float(u << 16); }
__device__ __forceinline__ float bfhi(unsigned u) { return __uint_as_float(u & 0xffff0000u); }
typedef __bf16 bf16x2v_t __attribute__((ext_vector_type(2)));
__device__ __forceinline__ unsigned pk2(float lo, float hi) { const f32x2 v = {lo, hi}; return __builtin_bit_cast(unsigned, __builtin_convertvector(v, bf16x2v_t)); }
__device__ __forceinline__ unsigned f2bf(float f) { return pk2(f, 0.f) & 0xffffu; }
__device__ __forceinline__ float rcpf_(float x) { return __builtin_amdgcn_rcpf(x); }
__device__ __forceinline__ float rsqf_(float x) { return __builtin_amdgcn_rsqf(x); }
template <int O> __device__ __forceinline__ float swz_xor(float v) { return __int_as_float(__builtin_amdgcn_ds_swizzle(__float_as_int(v), (O << 10) | 0x1f)); }
__device__ __forceinline__ float wave_sum(float v) {
    v += swz_xor<1>(v); v += swz_xor<2>(v); v += swz_xor<4>(v); v += swz_xor<8>(v); v += swz_xor<16>(v);
    const auto r = __builtin_amdgcn_permlane32_swap(__float_as_uint(v), __float_as_uint(v), false, false);
    return __uint_as_float(r[0]) + __uint_as_float(r[1]);
}
__device__ __forceinline__ float wave_max(float v) {
    v = fmaxf(v, swz_xor<1>(v)); v = fmaxf(v, swz_xor<2>(v)); v = fmaxf(v, swz_xor<4>(v)); v = fmaxf(v, swz_xor<8>(v)); v = fmaxf(v, swz_xor<16>(v));
    const auto r = __builtin_amdgcn_permlane32_swap(__float_as_uint(v), __float_as_uint(v), false, false);
    return fmaxf(__uint_as_float(r[0]), __uint_as_float(r[1]));
}
__device__ __forceinline__ float sigmoidf_(float x) { return __builtin_amdgcn_rcpf(1.f + __expf(-x)); }

#define XB_TMO      128
#define XB_XCNT(j)  (256  + 64 * (j))
#define XB_XSUB(j)  (1280 + 64 * (j))
#define XB_XGEN(j)  (2304 + 64 * (j))
#define XB_TOP      3328
#define XB_TOPGEN   3392
#define XCD_BAR_WORDS 3456
#define XB_SPIN_CAP (1u << 21)
__device__ __forceinline__ unsigned xb_ld(unsigned* p)              { return __hip_atomic_load(p, __ATOMIC_RELAXED, __HIP_MEMORY_SCOPE_AGENT); }
__device__ __forceinline__ unsigned xb_add(unsigned* p, unsigned v) { return __hip_atomic_fetch_add(p, v, __ATOMIC_RELAXED, __HIP_MEMORY_SCOPE_AGENT); }
__device__ __forceinline__ unsigned xb_xcc_id() { return (unsigned)__builtin_amdgcn_s_getreg((3 << 11) | 20) & 0xFu; }
#define XB_SPIN(cond, bar) do { unsigned _sp = 0; while (cond) { __builtin_amdgcn_s_sleep(1); \
    if ((++_sp & 255u) == 0u) { if (xb_ld(&(bar)[XB_TMO])) break; if (_sp > XB_SPIN_CAP) { atomicAdd(&(bar)[XB_TMO], 1u); break; } } } } while (0)
struct XcdBarrier { unsigned* bar; unsigned x; volatile LAS unsigned* st; };
__device__ __forceinline__ XcdBarrier xcd_barrier_post(unsigned* bar, volatile LAS unsigned* st, int tid) {
    XcdBarrier b; b.bar = bar; b.x = xb_xcc_id(); b.st = st;
    if (tid == 0) (void)xb_add(&bar[XB_XCNT(b.x)], 1u);
    return b;
}
__device__ __forceinline__ void xcd_barrier_complete(unsigned* bar, unsigned x, unsigned& nloc, unsigned& nx) {
    const unsigned G = gridDim.x * gridDim.y * gridDim.z;
    unsigned sum, cnt, sp = 0u;
    for (;;) {
        sum = 0u; cnt = 0u;
#pragma unroll 1
        for (unsigned j = 0; j < 16; ++j) { const unsigned c = xb_ld(&bar[XB_XCNT(j)]); sum += c; cnt += (c > 0u) ? 1u : 0u; }
        if (sum == G) break;
        __builtin_amdgcn_s_sleep(1);
        if ((++sp & 255u) == 0u) { if (xb_ld(&bar[XB_TMO])) break; if (sp > XB_SPIN_CAP) { atomicAdd(&bar[XB_TMO], 1u); break; } }
    }
    const unsigned mine = xb_ld(&bar[XB_XCNT(x)]);
    nloc = mine > 0u ? mine : 1u; nx = cnt > 0u ? cnt : 1u;
}
__device__ __noinline__ void xcd_barrier(const XcdBarrier b, const int tid) {
    asm volatile("s_waitcnt vmcnt(0)" ::: "memory");
    __syncthreads();
    if (tid == 0) {
        unsigned* bar = b.bar;
        __builtin_amdgcn_s_waitcnt(0);
        unsigned nloc = b.st[0], nx = b.st[1];
        if (nloc == 0u) { xcd_barrier_complete(bar, b.x, nloc, nx); b.st[0] = nloc; b.st[1] = nx; }
        const unsigned old = xb_add(&bar[XB_XSUB(b.x)], 1u);
        const unsigned gen = old / nloc;
        if (old + 1u == (gen + 1u) * nloc) {
            __builtin_amdgcn_fence(__ATOMIC_RELEASE, "agent");
            asm volatile("s_waitcnt vmcnt(0)" ::: "memory");
            const unsigned og = xb_add(&bar[XB_TOP], 1u);
            const unsigned tg = og / nx;
            if (og + 1u == (tg + 1u) * nx) xb_add(&bar[XB_TOPGEN], 1u);
            else XB_SPIN(xb_ld(&bar[XB_TOPGEN]) == tg, bar);
            __builtin_amdgcn_fence(__ATOMIC_ACQUIRE, "agent");
            xb_add(&bar[XB_XGEN(b.x)], 1u);
            asm volatile("s_waitcnt vmcnt(0)" ::: "memory");
        } else {
            XB_SPIN(xb_ld(&bar[XB_XGEN(b.x)]) == gen, bar);
            __builtin_amdgcn_fence(__ATOMIC_ACQUIRE, "agent");
            asm volatile("s_waitcnt vmcnt(0)" ::: "memory");
        }
    }
    __syncthreads();
}

struct Args { const void* in[24]; float* out; unsigned char* ws; int ph_lo, ph_hi; };
struct Ctx {
    LAS unsigned char* lds;
    unsigned* ctl;
    int tid, lane, wave, bid, G;
    int chunk, layer, pass;
    const float* x_in; float* xo;
    const float* xinf; float* xof; bf16_t* actf;
    float* sa;
    float* sbr;
    bf16_t* xb; bf16_t* x2;
    const int* pos;
    const unsigned char* lw;
    bf16_t *act, *proj, *hid, *ys;
    unsigned* rec; int* list; float* rsl;
};

template <class DMap>
__device__ __forceinline__ void tr_item64(const float* srcA, const float* srcB, int Nsrc, float scale, bf16_t* WT, int K, int n0, int k0, LAS float* scr, int lane, DMap dmap) {
    const int r4 = lane >> 4, c16 = lane & 15;
    const float* src = (c16 < 8 ? srcA + 4 * c16 : srcB + 4 * (c16 - 8));
    f32x4 v[16];
#pragma unroll
    for (int i = 0; i < 16; ++i) v[i] = *(const f32x4*)(src + (size_t)(k0 + 4 * i + r4) * Nsrc);
#pragma unroll
    for (int i = 0; i < 16; ++i) { LAS float* d = scr + (4 * i + r4) * 65 + 4 * c16; d[0] = v[i].x * scale; d[1] = v[i].y * scale; d[2] = v[i].z * scale; d[3] = v[i].w * scale; }
    LDS_WAIT(); asm volatile("" ::: "memory");
    const int kc = lane & 7;
#pragma unroll
    for (int j = 0; j < 8; ++j) { const int r = (lane >> 3) + 8 * j; const LAS float* q = scr + (8 * kc) * 65 + dmap(r);
        u32x4 o; o.x = pk2(q[0 * 65], q[1 * 65]); o.y = pk2(q[2 * 65], q[3 * 65]); o.z = pk2(q[4 * 65], q[5 * 65]); o.w = pk2(q[6 * 65], q[7 * 65]);
        *(u32x4*)(WT + (size_t)(n0 + r) * K + k0 + 8 * kc) = o; }
    LDS_WAIT(); asm volatile("" ::: "memory");
}
struct DMapId { __device__ __forceinline__ int operator()(int r) const { return r; } };
struct DMapGU { __device__ __forceinline__ int operator()(int r) const { return ((r >> 4) & 1) * 32 + (r >> 5) * 16 + (r & 15); } };
template <class DMap>
__device__ __forceinline__ void tr_item64q(const float* srcA, const float* srcB, int Nsrc, float scale, signed char* WTq, int K, int n0, int k0, LAS float* scr, int lane, const unsigned* cmax, DMap dmap) {
    const int r4 = lane >> 4, c16 = lane & 15;
    const float* src = (c16 < 8 ? srcA + 4 * c16 : srcB + 4 * (c16 - 8));
    f32x4 v[16];
#pragma unroll
    for (int i = 0; i < 16; ++i) v[i] = *(const f32x4*)(src + (size_t)(k0 + 4 * i + r4) * Nsrc);
#pragma unroll
    for (int i = 0; i < 16; ++i) { LAS float* d = scr + (4 * i + r4) * 65 + 4 * c16; d[0] = v[i].x * scale; d[1] = v[i].y * scale; d[2] = v[i].z * scale; d[3] = v[i].w * scale; }
    LDS_WAIT(); asm volatile("" ::: "memory");
    const int kc = lane & 3;
#pragma unroll
    for (int j = 0; j < 4; ++j) { const int r = (lane >> 2) + 16 * j; const LAS float* q = scr + (16 * kc) * 65 + dmap(r);
        const float mx = __uint_as_float(cmax[n0 + r]); const float inv = mx > 0.f ? 127.f / mx : 0.f;
        unsigned w[4];
#pragma unroll
        for (int k = 0; k < 4; ++k) { const int q0 = (int)__builtin_rintf(q[(4 * k + 0) * 65] * inv), q1 = (int)__builtin_rintf(q[(4 * k + 1) * 65] * inv), q2 = (int)__builtin_rintf(q[(4 * k + 2) * 65] * inv), q3 = (int)__builtin_rintf(q[(4 * k + 3) * 65] * inv);
            w[k] = (unsigned)(q0 & 0xff) | ((unsigned)(q1 & 0xff) << 8) | ((unsigned)(q2 & 0xff) << 16) | ((unsigned)(q3 & 0xff) << 24); }
        u32x4 o; o.x = w[0]; o.y = w[1]; o.z = w[2]; o.w = w[3];
        *(u32x4*)(WTq + (size_t)(n0 + r) * K + k0 + 16 * kc) = o; }
    LDS_WAIT(); asm volatile("" ::: "memory");
}
__device__ __forceinline__ void cmax_item64(const float* srcA, int Nsrc, float scale, int n0, int k0, int lane, unsigned* cmax) {
    const int r4 = lane >> 4, c16 = lane & 15;
    const float* src = srcA + 4 * c16;
    f32x4 m = {0.f, 0.f, 0.f, 0.f};
#pragma unroll
    for (int i = 0; i < 16; ++i) { const f32x4 v = *(const f32x4*)(src + (size_t)(k0 + 4 * i + r4) * Nsrc);
        m.x = fmaxf(m.x, fabsf(v.x)); m.y = fmaxf(m.y, fabsf(v.y)); m.z = fmaxf(m.z, fabsf(v.z)); m.w = fmaxf(m.w, fabsf(v.w)); }
    m.x = fmaxf(m.x, swz_xor<16>(m.x)); m.y = fmaxf(m.y, swz_xor<16>(m.y)); m.z = fmaxf(m.z, swz_xor<16>(m.z)); m.w = fmaxf(m.w, swz_xor<16>(m.w));
    const float mv[4] = {m.x, m.y, m.z, m.w};
#pragma unroll
    for (int k = 0; k < 4; ++k) { const auto r = __builtin_amdgcn_permlane32_swap(__float_as_uint(mv[k]), __float_as_uint(mv[k]), false, false);
        const float t = fmaxf(__uint_as_float(r[0]), __uint_as_float(r[1])) * scale;
        if (lane < 16) atomicMax(cmax + n0 + 4 * c16 + k, __float_as_uint(t)); }
}
constexpr int IT_WIN = (NP / 64) * 16, IT_WBR = 3 * 16 * 8, IT_WOUT = 16 * 16, IT_WGU = NE * 16 * 16, IT_WDN = NE * 16 * 8, IT_LAYER = IT_WIN + IT_WBR + IT_WOUT + IT_WGU + IT_WDN;
__device__ __forceinline__ void cmax_item64gu(const float* src0, int Nsrc, int col0, int isup, int k0, int lane, unsigned* cmax) {
    const int r4 = lane >> 4, c16 = lane & 15;
    const float* src = src0 + col0 + 4 * c16;
    f32x4 m = {0.f, 0.f, 0.f, 0.f};
#pragma unroll
    for (int i = 0; i < 16; ++i) { const f32x4 v = *(const f32x4*)(src + (size_t)(k0 + 4 * i + r4) * Nsrc);
        m.x = fmaxf(m.x, fabsf(v.x)); m.y = fmaxf(m.y, fabsf(v.y)); m.z = fmaxf(m.z, fabsf(v.z)); m.w = fmaxf(m.w, fabsf(v.w)); }
    m.x = fmaxf(m.x, swz_xor<16>(m.x)); m.y = fmaxf(m.y, swz_xor<16>(m.y)); m.z = fmaxf(m.z, swz_xor<16>(m.z)); m.w = fmaxf(m.w, swz_xor<16>(m.w));
    const float mv[4] = {m.x, m.y, m.z, m.w};
#pragma unroll
    for (int k = 0; k < 4; ++k) { const auto r = __builtin_amdgcn_permlane32_swap(__float_as_uint(mv[k]), __float_as_uint(mv[k]), false, false);
        const float t = fmaxf(__uint_as_float(r[0]), __uint_as_float(r[1])); const int j = col0 + 4 * c16 + k;
        if (lane < 16) atomicMax(cmax + 32 * (j >> 4) + 16 * isup + (j & 15), __float_as_uint(t)); }
}
__device__ __forceinline__ void phase_prep_a(const Args& a, float* tmpf, unsigned* cmaxb, int gw, int NGW, int lane, int gtid, int NGT) {
    constexpr int IT = (WIN_N / 64) * 16;
    for (int it = gw; it < DEPTH * IT; it += NGW) {
        const int l = it / IT, r = it % IT, gsrc = r / 16, kb = r % 16;
        int src = 64 * gsrc; if (src >= 1536) src += 16;
        const int n0 = src < 1536 ? src : src + 240;
        const float* W = (const float*)a.in[3] + (size_t)l * D * WIN_N + src;
        cmax_item64(W, WIN_N, n0 < 256 ? 0.125f : 1.f, n0, 64 * kb, lane, cmaxb + (size_t)l * NP);
    }
    constexpr int ITB = 3 * 16 * 8;
    for (int it = gw; it < DEPTH * ITB; it += NGW) {
        const int l = it / ITB, r = it % ITB, b = r / 128, g = (r / 8) & 15, kb = r % 8;
        const float* W = (const float*)a.in[16] + ((size_t)l * 3 + b) * 512 * D + 64 * g;
        cmax_item64(W, D, 1.f, 64 * g, 64 * kb, lane, cmaxb + (CW_CMAX3 - CW_CMAX) + ((size_t)l * 3 + b) * 1024);
    }
    constexpr int ITG = NE * 2 * 8 * 16;
    for (int it = gw; it < DEPTH * ITG; it += NGW) {
        const int l = it / ITG, r = it % ITG, e = r / 256, isup = (r / 128) & 1, cg = (r / 16) & 7, kb = r % 16;
        const float* W = (isup ? (const float*)a.in[22] : (const float*)a.in[21]) + ((size_t)l * NE + e) * D * FF;
        cmax_item64gu(W, FF, 64 * cg, isup, 64 * kb, lane, cmaxb + (CW_CMAX2 - CW_CMAX) + ((size_t)l * NE + e) * 1024);
    }
    for (int idx = gtid; idx < DEPTH * 256 * D; idx += NGT) {
        const int l = idx / (256 * D), j = (idx / D) % 256, k = idx % D;
        const float* W = (const float*)a.in[3] + (size_t)l * D * WIN_N + (size_t)k * WIN_N + 1536;
        const float* gu = (const float*)a.in[4] + (size_t)l * 16 * 256 + j;
        float s = 0.f;
#pragma unroll
        for (int r = 0; r < 16; ++r) s += W[r] * gu[r * 256];
        tmpf[idx] = s;
        float m = fabsf(s); m = wave_max(m);
        if (lane == 0) atomicMax(cmaxb + (size_t)l * NP + C_GP + j, __float_as_uint(m));
    }
}
__device__ __forceinline__ void phase_prep(const Args& a, const float* tmpf, const unsigned* cmaxb, LAS unsigned char* lds, int gw, int NGW, int wave, int lane, int gtid, int NGT) {
    LAS float* scr = (LAS float*)(lds + wave * 17408);
    for (int it = gw; it < DEPTH * IT_LAYER; it += NGW) {
        const int l = it / IT_LAYER; int r = it % IT_LAYER;
        unsigned char* lw = a.ws + WS_W + (size_t)l * LW_SIZE;
        if (r < IT_WIN) {
            const int g = r / 16, kb = r % 16;
            if (g >= C_GP / 64 && g < C_XB / 64) continue;
            const int n0 = 64 * g, src = n0 < C_GP ? n0 : n0 - 240;
            const float* W = (const float*)a.in[3] + (size_t)l * D * WIN_N + src;
            tr_item64q(W, W + 32, WIN_N, n0 < 256 ? 0.125f : 1.f, (signed char*)(lw + LW_WIN), D, n0, 64 * kb, scr, lane, cmaxb + (size_t)l * NP, DMapId());
            continue; }
        r -= IT_WIN;
        if (r < IT_WBR) {
            const int b = r / 128, g = (r % 128) / 8, kb = r % 8;
            const float* W = (const float*)a.in[16] + ((size_t)l * 3 + b) * 512 * D + 64 * g;
            tr_item64q(W, W + 32, D, 1.f, (signed char*)(lw + LW_WBR) + (size_t)b * D * 512, 512, 64 * g, 64 * kb, scr, lane, cmaxb + (CW_CMAX3 - CW_CMAX) + ((size_t)l * 3 + b) * 1024, DMapId());
            continue; }
        r -= IT_WBR;
        if (r < IT_WOUT) {
            const int g = r / 16, kb = r % 16;
            const float* W = (const float*)a.in[17] + (size_t)l * D * D + 64 * g;
            tr_item64(W, W + 32, D, 1.f, (bf16_t*)(lw + LW_WOUT), D, 64 * g, 64 * kb, scr, lane, DMapId());
            continue; }
        r -= IT_WOUT;
        if (r < IT_WGU) {
            const int e = r / 256, g = (r % 256) / 16, kb = r % 16;
            const float* Wg = (const float*)a.in[21] + ((size_t)l * NE + e) * D * FF + 32 * g;
            const float* Wu = (const float*)a.in[22] + ((size_t)l * NE + e) * D * FF + 32 * g;
            tr_item64q(Wg, Wu, FF, 1.f, (signed char*)(lw + LW_WGU) + (size_t)e * 1024 * D, D, 64 * g, 64 * kb, scr, lane, cmaxb + (CW_CMAX2 - CW_CMAX) + ((size_t)l * NE + e) * 1024, DMapGU());
            continue; }
        r -= IT_WGU;
        {
            const int e = r / 128, g = (r % 128) / 8, kb = r % 8;
            const float* W = (const float*)a.in[23] + ((size_t)l * NE + e) * FF * D + 64 * g;
            tr_item64(W, W + 32, D, 1.f, (bf16_t*)(lw + LW_WDN) + (size_t)e * D * FF, FF, 64 * g, 64 * kb, scr, lane, DMapId());
        }
    }
    for (int idx = gtid; idx < DEPTH * 256 * (D / 16); idx += NGT) {
        const int l = idx / (256 * (D / 16)), j = (idx / (D / 16)) % 256, k16 = idx % (D / 16);
        const float mx = __uint_as_float(cmaxb[(size_t)l * NP + C_GP + j]); const float inv = mx > 0.f ? 127.f / mx : 0.f;
        const f32x4* t = (const f32x4*)(tmpf + ((size_t)l * 256 + j) * D + 16 * k16);
        unsigned w[4];
#pragma unroll
        for (int k = 0; k < 4; ++k) { const f32x4 v = t[k]; const int q0 = (int)__builtin_rintf(v.x * inv), q1 = (int)__builtin_rintf(v.y * inv), q2 = (int)__builtin_rintf(v.z * inv), q3 = (int)__builtin_rintf(v.w * inv);
            w[k] = (unsigned)(q0 & 0xff) | ((unsigned)(q1 & 0xff) << 8) | ((unsigned)(q2 & 0xff) << 16) | ((unsigned)(q3 & 0xff) << 24); }
        u32x4 o; o.x = w[0]; o.y = w[1]; o.z = w[2]; o.w = w[3];
        *(u32x4*)((signed char*)(a.ws + WS_W + (size_t)l * LW_SIZE + LW_WIN) + (size_t)(C_GP + j) * D + 16 * k16) = o;
    }
}

__device__ __forceinline__ void moe_tables(const unsigned* cnt, LAS int* pt, LAS int* lc, int tid) {
    if (tid == 0) { int s = 0;
        for (int e = 0; e < NE; ++e) { const int c = (int)__hip_atomic_load(cnt + e, __ATOMIC_RELAXED, __HIP_MEMORY_SCOPE_AGENT); pt[e] = s; lc[e] = c; s += (c + 255) >> 8; }
        pt[NE] = s; }
    __syncthreads();
}

template <bool COMBINE, bool NORM, bool SRC_BF16>
__device__ __forceinline__ void phase_norm1(const Ctx& c, const float* gain, LAS const int* pt) {
    const int gw = c.bid * NWAVES + c.wave, NGW = c.G * NWAVES, lane = c.lane;
    f32x4 g4[4];
    if (NORM) {
#pragma unroll
        for (int j = 0; j < 4; ++j) g4[j] = *((const f32x4*)gain + 64 * j + lane); }
    constexpr int NR = 4;
    static_assert(TT % (NR * 2048) == 0, "rows per wave");
    for (int tok0 = gw; tok0 < TT; tok0 += NR * NGW) {
        f32x4 v[NR][4]; u32x2 xs[NR][4]; u32x2 ya[NR][4], yb[NR][4]; float w0[NR], w1[NR];
#pragma unroll
        for (int r = 0; r < NR; ++r) { const int tok = tok0 + r * NGW;
            if (SRC_BF16) { const u32x2* xr = (const u32x2*)(c.xb + (size_t)tok * D) + lane;
#pragma unroll
                for (int j = 0; j < 4; ++j) xs[r][j] = xr[64 * j]; }
            else { const f32x4* xr = (const f32x4*)(c.xinf + (size_t)tok * D) + lane;
#pragma unroll
                for (int j = 0; j < 4; ++j) v[r][j] = xr[64 * j]; }
            if (COMBINE) {
                const u32x4 rc = *(const u32x4*)(c.rec + (size_t)tok * 4);
                const int e0 = rc.x >> 20, e1 = rc.y >> 20;
                const size_t r0 = (size_t)pt[e0] * 256 + (rc.x & 0xfffffu), r1 = (size_t)pt[e1] * 256 + (rc.y & 0xfffffu);
                w0[r] = __uint_as_float(rc.z); w1[r] = __uint_as_float(rc.w);
                const u32x2* y0 = (const u32x2*)(c.ys + r0 * D) + lane; const u32x2* y1 = (const u32x2*)(c.ys + r1 * D) + lane;
#pragma unroll
                for (int j = 0; j < 4; ++j) { ya[r][j] = y0[64 * j]; yb[r][j] = y1[64 * j]; }
            } }
#pragma unroll
        for (int r = 0; r < NR; ++r) { const int tok = tok0 + r * NGW;
            if (SRC_BF16) {
#pragma unroll
                for (int j = 0; j < 4; ++j) { v[r][j].x = bflo(xs[r][j].x); v[r][j].y = bfhi(xs[r][j].x); v[r][j].z = bflo(xs[r][j].y); v[r][j].w = bfhi(xs[r][j].y); } }
            if (COMBINE) {
#pragma unroll
                for (int j = 0; j < 4; ++j) { const u32x2 a = ya[r][j], b = yb[r][j];
                    v[r][j].x += w0[r] * bflo(a.x) + w1[r] * bflo(b.x); v[r][j].y += w0[r] * bfhi(a.x) + w1[r] * bfhi(b.x);
                    v[r][j].z += w0[r] * bflo(a.y) + w1[r] * bflo(b.y); v[r][j].w += w0[r] * bfhi(a.y) + w1[r] * bfhi(b.y); }
                if (NORM) { u32x2* xw = (u32x2*)(c.x2 + (size_t)tok * D) + lane;
#pragma unroll
                    for (int j = 0; j < 4; ++j) { u32x2 w; w.x = pk2(v[r][j].x, v[r][j].y); w.y = pk2(v[r][j].z, v[r][j].w); xw[64 * j] = w; } }
                else { f32x4* xw = (f32x4*)(c.xof + (size_t)tok * D) + lane;
#pragma unroll
                    for (int j = 0; j < 4; ++j) __builtin_nontemporal_store(v[r][j], xw + 64 * j); }
            }
            if (NORM) {
                float ss = 0.f;
#pragma unroll
                for (int j = 0; j < 4; ++j) ss += (v[r][j].x * v[r][j].x + v[r][j].y * v[r][j].y) + (v[r][j].z * v[r][j].z + v[r][j].w * v[r][j].w);
                const float rs = rsqf_(wave_sum(ss) * (1.f / D) + RMS_EPS);
                float am = 0.f;
#pragma unroll
                for (int j = 0; j < 4; ++j) { v[r][j] = v[r][j] * rs * g4[j]; am = fmaxf(am, fmaxf(fmaxf(fabsf(v[r][j].x), fabsf(v[r][j].y)), fmaxf(fabsf(v[r][j].z), fabsf(v[r][j].w)))); }
                am = wave_max(am);
                const float inv = am > 0.f ? 127.f / am : 0.f;
                if (lane == 0) c.sa[tok] = am * (1.f / 127.f);
                unsigned* o = (unsigned*)((signed char*)c.actf + ((size_t)(tok / TC) * TC * 2 + (size_t)(tok % TC)) * D) + lane;
#pragma unroll
                for (int j = 0; j < 4; ++j) { const int q0 = (int)__builtin_rintf(v[r][j].x * inv), q1 = (int)__builtin_rintf(v[r][j].y * inv), q2 = (int)__builtin_rintf(v[r][j].z * inv), q3 = (int)__builtin_rintf(v[r][j].w * inv);
                    o[64 * j] = (unsigned)(q0 & 0xff) | ((unsigned)(q1 & 0xff) << 8) | ((unsigned)(q2 & 0xff) << 16) | ((unsigned)(q3 & 0xff) << 24); }
            } }
    }
}

__constant__ double kInvFreq[16] = {1.0, 0.44036660267178046, 0.19392274474868576, 0.08539710028576561, 0.03760603093086393, 0.016560440080994446, 0.007292664737217109, 0.003211445994752591,
    0.001414213562373095, 0.000622772421914596, 0.0002742481756762073, 0.00012076973741146504, 5.318295896944988e-05, 2.341999896140934e-05, 1.031338537721246e-05, 4.5416704806078695e-06};
__device__ __forceinline__ void phase_rope_table(const int* pos, float* tab, int gtid, int NGT) {
    for (int idx = gtid; idx < BATCH * SEQ * 16; idx += NGT) { const int tok = idx >> 4, i = idx & 15;
        double a = (double)pos[tok] * kInvFreq[i] * 0.15915494309189535; a -= rint(a);
        tab[(size_t)tok * 32 + i] = __builtin_amdgcn_cosf((float)a); tab[(size_t)tok * 32 + 16 + i] = __builtin_amdgcn_sinf((float)a); }
}

__device__ __forceinline__ float logsigmoidf_(float g) { return fminf(g, 0.f) - log1pf(__expf(-fabsf(g))); }
__device__ __forceinline__ float gelu_tanh(float y) { const float u2 = 1.5957691216057308f * (y + 0.044715f * y * y * y); return y * __builtin_amdgcn_rcpf(1.f + __expf(-u2)); }


typedef unsigned short u16x4 __attribute__((ext_vector_type(4)));
__device__ __forceinline__ unsigned offb(unsigned row, unsigned ch) { return 256u * row + 16u * (ch ^ (((row & 3u) << 2) | ((row >> 2) & 3u))); }
constexpr int ATT_UNITS_PER_SEQ = 3 * 4 * 16;
struct AttU { int b, p, h, blk, dsh, it0; size_t tok0; int qcol, kcol, vcol; };
__device__ __forceinline__ AttU att_decode(int unit) {
    AttU a; a.b = unit / ATT_UNITS_PER_SEQ; const int rem = unit % ATT_UNITS_PER_SEQ; a.p = rem / 64; a.h = (rem / 16) & 3; const int qb = rem & 15;
    a.dsh = 2 * a.p; const int nblk = 16 >> a.dsh, r = qb / nblk; a.blk = qb % nblk; a.tok0 = (size_t)a.b * SEQ + r; a.it0 = a.blk == 0 ? 4 : 0;
    a.qcol = C_QKV + (a.p * 4 + a.h) * 128; a.kcol = C_QKV + (12 + a.p * 4 + a.h) * 128; a.vcol = C_QKV + (24 + a.p * 4 + a.h) * 128; return a;
}
#define ATT_DMA(U, col, dst) do { const unsigned _ch = ((unsigned)lane & 15u) ^ ((((unsigned)lane >> 4) << 2) | ((unsigned)w & 3u)); \
        const int _srow0 = ((U).blk - 1) * 128 + 4 * w + (lane >> 4); \
        const bf16_t* _p0 = c.proj + ((long)(U).tok0 + (long)_srow0 * (long)(1 << (U).dsh)) * NP + (col) + _ch * 8; const size_t _st = ((size_t)32 << (U).dsh) * NP; \
        _Pragma("unroll") for (int it = 0; it < 8; ++it) if (it >= (U).it0) \
            __builtin_amdgcn_global_load_lds((const unsigned*)(_p0 + it * _st), (LAS unsigned*)((dst) + 1024 * (w + 8 * it)), 16, 0, 0); } while (0)
#define ATT_LOADQ(U) do { const size_t qt = (U).tok0 + ((size_t)((U).blk * 128 + qi) << (U).dsh); \
        _Pragma("unroll") for (int s = 0; s < 4; ++s) qr[s] = *(const u32x4*)(c.proj + qt * NP + (U).qcol + 32 * s + 8 * g); \
        const f32x4* rt = (const f32x4*)(rope_tab + qt * 32 + 8 * (g & 1)); qc0 = rt[0]; qc1 = rt[1]; qs0 = rt[4]; qs1 = rt[5]; \
        int srow = ((U).blk - 1) * 128 + (int)rrow; if (srow < 0) srow += 128; \
        const float* rt2 = rope_tab + ((U).tok0 + ((size_t)srow << (U).dsh)) * 32 + 8 * rps; \
        rc0 = *(const f32x4*)rt2; rc1 = *(const f32x4*)(rt2 + 4); rs0 = *(const f32x4*)(rt2 + 16); rs1 = *(const f32x4*)(rt2 + 20); } while (0)
__device__ __forceinline__ void attn_loop(const Ctx& c, unsigned* qhead, volatile LAS unsigned* mbox, float* lse_buf, const float* qgain, const float* kgain, const float* rope_tab  ) {
    const int tid = c.tid, lane = c.lane, w = c.wave;
    const unsigned NU = (unsigned)(BC * ATT_UNITS_PER_SEQ);
    LAS unsigned char* sK = c.lds; LAS unsigned char* sV = c.lds + 65536;
    LAS float* sRS = (LAS float*)(c.lds + MISC_OFF + 2048);
    const int qq = lane & 15, g = lane >> 4, qi = 16 * w + qq;
    const unsigned rrow = (unsigned)tid >> 1, rps = (unsigned)tid & 1u;
#if defined(PROBE_MASK) && PROBE_MASK
    unsigned long long _ta = __builtin_amdgcn_s_memrealtime();
#define ATT_STAMP(k) do { const unsigned long long _tb = __builtin_amdgcn_s_memrealtime(); if (blockIdx.x == PROBE_BLOCK && tid == 0) ((LAS unsigned*)(c.lds + MISC_OFF + 512))[(k)] += (unsigned)(_tb - _ta); _ta = _tb; } while (0)
#else
#define ATT_STAMP(k) do {} while (0)
#endif
    LAS float* sGQ = (LAS float*)(c.lds + MISC_OFF + 3072); LAS float* sGK = sGQ + 128;
    if (tid < 128) sGQ[tid] = qgain[tid]; else if (tid < 256) sGK[tid - 128] = kgain[tid - 128];
    if (tid == 0) { mbox[0] = __hip_atomic_fetch_add(qhead, 1u, __ATOMIC_RELAXED, __HIP_MEMORY_SCOPE_AGENT); mbox[1] = __hip_atomic_fetch_add(qhead, 1u, __ATOMIC_RELAXED, __HIP_MEMORY_SCOPE_AGENT); }
    __syncthreads();
    unsigned ucur = mbox[0], unxt = mbox[1];
    if (ucur >= NU) return;
    AttU U = att_decode((int)ucur);
    u32x4 qr[4]; f32x4 qc0, qc1, qs0, qs1, rc0, rc1, rs0, rs1;
    __syncthreads();
    ATT_DMA(U, U.kcol, sK); asm volatile("" ::: "memory");
    ATT_LOADQ(U); asm volatile("" ::: "memory");
    ATT_DMA(U, U.vcol, sV); asm volatile("" ::: "memory");
    bool first = true; unsigned nq = 0u;
    for (;;) {
        const int blk = U.blk, dsh = U.dsh, it0 = U.it0;
        const size_t qtok = U.tok0 + ((size_t)(blk * 128 + qi) << dsh);
        bf16x8 qf[4];
        {
            float qv[4][8]; float ss = 0.f;
#pragma unroll
            for (int s = 0; s < 4; ++s) { const unsigned wv[4] = {qr[s].x, qr[s].y, qr[s].z, qr[s].w};
#pragma unroll
                for (int k = 0; k < 4; ++k) { qv[s][2 * k] = bflo(wv[k]); qv[s][2 * k + 1] = bfhi(wv[k]); ss += qv[s][2 * k] * qv[s][2 * k] + qv[s][2 * k + 1] * qv[s][2 * k + 1]; } }
            ss += swz_xor<16>(ss);
            { const auto rr = __builtin_amdgcn_permlane32_swap(__float_as_uint(ss), __float_as_uint(ss), false, false); ss = __uint_as_float(rr[0]) + __uint_as_float(rr[1]); }
            const float rs = rsqf_(ss * (1.f / 128.f) + RMS_EPS);
#pragma unroll
            for (int s = 0; s < 4; ++s) { const f32x4 g0 = *(const LAS f32x4*)(sGQ + 32 * s + 8 * g), g1 = *(const LAS f32x4*)(sGQ + 32 * s + 8 * g + 4);
                const float gg[8] = {g0.x, g0.y, g0.z, g0.w, g1.x, g1.y, g1.z, g1.w};
#pragma unroll
                for (int j = 0; j < 8; ++j) qv[s][j] *= rs * gg[j]; }
            { const float cs8[8] = {qc0.x, qc0.y, qc0.z, qc0.w, qc1.x, qc1.y, qc1.z, qc1.w}, sn8[8] = {qs0.x, qs0.y, qs0.z, qs0.w, qs1.x, qs1.y, qs1.z, qs1.w};
              const float sgn = (g & 2) ? 1.f : -1.f;
#pragma unroll
              for (int j = 0; j < 8; ++j) { const auto rr = __builtin_amdgcn_permlane32_swap(__float_as_uint(qv[0][j]), __float_as_uint(qv[0][j]), false, false);
                  const float other = (g & 2) ? __uint_as_float(rr[0]) : __uint_as_float(rr[1]);
                  qv[0][j] = qv[0][j] * cs8[j] + sgn * other * sn8[j]; } }
#pragma unroll
            for (int s = 0; s < 4; ++s) { u32x4 pw; pw.x = pk2(qv[s][0], qv[s][1]); pw.y = pk2(qv[s][2], qv[s][3]); pw.z = pk2(qv[s][4], qv[s][5]); pw.w = pk2(qv[s][6], qv[s][7]); qf[s] = __builtin_bit_cast(bf16x8, pw); }
        }
        const f32x4 kc0 = rc0, kc1 = rc1, ks0v = rs0, ks1v = rs1;
        if (first) { if (it0) asm volatile("s_waitcnt vmcnt(4)" ::: "memory"); else asm volatile("s_waitcnt vmcnt(8)" ::: "memory"); }
        else       { if (it0) asm volatile("s_waitcnt vmcnt(13)" ::: "memory"); else asm volatile("s_waitcnt vmcnt(17)" ::: "memory"); }
        first = false;
        __syncthreads();
        if (tid == 0) nq = __hip_atomic_fetch_add(qhead, 1u, __ATOMIC_RELAXED, __HIP_MEMORY_SCOPE_AGENT);
        ATT_STAMP(5);
        {
            const int c16 = tid & 15, grp = tid >> 4;
            const f32x4 kg0 = *(const LAS f32x4*)(sGK + 8 * c16), kg1 = *(const LAS f32x4*)(sGK + 8 * c16 + 4);
            const float kg[8] = {kg0.x, kg0.y, kg0.z, kg0.w, kg1.x, kg1.y, kg1.z, kg1.w};
#pragma unroll 4
            for (int it = it0; it < 8; ++it) { const unsigned row = 32u * it + grp;
                LAS u32x4* kp_ = (LAS u32x4*)(sK + offb(row, c16));
                const u32x4 kr = *kp_; const unsigned wv[4] = {kr.x, kr.y, kr.z, kr.w};
                float kv[8]; float ss = 0.f;
#pragma unroll
                for (int k = 0; k < 4; ++k) { kv[2 * k] = bflo(wv[k]); kv[2 * k + 1] = bfhi(wv[k]); ss += kv[2 * k] * kv[2 * k] + kv[2 * k + 1] * kv[2 * k + 1]; }
                ss += swz_xor<1>(ss); ss += swz_xor<2>(ss); ss += swz_xor<4>(ss); ss += swz_xor<8>(ss);
                const float rs = rsqf_(ss * (1.f / 128.f) + RMS_EPS);
                if (c16 == 0) sRS[row] = rs;
                if (c16 >= 4) { u32x4 ko; ko.x = pk2(kv[0] * rs * kg[0], kv[1] * rs * kg[1]); ko.y = pk2(kv[2] * rs * kg[2], kv[3] * rs * kg[3]); ko.z = pk2(kv[4] * rs * kg[4], kv[5] * rs * kg[5]); ko.w = pk2(kv[6] * rs * kg[6], kv[7] * rs * kg[7]); *kp_ = ko; } }
        }
        __syncthreads();
        {
            const f32x4 ga0 = *(const LAS f32x4*)(sGK + 8 * rps), ga1 = *(const LAS f32x4*)(sGK + 8 * rps + 4), gb0 = *(const LAS f32x4*)(sGK + 16 + 8 * rps), gb1 = *(const LAS f32x4*)(sGK + 20 + 8 * rps);
            const float ga[8] = {ga0.x, ga0.y, ga0.z, ga0.w, ga1.x, ga1.y, ga1.z, ga1.w}, gb[8] = {gb0.x, gb0.y, gb0.z, gb0.w, gb1.x, gb1.y, gb1.z, gb1.w};
            const float cs8[8] = {kc0.x, kc0.y, kc0.z, kc0.w, kc1.x, kc1.y, kc1.z, kc1.w}, sn8[8] = {ks0v.x, ks0v.y, ks0v.z, ks0v.w, ks1v.x, ks1v.y, ks1v.z, ks1v.w};
            if (blk > 0 || rrow >= 128u) {
            LAS u32x4* p1 = (LAS u32x4*)(sK + offb(rrow, rps)); LAS u32x4* p2 = (LAS u32x4*)(sK + offb(rrow, rps + 2));
            const u32x4 a = *p1, b2 = *p2; const float rs = sRS[rrow];
            const unsigned wa[4] = {a.x, a.y, a.z, a.w}, wb[4] = {b2.x, b2.y, b2.z, b2.w};
            float o1[8], o2[8];
#pragma unroll
            for (int k = 0; k < 4; ++k) {
#pragma unroll
                for (int e = 0; e < 2; ++e) { const int j = 2 * k + e; const float x1 = (e ? bfhi(wa[k]) : bflo(wa[k])) * rs * ga[j], x2 = (e ? bfhi(wb[k]) : bflo(wb[k])) * rs * gb[j];
                    o1[j] = x1 * cs8[j] - x2 * sn8[j]; o2[j] = x2 * cs8[j] + x1 * sn8[j]; } }
            u32x4 w1, w2; w1.x = pk2(o1[0], o1[1]); w1.y = pk2(o1[2], o1[3]); w1.z = pk2(o1[4], o1[5]); w1.w = pk2(o1[6], o1[7]); w2.x = pk2(o2[0], o2[1]); w2.y = pk2(o2[2], o2[3]); w2.z = pk2(o2[4], o2[5]); w2.w = pk2(o2[6], o2[7]);
            *p1 = w1; *p2 = w2; }
        }
        __syncthreads();
        ATT_STAMP(6);
        const int ks0 = w >> 1, nskip = blk == 0 ? 4 : 0;
        f32x4 st[5][2];
        const unsigned krow_l = 8u * (qq >> 2) + (qq & 3u);
        LAS unsigned char* ka[2][4];
#pragma unroll
        for (int T = 0; T < 2; ++T)
#pragma unroll
            for (int s = 0; s < 4; ++s) ka[T][s] = sK + offb(32u * ks0 + krow_l + 4u * T, 4 * s + g);
#pragma unroll
        for (int n = 0; n < 5; ++n)
#pragma unroll
            for (int T = 0; T < 2; ++T) { f32x4 a = {0.f, 0.f, 0.f, 0.f};
                if (ks0 + n >= nskip) {
#pragma unroll
                for (int s = 0; s < 4; ++s) { const bf16x8 kf = *(const LAS bf16x8*)(ka[T][s] + 8192 * n); a = __builtin_amdgcn_mfma_f32_16x16x32_bf16(kf, qf[s], a, 0, 0, 0); } }
                st[n][T] = a; }
        asm volatile("s_waitcnt vmcnt(0) lgkmcnt(0)" ::: "memory");
        if (tid == 0) mbox[0] = nq;
        __syncthreads();
        const bool has_next = unxt < NU;
        AttU UN = att_decode(has_next ? (int)unxt : 0);
        if (has_next) { ATT_DMA(UN, UN.kcol, sK); asm volatile("" ::: "memory"); ATT_LOADQ(UN); }
        asm volatile("" ::: "memory");
        const float SC = 0.08838834764831845f * 1.4426950408889634f;
        float mx = -INFINITY;
#pragma unroll
        for (int n = 0; n < 5; ++n)
#pragma unroll
            for (int T = 0; T < 2; ++T)
#pragma unroll
                for (int i = 0; i < 4; ++i) { const int kj = 32 * (ks0 + n) + 8 * g + 4 * T + i;
                    bool ok = true;
                    if (n == 0) ok = kj >= qi;
                    if (n == 4) ok = kj <= qi + 128;
                    if (blk == 0) ok = ok && (kj >= 128);
                    const float v = ok ? st[n][T][i] : -INFINITY; st[n][T][i] = v; mx = fmaxf(mx, v); }
        mx = fmaxf(mx, swz_xor<16>(mx));
        { const auto rr = __builtin_amdgcn_permlane32_swap(__float_as_uint(mx), __float_as_uint(mx), false, false); mx = fmaxf(__uint_as_float(rr[0]), __uint_as_float(rr[1])); }
        float sum = 0.f; const float mxs = mx * SC;
#pragma unroll
        for (int n = 0; n < 5; ++n)
#pragma unroll
            for (int T = 0; T < 2; ++T)
#pragma unroll
                for (int i = 0; i < 4; ++i) { const float e = __builtin_amdgcn_exp2f(__builtin_fmaf(st[n][T][i], SC, -mxs)); st[n][T][i] = e; sum += e; }
        sum += swz_xor<16>(sum);
        { const auto rr = __builtin_amdgcn_permlane32_swap(__float_as_uint(sum), __float_as_uint(sum), false, false); sum = __uint_as_float(rr[0]) + __uint_as_float(rr[1]); }
        const float inv = rcpf_(sum);
        ATT_STAMP(7);
        f32x4 ot[8];
#pragma unroll
        for (int cc = 0; cc < 8; ++cc) ot[cc] = (f32x4){0.f, 0.f, 0.f, 0.f};
        const unsigned tq = (unsigned)qq >> 2, tp = (unsigned)qq & 3u;
        const unsigned vbase = (unsigned)(size_t)sV;
        unsigned va[2][8];
#pragma unroll
        for (int t = 0; t < 2; ++t)
#pragma unroll
            for (int cc = 0; cc < 8; ++cc) va[t][cc] = vbase + offb(32u * ks0 + 8u * g + 4u * t + tq, 2 * cc + (tp >> 1)) + 8u * (tp & 1u);
#pragma unroll
        for (int n = 0; n < 5; ++n) if (ks0 + n >= nskip) {
            u32x4 pw; pw.x = pk2(st[n][0][0], st[n][0][1]); pw.y = pk2(st[n][0][2], st[n][0][3]); pw.z = pk2(st[n][1][0], st[n][1][1]); pw.w = pk2(st[n][1][2], st[n][1][3]);
            const bf16x8 pf = __builtin_bit_cast(bf16x8, pw);
            u16x4 v0[8], v1[8];
            asm volatile("ds_read_b64_tr_b16 %0, %16 offset:%32\n\tds_read_b64_tr_b16 %8, %24 offset:%32\n\t"
                         "ds_read_b64_tr_b16 %1, %17 offset:%32\n\tds_read_b64_tr_b16 %9, %25 offset:%32\n\t"
                         "ds_read_b64_tr_b16 %2, %18 offset:%32\n\tds_read_b64_tr_b16 %10, %26 offset:%32\n\t"
                         "ds_read_b64_tr_b16 %3, %19 offset:%32\n\tds_read_b64_tr_b16 %11, %27 offset:%32\n\t"
                         "ds_read_b64_tr_b16 %4, %20 offset:%32\n\tds_read_b64_tr_b16 %12, %28 offset:%32\n\t"
                         "ds_read_b64_tr_b16 %5, %21 offset:%32\n\tds_read_b64_tr_b16 %13, %29 offset:%32\n\t"
                         "ds_read_b64_tr_b16 %6, %22 offset:%32\n\tds_read_b64_tr_b16 %14, %30 offset:%32\n\t"
                         "ds_read_b64_tr_b16 %7, %23 offset:%32\n\tds_read_b64_tr_b16 %15, %31 offset:%32\n\t"
                         "s_waitcnt lgkmcnt(0)"
                         : "=&v"(v0[0]), "=&v"(v0[1]), "=&v"(v0[2]), "=&v"(v0[3]), "=&v"(v0[4]), "=&v"(v0[5]), "=&v"(v0[6]), "=&v"(v0[7]),
                           "=&v"(v1[0]), "=&v"(v1[1]), "=&v"(v1[2]), "=&v"(v1[3]), "=&v"(v1[4]), "=&v"(v1[5]), "=&v"(v1[6]), "=&v"(v1[7])
                         : "v"(va[0][0]), "v"(va[0][1]), "v"(va[0][2]), "v"(va[0][3]), "v"(va[0][4]), "v"(va[0][5]), "v"(va[0][6]), "v"(va[0][7]),
                           "v"(va[1][0]), "v"(va[1][1]), "v"(va[1][2]), "v"(va[1][3]), "v"(va[1][4]), "v"(va[1][5]), "v"(va[1][6]), "v"(va[1][7]), "i"(8192 * n) : "memory");
#pragma unroll
            for (int cc = 0; cc < 8; ++cc) {
                bf16x8 vf; vf[0] = (short)v0[cc][0]; vf[1] = (short)v0[cc][1]; vf[2] = (short)v0[cc][2]; vf[3] = (short)v0[cc][3]; vf[4] = (short)v1[cc][0]; vf[5] = (short)v1[cc][1]; vf[6] = (short)v1[cc][2]; vf[7] = (short)v1[cc][3];
                ot[cc] = __builtin_amdgcn_mfma_f32_16x16x32_bf16(vf, pf, ot[cc], 0, 0, 0);
            }
        }
        __syncthreads();
        asm volatile("" ::: "memory");
        if (has_next) ATT_DMA(UN, UN.vcol, sV);
        asm volatile("" ::: "memory");
        bf16_t* orow = c.proj + qtok * NP + U.qcol;
#pragma unroll
        for (int cc = 0; cc < 8; ++cc) { u32x2 o; o.x = pk2(ot[cc][0] * inv, ot[cc][1] * inv); o.y = pk2(ot[cc][2] * inv, ot[cc][3] * inv); *(u32x2*)(orow + 16 * cc + 4 * g) = o; }
        if (g == 0) lse_buf[qtok * 12 + U.p * 4 + U.h] = mx * 0.08838834764831845f + __logf(sum);
        ATT_STAMP(8);
        if (!has_next) break;
        U = UN; unxt = mbox[0];
    }
    asm volatile("s_waitcnt vmcnt(0)" ::: "memory");
    __syncthreads();
}
#undef ATT_STAMP
#undef ATT_DMA
#undef ATT_LOADQ

__device__ __forceinline__ unsigned short q2i8(float a, float b, float inv) { const int x = (int)__builtin_rintf(a * inv), y = (int)__builtin_rintf(b * inv); return (unsigned short)((x & 0xff) | ((y & 0xff) << 8)); }
__device__ __forceinline__ void phase_attn_combine(const Ctx& c, const float* lse_buf) {
    const int gw = c.bid * NWAVES + c.wave, NGW = c.G * NWAVES, lane = c.lane;
    constexpr int NR = 2;
    for (int tok0 = gw; tok0 < TC; tok0 += NR * NGW) {
        unsigned u[NR][3][4], ua[NR][4], ub[NR][4]; float l[NR][12];
#pragma unroll
        for (int r = 0; r < NR; ++r) { const int tok = tok0 + r * NGW;
            const float* ls = lse_buf + (size_t)tok * 12; const bf16_t* prow = c.proj + (size_t)tok * NP;
#pragma unroll
            for (int k = 0; k < 12; ++k) l[r][k] = ls[k];
#pragma unroll
            for (int p = 0; p < 3; ++p)
#pragma unroll
                for (int h = 0; h < 4; ++h) u[r][p][h] = *((const unsigned*)(prow + C_QKV + (4 * p + h) * 128) + lane);
#pragma unroll
            for (int h = 0; h < 4; ++h) { ua[r][h] = *((const unsigned*)(prow + C_OG + h * 128) + lane); ub[r][h] = *((const unsigned*)(prow + C_YB + h * 128) + lane); } }
#pragma unroll
        for (int r = 0; r < NR; ++r) { const int tok = tok0 + r * NGW;
            float c0[4], c1[4]; float mc = 0.f, ma = 0.f, mb = 0.f;
#pragma unroll
            for (int h = 0; h < 4; ++h) {
                const float l0 = l[r][h], l1 = l[r][4 + h], l2 = l[r][8 + h], ml = fmaxf(l0, fmaxf(l1, l2));
                const float w0 = __expf(l0 - ml), w1 = __expf(l1 - ml), w2 = __expf(l2 - ml), wi = rcpf_(w0 + w1 + w2);
                c0[h] = (w0 * bflo(u[r][0][h]) + w1 * bflo(u[r][1][h]) + w2 * bflo(u[r][2][h])) * wi; c1[h] = (w0 * bfhi(u[r][0][h]) + w1 * bfhi(u[r][1][h]) + w2 * bfhi(u[r][2][h])) * wi;
                mc = fmaxf(mc, fmaxf(fabsf(c0[h]), fabsf(c1[h])));
                ma = fmaxf(ma, fmaxf(fabsf(bflo(ua[r][h])), fabsf(bfhi(ua[r][h])))); mb = fmaxf(mb, fmaxf(fabsf(bflo(ub[r][h])), fabsf(bfhi(ub[r][h])))); }
            ma = wave_max(ma); mb = wave_max(mb); mc = wave_max(mc);
            const float ia = ma > 0.f ? 127.f / ma : 0.f, ib = mb > 0.f ? 127.f / mb : 0.f, ic = mc > 0.f ? 127.f / mc : 0.f;
            if (lane == 0) { c.sbr[tok] = ma * (1.f / 127.f); c.sbr[TC + tok] = mb * (1.f / 127.f); c.sbr[2 * TC + tok] = mc * (1.f / 127.f); }
            unsigned char* prow = (unsigned char*)(c.proj + (size_t)tok * NP);
#pragma unroll
            for (int h = 0; h < 4; ++h) {
                *((unsigned short*)(prow + C_OG * 2 + h * 128) + lane) = q2i8(bflo(ua[r][h]), bfhi(ua[r][h]), ia);
                *((unsigned short*)(prow + C_YB * 2 + h * 128) + lane) = q2i8(bflo(ub[r][h]), bfhi(ub[r][h]), ib);
                *((unsigned short*)(prow + C_QKV * 2 + h * 128) + lane) = q2i8(c0[h], c1[h], ic); } }
    }
}

__device__ __forceinline__ int crow(int reg, int hh) { return (reg & 3) + 8 * (reg >> 2) + 4 * hh; }
typedef float f32x16 __attribute__((ext_vector_type(16)));
__device__ __forceinline__ unsigned tr_addr32(unsigned lane, unsigned rowbase, unsigned cblk, unsigned t, bool perm) {
    const unsigned hh = lane >> 5, blk = (lane >> 4) & 1u, q = (lane & 15u) >> 2, p = lane & 3u;
    const unsigned row = rowbase + (perm ? 8u * t + 4u * hh : 8u * hh + 4u * t) + q;
    return offb(row, 4u * cblk + 2u * blk + (p >> 1)) + 8u * (p & 1u);
}
__device__ __forceinline__ bf16x8 tr_frag(unsigned a0, unsigned a1) {
    u16x4 v0, v1;
    asm volatile("ds_read_b64_tr_b16 %0, %2\n\tds_read_b64_tr_b16 %1, %3\n\ts_waitcnt lgkmcnt(0)" : "=&v"(v0), "=&v"(v1) : "v"(a0), "v"(a1) : "memory");
    bf16x8 f; f[0] = (short)v0[0]; f[1] = (short)v0[1]; f[2] = (short)v0[2]; f[3] = (short)v0[3]; f[4] = (short)v1[0]; f[5] = (short)v1[1]; f[6] = (short)v1[2]; f[7] = (short)v1[3];
    return f;
}
__device__ __forceinline__ void tr_frag4(const unsigned (&a)[8], bf16x8 (&f)[4]) {
    u16x4 v[8];
    asm volatile("ds_read_b64_tr_b16 %0, %8\n\tds_read_b64_tr_b16 %1, %9\n\tds_read_b64_tr_b16 %2, %10\n\tds_read_b64_tr_b16 %3, %11\n\t"
                 "ds_read_b64_tr_b16 %4, %12\n\tds_read_b64_tr_b16 %5, %13\n\tds_read_b64_tr_b16 %6, %14\n\tds_read_b64_tr_b16 %7, %15\n\ts_waitcnt lgkmcnt(0)"
                 : "=&v"(v[0]), "=&v"(v[1]), "=&v"(v[2]), "=&v"(v[3]), "=&v"(v[4]), "=&v"(v[5]), "=&v"(v[6]), "=&v"(v[7])
                 : "v"(a[0]), "v"(a[1]), "v"(a[2]), "v"(a[3]), "v"(a[4]), "v"(a[5]), "v"(a[6]), "v"(a[7]) : "memory");
#pragma unroll
    for (int k = 0; k < 4; ++k) { f[k][0] = (short)v[2 * k][0]; f[k][1] = (short)v[2 * k][1]; f[k][2] = (short)v[2 * k][2]; f[k][3] = (short)v[2 * k][3];
        f[k][4] = (short)v[2 * k + 1][0]; f[k][5] = (short)v[2 * k + 1][1]; f[k][6] = (short)v[2 * k + 1][2]; f[k][7] = (short)v[2 * k + 1][3]; }
}
constexpr int GLA_QK = 0, GLA_KD = 16384, GLA_V = 32768  , GLA_ST = 65536  , GLA_O = 102400  , GLA_SEG = 136192  , GLA_DEC = 138240  ;
static_assert(GLA_DEC + 256 <= RING_BYTES, "gla lds");
__device__ __forceinline__ void gla_unit(const Ctx& c, int unit, const float* gbias, const float* ogain) {
    const int tid = c.tid, lane = c.lane, w = c.wave;
    const int b = unit >> 2, h = unit & 3;
    LAS unsigned char* L = c.lds;
    const unsigned hh = lane >> 5, r31 = lane & 31;
    const int ti = w >> 2, tv = w & 3;
    f32x16 St;
#pragma unroll
    for (int i = 0; i < 16; ++i) St[i] = 0.f;
    for (int i = tid; i < 18432 / 4; i += NTHR) ((LAS unsigned*)(L + GLA_ST))[i] = 0u;
    const float bias_d = gbias[h * 64 + lane];
    const int i3 = tid >> 3, seg = tid & 7;
    float gn[16];
#pragma unroll
    for (int k = 0; k < 16; ++k) gn[k] = ogain[16 * seg + k];
    const size_t tokb = (size_t)b * SEQ;
    unsigned short pq[8], pk[8], pg[8];
    u32x4 ogc0, ogc1, ogn0, ogn1;
#define GLA_PREFETCH(n) do { _Pragma("unroll") for (int rr = 0; rr < 8; ++rr) { const bf16_t* row = c.proj + (tokb + (n) * 64 + 8 * w + rr) * NP + h * 64 + lane; \
        pq[rr] = row[C_QA]; pk[rr] = row[C_KA]; pg[rr] = row[C_GP]; } } while (0)
#define GLA_OG(n, d0, d1) do { const bf16_t* ogp = c.proj + (tokb + (n) * 64 + i3) * NP + C_OG + h * 128 + 16 * seg; d0 = *(const u32x4*)ogp; d1 = *((const u32x4*)ogp + 1); } while (0)
#define GLA_VDMA(n) do { _Pragma("unroll") for (int it = 0; it < 2; ++it) { const int q = w + 8 * it; const unsigned nn = 64u * q + lane, row = nn >> 4, cs = nn & 15u, ch = cs ^ (((row & 3u) << 2) | ((row >> 2) & 3u)); \
        __builtin_amdgcn_global_load_lds((const unsigned*)(c.proj + (tokb + (n) * 64 + row) * NP + C_VA + h * 128 + ch * 8), (LAS unsigned*)(L + GLA_V + ((n) & 1) * 16384 + 1024 * q), 16, 0, 0); } } while (0)
#define CB() asm volatile("" ::: "memory")
    GLA_PREFETCH(0); CB(); GLA_OG(0, ogc0, ogc1); CB(); GLA_VDMA(0); CB(); GLA_VDMA(1); CB();
    for (int n = 0; n < SEQ / 64; ++n) {
        LAS unsigned char* STr = L + GLA_ST + (n & 1) * 18432; LAS unsigned char* STw = L + GLA_ST + ((n + 1) & 1) * 18432;
        LAS unsigned char* Vb = L + GLA_V + (n & 1) * 16384;
        float cl[8], qv[8], kv[8];
        { float run = 0.f;
#pragma unroll
          for (int rr = 0; rr < 8; ++rr) { const float g = bf2f(pg[rr]) + bias_d; run += (fminf(g, 0.f) - __logf(1.f + __expf(-fabsf(g)))) * (1.f / 16.f); cl[rr] = run; qv[rr] = bf2f(pq[rr]); kv[rr] = bf2f(pk[rr]); }
          ((LAS float*)(L + GLA_SEG))[w * 64 + lane] = run; }
        __syncthreads();
        { float pre = 0.f, tot = 0.f;
#pragma unroll
          for (int s = 0; s < 8; ++s) { const float v = ((LAS float*)(L + GLA_SEG))[s * 64 + lane]; tot += v; pre += (s < w) ? v : 0.f; }
          const float etot = __expf(tot);
          if (w == 0) ((LAS float*)(L + GLA_DEC))[lane] = etot;
#pragma unroll
          for (int rr = 0; rr < 8; ++rr) { const float cum = pre + cl[rr]; const unsigned row = 8 * w + rr;
              const float e = __expf(cum), ei = rcpf_(e), ed = etot * ei;
              const unsigned o1 = offb(row, lane >> 3) + (lane & 7) * 2, o2 = offb(row, 8 + (lane >> 3)) + (lane & 7) * 2;
              *(LAS unsigned short*)(L + GLA_QK + o1) = (unsigned short)f2bf(qv[rr] * e);
              *(LAS unsigned short*)(L + GLA_QK + o2) = (unsigned short)f2bf(kv[rr] * ei);
              *(LAS unsigned short*)(L + GLA_KD + o1) = (unsigned short)f2bf(kv[rr] * ed); } }
        if (n == 0) asm volatile("s_waitcnt vmcnt(2)" ::: "memory"); else asm volatile("s_waitcnt vmcnt(4)" ::: "memory");
        __syncthreads();
        CB();
        if (n + 1 < SEQ / 64) { GLA_OG(n + 1, ogn0, ogn1); CB(); GLA_PREFETCH(n + 1); }
        CB();
        bf16x8 qdf[4];
#pragma unroll
        for (int s = 0; s < 4; ++s) qdf[s] = *(const LAS bf16x8*)(L + GLA_QK + offb(32 * ti + r31, 2 * s + hh));
        f32x16 Z;
#pragma unroll
        for (int i = 0; i < 16; ++i) Z[i] = 0.f;
        { bf16x8 sf[4];
#pragma unroll
          for (int s = 0; s < 4; ++s) sf[s] = *(const LAS bf16x8*)(STr + (32 * tv + r31) * 144 + 32 * s + 16 * hh);
#pragma unroll
          for (int s = 0; s < 4; ++s) Z = __builtin_amdgcn_mfma_f32_32x32x16_bf16(qdf[s], sf[s], Z, 0, 0, 0); }
        const unsigned vb = (unsigned)(size_t)Vb;
#pragma unroll
        for (int tj = 0; tj < 2; ++tj) {
            if (tj <= ti) {
                bf16x8 kf[4];
#pragma unroll
                for (int s = 0; s < 4; ++s) kf[s] = *(const LAS bf16x8*)(L + GLA_QK + offb(32 * tj + r31, 8 + 2 * s + hh));
                unsigned va[8]; bf16x8 vf[4];
#pragma unroll
                for (int s = 0; s < 2; ++s) { va[2 * s] = vb + tr_addr32(lane, 32 * tj + 16 * s, tv, 0, true); va[2 * s + 1] = vb + tr_addr32(lane, 32 * tj + 16 * s, tv, 1, true);
                    va[4 + 2 * s] = va[2 * s]; va[5 + 2 * s] = va[2 * s + 1]; }
                tr_frag4(va, vf);
                f32x16 X;
#pragma unroll
                for (int i = 0; i < 16; ++i) X[i] = 0.f;
#pragma unroll
                for (int s = 0; s < 4; ++s) X = __builtin_amdgcn_mfma_f32_32x32x16_bf16(kf[s], qdf[s], X, 0, 0, 0);
                const int ig = 32 * ti + (int)r31;
#pragma unroll
                for (int i = 0; i < 16; ++i) X[i] = (ig >= 32 * tj + crow(i, hh)) ? X[i] : 0.f;
#pragma unroll
                for (int s = 0; s < 2; ++s) {
                    u32x4 pw; pw.x = pg8::cvt_pk_bf16(X[8 * s + 0], X[8 * s + 1]); pw.y = pg8::cvt_pk_bf16(X[8 * s + 2], X[8 * s + 3]); pw.z = pg8::cvt_pk_bf16(X[8 * s + 4], X[8 * s + 5]); pw.w = pg8::cvt_pk_bf16(X[8 * s + 6], X[8 * s + 7]);
                    Z = __builtin_amdgcn_mfma_f32_32x32x16_bf16(__builtin_bit_cast(bf16x8, pw), vf[s], Z, 0, 0, 0);
                }
            }
        }
#pragma unroll
        for (int i = 0; i < 16; ++i) ((LAS float*)(L + GLA_O))[(32 * ti + crow(i, hh)) * 132 + 32 * tv + r31] = Z[i];
        { const unsigned kb = (unsigned)(size_t)(L + GLA_KD);
          unsigned aa[8], ab[8]; bf16x8 af[4], bfr[4];
#pragma unroll
          for (int s = 0; s < 4; ++s) { aa[2 * s] = kb + tr_addr32(lane, 16 * s, ti, 0, false); aa[2 * s + 1] = kb + tr_addr32(lane, 16 * s, ti, 1, false);
              ab[2 * s] = vb + tr_addr32(lane, 16 * s, tv, 0, false); ab[2 * s + 1] = vb + tr_addr32(lane, 16 * s, tv, 1, false); }
          tr_frag4(aa, af); tr_frag4(ab, bfr);
#pragma unroll
          for (int i = 0; i < 16; ++i) St[i] *= ((LAS float*)(L + GLA_DEC))[32 * ti + crow(i, hh)];
#pragma unroll
          for (int s = 0; s < 4; ++s) St = __builtin_amdgcn_mfma_f32_32x32x16_bf16(af[s], bfr[s], St, 0, 0, 0); }
#pragma unroll
        for (int gq = 0; gq < 4; ++gq) { const float s0 = St[4 * gq], s1 = St[4 * gq + 1], s2 = St[4 * gq + 2], s3 = St[4 * gq + 3];
            u32x2 o; o.x = pk2(s0, s1); o.y = pk2(s2, s3);
            *(LAS u32x2*)(STw + (32 * tv + r31) * 144 + (32 * ti + 8 * gq + 4 * hh) * 2) = o; }
        __syncthreads();
        CB();
        if (n + 2 < SEQ / 64) GLA_VDMA(n + 2);
        CB();
        { const LAS f32x4* op = (const LAS f32x4*)(L + GLA_O + i3 * 528 + seg * 64);
          f32x4 o4[4]; float ss = 0.f;
#pragma unroll
          for (int k = 0; k < 4; ++k) { o4[k] = op[k]; ss += (o4[k].x * o4[k].x + o4[k].y * o4[k].y) + (o4[k].z * o4[k].z + o4[k].w * o4[k].w); }
          ss += swz_xor<1>(ss); ss += swz_xor<2>(ss); ss += swz_xor<4>(ss);
          const float rs = rsqf_(ss * (1.f / 128.f) + RMS_EPS);
          const unsigned ogw[8] = {ogc0.x, ogc0.y, ogc0.z, ogc0.w, ogc1.x, ogc1.y, ogc1.z, ogc1.w};
          unsigned ow[8];
#pragma unroll
          for (int k = 0; k < 8; ++k) { const float g0 = bflo(ogw[k]), g1 = bfhi(ogw[k]);
              const float a0 = o4[k >> 1][(2 * k) & 3] * rs * gn[2 * k] * g0 * sigmoidf_(g0), a1 = o4[k >> 1][(2 * k + 1) & 3] * rs * gn[2 * k + 1] * g1 * sigmoidf_(g1);
              ow[k] = pk2(a0, a1); }
          u32x4 w0, w1; w0.x = ow[0]; w0.y = ow[1]; w0.z = ow[2]; w0.w = ow[3]; w1.x = ow[4]; w1.y = ow[5]; w1.z = ow[6]; w1.w = ow[7];
          bf16_t* dst = c.proj + (tokb + n * 64 + i3) * NP + C_OG + h * 128 + 16 * seg;
          *(u32x4*)dst = w0; *((u32x4*)dst + 1) = w1; }
        CB();
        ogc0 = ogn0; ogc1 = ogn1;
    }
    asm volatile("s_waitcnt vmcnt(0)" ::: "memory");
    __syncthreads();
#undef GLA_PREFETCH
#undef GLA_OG
#undef GLA_VDMA
#undef CB
}

constexpr int LRU_X = 0  , LRU_R = 16384  , LRU_I = 32768, LRU_SP = 49152  , LRU_SH = 51200;
__device__ __forceinline__ void lru_unit(const Ctx& c, int unit, const float* convw, const float* convb, const float* wa_, const float* ba_, const float* wx_, const float* bx_, const float* lam_) {
    const int lane = c.lane, w = c.wave;
    const int b = unit >> 3, nb = unit & 7, ch = nb * 64 + lane;
    LAS unsigned char* L = c.lds;
    const unsigned hh = lane >> 5, r31 = lane & 31;
    const int gate = w >> 2, tt = (w >> 1) & 1, td = w & 1;
    bf16x8 wf[4];
    { const float* W = (gate ? wx_ : wa_) + (size_t)nb * 4096 + 32 * td + r31;
#pragma unroll
      for (int s = 0; s < 4; ++s) { float t8[8];
#pragma unroll
          for (int jj = 0; jj < 8; ++jj) t8[jj] = W[(16 * s + 8 * hh + jj) * 64];
          u32x4 pw; pw.x = pk2(t8[0], t8[1]); pw.y = pk2(t8[2], t8[3]); pw.z = pk2(t8[4], t8[5]); pw.w = pk2(t8[6], t8[7]); wf[s] = __builtin_bit_cast(bf16x8, pw); } }
    const float gbias = (gate ? bx_ : ba_)[nb * 64 + 32 * td + r31];
    const float cw0 = convw[ch], cw1 = convw[512 + ch], cw2 = convw[1024 + ch], cw3 = convw[1536 + ch], cb = convb[ch];
    const float lam = lam_[ch]; const float c8 = 8.f * (fmaxf(-lam, 0.f) + log1pf(__expf(-fabsf(lam))));
    const size_t tokb = (size_t)b * SEQ;
    unsigned short px[11], py[8];
#define LRU_PREFETCH(n) do { _Pragma("unroll") for (int rr = 0; rr < 11; ++rr) { const int t = (n) * 64 + 8 * w + rr - 3; px[rr] = t >= 0 ? c.proj[(tokb + t) * NP + C_XB + ch] : (unsigned short)0; } \
        _Pragma("unroll") for (int rr = 0; rr < 8; ++rr) py[rr] = c.proj[(tokb + (n) * 64 + 8 * w + rr) * NP + C_YB + ch]; } while (0)
    LRU_PREFETCH(0);
    float hcarry = 0.f;
    for (int n = 0; n < SEQ / 64; ++n) {
        float xc[8], yv[8];
        { float xr[11];
#pragma unroll
          for (int rr = 0; rr < 11; ++rr) xr[rr] = bf2f(px[rr]);
#pragma unroll
          for (int rr = 0; rr < 8; ++rr) { xc[rr] = cb + cw0 * xr[rr] + cw1 * xr[rr + 1] + cw2 * xr[rr + 2] + cw3 * xr[rr + 3]; yv[rr] = bf2f(py[rr]);
              *(LAS unsigned short*)(L + LRU_X + offb(8 * w + rr, lane >> 3) + (lane & 7) * 2) = (unsigned short)f2bf(xc[rr]); } }
        __syncthreads();
        if (n + 1 < SEQ / 64) LRU_PREFETCH(n + 1);
        { f32x16 Z;
#pragma unroll
          for (int i = 0; i < 16; ++i) Z[i] = 0.f;
#pragma unroll
          for (int s = 0; s < 4; ++s) { const bf16x8 af = *(const LAS bf16x8*)(L + LRU_X + offb(32 * tt + r31, 2 * s + hh)); Z = __builtin_amdgcn_mfma_f32_32x32x16_bf16(af, wf[s], Z, 0, 0, 0); }
          LAS float* dst = (LAS float*)(L + (gate ? LRU_I : LRU_R));
#pragma unroll
          for (int i = 0; i < 16; ++i) dst[(32 * tt + crow(i, hh)) * 64 + 32 * td + r31] = sigmoidf_(Z[i] + gbias); }
        __syncthreads();
        float hl[8], pc[8];
        { float hrun = 0.f, prun = 1.f;
#pragma unroll
          for (int rr = 0; rr < 8; ++rr) { const float r = ((const LAS float*)(L + LRU_R))[(8 * w + rr) * 64 + lane], ig = ((const LAS float*)(L + LRU_I))[(8 * w + rr) * 64 + lane];
              const float a = __expf(-c8 * r), u = __builtin_amdgcn_sqrtf(fmaxf(1.f - a * a, 0.f)) * ig * xc[rr];
              hrun = a * hrun + u; prun *= a; hl[rr] = hrun; pc[rr] = prun; }
          ((LAS float*)(L + LRU_SP))[w * 64 + lane] = prun; ((LAS float*)(L + LRU_SH))[w * 64 + lane] = hrun; }
        __syncthreads();
        { float hin = hcarry, hall = hcarry;
#pragma unroll
          for (int s = 0; s < 8; ++s) { const float P = ((const LAS float*)(L + LRU_SP))[s * 64 + lane], H = ((const LAS float*)(L + LRU_SH))[s * 64 + lane];
              hall = P * hall + H; hin = (s < w) ? hall : hin; }
          hcarry = hall;
#pragma unroll
          for (int rr = 0; rr < 8; ++rr) { const float hv = hl[rr] + pc[rr] * hin;
              c.proj[(tokb + n * 64 + 8 * w + rr) * NP + C_YB + ch] = (bf16_t)f2bf(hv * gelu_tanh(yv[rr])); } }
    }
    __syncthreads();
#undef LRU_PREFETCH
}

constexpr int TPB = TT / 256;
constexpr int RW_STRIDE = 1032;
__device__ __forceinline__ void phase_router(const Ctx& c, const float* gain, const float* rw, const float* rb, unsigned* gcnt) {
    LAS bf16_t* sWh = (LAS bf16_t*)c.lds;
    LAS bf16_t* sWl = sWh + 16 * RW_STRIDE;
    LAS float* sGn = (LAS float*)(c.lds + 69632);
    LAS unsigned* sRec = (LAS unsigned*)(c.lds + 73728);
    LAS unsigned* sCnt = (LAS unsigned*)(c.lds + MISC_OFF + 256);
    LAS unsigned* sBase = sCnt + 16;
    const int tid = c.tid, lane = c.lane, w = c.wave;
    for (int idx = tid; idx < D * NE; idx += NTHR) { const int e = idx >> 10, k = idx & 1023; const float v = rw[k * 16 + e] * gain[k];
        const unsigned hi = f2bf(v); const float lo = v - bflo(hi); sWh[e * RW_STRIDE + k] = (bf16_t)hi; sWl[e * RW_STRIDE + k] = (bf16_t)f2bf(lo); }
    for (int idx = tid; idx < D; idx += NTHR) sGn[idx] = gain[idx];
    if (tid < 16) sCnt[tid] = 0u;
    __syncthreads();
    const int t = lane & 15, g = lane >> 4;
#pragma unroll 1
    for (int sub = 0; sub < TPB / 128; ++sub) {
    const int lt = sub * 128 + w * 16 + t, tok = c.bid * TPB + lt;
    const bf16_t* xrow = c.xb + (size_t)tok * D + 8 * g; signed char* hrow = (signed char*)c.actf + (size_t)tok * D + 8 * g;
    f32x4 acc = {0.f, 0.f, 0.f, 0.f}; float ss = 0.f, am = 0.f;
    u32x4 xn[4];
#pragma unroll
    for (int j = 0; j < 4; ++j) xn[j] = *(const u32x4*)(xrow + 32 * j);
#pragma unroll 1
    for (int s4 = 0; s4 < 8; ++s4) {
        u32x4 xc[4];
#pragma unroll
        for (int j = 0; j < 4; ++j) xc[j] = xn[j];
        if (s4 + 1 < 8) {
#pragma unroll
            for (int j = 0; j < 4; ++j) xn[j] = *(const u32x4*)(xrow + 32 * (4 * s4 + 4 + j)); }
#pragma unroll
        for (int j = 0; j < 4; ++j) { const int s = 4 * s4 + j;
            const unsigned xw[4] = {xc[j].x, xc[j].y, xc[j].z, xc[j].w};
            float xv[8];
#pragma unroll
            for (int k = 0; k < 4; ++k) { xv[2 * k] = bflo(xw[k]); xv[2 * k + 1] = bfhi(xw[k]); }
            { const f32x4 q0 = *(const LAS f32x4*)(sGn + 32 * s + 8 * g), q1 = *(const LAS f32x4*)(sGn + 32 * s + 8 * g + 4);
              am = fmaxf(am, fmaxf(fmaxf(fmaxf(fabsf(xv[0] * q0.x), fabsf(xv[1] * q0.y)), fmaxf(fabsf(xv[2] * q0.z), fabsf(xv[3] * q0.w))), fmaxf(fmaxf(fabsf(xv[4] * q1.x), fabsf(xv[5] * q1.y)), fmaxf(fabsf(xv[6] * q1.z), fabsf(xv[7] * q1.w))))); }
            const bf16x8 bh = __builtin_bit_cast(bf16x8, xc[j]);
#pragma unroll
            for (int k = 0; k < 8; ++k) ss += xv[k] * xv[k];
            const bf16x8 ah = *(const LAS bf16x8*)(sWh + t * RW_STRIDE + 32 * s + 8 * g), al = *(const LAS bf16x8*)(sWl + t * RW_STRIDE + 32 * s + 8 * g);
            acc = __builtin_amdgcn_mfma_f32_16x16x32_bf16(ah, bh, acc, 0, 0, 0);
            acc = __builtin_amdgcn_mfma_f32_16x16x32_bf16(al, bh, acc, 0, 0, 0); }
    }
    ss += swz_xor<16>(ss);
    { const auto r = __builtin_amdgcn_permlane32_swap(__float_as_uint(ss), __float_as_uint(ss), false, false); ss = __uint_as_float(r[0]) + __uint_as_float(r[1]); }
    const float rs = rsqf_(ss * (1.f / D) + RMS_EPS);
    am = fmaxf(am, swz_xor<16>(am));
    { const auto r = __builtin_amdgcn_permlane32_swap(__float_as_uint(am), __float_as_uint(am), false, false); am = fmaxf(__uint_as_float(r[0]), __uint_as_float(r[1])); }
    const float qinv = am > 0.f ? 127.f / am : 0.f, qs = am * (1.f / 127.f);
    float sc[4]; float mx = -INFINITY;
#pragma unroll
    for (int i = 0; i < 4; ++i) { sc[i] = acc[i] * rs + rb[4 * g + i]; mx = fmaxf(mx, sc[i]); }
    mx = fmaxf(mx, swz_xor<16>(mx));
    { const auto r = __builtin_amdgcn_permlane32_swap(__float_as_uint(mx), __float_as_uint(mx), false, false); mx = fmaxf(__uint_as_float(r[0]), __uint_as_float(r[1])); }
    float sum = 0.f;
#pragma unroll
    for (int i = 0; i < 4; ++i) { sc[i] = __expf(sc[i] - mx); sum += sc[i]; }
    sum += swz_xor<16>(sum);
    { const auto r = __builtin_amdgcn_permlane32_swap(__float_as_uint(sum), __float_as_uint(sum), false, false); sum = __uint_as_float(r[0]) + __uint_as_float(r[1]); }
    const float isum = rcpf_(sum);
#pragma unroll
    for (int i = 0; i < 4; ++i) sc[i] *= isum;
    float gs;
    { const float hi1 = fmaxf(sc[0], sc[1]), lo1 = fminf(sc[0], sc[1]), hi2 = fmaxf(sc[2], sc[3]), lo2 = fminf(sc[2], sc[3]);
      gs = fmaxf(hi1, hi2) + fmaxf(fminf(hi1, hi2), fmaxf(lo1, lo2)); }
    const float g1 = swz_xor<16>(gs);
    float g2, g3;
    { const auto r = __builtin_amdgcn_permlane32_swap(__float_as_uint(gs), __float_as_uint(gs), false, false); g2 = (g & 2) ? __uint_as_float(r[0]) : __uint_as_float(r[1]); }
    { const auto r = __builtin_amdgcn_permlane32_swap(__float_as_uint(g1), __float_as_uint(g1), false, false); g3 = (g & 2) ? __uint_as_float(r[0]) : __uint_as_float(r[1]); }
    const bool win = ((gs > g1) || (gs == g1 && g < (g ^ 1))) && ((gs > g2) || (gs == g2 && g < (g ^ 2))) && ((gs > g3) || (gs == g3 && g < (g ^ 3)));
    if (win) {
        int i0 = 0; float b0 = sc[0];
#pragma unroll
        for (int k = 1; k < 4; ++k) if (sc[k] > b0) { b0 = sc[k]; i0 = k; }
        int i1 = -1; float b1 = -1.f;
#pragma unroll
        for (int k = 0; k < 4; ++k) if (k != i0 && sc[k] > b1) { b1 = sc[k]; i1 = k; }
        const int e0 = 4 * g + i0, e1 = 4 * g + i1; const float wn = rcpf_(b0 + b1);
        const unsigned l0 = atomicAdd((unsigned*)&sCnt[e0], 1u), l1 = atomicAdd((unsigned*)&sCnt[e1], 1u);
        sRec[lt * 8 + 0] = (unsigned)e0; sRec[lt * 8 + 1] = l0; sRec[lt * 8 + 2] = (unsigned)e1; sRec[lt * 8 + 3] = l1; sRec[lt * 8 + 4] = __float_as_uint(b0 * wn); sRec[lt * 8 + 5] = __float_as_uint(b1 * wn); sRec[lt * 8 + 6] = __float_as_uint(rs * qs);
    }
#pragma unroll 1
    for (int s4 = 0; s4 < 8; ++s4) { u32x4 xx[4];
#pragma unroll
        for (int j = 0; j < 4; ++j) xx[j] = *(const u32x4*)(xrow + 32 * (4 * s4 + j));
#pragma unroll
        for (int j = 0; j < 4; ++j) { const int s = 4 * s4 + j; const unsigned xw[4] = {xx[j].x, xx[j].y, xx[j].z, xx[j].w};
            const f32x4 q0 = *(const LAS f32x4*)(sGn + 32 * s + 8 * g), q1 = *(const LAS f32x4*)(sGn + 32 * s + 8 * g + 4);
            const int i0 = (int)__builtin_rintf(bflo(xw[0]) * q0.x * qinv), i1 = (int)__builtin_rintf(bfhi(xw[0]) * q0.y * qinv), i2 = (int)__builtin_rintf(bflo(xw[1]) * q0.z * qinv), i3 = (int)__builtin_rintf(bfhi(xw[1]) * q0.w * qinv);
            const int i4 = (int)__builtin_rintf(bflo(xw[2]) * q1.x * qinv), i5 = (int)__builtin_rintf(bfhi(xw[2]) * q1.y * qinv), i6 = (int)__builtin_rintf(bflo(xw[3]) * q1.z * qinv), i7 = (int)__builtin_rintf(bfhi(xw[3]) * q1.w * qinv);
            u32x2 o; o.x = (unsigned)(i0 & 0xff) | ((unsigned)(i1 & 0xff) << 8) | ((unsigned)(i2 & 0xff) << 16) | ((unsigned)(i3 & 0xff) << 24);
            o.y = (unsigned)(i4 & 0xff) | ((unsigned)(i5 & 0xff) << 8) | ((unsigned)(i6 & 0xff) << 16) | ((unsigned)(i7 & 0xff) << 24);
            *(u32x2*)(hrow + 32 * s) = o; } }
    }
    __syncthreads();
    if (tid < 16) sBase[tid] = __hip_atomic_fetch_add(gcnt + tid, sCnt[tid], __ATOMIC_RELAXED, __HIP_MEMORY_SCOPE_AGENT);
    __syncthreads();
    if (tid < TPB) { const int tk = c.bid * TPB + tid; const unsigned e0 = sRec[tid * 8], e1 = sRec[tid * 8 + 2];
        const unsigned p0 = sBase[e0] + sRec[tid * 8 + 1], p1 = sBase[e1] + sRec[tid * 8 + 3];
        u32x4 r; r.x = (e0 << 20) | p0; r.y = (e1 << 20) | p1; r.z = sRec[tid * 8 + 4]; r.w = sRec[tid * 8 + 5];
        *(u32x4*)(c.rec + (size_t)tk * 4) = r;
        const float rsv = __uint_as_float(sRec[tid * 8 + 6]);
        c.list[(size_t)e0 * TT + p0] = tk; c.list[(size_t)e1 * TT + p1] = tk; c.rsl[(size_t)e0 * TT + p0] = rsv; c.rsl[(size_t)e1 * TT + p1] = rsv; }
}

struct PlainOrder {
    int nM, nN, G, c; const char* A; const char* Bt; size_t a_tile, b_tile; int r0, r1;
    __device__ __forceinline__ bool next(int i, pg8::Unit& u) const { u.g = 0; if (r0 + i >= r1) return false; return pg8::static_tile(nM, nN, G, c, r0 + i, u.pm, u.pn); }
    __device__ __forceinline__ const char* aptr(const pg8::Unit& u) const { return A + (size_t)u.pm * a_tile; }
    __device__ __forceinline__ const char* bptr(const pg8::Unit& u) const { return Bt + (size_t)u.pn * b_tile; }
    __device__ __forceinline__ unsigned arow(const pg8::Unit&, int) const { return 0u; }
};
struct MergeOrder {
    int G, c; const char* proj; const char* wbr;
    __device__ __forceinline__ bool next(int i, pg8::Unit& u) const { u.g = i % 3; return pg8::static_tile(TC / 256, 4, G, c, i / 3, u.pm, u.pn); }
    __device__ __forceinline__ const char* aptr(const pg8::Unit& u) const { const int col = u.g == 0 ? C_OG : (u.g == 1 ? C_YB : C_QKV); return proj + ((size_t)u.pm * 256 * NP + col) * 2; }
    __device__ __forceinline__ const char* bptr(const pg8::Unit& u) const { return wbr + ((size_t)u.g * D + (size_t)u.pn * 256) * 512; }
    __device__ __forceinline__ unsigned arow(const pg8::Unit&, int) const { return 0u; }
};
template <bool UP> struct MoeOrder {
    int G, c; LAS const int* pt; LAS const int* lc; const char* A; const char* W; const int* list;
    __device__ __forceinline__ bool next(int i, pg8::Unit& u) const { const int x = c & 7, j = c >> 3, tau = (G >> 2) * i + 8 * x + (j >> 2); if (tau >= pt[NE]) return false;
        int e = 0;
#pragma unroll
        for (int k = 1; k < NE; ++k) e += (tau >= pt[k]) ? 1 : 0;
        u.pm = tau; u.pn = j & 3; u.g = e; return true; }
    __device__ __forceinline__ const char* aptr(const pg8::Unit& u) const { return UP ? A : A + (size_t)u.pm * 256 * FF * 2; }
    __device__ __forceinline__ const char* bptr(const pg8::Unit& u) const { return UP ? W + ((size_t)u.g * 1024 + (size_t)u.pn * 256) * D : W + ((size_t)u.g * D + (size_t)u.pn * 256) * FF * 2; }
    __device__ __forceinline__ unsigned arow(const pg8::Unit& u, int r) const { int p = (u.pm - pt[u.g]) * 256 + r; const int n = lc[u.g]; p = p < n ? p : n - 1;
        return (unsigned)list[(size_t)u.g * TT + p] * (unsigned)D; }
};

struct EpiStoreBf16 {
    static constexpr bool PERM = true;
    bf16_t* O; int ldc;
    __device__ __forceinline__ void operator()(const f32x4 (&acc)[2][2][4][2], const pg8::Unit& u, int wr, int wc, int fr, int fq) const {
        const int row0 = u.pm * 256 + wr * 64 + fr, col0 = u.pn * 256 + wc * 32 + 8 * fq;
#pragma unroll
        for (int ai = 0; ai < 2; ++ai)
#pragma unroll
            for (int m = 0; m < 4; ++m) { bf16_t* rowp = O + (size_t)(row0 + ai * 128 + m * 16) * ldc + col0;
#pragma unroll
                for (int bj = 0; bj < 2; ++bj) { const f32x4 v0 = acc[ai][bj][m][0], v1 = acc[ai][bj][m][1];
                    u32x4 w; w.x = pg8::cvt_pk_bf16(v0[0], v0[1]); w.y = pg8::cvt_pk_bf16(v0[2], v0[3]); w.z = pg8::cvt_pk_bf16(v1[0], v1[1]); w.w = pg8::cvt_pk_bf16(v1[2], v1[3]);
                    __builtin_nontemporal_store(w, (u32x4*)(rowp + bj * 128)); } }
    }
};
struct EpiProj {
    static constexpr bool PERM = true;
    bf16_t* O; const float* sa  ; const unsigned* cmax  ;
    __device__ __forceinline__ void operator()(const i32x4 (&acc)[2][2][4][2], const pg8::Unit& u, int wr, int wc, int fr, int fq) const {
        const int row0 = u.pm * 256 + wr * 64 + fr, col0 = u.pn * 256 + wc * 32 + 8 * fq;
        f32x4 sb0[2], sb1[2];
#pragma unroll
        for (int bj = 0; bj < 2; ++bj) { const u32x4 m0 = *(const u32x4*)(cmax + col0 + bj * 128), m1 = *(const u32x4*)(cmax + col0 + bj * 128 + 4); const float k = 1.f / 127.f;
            sb0[bj] = (f32x4){__uint_as_float(m0.x) * k, __uint_as_float(m0.y) * k, __uint_as_float(m0.z) * k, __uint_as_float(m0.w) * k};
            sb1[bj] = (f32x4){__uint_as_float(m1.x) * k, __uint_as_float(m1.y) * k, __uint_as_float(m1.z) * k, __uint_as_float(m1.w) * k}; }
        float sar[2][4];
#pragma unroll
        for (int ai = 0; ai < 2; ++ai)
#pragma unroll
            for (int m = 0; m < 4; ++m) sar[ai][m] = sa[row0 + ai * 128 + m * 16];
        if (u.pn * 256 >= C_G) {
#pragma unroll
            for (int ai = 0; ai < 2; ++ai)
#pragma unroll
                for (int m = 0; m < 4; ++m) { unsigned char* rowp = (unsigned char*)(O + (size_t)(row0 + ai * 128 + m * 16) * NP + C_G) + (col0 - C_G);
#pragma unroll
                    for (int bj = 0; bj < 2; ++bj) { const i32x4 a0 = acc[ai][bj][m][0], a1 = acc[ai][bj][m][1]; const f32x4 s0 = sb0[bj] * sar[ai][m], s1 = sb1[bj] * sar[ai][m];
                        unsigned q[8];
#pragma unroll
                        for (int k = 0; k < 4; ++k) { q[k] = (unsigned)(sigmoidf_((float)a0[k] * s0[k]) * 255.f + 0.5f); q[4 + k] = (unsigned)(sigmoidf_((float)a1[k] * s1[k]) * 255.f + 0.5f); }
                        u32x2 w; w.x = q[0] | (q[1] << 8) | (q[2] << 16) | (q[3] << 24); w.y = q[4] | (q[5] << 8) | (q[6] << 16) | (q[7] << 24);
                        __builtin_nontemporal_store(w, (u32x2*)(rowp + bj * 128)); } }
        } else {
#pragma unroll
            for (int ai = 0; ai < 2; ++ai)
#pragma unroll
                for (int m = 0; m < 4; ++m) { bf16_t* rowp = O + (size_t)(row0 + ai * 128 + m * 16) * NP + col0;
#pragma unroll
                    for (int bj = 0; bj < 2; ++bj) { const i32x4 a0 = acc[ai][bj][m][0], a1 = acc[ai][bj][m][1]; const f32x4 s0 = sb0[bj] * sar[ai][m], s1 = sb1[bj] * sar[ai][m];
                        u32x4 w; w.x = pk2((float)a0[0] * s0[0], (float)a0[1] * s0[1]); w.y = pk2((float)a0[2] * s0[2], (float)a0[3] * s0[3]); w.z = pk2((float)a1[0] * s1[0], (float)a1[1] * s1[1]); w.w = pk2((float)a1[2] * s1[2], (float)a1[3] * s1[3]);
                        __builtin_nontemporal_store(w, (u32x4*)(rowp + bj * 128)); } }
        }
    }
};
__device__ __forceinline__ int lane_fresh() { int l; asm volatile("v_mbcnt_lo_u32_b32 %0, -1, 0\n\tv_mbcnt_hi_u32_b32 %0, -1, %0" : "=v"(l)); return l; }
struct EpiMerge {
    static constexpr bool PERM = true;
    const bf16_t* proj; bf16_t* mg; const float* sbr  ; const unsigned* cmax  ;
    __device__ __forceinline__ void operator()(const i32x4 (&acc)[2][2][4][2], const pg8::Unit& u, int wr, int wc, int fr, int fq) const {
        const int ln_ = lane_fresh(), fr_ = ln_ & 15, fq_ = ln_ >> 4;
        const unsigned lrow = (unsigned)(wr * 64 + fr_), lcol = (unsigned)(wc * 32 + 8 * fq_);
        const int upm = __builtin_amdgcn_readfirstlane(u.pm), upn = __builtin_amdgcn_readfirstlane(u.pn), ug = __builtin_amdgcn_readfirstlane(u.g);
        const unsigned char* gB = (const unsigned char*)(proj + (size_t)(upm * 256) * NP + C_G) + ug * D + upn * 256;
        unsigned char* mB = (unsigned char*)(mg + (size_t)(upm * 256) * D + upn * 256);
        const unsigned char* sB = (const unsigned char*)(sbr + (size_t)ug * TC + upm * 256);
        const unsigned char* cB = (const unsigned char*)(cmax + ug * 1024 + upn * 256);
        unsigned gl = lrow * (unsigned)(NP * 2) + lcol, ml = lrow * (unsigned)(D * 2) + lcol * 2u, sl = lrow * 4u, cl = lcol * 4u;
#pragma unroll
        for (int aim = 0; aim < 4; ++aim) { const int ai = aim >> 1, mh = (aim & 1) * 2;
            asm volatile("" : "+v"(gl), "+v"(ml), "+v"(sl), "+v"(cl));
            u32x2 gv[2][2]; u32x4 pv[2][2]; float sar[2];
#pragma unroll
            for (int mm = 0; mm < 2; ++mm) { const unsigned rr = (unsigned)(ai * 128 + (mh + mm) * 16); sar[mm] = *(const float*)(sB + (sl + rr * 4u));
#pragma unroll
                for (int bj = 0; bj < 2; ++bj) {
                    gv[mm][bj] = *(const u32x2*)(gB + (gl + rr * (unsigned)(NP * 2) + (unsigned)(bj * 128)));
                    if (ug > 0) pv[mm][bj] = *(const u32x4*)(mB + (ml + rr * (unsigned)(D * 2) + (unsigned)(bj * 256))); else pv[mm][bj] = (u32x4){0u, 0u, 0u, 0u}; } }
            asm volatile("" ::: "memory");
#pragma unroll
            for (int mm = 0; mm < 2; ++mm)
#pragma unroll
                for (int bj = 0; bj < 2; ++bj) { const int m = mh + mm; const unsigned rr = (unsigned)(ai * 128 + m * 16);
                    const u32x2 g = gv[mm][bj]; const u32x4 p = pv[mm][bj];
                    const i32x4 a0 = acc[ai][bj][m][0], a1 = acc[ai][bj][m][1];
                    const float k255 = sar[mm] * (1.f / (255.f * 127.f));
                    const u32x4 m0 = *(const u32x4*)(cB + (cl + (unsigned)(bj * 512))), m1 = *(const u32x4*)(cB + (cl + (unsigned)(bj * 512 + 16)));
                    const f32x4 s0 = (f32x4){__uint_as_float(m0.x), __uint_as_float(m0.y), __uint_as_float(m0.z), __uint_as_float(m0.w)} * k255, s1 = (f32x4){__uint_as_float(m1.x), __uint_as_float(m1.y), __uint_as_float(m1.z), __uint_as_float(m1.w)} * k255;
                    float r[8];
                    r[0] = (float)a0[0] * s0[0] * (float)(g.x & 0xffu) + bflo(p.x); r[1] = (float)a0[1] * s0[1] * (float)((g.x >> 8) & 0xffu) + bfhi(p.x);
                    r[2] = (float)a0[2] * s0[2] * (float)((g.x >> 16) & 0xffu) + bflo(p.y); r[3] = (float)a0[3] * s0[3] * (float)(g.x >> 24) + bfhi(p.y);
                    r[4] = (float)a1[0] * s1[0] * (float)(g.y & 0xffu) + bflo(p.z); r[5] = (float)a1[1] * s1[1] * (float)((g.y >> 8) & 0xffu) + bfhi(p.z);
                    r[6] = (float)a1[2] * s1[2] * (float)((g.y >> 16) & 0xffu) + bflo(p.w); r[7] = (float)a1[3] * s1[3] * (float)(g.y >> 24) + bfhi(p.w);
                    u32x4 w; w.x = pk2(r[0], r[1]); w.y = pk2(r[2], r[3]); w.z = pk2(r[4], r[5]); w.w = pk2(r[6], r[7]);
                    *(u32x4*)(mB + (ml + rr * (unsigned)(D * 2) + (unsigned)(bj * 256))) = w; }
            asm volatile("" ::: "memory");
        }
    }
};
template <bool BASE_BF16> struct EpiResid {
    static constexpr bool PERM = true;
    const void* base; bf16_t* out;
    __device__ __forceinline__ void operator()(const f32x4 (&acc)[2][2][4][2], const pg8::Unit& u, int wr, int wc, int fr, int fq) const {
        const int row0 = u.pm * 256 + wr * 64 + fr, col0 = u.pn * 256 + wc * 32 + 8 * fq;
#pragma unroll
        for (int ai = 0; ai < 2; ++ai) {
            f32x4 b0[4][2], b1[4][2];
#pragma unroll
            for (int m = 0; m < 4; ++m) { const size_t off = (size_t)(row0 + ai * 128 + m * 16) * D + col0;
#pragma unroll
                for (int bj = 0; bj < 2; ++bj) {
                    if (BASE_BF16) { const u32x4 w = *(const u32x4*)((const bf16_t*)base + off + bj * 128);
                        b0[m][bj] = (f32x4){bflo(w.x), bfhi(w.x), bflo(w.y), bfhi(w.y)}; b1[m][bj] = (f32x4){bflo(w.z), bfhi(w.z), bflo(w.w), bfhi(w.w)}; }
                    else { b0[m][bj] = *(const f32x4*)((const float*)base + off + bj * 128); b1[m][bj] = *(const f32x4*)((const float*)base + off + bj * 128 + 4); } } }
            asm volatile("" ::: "memory");
#pragma unroll
            for (int m = 0; m < 4; ++m) { const size_t off = (size_t)(row0 + ai * 128 + m * 16) * D + col0;
#pragma unroll
                for (int bj = 0; bj < 2; ++bj) { const f32x4 v0 = b0[m][bj] + acc[ai][bj][m][0], v1 = b1[m][bj] + acc[ai][bj][m][1];
                    u32x4 w; w.x = pk2(v0[0], v0[1]); w.y = pk2(v0[2], v0[3]); w.z = pk2(v1[0], v1[1]); w.w = pk2(v1[2], v1[3]);
                    *(u32x4*)(out + off + bj * 128) = w; } }
        }
    }
};
struct EpiSwiGLU {
    static constexpr bool PERM = false;
    bf16_t* hid; const float* rsl; LAS const int* pt; LAS const int* lc; const unsigned* cmax  ;
    __device__ __forceinline__ void operator()(const i32x4 (&acc)[2][2][4][2], const pg8::Unit& u, int wr, int wc, int fr, int fq) const {
        const int row0 = u.pm * 256 + wr * 64 + fr, col0 = u.pn * 128 + wc * 16 + 4 * fq;
        const int pbase = (u.pm - pt[u.g]) * 256 + wr * 64 + fr, nrow = lc[u.g];
        float rsv[2][4]; f32x4 sg[2], su[2];
#pragma unroll
        for (int ai = 0; ai < 2; ++ai)
#pragma unroll
            for (int m = 0; m < 4; ++m) { int p = pbase + ai * 128 + m * 16; p = p < nrow ? p : nrow - 1; rsv[ai][m] = rsl[(size_t)u.g * TT + p]; }
#pragma unroll
        for (int bj = 0; bj < 2; ++bj) { const unsigned* cm = cmax + (size_t)u.g * 1024 + u.pn * 256 + bj * 128 + wc * 32 + 4 * fq; const u32x4 a = *(const u32x4*)cm, b = *(const u32x4*)(cm + 16); const float k = 1.f / 127.f;
            sg[bj] = (f32x4){__uint_as_float(a.x) * k, __uint_as_float(a.y) * k, __uint_as_float(a.z) * k, __uint_as_float(a.w) * k};
            su[bj] = (f32x4){__uint_as_float(b.x) * k, __uint_as_float(b.y) * k, __uint_as_float(b.z) * k, __uint_as_float(b.w) * k}; }
#pragma unroll
        for (int ai = 0; ai < 2; ++ai)
#pragma unroll
            for (int m = 0; m < 4; ++m) { bf16_t* rowp = hid + (size_t)(row0 + ai * 128 + m * 16) * FF + col0; const float rs = rsv[ai][m];
#pragma unroll
                for (int bj = 0; bj < 2; ++bj) { const i32x4 ag = acc[ai][bj][m][0], au = acc[ai][bj][m][1]; float g[4], up[4];
#pragma unroll
                    for (int k = 0; k < 4; ++k) { g[k] = (float)ag[k] * (sg[bj][k] * rs); up[k] = (float)au[k] * (su[bj][k] * rs); }
                    u32x2 w; w.x = pk2(g[0] * sigmoidf_(g[0]) * up[0], g[1] * sigmoidf_(g[1]) * up[1]); w.y = pk2(g[2] * sigmoidf_(g[2]) * up[2], g[3] * sigmoidf_(g[3]) * up[3]);
                    *(u32x2*)(rowp + bj * 64) = w; } }
    }
};

constexpr int PH_PER_LAYER = 1 + NCH * 4 + 4, PH_TOTAL = 1 + DEPTH * PH_PER_LAYER + 1;
#ifndef MK_LAUNCH_PER_PHASE
#define MK_LAUNCH_PER_PHASE 0
#endif
#ifndef PHMASK
#define PHMASK 0xFFFF
#endif
#ifndef MIXM
#define MIXM 7
#endif
#define EN(j) (((PHMASK) >> (j)) & 1)
typedef const __attribute__((address_space(4))) char* kptr_t;
__device__ __forceinline__ const void* karg_ptr(kptr_t kp, int i) { return *(const void* const __attribute__((address_space(4)))*)(kp + 8 * i); }
__device__ __forceinline__ void make_ctx(Ctx& c, kptr_t& kp, int layer, int chunk, int wave_s) {
    int t = wave_s * 64 + lane_fresh();
    kp = (kptr_t)__builtin_amdgcn_kernarg_segment_ptr(); asm volatile("" : "+s"(kp));
    c.tid = t; c.lane = t & 63; c.wave = __builtin_amdgcn_readfirstlane(t >> 6); c.bid = blockIdx.x; c.G = gridDim.x;
    unsigned char* ws = (unsigned char*)karg_ptr(kp, 25); float* out = (float*)karg_ptr(kp, 24);
    c.ctl = (unsigned*)(ws + WS_CTL);
    c.actf = (bf16_t*)(ws + WS_ACT); c.act = c.actf + (size_t)chunk * TC * D; c.proj = (bf16_t*)(ws + WS_PROJ); c.hid = (bf16_t*)(ws + WS_HID); c.ys = (bf16_t*)(ws + WS_YS);
    c.rec = (unsigned*)(ws + WS_REC); c.list = (int*)(ws + WS_LIST); c.rsl = (float*)(ws + WS_RSL);
    c.chunk = chunk; c.layer = layer; c.pass = layer * NCH + chunk;
    c.xinf = (const float*)karg_ptr(kp, 0); c.xof = out; c.xb = (bf16_t*)(ws + WS_XB); c.x2 = (bf16_t*)out; c.sa = (float*)(ws + WS_SA); c.sbr = (float*)(ws + WS_SBR);
    c.x_in = c.xinf + (size_t)chunk * TC * D; c.xo = out + (size_t)chunk * TC * D;
    c.pos = (const int*)karg_ptr(kp, 1) + (size_t)chunk * TC;
    c.lw = ws + WS_W + (size_t)layer * LW_SIZE;
}
#define INP(i) ((const float*)karg_ptr(kp, (i)))
__global__ void __launch_bounds__(NTHR, 2) fwd(Args args) {
    extern __shared__ __attribute__((aligned(16))) unsigned char lds_raw[];
    Ctx c; kptr_t kp;
    c.lds = (LAS unsigned char*)lds_raw;
    const int wave_s = __builtin_amdgcn_readfirstlane((int)threadIdx.x >> 6);
    make_ctx(c, kp, 0, 0, wave_s);
    volatile LAS unsigned* MISC = (volatile LAS unsigned*)(c.lds + MISC_OFF);
    LAS int* sPT = (LAS int*)(c.lds + MISC_OFF + 64);
    LAS int* sLC = (LAS int*)(c.lds + MISC_OFF + 160);
    for (int u = c.tid; u < 1024; u += NTHR) MISC[u] = 0u;
    __syncthreads();
    XcdBarrier bar; bar.bar = c.ctl + CW_BAR; bar.x = 0; bar.st = nullptr;
    if (!MK_LAUNCH_PER_PHASE) bar = xcd_barrier_post(c.ctl + CW_BAR, MISC, c.tid);
    const int lo = args.ph_lo, hi = args.ph_hi;
#define IN(k) (lo <= (k) && (k) < hi)
#ifndef PROBE_MASK
#define PROBE_MASK 0
#endif
#ifndef PROBE_CLK_CLS
#define PROBE_CLK_CLS 2
#endif
#ifndef PROBE_BLOCK
#define PROBE_BLOCK 0
#endif
#ifndef PROBE_K
#define PROBE_K 4
#endif
    unsigned long long t_prev = 0, c_prev = 0; LAS unsigned* sAcc = (LAS unsigned*)(c.lds + MISC_OFF + 512);
    if (PROBE_MASK) { t_prev = __builtin_amdgcn_s_memrealtime(); c_prev = (unsigned long long)clock64(); }
#define STAMP(cls) do { if (PROBE_MASK) { const unsigned long long _n = __builtin_amdgcn_s_memrealtime(); const unsigned long long _ck = (unsigned long long)clock64(); if (blockIdx.x == PROBE_BLOCK && c.tid == 0) { sAcc[(cls)] += (unsigned)(_n - t_prev); if ((cls) == PROBE_CLK_CLS) sAcc[15] += (unsigned)((_ck - c_prev) >> 4); } t_prev = _n; c_prev = _ck; } } while (0)
#ifndef PROBE_GEMM_CLS
#define PROBE_GEMM_CLS -1
#endif
#define GEMM_FLAG(cls) do { if (PROBE_MASK) { if (c.tid == 0) MISC[6] = ((cls) == PROBE_GEMM_CLS) ? 1u : 0u; __syncthreads(); } } while (0)
#define SEAM(k) do { if (IN(k) && IN((k) + 1)) { XcdBarrier _b = bar; kptr_t _k = (kptr_t)__builtin_amdgcn_kernarg_segment_ptr(); asm volatile("" : "+s"(_k)); _b.bar = (unsigned*)((unsigned char*)karg_ptr(_k, 25) + WS_CTL) + CW_BAR; { int _t = wave_s * 64 + lane_fresh(); const unsigned long long _b0 = PROBE_MASK ? __builtin_amdgcn_s_memrealtime() : 0ull; xcd_barrier(_b, _t); if (PROBE_MASK && blockIdx.x == PROBE_BLOCK && _t == 0) sAcc[13] += (unsigned)(__builtin_amdgcn_s_memrealtime() - _b0); } } } while (0)

    if (EN(0) && IN(0)) { Args a2;
#pragma unroll
        for (int i = 0; i < 24; ++i) a2.in[i] = karg_ptr(kp, i);
        a2.ws = (unsigned char*)karg_ptr(kp, 25); a2.out = nullptr; a2.ph_lo = 0; a2.ph_hi = 0;
        float* tmpf = (float*)(a2.ws + WS_XB); unsigned* cmaxb = c.ctl + CW_CMAX;
        phase_prep_a(a2, tmpf, cmaxb, c.bid * NWAVES + c.wave, c.G * NWAVES, c.lane, c.bid * NTHR + c.tid, c.G * NTHR);
        { XcdBarrier _b = bar; _b.bar = c.ctl + CW_BAR; xcd_barrier(_b, c.tid); }
        phase_prep(a2, tmpf, cmaxb, c.lds, c.bid * NWAVES + c.wave, c.G * NWAVES, c.wave, c.lane, c.bid * NTHR + c.tid, c.G * NTHR);
        phase_rope_table((const int*)karg_ptr(kp, 1), (float*)(c.ctl) + (WS_BRC + 4 * MiB) / 4, c.bid * NTHR + c.tid, c.G * NTHR); }
    SEAM(0); STAMP(0);

    for (int layer = 0; layer < DEPTH; ++layer) {
        const int pl = 1 + layer * PH_PER_LAYER;
        if (EN(1) && IN(pl)) { make_ctx(c, kp, layer, 0, wave_s);
            const float* g1 = INP(2) + layer * D;
            if (layer == 0) phase_norm1<false, true, false>(c, g1, sPT);
            else { moe_tables(c.ctl + CW_CNT + 64 * (layer - 1), sPT, sLC, c.tid); phase_norm1<true, true, true>(c, g1, sPT); }
        }
        SEAM(pl); STAMP(1);
        for (int chunk = 0; chunk < NCH; ++chunk) {
            const int pb = pl + 1 + chunk * 4;
            if (EN(2) && IN(pb + 0)) { make_ctx(c, kp, layer, chunk, wave_s);
                EpiProj E{c.proj, c.sa + (size_t)chunk * TC, c.ctl + CW_CMAX + (size_t)layer * NP};
                GEMM_FLAG(2);
                PlainOrder S{TC / 256, NP / 256, c.G, c.bid, (const char*)c.act, (const char*)(c.lw + LW_WIN), (size_t)256 * D, (size_t)256 * D, 0, 1 << 20};
                pg8::gemm_phase<EpiProj, PlainOrder, false, true>(c.lds, S, E, D / 2, D / 2, c.tid);
            }
            SEAM(pb + 0); STAMP(2);
            if (EN(4) && IN(pb + 1)) { make_ctx(c, kp, layer, chunk, wave_s);
                float* lse = (float*)(c.ctl) + (WS_BRC / 4);
                if ((MIXM & 1) && c.bid < 4 * BC) gla_unit(c, c.bid, INP(5) + layer * 256, INP(6) + layer * 128);
                else if ((MIXM & 2) && c.bid < 12 * BC) lru_unit(c, c.bid - 4 * BC, INP(7) + layer * 4 * 512, INP(8) + layer * 512, INP(9) + layer * 8 * 64 * 64,
                                                    INP(10) + layer * 512, INP(11) + layer * 8 * 64 * 64, INP(12) + layer * 512, INP(13) + layer * 512);
                STAMP(12);
                unsigned* qh = c.ctl + CW_Q + 64 * c.pass;
                if (MIXM & 4) attn_loop(c, qh, MISC + 4, lse, INP(14) + layer * 128, INP(15) + layer * 128, (const float*)(c.ctl) + (WS_BRC + 4 * MiB) / 4 + (size_t)chunk * TC * 32);
            }
            SEAM(pb + 1); STAMP(4);
            if (EN(11) && IN(pb + 2)) { make_ctx(c, kp, layer, chunk, wave_s); phase_attn_combine(c, (const float*)(c.ctl) + (WS_BRC / 4)); }
            SEAM(pb + 2); STAMP(11);
            if (EN(5) && IN(pb + 3)) { make_ctx(c, kp, layer, chunk, wave_s);
                MergeOrder S{c.G, c.bid, (const char*)c.proj, (const char*)(c.lw + LW_WBR)};
                EpiMerge E{c.proj, c.act, c.sbr, c.ctl + CW_CMAX3 + (size_t)layer * 3 * 1024};
                GEMM_FLAG(5);
                pg8::gemm_phase<EpiMerge, MergeOrder, false, true>(c.lds, S, E, 256, NP, c.tid);
            }
            SEAM(pb + 3); STAMP(5);
        }
        const int pm = pl + 2 + NCH * 4;
        if (EN(6) && IN(pm - 1)) { make_ctx(c, kp, layer, 0, wave_s);
            PlainOrder S{TT / 256, D / 256, c.G, c.bid, (const char*)c.actf, (const char*)(c.lw + LW_WOUT), (size_t)256 * D * 2, (size_t)256 * D * 2, 0, 1 << 20};
            GEMM_FLAG(6);
            if (layer == 0) { EpiResid<false> E{(const void*)c.xinf, c.xb}; pg8::gemm_phase<EpiResid<false>, PlainOrder, false>(c.lds, S, E, D, D, c.tid); }
            else            { EpiResid<true>  E{(const void*)c.x2,  c.xb}; pg8::gemm_phase<EpiResid<true>,  PlainOrder, false>(c.lds, S, E, D, D, c.tid); }
        }
        SEAM(pm - 1); STAMP(6);
        if (EN(7) && IN(pm + 0)) { make_ctx(c, kp, layer, 0, wave_s); phase_router(c, INP(18) + layer * D, INP(19), INP(20), c.ctl + CW_CNT + 64 * layer); }
        SEAM(pm + 0); STAMP(7);
        if (EN(8) && IN(pm + 1)) { make_ctx(c, kp, layer, 0, wave_s);
            moe_tables(c.ctl + CW_CNT + 64 * layer, sPT, sLC, c.tid);
            MoeOrder<true> S{c.G, c.bid, sPT, sLC, (const char*)c.actf, (const char*)(c.lw + LW_WGU), c.list};
            EpiSwiGLU E{c.hid, c.rsl, sPT, sLC, c.ctl + CW_CMAX2 + (size_t)layer * NE * 1024};
            GEMM_FLAG(8);
            pg8::gemm_phase<EpiSwiGLU, MoeOrder<true>, true, true>(c.lds, S, E, D / 2, D / 2, c.tid);
        }
        SEAM(pm + 1); STAMP(8);
        if (EN(9) && IN(pm + 2)) { make_ctx(c, kp, layer, 0, wave_s);
            moe_tables(c.ctl + CW_CNT + 64 * layer, sPT, sLC, c.tid);
            MoeOrder<false> S{c.G, c.bid, sPT, sLC, (const char*)c.hid, (const char*)(c.lw + LW_WDN), c.list};
            EpiStoreBf16 E{c.ys, D};
            GEMM_FLAG(9);
            pg8::gemm_phase<EpiStoreBf16, MoeOrder<false>, false>(c.lds, S, E, FF, FF, c.tid);
        }
        SEAM(pm + 2); STAMP(9);
    }
    if (EN(10) && IN(PH_TOTAL - 1)) { make_ctx(c, kp, DEPTH - 1, 0, wave_s);
        moe_tables(c.ctl + CW_CNT + 64 * (DEPTH - 1), sPT, sLC, c.tid);
        phase_norm1<true, false, true>(c, nullptr, sPT);
    }
    if (PROBE_MASK) {
        make_ctx(c, kp, DEPTH - 1, 0, wave_s);
        STAMP(10);
        if (blockIdx.x == PROBE_BLOCK && c.tid == 0) { unsigned sel = 0; for (int k = 0; k < 16; ++k) if ((PROBE_MASK >> k) & 1) sel += sAcc[k]; __hip_atomic_store(c.ctl + CW_Q + 64 * 8, sel, __ATOMIC_RELAXED, __HIP_MEMORY_SCOPE_AGENT); }
        { XcdBarrier _b = bar; _b.bar = c.ctl + CW_BAR; xcd_barrier(_b, c.tid); }
        const unsigned sel = __hip_atomic_load(c.ctl + CW_Q + 64 * 8, __ATOMIC_RELAXED, __HIP_MEMORY_SCOPE_AGENT);
        const unsigned long long t0 = __builtin_amdgcn_s_memrealtime();
        while (__builtin_amdgcn_s_memrealtime() - t0 < (unsigned long long)sel * PROBE_K) __builtin_amdgcn_s_sleep(8);
    }
#undef IN
#undef SEAM
}

extern "C" void kernel_launch(void* const* d_in, const int* in_sizes, int n_in, void* d_out, int out_size, void* d_ws, size_t ws_size, hipStream_t stream) {
    static int grid = 0;
    if (grid == 0) {
        if (n_in != 24 || in_sizes[0] != BATCH * SEQ * D || out_size != BATCH * SEQ * D || ws_size < WS_END) { fprintf(stderr, "kernel_launch: unexpected shapes / workspace (%zu < %zu)\n", ws_size, (size_t)WS_END); grid = -1; return; }
        int dev = 0, cus = 0;
        if (hipGetDevice(&dev) != hipSuccess || hipDeviceGetAttribute(&cus, hipDeviceAttributeMultiprocessorCount, dev) != hipSuccess || cus < 256) { fprintf(stderr, "kernel_launch: needs a 256-CU device\n"); grid = -1; return; }
        if (hipFuncSetAttribute((const void*)fwd, hipFuncAttributeMaxDynamicSharedMemorySize, LDS_BYTES) != hipSuccess) { fprintf(stderr, "kernel_launch: hipFuncSetAttribute failed\n"); grid = -1; return; }
        int per_cu = 0;
        if (hipOccupancyMaxActiveBlocksPerMultiprocessor(&per_cu, (const void*)fwd, NTHR, LDS_BYTES) != hipSuccess || per_cu < 1) fprintf(stderr, "kernel_launch: occupancy query says %d\n", per_cu);
        (void)hipGetLastError();
        grid = 256;
    }
    if (grid < 0) return;
    if (hipMemsetAsync((char*)d_ws + WS_CTL, 0, CTL_ZERO_BYTES, stream) != hipSuccess) return;
    Args a{};
    for (int i = 0; i < 24; ++i) a.in[i] = d_in[i];
    a.out = (float*)d_out; a.ws = (unsigned char*)d_ws;
#if MK_LAUNCH_PER_PHASE
    for (int k = 0; k < PH_TOTAL; ++k) { a.ph_lo = k; a.ph_hi = k + 1; hipLaunchKernelGGL(fwd, dim3(grid), dim3(NTHR), LDS_BYTES, stream, a); }
#else
    a.ph_lo = 0; a.ph_hi = PH_TOTAL;
    hipLaunchKernelGGL(fwd, dim3(grid), dim3(NTHR), LDS_BYTES, stream, a);
#endif
}
```

```cpp
#include <hip/hip_runtime.h>
#include <cstdio>
#include <cstdint>

#define LAS __attribute__((address_space(3)))
#define GAS __attribute__((address_space(1)))
typedef unsigned short bf16_t;
typedef short bf16x8 __attribute__((ext_vector_type(8)));
typedef float f32x4 __attribute__((ext_vector_type(4)));
typedef float f32x2 __attribute__((ext_vector_type(2)));
typedef unsigned u32x4 __attribute__((ext_vector_type(4)));
typedef unsigned u32x2 __attribute__((ext_vector_type(2)));
typedef int i32x4 __attribute__((ext_vector_type(4)));

namespace pg8 {
constexpr int BM = 256, BK = 64, HALF = 128, HTB = HALF * BK * 2, STAGE_BYTES = 8 * HTB, NXCD = 8, WGM = 8;
__host__ __device__ __forceinline__ int lds_byte(int r, int c) { const int st = (r >> 4) * 2 + (c >> 5), rr = r & 15, cc = c & 31, ob = rr * 64 + cc * 2; return st * 1024 + (ob ^ (((ob >> 9) & 1) << 5)); }
__host__ __device__ __forceinline__ void stage_rc(int b, int& R, int& C) { const int st = b / 1024, sb = b % 1024, swz = sb ^ (((sb >> 9) & 1) << 5); R = (st >> 1) * 16 + swz / 64; C = (st & 1) * 32 + (swz % 64) / 2; }
__host__ __device__ __forceinline__ int perm32(int rho) { const int n = rho >> 4, i = rho & 15; return 8 * (i >> 2) + 4 * n + (i & 3); }

struct Unit { int pm, pn, g; };

__device__ __forceinline__ bool static_tile(int nM, int nN, int G, int c, int i, int& pm, int& pn) {
    const int nwg = nM * nN; const long L = (long)i * G + c; if (L >= nwg) return false;
    int wgid = (int)L; { const int q = nwg / NXCD, r = nwg % NXCD, xcd = wgid % NXCD, off = wgid / NXCD; wgid = (xcd < r ? xcd * (q + 1) : r * (q + 1) + (xcd - r) * q) + off; }
    const int nig = WGM * nN, gid = wgid / nig, fm = gid * WGM, gsz = (nM - fm) < WGM ? (nM - fm) : WGM;
    pm = fm + ((wgid % nig) % gsz); pn = (wgid % nig) / gsz; return true;
}
typedef __bf16 bf16x2c_t __attribute__((ext_vector_type(2)));
__device__ __forceinline__ unsigned cvt_pk_bf16(float lo, float hi) { const f32x2 v = {lo, hi}; return __builtin_bit_cast(unsigned, __builtin_convertvector(v, bf16x2c_t)); }

template <bool I8> struct AccT { typedef f32x4 t; };
template <> struct AccT<true> { typedef i32x4 t; };
template <class Epi, class Sched, bool GATHER, bool I8 = false, bool HM = false>
__device__ __forceinline__ void gemm_phase(LAS unsigned char* lds, const Sched& S, const Epi& E, const int K, const int lda, int tid_) {
    asm volatile("" : "+v"(tid_));
    const int tid = tid_, wid = __builtin_amdgcn_readfirstlane(tid >> 6), lane = tid & 63, wr = wid >> 2, wc = wid & 3, fr = lane & 15, fq = lane >> 4;
    const int nt = K / BK;
    int sR[2], sC[2];
    unsigned voffB[2], voffA[2], vAc[2][2], vAn[2][2];
#pragma unroll
    for (int i = 0; i < 2; ++i) { int R, C; stage_rc(tid * 16 + i * 8192, R, C); sR[i] = R; sC[i] = C; const int Rb = Epi::PERM ? ((R & ~31) + perm32(R & 31)) : R;
        voffB[i] = (unsigned)(Rb * K + C) * 2u; voffA[i] = (unsigned)(R * lda + C) * 2u; }
    const size_t kstep = (size_t)(BK * 2);
    const size_t hstepB = (size_t)HALF * K * 2, hstepA = (size_t)HALF * lda * 2;
    const unsigned ldsw = (unsigned)wid * 1024u;
    const int aoff = lds_byte(wr * 64 + fr, fq * 8), boff = lds_byte(wc * 32 + fr, fq * 8);
#define PG8_SA(b, h) (((b) * 2 + (h)) * HTB)
#define PG8_SB(b, h) ((4 + (b) * 2 + (h)) * HTB)
#define PG8_STAGE(bufoff, gbase, voff) do { _Pragma("unroll") for (int _i = 0; _i < 2; ++_i) \
        __builtin_amdgcn_global_load_lds((const unsigned*)((const char*)(gbase) + (voff)[_i]), (LAS unsigned*)(lds + (bufoff) + ldsw + _i * 8192), 16, 0, 0); } while (0)
#define PG8_LDA(dst, b, h) do { _Pragma("unroll") for (int m = 0; m < 4; ++m) _Pragma("unroll") for (int k = 0; k < 2; ++k) dst[m][k] = *(const LAS bf16x8*)(lds + PG8_SA(b, h) + aoff + m * 2048 + k * 1024); } while (0)
#define PG8_LDB(dst, b, h) do { _Pragma("unroll") for (int n = 0; n < 2; ++n) _Pragma("unroll") for (int k = 0; k < 2; ++k) dst[n][k] = *(const LAS bf16x8*)(lds + PG8_SB(b, h) + boff + n * 2048 + k * 1024); } while (0)
#define PG8_MMA(ai, bj, At, Bt) do { __builtin_amdgcn_s_setprio(1); _Pragma("unroll") for (int m = 0; m < 4; ++m) _Pragma("unroll") for (int n = 0; n < 2; ++n) _Pragma("unroll") for (int k = 0; k < 2; ++k) \
        { if constexpr (I8) acc[ai][bj][m][n] = __builtin_amdgcn_mfma_i32_16x16x64_i8(__builtin_bit_cast(i32x4, Bt[n][k]), __builtin_bit_cast(i32x4, At[m][k]), acc[ai][bj][m][n], 0, 0, 0); \
          else acc[ai][bj][m][n] = __builtin_amdgcn_mfma_f32_16x16x32_bf16(Bt[n][k], At[m][k], acc[ai][bj][m][n], 0, 0, 0); } __builtin_amdgcn_s_setprio(0); } while (0)
#define PG8_WAIT_V(n) asm volatile("s_waitcnt vmcnt(" #n ")" ::: "memory")
#define PG8_WAIT_L(n) asm volatile("s_waitcnt lgkmcnt(" #n ")" ::: "memory")
#define PG8_BAR __builtin_amdgcn_s_barrier()
#define PG8_SCHED __builtin_amdgcn_sched_barrier(0)
#define PG8_AOFF(dst, u) do { if constexpr (GATHER) { _Pragma("unroll") for (int _h = 0; _h < 2; ++_h) _Pragma("unroll") for (int _i = 0; _i < 2; ++_i) \
        dst[_h][_i] = S.arow(u, _h * HALF + sR[_i]) + (unsigned)sC[_i] * 2u; } } while (0)
#define PG8_STAGE_A(bufoff, gptr, h, usenext) do { if constexpr (GATHER) { _Pragma("unroll") for (int _i = 0; _i < 2; ++_i) { const unsigned _vo = (usenext) ? vAn[h][_i] : vAc[h][_i]; \
        __builtin_amdgcn_global_load_lds((const unsigned*)((const char*)(gptr) + _vo), (LAS unsigned*)(lds + (bufoff) + ldsw + _i * 8192), 16, 0, 0); } } \
        else { PG8_STAGE(bufoff, (gptr) + (h) * hstepA, voffA); } } while (0)
    Unit cur, nxt; int ui = 0;
    if (!S.next(0, cur)) return;
    typedef typename AccT<I8>::t acc_t;
    acc_t acc[2][2][4][2];
#pragma unroll
    for (int a = 0; a < 2; ++a)
#pragma unroll
        for (int b = 0; b < 2; ++b)
#pragma unroll
            for (int m = 0; m < 4; ++m)
#pragma unroll
                for (int n = 0; n < 2; ++n) acc[a][b][m][n] = (acc_t){0, 0, 0, 0};
    bf16x8 At[4][2], B0[2][2], B1[2][2];
    const char* cA = S.aptr(cur); const char* cB = S.bptr(cur);
    PG8_AOFF(vAc, cur);
    PG8_STAGE(PG8_SB(0, 0), cB, voffB); PG8_STAGE(PG8_SB(0, 1), cB + hstepB, voffB); PG8_STAGE_A(PG8_SA(0, 0), cA, 0, false); if constexpr (!HM) PG8_STAGE_A(PG8_SA(0, 1), cA, 1, false);
    if (wr == 1) PG8_BAR;
    if constexpr (HM) PG8_WAIT_V(0); else PG8_WAIT_V(2);
    PG8_BAR;
    PG8_STAGE(PG8_SB(1, 0), cB + kstep, voffB); PG8_STAGE_A(PG8_SA(1, 0), cA + kstep, 0, false); PG8_STAGE(PG8_SB(1, 1), cB + hstepB + kstep, voffB);
    PG8_WAIT_V(6); PG8_BAR;
    for (;;) {
        const bool has_next = S.next(ui + 1, nxt);
        const char* nA = has_next ? S.aptr(nxt) : cA; const char* nB = has_next ? S.bptr(nxt) : cB;
        if constexpr (GATHER) { if (has_next) { PG8_AOFF(vAn, nxt); } else {
#pragma unroll
            for (int h = 0; h < 2; ++h)
#pragma unroll
                for (int i = 0; i < 2; ++i) vAn[h][i] = vAc[h][i]; } }
#if defined(PROBE_MASK) && PROBE_MASK
        const unsigned long long _tk0 = __builtin_amdgcn_s_memrealtime();
#endif
        for (int t = 0; t < nt; t += 2) {
            const bool last = (t == nt - 2);
            const char* a1 = cA + (size_t)(t + 1) * kstep;
            const char* a2 = last ? nA : cA + (size_t)(t + 2) * kstep; const char* b2 = last ? nB : cB + (size_t)(t + 2) * kstep;
            const char* a3 = a2 + kstep; const char* b3 = b2 + kstep;
            if constexpr (!HM) {
            PG8_LDB(B0, 0, 0); PG8_LDB(B1, 0, 1); PG8_SCHED; PG8_LDA(At, 0, 0); PG8_STAGE_A(PG8_SA(1, 1), a1, 1, false);
            PG8_WAIT_V(8); PG8_WAIT_L(0); PG8_BAR; PG8_MMA(0, 0, At, B0); PG8_MMA(0, 1, At, B1); PG8_BAR; PG8_SCHED;
            PG8_LDA(At, 0, 1); PG8_STAGE(PG8_SB(0, 0), b2, voffB); PG8_STAGE(PG8_SB(0, 1), b2 + hstepB, voffB); PG8_STAGE_A(PG8_SA(0, 0), a2, 0, last);
            PG8_WAIT_V(8); PG8_WAIT_L(0); PG8_BAR; PG8_MMA(1, 0, At, B0); PG8_MMA(1, 1, At, B1); PG8_BAR; PG8_SCHED;
            PG8_LDB(B0, 1, 0); PG8_LDB(B1, 1, 1); PG8_SCHED; PG8_LDA(At, 1, 0); PG8_STAGE_A(PG8_SA(0, 1), a2, 1, last);
            PG8_WAIT_V(8); PG8_WAIT_L(0); PG8_BAR; PG8_MMA(0, 0, At, B0); PG8_MMA(0, 1, At, B1); PG8_BAR; PG8_SCHED;
            PG8_LDA(At, 1, 1); PG8_STAGE(PG8_SB(1, 0), b3, voffB); PG8_STAGE(PG8_SB(1, 1), b3 + hstepB, voffB); PG8_STAGE_A(PG8_SA(1, 0), a3, 0, last);
            PG8_WAIT_V(8); PG8_WAIT_L(0); PG8_BAR; PG8_MMA(1, 0, At, B0); PG8_MMA(1, 1, At, B1); PG8_BAR; PG8_SCHED;
            } else {
            (void)a1;
            PG8_LDB(B0, 0, 0); PG8_LDB(B1, 0, 1); PG8_SCHED; PG8_LDA(At, 0, 0);
            PG8_WAIT_L(0); PG8_BAR; PG8_MMA(0, 0, At, B0); PG8_MMA(0, 1, At, B1); PG8_BAR; PG8_SCHED;
            PG8_STAGE(PG8_SB(0, 0), b2, voffB); PG8_STAGE(PG8_SB(0, 1), b2 + hstepB, voffB); PG8_STAGE_A(PG8_SA(0, 0), a2, 0, last);
            PG8_WAIT_V(6); PG8_BAR; PG8_BAR; PG8_SCHED;
            PG8_LDB(B0, 1, 0); PG8_LDB(B1, 1, 1); PG8_SCHED; PG8_LDA(At, 1, 0);
            PG8_WAIT_L(0); PG8_BAR; PG8_MMA(0, 0, At, B0); PG8_MMA(0, 1, At, B1); PG8_BAR; PG8_SCHED;
            PG8_STAGE(PG8_SB(1, 0), b3, voffB); PG8_STAGE(PG8_SB(1, 1), b3 + hstepB, voffB); PG8_STAGE_A(PG8_SA(1, 0), a3, 0, last);
            PG8_WAIT_V(6); PG8_BAR; PG8_BAR; PG8_SCHED;
            }
        }
#if defined(PROBE_MASK) && PROBE_MASK
        if (blockIdx.x == PROBE_BLOCK && tid == 0 && ((volatile LAS unsigned*)(lds + 147456))[6]) ((LAS unsigned*)(lds + 147456 + 512))[14] += (unsigned)(__builtin_amdgcn_s_memrealtime() - _tk0);
#endif
        if (wr == 0) PG8_BAR;
#if defined(PROBE_MASK) && PROBE_MASK
        { const unsigned long long _t0 = __builtin_amdgcn_s_memrealtime();
          E(acc, cur, wr, wc, fr, fq);
          asm volatile("s_waitcnt vmcnt(0)" ::: "memory");
          if (blockIdx.x == PROBE_BLOCK && tid == 0 && ((volatile LAS unsigned*)(lds + 147456))[6]) ((LAS unsigned*)(lds + 147456 + 512))[13] += (unsigned)(__builtin_amdgcn_s_memrealtime() - _t0); }
#else
        E(acc, cur, wr, wc, fr, fq);
#endif
        if (!has_next) break;
#pragma unroll
        for (int a = 0; a < (HM ? 1 : 2); ++a)
#pragma unroll
            for (int b = 0; b < 2; ++b)
#pragma unroll
                for (int m = 0; m < 4; ++m)
#pragma unroll
                    for (int n = 0; n < 2; ++n) acc[a][b][m][n] = (acc_t){0, 0, 0, 0};
        cur = nxt; cA = nA; cB = nB; ++ui;
        if constexpr (GATHER) {
#pragma unroll
        for (int h = 0; h < 2; ++h)
#pragma unroll
            for (int i = 0; i < 2; ++i) vAc[h][i] = vAn[h][i]; }
        if (wr == 1) PG8_BAR;
    }
    PG8_WAIT_V(0);
    PG8_BAR;
#undef PG8_SA
#undef PG8_SB
#undef PG8_STAGE
#undef PG8_LDA
#undef PG8_LDB
#undef PG8_MMA
#undef PG8_WAIT_V
#undef PG8_WAIT_L
#undef PG8_BAR
#undef PG8_SCHED
#undef PG8_AOFF
#undef PG8_STAGE_A
}
}

constexpr int D = 1024, BATCH = 32, SEQ = 2048, DEPTH = 2;
constexpr int NCH = 2, BC = BATCH / NCH, TC = BC * SEQ;
constexpr int TT = BATCH * SEQ;
constexpr int NP = 10496;
constexpr int C_QA = 0, C_KA = 256, C_VA = 512, C_OG = 1024, C_GP = 1536, C_XB = 1792, C_YB = 2304, C_QKV = 2816, C_G = 7424;
constexpr int WIN_N = 10256;
constexpr int NE = 16, FF = 512;
constexpr int RP = 2 * TT + NE * 256;
constexpr float RMS_EPS = 1e-6f;
constexpr int NWAVES = 8, NTHR = 512;

constexpr size_t MiB = 1u << 20;
constexpr size_t WS_CTL = 0, CTL_ZERO_BYTES = 1 * MiB;
constexpr size_t WS_REC = 1 * MiB;
constexpr size_t WS_LIST = 2 * MiB;
constexpr size_t WS_W = 6 * MiB;
constexpr size_t LW_WIN = 0, LW_WBR = LW_WIN + (size_t)NP * D * 2, LW_WOUT = LW_WBR + (size_t)3 * D * 512 * 2, LW_WGU = LW_WOUT + (size_t)D * D * 2,
                 LW_WDN = LW_WGU + (size_t)NE * 1024 * D * 2, LW_SIZE = LW_WDN + (size_t)NE * D * FF * 2;
static_assert(LW_SIZE == 77070336, "layer weights");
constexpr size_t WS_BRC = 154 * MiB;
constexpr size_t WS_SA = WS_BRC + 2 * MiB;
constexpr size_t WS_SBR = WS_BRC + 3 * MiB;
constexpr size_t WS_ACT = 166 * MiB;
constexpr size_t WS_PROJ = 294 * MiB;
constexpr size_t WS_HID = WS_PROJ;
constexpr size_t WS_YS = WS_PROJ + 136 * MiB;
constexpr size_t WS_XB = WS_PROJ + 400 * MiB;
constexpr size_t WS_RSL = WS_PROJ + 656 * MiB;
constexpr size_t WS_END = WS_RSL + 4 * MiB;
static_assert(WS_W + 2 * LW_SIZE <= WS_BRC && WS_BRC + 12 * MiB <= WS_ACT && WS_ACT + (size_t)TT * D * 2 <= WS_PROJ && (size_t)TC * NP * 2 <= 656 * MiB && (size_t)RP * 512 * 2 <= 136 * MiB && WS_YS + (size_t)RP * 2048 <= WS_XB && WS_XB + (size_t)TT * D * 2 <= WS_RSL, "ws map");
constexpr int CW_BAR = 4096;
constexpr int CW_CNT = 8192;
constexpr int CW_Q = 12288;
constexpr int CW_CMAX3 = 65536 + 2 * NP + 2 * NE * 1024;
constexpr int CW_CMAX2 = 65536 + 2 * NP;
constexpr int CW_CMAX = 65536;

constexpr int RING_BYTES = 147456;
constexpr int MISC_OFF = RING_BYTES;
constexpr int LDS_BYTES = 155648;

#define LDS_WAIT() asm volatile("s_waitcnt lgkmcnt(0)" ::: "memory")
#define VM_WAIT() asm volatile("s_waitcnt vmcnt(0)" ::: "memory")
__device__ __forceinline__ float bf2f(unsigned short b) { return __uint_as_float(((unsigned)b) << 16); }
__device__ __forceinline__ float bflo(unsigned u) { return __uint_as_float(u << 16); }
__device__ __forceinline__ float bfhi(unsigned u) { return __uint_as_float(u & 0xffff0000u); }
typedef __bf16 bf16x2v_t __attribute__((ext_vector_type(2)));
__device__ __forceinline__ unsigned pk2(float lo, float hi) { const f32x2 v = {lo, hi}; return __builtin_bit_cast(unsigned, __builtin_convertvector(v, bf16x2v_t)); }
__device__ __forceinline__ unsigned f2bf(float f) { return pk2(f, 0.f) & 0xffffu; }
__device__ __forceinline__ float rcpf_(float x) { return __builtin_amdgcn_rcpf(x); }
__device__ __forceinline__ float rsqf_(float x) { return __builtin_amdgcn_rsqf(x); }
template <int O> __device__ __forceinline__ float swz_xor(float v) { return __int_as_float(__builtin_amdgcn_ds_swizzle(__float_as_int(v), (O << 10) | 0x1f)); }
__device__ __forceinline__ float wave_sum(float v) {
    v += swz_xor<1>(v); v += swz_xor<2>(v); v += swz_xor<4>(v); v += swz_xor<8>(v); v += swz_xor<16>(v);
    const auto r = __builtin_amdgcn_permlane32_swap(__float_as_uint(v), __float_as_uint(v), false, false);
    return __uint_as_float(r[0]) + __uint_as_float(r[1]);
}
__device__ __forceinline__ float wave_max(float v) {
    v = fmaxf(v, swz_xor<1>(v)); v = fmaxf(v, swz_xor<2>(v)); v = fmaxf(v, swz_xor<4>(v)); v = fmaxf(v, swz_xor<8>(v)); v = fmaxf(v, swz_xor<16>(v));
    const auto r = __builtin_amdgcn_permlane32_swap(__float_as_uint(v), __float_as_uint(v), false, false);
    return fmaxf(__uint_as_float(r[0]), __uint_as_float(r[1]));
}
__device__ __forceinline__ float sigmoidf_(float x) { return __builtin_amdgcn_rcpf(1.f + __expf(-x)); }

#define XB_TMO      128
#define XB_XCNT(j)  (256  + 64 * (j))
#define XB_XSUB(j)  (1280 + 64 * (j))
#define XB_XGEN(j)  (2304 + 64 * (j))
#define XB_TOP      3328
#define XB_TOPGEN   3392
#define XCD_BAR_WORDS 3456
#define XB_SPIN_CAP (1u << 21)
__device__ __forceinline__ unsigned xb_ld(unsigned* p)              { return __hip_atomic_load(p, __ATOMIC_RELAXED, __HIP_MEMORY_SCOPE_AGENT); }
__device__ __forceinline__ unsigned xb_add(unsigned* p, unsigned v) { return __hip_atomic_fetch_add(p, v, __ATOMIC_RELAXED, __HIP_MEMORY_SCOPE_AGENT); }
__device__ __forceinline__ unsigned xb_xcc_id() { return (unsigned)__builtin_amdgcn_s_getreg((3 << 11) | 20) & 0xFu; }
#define XB_SPIN(cond, bar) do { unsigned _sp = 0; while (cond) { __builtin_amdgcn_s_sleep(1); \
    if ((++_sp & 255u) == 0u) { if (xb_ld(&(bar)[XB_TMO])) break; if (_sp > XB_SPIN_CAP) { atomicAdd(&(bar)[XB_TMO], 1u); break; } } } } while (0)
struct XcdBarrier { unsigned* bar; unsigned x; volatile LAS unsigned* st; };
__device__ __forceinline__ XcdBarrier xcd_barrier_post(unsigned* bar, volatile LAS unsigned* st, int tid) {
    XcdBarrier b; b.bar = bar; b.x = xb_xcc_id(); b.st = st;
    if (tid == 0) (void)xb_add(&bar[XB_XCNT(b.x)], 1u);
    return b;
}
__device__ __forceinline__ void xcd_barrier_complete(unsigned* bar, unsigned x, unsigned& nloc, unsigned& nx) {
    const unsigned G = gridDim.x * gridDim.y * gridDim.z;
    unsigned sum, cnt, sp = 0u;
    for (;;) {
        sum = 0u; cnt = 0u;
#pragma unroll 1
        for (unsigned j = 0; j < 16; ++j) { const unsigned c = xb_ld(&bar[XB_XCNT(j)]); sum += c; cnt += (c > 0u) ? 1u : 0u; }
        if (sum == G) break;
        __builtin_amdgcn_s_sleep(1);
        if ((++sp & 255u) == 0u) { if (xb_ld(&bar[XB_TMO])) break; if (sp > XB_SPIN_CAP) { atomicAdd(&bar[XB_TMO], 1u); break; } }
    }
    const unsigned mine = xb_ld(&bar[XB_XCNT(x)]);
    nloc = mine > 0u ? mine : 1u; nx = cnt > 0u ? cnt : 1u;
}
__device__ __noinline__ void xcd_barrier(const XcdBarrier b, const int tid) {
    asm volatile("s_waitcnt vmcnt(0)" ::: "memory");
    __syncthreads();
    if (tid == 0) {
        unsigned* bar = b.bar;
        __builtin_amdgcn_s_waitcnt(0);
        unsigned nloc = b.st[0], nx = b.st[1];
        if (nloc == 0u) { xcd_barrier_complete(bar, b.x, nloc, nx); b.st[0] = nloc; b.st[1] = nx; }
        const unsigned old = xb_add(&bar[XB_XSUB(b.x)], 1u);
        const unsigned gen = old / nloc;
        if (old + 1u == (gen + 1u) * nloc) {
            __builtin_amdgcn_fence(__ATOMIC_RELEASE, "agent");
            asm volatile("s_waitcnt vmcnt(0)" ::: "memory");
            const unsigned og = xb_add(&bar[XB_TOP], 1u);
            const unsigned tg = og / nx;
            if (og + 1u == (tg + 1u) * nx) xb_add(&bar[XB_TOPGEN], 1u);
            else XB_SPIN(xb_ld(&bar[XB_TOPGEN]) == tg, bar);
            __builtin_amdgcn_fence(__ATOMIC_ACQUIRE, "agent");
            xb_add(&bar[XB_XGEN(b.x)], 1u);
            asm volatile("s_waitcnt vmcnt(0)" ::: "memory");
        } else {
            XB_SPIN(xb_ld(&bar[XB_XGEN(b.x)]) == gen, bar);
            __builtin_amdgcn_fence(__ATOMIC_ACQUIRE, "agent");
            asm volatile("s_waitcnt vmcnt(0)" ::: "memory");
        }
    }
    __syncthreads();
}

struct Args { const void* in[24]; float* out; unsigned char* ws; int ph_lo, ph_hi; };
struct Ctx {
    LAS unsigned char* lds;
    unsigned* ctl;
    int tid, lane, wave, bid, G;
    int chunk, layer, pass;
    const float* x_in; float* xo;
    const float* xinf; float* xof; bf16_t* actf;
    float* sa;
    float* sbr;
    bf16_t* xb; bf16_t* x2;
    const int* pos;
    const unsigned char* lw;
    bf16_t *act, *proj, *hid, *ys;
    unsigned* rec; int* list; float* rsl;
};

template <class DMap>
__device__ __forceinline__ void tr_item64(const float* srcA, const float* srcB, int Nsrc, float scale, bf16_t* WT, int K, int n0, int k0, LAS float* scr, int lane, DMap dmap) {
    const int r4 = lane >> 4, c16 = lane & 15;
    const float* src = (c16 < 8 ? srcA + 4 * c16 : srcB + 4 * (c16 - 8));
    f32x4 v[16];
#pragma unroll
    for (int i = 0; i < 16; ++i) v[i] = *(const f32x4*)(src + (size_t)(k0 + 4 * i + r4) * Nsrc);
#pragma unroll
    for (int i = 0; i < 16; ++i) { LAS float* d = scr + (4 * i + r4) * 65 + 4 * c16; d[0] = v[i].x * scale; d[1] = v[i].y * scale; d[2] = v[i].z * scale; d[3] = v[i].w * scale; }
    LDS_WAIT(); asm volatile("" ::: "memory");
    const int kc = lane & 7;
#pragma unroll
    for (int j = 0; j < 8; ++j) { const int r = (lane >> 3) + 8 * j; const LAS float* q = scr + (8 * kc) * 65 + dmap(r);
        u32x4 o; o.x = pk2(q[0 * 65], q[1 * 65]); o.y = pk2(q[2 * 65], q[3 * 65]); o.z = pk2(q[4 * 65], q[5 * 65]); o.w = pk2(q[6 * 65], q[7 * 65]);
        *(u32x4*)(WT + (size_t)(n0 + r) * K + k0 + 8 * kc) = o; }
    LDS_WAIT(); asm volatile("" ::: "memory");
}
struct DMapId { __device__ __forceinline__ int operator()(int r) const { return r; } };
struct DMapGU { __device__ __forceinline__ int operator()(int r) const { return ((r >> 4) & 1) * 32 + (r >> 5) * 16 + (r & 15); } };
template <class DMap>
__device__ __forceinline__ void tr_item64q(const float* srcA, const float* srcB, int Nsrc, float scale, signed char* WTq, int K, int n0, int k0, LAS float* scr, int lane, const unsigned* cmax, DMap dmap) {
    const int r4 = lane >> 4, c16 = lane & 15;
    const float* src = (c16 < 8 ? srcA + 4 * c16 : srcB + 4 * (c16 - 8));
    f32x4 v[16];
#pragma unroll
    for (int i = 0; i < 16; ++i) v[i] = *(const f32x4*)(src + (size_t)(k0 + 4 * i + r4) * Nsrc);
#pragma unroll
    for (int i = 0; i < 16; ++i) { LAS float* d = scr + (4 * i + r4) * 65 + 4 * c16; d[0] = v[i].x * scale; d[1] = v[i].y * scale; d[2] = v[i].z * scale; d[3] = v[i].w * scale; }
    LDS_WAIT(); asm volatile("" ::: "memory");
    const int kc = lane & 3;
#pragma unroll
    for (int j = 0; j < 4; ++j) { const int r = (lane >> 2) + 16 * j; const LAS float* q = scr + (16 * kc) * 65 + dmap(r);
        const float mx = __uint_as_float(cmax[n0 + r]); const float inv = mx > 0.f ? 127.f / mx : 0.f;
        unsigned w[4];
#pragma unroll
        for (int k = 0; k < 4; ++k) { const int q0 = (int)__builtin_rintf(q[(4 * k + 0) * 65] * inv), q1 = (int)__builtin_rintf(q[(4 * k + 1) * 65] * inv), q2 = (int)__builtin_rintf(q[(4 * k + 2) * 65] * inv), q3 = (int)__builtin_rintf(q[(4 * k + 3) * 65] * inv);
            w[k] = (unsigned)(q0 & 0xff) | ((unsigned)(q1 & 0xff) << 8) | ((unsigned)(q2 & 0xff) << 16) | ((unsigned)(q3 & 0xff) << 24); }
        u32x4 o; o.x = w[0]; o.y = w[1]; o.z = w[2]; o.w = w[3];
        *(u32x4*)(WTq + (size_t)(n0 + r) * K + k0 + 16 * kc) = o; }
    LDS_WAIT(); asm volatile("" ::: "memory");
}
__device__ __forceinline__ void cmax_item64(const float* srcA, int Nsrc, float scale, int n0, int k0, int lane, unsigned* cmax) {
    const int r4 = lane >> 4, c16 = lane & 15;
    const float* src = srcA + 4 * c16;
    f32x4 m = {0.f, 0.f, 0.f, 0.f};
#pragma unroll
    for (int i = 0; i < 16; ++i) { const f32x4 v = *(const f32x4*)(src + (size_t)(k0 + 4 * i + r4) * Nsrc);
        m.x = fmaxf(m.x, fabsf(v.x)); m.y = fmaxf(m.y, fabsf(v.y)); m.z = fmaxf(m.z, fabsf(v.z)); m.w = fmaxf(m.w, fabsf(v.w)); }
    m.x = fmaxf(m.x, swz_xor<16>(m.x)); m.y = fmaxf(m.y, swz_xor<16>(m.y)); m.z = fmaxf(m.z, swz_xor<16>(m.z)); m.w = fmaxf(m.w, swz_xor<16>(m.w));
    const float mv[4] = {m.x, m.y, m.z, m.w};
#pragma unroll
    for (int k = 0; k < 4; ++k) { const auto r = __builtin_amdgcn_permlane32_swap(__float_as_uint(mv[k]), __float_as_uint(mv[k]), false, false);
        const float t = fmaxf(__uint_as_float(r[0]), __uint_as_float(r[1])) * scale;
        if (lane < 16) atomicMax(cmax + n0 + 4 * c16 + k, __float_as_uint(t)); }
}
constexpr int IT_WIN = (NP / 64) * 16, IT_WBR = 3 * 16 * 8, IT_WOUT = 16 * 16, IT_WGU = NE * 16 * 16, IT_WDN = NE * 16 * 8, IT_LAYER = IT_WIN + IT_WBR + IT_WOUT + IT_WGU + IT_WDN;
__device__ __forceinline__ void cmax_item64gu(const float* src0, int Nsrc, int col0, int isup, int k0, int lane, unsigned* cmax) {
    const int r4 = lane >> 4, c16 = lane & 15;
    const float* src = src0 + col0 + 4 * c16;
    f32x4 m = {0.f, 0.f, 0.f, 0.f};
#pragma unroll
    for (int i = 0; i < 16; ++i) { const f32x4 v = *(const f32x4*)(src + (size_t)(k0 + 4 * i + r4) * Nsrc);
        m.x = fmaxf(m.x, fabsf(v.x)); m.y = fmaxf(m.y, fabsf(v.y)); m.z = fmaxf(m.z, fabsf(v.z)); m.w = fmaxf(m.w, fabsf(v.w)); }
    m.x = fmaxf(m.x, swz_xor<16>(m.x)); m.y = fmaxf(m.y, swz_xor<16>(m.y)); m.z = fmaxf(m.z, swz_xor<16>(m.z)); m.w = fmaxf(m.w, swz_xor<16>(m.w));
    const float mv[4] = {m.x, m.y, m.z, m.w};
#pragma unroll
    for (int k = 0; k < 4; ++k) { const auto r = __builtin_amdgcn_permlane32_swap(__float_as_uint(mv[k]), __float_as_uint(mv[k]), false, false);
        const float t = fmaxf(__uint_as_float(r[0]), __uint_as_float(r[1])); const int j = col0 + 4 * c16 + k;
        if (lane < 16) atomicMax(cmax + 32 * (j >> 4) + 16 * isup + (j & 15), __float_as_uint(t)); }
}
__device__ __forceinline__ void phase_prep_a(const Args& a, float* tmpf, unsigned* cmaxb, int gw, int NGW, int lane, int gtid, int NGT) {
    constexpr int IT = (WIN_N / 64) * 16;
    for (int it = gw; it < DEPTH * IT; it += NGW) {
        const int l = it / IT, r = it % IT, gsrc = r / 16, kb = r % 16;
        int src = 64 * gsrc; if (src >= 1536) src += 16;
        const int n0 = src < 1536 ? src : src + 240;
        const float* W = (const float*)a.in[3] + (size_t)l * D * WIN_N + src;
        cmax_item64(W, WIN_N, n0 < 256 ? 0.125f : 1.f, n0, 64 * kb, lane, cmaxb + (size_t)l * NP);
    }
    constexpr int ITB = 3 * 16 * 8;
    for (int it = gw; it < DEPTH * ITB; it += NGW) {
        const int l = it / ITB, r = it % ITB, b = r / 128, g = (r / 8) & 15, kb = r % 8;
        const float* W = (const float*)a.in[16] + ((size_t)l * 3 + b) * 512 * D + 64 * g;
        cmax_item64(W, D, 1.f, 64 * g, 64 * kb, lane, cmaxb + (CW_CMAX3 - CW_CMAX) + ((size_t)l * 3 + b) * 1024);
    }
    constexpr int ITG = NE * 2 * 8 * 16;
    for (int it = gw; it < DEPTH * ITG; it += NGW) {
        const int l = it / ITG, r = it % ITG, e = r / 256, isup = (r / 128) & 1, cg = (r / 16) & 7, kb = r % 16;
        const float* W = (isup ? (const float*)a.in[22] : (const float*)a.in[21]) + ((size_t)l * NE + e) * D * FF;
        cmax_item64gu(W, FF, 64 * cg, isup, 64 * kb, lane, cmaxb + (CW_CMAX2 - CW_CMAX) + ((size_t)l * NE + e) * 1024);
    }
    for (int idx = gtid; idx < DEPTH * 256 * D; idx += NGT) {
        const int l = idx / (256 * D), j = (idx / D) % 256, k = idx % D;
        const float* W = (const float*)a.in[3] + (size_t)l * D * WIN_N + (size_t)k * WIN_N + 1536;
        const float* gu = (const float*)a.in[4] + (size_t)l * 16 * 256 + j;
        float s = 0.f;
#pragma unroll
        for (int r = 0; r < 16; ++r) s += W[r] * gu[r * 256];
        tmpf[idx] = s;
        float m = fabsf(s); m = wave_max(m);
        if (lane == 0) atomicMax(cmaxb + (size_t)l * NP + C_GP + j, __float_as_uint(m));
    }
}
__device__ __forceinline__ void phase_prep(const Args& a, const float* tmpf, const unsigned* cmaxb, LAS unsigned char* lds, int gw, int NGW, int wave, int lane, int gtid, int NGT) {
    LAS float* scr = (LAS float*)(lds + wave * 17408);
    for (int it = gw; it < DEPTH * IT_LAYER; it += NGW) {
        const int l = it / IT_LAYER; int r = it % IT_LAYER;
        unsigned char* lw = a.ws + WS_W + (size_t)l * LW_SIZE;
        if (r < IT_WIN) {
            const int g = r / 16, kb = r % 16;
            if (g >= C_GP / 64 && g < C_XB / 64) continue;
            const int n0 = 64 * g, src = n0 < C_GP ? n0 : n0 - 240;
            const float* W = (const float*)a.in[3] + (size_t)l * D * WIN_N + src;
            tr_item64q(W, W + 32, WIN_N, n0 < 256 ? 0.125f : 1.f, (signed char*)(lw + LW_WIN), D, n0, 64 * kb, scr, lane, cmaxb + (size_t)l * NP, DMapId());
            continue; }
        r -= IT_WIN;
        if (r < IT_WBR) {
            const int b = r / 128, g = (r % 128) / 8, kb = r % 8;
            const float* W = (const float*)a.in[16] + ((size_t)l * 3 + b) * 512 * D + 64 * g;
            tr_item64q(W, W + 32, D, 1.f, (signed char*)(lw + LW_WBR) + (size_t)b * D * 512, 512, 64 * g, 64 * kb, scr, lane, cmaxb + (CW_CMAX3 - CW_CMAX) + ((size_t)l * 3 + b) * 1024, DMapId());
            continue; }
        r -= IT_WBR;
        if (r < IT_WOUT) {
            const int g = r / 16, kb = r % 16;
            const float* W = (const float*)a.in[17] + (size_t)l * D * D + 64 * g;
            tr_item64(W, W + 32, D, 1.f, (bf16_t*)(lw + LW_WOUT), D, 64 * g, 64 * kb, scr, lane, DMapId());
            continue; }
        r -= IT_WOUT;
        if (r < IT_WGU) {
            const int e = r / 256, g = (r % 256) / 16, kb = r % 16;
            const float* Wg = (const float*)a.in[21] + ((size_t)l * NE + e) * D * FF + 32 * g;
            const float* Wu = (const float*)a.in[22] + ((size_t)l * NE + e) * D * FF + 32 * g;
            tr_item64q(Wg, Wu, FF, 1.f, (signed char*)(lw + LW_WGU) + (size_t)e * 1024 * D, D, 64 * g, 64 * kb, scr, lane, cmaxb + (CW_CMAX2 - CW_CMAX) + ((size_t)l * NE + e) * 1024, DMapGU());
            continue; }
        r -= IT_WGU;
        {
            const int e = r / 128, g = (r % 128) / 8, kb = r % 8;
            const float* W = (const float*)a.in[23] + ((size_t)l * NE + e) * FF * D + 64 * g;
            tr_item64(W, W + 32, D, 1.f, (bf16_t*)(lw + LW_WDN) + (size_t)e * D * FF, FF, 64 * g, 64 * kb, scr, lane, DMapId());
        }
    }
    for (int idx = gtid; idx < DEPTH * 256 * (D / 16); idx += NGT) {
        const int l = idx / (256 * (D / 16)), j = (idx / (D / 16)) % 256, k16 = idx % (D / 16);
        const float mx = __uint_as_float(cmaxb[(size_t)l * NP + C_GP + j]); const float inv = mx > 0.f ? 127.f / mx : 0.f;
        const f32x4* t = (const f32x4*)(tmpf + ((size_t)l * 256 + j) * D + 16 * k16);
        unsigned w[4];
#pragma unroll
        for (int k = 0; k < 4; ++k) { const f32x4 v = t[k]; const int q0 = (int)__builtin_rintf(v.x * inv), q1 = (int)__builtin_rintf(v.y * inv), q2 = (int)__builtin_rintf(v.z * inv), q3 = (int)__builtin_rintf(v.w * inv);
            w[k] = (unsigned)(q0 & 0xff) | ((unsigned)(q1 & 0xff) << 8) | ((unsigned)(q2 & 0xff) << 16) | ((unsigned)(q3 & 0xff) << 24); }
        u32x4 o; o.x = w[0]; o.y = w[1]; o.z = w[2]; o.w = w[3];
        *(u32x4*)((signed char*)(a.ws + WS_W + (size_t)l * LW_SIZE + LW_WIN) + (size_t)(C_GP + j) * D + 16 * k16) = o;
    }
}

__device__ __forceinline__ void moe_tables(const unsigned* cnt, LAS int* pt, LAS int* lc, int tid) {
    if (tid == 0) { int s = 0;
        for (int e = 0; e < NE; ++e) { const int c = (int)__hip_atomic_load(cnt + e, __ATOMIC_RELAXED, __HIP_MEMORY_SCOPE_AGENT); pt[e] = s; lc[e] = c; s += (c + 255) >> 8; }
        pt[NE] = s; }
    __syncthreads();
}

template <bool COMBINE, bool NORM, bool SRC_BF16>
__device__ __forceinline__ void phase_norm1(const Ctx& c, const float* gain, LAS const int* pt) {
    const int gw = c.bid * NWAVES + c.wave, NGW = c.G * NWAVES, lane = c.lane;
    f32x4 g4[4];
    if (NORM) {
#pragma unroll
        for (int j = 0; j < 4; ++j) g4[j] = *((const f32x4*)gain + 64 * j + lane); }
    constexpr int NR = 4;
    static_assert(TT % (NR * 2048) == 0, "rows per wave");
    for (int tok0 = gw; tok0 < TT; tok0 += NR * NGW) {
        f32x4 v[NR][4]; u32x2 xs[NR][4]; u32x2 ya[NR][4], yb[NR][4]; float w0[NR], w1[NR];
#pragma unroll
        for (int r = 0; r < NR; ++r) { const int tok = tok0 + r * NGW;
            if (SRC_BF16) { const u32x2* xr = (const u32x2*)(c.xb + (size_t)tok * D) + lane;
#pragma unroll
                for (int j = 0; j < 4; ++j) xs[r][j] = xr[64 * j]; }
            else { const f32x4* xr = (const f32x4*)(c.xinf + (size_t)tok * D) + lane;
#pragma unroll
                for (int j = 0; j < 4; ++j) v[r][j] = xr[64 * j]; }
            if (COMBINE) {
                const u32x4 rc = *(const u32x4*)(c.rec + (size_t)tok * 4);
                const int e0 = rc.x >> 20, e1 = rc.y >> 20;
                const size_t r0 = (size_t)pt[e0] * 256 + (rc.x & 0xfffffu), r1 = (size_t)pt[e1] * 256 + (rc.y & 0xfffffu);
                w0[r] = __uint_as_float(rc.z); w1[r] = __uint_as_float(rc.w);
                const u32x2* y0 = (const u32x2*)(c.ys + r0 * D) + lane; const u32x2* y1 = (const u32x2*)(c.ys + r1 * D) + lane;
#pragma unroll
                for (int j = 0; j < 4; ++j) { ya[r][j] = y0[64 * j]; yb[r][j] = y1[64 * j]; }
            } }
#pragma unroll
        for (int r = 0; r < NR; ++r) { const int tok = tok0 + r * NGW;
            if (SRC_BF16) {
#pragma unroll
                for (int j = 0; j < 4; ++j) { v[r][j].x = bflo(xs[r][j].x); v[r][j].y = bfhi(xs[r][j].x); v[r][j].z = bflo(xs[r][j].y); v[r][j].w = bfhi(xs[r][j].y); } }
            if (COMBINE) {
#pragma unroll
                for (int j = 0; j < 4; ++j) { const u32x2 a = ya[r][j], b = yb[r][j];
                    v[r][j].x += w0[r] * bflo(a.x) + w1[r] * bflo(b.x); v[r][j].y += w0[r] * bfhi(a.x) + w1[r] * bfhi(b.x);
                    v[r][j].z += w0[r] * bflo(a.y) + w1[r] * bflo(b.y); v[r][j].w += w0[r] * bfhi(a.y) + w1[r] * bfhi(b.y); }
                if (NORM) { u32x2* xw = (u32x2*)(c.x2 + (size_t)tok * D) + lane;
#pragma unroll
                    for (int j = 0; j < 4; ++j) { u32x2 w; w.x = pk2(v[r][j].x, v[r][j].y); w.y = pk2(v[r][j].z, v[r][j].w); xw[64 * j] = w; } }
                else { f32x4* xw = (f32x4*)(c.xof + (size_t)tok * D) + lane;
#pragma unroll
                    for (int j = 0; j < 4; ++j) __builtin_nontemporal_store(v[r][j], xw + 64 * j); }
            }
            if (NORM) {
                float ss = 0.f;
#pragma unroll
                for (int j = 0; j < 4; ++j) ss += (v[r][j].x * v[r][j].x + v[r][j].y * v[r][j].y) + (v[r][j].z * v[r][j].z + v[r][j].w * v[r][j].w);
                const float rs = rsqf_(wave_sum(ss) * (1.f / D) + RMS_EPS);
                float am = 0.f;
#pragma unroll
                for (int j = 0; j < 4; ++j) { v[r][j] = v[r][j] * rs * g4[j]; am = fmaxf(am, fmaxf(fmaxf(fabsf(v[r][j].x), fabsf(v[r][j].y)), fmaxf(fabsf(v[r][j].z), fabsf(v[r][j].w)))); }
                am = wave_max(am);
                const float inv = am > 0.f ? 127.f / am : 0.f;
                if (lane == 0) c.sa[tok] = am * (1.f / 127.f);
                unsigned* o = (unsigned*)((signed char*)c.actf + ((size_t)(tok / TC) * TC * 2 + (size_t)(tok % TC)) * D) + lane;
#pragma unroll
                for (int j = 0; j < 4; ++j) { const int q0 = (int)__builtin_rintf(v[r][j].x * inv), q1 = (int)__builtin_rintf(v[r][j].y * inv), q2 = (int)__builtin_rintf(v[r][j].z * inv), q3 = (int)__builtin_rintf(v[r][j].w * inv);
                    o[64 * j] = (unsigned)(q0 & 0xff) | ((unsigned)(q1 & 0xff) << 8) | ((unsigned)(q2 & 0xff) << 16) | ((unsigned)(q3 & 0xff) << 24); }
            } }
    }
}

__constant__ double kInvFreq[16] = {1.0, 0.44036660267178046, 0.19392274474868576, 0.08539710028576561, 0.03760603093086393, 0.016560440080994446, 0.007292664737217109, 0.003211445994752591,
    0.001414213562373095, 0.000622772421914596, 0.0002742481756762073, 0.00012076973741146504, 5.318295896944988e-05, 2.341999896140934e-05, 1.031338537721246e-05, 4.5416704806078695e-06};
__device__ __forceinline__ void phase_rope_table(const int* pos, float* tab, int gtid, int NGT) {
    for (int idx = gtid; idx < BATCH * SEQ * 16; idx += NGT) { const int tok = idx >> 4, i = idx & 15;
        double a = (double)pos[tok] * kInvFreq[i] * 0.15915494309189535; a -= rint(a);
        tab[(size_t)tok * 32 + i] = __builtin_amdgcn_cosf((float)a); tab[(size_t)tok * 32 + 16 + i] = __builtin_amdgcn_sinf((float)a); }
}

__device__ __forceinline__ float logsigmoidf_(float g) { return fminf(g, 0.f) - log1pf(__expf(-fabsf(g))); }
__device__ __forceinline__ float gelu_tanh(float y) { const float u2 = 1.5957691216057308f * (y + 0.044715f * y * y * y); return y * __builtin_amdgcn_rcpf(1.f + __expf(-u2)); }


typedef unsigned short u16x4 __attribute__((ext_vector_type(4)));
__device__ __forceinline__ unsigned offb(unsigned row, unsigned ch) { return 256u * row + 16u * (ch ^ (((row & 3u) << 2) | ((row >> 2) & 3u))); }
constexpr int ATT_UNITS_PER_SEQ = 3 * 4 * 16;
struct AttU { int b, p, h, blk, dsh, it0; size_t tok0; int qcol, kcol, vcol; };
__device__ __forceinline__ AttU att_decode(int unit) {
    AttU a; a.b = unit / ATT_UNITS_PER_SEQ; const int rem = unit % ATT_UNITS_PER_SEQ; a.p = rem / 64; a.h = (rem / 16) & 3; const int qb = rem & 15;
    a.dsh = 2 * a.p; const int nblk = 16 >> a.dsh, r = qb / nblk; a.blk = qb % nblk; a.tok0 = (size_t)a.b * SEQ + r; a.it0 = a.blk == 0 ? 4 : 0;
    a.qcol = C_QKV + (a.p * 4 + a.h) * 128; a.kcol = C_QKV + (12 + a.p * 4 + a.h) * 128; a.vcol = C_QKV + (24 + a.p * 4 + a.h) * 128; return a;
}
#define ATT_DMA(U, col, dst) do { const unsigned _ch = ((unsigned)lane & 15u) ^ ((((unsigned)lane >> 4) << 2) | ((unsigned)w & 3u)); \
        const int _srow0 = ((U).blk - 1) * 128 + 4 * w + (lane >> 4); \
        const bf16_t* _p0 = c.proj + ((long)(U).tok0 + (long)_srow0 * (long)(1 << (U).dsh)) * NP + (col) + _ch * 8; const size_t _st = ((size_t)32 << (U).dsh) * NP; \
        _Pragma("unroll") for (int it = 0; it < 8; ++it) if (it >= (U).it0) \
            __builtin_amdgcn_global_load_lds((const unsigned*)(_p0 + it * _st), (LAS unsigned*)((dst) + 1024 * (w + 8 * it)), 16, 0, 0); } while (0)
#define ATT_LOADQ(U) do { const size_t qt = (U).tok0 + ((size_t)((U).blk * 128 + qi) << (U).dsh); \
        _Pragma("unroll") for (int s = 0; s < 4; ++s) qr[s] = *(const u32x4*)(c.proj + qt * NP + (U).qcol + 32 * s + 8 * g); \
        const f32x4* rt = (const f32x4*)(rope_tab + qt * 32 + 8 * (g & 1)); qc0 = rt[0]; qc1 = rt[1]; qs0 = rt[4]; qs1 = rt[5]; \
        int srow = ((U).blk - 1) * 128 + (int)rrow; if (srow < 0) srow += 128; \
        const float* rt2 = rope_tab + ((U).tok0 + ((size_t)srow << (U).dsh)) * 32 + 8 * rps; \
        rc0 = *(const f32x4*)rt2; rc1 = *(const f32x4*)(rt2 + 4); rs0 = *(const f32x4*)(rt2 + 16); rs1 = *(const f32x4*)(rt2 + 20); } while (0)
__device__ __forceinline__ void attn_loop(const Ctx& c, unsigned* qhead, volatile LAS unsigned* mbox, float* lse_buf, const float* qgain, const float* kgain, const float* rope_tab  ) {
    const int tid = c.tid, lane = c.lane, w = c.wave;
    const unsigned NU = (unsigned)(BC * ATT_UNITS_PER_SEQ);
    LAS unsigned char* sK = c.lds; LAS unsigned char* sV = c.lds + 65536;
    LAS float* sRS = (LAS float*)(c.lds + MISC_OFF + 2048);
    const int qq = lane & 15, g = lane >> 4, qi = 16 * w + qq;
    const unsigned rrow = (unsigned)tid >> 1, rps = (unsigned)tid & 1u;
#if defined(PROBE_MASK) && PROBE_MASK
    unsigned long long _ta = __builtin_amdgcn_s_memrealtime();
#define ATT_STAMP(k) do { const unsigned long long _tb = __builtin_amdgcn_s_memrealtime(); if (blockIdx.x == PROBE_BLOCK && tid == 0) ((LAS unsigned*)(c.lds + MISC_OFF + 512))[(k)] += (unsigned)(_tb - _ta); _ta = _tb; } while (0)
#else
#define ATT_STAMP(k) do {} while (0)
#endif
    LAS float* sGQ = (LAS float*)(c.lds + MISC_OFF + 3072); LAS float* sGK = sGQ + 128;
    if (tid < 128) sGQ[tid] = qgain[tid]; else if (tid < 256) sGK[tid - 128] = kgain[tid - 128];
    if (tid == 0) { mbox[0] = __hip_atomic_fetch_add(qhead, 1u, __ATOMIC_RELAXED, __HIP_MEMORY_SCOPE_AGENT); mbox[1] = __hip_atomic_fetch_add(qhead, 1u, __ATOMIC_RELAXED, __HIP_MEMORY_SCOPE_AGENT); }
    __syncthreads();
    unsigned ucur = mbox[0], unxt = mbox[1];
    if (ucur >= NU) return;
    AttU U = att_decode((int)ucur);
    u32x4 qr[4]; f32x4 qc0, qc1, qs0, qs1, rc0, rc1, rs0, rs1;
    __syncthreads();
    ATT_DMA(U, U.kcol, sK); asm volatile("" ::: "memory");
    ATT_LOADQ(U); asm volatile("" ::: "memory");
    ATT_DMA(U, U.vcol, sV); asm volatile("" ::: "memory");
    bool first = true; unsigned nq = 0u;
    for (;;) {
        const int blk = U.blk, dsh = U.dsh, it0 = U.it0;
        const size_t qtok = U.tok0 + ((size_t)(blk * 128 + qi) << dsh);
        bf16x8 qf[4];
        {
            float qv[4][8]; float ss = 0.f;
#pragma unroll
            for (int s = 0; s < 4; ++s) { const unsigned wv[4] = {qr[s].x, qr[s].y, qr[s].z, qr[s].w};
#pragma unroll
                for (int k = 0; k < 4; ++k) { qv[s][2 * k] = bflo(wv[k]); qv[s][2 * k + 1] = bfhi(wv[k]); ss += qv[s][2 * k] * qv[s][2 * k] + qv[s][2 * k + 1] * qv[s][2 * k + 1]; } }
            ss += swz_xor<16>(ss);
            { const auto rr = __builtin_amdgcn_permlane32_swap(__float_as_uint(ss), __float_as_uint(ss), false, false); ss = __uint_as_float(rr[0]) + __uint_as_float(rr[1]); }
            const float rs = rsqf_(ss * (1.f / 128.f) + RMS_EPS);
#pragma unroll
            for (int s = 0; s < 4; ++s) { const f32x4 g0 = *(const LAS f32x4*)(sGQ + 32 * s + 8 * g), g1 = *(const LAS f32x4*)(sGQ + 32 * s + 8 * g + 4);
                const float gg[8] = {g0.x, g0.y, g0.z, g0.w, g1.x, g1.y, g1.z, g1.w};
#pragma unroll
                for (int j = 0; j < 8; ++j) qv[s][j] *= rs * gg[j]; }
            { const float cs8[8] = {qc0.x, qc0.y, qc0.z, qc0.w, qc1.x, qc1.y, qc1.z, qc1.w}, sn8[8] = {qs0.x, qs0.y, qs0.z, qs0.w, qs1.x, qs1.y, qs1.z, qs1.w};
              const float sgn = (g & 2) ? 1.f : -1.f;
#pragma unroll
              for (int j = 0; j < 8; ++j) { const auto rr = __builtin_amdgcn_permlane32_swap(__float_as_uint(qv[0][j]), __float_as_uint(qv[0][j]), false, false);
                  const float other = (g & 2) ? __uint_as_float(rr[0]) : __uint_as_float(rr[1]);
                  qv[0][j] = qv[0][j] * cs8[j] + sgn * other * sn8[j]; } }
#pragma unroll
            for (int s = 0; s < 4; ++s) { u32x4 pw; pw.x = pk2(qv[s][0], qv[s][1]); pw.y = pk2(qv[s][2], qv[s][3]); pw.z = pk2(qv[s][4], qv[s][5]); pw.w = pk2(qv[s][6], qv[s][7]); qf[s] = __builtin_bit_cast(bf16x8, pw); }
        }
        const f32x4 kc0 = rc0, kc1 = rc1, ks0v = rs0, ks1v = rs1;
        if (first) { if (it0) asm volatile("s_waitcnt vmcnt(4)" ::: "memory"); else asm volatile("s_waitcnt vmcnt(8)" ::: "memory"); }
        else       { if (it0) asm volatile("s_waitcnt vmcnt(13)" ::: "memory"); else asm volatile("s_waitcnt vmcnt(17)" ::: "memory"); }
        first = false;
        __syncthreads();
        if (tid == 0) nq = __hip_atomic_fetch_add(qhead, 1u, __ATOMIC_RELAXED, __HIP_MEMORY_SCOPE_AGENT);
        ATT_STAMP(5);
        {
            const int c16 = tid & 15, grp = tid >> 4;
            const f32x4 kg0 = *(const LAS f32x4*)(sGK + 8 * c16), kg1 = *(const LAS f32x4*)(sGK + 8 * c16 + 4);
            const float kg[8] = {kg0.x, kg0.y, kg0.z, kg0.w, kg1.x, kg1.y, kg1.z, kg1.w};
#pragma unroll 4
            for (int it = it0; it < 8; ++it) { const unsigned row = 32u * it + grp;
                LAS u32x4* kp_ = (LAS u32x4*)(sK + offb(row, c16));
                const u32x4 kr = *kp_; const unsigned wv[4] = {kr.x, kr.y, kr.z, kr.w};
                float kv[8]; float ss = 0.f;
#pragma unroll
                for (int k = 0; k < 4; ++k) { kv[2 * k] = bflo(wv[k]); kv[2 * k + 1] = bfhi(wv[k]); ss += kv[2 * k] * kv[2 * k] + kv[2 * k + 1] * kv[2 * k + 1]; }
                ss += swz_xor<1>(ss); ss += swz_xor<2>(ss); ss += swz_xor<4>(ss); ss += swz_xor<8>(ss);
                const float rs = rsqf_(ss * (1.f / 128.f) + RMS_EPS);
                if (c16 == 0) sRS[row] = rs;
                if (c16 >= 4) { u32x4 ko; ko.x = pk2(kv[0] * rs * kg[0], kv[1] * rs * kg[1]); ko.y = pk2(kv[2] * rs * kg[2], kv[3] * rs * kg[3]); ko.z = pk2(kv[4] * rs * kg[4], kv[5] * rs * kg[5]); ko.w = pk2(kv[6] * rs * kg[6], kv[7] * rs * kg[7]); *kp_ = ko; } }
        }
        __syncthreads();
        {
            const f32x4 ga0 = *(const LAS f32x4*)(sGK + 8 * rps), ga1 = *(const LAS f32x4*)(sGK + 8 * rps + 4), gb0 = *(const LAS f32x4*)(sGK + 16 + 8 * rps), gb1 = *(const LAS f32x4*)(sGK + 20 + 8 * rps);
            const float ga[8] = {ga0.x, ga0.y, ga0.z, ga0.w, ga1.x, ga1.y, ga1.z, ga1.w}, gb[8] = {gb0.x, gb0.y, gb0.z, gb0.w, gb1.x, gb1.y, gb1.z, gb1.w};
            const float cs8[8] = {kc0.x, kc0.y, kc0.z, kc0.w, kc1.x, kc1.y, kc1.z, kc1.w}, sn8[8] = {ks0v.x, ks0v.y, ks0v.z, ks0v.w, ks1v.x, ks1v.y, ks1v.z, ks1v.w};
            if (blk > 0 || rrow >= 128u) {
            LAS u32x4* p1 = (LAS u32x4*)(sK + offb(rrow, rps)); LAS u32x4* p2 = (LAS u32x4*)(sK + offb(rrow, rps + 2));
            const u32x4 a = *p1, b2 = *p2; const float rs = sRS[rrow];
            const unsigned wa[4] = {a.x, a.y, a.z, a.w}, wb[4] = {b2.x, b2.y, b2.z, b2.w};
            float o1[8], o2[8];
#pragma unroll
            for (int k = 0; k < 4; ++k) {
#pragma unroll
                for (int e = 0; e < 2; ++e) { const int j = 2 * k + e; const float x1 = (e ? bfhi(wa[k]) : bflo(wa[k])) * rs * ga[j], x2 = (e ? bfhi(wb[k]) : bflo(wb[k])) * rs * gb[j];
                    o1[j] = x1 * cs8[j] - x2 * sn8[j]; o2[j] = x2 * cs8[j] + x1 * sn8[j]; } }
            u32x4 w1, w2; w1.x = pk2(o1[0], o1[1]); w1.y = pk2(o1[2], o1[3]); w1.z = pk2(o1[4], o1[5]); w1.w = pk2(o1[6], o1[7]); w2.x = pk2(o2[0], o2[1]); w2.y = pk2(o2[2], o2[3]); w2.z = pk2(o2[4], o2[5]); w2.w = pk2(o2[6], o2[7]);
            *p1 = w1; *p2 = w2; }
        }
        __syncthreads();
        ATT_STAMP(6);
        const int ks0 = w >> 1, nskip = blk == 0 ? 4 : 0;
        f32x4 st[5][2];
        const unsigned krow_l = 8u * (qq >> 2) + (qq & 3u);
        LAS unsigned char* ka[2][4];
#pragma unroll
        for (int T = 0; T < 2; ++T)
#pragma unroll
            for (int s = 0; s < 4; ++s) ka[T][s] = sK + offb(32u * ks0 + krow_l + 4u * T, 4 * s + g);
#pragma unroll
        for (int n = 0; n < 5; ++n)
#pragma unroll
            for (int T = 0; T < 2; ++T) { f32x4 a = {0.f, 0.f, 0.f, 0.f};
                if (ks0 + n >= nskip) {
#pragma unroll
                for (int s = 0; s < 4; ++s) { const bf16x8 kf = *(const LAS bf16x8*)(ka[T][s] + 8192 * n); a = __builtin_amdgcn_mfma_f32_16x16x32_bf16(kf, qf[s], a, 0, 0, 0); } }
                st[n][T] = a; }
        asm volatile("s_waitcnt vmcnt(0) lgkmcnt(0)" ::: "memory");
        if (tid == 0) mbox[0] = nq;
        __syncthreads();
        const bool has_next = unxt < NU;
        AttU UN = att_decode(has_next ? (int)unxt : 0);
        if (has_next) { ATT_DMA(UN, UN.kcol, sK); asm volatile("" ::: "memory"); ATT_LOADQ(UN); }
        asm volatile("" ::: "memory");
        const float SC = 0.08838834764831845f * 1.4426950408889634f;
        float mx = -INFINITY;
#pragma unroll
        for (int n = 0; n < 5; ++n)
#pragma unroll
            for (int T = 0; T < 2; ++T)
#pragma unroll
                for (int i = 0; i < 4; ++i) { const int kj = 32 * (ks0 + n) + 8 * g + 4 * T + i;
                    bool ok = true;
                    if (n == 0) ok = kj >= qi;
                    if (n == 4) ok = kj <= qi + 128;
                    if (blk == 0) ok = ok && (kj >= 128);
                    const float v = ok ? st[n][T][i] : -INFINITY; st[n][T][i] = v; mx = fmaxf(mx, v); }
        mx = fmaxf(mx, swz_xor<16>(mx));
        { const auto rr = __builtin_amdgcn_permlane32_swap(__float_as_uint(mx), __float_as_uint(mx), false, false); mx = fmaxf(__uint_as_float(rr[0]), __uint_as_float(rr[1])); }
        float sum = 0.f; const float mxs = mx * SC;
#pragma unroll
        for (int n = 0; n < 5; ++n)
#pragma unroll
            for (int T = 0; T < 2; ++T)
#pragma unroll
                for (int i = 0; i < 4; ++i) { const float e = __builtin_amdgcn_exp2f(__builtin_fmaf(st[n][T][i], SC, -mxs)); st[n][T][i] = e; sum += e; }
        sum += swz_xor<16>(sum);
        { const auto rr = __builtin_amdgcn_permlane32_swap(__float_as_uint(sum), __float_as_uint(sum), false, false); sum = __uint_as_float(rr[0]) + __uint_as_float(rr[1]); }
        const float inv = rcpf_(sum);
        ATT_STAMP(7);
        f32x4 ot[8];
#pragma unroll
        for (int cc = 0; cc < 8; ++cc) ot[cc] = (f32x4){0.f, 0.f, 0.f, 0.f};
        const unsigned tq = (unsigned)qq >> 2, tp = (unsigned)qq & 3u;
        const unsigned vbase = (unsigned)(size_t)sV;
        unsigned va[2][8];
#pragma unroll
        for (int t = 0; t < 2; ++t)
#pragma unroll
            for (int cc = 0; cc < 8; ++cc) va[t][cc] = vbase + offb(32u * ks0 + 8u * g + 4u * t + tq, 2 * cc + (tp >> 1)) + 8u * (tp & 1u);
#pragma unroll
        for (int n = 0; n < 5; ++n) if (ks0 + n >= nskip) {
            u32x4 pw; pw.x = pk2(st[n][0][0], st[n][0][1]); pw.y = pk2(st[n][0][2], st[n][0][3]); pw.z = pk2(st[n][1][0], st[n][1][1]); pw.w = pk2(st[n][1][2], st[n][1][3]);
            const bf16x8 pf = __builtin_bit_cast(bf16x8, pw);
            u16x4 v0[8], v1[8];
            asm volatile("ds_read_b64_tr_b16 %0, %16 offset:%32\n\tds_read_b64_tr_b16 %8, %24 offset:%32\n\t"
                         "ds_read_b64_tr_b16 %1, %17 offset:%32\n\tds_read_b64_tr_b16 %9, %25 offset:%32\n\t"
                         "ds_read_b64_tr_b16 %2, %18 offset:%32\n\tds_read_b64_tr_b16 %10, %26 offset:%32\n\t"
                         "ds_read_b64_tr_b16 %3, %19 offset:%32\n\tds_read_b64_tr_b16 %11, %27 offset:%32\n\t"
                         "ds_read_b64_tr_b16 %4, %20 offset:%32\n\tds_read_b64_tr_b16 %12, %28 offset:%32\n\t"
                         "ds_read_b64_tr_b16 %5, %21 offset:%32\n\tds_read_b64_tr_b16 %13, %29 offset:%32\n\t"
                         "ds_read_b64_tr_b16 %6, %22 offset:%32\n\tds_read_b64_tr_b16 %14, %30 offset:%32\n\t"
                         "ds_read_b64_tr_b16 %7, %23 offset:%32\n\tds_read_b64_tr_b16 %15, %31 offset:%32\n\t"
                         "s_waitcnt lgkmcnt(0)"
                         : "=&v"(v0[0]), "=&v"(v0[1]), "=&v"(v0[2]), "=&v"(v0[3]), "=&v"(v0[4]), "=&v"(v0[5]), "=&v"(v0[6]), "=&v"(v0[7]),
                           "=&v"(v1[0]), "=&v"(v1[1]), "=&v"(v1[2]), "=&v"(v1[3]), "=&v"(v1[4]), "=&v"(v1[5]), "=&v"(v1[6]), "=&v"(v1[7])
                         : "v"(va[0][0]), "v"(va[0][1]), "v"(va[0][2]), "v"(va[0][3]), "v"(va[0][4]), "v"(va[0][5]), "v"(va[0][6]), "v"(va[0][7]),
                           "v"(va[1][0]), "v"(va[1][1]), "v"(va[1][2]), "v"(va[1][3]), "v"(va[1][4]), "v"(va[1][5]), "v"(va[1][6]), "v"(va[1][7]), "i"(8192 * n) : "memory");
#pragma unroll
            for (int cc = 0; cc < 8; ++cc) {
                bf16x8 vf; vf[0] = (short)v0[cc][0]; vf[1] = (short)v0[cc][1]; vf[2] = (short)v0[cc][2]; vf[3] = (short)v0[cc][3]; vf[4] = (short)v1[cc][0]; vf[5] = (short)v1[cc][1]; vf[6] = (short)v1[cc][2]; vf[7] = (short)v1[cc][3];
                ot[cc] = __builtin_amdgcn_mfma_f32_16x16x32_bf16(vf, pf, ot[cc], 0, 0, 0);
            }
        }
        __syncthreads();
        asm volatile("" ::: "memory");
        if (has_next) ATT_DMA(UN, UN.vcol, sV);
        asm volatile("" ::: "memory");
        bf16_t* orow = c.proj + qtok * NP + U.qcol;
#pragma unroll
        for (int cc = 0; cc < 8; ++cc) { u32x2 o; o.x = pk2(ot[cc][0] * inv, ot[cc][1] * inv); o.y = pk2(ot[cc][2] * inv, ot[cc][3] * inv); *(u32x2*)(orow + 16 * cc + 4 * g) = o; }
        if (g == 0) lse_buf[qtok * 12 + U.p * 4 + U.h] = mx * 0.08838834764831845f + __logf(sum);
        ATT_STAMP(8);
        if (!has_next) break;
        U = UN; unxt = mbox[0];
    }
    asm volatile("s_waitcnt vmcnt(0)" ::: "memory");
    __syncthreads();
}
#undef ATT_STAMP
#undef ATT_DMA
#undef ATT_LOADQ

__device__ __forceinline__ unsigned short q2i8(float a, float b, float inv) { const int x = (int)__builtin_rintf(a * inv), y = (int)__builtin_rintf(b * inv); return (unsigned short)((x & 0xff) | ((y & 0xff) << 8)); }
__device__ __forceinline__ void phase_attn_combine(const Ctx& c, const float* lse_buf) {
    const int gw = c.bid * NWAVES + c.wave, NGW = c.G * NWAVES, lane = c.lane;
    constexpr int NR = 2;
    for (int tok0 = gw; tok0 < TC; tok0 += NR * NGW) {
        unsigned u[NR][3][4], ua[NR][4], ub[NR][4]; float l[NR][12];
#pragma unroll
        for (int r = 0; r < NR; ++r) { const int tok = tok0 + r * NGW;
            const float* ls = lse_buf + (size_t)tok * 12; const bf16_t* prow = c.proj + (size_t)tok * NP;
#pragma unroll
            for (int k = 0; k < 12; ++k) l[r][k] = ls[k];
#pragma unroll
            for (int p = 0; p < 3; ++p)
#pragma unroll
                for (int h = 0; h < 4; ++h) u[r][p][h] = *((const unsigned*)(prow + C_QKV + (4 * p + h) * 128) + lane);
#pragma unroll
            for (int h = 0; h < 4; ++h) { ua[r][h] = *((const unsigned*)(prow + C_OG + h * 128) + lane); ub[r][h] = *((const unsigned*)(prow + C_YB + h * 128) + lane); } }
#pragma unroll
        for (int r = 0; r < NR; ++r) { const int tok = tok0 + r * NGW;
            float c0[4], c1[4]; float mc = 0.f, ma = 0.f, mb = 0.f;
#pragma unroll
            for (int h = 0; h < 4; ++h) {
                const float l0 = l[r][h], l1 = l[r][4 + h], l2 = l[r][8 + h], ml = fmaxf(l0, fmaxf(l1, l2));
                const float w0 = __expf(l0 - ml), w1 = __expf(l1 - ml), w2 = __expf(l2 - ml), wi = rcpf_(w0 + w1 + w2);
                c0[h] = (w0 * bflo(u[r][0][h]) + w1 * bflo(u[r][1][h]) + w2 * bflo(u[r][2][h])) * wi; c1[h] = (w0 * bfhi(u[r][0][h]) + w1 * bfhi(u[r][1][h]) + w2 * bfhi(u[r][2][h])) * wi;
                mc = fmaxf(mc, fmaxf(fabsf(c0[h]), fabsf(c1[h])));
                ma = fmaxf(ma, fmaxf(fabsf(bflo(ua[r][h])), fabsf(bfhi(ua[r][h])))); mb = fmaxf(mb, fmaxf(fabsf(bflo(ub[r][h])), fabsf(bfhi(ub[r][h])))); }
            ma = wave_max(ma); mb = wave_max(mb); mc = wave_max(mc);
            const float ia = ma > 0.f ? 127.f / ma : 0.f, ib = mb > 0.f ? 127.f / mb : 0.f, ic = mc > 0.f ? 127.f / mc : 0.f;
            if (lane == 0) { c.sbr[tok] = ma * (1.f / 127.f); c.sbr[TC + tok] = mb * (1.f / 127.f); c.sbr[2 * TC + tok] = mc * (1.f / 127.f); }
            unsigned char* prow = (unsigned char*)(c.proj + (size_t)tok * NP);
#pragma unroll
            for (int h = 0; h < 4; ++h) {
                *((unsigned short*)(prow + C_OG * 2 + h * 128) + lane) = q2i8(bflo(ua[r][h]), bfhi(ua[r][h]), ia);
                *((unsigned short*)(prow + C_YB * 2 + h * 128) + lane) = q2i8(bflo(ub[r][h]), bfhi(ub[r][h]), ib);
                *((unsigned short*)(prow + C_QKV * 2 + h * 128) + lane) = q2i8(c0[h], c1[h], ic); } }
    }
}

__device__ __forceinline__ int crow(int reg, int hh) { return (reg & 3) + 8 * (reg >> 2) + 4 * hh; }
typedef float f32x16 __attribute__((ext_vector_type(16)));
__device__ __forceinline__ unsigned tr_addr32(unsigned lane, unsigned rowbase, unsigned cblk, unsigned t, bool perm) {
    const unsigned hh = lane >> 5, blk = (lane >> 4) & 1u, q = (lane & 15u) >> 2, p = lane & 3u;
    const unsigned row = rowbase + (perm ? 8u * t + 4u * hh : 8u * hh + 4u * t) + q;
    return offb(row, 4u * cblk + 2u * blk + (p >> 1)) + 8u * (p & 1u);
}
__device__ __forceinline__ bf16x8 tr_frag(unsigned a0, unsigned a1) {
    u16x4 v0, v1;
    asm volatile("ds_read_b64_tr_b16 %0, %2\n\tds_read_b64_tr_b16 %1, %3\n\ts_waitcnt lgkmcnt(0)" : "=&v"(v0), "=&v"(v1) : "v"(a0), "v"(a1) : "memory");
    bf16x8 f; f[0] = (short)v0[0]; f[1] = (short)v0[1]; f[2] = (short)v0[2]; f[3] = (short)v0[3]; f[4] = (short)v1[0]; f[5] = (short)v1[1]; f[6] = (short)v1[2]; f[7] = (short)v1[3];
    return f;
}
__device__ __forceinline__ void tr_frag4(const unsigned (&a)[8], bf16x8 (&f)[4]) {
    u16x4 v[8];
    asm volatile("ds_read_b64_tr_b16 %0, %8\n\tds_read_b64_tr_b16 %1, %9\n\tds_read_b64_tr_b16 %2, %10\n\tds_read_b64_tr_b16 %3, %11\n\t"
                 "ds_read_b64_tr_b16 %4, %12\n\tds_read_b64_tr_b16 %5, %13\n\tds_read_b64_tr_b16 %6, %14\n\tds_read_b64_tr_b16 %7, %15\n\ts_waitcnt lgkmcnt(0)"
                 : "=&v"(v[0]), "=&v"(v[1]), "=&v"(v[2]), "=&v"(v[3]), "=&v"(v[4]), "=&v"(v[5]), "=&v"(v[6]), "=&v"(v[7])
                 : "v"(a[0]), "v"(a[1]), "v"(a[2]), "v"(a[3]), "v"(a[4]), "v"(a[5]), "v"(a[6]), "v"(a[7]) : "memory");
#pragma unroll
    for (int k = 0; k < 4; ++k) { f[k][0] = (short)v[2 * k][0]; f[k][1] = (short)v[2 * k][1]; f[k][2] = (short)v[2 * k][2]; f[k][3] = (short)v[2 * k][3];
        f[k][4] = (short)v[2 * k + 1][0]; f[k][5] = (short)v[2 * k + 1][1]; f[k][6] = (short)v[2 * k + 1][2]; f[k][7] = (short)v[2 * k + 1][3]; }
}
constexpr int GLA_QK = 0, GLA_KD = 16384, GLA_V = 32768  , GLA_ST = 65536  , GLA_O = 102400  , GLA_SEG = 136192  , GLA_DEC = 138240  ;
static_assert(GLA_DEC + 256 <= RING_BYTES, "gla lds");
__device__ __forceinline__ void gla_unit(const Ctx& c, int unit, const float* gbias, const float* ogain) {
    const int tid = c.tid, lane = c.lane, w = c.wave;
    const int b = unit >> 2, h = unit & 3;
    LAS unsigned char* L = c.lds;
    const unsigned hh = lane >> 5, r31 = lane & 31;
    const int ti = w >> 2, tv = w & 3;
    f32x16 St;
#pragma unroll
    for (int i = 0; i < 16; ++i) St[i] = 0.f;
    for (int i = tid; i < 18432 / 4; i += NTHR) ((LAS unsigned*)(L + GLA_ST))[i] = 0u;
    const float bias_d = gbias[h * 64 + lane];
    const int i3 = tid >> 3, seg = tid & 7;
    float gn[16];
#pragma unroll
    for (int k = 0; k < 16; ++k) gn[k] = ogain[16 * seg + k];
    const size_t tokb = (size_t)b * SEQ;
    unsigned short pq[8], pk[8], pg[8];
    u32x4 ogc0, ogc1, ogn0, ogn1;
#define GLA_PREFETCH(n) do { _Pragma("unroll") for (int rr = 0; rr < 8; ++rr) { const bf16_t* row = c.proj + (tokb + (n) * 64 + 8 * w + rr) * NP + h * 64 + lane; \
        pq[rr] = row[C_QA]; pk[rr] = row[C_KA]; pg[rr] = row[C_GP]; } } while (0)
#define GLA_OG(n, d0, d1) do { const bf16_t* ogp = c.proj + (tokb + (n) * 64 + i3) * NP + C_OG + h * 128 + 16 * seg; d0 = *(const u32x4*)ogp; d1 = *((const u32x4*)ogp + 1); } while (0)
#define GLA_VDMA(n) do { _Pragma("unroll") for (int it = 0; it < 2; ++it) { const int q = w + 8 * it; const unsigned nn = 64u * q + lane, row = nn >> 4, cs = nn & 15u, ch = cs ^ (((row & 3u) << 2) | ((row >> 2) & 3u)); \
        __builtin_amdgcn_global_load_lds((const unsigned*)(c.proj + (tokb + (n) * 64 + row) * NP + C_VA + h * 128 + ch * 8), (LAS unsigned*)(L + GLA_V + ((n) & 1) * 16384 + 1024 * q), 16, 0, 0); } } while (0)
#define CB() asm volatile("" ::: "memory")
    GLA_PREFETCH(0); CB(); GLA_OG(0, ogc0, ogc1); CB(); GLA_VDMA(0); CB(); GLA_VDMA(1); CB();
    for (int n = 0; n < SEQ / 64; ++n) {
        LAS unsigned char* STr = L + GLA_ST + (n & 1) * 18432; LAS unsigned char* STw = L + GLA_ST + ((n + 1) & 1) * 18432;
        LAS unsigned char* Vb = L + GLA_V + (n & 1) * 16384;
        float cl[8], qv[8], kv[8];
        { float run = 0.f;
#pragma unroll
          for (int rr = 0; rr < 8; ++rr) { const float g = bf2f(pg[rr]) + bias_d; run += (fminf(g, 0.f) - __logf(1.f + __expf(-fabsf(g)))) * (1.f / 16.f); cl[rr] = run; qv[rr] = bf2f(pq[rr]); kv[rr] = bf2f(pk[rr]); }
          ((LAS float*)(L + GLA_SEG))[w * 64 + lane] = run; }
        __syncthreads();
        { float pre = 0.f, tot = 0.f;
#pragma unroll
          for (int s = 0; s < 8; ++s) { const float v = ((LAS float*)(L + GLA_SEG))[s * 64 + lane]; tot += v; pre += (s < w) ? v : 0.f; }
          const float etot = __expf(tot);
          if (w == 0) ((LAS float*)(L + GLA_DEC))[lane] = etot;
#pragma unroll
          for (int rr = 0; rr < 8; ++rr) { const float cum = pre + cl[rr]; const unsigned row = 8 * w + rr;
              const float e = __expf(cum), ei = rcpf_(e), ed = etot * ei;
              const unsigned o1 = offb(row, lane >> 3) + (lane & 7) * 2, o2 = offb(row, 8 + (lane >> 3)) + (lane & 7) * 2;
              *(LAS unsigned short*)(L + GLA_QK + o1) = (unsigned short)f2bf(qv[rr] * e);
              *(LAS unsigned short*)(L + GLA_QK + o2) = (unsigned short)f2bf(kv[rr] * ei);
              *(LAS unsigned short*)(L + GLA_KD + o1) = (unsigned short)f2bf(kv[rr] * ed); } }
        if (n == 0) asm volatile("s_waitcnt vmcnt(2)" ::: "memory"); else asm volatile("s_waitcnt vmcnt(4)" ::: "memory");
        __syncthreads();
        CB();
        if (n + 1 < SEQ / 64) { GLA_OG(n + 1, ogn0, ogn1); CB(); GLA_PREFETCH(n + 1); }
        CB();
        bf16x8 qdf[4];
#pragma unroll
        for (int s = 0; s < 4; ++s) qdf[s] = *(const LAS bf16x8*)(L + GLA_QK + offb(32 * ti + r31, 2 * s + hh));
        f32x16 Z;
#pragma unroll
        for (int i = 0; i < 16; ++i) Z[i] = 0.f;
        { bf16x8 sf[4];
#pragma unroll
          for (int s = 0; s < 4; ++s) sf[s] = *(const LAS bf16x8*)(STr + (32 * tv + r31) * 144 + 32 * s + 16 * hh);
#pragma unroll
          for (int s = 0; s < 4; ++s) Z = __builtin_amdgcn_mfma_f32_32x32x16_bf16(qdf[s], sf[s], Z, 0, 0, 0); }
        const unsigned vb = (unsigned)(size_t)Vb;
#pragma unroll
        for (int tj = 0; tj < 2; ++tj) {
            if (tj <= ti) {
                bf16x8 kf[4];
#pragma unroll
                for (int s = 0; s < 4; ++s) kf[s] = *(const LAS bf16x8*)(L + GLA_QK + offb(32 * tj + r31, 8 + 2 * s + hh));
                unsigned va[8]; bf16x8 vf[4];
#pragma unroll
                for (int s = 0; s < 2; ++s) { va[2 * s] = vb + tr_addr32(lane, 32 * tj + 16 * s, tv, 0, true); va[2 * s + 1] = vb + tr_addr32(lane, 32 * tj + 16 * s, tv, 1, true);
                    va[4 + 2 * s] = va[2 * s]; va[5 + 2 * s] = va[2 * s + 1]; }
                tr_frag4(va, vf);
                f32x16 X;
#pragma unroll
                for (int i = 0; i < 16; ++i) X[i] = 0.f;
#pragma unroll
                for (int s = 0; s < 4; ++s) X = __builtin_amdgcn_mfma_f32_32x32x16_bf16(kf[s], qdf[s], X, 0, 0, 0);
                const int ig = 32 * ti + (int)r31;
#pragma unroll
                for (int i = 0; i < 16; ++i) X[i] = (ig >= 32 * tj + crow(i, hh)) ? X[i] : 0.f;
#pragma unroll
                for (int s = 0; s < 2; ++s) {
                    u32x4 pw; pw.x = pg8::cvt_pk_bf16(X[8 * s + 0], X[8 * s + 1]); pw.y = pg8::cvt_pk_bf16(X[8 * s + 2], X[8 * s + 3]); pw.z = pg8::cvt_pk_bf16(X[8 * s + 4], X[8 * s + 5]); pw.w = pg8::cvt_pk_bf16(X[8 * s + 6], X[8 * s + 7]);
                    Z = __builtin_amdgcn_mfma_f32_32x32x16_bf16(__builtin_bit_cast(bf16x8, pw), vf[s], Z, 0, 0, 0);
                }
            }
        }
#pragma unroll
        for (int i = 0; i < 16; ++i) ((LAS float*)(L + GLA_O))[(32 * ti + crow(i, hh)) * 132 + 32 * tv + r31] = Z[i];
        { const unsigned kb = (unsigned)(size_t)(L + GLA_KD);
          unsigned aa[8], ab[8]; bf16x8 af[4], bfr[4];
#pragma unroll
          for (int s = 0; s < 4; ++s) { aa[2 * s] = kb + tr_addr32(lane, 16 * s, ti, 0, false); aa[2 * s + 1] = kb + tr_addr32(lane, 16 * s, ti, 1, false);
              ab[2 * s] = vb + tr_addr32(lane, 16 * s, tv, 0, false); ab[2 * s + 1] = vb + tr_addr32(lane, 16 * s, tv, 1, false); }
          tr_frag4(aa, af); tr_frag4(ab, bfr);
#pragma unroll
          for (int i = 0; i < 16; ++i) St[i] *= ((LAS float*)(L + GLA_DEC))[32 * ti + crow(i, hh)];
#pragma unroll
          for (int s = 0; s < 4; ++s) St = __builtin_amdgcn_mfma_f32_32x32x16_bf16(af[s], bfr[s], St, 0, 0, 0); }
#pragma unroll
        for (int gq = 0; gq < 4; ++gq) { const float s0 = St[4 * gq], s1 = St[4 * gq + 1], s2 = St[4 * gq + 2], s3 = St[4 * gq + 3];
            u32x2 o; o.x = pk2(s0, s1); o.y = pk2(s2, s3);
            *(LAS u32x2*)(STw + (32 * tv + r31) * 144 + (32 * ti + 8 * gq + 4 * hh) * 2) = o; }
        __syncthreads();
        CB();
        if (n + 2 < SEQ / 64) GLA_VDMA(n + 2);
        CB();
        { const LAS f32x4* op = (const LAS f32x4*)(L + GLA_O + i3 * 528 + seg * 64);
          f32x4 o4[4]; float ss = 0.f;
#pragma unroll
          for (int k = 0; k < 4; ++k) { o4[k] = op[k]; ss += (o4[k].x * o4[k].x + o4[k].y * o4[k].y) + (o4[k].z * o4[k].z + o4[k].w * o4[k].w); }
          ss += swz_xor<1>(ss); ss += swz_xor<2>(ss); ss += swz_xor<4>(ss);
          const float rs = rsqf_(ss * (1.f / 128.f) + RMS_EPS);
          const unsigned ogw[8] = {ogc0.x, ogc0.y, ogc0.z, ogc0.w, ogc1.x, ogc1.y, ogc1.z, ogc1.w};
          unsigned ow[8];
#pragma unroll
          for (int k = 0; k < 8; ++k) { const float g0 = bflo(ogw[k]), g1 = bfhi(ogw[k]);
              const float a0 = o4[k >> 1][(2 * k) & 3] * rs * gn[2 * k] * g0 * sigmoidf_(g0), a1 = o4[k >> 1][(2 * k + 1) & 3] * rs * gn[2 * k + 1] * g1 * sigmoidf_(g1);
              ow[k] = pk2(a0, a1); }
          u32x4 w0, w1; w0.x = ow[0]; w0.y = ow[1]; w0.z = ow[2]; w0.w = ow[3]; w1.x = ow[4]; w1.y = ow[5]; w1.z = ow[6]; w1.w = ow[7];
          bf16_t* dst = c.proj + (tokb + n * 64 + i3) * NP + C_OG + h * 128 + 16 * seg;
          *(u32x4*)dst = w0; *((u32x4*)dst + 1) = w1; }
        CB();
        ogc0 = ogn0; ogc1 = ogn1;
    }
    asm volatile("s_waitcnt vmcnt(0)" ::: "memory");
    __syncthreads();
#undef GLA_PREFETCH
#undef GLA_OG
#undef GLA_VDMA
#undef CB
}

constexpr int LRU_X = 0  , LRU_R = 16384  , LRU_I = 32768, LRU_SP = 49152  , LRU_SH = 51200;
__device__ __forceinline__ void lru_unit(const Ctx& c, int unit, const float* convw, const float* convb, const float* wa_, const float* ba_, const float* wx_, const float* bx_, const float* lam_) {
    const int lane = c.lane, w = c.wave;
    const int b = unit >> 3, nb = unit & 7, ch = nb * 64 + lane;
    LAS unsigned char* L = c.lds;
    const unsigned hh = lane >> 5, r31 = lane & 31;
    const int gate = w >> 2, tt = (w >> 1) & 1, td = w & 1;
    bf16x8 wf[4];
    { const float* W = (gate ? wx_ : wa_) + (size_t)nb * 4096 + 32 * td + r31;
#pragma unroll
      for (int s = 0; s < 4; ++s) { float t8[8];
#pragma unroll
          for (int jj = 0; jj < 8; ++jj) t8[jj] = W[(16 * s + 8 * hh + jj) * 64];
          u32x4 pw; pw.x = pk2(t8[0], t8[1]); pw.y = pk2(t8[2], t8[3]); pw.z = pk2(t8[4], t8[5]); pw.w = pk2(t8[6], t8[7]); wf[s] = __builtin_bit_cast(bf16x8, pw); } }
    const float gbias = (gate ? bx_ : ba_)[nb * 64 + 32 * td + r31];
    const float cw0 = convw[ch], cw1 = convw[512 + ch], cw2 = convw[1024 + ch], cw3 = convw[1536 + ch], cb = convb[ch];
    const float lam = lam_[ch]; const float c8 = 8.f * (fmaxf(-lam, 0.f) + log1pf(__expf(-fabsf(lam))));
    const size_t tokb = (size_t)b * SEQ;
    unsigned short px[11], py[8];
#define LRU_PREFETCH(n) do { _Pragma("unroll") for (int rr = 0; rr < 11; ++rr) { const int t = (n) * 64 + 8 * w + rr - 3; px[rr] = t >= 0 ? c.proj[(tokb + t) * NP + C_XB + ch] : (unsigned short)0; } \
        _Pragma("unroll") for (int rr = 0; rr < 8; ++rr) py[rr] = c.proj[(tokb + (n) * 64 + 8 * w + rr) * NP + C_YB + ch]; } while (0)
    LRU_PREFETCH(0);
    float hcarry = 0.f;
    for (int n = 0; n < SEQ / 64; ++n) {
        float xc[8], yv[8];
        { float xr[11];
#pragma unroll
          for (int rr = 0; rr < 11; ++rr) xr[rr] = bf2f(px[rr]);
#pragma unroll
          for (int rr = 0; rr < 8; ++rr) { xc[rr] = cb + cw0 * xr[rr] + cw1 * xr[rr + 1] + cw2 * xr[rr + 2] + cw3 * xr[rr + 3]; yv[rr] = bf2f(py[rr]);
              *(LAS unsigned short*)(L + LRU_X + offb(8 * w + rr, lane >> 3) + (lane & 7) * 2) = (unsigned short)f2bf(xc[rr]); } }
        __syncthreads();
        if (n + 1 < SEQ / 64) LRU_PREFETCH(n + 1);
        { f32x16 Z;
#pragma unroll
          for (int i = 0; i < 16; ++i) Z[i] = 0.f;
#pragma unroll
          for (int s = 0; s < 4; ++s) { const bf16x8 af = *(const LAS bf16x8*)(L + LRU_X + offb(32 * tt + r31, 2 * s + hh)); Z = __builtin_amdgcn_mfma_f32_32x32x16_bf16(af, wf[s], Z, 0, 0, 0); }
          LAS float* dst = (LAS float*)(L + (gate ? LRU_I : LRU_R));
#pragma unroll
          for (int i = 0; i < 16; ++i) dst[(32 * tt + crow(i, hh)) * 64 + 32 * td + r31] = sigmoidf_(Z[i] + gbias); }
        __syncthreads();
        float hl[8], pc[8];
        { float hrun = 0.f, prun = 1.f;
#pragma unroll
          for (int rr = 0; rr < 8; ++rr) { const float r = ((const LAS float*)(L + LRU_R))[(8 * w + rr) * 64 + lane], ig = ((const LAS float*)(L + LRU_I))[(8 * w + rr) * 64 + lane];
              const float a = __expf(-c8 * r), u = __builtin_amdgcn_sqrtf(fmaxf(1.f - a * a, 0.f)) * ig * xc[rr];
              hrun = a * hrun + u; prun *= a; hl[rr] = hrun; pc[rr] = prun; }
          ((LAS float*)(L + LRU_SP))[w * 64 + lane] = prun; ((LAS float*)(L + LRU_SH))[w * 64 + lane] = hrun; }
        __syncthreads();
        { float hin = hcarry, hall = hcarry;
#pragma unroll
          for (int s = 0; s < 8; ++s) { const float P = ((const LAS float*)(L + LRU_SP))[s * 64 + lane], H = ((const LAS float*)(L + LRU_SH))[s * 64 + lane];
              hall = P * hall + H; hin = (s < w) ? hall : hin; }
          hcarry = hall;
#pragma unroll
          for (int rr = 0; rr < 8; ++rr) { const float hv = hl[rr] + pc[rr] * hin;
              c.proj[(tokb + n * 64 + 8 * w + rr) * NP + C_YB + ch] = (bf16_t)f2bf(hv * gelu_tanh(yv[rr])); } }
    }
    __syncthreads();
#undef LRU_PREFETCH
}

constexpr int TPB = TT / 256;
constexpr int RW_STRIDE = 1032;
__device__ __forceinline__ void phase_router(const Ctx& c, const float* gain, const float* rw, const float* rb, unsigned* gcnt) {
    LAS bf16_t* sWh = (LAS bf16_t*)c.lds;
    LAS bf16_t* sWl = sWh + 16 * RW_STRIDE;
    LAS float* sGn = (LAS float*)(c.lds + 69632);
    LAS unsigned* sRec = (LAS unsigned*)(c.lds + 73728);
    LAS unsigned* sCnt = (LAS unsigned*)(c.lds + MISC_OFF + 256);
    LAS unsigned* sBase = sCnt + 16;
    const int tid = c.tid, lane = c.lane, w = c.wave;
    for (int idx = tid; idx < D * NE; idx += NTHR) { const int e = idx >> 10, k = idx & 1023; const float v = rw[k * 16 + e] * gain[k];
        const unsigned hi = f2bf(v); const float lo = v - bflo(hi); sWh[e * RW_STRIDE + k] = (bf16_t)hi; sWl[e * RW_STRIDE + k] = (bf16_t)f2bf(lo); }
    for (int idx = tid; idx < D; idx += NTHR) sGn[idx] = gain[idx];
    if (tid < 16) sCnt[tid] = 0u;
    __syncthreads();
    const int t = lane & 15, g = lane >> 4;
#pragma unroll 1
    for (int sub = 0; sub < TPB / 128; ++sub) {
    const int lt = sub * 128 + w * 16 + t, tok = c.bid * TPB + lt;
    const bf16_t* xrow = c.xb + (size_t)tok * D + 8 * g; signed char* hrow = (signed char*)c.actf + (size_t)tok * D + 8 * g;
    f32x4 acc = {0.f, 0.f, 0.f, 0.f}; float ss = 0.f, am = 0.f;
    u32x4 xn[4];
#pragma unroll
    for (int j = 0; j < 4; ++j) xn[j] = *(const u32x4*)(xrow + 32 * j);
#pragma unroll 1
    for (int s4 = 0; s4 < 8; ++s4) {
        u32x4 xc[4];
#pragma unroll
        for (int j = 0; j < 4; ++j) xc[j] = xn[j];
        if (s4 + 1 < 8) {
#pragma unroll
            for (int j = 0; j < 4; ++j) xn[j] = *(const u32x4*)(xrow + 32 * (4 * s4 + 4 + j)); }
#pragma unroll
        for (int j = 0; j < 4; ++j) { const int s = 4 * s4 + j;
            const unsigned xw[4] = {xc[j].x, xc[j].y, xc[j].z, xc[j].w};
            float xv[8];
#pragma unroll
            for (int k = 0; k < 4; ++k) { xv[2 * k] = bflo(xw[k]); xv[2 * k + 1] = bfhi(xw[k]); }
            { const f32x4 q0 = *(const LAS f32x4*)(sGn + 32 * s + 8 * g), q1 = *(const LAS f32x4*)(sGn + 32 * s + 8 * g + 4);
              am = fmaxf(am, fmaxf(fmaxf(fmaxf(fabsf(xv[0] * q0.x), fabsf(xv[1] * q0.y)), fmaxf(fabsf(xv[2] * q0.z), fabsf(xv[3] * q0.w))), fmaxf(fmaxf(fabsf(xv[4] * q1.x), fabsf(xv[5] * q1.y)), fmaxf(fabsf(xv[6] * q1.z), fabsf(xv[7] * q1.w))))); }
            const bf16x8 bh = __builtin_bit_cast(bf16x8, xc[j]);
#pragma unroll
            for (int k = 0; k < 8; ++k) ss += xv[k] * xv[k];
            const bf16x8 ah = *(const LAS bf16x8*)(sWh + t * RW_STRIDE + 32 * s + 8 * g), al = *(const LAS bf16x8*)(sWl + t * RW_STRIDE + 32 * s + 8 * g);
            acc = __builtin_amdgcn_mfma_f32_16x16x32_bf16(ah, bh, acc, 0, 0, 0);
            acc = __builtin_amdgcn_mfma_f32_16x16x32_bf16(al, bh, acc, 0, 0, 0); }
    }
    ss += swz_xor<16>(ss);
    { const auto r = __builtin_amdgcn_permlane32_swap(__float_as_uint(ss), __float_as_uint(ss), false, false); ss = __uint_as_float(r[0]) + __uint_as_float(r[1]); }
    const float rs = rsqf_(ss * (1.f / D) + RMS_EPS);
    am = fmaxf(am, swz_xor<16>(am));
    { const auto r = __builtin_amdgcn_permlane32_swap(__float_as_uint(am), __float_as_uint(am), false, false); am = fmaxf(__uint_as_float(r[0]), __uint_as_float(r[1])); }
    const float qinv = am > 0.f ? 127.f / am : 0.f, qs = am * (1.f / 127.f);
    float sc[4]; float mx = -INFINITY;
#pragma unroll
    for (int i = 0; i < 4; ++i) { sc[i] = acc[i] * rs + rb[4 * g + i]; mx = fmaxf(mx, sc[i]); }
    mx = fmaxf(mx, swz_xor<16>(mx));
    { const auto r = __builtin_amdgcn_permlane32_swap(__float_as_uint(mx), __float_as_uint(mx), false, false); mx = fmaxf(__uint_as_float(r[0]), __uint_as_float(r[1])); }
    float sum = 0.f;
#pragma unroll
    for (int i = 0; i < 4; ++i) { sc[i] = __expf(sc[i] - mx); sum += sc[i]; }
    sum += swz_xor<16>(sum);
    { const auto r = __builtin_amdgcn_permlane32_swap(__float_as_uint(sum), __float_as_uint(sum), false, false); sum = __uint_as_float(r[0]) + __uint_as_float(r[1]); }
    const float isum = rcpf_(sum);
#pragma unroll
    for (int i = 0; i < 4; ++i) sc[i] *= isum;
    float gs;
    { const float hi1 = fmaxf(sc[0], sc[1]), lo1 = fminf(sc[0], sc[1]), hi2 = fmaxf(sc[2], sc[3]), lo2 = fminf(sc[2], sc[3]);
      gs = fmaxf(hi1, hi2) + fmaxf(fminf(hi1, hi2), fmaxf(lo1, lo2)); }
    const float g1 = swz_xor<16>(gs);
    float g2, g3;
    { const auto r = __builtin_amdgcn_permlane32_swap(__float_as_uint(gs), __float_as_uint(gs), false, false); g2 = (g & 2) ? __uint_as_float(r[0]) : __uint_as_float(r[1]); }
    { const auto r = __builtin_amdgcn_permlane32_swap(__float_as_uint(g1), __float_as_uint(g1), false, false); g3 = (g & 2) ? __uint_as_float(r[0]) : __uint_as_float(r[1]); }
    const bool win = ((gs > g1) || (gs == g1 && g < (g ^ 1))) && ((gs > g2) || (gs == g2 && g < (g ^ 2))) && ((gs > g3) || (gs == g3 && g < (g ^ 3)));
    if (win) {
        int i0 = 0; float b0 = sc[0];
#pragma unroll
        for (int k = 1; k < 4; ++k) if (sc[k] > b0) { b0 = sc[k]; i0 = k; }
        int i1 = -1; float b1 = -1.f;
#pragma unroll
        for (int k = 0; k < 4; ++k) if (k != i0 && sc[k] > b1) { b1 = sc[k]; i1 = k; }
        const int e0 = 4 * g + i0, e1 = 4 * g + i1; const float wn = rcpf_(b0 + b1);
        const unsigned l0 = atomicAdd((unsigned*)&sCnt[e0], 1u), l1 = atomicAdd((unsigned*)&sCnt[e1], 1u);
        sRec[lt * 8 + 0] = (unsigned)e0; sRec[lt * 8 + 1] = l0; sRec[lt * 8 + 2] = (unsigned)e1; sRec[lt * 8 + 3] = l1; sRec[lt * 8 + 4] = __float_as_uint(b0 * wn); sRec[lt * 8 + 5] = __float_as_uint(b1 * wn); sRec[lt * 8 + 6] = __float_as_uint(rs * qs);
    }
#pragma unroll 1
    for (int s4 = 0; s4 < 8; ++s4) { u32x4 xx[4];
#pragma unroll
        for (int j = 0; j < 4; ++j) xx[j] = *(const u32x4*)(xrow + 32 * (4 * s4 + j));
#pragma unroll
        for (int j = 0; j < 4; ++j) { const int s = 4 * s4 + j; const unsigned xw[4] = {xx[j].x, xx[j].y, xx[j].z, xx[j].w};
            const f32x4 q0 = *(const LAS f32x4*)(sGn + 32 * s + 8 * g), q1 = *(const LAS f32x4*)(sGn + 32 * s + 8 * g + 4);
            const int i0 = (int)__builtin_rintf(bflo(xw[0]) * q0.x * qinv), i1 = (int)__builtin_rintf(bfhi(xw[0]) * q0.y * qinv), i2 = (int)__builtin_rintf(bflo(xw[1]) * q0.z * qinv), i3 = (int)__builtin_rintf(bfhi(xw[1]) * q0.w * qinv);
            const int i4 = (int)__builtin_rintf(bflo(xw[2]) * q1.x * qinv), i5 = (int)__builtin_rintf(bfhi(xw[2]) * q1.y * qinv), i6 = (int)__builtin_rintf(bflo(xw[3]) * q1.z * qinv), i7 = (int)__builtin_rintf(bfhi(xw[3]) * q1.w * qinv);
            u32x2 o; o.x = (unsigned)(i0 & 0xff) | ((unsigned)(i1 & 0xff) << 8) | ((unsigned)(i2 & 0xff) << 16) | ((unsigned)(i3 & 0xff) << 24);
            o.y = (unsigned)(i4 & 0xff) | ((unsigned)(i5 & 0xff) << 8) | ((unsigned)(i6 & 0xff) << 16) | ((unsigned)(i7 & 0xff) << 24);
            *(u32x2*)(hrow + 32 * s) = o; } }
    }
    __syncthreads();
    if (tid < 16) sBase[tid] = __hip_atomic_fetch_add(gcnt + tid, sCnt[tid], __ATOMIC_RELAXED, __HIP_MEMORY_SCOPE_AGENT);
    __syncthreads();
    if (tid < TPB) { const int tk = c.bid * TPB + tid; const unsigned e0 = sRec[tid * 8], e1 = sRec[tid * 8 + 2];
        const unsigned p0 = sBase[e0] + sRec[tid * 8 + 1], p1 = sBase[e1] + sRec[tid * 8 + 3];
        u32x4 r; r.x = (e0 << 20) | p0; r.y = (e1 << 20) | p1; r.z = sRec[tid * 8 + 4]; r.w = sRec[tid * 8 + 5];
        *(u32x4*)(c.rec + (size_t)tk * 4) = r;
        const float rsv = __uint_as_float(sRec[tid * 8 + 6]);
        c.list[(size_t)e0 * TT + p0] = tk; c.list[(size_t)e1 * TT + p1] = tk; c.rsl[(size_t)e0 * TT + p0] = rsv; c.rsl[(size_t)e1 * TT + p1] = rsv; }
}

struct PlainOrder {
    int nM, nN, G, c; const char* A; const char* Bt; size_t a_tile, b_tile; int r0, r1;
    __device__ __forceinline__ bool next(int i, pg8::Unit& u) const { u.g = 0; if (r0 + i >= r1) return false; return pg8::static_tile(nM, nN, G, c, r0 + i, u.pm, u.pn); }
    __device__ __forceinline__ const char* aptr(const pg8::Unit& u) const { return A + (size_t)u.pm * a_tile; }
    __device__ __forceinline__ const char* bptr(const pg8::Unit& u) const { return Bt + (size_t)u.pn * b_tile; }
    __device__ __forceinline__ unsigned arow(const pg8::Unit&, int) const { return 0u; }
};
struct MergeOrder {
    int G, c; const char* proj; const char* wbr;
    __device__ __forceinline__ bool next(int i, pg8::Unit& u) const { u.g = i % 3; return pg8::static_tile(TC / 128, 4, G, c, i / 3, u.pm, u.pn); }
    __device__ __forceinline__ const char* aptr(const pg8::Unit& u) const { const int col = u.g == 0 ? C_OG : (u.g == 1 ? C_YB : C_QKV); return proj + ((size_t)u.pm * 128 * NP + col) * 2; }
    __device__ __forceinline__ const char* bptr(const pg8::Unit& u) const { return wbr + ((size_t)u.g * D + (size_t)u.pn * 256) * 512; }
    __device__ __forceinline__ unsigned arow(const pg8::Unit&, int) const { return 0u; }
};
template <bool UP> struct MoeOrder {
    int G, c; LAS const int* pt; LAS const int* lc; const char* A; const char* W; const int* list;
    __device__ __forceinline__ bool next(int i, pg8::Unit& u) const { const int x = c & 7, j = c >> 3, tau = (G >> 2) * i + 8 * x + (j >> 2); if (tau >= pt[NE]) return false;
        int e = 0;
#pragma unroll
        for (int k = 1; k < NE; ++k) e += (tau >= pt[k]) ? 1 : 0;
        u.pm = tau; u.pn = j & 3; u.g = e; return true; }
    __device__ __forceinline__ const char* aptr(const pg8::Unit& u) const { return UP ? A : A + (size_t)u.pm * 256 * FF * 2; }
    __device__ __forceinline__ const char* bptr(const pg8::Unit& u) const { return UP ? W + ((size_t)u.g * 1024 + (size_t)u.pn * 256) * D : W + ((size_t)u.g * D + (size_t)u.pn * 256) * FF * 2; }
    __device__ __forceinline__ unsigned arow(const pg8::Unit& u, int r) const { int p = (u.pm - pt[u.g]) * 256 + r; const int n = lc[u.g]; p = p < n ? p : n - 1;
        return (unsigned)list[(size_t)u.g * TT + p] * (unsigned)D; }
};

struct EpiStoreBf16 {
    static constexpr bool PERM = true;
    bf16_t* O; int ldc;
    __device__ __forceinline__ void operator()(const f32x4 (&acc)[2][2][4][2], const pg8::Unit& u, int wr, int wc, int fr, int fq) const {
        const int row0 = u.pm * 256 + wr * 64 + fr, col0 = u.pn * 256 + wc * 32 + 8 * fq;
#pragma unroll
        for (int ai = 0; ai < 2; ++ai)
#pragma unroll
            for (int m = 0; m < 4; ++m) { bf16_t* rowp = O + (size_t)(row0 + ai * 128 + m * 16) * ldc + col0;
#pragma unroll
                for (int bj = 0; bj < 2; ++bj) { const f32x4 v0 = acc[ai][bj][m][0], v1 = acc[ai][bj][m][1];
                    u32x4 w; w.x = pg8::cvt_pk_bf16(v0[0], v0[1]); w.y = pg8::cvt_pk_bf16(v0[2], v0[3]); w.z = pg8::cvt_pk_bf16(v1[0], v1[1]); w.w = pg8::cvt_pk_bf16(v1[2], v1[3]);
                    __builtin_nontemporal_store(w, (u32x4*)(rowp + bj * 128)); } }
    }
};
struct EpiProj {
    static constexpr bool PERM = true;
    bf16_t* O; const float* sa  ; const unsigned* cmax  ;
    __device__ __forceinline__ void operator()(const i32x4 (&acc)[2][2][4][2], const pg8::Unit& u, int wr, int wc, int fr, int fq) const {
        const int row0 = u.pm * 256 + wr * 64 + fr, col0 = u.pn * 256 + wc * 32 + 8 * fq;
        f32x4 sb0[2], sb1[2];
#pragma unroll
        for (int bj = 0; bj < 2; ++bj) { const u32x4 m0 = *(const u32x4*)(cmax + col0 + bj * 128), m1 = *(const u32x4*)(cmax + col0 + bj * 128 + 4); const float k = 1.f / 127.f;
            sb0[bj] = (f32x4){__uint_as_float(m0.x) * k, __uint_as_float(m0.y) * k, __uint_as_float(m0.z) * k, __uint_as_float(m0.w) * k};
            sb1[bj] = (f32x4){__uint_as_float(m1.x) * k, __uint_as_float(m1.y) * k, __uint_as_float(m1.z) * k, __uint_as_float(m1.w) * k}; }
        float sar[2][4];
#pragma unroll
        for (int ai = 0; ai < 2; ++ai)
#pragma unroll
            for (int m = 0; m < 4; ++m) sar[ai][m] = sa[row0 + ai * 128 + m * 16];
        if (u.pn * 256 >= C_G) {
#pragma unroll
            for (int ai = 0; ai < 2; ++ai)
#pragma unroll
                for (int m = 0; m < 4; ++m) { unsigned char* rowp = (unsigned char*)(O + (size_t)(row0 + ai * 128 + m * 16) * NP + C_G) + (col0 - C_G);
#pragma unroll
                    for (int bj = 0; bj < 2; ++bj) { const i32x4 a0 = acc[ai][bj][m][0], a1 = acc[ai][bj][m][1]; const f32x4 s0 = sb0[bj] * sar[ai][m], s1 = sb1[bj] * sar[ai][m];
                        unsigned q[8];
#pragma unroll
                        for (int k = 0; k < 4; ++k) { q[k] = (unsigned)(sigmoidf_((float)a0[k] * s0[k]) * 255.f + 0.5f); q[4 + k] = (unsigned)(sigmoidf_((float)a1[k] * s1[k]) * 255.f + 0.5f); }
                        u32x2 w; w.x = q[0] | (q[1] << 8) | (q[2] << 16) | (q[3] << 24); w.y = q[4] | (q[5] << 8) | (q[6] << 16) | (q[7] << 24);
                        __builtin_nontemporal_store(w, (u32x2*)(rowp + bj * 128)); } }
        } else {
#pragma unroll
            for (int ai = 0; ai < 2; ++ai)
#pragma unroll
                for (int m = 0; m < 4; ++m) { bf16_t* rowp = O + (size_t)(row0 + ai * 128 + m * 16) * NP + col0;
#pragma unroll
                    for (int bj = 0; bj < 2; ++bj) { const i32x4 a0 = acc[ai][bj][m][0], a1 = acc[ai][bj][m][1]; const f32x4 s0 = sb0[bj] * sar[ai][m], s1 = sb1[bj] * sar[ai][m];
                        u32x4 w; w.x = pk2((float)a0[0] * s0[0], (float)a0[1] * s0[1]); w.y = pk2((float)a0[2] * s0[2], (float)a0[3] * s0[3]); w.z = pk2((float)a1[0] * s1[0], (float)a1[1] * s1[1]); w.w = pk2((float)a1[2] * s1[2], (float)a1[3] * s1[3]);
                        __builtin_nontemporal_store(w, (u32x4*)(rowp + bj * 128)); } }
        }
    }
};
__device__ __forceinline__ int lane_fresh() { int l; asm volatile("v_mbcnt_lo_u32_b32 %0, -1, 0\n\tv_mbcnt_hi_u32_b32 %0, -1, %0" : "=v"(l)); return l; }
struct EpiMerge {
    static constexpr bool PERM = true;
    const bf16_t* proj; bf16_t* mg; const float* sbr  ; const unsigned* cmax  ;
    __device__ __forceinline__ void operator()(i32x4 (&acc)[2][2][4][2], const pg8::Unit& u, int wr, int wc, int, int) const {
        const int ln_ = lane_fresh(), fr_ = ln_ & 15, fq_ = ln_ >> 4;
        const unsigned lrow = (unsigned)(wr * 64 + fr_), lcol = (unsigned)(wc * 32 + 8 * fq_);
        const int upm = __builtin_amdgcn_readfirstlane(u.pm), upn = __builtin_amdgcn_readfirstlane(u.pn), ug = __builtin_amdgcn_readfirstlane(u.g);
        const unsigned char* gB = (const unsigned char*)(proj + (size_t)(upm * 128) * NP + C_G) + ug * D + upn * 256;
        unsigned char* mB = (unsigned char*)(mg + (size_t)(upm * 128) * D + upn * 256);
        const unsigned char* sB = (const unsigned char*)(sbr + (size_t)ug * TC + upm * 128);
        const unsigned char* cB = (const unsigned char*)(cmax + ug * 1024 + upn * 256);
        const unsigned gl = lrow * (unsigned)(NP * 2) + lcol, ml = lrow * (unsigned)(D * 2) + lcol * 2u, sl = lrow * 4u, cl = lcol * 4u;
        u32x2 gv[4][2]; float sar[4];
#pragma unroll
        for (int m = 0; m < 4; ++m) { const unsigned rr = (unsigned)(m * 16); sar[m] = *(const float*)(sB + (sl + rr * 4u));
#pragma unroll
            for (int bj = 0; bj < 2; ++bj) gv[m][bj] = *(const u32x2*)(gB + (gl + rr * (unsigned)(NP * 2) + (unsigned)(bj * 128))); }
        asm volatile("" ::: "memory");
#pragma unroll
        for (int bj = 0; bj < 2; ++bj) {
            const u32x4 m0 = *(const u32x4*)(cB + (cl + (unsigned)(bj * 512))), m1 = *(const u32x4*)(cB + (cl + (unsigned)(bj * 512 + 16)));
            const f32x4 c0 = (f32x4){__uint_as_float(m0.x), __uint_as_float(m0.y), __uint_as_float(m0.z), __uint_as_float(m0.w)}, c1 = (f32x4){__uint_as_float(m1.x), __uint_as_float(m1.y), __uint_as_float(m1.z), __uint_as_float(m1.w)};
#pragma unroll
            for (int m = 0; m < 4; ++m) { const unsigned rr = (unsigned)(m * 16);
                const u32x2 g = gv[m][bj];
                const i32x4 a0 = acc[0][bj][m][0], a1 = acc[0][bj][m][1];
                const float k255 = sar[m] * (1.f / (255.f * 127.f));
                const f32x4 s0 = c0 * k255, s1 = c1 * k255;
                f32x4 t0, t1;
                if (ug == 0) { t0 = (f32x4){0.f, 0.f, 0.f, 0.f}; t1 = t0; } else { t0 = __builtin_bit_cast(f32x4, acc[1][bj][m][0]); t1 = __builtin_bit_cast(f32x4, acc[1][bj][m][1]); }
                t0[0] += (float)a0[0] * s0[0] * (float)(g.x & 0xffu); t0[1] += (float)a0[1] * s0[1] * (float)((g.x >> 8) & 0xffu);
                t0[2] += (float)a0[2] * s0[2] * (float)((g.x >> 16) & 0xffu); t0[3] += (float)a0[3] * s0[3] * (float)(g.x >> 24);
                t1[0] += (float)a1[0] * s1[0] * (float)(g.y & 0xffu); t1[1] += (float)a1[1] * s1[1] * (float)((g.y >> 8) & 0xffu);
                t1[2] += (float)a1[2] * s1[2] * (float)((g.y >> 16) & 0xffu); t1[3] += (float)a1[3] * s1[3] * (float)(g.y >> 24);
                acc[1][bj][m][0] = __builtin_bit_cast(i32x4, t0); acc[1][bj][m][1] = __builtin_bit_cast(i32x4, t1);
                if (ug == 2) { u32x4 w; w.x = pk2(t0[0], t0[1]); w.y = pk2(t0[2], t0[3]); w.z = pk2(t1[0], t1[1]); w.w = pk2(t1[2], t1[3]);
                    *(u32x4*)(mB + (ml + rr * (unsigned)(D * 2) + (unsigned)(bj * 256))) = w; } }
        }
    }
};
template <bool BASE_BF16> struct EpiResid {
    static constexpr bool PERM = true;
    const void* base; bf16_t* out;
    __device__ __forceinline__ void operator()(const f32x4 (&acc)[2][2][4][2], const pg8::Unit& u, int wr, int wc, int fr, int fq) const {
        const int row0 = u.pm * 256 + wr * 64 + fr, col0 = u.pn * 256 + wc * 32 + 8 * fq;
#pragma unroll
        for (int ai = 0; ai < 2; ++ai) {
            f32x4 b0[4][2], b1[4][2];
#pragma unroll
            for (int m = 0; m < 4; ++m) { const size_t off = (size_t)(row0 + ai * 128 + m * 16) * D + col0;
#pragma unroll
                for (int bj = 0; bj < 2; ++bj) {
                    if (BASE_BF16) { const u32x4 w = *(const u32x4*)((const bf16_t*)base + off + bj * 128);
                        b0[m][bj] = (f32x4){bflo(w.x), bfhi(w.x), bflo(w.y), bfhi(w.y)}; b1[m][bj] = (f32x4){bflo(w.z), bfhi(w.z), bflo(w.w), bfhi(w.w)}; }
                    else { b0[m][bj] = *(const f32x4*)((const float*)base + off + bj * 128); b1[m][bj] = *(const f32x4*)((const float*)base + off + bj * 128 + 4); } } }
            asm volatile("" ::: "memory");
#pragma unroll
            for (int m = 0; m < 4; ++m) { const size_t off = (size_t)(row0 + ai * 128 + m * 16) * D + col0;
#pragma unroll
                for (int bj = 0; bj < 2; ++bj) { const f32x4 v0 = b0[m][bj] + acc[ai][bj][m][0], v1 = b1[m][bj] + acc[ai][bj][m][1];
                    u32x4 w; w.x = pk2(v0[0], v0[1]); w.y = pk2(v0[2], v0[3]); w.z = pk2(v1[0], v1[1]); w.w = pk2(v1[2], v1[3]);
                    *(u32x4*)(out + off + bj * 128) = w; } }
        }
    }
};
struct EpiSwiGLU {
    static constexpr bool PERM = false;
    bf16_t* hid; const float* rsl; LAS const int* pt; LAS const int* lc; const unsigned* cmax  ;
    __device__ __forceinline__ void operator()(const i32x4 (&acc)[2][2][4][2], const pg8::Unit& u, int wr, int wc, int fr, int fq) const {
        const int row0 = u.pm * 256 + wr * 64 + fr, col0 = u.pn * 128 + wc * 16 + 4 * fq;
        const int pbase = (u.pm - pt[u.g]) * 256 + wr * 64 + fr, nrow = lc[u.g];
        float rsv[2][4]; f32x4 sg[2], su[2];
#pragma unroll
        for (int ai = 0; ai < 2; ++ai)
#pragma unroll
            for (int m = 0; m < 4; ++m) { int p = pbase + ai * 128 + m * 16; p = p < nrow ? p : nrow - 1; rsv[ai][m] = rsl[(size_t)u.g * TT + p]; }
#pragma unroll
        for (int bj = 0; bj < 2; ++bj) { const unsigned* cm = cmax + (size_t)u.g * 1024 + u.pn * 256 + bj * 128 + wc * 32 + 4 * fq; const u32x4 a = *(const u32x4*)cm, b = *(const u32x4*)(cm + 16); const float k = 1.f / 127.f;
            sg[bj] = (f32x4){__uint_as_float(a.x) * k, __uint_as_float(a.y) * k, __uint_as_float(a.z) * k, __uint_as_float(a.w) * k};
            su[bj] = (f32x4){__uint_as_float(b.x) * k, __uint_as_float(b.y) * k, __uint_as_float(b.z) * k, __uint_as_float(b.w) * k}; }
#pragma unroll
        for (int ai = 0; ai < 2; ++ai)
#pragma unroll
            for (int m = 0; m < 4; ++m) { bf16_t* rowp = hid + (size_t)(row0 + ai * 128 + m * 16) * FF + col0; const float rs = rsv[ai][m];
#pragma unroll
                for (int bj = 0; bj < 2; ++bj) { const i32x4 ag = acc[ai][bj][m][0], au = acc[ai][bj][m][1]; float g[4], up[4];
#pragma unroll
                    for (int k = 0; k < 4; ++k) { g[k] = (float)ag[k] * (sg[bj][k] * rs); up[k] = (float)au[k] * (su[bj][k] * rs); }
                    u32x2 w; w.x = pk2(g[0] * sigmoidf_(g[0]) * up[0], g[1] * sigmoidf_(g[1]) * up[1]); w.y = pk2(g[2] * sigmoidf_(g[2]) * up[2], g[3] * sigmoidf_(g[3]) * up[3]);
                    *(u32x2*)(rowp + bj * 64) = w; } }
    }
};

constexpr int PH_PER_LAYER = 1 + NCH * 4 + 4, PH_TOTAL = 1 + DEPTH * PH_PER_LAYER + 1;
#ifndef MK_LAUNCH_PER_PHASE
#define MK_LAUNCH_PER_PHASE 0
#endif
#ifndef PHMASK
#define PHMASK 0xFFFF
#endif
#ifndef MIXM
#define MIXM 7
#endif
#define EN(j) (((PHMASK) >> (j)) & 1)
typedef const __attribute__((address_space(4))) char* kptr_t;
__device__ __forceinline__ const void* karg_ptr(kptr_t kp, int i) { return *(const void* const __attribute__((address_space(4)))*)(kp + 8 * i); }
__device__ __forceinline__ void make_ctx(Ctx& c, kptr_t& kp, int layer, int chunk, int wave_s) {
    int t = wave_s * 64 + lane_fresh();
    kp = (kptr_t)__builtin_amdgcn_kernarg_segment_ptr(); asm volatile("" : "+s"(kp));
    c.tid = t; c.lane = t & 63; c.wave = __builtin_amdgcn_readfirstlane(t >> 6); c.bid = blockIdx.x; c.G = gridDim.x;
    unsigned char* ws = (unsigned char*)karg_ptr(kp, 25); float* out = (float*)karg_ptr(kp, 24);
    c.ctl = (unsigned*)(ws + WS_CTL);
    c.actf = (bf16_t*)(ws + WS_ACT); c.act = c.actf + (size_t)chunk * TC * D; c.proj = (bf16_t*)(ws + WS_PROJ); c.hid = (bf16_t*)(ws + WS_HID); c.ys = (bf16_t*)(ws + WS_YS);
    c.rec = (unsigned*)(ws + WS_REC); c.list = (int*)(ws + WS_LIST); c.rsl = (float*)(ws + WS_RSL);
    c.chunk = chunk; c.layer = layer; c.pass = layer * NCH + chunk;
    c.xinf = (const float*)karg_ptr(kp, 0); c.xof = out; c.xb = (bf16_t*)(ws + WS_XB); c.x2 = (bf16_t*)out; c.sa = (float*)(ws + WS_SA); c.sbr = (float*)(ws + WS_SBR);
    c.x_in = c.xinf + (size_t)chunk * TC * D; c.xo = out + (size_t)chunk * TC * D;
    c.pos = (const int*)karg_ptr(kp, 1) + (size_t)chunk * TC;
    c.lw = ws + WS_W + (size_t)layer * LW_SIZE;
}
#define INP(i) ((const float*)karg_ptr(kp, (i)))
__global__ void __launch_bounds__(NTHR, 2) fwd(Args args) {
    extern __shared__ __attribute__((aligned(16))) unsigned char lds_raw[];
    Ctx c; kptr_t kp;
    c.lds = (LAS unsigned char*)lds_raw;
    const int wave_s = __builtin_amdgcn_readfirstlane((int)threadIdx.x >> 6);
    make_ctx(c, kp, 0, 0, wave_s);
    volatile LAS unsigned* MISC = (volatile LAS unsigned*)(c.lds + MISC_OFF);
    LAS int* sPT = (LAS int*)(c.lds + MISC_OFF + 64);
    LAS int* sLC = (LAS int*)(c.lds + MISC_OFF + 160);
    for (int u = c.tid; u < 1024; u += NTHR) MISC[u] = 0u;
    __syncthreads();
    XcdBarrier bar; bar.bar = c.ctl + CW_BAR; bar.x = 0; bar.st = nullptr;
    if (!MK_LAUNCH_PER_PHASE) bar = xcd_barrier_post(c.ctl + CW_BAR, MISC, c.tid);
    const int lo = args.ph_lo, hi = args.ph_hi;
#define IN(k) (lo <= (k) && (k) < hi)
#ifndef PROBE_MASK
#define PROBE_MASK 0
#endif
#ifndef PROBE_CLK_CLS
#define PROBE_CLK_CLS 2
#endif
#ifndef PROBE_BLOCK
#define PROBE_BLOCK 0
#endif
#ifndef PROBE_K
#define PROBE_K 4
#endif
    unsigned long long t_prev = 0, c_prev = 0; LAS unsigned* sAcc = (LAS unsigned*)(c.lds + MISC_OFF + 512);
    if (PROBE_MASK) { t_prev = __builtin_amdgcn_s_memrealtime(); c_prev = (unsigned long long)clock64(); }
#define STAMP(cls) do { if (PROBE_MASK) { const unsigned long long _n = __builtin_amdgcn_s_memrealtime(); const unsigned long long _ck = (unsigned long long)clock64(); if (blockIdx.x == PROBE_BLOCK && c.tid == 0) { sAcc[(cls)] += (unsigned)(_n - t_prev); if ((cls) == PROBE_CLK_CLS) sAcc[15] += (unsigned)((_ck - c_prev) >> 4); } t_prev = _n; c_prev = _ck; } } while (0)
#ifndef PROBE_GEMM_CLS
#define PROBE_GEMM_CLS -1
#endif
#define GEMM_FLAG(cls) do { if (PROBE_MASK) { if (c.tid == 0) MISC[6] = ((cls) == PROBE_GEMM_CLS) ? 1u : 0u; __syncthreads(); } } while (0)
#define SEAM(k) do { if (IN(k) && IN((k) + 1)) { XcdBarrier _b = bar; kptr_t _k = (kptr_t)__builtin_amdgcn_kernarg_segment_ptr(); asm volatile("" : "+s"(_k)); _b.bar = (unsigned*)((unsigned char*)karg_ptr(_k, 25) + WS_CTL) + CW_BAR; { int _t = wave_s * 64 + lane_fresh(); const unsigned long long _b0 = PROBE_MASK ? __builtin_amdgcn_s_memrealtime() : 0ull; xcd_barrier(_b, _t); if (PROBE_MASK && blockIdx.x == PROBE_BLOCK && _t == 0) sAcc[13] += (unsigned)(__builtin_amdgcn_s_memrealtime() - _b0); } } } while (0)

    if (EN(0) && IN(0)) { Args a2;
#pragma unroll
        for (int i = 0; i < 24; ++i) a2.in[i] = karg_ptr(kp, i);
        a2.ws = (unsigned char*)karg_ptr(kp, 25); a2.out = nullptr; a2.ph_lo = 0; a2.ph_hi = 0;
        float* tmpf = (float*)(a2.ws + WS_XB); unsigned* cmaxb = c.ctl + CW_CMAX;
        phase_prep_a(a2, tmpf, cmaxb, c.bid * NWAVES + c.wave, c.G * NWAVES, c.lane, c.bid * NTHR + c.tid, c.G * NTHR);
        { XcdBarrier _b = bar; _b.bar = c.ctl + CW_BAR; xcd_barrier(_b, c.tid); }
        phase_prep(a2, tmpf, cmaxb, c.lds, c.bid * NWAVES + c.wave, c.G * NWAVES, c.wave, c.lane, c.bid * NTHR + c.tid, c.G * NTHR);
        phase_rope_table((const int*)karg_ptr(kp, 1), (float*)(c.ctl) + (WS_BRC + 4 * MiB) / 4, c.bid * NTHR + c.tid, c.G * NTHR); }
    SEAM(0); STAMP(0);

    for (int layer = 0; layer < DEPTH; ++layer) {
        const int pl = 1 + layer * PH_PER_LAYER;
        if (EN(1) && IN(pl)) { make_ctx(c, kp, layer, 0, wave_s);
            const float* g1 = INP(2) + layer * D;
            if (layer == 0) phase_norm1<false, true, false>(c, g1, sPT);
            else { moe_tables(c.ctl + CW_CNT + 64 * (layer - 1), sPT, sLC, c.tid); phase_norm1<true, true, true>(c, g1, sPT); }
        }
        SEAM(pl); STAMP(1);
        for (int chunk = 0; chunk < NCH; ++chunk) {
            const int pb = pl + 1 + chunk * 4;
            if (EN(2) && IN(pb + 0)) { make_ctx(c, kp, layer, chunk, wave_s);
                EpiProj E{c.proj, c.sa + (size_t)chunk * TC, c.ctl + CW_CMAX + (size_t)layer * NP};
                GEMM_FLAG(2);
                PlainOrder S{TC / 256, NP / 256, c.G, c.bid, (const char*)c.act, (const char*)(c.lw + LW_WIN), (size_t)256 * D, (size_t)256 * D, 0, 1 << 20};
                pg8::gemm_phase<EpiProj, PlainOrder, false, true>(c.lds, S, E, D / 2, D / 2, c.tid);
            }
            SEAM(pb + 0); STAMP(2);
            if (EN(4) && IN(pb + 1)) { make_ctx(c, kp, layer, chunk, wave_s);
                float* lse = (float*)(c.ctl) + (WS_BRC / 4);
                if ((MIXM & 1) && c.bid < 4 * BC) gla_unit(c, c.bid, INP(5) + layer * 256, INP(6) + layer * 128);
                else if ((MIXM & 2) && c.bid < 12 * BC) lru_unit(c, c.bid - 4 * BC, INP(7) + layer * 4 * 512, INP(8) + layer * 512, INP(9) + layer * 8 * 64 * 64,
                                                    INP(10) + layer * 512, INP(11) + layer * 8 * 64 * 64, INP(12) + layer * 512, INP(13) + layer * 512);
                STAMP(12);
                unsigned* qh = c.ctl + CW_Q + 64 * c.pass;
                if (MIXM & 4) attn_loop(c, qh, MISC + 4, lse, INP(14) + layer * 128, INP(15) + layer * 128, (const float*)(c.ctl) + (WS_BRC + 4 * MiB) / 4 + (size_t)chunk * TC * 32);
            }
            SEAM(pb + 1); STAMP(4);
            if (EN(11) && IN(pb + 2)) { make_ctx(c, kp, layer, chunk, wave_s); phase_attn_combine(c, (const float*)(c.ctl) + (WS_BRC / 4)); }
            SEAM(pb + 2); STAMP(11);
            if (EN(5) && IN(pb + 3)) { make_ctx(c, kp, layer, chunk, wave_s);
                MergeOrder S{c.G, c.bid, (const char*)c.proj, (const char*)(c.lw + LW_WBR)};
                EpiMerge E{c.proj, c.act, c.sbr, c.ctl + CW_CMAX3 + (size_t)layer * 3 * 1024};
                GEMM_FLAG(5);
                pg8::gemm_phase<EpiMerge, MergeOrder, false, true, true>(c.lds, S, E, 256, NP, c.tid);
            }
            SEAM(pb + 3); STAMP(5);
        }
        const int pm = pl + 2 + NCH * 4;
        if (EN(6) && IN(pm - 1)) { make_ctx(c, kp, layer, 0, wave_s);
            PlainOrder S{TT / 256, D / 256, c.G, c.bid, (const char*)c.actf, (const char*)(c.lw + LW_WOUT), (size_t)256 * D * 2, (size_t)256 * D * 2, 0, 1 << 20};
            GEMM_FLAG(6);
            if (layer == 0) { EpiResid<false> E{(const void*)c.xinf, c.xb}; pg8::gemm_phase<EpiResid<false>, PlainOrder, false>(c.lds, S, E, D, D, c.tid); }
            else            { EpiResid<true>  E{(const void*)c.x2,  c.xb}; pg8::gemm_phase<EpiResid<true>,  PlainOrder, false>(c.lds, S, E, D, D, c.tid); }
        }
        SEAM(pm - 1); STAMP(6);
        if (EN(7) && IN(pm + 0)) { make_ctx(c, kp, layer, 0, wave_s); phase_router(c, INP(18) + layer * D, INP(19), INP(20), c.ctl + CW_CNT + 64 * layer); }
        SEAM(pm + 0); STAMP(7);
        if (EN(8) && IN(pm + 1)) { make_ctx(c, kp, layer, 0, wave_s);
            moe_tables(c.ctl + CW_CNT + 64 * layer, sPT, sLC, c.tid);
            MoeOrder<true> S{c.G, c.bid, sPT, sLC, (const char*)c.actf, (const char*)(c.lw + LW_WGU), c.list};
            EpiSwiGLU E{c.hid, c.rsl, sPT, sLC, c.ctl + CW_CMAX2 + (size_t)layer * NE * 1024};
            GEMM_FLAG(8);
            pg8::gemm_phase<EpiSwiGLU, MoeOrder<true>, true, true>(c.lds, S, E, D / 2, D / 2, c.tid);
        }
        SEAM(pm + 1); STAMP(8);
        if (EN(9) && IN(pm + 2)) { make_ctx(c, kp, layer, 0, wave_s);
            moe_tables(c.ctl + CW_CNT + 64 * layer, sPT, sLC, c.tid);
            MoeOrder<false> S{c.G, c.bid, sPT, sLC, (const char*)c.hid, (const char*)(c.lw + LW_WDN), c.list};
            EpiStoreBf16 E{c.ys, D};
            GEMM_FLAG(9);
            pg8::gemm_phase<EpiStoreBf16, MoeOrder<false>, false>(c.lds, S, E, FF, FF, c.tid);
        }
        SEAM(pm + 2); STAMP(9);
    }
    if (EN(10) && IN(PH_TOTAL - 1)) { make_ctx(c, kp, DEPTH - 1, 0, wave_s);
        moe_tables(c.ctl + CW_CNT + 64 * (DEPTH - 1), sPT, sLC, c.tid);
        phase_norm1<true, false, true>(c, nullptr, sPT);
    }
    if (PROBE_MASK) {
        make_ctx(c, kp, DEPTH - 1, 0, wave_s);
        STAMP(10);
        if (blockIdx.x == PROBE_BLOCK && c.tid == 0) { unsigned sel = 0; for (int k = 0; k < 16; ++k) if ((PROBE_MASK >> k) & 1) sel += sAcc[k]; __hip_atomic_store(c.ctl + CW_Q + 64 * 8, sel, __ATOMIC_RELAXED, __HIP_MEMORY_SCOPE_AGENT); }
        { XcdBarrier _b = bar; _b.bar = c.ctl + CW_BAR; xcd_barrier(_b, c.tid); }
        const unsigned sel = __hip_atomic_load(c.ctl + CW_Q + 64 * 8, __ATOMIC_RELAXED, __HIP_MEMORY_SCOPE_AGENT);
        const unsigned long long t0 = __builtin_amdgcn_s_memrealtime();
        while (__builtin_amdgcn_s_memrealtime() - t0 < (unsigned long long)sel * PROBE_K) __builtin_amdgcn_s_sleep(8);
    }
#undef IN
#undef SEAM
}

extern "C" void kernel_launch(void* const* d_in, const int* in_sizes, int n_in, void* d_out, int out_size, void* d_ws, size_t ws_size, hipStream_t stream) {
    static int grid = 0;
    if (grid == 0) {
        if (n_in != 24 || in_sizes[0] != BATCH * SEQ * D || out_size != BATCH * SEQ * D || ws_size < WS_END) { fprintf(stderr, "kernel_launch: unexpected shapes / workspace (%zu < %zu)\n", ws_size, (size_t)WS_END); grid = -1; return; }
        int dev = 0, cus = 0;
        if (hipGetDevice(&dev) != hipSuccess || hipDeviceGetAttribute(&cus, hipDeviceAttributeMultiprocessorCount, dev) != hipSuccess || cus < 256) { fprintf(stderr, "kernel_launch: needs a 256-CU device\n"); grid = -1; return; }
        if (hipFuncSetAttribute((const void*)fwd, hipFuncAttributeMaxDynamicSharedMemorySize, LDS_BYTES) != hipSuccess) { fprintf(stderr, "kernel_launch: hipFuncSetAttribute failed\n"); grid = -1; return; }
        int per_cu = 0;
        if (hipOccupancyMaxActiveBlocksPerMultiprocessor(&per_cu, (const void*)fwd, NTHR, LDS_BYTES) != hipSuccess || per_cu < 1) fprintf(stderr, "kernel_launch: occupancy query says %d\n", per_cu);
        (void)hipGetLastError();
        grid = 256;
    }
    if (grid < 0) return;
    if (hipMemsetAsync((char*)d_ws + WS_CTL, 0, CTL_ZERO_BYTES, stream) != hipSuccess) return;
    Args a{};
    for (int i = 0; i < 24; ++i) a.in[i] = d_in[i];
    a.out = (float*)d_out; a.ws = (unsigned char*)d_ws;
#if MK_LAUNCH_PER_PHASE
    for (int k = 0; k < PH_TOTAL; ++k) { a.ph_lo = k; a.ph_hi = k + 1; hipLaunchKernelGGL(fwd, dim3(grid), dim3(NTHR), LDS_BYTES, stream, a); }
#else
    a.ph_lo = 0; a.ph_hi = PH_TOTAL;
    hipLaunchKernelGGL(fwd, dim3(grid), dim3(NTHR), LDS_BYTES, stream, a);
#endif
}
```

```cpp
#include <hip/hip_runtime.h>
#include <cstdio>
#include <cstdint>

#define LAS __attribute__((address_space(3)))
#define GAS __attribute__((address_space(1)))
typedef unsigned short bf16_t;
typedef short bf16x8 __attribute__((ext_vector_type(8)));
typedef float f32x4 __attribute__((ext_vector_type(4)));
typedef float f32x2 __attribute__((ext_vector_type(2)));
typedef unsigned u32x4 __attribute__((ext_vector_type(4)));
typedef unsigned u32x2 __attribute__((ext_vector_type(2)));
typedef int i32x4 __attribute__((ext_vector_type(4)));
typedef int i32x8 __attribute__((ext_vector_type(8)));

namespace pg8 {
constexpr int BM = 256, BK = 64, HALF = 128, HTB = HALF * BK * 2, STAGE_BYTES = 8 * HTB, NXCD = 8, WGM = 8;
__host__ __device__ __forceinline__ int lds_byte(int r, int c) { const int st = (r >> 4) * 2 + (c >> 5), rr = r & 15, cc = c & 31, ob = rr * 64 + cc * 2; return st * 1024 + (ob ^ (((ob >> 9) & 1) << 5)); }
__host__ __device__ __forceinline__ void stage_rc(int b, int& R, int& C) { const int st = b / 1024, sb = b % 1024, swz = sb ^ (((sb >> 9) & 1) << 5); R = (st >> 1) * 16 + swz / 64; C = (st & 1) * 32 + (swz % 64) / 2; }
__host__ __device__ __forceinline__ int perm32(int rho) { const int n = rho >> 4, i = rho & 15; return 8 * (i >> 2) + 4 * n + (i & 3); }

struct Unit { int pm, pn, g; };

__device__ __forceinline__ bool static_tile(int nM, int nN, int G, int c, int i, int& pm, int& pn) {
    const int nwg = nM * nN; const long L = (long)i * G + c; if (L >= nwg) return false;
    int wgid = (int)L; { const int q = nwg / NXCD, r = nwg % NXCD, xcd = wgid % NXCD, off = wgid / NXCD; wgid = (xcd < r ? xcd * (q + 1) : r * (q + 1) + (xcd - r) * q) + off; }
    const int nig = WGM * nN, gid = wgid / nig, fm = gid * WGM, gsz = (nM - fm) < WGM ? (nM - fm) : WGM;
    pm = fm + ((wgid % nig) % gsz); pn = (wgid % nig) / gsz; return true;
}
typedef __bf16 bf16x2c_t __attribute__((ext_vector_type(2)));
__device__ __forceinline__ unsigned cvt_pk_bf16(float lo, float hi) { const f32x2 v = {lo, hi}; return __builtin_bit_cast(unsigned, __builtin_convertvector(v, bf16x2c_t)); }

__device__ __forceinline__ int lane_id_fresh() { int l; asm volatile("v_mbcnt_lo_u32_b32 %0, -1, 0\n\tv_mbcnt_hi_u32_b32 %0, -1, %0" : "=v"(l)); return l; }
template <class Epi, bool HM> struct PfT { struct t {}; };
template <class Epi> struct PfT<Epi, true> { typedef typename Epi::Pf t; };
template <bool I8> struct AccT { typedef f32x4 t; };
template <> struct AccT<true> { typedef i32x4 t; };
template <class Epi, class Sched, bool GATHER, bool I8 = false, bool HM = false, bool F8 = false>
__device__ __forceinline__ void gemm_phase(LAS unsigned char* lds, const Sched& S, const Epi& E, const int K, const int lda, int tid_) {
    asm volatile("" : "+v"(tid_));
    const int tid = tid_, wid = __builtin_amdgcn_readfirstlane(tid >> 6), lane = tid & 63, wr = wid >> 2, wc = wid & 3, fr = lane & 15, fq = lane >> 4;
    const int nt = K / BK;
    unsigned voffB, voffA, vAc[2][2], vAn[2][2];
    { int R, C; stage_rc(tid * 16, R, C); const int Rb = Epi::PERM ? ((R & ~31) + perm32(R & 31)) : R;
      voffB = (unsigned)(Rb * K + C) * 2u; voffA = (unsigned)(R * lda + C) * 2u; }
    const size_t qstepB = (size_t)64 * K * 2, qstepA = (size_t)64 * lda * 2;
    const size_t kstep = (size_t)(BK * 2);
    const size_t hstepB = (size_t)HALF * K * 2, hstepA = (size_t)HALF * lda * 2;
    const unsigned ldsw = (unsigned)wid * 1024u;
    const int aoff = lds_byte(wr * 64 + fr, fq * 8), boff = lds_byte(wc * 32 + fr, fq * 8);
#define PG8_SA(b, h) (((b) * 2 + (h)) * HTB)
#define PG8_SB(b, h) ((4 + (b) * 2 + (h)) * HTB)
#define PG8_STAGE(bufoff, gbase, voff) do { _Pragma("unroll") for (int _i = 0; _i < 2; ++_i) \
        __builtin_amdgcn_global_load_lds((const unsigned*)((const char*)(gbase) + _i * voff##_q + (voff)), (LAS unsigned*)(lds + (bufoff) + ldsw + _i * 8192), 16, 0, 0); } while (0)
#define voffB_q qstepB
#define voffA_q qstepA
#define PG8_LDA(dst, b, h) do { _Pragma("unroll") for (int m = 0; m < 4; ++m) _Pragma("unroll") for (int k = 0; k < 2; ++k) dst[m][k] = *(const LAS bf16x8*)(lds + PG8_SA(b, h) + aoff + m * 2048 + k * 1024); } while (0)
#define PG8_LDB(dst, b, h) do { _Pragma("unroll") for (int n = 0; n < 2; ++n) _Pragma("unroll") for (int k = 0; k < 2; ++k) dst[n][k] = *(const LAS bf16x8*)(lds + PG8_SB(b, h) + boff + n * 2048 + k * 1024); } while (0)
#define PG8_MMA(ai, bj, At, Bt) do { __builtin_amdgcn_s_setprio(1); _Pragma("unroll") for (int m = 0; m < 4; ++m) _Pragma("unroll") for (int n = 0; n < 2; ++n) { if constexpr (F8) { \
          const i32x8 _B = __builtin_shufflevector(__builtin_bit_cast(i32x4, Bt[n][0]), __builtin_bit_cast(i32x4, Bt[n][1]), 0, 1, 2, 3, 4, 5, 6, 7), _A = __builtin_shufflevector(__builtin_bit_cast(i32x4, At[m][0]), __builtin_bit_cast(i32x4, At[m][1]), 0, 1, 2, 3, 4, 5, 6, 7); \
          acc[ai][bj][m][n] = __builtin_amdgcn_mfma_scale_f32_16x16x128_f8f6f4(_B, _A, acc[ai][bj][m][n], 0, 0, 0, 0x7F7F7F7F, 0, 0x7F7F7F7F); asm volatile("" : "+v"(acc[ai][bj][m][n])); }     else _Pragma("unroll") for (int k = 0; k < 2; ++k) \
        { if constexpr (I8) acc[ai][bj][m][n] = __builtin_amdgcn_mfma_i32_16x16x64_i8(__builtin_bit_cast(i32x4, Bt[n][k]), __builtin_bit_cast(i32x4, At[m][k]), acc[ai][bj][m][n], 0, 0, 0); \
          else acc[ai][bj][m][n] = __builtin_amdgcn_mfma_f32_16x16x32_bf16(Bt[n][k], At[m][k], acc[ai][bj][m][n], 0, 0, 0); } } __builtin_amdgcn_s_setprio(0); } while (0)
#define PG8_WAIT_V(n) asm volatile("s_waitcnt vmcnt(" #n ")" ::: "memory")
#define PG8_WAIT_L(n) asm volatile("s_waitcnt lgkmcnt(" #n ")" ::: "memory")
#define PG8_BAR __builtin_amdgcn_s_barrier()
#define PG8_SCHED __builtin_amdgcn_sched_barrier(0)
#define PG8_AOFF(dst, u) do { if constexpr (GATHER) { _Pragma("unroll") for (int _h = 0; _h < 2; ++_h) _Pragma("unroll") for (int _i = 0; _i < 2; ++_i) \
        { int _R, _C; int _tl = lane_id_fresh() + (int)wid * 64; stage_rc(_tl * 16 + _i * 8192, _R, _C); dst[_h][_i] = S.arow(u, _h * HALF + _R) + (unsigned)_C * 2u; } } } while (0)
#define PG8_STAGE_A(bufoff, gptr, h, usenext) do { if constexpr (GATHER) { _Pragma("unroll") for (int _i = 0; _i < 2; ++_i) { const unsigned _vo = (usenext) ? vAn[h][_i] : vAc[h][_i]; \
        __builtin_amdgcn_global_load_lds((const unsigned*)((const char*)(gptr) + _vo), (LAS unsigned*)(lds + (bufoff) + ldsw + _i * 8192), 16, 0, 0); } } \
        else { PG8_STAGE(bufoff, (gptr) + (h) * hstepA, voffA); } } while (0)
    Unit cur, nxt; int ui = 0;
    if (!S.next(0, cur)) return;
    typedef typename AccT<I8>::t acc_t;
    acc_t acc[2][2][4][2];
#pragma unroll
    for (int a = 0; a < 2; ++a)
#pragma unroll
        for (int b = 0; b < 2; ++b)
#pragma unroll
            for (int m = 0; m < 4; ++m)
#pragma unroll
                for (int n = 0; n < 2; ++n) acc[a][b][m][n] = (acc_t){0, 0, 0, 0};
    bf16x8 At[4][2], B0[2][2], B1[2][2];
    typename PfT<Epi, HM>::t pf, pfn;
    if constexpr (HM) E.prefetch(pf, cur, wr, wc);
    const char* cA = S.aptr(cur); const char* cB = S.bptr(cur);
    PG8_AOFF(vAc, cur);
    PG8_STAGE(PG8_SB(0, 0), cB, voffB); PG8_STAGE(PG8_SB(0, 1), cB + hstepB, voffB); PG8_STAGE_A(PG8_SA(0, 0), cA, 0, false); if constexpr (!HM) PG8_STAGE_A(PG8_SA(0, 1), cA, 1, false);
    if (wr == 1) PG8_BAR;
    if constexpr (HM) PG8_WAIT_V(0); else PG8_WAIT_V(2);
    PG8_BAR;
    PG8_STAGE(PG8_SB(1, 0), cB + kstep, voffB); PG8_STAGE_A(PG8_SA(1, 0), cA + kstep, 0, false); PG8_STAGE(PG8_SB(1, 1), cB + hstepB + kstep, voffB);
    PG8_WAIT_V(6); PG8_BAR;
    for (;;) {
        const bool has_next = S.next(ui + 1, nxt);
        const char* nA = has_next ? S.aptr(nxt) : cA; const char* nB = has_next ? S.bptr(nxt) : cB;
        if constexpr (GATHER) { if (has_next) { PG8_AOFF(vAn, nxt); } else {
#pragma unroll
            for (int h = 0; h < 2; ++h)
#pragma unroll
                for (int i = 0; i < 2; ++i) vAn[h][i] = vAc[h][i]; } }
#if defined(PROBE_MASK) && PROBE_MASK
        const unsigned long long _tk0 = __builtin_amdgcn_s_memrealtime();
#endif
        for (int t = 0; t < nt; t += 2) {
            const bool last = (t == nt - 2);
            const char* a1 = cA + (size_t)(t + 1) * kstep;
            const char* a2 = last ? nA : cA + (size_t)(t + 2) * kstep; const char* b2 = last ? nB : cB + (size_t)(t + 2) * kstep;
            const char* a3 = a2 + kstep; const char* b3 = b2 + kstep;
            if constexpr (!HM) {
            PG8_LDB(B0, 0, 0); PG8_LDB(B1, 0, 1); PG8_SCHED; PG8_LDA(At, 0, 0); PG8_STAGE_A(PG8_SA(1, 1), a1, 1, false);
            PG8_WAIT_V(8); PG8_WAIT_L(0); PG8_BAR; PG8_MMA(0, 0, At, B0); PG8_MMA(0, 1, At, B1); PG8_BAR; PG8_SCHED;
            PG8_LDA(At, 0, 1); PG8_STAGE(PG8_SB(0, 0), b2, voffB); PG8_STAGE(PG8_SB(0, 1), b2 + hstepB, voffB); PG8_STAGE_A(PG8_SA(0, 0), a2, 0, last);
            PG8_WAIT_V(8); PG8_WAIT_L(0); PG8_BAR; PG8_MMA(1, 0, At, B0); PG8_MMA(1, 1, At, B1); PG8_BAR; PG8_SCHED;
            PG8_LDB(B0, 1, 0); PG8_LDB(B1, 1, 1); PG8_SCHED; PG8_LDA(At, 1, 0); PG8_STAGE_A(PG8_SA(0, 1), a2, 1, last);
            PG8_WAIT_V(8); PG8_WAIT_L(0); PG8_BAR; PG8_MMA(0, 0, At, B0); PG8_MMA(0, 1, At, B1); PG8_BAR; PG8_SCHED;
            PG8_LDA(At, 1, 1); PG8_STAGE(PG8_SB(1, 0), b3, voffB); PG8_STAGE(PG8_SB(1, 1), b3 + hstepB, voffB); PG8_STAGE_A(PG8_SA(1, 0), a3, 0, last);
            PG8_WAIT_V(8); PG8_WAIT_L(0); PG8_BAR; PG8_MMA(1, 0, At, B0); PG8_MMA(1, 1, At, B1); PG8_BAR; PG8_SCHED;
            } else {
            (void)a1;
            PG8_LDB(B0, 0, 0); PG8_LDB(B1, 0, 1); PG8_SCHED; PG8_LDA(At, 0, 0);
            PG8_WAIT_L(0); PG8_BAR; PG8_MMA(0, 0, At, B0); PG8_MMA(0, 1, At, B1); PG8_BAR; PG8_SCHED;
            PG8_STAGE(PG8_SB(0, 0), b2, voffB); PG8_STAGE(PG8_SB(0, 1), b2 + hstepB, voffB); PG8_STAGE_A(PG8_SA(0, 0), a2, 0, last);
            if (t == 0 && ui > 0) { if (Epi::stored(cur)) asm volatile("s_waitcnt vmcnt(%0)" :: "n"(6 + Epi::PF_LOADS + Epi::EPI_STORES) : "memory"); else asm volatile("s_waitcnt vmcnt(%0)" :: "n"(6 + Epi::PF_LOADS) : "memory"); }
            else PG8_WAIT_V(6);
            PG8_BAR; PG8_BAR; PG8_SCHED;
            PG8_LDB(B0, 1, 0); PG8_LDB(B1, 1, 1); PG8_SCHED; PG8_LDA(At, 1, 0);
            PG8_WAIT_L(0); PG8_BAR; PG8_MMA(0, 0, At, B0); PG8_MMA(0, 1, At, B1); PG8_BAR; PG8_SCHED;
            PG8_STAGE(PG8_SB(1, 0), b3, voffB); PG8_STAGE(PG8_SB(1, 1), b3 + hstepB, voffB); PG8_STAGE_A(PG8_SA(1, 0), a3, 0, last);
            PG8_WAIT_V(6); PG8_BAR; PG8_BAR; PG8_SCHED;
            }
        }
#if defined(PROBE_MASK) && PROBE_MASK
        if (blockIdx.x == PROBE_BLOCK && tid == 0 && ((volatile LAS unsigned*)(lds + 147456))[6]) ((LAS unsigned*)(lds + 147456 + 512))[14] += (unsigned)(__builtin_amdgcn_s_memrealtime() - _tk0);
#endif
        if (wr == 0) PG8_BAR;
#if defined(PROBE_MASK) && PROBE_MASK
        { const unsigned long long _t0 = __builtin_amdgcn_s_memrealtime();
          if constexpr (HM) { E(acc, cur, wr, wc, pf, has_next, nxt, pfn); pf = pfn; } else E(acc, cur, wr, wc, fr, fq);
          if constexpr (!HM) asm volatile("s_waitcnt vmcnt(0)" ::: "memory");
          if (blockIdx.x == PROBE_BLOCK && tid == 0 && ((volatile LAS unsigned*)(lds + 147456))[6]) ((LAS unsigned*)(lds + 147456 + 512))[13] += (unsigned)(__builtin_amdgcn_s_memrealtime() - _t0); }
#else
        if constexpr (HM) { E(acc, cur, wr, wc, pf, has_next, nxt, pfn); pf = pfn; } else E(acc, cur, wr, wc, fr, fq);
#endif
        if (!has_next) break;
#pragma unroll
        for (int a = 0; a < (HM ? 1 : 2); ++a)
#pragma unroll
            for (int b = 0; b < 2; ++b)
#pragma unroll
                for (int m = 0; m < 4; ++m)
#pragma unroll
                    for (int n = 0; n < 2; ++n) acc[a][b][m][n] = (acc_t){0, 0, 0, 0};
        cur = nxt; cA = nA; cB = nB; ++ui;
        if constexpr (GATHER) {
#pragma unroll
        for (int h = 0; h < 2; ++h)
#pragma unroll
            for (int i = 0; i < 2; ++i) vAc[h][i] = vAn[h][i]; }
        if (wr == 1) PG8_BAR;
    }
    PG8_WAIT_V(0);
    PG8_BAR;
#undef PG8_SA
#undef PG8_SB
#undef PG8_STAGE
#undef voffB_q
#undef voffA_q
#undef PG8_LDA
#undef PG8_LDB
#undef PG8_MMA
#undef PG8_WAIT_V
#undef PG8_WAIT_L
#undef PG8_BAR
#undef PG8_SCHED
#undef PG8_AOFF
#undef PG8_STAGE_A
}
}

constexpr int D = 1024, BATCH = 32, SEQ = 2048, DEPTH = 2;
constexpr int NCH = 2, BC = BATCH / NCH, TC = BC * SEQ;
constexpr int TT = BATCH * SEQ;
constexpr int NP = 10496;
constexpr int C_QA = 0, C_KA = 256, C_VA = 512, C_OG = 1024, C_GP = 1536, C_XB = 1792, C_YB = 2304, C_QKV = 2816, C_G = 7424;
constexpr int WIN_N = 10256;
constexpr int NE = 16, FF = 512;
constexpr int RP = 2 * TT + NE * 256;
constexpr float RMS_EPS = 1e-6f;
constexpr int NWAVES = 8, NTHR = 512;

constexpr size_t MiB = 1u << 20;
constexpr size_t WS_CTL = 0, CTL_ZERO_BYTES = 1 * MiB;
constexpr size_t WS_REC = 1 * MiB;
constexpr size_t WS_LIST = 2 * MiB;
constexpr size_t WS_W = 6 * MiB;
constexpr size_t LW_WIN = 0, LW_WBR = LW_WIN + (size_t)NP * D * 2, LW_WOUT = LW_WBR + (size_t)3 * D * 512 * 2, LW_WGU = LW_WOUT + (size_t)D * D * 2,
                 LW_WDN = LW_WGU + (size_t)NE * 1024 * D * 2, LW_SIZE = LW_WDN + (size_t)NE * D * FF * 2;
static_assert(LW_SIZE == 77070336, "layer weights");
constexpr size_t WS_BRC = 154 * MiB;
constexpr size_t WS_SA = WS_BRC + 2 * MiB;
constexpr size_t WS_SMG = WS_BRC + 2 * MiB + 512 * 1024;
constexpr int RW_STRIDE = 1032;
constexpr size_t WS_RW = WS_BRC + 3 * MiB + 512 * 1024;
constexpr size_t WS_SBR = WS_BRC + 3 * MiB;
constexpr size_t WS_ACT = 166 * MiB;
constexpr size_t WS_PROJ = 294 * MiB;
constexpr size_t WS_HID = WS_PROJ;
constexpr size_t WS_YS = WS_PROJ + 136 * MiB;
constexpr size_t WS_XB = WS_PROJ + 400 * MiB;
constexpr size_t WS_RSL = WS_PROJ + 656 * MiB;
constexpr size_t WS_END = WS_RSL + 4 * MiB;
static_assert(WS_W + 2 * LW_SIZE <= WS_BRC && WS_BRC + 12 * MiB <= WS_ACT && WS_ACT + (size_t)TT * D * 2 <= WS_PROJ && (size_t)TC * NP * 2 <= 656 * MiB && (size_t)RP * 512 * 2 <= 136 * MiB && WS_YS + (size_t)RP * 2048 <= WS_XB && WS_XB + (size_t)TT * D * 2 <= WS_RSL, "ws map");
constexpr int CW_BAR = 4096;
constexpr float F8_WSCALE = 32.f, F8_HSCALE = 8.f;
constexpr int CNT_PAD = 32, CNT_LAYER = 16 * CNT_PAD;
constexpr int CW_CNT = 8192;
constexpr int CW_Q = 12288;
constexpr int CW_CMAX3 = 65536 + 2 * NP + 2 * NE * 1024;
constexpr int CW_CMAX4 = CW_CMAX3 + DEPTH * 3 * 1024;
constexpr int CW_CMAX2 = 65536 + 2 * NP;
constexpr int CW_CMAX = 65536;

constexpr int RING_BYTES = 147456;
constexpr int MISC_OFF = RING_BYTES;
constexpr int LDS_BYTES = 155648;

#define LDS_WAIT() asm volatile("s_waitcnt lgkmcnt(0)" ::: "memory")
#define VM_WAIT() asm volatile("s_waitcnt vmcnt(0)" ::: "memory")
__device__ __forceinline__ float bf2f(unsigned short b) { return __uint_as_float(((unsigned)b) << 16); }
__device__ __forceinline__ float bflo(unsigned u) { return __uint_as_float(u << 16); }
__device__ __forceinline__ float bfhi(unsigned u) { return __uint_as_float(u & 0xffff0000u); }
typedef __bf16 bf16x2v_t __attribute__((ext_vector_type(2)));
__device__ __forceinline__ unsigned pk2(float lo, float hi) { const f32x2 v = {lo, hi}; return __builtin_bit_cast(unsigned, __builtin_convertvector(v, bf16x2v_t)); }
__device__ __forceinline__ unsigned f2bf(float f) { return pk2(f, 0.f) & 0xffffu; }
__device__ __forceinline__ float rcpf_(float x) { return __builtin_amdgcn_rcpf(x); }
__device__ __forceinline__ float rsqf_(float x) { return __builtin_amdgcn_rsqf(x); }
template <int O> __device__ __forceinline__ float swz_xor(float v) { return __int_as_float(__builtin_amdgcn_ds_swizzle(__float_as_int(v), (O << 10) | 0x1f)); }
__device__ __forceinline__ float wave_sum(float v) {
    v += swz_xor<1>(v); v += swz_xor<2>(v); v += swz_xor<4>(v); v += swz_xor<8>(v); v += swz_xor<16>(v);
    const auto r = __builtin_amdgcn_permlane32_swap(__float_as_uint(v), __float_as_uint(v), false, false);
    return __uint_as_float(r[0]) + __uint_as_float(r[1]);
}
__device__ __forceinline__ float wave_max(float v) {
    v = fmaxf(v, swz_xor<1>(v)); v = fmaxf(v, swz_xor<2>(v)); v = fmaxf(v, swz_xor<4>(v)); v = fmaxf(v, swz_xor<8>(v)); v = fmaxf(v, swz_xor<16>(v));
    const auto r = __builtin_amdgcn_permlane32_swap(__float_as_uint(v), __float_as_uint(v), false, false);
    return fmaxf(__uint_as_float(r[0]), __uint_as_float(r[1]));
}
__device__ __forceinline__ float sigmoidf_(float x) { return __builtin_amdgcn_rcpf(1.f + __expf(-x)); }

#define XB_TMO      128
#define XB_XCNT(j)  (256  + 64 * (j))
#define XB_XSUB(j)  (1280 + 64 * (j))
#define XB_XGEN(j)  (2304 + 64 * (j))
#define XB_TOP      3328
#define XB_TOPGEN   3392
#define XCD_BAR_WORDS 3456
#define XB_SPIN_CAP (1u << 21)
__device__ __forceinline__ unsigned xb_ld(unsigned* p)              { return __hip_atomic_load(p, __ATOMIC_RELAXED, __HIP_MEMORY_SCOPE_AGENT); }
__device__ __forceinline__ unsigned xb_add(unsigned* p, unsigned v) { return __hip_atomic_fetch_add(p, v, __ATOMIC_RELAXED, __HIP_MEMORY_SCOPE_AGENT); }
__device__ __forceinline__ unsigned xb_xcc_id() { return (unsigned)__builtin_amdgcn_s_getreg((3 << 11) | 20) & 0xFu; }
#define XB_SPIN(cond, bar) do { unsigned _sp = 0; while (cond) { __builtin_amdgcn_s_sleep(1); \
    if ((++_sp & 255u) == 0u) { if (xb_ld(&(bar)[XB_TMO])) break; if (_sp > XB_SPIN_CAP) { atomicAdd(&(bar)[XB_TMO], 1u); break; } } } } while (0)
struct XcdBarrier { unsigned* bar; unsigned x; volatile LAS unsigned* st; };
__device__ __forceinline__ XcdBarrier xcd_barrier_post(unsigned* bar, volatile LAS unsigned* st, int tid) {
    XcdBarrier b; b.bar = bar; b.x = xb_xcc_id(); b.st = st;
    if (tid == 0) (void)xb_add(&bar[XB_XCNT(b.x)], 1u);
    return b;
}
__device__ __forceinline__ void xcd_barrier_complete(unsigned* bar, unsigned x, unsigned& nloc, unsigned& nx) {
    const unsigned G = gridDim.x * gridDim.y * gridDim.z;
    unsigned sum, cnt, sp = 0u;
    for (;;) {
        sum = 0u; cnt = 0u;
#pragma unroll 1
        for (unsigned j = 0; j < 16; ++j) { const unsigned c = xb_ld(&bar[XB_XCNT(j)]); sum += c; cnt += (c > 0u) ? 1u : 0u; }
        if (sum == G) break;
        __builtin_amdgcn_s_sleep(1);
        if ((++sp & 255u) == 0u) { if (xb_ld(&bar[XB_TMO])) break; if (sp > XB_SPIN_CAP) { atomicAdd(&bar[XB_TMO], 1u); break; } }
    }
    const unsigned mine = xb_ld(&bar[XB_XCNT(x)]);
    nloc = mine > 0u ? mine : 1u; nx = cnt > 0u ? cnt : 1u;
}
__device__ __noinline__ void xcd_barrier(const XcdBarrier b, const int tid) {
    asm volatile("s_waitcnt vmcnt(0)" ::: "memory");
    __syncthreads();
    if (tid == 0) {
        unsigned* bar = b.bar;
        __builtin_amdgcn_s_waitcnt(0);
        unsigned nloc = b.st[0], nx = b.st[1];
        if (nloc == 0u) { xcd_barrier_complete(bar, b.x, nloc, nx); b.st[0] = nloc; b.st[1] = nx; }
        const unsigned old = xb_add(&bar[XB_XSUB(b.x)], 1u);
        const unsigned gen = old / nloc;
        if (old + 1u == (gen + 1u) * nloc) {
            __builtin_amdgcn_fence(__ATOMIC_RELEASE, "agent");
            asm volatile("s_waitcnt vmcnt(0)" ::: "memory");
            const unsigned og = xb_add(&bar[XB_TOP], 1u);
            const unsigned tg = og / nx;
            if (og + 1u == (tg + 1u) * nx) xb_add(&bar[XB_TOPGEN], 1u);
            else XB_SPIN(xb_ld(&bar[XB_TOPGEN]) == tg, bar);
            __builtin_amdgcn_fence(__ATOMIC_ACQUIRE, "agent");
            xb_add(&bar[XB_XGEN(b.x)], 1u);
            asm volatile("s_waitcnt vmcnt(0)" ::: "memory");
        } else {
            XB_SPIN(xb_ld(&bar[XB_XGEN(b.x)]) == gen, bar);
            __builtin_amdgcn_fence(__ATOMIC_ACQUIRE, "agent");
            asm volatile("s_waitcnt vmcnt(0)" ::: "memory");
        }
    }
    __syncthreads();
}

struct Args { const void* in[24]; float* out; unsigned char* ws; int ph_lo, ph_hi; };
struct Ctx {
    LAS unsigned char* lds;
    unsigned* ctl;
    int tid, lane, wave, bid, G;
    int chunk, layer, pass;
    const float* x_in; float* xo;
    const float* xinf; float* xof; bf16_t* actf;
    float* sa;
    float* sbr;
    float* smg;
    bf16_t* xb; bf16_t* x2;
    const int* pos;
    const unsigned char* lw;
    bf16_t *act, *proj, *hid, *ys;
    unsigned* rec; int* list; float* rsl;
};

template <class DMap>
__device__ __forceinline__ void tr_item64(const float* srcA, const float* srcB, int Nsrc, float scale, bf16_t* WT, int K, int n0, int k0, LAS float* scr, int lane, DMap dmap) {
    const int r4 = lane >> 4, c16 = lane & 15;
    const float* src = (c16 < 8 ? srcA + 4 * c16 : srcB + 4 * (c16 - 8));
    f32x4 v[16];
#pragma unroll
    for (int i = 0; i < 16; ++i) v[i] = *(const f32x4*)(src + (size_t)(k0 + 4 * i + r4) * Nsrc);
#pragma unroll
    for (int i = 0; i < 16; ++i) { LAS float* d = scr + (4 * i + r4) * 65 + 4 * c16; d[0] = v[i].x * scale; d[1] = v[i].y * scale; d[2] = v[i].z * scale; d[3] = v[i].w * scale; }
    LDS_WAIT(); asm volatile("" ::: "memory");
    const int kc = lane & 7;
#pragma unroll
    for (int j = 0; j < 8; ++j) { const int r = (lane >> 3) + 8 * j; const LAS float* q = scr + (8 * kc) * 65 + dmap(r);
        u32x4 o; o.x = pk2(q[0 * 65], q[1 * 65]); o.y = pk2(q[2 * 65], q[3 * 65]); o.z = pk2(q[4 * 65], q[5 * 65]); o.w = pk2(q[6 * 65], q[7 * 65]);
        *(u32x4*)(WT + (size_t)(n0 + r) * K + k0 + 8 * kc) = o; }
    LDS_WAIT(); asm volatile("" ::: "memory");
}
__device__ __forceinline__ float clamp448(float v) { return __builtin_fminf(__builtin_fmaxf(v, -448.f), 448.f); }
__device__ __forceinline__ unsigned pk4_fp8(float a, float b, float c_, float d) { int w = 0; w = __builtin_amdgcn_cvt_pk_fp8_f32(clamp448(a), clamp448(b), w, false); w = __builtin_amdgcn_cvt_pk_fp8_f32(clamp448(c_), clamp448(d), w, true); return (unsigned)w; }
template <class DMap>
__device__ __forceinline__ void tr_item64f8(const float* srcA, const float* srcB, int Nsrc, float scale, unsigned char* WT8, int K, int n0, int k0, LAS float* scr, int lane, DMap dmap) {
    const int r4 = lane >> 4, c16 = lane & 15;
    const float* src = (c16 < 8 ? srcA + 4 * c16 : srcB + 4 * (c16 - 8));
    f32x4 v[16];
#pragma unroll
    for (int i = 0; i < 16; ++i) v[i] = *(const f32x4*)(src + (size_t)(k0 + 4 * i + r4) * Nsrc);
#pragma unroll
    for (int i = 0; i < 16; ++i) { LAS float* d = scr + (4 * i + r4) * 65 + 4 * c16; d[0] = v[i].x * scale; d[1] = v[i].y * scale; d[2] = v[i].z * scale; d[3] = v[i].w * scale; }
    LDS_WAIT(); asm volatile("" ::: "memory");
    const int kc = lane & 7;
#pragma unroll
    for (int j = 0; j < 8; ++j) { const int r = (lane >> 3) + 8 * j; const LAS float* q = scr + (8 * kc) * 65 + dmap(r);
        u32x2 o; o.x = pk4_fp8(q[0 * 65], q[1 * 65], q[2 * 65], q[3 * 65]); o.y = pk4_fp8(q[4 * 65], q[5 * 65], q[6 * 65], q[7 * 65]);
        *(u32x2*)(WT8 + (size_t)(n0 + r) * K + k0 + 8 * kc) = o; }
    LDS_WAIT(); asm volatile("" ::: "memory");
}
struct DMapId { __device__ __forceinline__ int operator()(int r) const { return r; } };
struct DMapGU { __device__ __forceinline__ int operator()(int r) const { return ((r >> 4) & 1) * 32 + (r >> 5) * 16 + (r & 15); } };
template <class DMap>
__device__ __forceinline__ void tr_item64q(const float* srcA, const float* srcB, int Nsrc, float scale, signed char* WTq, int K, int n0, int k0, LAS float* scr, int lane, const unsigned* cmax, DMap dmap) {
    const int r4 = lane >> 4, c16 = lane & 15;
    const float* src = (c16 < 8 ? srcA + 4 * c16 : srcB + 4 * (c16 - 8));
    f32x4 v[16];
#pragma unroll
    for (int i = 0; i < 16; ++i) v[i] = *(const f32x4*)(src + (size_t)(k0 + 4 * i + r4) * Nsrc);
#pragma unroll
    for (int i = 0; i < 16; ++i) { LAS float* d = scr + (4 * i + r4) * 65 + 4 * c16; d[0] = v[i].x * scale; d[1] = v[i].y * scale; d[2] = v[i].z * scale; d[3] = v[i].w * scale; }
    LDS_WAIT(); asm volatile("" ::: "memory");
    const int kc = lane & 3;
#pragma unroll
    for (int j = 0; j < 4; ++j) { const int r = (lane >> 2) + 16 * j; const LAS float* q = scr + (16 * kc) * 65 + dmap(r);
        const float mx = __uint_as_float(cmax[n0 + r]); const float inv = mx > 0.f ? 127.f / mx : 0.f;
        unsigned w[4];
#pragma unroll
        for (int k = 0; k < 4; ++k) { const int q0 = (int)__builtin_rintf(q[(4 * k + 0) * 65] * inv), q1 = (int)__builtin_rintf(q[(4 * k + 1) * 65] * inv), q2 = (int)__builtin_rintf(q[(4 * k + 2) * 65] * inv), q3 = (int)__builtin_rintf(q[(4 * k + 3) * 65] * inv);
            w[k] = (unsigned)(q0 & 0xff) | ((unsigned)(q1 & 0xff) << 8) | ((unsigned)(q2 & 0xff) << 16) | ((unsigned)(q3 & 0xff) << 24); }
        u32x4 o; o.x = w[0]; o.y = w[1]; o.z = w[2]; o.w = w[3];
        *(u32x4*)(WTq + (size_t)(n0 + r) * K + k0 + 16 * kc) = o; }
    LDS_WAIT(); asm volatile("" ::: "memory");
}
__device__ __forceinline__ void cmax_item64(const float* srcA, int Nsrc, float scale, int n0, int k0, int lane, unsigned* cmax) {
    const int r4 = lane >> 4, c16 = lane & 15;
    const float* src = srcA + 4 * c16;
    f32x4 m = {0.f, 0.f, 0.f, 0.f};
#pragma unroll
    for (int i = 0; i < 16; ++i) { const f32x4 v = *(const f32x4*)(src + (size_t)(k0 + 4 * i + r4) * Nsrc);
        m.x = fmaxf(m.x, fabsf(v.x)); m.y = fmaxf(m.y, fabsf(v.y)); m.z = fmaxf(m.z, fabsf(v.z)); m.w = fmaxf(m.w, fabsf(v.w)); }
    m.x = fmaxf(m.x, swz_xor<16>(m.x)); m.y = fmaxf(m.y, swz_xor<16>(m.y)); m.z = fmaxf(m.z, swz_xor<16>(m.z)); m.w = fmaxf(m.w, swz_xor<16>(m.w));
    const float mv[4] = {m.x, m.y, m.z, m.w};
#pragma unroll
    for (int k = 0; k < 4; ++k) { const auto r = __builtin_amdgcn_permlane32_swap(__float_as_uint(mv[k]), __float_as_uint(mv[k]), false, false);
        const float t = fmaxf(__uint_as_float(r[0]), __uint_as_float(r[1])) * scale;
        if (lane < 16) atomicMax(cmax + n0 + 4 * c16 + k, __float_as_uint(t)); }
}
constexpr int IT_WIN = (NP / 64) * 16, IT_WBR = 3 * 16 * 8, IT_WOUT = 16 * 16, IT_WGU = NE * 16 * 16, IT_WDN = NE * 16 * 8, IT_LAYER = IT_WIN + IT_WBR + IT_WOUT + IT_WGU + IT_WDN;
__device__ __forceinline__ void cmax_item64gu(const float* src0, int Nsrc, int col0, int isup, int k0, int lane, unsigned* cmax) {
    const int r4 = lane >> 4, c16 = lane & 15;
    const float* src = src0 + col0 + 4 * c16;
    f32x4 m = {0.f, 0.f, 0.f, 0.f};
#pragma unroll
    for (int i = 0; i < 16; ++i) { const f32x4 v = *(const f32x4*)(src + (size_t)(k0 + 4 * i + r4) * Nsrc);
        m.x = fmaxf(m.x, fabsf(v.x)); m.y = fmaxf(m.y, fabsf(v.y)); m.z = fmaxf(m.z, fabsf(v.z)); m.w = fmaxf(m.w, fabsf(v.w)); }
    m.x = fmaxf(m.x, swz_xor<16>(m.x)); m.y = fmaxf(m.y, swz_xor<16>(m.y)); m.z = fmaxf(m.z, swz_xor<16>(m.z)); m.w = fmaxf(m.w, swz_xor<16>(m.w));
    const float mv[4] = {m.x, m.y, m.z, m.w};
#pragma unroll
    for (int k = 0; k < 4; ++k) { const auto r = __builtin_amdgcn_permlane32_swap(__float_as_uint(mv[k]), __float_as_uint(mv[k]), false, false);
        const float t = fmaxf(__uint_as_float(r[0]), __uint_as_float(r[1])); const int j = col0 + 4 * c16 + k;
        if (lane < 16) atomicMax(cmax + 32 * (j >> 4) + 16 * isup + (j & 15), __float_as_uint(t)); }
}
template <int NT, class DMap>
__device__ __forceinline__ void prep_fused_group(const float* srcA, const float* srcB, int Nsrc, float scale, signed char* WTq, int n0, unsigned* cmax_out, LAS unsigned char* lds, int wave, int lane, int tid, DMap dmap) {
    LAS float* scr = (LAS float*)(lds + wave * 17408);
    LAS float* smax = (LAS float*)(lds + 8 * 17408);
    LAS float* cm = smax + 512;
    const int r4 = lane >> 4, c16 = lane & 15;
    const float* src = (c16 < 8 ? srcA + 4 * c16 : srcB + 4 * (c16 - 8));
    f32x4 v[NT][16];
    { const float* pl = src + (size_t)(64 * NT * wave + r4) * Nsrc; const size_t st = (size_t)4 * Nsrc;
#pragma unroll
      for (int t = 0; t < NT; ++t)
#pragma unroll
          for (int i = 0; i < 16; ++i) { v[t][i] = *(const f32x4*)pl; pl += st; asm volatile("" : "+v"(pl)); } }
    f32x4 m = {0.f, 0.f, 0.f, 0.f};
#pragma unroll
    for (int t = 0; t < NT; ++t)
#pragma unroll
        for (int i = 0; i < 16; ++i) { m.x = fmaxf(m.x, fabsf(v[t][i].x)); m.y = fmaxf(m.y, fabsf(v[t][i].y)); m.z = fmaxf(m.z, fabsf(v[t][i].z)); m.w = fmaxf(m.w, fabsf(v[t][i].w)); }
    m.x = fmaxf(m.x, swz_xor<16>(m.x)); m.y = fmaxf(m.y, swz_xor<16>(m.y)); m.z = fmaxf(m.z, swz_xor<16>(m.z)); m.w = fmaxf(m.w, swz_xor<16>(m.w));
    { const float mv[4] = {m.x, m.y, m.z, m.w};
#pragma unroll
      for (int k = 0; k < 4; ++k) { const auto r = __builtin_amdgcn_permlane32_swap(__float_as_uint(mv[k]), __float_as_uint(mv[k]), false, false);
          const float tmx = fmaxf(__uint_as_float(r[0]), __uint_as_float(r[1])) * scale;
          if (lane < 16) smax[wave * 64 + 4 * c16 + k] = tmx; } }
    __syncthreads();
    if (tid < 64) { float t = 0.f;
#pragma unroll
        for (int w8 = 0; w8 < 8; ++w8) t = fmaxf(t, smax[w8 * 64 + tid]);
        cm[tid] = t; }
    __syncthreads();
    if (tid < 64) cmax_out[n0 + tid] = __float_as_uint(cm[dmap(tid)]);
#pragma unroll
    for (int t = 0; t < NT; ++t) { const int k0 = 64 * (NT * wave + t);
#pragma unroll
        for (int i = 0; i < 16; ++i) { LAS float* d = scr + (4 * i + r4) * 65 + 4 * c16; d[0] = v[t][i].x * scale; d[1] = v[t][i].y * scale; d[2] = v[t][i].z * scale; d[3] = v[t][i].w * scale; }
        LDS_WAIT(); asm volatile("" ::: "memory");
        const int kc = lane & 3;
#pragma unroll
        for (int j = 0; j < 4; ++j) { const int r = (lane >> 2) + 16 * j; const LAS float* q = scr + (16 * kc) * 65 + dmap(r);
            const float mx = cm[dmap(r)]; const float inv = mx > 0.f ? 127.f / mx : 0.f;
            unsigned w[4];
#pragma unroll
            for (int k = 0; k < 4; ++k) { const int q0 = (int)__builtin_rintf(q[(4 * k + 0) * 65] * inv), q1 = (int)__builtin_rintf(q[(4 * k + 1) * 65] * inv), q2 = (int)__builtin_rintf(q[(4 * k + 2) * 65] * inv), q3 = (int)__builtin_rintf(q[(4 * k + 3) * 65] * inv);
                w[k] = (unsigned)(q0 & 0xff) | ((unsigned)(q1 & 0xff) << 8) | ((unsigned)(q2 & 0xff) << 16) | ((unsigned)(q3 & 0xff) << 24); }
            u32x4 o; o.x = w[0]; o.y = w[1]; o.z = w[2]; o.w = w[3];
            *(u32x4*)(WTq + (size_t)(n0 + r) * (512 * NT) + k0 + 16 * kc) = o; }
        LDS_WAIT(); asm volatile("" ::: "memory"); }
    __syncthreads();
}
__device__ __forceinline__ void prep_folded_rows(const Args& a, int l, int j0, unsigned* cmaxb, int wave, int lane) {
    const int j = j0 + wave;
    const float* Wb = (const float*)a.in[3] + (size_t)l * D * WIN_N + 1536 + (size_t)(16 * lane) * WIN_N;
    const float* gu = (const float*)a.in[4] + (size_t)l * 16 * 256 + j;
    float g[16];
#pragma unroll
    for (int r = 0; r < 16; ++r) g[r] = gu[r * 256];
    float v[16]; float mx = 0.f;
#pragma unroll
    for (int i = 0; i < 16; ++i) { const float* wrow = Wb + (size_t)i * WIN_N;
        const f32x4 w0 = *(const f32x4*)wrow, w1 = *(const f32x4*)(wrow + 4), w2 = *(const f32x4*)(wrow + 8), w3 = *(const f32x4*)(wrow + 12);
        float s = 0.f;
        s += w0.x * g[0]; s += w0.y * g[1]; s += w0.z * g[2]; s += w0.w * g[3]; s += w1.x * g[4]; s += w1.y * g[5]; s += w1.z * g[6]; s += w1.w * g[7];
        s += w2.x * g[8]; s += w2.y * g[9]; s += w2.z * g[10]; s += w2.w * g[11]; s += w3.x * g[12]; s += w3.y * g[13]; s += w3.z * g[14]; s += w3.w * g[15];
        v[i] = s; mx = fmaxf(mx, fabsf(s)); }
    mx = wave_max(mx);
    if (lane == 0) cmaxb[(size_t)l * NP + C_GP + j] = __float_as_uint(mx);
    const float inv = mx > 0.f ? 127.f / mx : 0.f;
    unsigned w[4];
#pragma unroll
    for (int kk = 0; kk < 4; ++kk) { const int q0 = (int)__builtin_rintf(v[4 * kk] * inv), q1 = (int)__builtin_rintf(v[4 * kk + 1] * inv), q2 = (int)__builtin_rintf(v[4 * kk + 2] * inv), q3 = (int)__builtin_rintf(v[4 * kk + 3] * inv);
        w[kk] = (unsigned)(q0 & 0xff) | ((unsigned)(q1 & 0xff) << 8) | ((unsigned)(q2 & 0xff) << 16) | ((unsigned)(q3 & 0xff) << 24); }
    u32x4 o; o.x = w[0]; o.y = w[1]; o.z = w[2]; o.w = w[3];
    *(u32x4*)((signed char*)(a.ws + WS_W + (size_t)l * LW_SIZE + LW_WIN) + (size_t)(C_GP + j) * D + 16 * lane) = o;
}
__device__ __forceinline__ void phase_prep_fused(const Args& a, unsigned* cmaxb, LAS unsigned char* lds, int bid, int G, int wave, int lane, int tid) {
    constexpr int GW = NP / 64 - 4, GG = NE * 16, GO = 16, GB = 48, GL = GW + GG + GO + GB, NFUSED = DEPTH * GL, NFOLD = DEPTH * 32;
    for (int it = bid; it < NFUSED + NFOLD; it += G) {
        if (it >= NFUSED) { const int f = it - NFUSED; prep_folded_rows(a, f / 32, 8 * (f % 32), cmaxb, wave, lane); continue; }
        const int l = it / GL, r = it % GL;
        unsigned char* lw = a.ws + WS_W + (size_t)l * LW_SIZE;
        if (r < GW) { const int g = r < C_GP / 64 ? r : r + 4;
            const int n0 = 64 * g, src = n0 < C_GP ? n0 : n0 - 240;
            const float* W = (const float*)a.in[3] + (size_t)l * D * WIN_N + src;
            prep_fused_group<2>(W, W + 32, WIN_N, n0 < 256 ? 0.125f : 1.f, (signed char*)(lw + LW_WIN), n0, cmaxb + (size_t)l * NP, lds, wave, lane, tid, DMapId());
        } else if (r < GW + GG) { const int e = (r - GW) / 16, g = (r - GW) % 16;
            const float* Wg = (const float*)a.in[21] + ((size_t)l * NE + e) * D * FF + 32 * g;
            const float* Wu = (const float*)a.in[22] + ((size_t)l * NE + e) * D * FF + 32 * g;
            prep_fused_group<2>(Wg, Wu, FF, 1.f, (signed char*)(lw + LW_WGU) + (size_t)e * 1024 * D, 64 * g, cmaxb + (CW_CMAX2 - CW_CMAX) + ((size_t)l * NE + e) * 1024, lds, wave, lane, tid, DMapGU());
        } else if (r < GW + GG + GO) { const int g = r - GW - GG;
            const float* W = (const float*)a.in[17] + (size_t)l * D * D + 64 * g;
            prep_fused_group<2>(W, W + 32, D, 1.f, (signed char*)(lw + LW_WOUT), 64 * g, cmaxb + (CW_CMAX4 - CW_CMAX) + (size_t)l * 1024, lds, wave, lane, tid, DMapId());
        } else { const int rb = r - GW - GG - GO, b = rb / 16, g = rb % 16;
            const float* W = (const float*)a.in[16] + ((size_t)l * 3 + b) * 512 * D + 64 * g;
            prep_fused_group<1>(W, W + 32, D, 1.f, (signed char*)(lw + LW_WBR) + (size_t)b * D * 512, 64 * g, cmaxb + (CW_CMAX3 - CW_CMAX) + ((size_t)l * 3 + b) * 1024, lds, wave, lane, tid, DMapId());
        }
    }
}
__device__ __forceinline__ void phase_prep_a(const Args& a, float* tmpf, unsigned* cmaxb, int gw, int NGW, int lane, int gtid, int NGT) {
    for (int idx = gtid; idx < DEPTH * 256 * D; idx += NGT) {
        const int l = idx / (256 * D), j = (idx / D) % 256, k = idx % D;
        const float* W = (const float*)a.in[3] + (size_t)l * D * WIN_N + (size_t)k * WIN_N + 1536;
        const float* gu = (const float*)a.in[4] + (size_t)l * 16 * 256 + j;
        float s = 0.f;
#pragma unroll
        for (int r = 0; r < 16; ++r) s += W[r] * gu[r * 256];
        tmpf[idx] = s;
        float m = fabsf(s); m = wave_max(m);
        if (lane == 0) atomicMax(cmaxb + (size_t)l * NP + C_GP + j, __float_as_uint(m));
    }
}
__device__ __forceinline__ void phase_prep(const Args& a, const float* tmpf, const unsigned* cmaxb, LAS unsigned char* lds, int gw, int NGW, int wave, int lane, int gtid, int NGT) {
    LAS float* scr = (LAS float*)(lds + wave * 17408);
    for (int it = gw; it < DEPTH * IT_LAYER; it += NGW) {
        const int l = it / IT_LAYER; int r = it % IT_LAYER;
        unsigned char* lw = a.ws + WS_W + (size_t)l * LW_SIZE;
        if (r < IT_WIN) continue;
        r -= IT_WIN;
        if (r < IT_WBR) continue;
        r -= IT_WBR;
        if (r < IT_WOUT) continue;
        r -= IT_WOUT;
        if (r < IT_WGU) continue;
        r -= IT_WGU;
        {
            const int e = r / 128, g = (r % 128) / 8, kb = r % 8;
            const float* W = (const float*)a.in[23] + ((size_t)l * NE + e) * FF * D + 64 * g;
            tr_item64f8(W, W + 32, D, F8_WSCALE, (unsigned char*)(lw + LW_WDN) + (size_t)e * D * FF, FF, 64 * g, 64 * kb, scr, lane, DMapId());
        }
    }
}

__device__ __forceinline__ void moe_tables(const unsigned* cnt, LAS int* pt, LAS int* lc, int tid) {
    if (tid < NE) lc[tid] = (int)__hip_atomic_load(cnt + tid * CNT_PAD, __ATOMIC_RELAXED, __HIP_MEMORY_SCOPE_AGENT);
    __syncthreads();
    if (tid == 0) { int s = 0;
        for (int e = 0; e < NE; ++e) { pt[e] = s; s += (lc[e] + 255) >> 8; }
        pt[NE] = s; }
    __syncthreads();
}

template <bool COMBINE, bool NORM, bool SRC_BF16>
__device__ __forceinline__ void phase_norm1(const Ctx& c, const float* gain, LAS const int* pt) {
    const int gw = c.bid * NWAVES + c.wave, NGW = c.G * NWAVES, lane = c.lane;
    f32x4 g4[4];
    if (NORM) {
#pragma unroll
        for (int q = 0; q < 4; ++q) g4[q] = *((const f32x4*)gain + 2 * lane + 128 * (q >> 1) + (q & 1)); }
    constexpr int NR = 4;
    static_assert(TT % (NR * 2048) == 0, "rows per wave");
    for (int tok0 = gw; tok0 < TT; tok0 += NR * NGW) {
        f32x4 v[NR][4]; u32x4 xs[NR][2]; u32x4 ya[NR][2], yb[NR][2]; float w0[NR], w1[NR];
#pragma unroll
        for (int r = 0; r < NR; ++r) { const int tok = tok0 + r * NGW;
            if (SRC_BF16) { const u32x4* xr = (const u32x4*)(c.xb + (size_t)tok * D) + lane;
#pragma unroll
                for (int j = 0; j < 2; ++j) xs[r][j] = xr[64 * j]; }
            else { const f32x4* xr = (const f32x4*)(c.xinf + (size_t)tok * D) + 2 * lane;
#pragma unroll
                for (int q = 0; q < 4; ++q) v[r][q] = xr[128 * (q >> 1) + (q & 1)]; }
            if (COMBINE) {
                const u32x4 rc = *(const u32x4*)(c.rec + (size_t)tok * 4);
                const int e0 = rc.x >> 20, e1 = rc.y >> 20;
                const size_t r0 = (size_t)pt[e0] * 256 + (rc.x & 0xfffffu), r1 = (size_t)pt[e1] * 256 + (rc.y & 0xfffffu);
                w0[r] = __uint_as_float(rc.z); w1[r] = __uint_as_float(rc.w);
                const u32x4* y0 = (const u32x4*)(c.ys + r0 * D) + lane; const u32x4* y1 = (const u32x4*)(c.ys + r1 * D) + lane;
#pragma unroll
                for (int j = 0; j < 2; ++j) { ya[r][j] = y0[64 * j]; yb[r][j] = y1[64 * j]; }
            } }
#pragma unroll
        for (int r = 0; r < NR; ++r) { const int tok = tok0 + r * NGW;
            if (SRC_BF16) {
#pragma unroll
                for (int j = 0; j < 2; ++j) { const u32x4 w = xs[r][j];
                    v[r][2 * j].x = bflo(w.x); v[r][2 * j].y = bfhi(w.x); v[r][2 * j].z = bflo(w.y); v[r][2 * j].w = bfhi(w.y);
                    v[r][2 * j + 1].x = bflo(w.z); v[r][2 * j + 1].y = bfhi(w.z); v[r][2 * j + 1].z = bflo(w.w); v[r][2 * j + 1].w = bfhi(w.w); } }
            if (COMBINE) {
#pragma unroll
                for (int j = 0; j < 2; ++j) { const u32x4 a = ya[r][j], b = yb[r][j];
                    v[r][2 * j].x += w0[r] * bflo(a.x) + w1[r] * bflo(b.x); v[r][2 * j].y += w0[r] * bfhi(a.x) + w1[r] * bfhi(b.x);
                    v[r][2 * j].z += w0[r] * bflo(a.y) + w1[r] * bflo(b.y); v[r][2 * j].w += w0[r] * bfhi(a.y) + w1[r] * bfhi(b.y);
                    v[r][2 * j + 1].x += w0[r] * bflo(a.z) + w1[r] * bflo(b.z); v[r][2 * j + 1].y += w0[r] * bfhi(a.z) + w1[r] * bfhi(b.z);
                    v[r][2 * j + 1].z += w0[r] * bflo(a.w) + w1[r] * bflo(b.w); v[r][2 * j + 1].w += w0[r] * bfhi(a.w) + w1[r] * bfhi(b.w); }
                if (NORM) { u32x4* xw = (u32x4*)(c.x2 + (size_t)tok * D) + lane;
#pragma unroll
                    for (int j = 0; j < 2; ++j) { u32x4 w; w.x = pk2(v[r][2 * j].x, v[r][2 * j].y); w.y = pk2(v[r][2 * j].z, v[r][2 * j].w); w.z = pk2(v[r][2 * j + 1].x, v[r][2 * j + 1].y); w.w = pk2(v[r][2 * j + 1].z, v[r][2 * j + 1].w); xw[64 * j] = w; } }
                else { f32x4* xw = (f32x4*)(c.xof + (size_t)tok * D) + 2 * lane;
#pragma unroll
                    for (int q = 0; q < 4; ++q) __builtin_nontemporal_store(v[r][q], xw + 128 * (q >> 1) + (q & 1)); }
            }
            if (NORM) {
                float ss = 0.f;
#pragma unroll
                for (int j = 0; j < 4; ++j) ss += (v[r][j].x * v[r][j].x + v[r][j].y * v[r][j].y) + (v[r][j].z * v[r][j].z + v[r][j].w * v[r][j].w);
                const float rs = rsqf_(wave_sum(ss) * (1.f / D) + RMS_EPS);
                float am = 0.f;
#pragma unroll
                for (int j = 0; j < 4; ++j) { v[r][j] = v[r][j] * rs * g4[j]; am = fmaxf(am, fmaxf(fmaxf(fabsf(v[r][j].x), fabsf(v[r][j].y)), fmaxf(fabsf(v[r][j].z), fabsf(v[r][j].w)))); }
                am = wave_max(am);
                const float inv = am > 0.f ? 127.f / am : 0.f;
                if (lane == 0) c.sa[tok] = am * (1.f / 127.f);
                u32x2* o = (u32x2*)((signed char*)c.actf + ((size_t)(tok / TC) * TC * 2 + (size_t)(tok % TC)) * D) + lane;
#pragma unroll
                for (int j = 0; j < 2; ++j) { unsigned pk[2];
#pragma unroll
                    for (int hf = 0; hf < 2; ++hf) { const f32x4 t = v[r][2 * j + hf]; const int q0 = (int)__builtin_rintf(t.x * inv), q1 = (int)__builtin_rintf(t.y * inv), q2 = (int)__builtin_rintf(t.z * inv), q3 = (int)__builtin_rintf(t.w * inv);
                        pk[hf] = (unsigned)(q0 & 0xff) | ((unsigned)(q1 & 0xff) << 8) | ((unsigned)(q2 & 0xff) << 16) | ((unsigned)(q3 & 0xff) << 24); }
                    u32x2 w; w.x = pk[0]; w.y = pk[1]; o[64 * j] = w; }
            } }
    }
}

__constant__ double kInvFreq[16] = {1.0, 0.44036660267178046, 0.19392274474868576, 0.08539710028576561, 0.03760603093086393, 0.016560440080994446, 0.007292664737217109, 0.003211445994752591,
    0.001414213562373095, 0.000622772421914596, 0.0002742481756762073, 0.00012076973741146504, 5.318295896944988e-05, 2.341999896140934e-05, 1.031338537721246e-05, 4.5416704806078695e-06};
__device__ __forceinline__ void phase_prep_router(const Args& a, bf16_t* out, int gtid, int NGT) {
    for (int idx = gtid; idx < DEPTH * D * NE; idx += NGT) { const int l = idx / (D * NE), rem = idx % (D * NE), e = rem & 15, k = rem >> 4;
        const float v = ((const float*)a.in[19])[rem] * ((const float*)a.in[18])[l * D + k];
        const unsigned hi = f2bf(v); const float lo = v - bflo(hi);
        out[(size_t)l * 65536 + e * RW_STRIDE + k] = (bf16_t)hi; out[(size_t)l * 65536 + 16 * RW_STRIDE + e * RW_STRIDE + k] = (bf16_t)f2bf(lo); }
}
__device__ __forceinline__ void phase_rope_table(const int* pos, bf16_t* tab, int gtid, int NGT) {
    for (int idx = gtid; idx < BATCH * SEQ * 16; idx += NGT) { const int tok = idx >> 4, i = idx & 15;
        double a = (double)pos[tok] * kInvFreq[i] * 0.15915494309189535; a -= rint(a);
        tab[(size_t)tok * 32 + i] = (bf16_t)f2bf(__builtin_amdgcn_cosf((float)a)); tab[(size_t)tok * 32 + 16 + i] = (bf16_t)f2bf(__builtin_amdgcn_sinf((float)a)); }
}

__device__ __forceinline__ float logsigmoidf_(float g) { return fminf(g, 0.f) - log1pf(__expf(-fabsf(g))); }
__device__ __forceinline__ float gelu_tanh(float y) { const float u2 = 1.5957691216057308f * (y + 0.044715f * y * y * y); return y * __builtin_amdgcn_rcpf(1.f + __expf(-u2)); }


typedef unsigned short u16x4 __attribute__((ext_vector_type(4)));
__device__ __forceinline__ unsigned offb(unsigned row, unsigned ch) { return 256u * row + 16u * (ch ^ (((row & 3u) << 2) | ((row >> 2) & 3u))); }
constexpr int ATT_UNITS_PER_SEQ = 3 * 4 * 16;
struct AttU { int b, p, h, blk, dsh, it0; size_t tok0; int qcol, kcol, vcol; };
__device__ __forceinline__ AttU att_decode(int unit) {
    AttU a; a.b = unit / ATT_UNITS_PER_SEQ; const int rem = unit % ATT_UNITS_PER_SEQ; a.p = rem / 64; a.h = (rem / 16) & 3; const int qb = rem & 15;
    a.dsh = 2 * a.p; const int nblk = 16 >> a.dsh, r = qb / nblk; a.blk = qb % nblk; a.tok0 = (size_t)a.b * SEQ + r; a.it0 = a.blk == 0 ? 4 : 0;
    a.qcol = C_QKV + (a.p * 4 + a.h) * 128; a.kcol = C_QKV + (12 + a.p * 4 + a.h) * 128; a.vcol = C_QKV + (24 + a.p * 4 + a.h) * 128; return a;
}
#define ATT_DMA(U, col, dst) do { const unsigned _ch = ((unsigned)lane & 15u) ^ ((((unsigned)lane >> 4) << 2) | ((unsigned)w & 3u)); \
        const int _srow0 = ((U).blk - 1) * 128 + 4 * w + (lane >> 4); \
        const bf16_t* _p0 = c.proj + ((long)(U).tok0 + (long)_srow0 * (long)(1 << (U).dsh)) * NP + (col) + _ch * 8; const size_t _st = ((size_t)32 << (U).dsh) * NP; \
        _Pragma("unroll") for (int it = 0; it < 8; ++it) if (it >= (U).it0) \
            __builtin_amdgcn_global_load_lds((const unsigned*)(_p0 + it * _st), (LAS unsigned*)((dst) + 1024 * (w + 8 * it)), 16, 0, 0); } while (0)
#define ATT_LOADQ(U) do { const size_t qt = (U).tok0 + ((size_t)((U).blk * 128 + qi) << (U).dsh); \
        _Pragma("unroll") for (int s = 0; s < 4; ++s) qr[s] = *(const u32x4*)(c.proj + qt * NP + (U).qcol + 32 * s + 8 * g); \
        const u32x4* rt = (const u32x4*)(rope_tab + qt * 32 + 8 * (g & 1)); qcw = rt[0]; qsw = rt[2]; \
        int srow = ((U).blk - 1) * 128 + (int)rrow; if (srow < 0) srow += 128; \
        const bf16_t* rt2 = rope_tab + ((U).tok0 + ((size_t)srow << (U).dsh)) * 32 + 8 * rps; \
        rcw = *(const u32x4*)rt2; rsw = *(const u32x4*)(rt2 + 16); } while (0)
constexpr unsigned ATT_NUQ = (unsigned)(BC * ATT_UNITS_PER_SEQ) / 8u;
__device__ __forceinline__ unsigned att_qmap(unsigned q, unsigned raw) { return (q + 8u * (raw >> 4)) * 16u + (raw & 15u); }
__device__ __forceinline__ unsigned att_fetch_sync(unsigned* qheads, unsigned& q, int& qleft) {
    while (qleft > 0) { const unsigned raw = __hip_atomic_fetch_add(qheads + 64u * q, 1u, __ATOMIC_RELAXED, __HIP_MEMORY_SCOPE_AGENT);
        if (raw < ATT_NUQ) return att_qmap(q, raw);
        q = (q + 1u) & 7u; --qleft; }
    return 0xffffffffu;
}
__device__ __forceinline__ void attn_loop(const Ctx& c, unsigned* qhead, volatile LAS unsigned* mbox, float* lse_buf, const float* qgain, const float* kgain, const bf16_t* rope_tab  ) {
    const int tid = c.tid, lane = c.lane, w = c.wave;
    const unsigned NU = (unsigned)(BC * ATT_UNITS_PER_SEQ);
    LAS unsigned char* sK = c.lds; LAS unsigned char* sV = c.lds + 65536;
    LAS float* sRS = (LAS float*)(c.lds + MISC_OFF + 2048);
    const int qq = lane & 15, g = lane >> 4, qi = 16 * w + qq;
    const unsigned rrow = (unsigned)tid >> 1, rps = (unsigned)tid & 1u;
#if defined(PROBE_ATT) && PROBE_ATT
    unsigned long long _ta = __builtin_amdgcn_s_memrealtime();
#define ATT_STAMP(k) do { const unsigned long long _tb = __builtin_amdgcn_s_memrealtime(); if (blockIdx.x == PROBE_BLOCK && tid == 0) ((LAS unsigned*)(c.lds + MISC_OFF + 512))[(k)] += (unsigned)(_tb - _ta); _ta = _tb; } while (0)
#else
#define ATT_STAMP(k) do {} while (0)
#endif
    LAS float* sGQ = (LAS float*)(c.lds + MISC_OFF + 3072); LAS float* sGK = sGQ + 128;
    if (tid < 128) sGQ[tid] = qgain[tid]; else if (tid < 256) sGK[tid - 128] = kgain[tid - 128];
    unsigned qx = (unsigned)c.bid & 7u; int qleft = 8;
    if (tid == 0) { const unsigned u0 = att_fetch_sync(qhead, qx, qleft); mbox[0] = u0; mbox[1] = att_fetch_sync(qhead, qx, qleft); }
    __syncthreads();
    unsigned ucur = mbox[0], unxt = mbox[1];
    if (ucur >= NU) return;
    AttU U = att_decode((int)ucur);
    u32x4 qr[4]; u32x4 qcw, qsw, rcw, rsw;
    __syncthreads();
    ATT_DMA(U, U.kcol, sK); asm volatile("" ::: "memory");
    ATT_LOADQ(U); asm volatile("" ::: "memory");
    ATT_DMA(U, U.vcol, sV); asm volatile("" ::: "memory");
    bool first = true; unsigned nq = 0u;
    for (;;) {
        const int blk = U.blk, dsh = U.dsh, it0 = U.it0;
        const size_t qtok = U.tok0 + ((size_t)(blk * 128 + qi) << dsh);
        bf16x8 qf[4];
        {
            float qv[4][8]; float ss = 0.f;
#pragma unroll
            for (int s = 0; s < 4; ++s) { const unsigned wv[4] = {qr[s].x, qr[s].y, qr[s].z, qr[s].w};
#pragma unroll
                for (int k = 0; k < 4; ++k) { qv[s][2 * k] = bflo(wv[k]); qv[s][2 * k + 1] = bfhi(wv[k]); ss += qv[s][2 * k] * qv[s][2 * k] + qv[s][2 * k + 1] * qv[s][2 * k + 1]; } }
            ss += swz_xor<16>(ss);
            { const auto rr = __builtin_amdgcn_permlane32_swap(__float_as_uint(ss), __float_as_uint(ss), false, false); ss = __uint_as_float(rr[0]) + __uint_as_float(rr[1]); }
            const float rs = rsqf_(ss * (1.f / 128.f) + RMS_EPS);
#pragma unroll
            for (int s = 0; s < 4; ++s) { const f32x4 g0 = *(const LAS f32x4*)(sGQ + 32 * s + 8 * g), g1 = *(const LAS f32x4*)(sGQ + 32 * s + 8 * g + 4);
                const float gg[8] = {g0.x, g0.y, g0.z, g0.w, g1.x, g1.y, g1.z, g1.w};
#pragma unroll
                for (int j = 0; j < 8; ++j) qv[s][j] *= rs * gg[j]; }
            { const float cs8[8] = {bflo(qcw.x), bfhi(qcw.x), bflo(qcw.y), bfhi(qcw.y), bflo(qcw.z), bfhi(qcw.z), bflo(qcw.w), bfhi(qcw.w)}, sn8[8] = {bflo(qsw.x), bfhi(qsw.x), bflo(qsw.y), bfhi(qsw.y), bflo(qsw.z), bfhi(qsw.z), bflo(qsw.w), bfhi(qsw.w)};
              const float sgn = (g & 2) ? 1.f : -1.f;
#pragma unroll
              for (int j = 0; j < 8; ++j) { const auto rr = __builtin_amdgcn_permlane32_swap(__float_as_uint(qv[0][j]), __float_as_uint(qv[0][j]), false, false);
                  const float other = (g & 2) ? __uint_as_float(rr[0]) : __uint_as_float(rr[1]);
                  qv[0][j] = qv[0][j] * cs8[j] + sgn * other * sn8[j]; } }
#pragma unroll
            for (int s = 0; s < 4; ++s) { u32x4 pw; pw.x = pk2(qv[s][0], qv[s][1]); pw.y = pk2(qv[s][2], qv[s][3]); pw.z = pk2(qv[s][4], qv[s][5]); pw.w = pk2(qv[s][6], qv[s][7]); qf[s] = __builtin_bit_cast(bf16x8, pw); }
        }
        const u32x4 kcw = rcw, ksw = rsw;
        if (first) { if (it0) asm volatile("s_waitcnt vmcnt(4)" ::: "memory"); else asm volatile("s_waitcnt vmcnt(8)" ::: "memory"); }
        else       { if (it0) asm volatile("s_waitcnt vmcnt(9)" ::: "memory"); else asm volatile("s_waitcnt vmcnt(13)" ::: "memory"); }
        first = false;
        __syncthreads();
        if (tid == 0 && qleft > 0) nq = __hip_atomic_fetch_add(qhead + 64u * qx, 1u, __ATOMIC_RELAXED, __HIP_MEMORY_SCOPE_AGENT);
        ATT_STAMP(5);
        {
            const unsigned row = rrow, half = rps;
            const float cs_o[8] = {bflo(kcw.x), bfhi(kcw.x), bflo(kcw.y), bfhi(kcw.y), bflo(kcw.z), bfhi(kcw.z), bflo(kcw.w), bfhi(kcw.w)}, sn_o[8] = {bflo(ksw.x), bfhi(ksw.x), bflo(ksw.y), bfhi(ksw.y), bflo(ksw.z), bfhi(ksw.z), bflo(ksw.w), bfhi(ksw.w)};
            float cs_p[8], sn_p[8];
#pragma unroll
            for (int j = 0; j < 8; ++j) { cs_p[j] = __uint_as_float((unsigned)__builtin_amdgcn_update_dpp(0, (int)__float_as_uint(cs_o[j]), 0xB1, 0xf, 0xf, true));
                                          sn_p[j] = __uint_as_float((unsigned)__builtin_amdgcn_update_dpp(0, (int)__float_as_uint(sn_o[j]), 0xB1, 0xf, 0xf, true)); }
            if (blk > 0 || row >= 128u) {
                float ss = 0.f;
#pragma unroll
                for (int j = 0; j < 8; ++j) { const u32x4 kq = *(const LAS u32x4*)(sK + offb(row, 8u * half + j)); const unsigned wv[4] = {kq.x, kq.y, kq.z, kq.w};
#pragma unroll
                    for (int k = 0; k < 4; ++k) { const float a = bflo(wv[k]), b2 = bfhi(wv[k]); ss += a * a + b2 * b2; } }
                ss += __uint_as_float((unsigned)__builtin_amdgcn_update_dpp(0, (int)__float_as_uint(ss), 0xB1, 0xf, 0xf, true));
                const float rs = rsqf_(ss * (1.f / 128.f) + RMS_EPS);
#pragma unroll 1
                for (int j = half ? 0 : 4; j < 8; ++j) {
                    const f32x4 g0 = *(const LAS f32x4*)(sGK + 64 * half + 8 * j), g1 = *(const LAS f32x4*)(sGK + 64 * half + 8 * j + 4);
                    const u32x4 kq = *(const LAS u32x4*)(sK + offb(row, 8u * half + j));
                    u32x4 ko; ko.x = pk2(bflo(kq.x) * rs * g0.x, bfhi(kq.x) * rs * g0.y); ko.y = pk2(bflo(kq.y) * rs * g0.z, bfhi(kq.y) * rs * g0.w);
                    ko.z = pk2(bflo(kq.z) * rs * g1.x, bfhi(kq.z) * rs * g1.y); ko.w = pk2(bflo(kq.w) * rs * g1.z, bfhi(kq.w) * rs * g1.w);
                    *(LAS u32x4*)(sK + offb(row, 8u * half + j)) = ko; }
                if (half == 0u) {
#pragma unroll
                    for (int ps = 0; ps < 2; ++ps) {
                        const f32x4 ga0 = *(const LAS f32x4*)(sGK + 8 * ps), ga1 = *(const LAS f32x4*)(sGK + 8 * ps + 4), gb0 = *(const LAS f32x4*)(sGK + 16 + 8 * ps), gb1 = *(const LAS f32x4*)(sGK + 20 + 8 * ps);
                        const float ga[8] = {ga0.x, ga0.y, ga0.z, ga0.w, ga1.x, ga1.y, ga1.z, ga1.w}, gb[8] = {gb0.x, gb0.y, gb0.z, gb0.w, gb1.x, gb1.y, gb1.z, gb1.w};
                        const u32x4 ka_ = *(const LAS u32x4*)(sK + offb(row, (unsigned)ps)), kb_ = *(const LAS u32x4*)(sK + offb(row, (unsigned)ps + 2u));
                        const unsigned wa[4] = {ka_.x, ka_.y, ka_.z, ka_.w}, wb[4] = {kb_.x, kb_.y, kb_.z, kb_.w};
                        float o1[8], o2[8];
#pragma unroll
                        for (int k = 0; k < 4; ++k) {
#pragma unroll
                            for (int e = 0; e < 2; ++e) { const int j = 2 * k + e; const float x1 = (e ? bfhi(wa[k]) : bflo(wa[k])) * rs * ga[j], x2 = (e ? bfhi(wb[k]) : bflo(wb[k])) * rs * gb[j];
                                const float cj = ps ? cs_p[j] : cs_o[j], sj = ps ? sn_p[j] : sn_o[j];
                                o1[j] = x1 * cj - x2 * sj; o2[j] = x2 * cj + x1 * sj; } }
                        u32x4 w1, w2; w1.x = pk2(o1[0], o1[1]); w1.y = pk2(o1[2], o1[3]); w1.z = pk2(o1[4], o1[5]); w1.w = pk2(o1[6], o1[7]); w2.x = pk2(o2[0], o2[1]); w2.y = pk2(o2[2], o2[3]); w2.z = pk2(o2[4], o2[5]); w2.w = pk2(o2[6], o2[7]);
                        *(LAS u32x4*)(sK + offb(row, (unsigned)ps)) = w1; *(LAS u32x4*)(sK + offb(row, (unsigned)ps + 2u)) = w2; }
                }
            }
        }
        __syncthreads();
        ATT_STAMP(6);
        const int ks0 = w >> 1, nskip = blk == 0 ? 4 : 0;
        f32x4 st[5][2];
        const unsigned krow_l = 8u * (qq >> 2) + (qq & 3u);
        LAS unsigned char* ka[2][4];
#pragma unroll
        for (int T = 0; T < 2; ++T)
#pragma unroll
            for (int s = 0; s < 4; ++s) ka[T][s] = sK + offb(32u * ks0 + krow_l + 4u * T, 4 * s + g);
#pragma unroll
        for (int n = 0; n < 5; ++n)
#pragma unroll
            for (int T = 0; T < 2; ++T) { f32x4 a = {0.f, 0.f, 0.f, 0.f};
                if (ks0 + n >= nskip) {
#pragma unroll
                for (int s = 0; s < 4; ++s) { const bf16x8 kf = *(const LAS bf16x8*)(ka[T][s] + 8192 * n); a = __builtin_amdgcn_mfma_f32_16x16x32_bf16(kf, qf[s], a, 0, 0, 0); } }
                st[n][T] = a; }
        asm volatile("s_waitcnt vmcnt(0) lgkmcnt(0)" ::: "memory");
        if (tid == 0) { unsigned un = 0xffffffffu;
            if (qleft > 0) { if (nq < ATT_NUQ) un = att_qmap(qx, nq); else { qx = (qx + 1u) & 7u; --qleft; un = att_fetch_sync(qhead, qx, qleft); } }
            mbox[0] = un; }
        __syncthreads();
        const bool has_next = unxt < NU;
        AttU UN = att_decode(has_next ? (int)unxt : 0);
        if (has_next) { ATT_DMA(UN, UN.kcol, sK); asm volatile("" ::: "memory"); ATT_LOADQ(UN); }
        asm volatile("" ::: "memory");
        const float SC = 0.08838834764831845f * 1.4426950408889634f;
        float mx = -INFINITY;
#pragma unroll
        for (int n = 0; n < 5; ++n)
#pragma unroll
            for (int T = 0; T < 2; ++T)
#pragma unroll
                for (int i = 0; i < 4; ++i) { const int kj = 32 * (ks0 + n) + 8 * g + 4 * T + i;
                    bool ok = true;
                    if (n == 0) ok = kj >= qi;
                    if (n == 4) ok = kj <= qi + 128;
                    if (blk == 0) ok = ok && (kj >= 128);
                    const float v = ok ? st[n][T][i] : -INFINITY; st[n][T][i] = v; mx = fmaxf(mx, v); }
        mx = fmaxf(mx, swz_xor<16>(mx));
        { const auto rr = __builtin_amdgcn_permlane32_swap(__float_as_uint(mx), __float_as_uint(mx), false, false); mx = fmaxf(__uint_as_float(rr[0]), __uint_as_float(rr[1])); }
        float sum = 0.f; const float mxs = mx * SC;
#pragma unroll
        for (int n = 0; n < 5; ++n)
#pragma unroll
            for (int T = 0; T < 2; ++T)
#pragma unroll
                for (int i = 0; i < 4; ++i) { const float e = __builtin_amdgcn_exp2f(__builtin_fmaf(st[n][T][i], SC, -mxs)); st[n][T][i] = e; sum += e; }
        sum += swz_xor<16>(sum);
        { const auto rr = __builtin_amdgcn_permlane32_swap(__float_as_uint(sum), __float_as_uint(sum), false, false); sum = __uint_as_float(rr[0]) + __uint_as_float(rr[1]); }
        const float inv = rcpf_(sum);
        ATT_STAMP(7);
        f32x4 ot[8];
#pragma unroll
        for (int cc = 0; cc < 8; ++cc) ot[cc] = (f32x4){0.f, 0.f, 0.f, 0.f};
        const unsigned tq = (unsigned)qq >> 2, tp = (unsigned)qq & 3u;
        const unsigned vbase = (unsigned)(size_t)sV;
        unsigned va[2][8];
#pragma unroll
        for (int t = 0; t < 2; ++t)
#pragma unroll
            for (int cc = 0; cc < 8; ++cc) va[t][cc] = vbase + offb(32u * ks0 + 8u * g + 4u * t + tq, 2 * cc + (tp >> 1)) + 8u * (tp & 1u);
#pragma unroll
        for (int n = 0; n < 5; ++n) if (ks0 + n >= nskip) {
            u32x4 pw; pw.x = pk2(st[n][0][0], st[n][0][1]); pw.y = pk2(st[n][0][2], st[n][0][3]); pw.z = pk2(st[n][1][0], st[n][1][1]); pw.w = pk2(st[n][1][2], st[n][1][3]);
            const bf16x8 pf = __builtin_bit_cast(bf16x8, pw);
            u16x4 v0[8], v1[8];
            asm volatile("ds_read_b64_tr_b16 %0, %16 offset:%32\n\tds_read_b64_tr_b16 %8, %24 offset:%32\n\t"
                         "ds_read_b64_tr_b16 %1, %17 offset:%32\n\tds_read_b64_tr_b16 %9, %25 offset:%32\n\t"
                         "ds_read_b64_tr_b16 %2, %18 offset:%32\n\tds_read_b64_tr_b16 %10, %26 offset:%32\n\t"
                         "ds_read_b64_tr_b16 %3, %19 offset:%32\n\tds_read_b64_tr_b16 %11, %27 offset:%32\n\t"
                         "ds_read_b64_tr_b16 %4, %20 offset:%32\n\tds_read_b64_tr_b16 %12, %28 offset:%32\n\t"
                         "ds_read_b64_tr_b16 %5, %21 offset:%32\n\tds_read_b64_tr_b16 %13, %29 offset:%32\n\t"
                         "ds_read_b64_tr_b16 %6, %22 offset:%32\n\tds_read_b64_tr_b16 %14, %30 offset:%32\n\t"
                         "ds_read_b64_tr_b16 %7, %23 offset:%32\n\tds_read_b64_tr_b16 %15, %31 offset:%32\n\t"
                         "s_waitcnt lgkmcnt(0)"
                         : "=&v"(v0[0]), "=&v"(v0[1]), "=&v"(v0[2]), "=&v"(v0[3]), "=&v"(v0[4]), "=&v"(v0[5]), "=&v"(v0[6]), "=&v"(v0[7]),
                           "=&v"(v1[0]), "=&v"(v1[1]), "=&v"(v1[2]), "=&v"(v1[3]), "=&v"(v1[4]), "=&v"(v1[5]), "=&v"(v1[6]), "=&v"(v1[7])
                         : "v"(va[0][0]), "v"(va[0][1]), "v"(va[0][2]), "v"(va[0][3]), "v"(va[0][4]), "v"(va[0][5]), "v"(va[0][6]), "v"(va[0][7]),
                           "v"(va[1][0]), "v"(va[1][1]), "v"(va[1][2]), "v"(va[1][3]), "v"(va[1][4]), "v"(va[1][5]), "v"(va[1][6]), "v"(va[1][7]), "i"(8192 * n) : "memory");
#pragma unroll
            for (int cc = 0; cc < 8; ++cc) {
                bf16x8 vf; vf[0] = (short)v0[cc][0]; vf[1] = (short)v0[cc][1]; vf[2] = (short)v0[cc][2]; vf[3] = (short)v0[cc][3]; vf[4] = (short)v1[cc][0]; vf[5] = (short)v1[cc][1]; vf[6] = (short)v1[cc][2]; vf[7] = (short)v1[cc][3];
                ot[cc] = __builtin_amdgcn_mfma_f32_16x16x32_bf16(vf, pf, ot[cc], 0, 0, 0);
            }
        }
        bf16_t* orow = c.proj + qtok * NP + U.qcol;
#pragma unroll
        for (int cc = 0; cc < 8; cc += 2) { u32x2 a, b; a.x = pk2(ot[cc][0] * inv, ot[cc][1] * inv); a.y = pk2(ot[cc][2] * inv, ot[cc][3] * inv); b.x = pk2(ot[cc + 1][0] * inv, ot[cc + 1][1] * inv); b.y = pk2(ot[cc + 1][2] * inv, ot[cc + 1][3] * inv);
            { const auto r = __builtin_amdgcn_permlane16_swap(a.x, b.x, false, false); a.x = r[0]; b.x = r[1]; }
            { const auto r = __builtin_amdgcn_permlane16_swap(a.y, b.y, false, false); a.y = r[0]; b.y = r[1]; }
            u32x4 wv; wv.x = a.x; wv.y = a.y; wv.z = b.x; wv.w = b.y;
            *(u32x4*)(orow + ((g & 1) ? 16 * (cc + 1) + 4 * (g - 1) : 16 * cc + 4 * g)) = wv; }
        if (g == 0) lse_buf[qtok * 12 + U.p * 4 + U.h] = mx * 0.08838834764831845f + __logf(sum);
        asm volatile("" ::: "memory");
        __syncthreads();
        asm volatile("" ::: "memory");
        if (has_next) ATT_DMA(UN, UN.vcol, sV);
        asm volatile("" ::: "memory");
        ATT_STAMP(8);
        if (!has_next) break;
        U = UN; unxt = mbox[0];
    }
    asm volatile("s_waitcnt vmcnt(0)" ::: "memory");
    __syncthreads();
}
#undef ATT_STAMP
#undef ATT_DMA
#undef ATT_LOADQ

__device__ __forceinline__ u32x2 q8i8(const float (&v)[8], float inv) { unsigned o[2];
#pragma unroll
    for (int k = 0; k < 2; ++k) { const int i0 = (int)__builtin_rintf(v[4 * k] * inv), i1 = (int)__builtin_rintf(v[4 * k + 1] * inv), i2 = (int)__builtin_rintf(v[4 * k + 2] * inv), i3 = (int)__builtin_rintf(v[4 * k + 3] * inv);
        o[k] = (unsigned)(i0 & 0xff) | ((unsigned)(i1 & 0xff) << 8) | ((unsigned)(i2 & 0xff) << 16) | ((unsigned)(i3 & 0xff) << 24); }
    u32x2 r; r.x = o[0]; r.y = o[1]; return r; }
__device__ __forceinline__ void unpack8(const u32x4 w, float (&v)[8]) { v[0] = bflo(w.x); v[1] = bfhi(w.x); v[2] = bflo(w.y); v[3] = bfhi(w.y); v[4] = bflo(w.z); v[5] = bfhi(w.z); v[6] = bflo(w.w); v[7] = bfhi(w.w); }
__device__ __forceinline__ void phase_attn_combine(const Ctx& c, const float* lse_buf) {
    const int lane = c.lane, hd = lane >> 4;
    constexpr int NR = 4;
    const int tbeg = c.bid * 128 + c.wave * 16;
#pragma unroll 1
    for (int tok0 = tbeg; tok0 < tbeg + 16; tok0 += NR) {
        u32x4 u[NR][3], ua[NR], ub[NR]; float l[NR][3];
#pragma unroll
        for (int r = 0; r < NR; ++r) { const int tok = tok0 + r;
            const float* ls = lse_buf + (size_t)tok * 12 + hd; const bf16_t* prow = c.proj + (size_t)tok * NP + 8 * lane;
#pragma unroll
            for (int p = 0; p < 3; ++p) { l[r][p] = ls[4 * p]; u[r][p] = *(const u32x4*)(prow + C_QKV + p * 512); }
            ua[r] = *(const u32x4*)(prow + C_OG); ub[r] = *(const u32x4*)(prow + C_YB); }
#pragma unroll
        for (int r = 0; r < NR; ++r) { const int tok = tok0 + r;
            const float ml = fmaxf(l[r][0], fmaxf(l[r][1], l[r][2]));
            const float w0 = __expf(l[r][0] - ml), w1 = __expf(l[r][1] - ml), w2 = __expf(l[r][2] - ml), wi = rcpf_(w0 + w1 + w2);
            float x0[8], x1[8], x2[8], va[8], vb[8], vc[8]; unpack8(u[r][0], x0); unpack8(u[r][1], x1); unpack8(u[r][2], x2); unpack8(ua[r], va); unpack8(ub[r], vb);
            float mc = 0.f, ma = 0.f, mb = 0.f;
#pragma unroll
            for (int i = 0; i < 8; ++i) { vc[i] = (w0 * x0[i] + w1 * x1[i] + w2 * x2[i]) * wi; mc = fmaxf(mc, fabsf(vc[i])); ma = fmaxf(ma, fabsf(va[i])); mb = fmaxf(mb, fabsf(vb[i])); }
            ma = wave_max(ma); mb = wave_max(mb); mc = wave_max(mc);
            const float ia = ma > 0.f ? 127.f / ma : 0.f, ib = mb > 0.f ? 127.f / mb : 0.f, ic = mc > 0.f ? 127.f / mc : 0.f;
            if (lane == 0) { c.sbr[tok] = ma * (1.f / 127.f); c.sbr[TC + tok] = mb * (1.f / 127.f); c.sbr[2 * TC + tok] = mc * (1.f / 127.f); }
            unsigned char* prow = (unsigned char*)(c.proj + (size_t)tok * NP) + 8 * lane;
            *(u32x2*)(prow + C_OG * 2) = q8i8(va, ia); *(u32x2*)(prow + C_YB * 2) = q8i8(vb, ib); *(u32x2*)(prow + C_QKV * 2) = q8i8(vc, ic); }
    }
}

__device__ __forceinline__ int crow(int reg, int hh) { return (reg & 3) + 8 * (reg >> 2) + 4 * hh; }
typedef float f32x16 __attribute__((ext_vector_type(16)));
__device__ __forceinline__ unsigned tr_addr32(unsigned lane, unsigned rowbase, unsigned cblk, unsigned t, bool perm) {
    const unsigned hh = lane >> 5, blk = (lane >> 4) & 1u, q = (lane & 15u) >> 2, p = lane & 3u;
    const unsigned row = rowbase + (perm ? 8u * t + 4u * hh : 8u * hh + 4u * t) + q;
    return offb(row, 4u * cblk + 2u * blk + (p >> 1)) + 8u * (p & 1u);
}
__device__ __forceinline__ bf16x8 tr_frag(unsigned a0, unsigned a1) {
    u16x4 v0, v1;
    asm volatile("ds_read_b64_tr_b16 %0, %2\n\tds_read_b64_tr_b16 %1, %3\n\ts_waitcnt lgkmcnt(0)" : "=&v"(v0), "=&v"(v1) : "v"(a0), "v"(a1) : "memory");
    bf16x8 f; f[0] = (short)v0[0]; f[1] = (short)v0[1]; f[2] = (short)v0[2]; f[3] = (short)v0[3]; f[4] = (short)v1[0]; f[5] = (short)v1[1]; f[6] = (short)v1[2]; f[7] = (short)v1[3];
    return f;
}
__device__ __forceinline__ void tr_frag4(const unsigned (&a)[8], bf16x8 (&f)[4]) {
    u16x4 v[8];
    asm volatile("ds_read_b64_tr_b16 %0, %8\n\tds_read_b64_tr_b16 %1, %9\n\tds_read_b64_tr_b16 %2, %10\n\tds_read_b64_tr_b16 %3, %11\n\t"
                 "ds_read_b64_tr_b16 %4, %12\n\tds_read_b64_tr_b16 %5, %13\n\tds_read_b64_tr_b16 %6, %14\n\tds_read_b64_tr_b16 %7, %15\n\ts_waitcnt lgkmcnt(0)"
                 : "=&v"(v[0]), "=&v"(v[1]), "=&v"(v[2]), "=&v"(v[3]), "=&v"(v[4]), "=&v"(v[5]), "=&v"(v[6]), "=&v"(v[7])
                 : "v"(a[0]), "v"(a[1]), "v"(a[2]), "v"(a[3]), "v"(a[4]), "v"(a[5]), "v"(a[6]), "v"(a[7]) : "memory");
#pragma unroll
    for (int k = 0; k < 4; ++k) { f[k][0] = (short)v[2 * k][0]; f[k][1] = (short)v[2 * k][1]; f[k][2] = (short)v[2 * k][2]; f[k][3] = (short)v[2 * k][3];
        f[k][4] = (short)v[2 * k + 1][0]; f[k][5] = (short)v[2 * k + 1][1]; f[k][6] = (short)v[2 * k + 1][2]; f[k][7] = (short)v[2 * k + 1][3]; }
}
constexpr int GLA_QK = 0, GLA_KD = 16384, GLA_V = 32768  , GLA_ST = 65536  , GLA_O = 102400  , GLA_SEG = 136192  , GLA_DEC = 138240  ;
static_assert(GLA_DEC + 256 <= RING_BYTES, "gla lds");
__device__ __forceinline__ void gla_unit(const Ctx& c, int unit, const float* gbias, const float* ogain) {
    const int tid = c.tid, lane = c.lane, w = c.wave;
    const int b = unit >> 2, h = unit & 3;
    LAS unsigned char* L = c.lds;
    const unsigned hh = lane >> 5, r31 = lane & 31;
    const int ti = w >> 2, tv = w & 3;
    f32x16 St;
#pragma unroll
    for (int i = 0; i < 16; ++i) St[i] = 0.f;
    for (int i = tid; i < 18432 / 4; i += NTHR) ((LAS unsigned*)(L + GLA_ST))[i] = 0u;
    const float bias_d = gbias[h * 64 + lane];
    const int i3 = tid >> 3, seg = tid & 7;
    float gn[16];
#pragma unroll
    for (int k = 0; k < 16; ++k) gn[k] = ogain[16 * seg + k];
    const size_t tokb = (size_t)b * SEQ;
    unsigned short pq[8], pk[8], pg[8];
    u32x4 ogc0, ogc1, ogn0, ogn1;
#define GLA_PREFETCH(n) do { _Pragma("unroll") for (int rr = 0; rr < 8; ++rr) { const bf16_t* row = c.proj + (tokb + (n) * 64 + 8 * w + rr) * NP + h * 64 + lane; \
        pq[rr] = row[C_QA]; pk[rr] = row[C_KA]; pg[rr] = row[C_GP]; } } while (0)
#define GLA_OG(n, d0, d1) do { const bf16_t* ogp = c.proj + (tokb + (n) * 64 + i3) * NP + C_OG + h * 128 + 16 * seg; d0 = *(const u32x4*)ogp; d1 = *((const u32x4*)ogp + 1); } while (0)
#define GLA_VDMA(n) do { _Pragma("unroll") for (int it = 0; it < 2; ++it) { const int q = w + 8 * it; const unsigned nn = 64u * q + lane, row = nn >> 4, cs = nn & 15u, ch = cs ^ (((row & 3u) << 2) | ((row >> 2) & 3u)); \
        __builtin_amdgcn_global_load_lds((const unsigned*)(c.proj + (tokb + (n) * 64 + row) * NP + C_VA + h * 128 + ch * 8), (LAS unsigned*)(L + GLA_V + ((n) & 1) * 16384 + 1024 * q), 16, 0, 0); } } while (0)
#define CB() asm volatile("" ::: "memory")
    GLA_PREFETCH(0); CB(); GLA_OG(0, ogc0, ogc1); CB(); GLA_VDMA(0); CB(); GLA_VDMA(1); CB();
    for (int n = 0; n < SEQ / 64; ++n) {
        LAS unsigned char* STr = L + GLA_ST + (n & 1) * 18432; LAS unsigned char* STw = L + GLA_ST + ((n + 1) & 1) * 18432;
        LAS unsigned char* Vb = L + GLA_V + (n & 1) * 16384;
        float cl[8], qv[8], kv[8];
        { float run = 0.f;
#pragma unroll
          for (int rr = 0; rr < 8; ++rr) { const float g = bf2f(pg[rr]) + bias_d; run += (fminf(g, 0.f) - __logf(1.f + __expf(-fabsf(g)))) * (1.f / 16.f); cl[rr] = run; qv[rr] = bf2f(pq[rr]); kv[rr] = bf2f(pk[rr]); }
          ((LAS float*)(L + GLA_SEG))[w * 64 + lane] = run; }
        __syncthreads();
        { float pre = 0.f, tot = 0.f;
#pragma unroll
          for (int s = 0; s < 8; ++s) { const float v = ((LAS float*)(L + GLA_SEG))[s * 64 + lane]; tot += v; pre += (s < w) ? v : 0.f; }
          const float etot = __expf(tot);
          if (w == 0) ((LAS float*)(L + GLA_DEC))[lane] = etot;
#pragma unroll
          for (int rr = 0; rr < 8; ++rr) { const float cum = pre + cl[rr]; const unsigned row = 8 * w + rr;
              const float e = __expf(cum), ei = rcpf_(e), ed = etot * ei;
              const unsigned o1 = offb(row, lane >> 3) + (lane & 7) * 2, o2 = offb(row, 8 + (lane >> 3)) + (lane & 7) * 2;
              *(LAS unsigned short*)(L + GLA_QK + o1) = (unsigned short)f2bf(qv[rr] * e);
              *(LAS unsigned short*)(L + GLA_QK + o2) = (unsigned short)f2bf(kv[rr] * ei);
              *(LAS unsigned short*)(L + GLA_KD + o1) = (unsigned short)f2bf(kv[rr] * ed); } }
        if (n == 0) asm volatile("s_waitcnt vmcnt(2)" ::: "memory"); else asm volatile("s_waitcnt vmcnt(4)" ::: "memory");
        __syncthreads();
        CB();
        if (n + 1 < SEQ / 64) { GLA_OG(n + 1, ogn0, ogn1); CB(); GLA_PREFETCH(n + 1); }
        CB();
        bf16x8 qdf[4];
#pragma unroll
        for (int s = 0; s < 4; ++s) qdf[s] = *(const LAS bf16x8*)(L + GLA_QK + offb(32 * ti + r31, 2 * s + hh));
        f32x16 Z;
#pragma unroll
        for (int i = 0; i < 16; ++i) Z[i] = 0.f;
        { bf16x8 sf[4];
#pragma unroll
          for (int s = 0; s < 4; ++s) sf[s] = *(const LAS bf16x8*)(STr + (32 * tv + r31) * 144 + 32 * s + 16 * hh);
#pragma unroll
          for (int s = 0; s < 4; ++s) Z = __builtin_amdgcn_mfma_f32_32x32x16_bf16(qdf[s], sf[s], Z, 0, 0, 0); }
        const unsigned vb = (unsigned)(size_t)Vb;
#pragma unroll
        for (int tj = 0; tj < 2; ++tj) {
            if (tj <= ti) {
                bf16x8 kf[4];
#pragma unroll
                for (int s = 0; s < 4; ++s) kf[s] = *(const LAS bf16x8*)(L + GLA_QK + offb(32 * tj + r31, 8 + 2 * s + hh));
                unsigned va[8]; bf16x8 vf[4];
#pragma unroll
                for (int s = 0; s < 2; ++s) { va[2 * s] = vb + tr_addr32(lane, 32 * tj + 16 * s, tv, 0, true); va[2 * s + 1] = vb + tr_addr32(lane, 32 * tj + 16 * s, tv, 1, true);
                    va[4 + 2 * s] = va[2 * s]; va[5 + 2 * s] = va[2 * s + 1]; }
                tr_frag4(va, vf);
                f32x16 X;
#pragma unroll
                for (int i = 0; i < 16; ++i) X[i] = 0.f;
#pragma unroll
                for (int s = 0; s < 4; ++s) X = __builtin_amdgcn_mfma_f32_32x32x16_bf16(kf[s], qdf[s], X, 0, 0, 0);
                const int ig = 32 * ti + (int)r31;
#pragma unroll
                for (int i = 0; i < 16; ++i) X[i] = (ig >= 32 * tj + crow(i, hh)) ? X[i] : 0.f;
#pragma unroll
                for (int s = 0; s < 2; ++s) {
                    u32x4 pw; pw.x = pg8::cvt_pk_bf16(X[8 * s + 0], X[8 * s + 1]); pw.y = pg8::cvt_pk_bf16(X[8 * s + 2], X[8 * s + 3]); pw.z = pg8::cvt_pk_bf16(X[8 * s + 4], X[8 * s + 5]); pw.w = pg8::cvt_pk_bf16(X[8 * s + 6], X[8 * s + 7]);
                    Z = __builtin_amdgcn_mfma_f32_32x32x16_bf16(__builtin_bit_cast(bf16x8, pw), vf[s], Z, 0, 0, 0);
                }
            }
        }
#pragma unroll
        for (int i = 0; i < 16; ++i) ((LAS float*)(L + GLA_O))[(32 * ti + crow(i, hh)) * 132 + 32 * tv + r31] = Z[i];
        { const unsigned kb = (unsigned)(size_t)(L + GLA_KD);
          unsigned aa[8], ab[8]; bf16x8 af[4], bfr[4];
#pragma unroll
          for (int s = 0; s < 4; ++s) { aa[2 * s] = kb + tr_addr32(lane, 16 * s, ti, 0, false); aa[2 * s + 1] = kb + tr_addr32(lane, 16 * s, ti, 1, false);
              ab[2 * s] = vb + tr_addr32(lane, 16 * s, tv, 0, false); ab[2 * s + 1] = vb + tr_addr32(lane, 16 * s, tv, 1, false); }
          tr_frag4(aa, af); tr_frag4(ab, bfr);
#pragma unroll
          for (int i = 0; i < 16; ++i) St[i] *= ((LAS float*)(L + GLA_DEC))[32 * ti + crow(i, hh)];
#pragma unroll
          for (int s = 0; s < 4; ++s) St = __builtin_amdgcn_mfma_f32_32x32x16_bf16(af[s], bfr[s], St, 0, 0, 0); }
#pragma unroll
        for (int gq = 0; gq < 4; ++gq) { const float s0 = St[4 * gq], s1 = St[4 * gq + 1], s2 = St[4 * gq + 2], s3 = St[4 * gq + 3];
            u32x2 o; o.x = pk2(s0, s1); o.y = pk2(s2, s3);
            *(LAS u32x2*)(STw + (32 * tv + r31) * 144 + (32 * ti + 8 * gq + 4 * hh) * 2) = o; }
        __syncthreads();
        CB();
        if (n + 2 < SEQ / 64) GLA_VDMA(n + 2);
        CB();
        { const LAS f32x4* op = (const LAS f32x4*)(L + GLA_O + i3 * 528 + seg * 64);
          f32x4 o4[4]; float ss = 0.f;
#pragma unroll
          for (int k = 0; k < 4; ++k) { o4[k] = op[k]; ss += (o4[k].x * o4[k].x + o4[k].y * o4[k].y) + (o4[k].z * o4[k].z + o4[k].w * o4[k].w); }
          ss += swz_xor<1>(ss); ss += swz_xor<2>(ss); ss += swz_xor<4>(ss);
          const float rs = rsqf_(ss * (1.f / 128.f) + RMS_EPS);
          const unsigned ogw[8] = {ogc0.x, ogc0.y, ogc0.z, ogc0.w, ogc1.x, ogc1.y, ogc1.z, ogc1.w};
          unsigned ow[8];
#pragma unroll
          for (int k = 0; k < 8; ++k) { const float g0 = bflo(ogw[k]), g1 = bfhi(ogw[k]);
              const float a0 = o4[k >> 1][(2 * k) & 3] * rs * gn[2 * k] * g0 * sigmoidf_(g0), a1 = o4[k >> 1][(2 * k + 1) & 3] * rs * gn[2 * k + 1] * g1 * sigmoidf_(g1);
              ow[k] = pk2(a0, a1); }
          u32x4 w0, w1; w0.x = ow[0]; w0.y = ow[1]; w0.z = ow[2]; w0.w = ow[3]; w1.x = ow[4]; w1.y = ow[5]; w1.z = ow[6]; w1.w = ow[7];
          bf16_t* dst = c.proj + (tokb + n * 64 + i3) * NP + C_OG + h * 128 + 16 * seg;
          *(u32x4*)dst = w0; *((u32x4*)dst + 1) = w1; }
        CB();
        ogc0 = ogn0; ogc1 = ogn1;
    }
    asm volatile("s_waitcnt vmcnt(0)" ::: "memory");
    __syncthreads();
#undef GLA_PREFETCH
#undef GLA_OG
#undef GLA_VDMA
#undef CB
}

constexpr int LRU_T = 128, LRU_RW = 16;
constexpr int LRU_X = 0  , LRU_R = 32768  , LRU_I = 65536, LRU_SP = 98304  , LRU_SH = 100352;
static_assert(LRU_SH + 2048 <= RING_BYTES, "lru lds");
__device__ __forceinline__ void lru_unit(const Ctx& c, int unit, const float* convw, const float* convb, const float* wa_, const float* ba_, const float* wx_, const float* bx_, const float* lam_) {
    const int lane = c.lane, w = c.wave;
    const int b = unit >> 3, nb = unit & 7, ch = nb * 64 + lane;
    LAS unsigned char* L = c.lds;
    const unsigned hh = lane >> 5, r31 = lane & 31;
    const int gate = w >> 2, tt = (w >> 1) & 1, td = w & 1;
    bf16x8 wf[4];
    { const float* W = (gate ? wx_ : wa_) + (size_t)nb * 4096 + 32 * td + r31;
#pragma unroll
      for (int s = 0; s < 4; ++s) { float t8[8];
#pragma unroll
          for (int jj = 0; jj < 8; ++jj) t8[jj] = W[(16 * s + 8 * hh + jj) * 64];
          u32x4 pw; pw.x = pk2(t8[0], t8[1]); pw.y = pk2(t8[2], t8[3]); pw.z = pk2(t8[4], t8[5]); pw.w = pk2(t8[6], t8[7]); wf[s] = __builtin_bit_cast(bf16x8, pw); } }
    const float gbias = (gate ? bx_ : ba_)[nb * 64 + 32 * td + r31];
    const float cw0 = convw[ch], cw1 = convw[512 + ch], cw2 = convw[1024 + ch], cw3 = convw[1536 + ch], cb = convb[ch];
    const float lam = lam_[ch]; const float c8 = 8.f * (fmaxf(-lam, 0.f) + log1pf(__expf(-fabsf(lam))));
    const size_t tokb = (size_t)b * SEQ;
    unsigned short px[LRU_RW + 3], py[LRU_RW];
#define LRU_PREFETCH(n) do { _Pragma("unroll") for (int rr = 0; rr < LRU_RW + 3; ++rr) { const int t = (n) * LRU_T + LRU_RW * w + rr - 3; px[rr] = t >= 0 ? c.proj[(tokb + t) * NP + C_XB + ch] : (unsigned short)0; } \
        _Pragma("unroll") for (int rr = 0; rr < LRU_RW; ++rr) py[rr] = c.proj[(tokb + (n) * LRU_T + LRU_RW * w + rr) * NP + C_YB + ch]; } while (0)
    LRU_PREFETCH(0);
    float hcarry = 0.f;
    for (int n = 0; n < SEQ / LRU_T; ++n) {
        float xc[LRU_RW], yv[LRU_RW];
        { float xr[LRU_RW + 3];
#pragma unroll
          for (int rr = 0; rr < LRU_RW + 3; ++rr) xr[rr] = bf2f(px[rr]);
#pragma unroll
          for (int rr = 0; rr < LRU_RW; ++rr) { xc[rr] = cb + cw0 * xr[rr] + cw1 * xr[rr + 1] + cw2 * xr[rr + 2] + cw3 * xr[rr + 3]; yv[rr] = bf2f(py[rr]);
              *(LAS unsigned short*)(L + LRU_X + offb(LRU_RW * w + rr, lane >> 3) + (lane & 7) * 2) = (unsigned short)f2bf(xc[rr]); } }
        __syncthreads();
        if (n + 1 < SEQ / LRU_T) LRU_PREFETCH(n + 1);
#pragma unroll
        for (int k2 = 0; k2 < 2; ++k2) { const int rt = tt + 2 * k2; f32x16 Z;
#pragma unroll
          for (int i = 0; i < 16; ++i) Z[i] = 0.f;
#pragma unroll
          for (int s = 0; s < 4; ++s) { const bf16x8 af = *(const LAS bf16x8*)(L + LRU_X + offb(32 * rt + r31, 2 * s + hh)); Z = __builtin_amdgcn_mfma_f32_32x32x16_bf16(af, wf[s], Z, 0, 0, 0); }
          LAS float* dst = (LAS float*)(L + (gate ? LRU_I : LRU_R));
#pragma unroll
          for (int i = 0; i < 16; ++i) dst[(32 * rt + crow(i, hh)) * 64 + 32 * td + r31] = sigmoidf_(Z[i] + gbias); }
        __syncthreads();
        float hl[LRU_RW], pc[LRU_RW];
        { float hrun = 0.f, prun = 1.f;
#pragma unroll
          for (int rr = 0; rr < LRU_RW; ++rr) { const float r = ((const LAS float*)(L + LRU_R))[(LRU_RW * w + rr) * 64 + lane], ig = ((const LAS float*)(L + LRU_I))[(LRU_RW * w + rr) * 64 + lane];
              const float a = __expf(-c8 * r), u = __builtin_amdgcn_sqrtf(fmaxf(1.f - a * a, 0.f)) * ig * xc[rr];
              hrun = a * hrun + u; prun *= a; hl[rr] = hrun; pc[rr] = prun; }
          ((LAS float*)(L + LRU_SP))[w * 64 + lane] = prun; ((LAS float*)(L + LRU_SH))[w * 64 + lane] = hrun; }
        __syncthreads();
        { float hin = hcarry, hall = hcarry;
#pragma unroll
          for (int s = 0; s < 8; ++s) { const float P = ((const LAS float*)(L + LRU_SP))[s * 64 + lane], H = ((const LAS float*)(L + LRU_SH))[s * 64 + lane];
              hall = P * hall + H; hin = (s < w) ? hall : hin; }
          hcarry = hall;
#pragma unroll
          for (int rr = 0; rr < LRU_RW; ++rr) { const float hv = hl[rr] + pc[rr] * hin;
              c.proj[(tokb + n * LRU_T + LRU_RW * w + rr) * NP + C_YB + ch] = (bf16_t)f2bf(hv * gelu_tanh(yv[rr])); } }
    }
    __syncthreads();
#undef LRU_PREFETCH
}

constexpr int TPB = TT / 256;
__device__ __forceinline__ void phase_router(const Ctx& c, const float* gain, const float* rw, const float* rb, unsigned* gcnt) {
    LAS bf16_t* sWh = (LAS bf16_t*)c.lds;
    LAS bf16_t* sWl = sWh + 16 * RW_STRIDE;
    LAS float* sGn = (LAS float*)(c.lds + 69632);
    LAS unsigned* sRec = (LAS unsigned*)(c.lds + 73728);
    LAS unsigned* sCnt = (LAS unsigned*)(c.lds + MISC_OFF + 256);
    LAS unsigned* sBase = sCnt + 16;
    const int tid = c.tid, lane = c.lane, w = c.wave;
    { const u32x4* img = (const u32x4*)rw;
      for (int i = tid; i < 2 * 16 * RW_STRIDE * 2 / 16; i += NTHR) ((LAS u32x4*)sWh)[i] = img[i]; }
    for (int idx = tid; idx < D; idx += NTHR) sGn[idx] = gain[idx];
    if (tid < 16) sCnt[tid] = 0u;
    __syncthreads();
    const int t = lane & 15, g = lane >> 4;
#pragma unroll 1
    for (int sub = 0; sub < TPB / 128; ++sub) {
    const int lt = sub * 128 + w * 16 + t, tok = c.bid * TPB + lt;
    const bf16_t* xrow = c.xb + (size_t)tok * D + 8 * g; signed char* hrow = (signed char*)c.actf + (size_t)tok * D + 8 * g;
    LAS float* sGa = sGn; LAS float* sGb = sGn; LAS bf16_t* sWa = sWh; asm volatile("" : "+v"(sGa), "+v"(sGb), "+v"(sWa));
    f32x4 acc = {0.f, 0.f, 0.f, 0.f}; float ss = 0.f, am = 0.f;
    u32x4 xr[32];
#pragma unroll
    for (int s = 0; s < 32; ++s) xr[s] = *(const u32x4*)(xrow + 32 * s);
#pragma unroll
    for (int s = 0; s < 32; ++s) {
            const unsigned xw[4] = {xr[s].x, xr[s].y, xr[s].z, xr[s].w};
            float xv[8];
#pragma unroll
            for (int k = 0; k < 4; ++k) { xv[2 * k] = bflo(xw[k]); xv[2 * k + 1] = bfhi(xw[k]); }
            { const f32x4 q0 = *(const LAS f32x4*)(sGa + 32 * s + 8 * g), q1 = *(const LAS f32x4*)(sGa + 32 * s + 8 * g + 4);
              am = fmaxf(am, fmaxf(fmaxf(fmaxf(fabsf(xv[0] * q0.x), fabsf(xv[1] * q0.y)), fmaxf(fabsf(xv[2] * q0.z), fabsf(xv[3] * q0.w))), fmaxf(fmaxf(fabsf(xv[4] * q1.x), fabsf(xv[5] * q1.y)), fmaxf(fabsf(xv[6] * q1.z), fabsf(xv[7] * q1.w))))); }
            const bf16x8 bh = __builtin_bit_cast(bf16x8, xr[s]);
#pragma unroll
            for (int k = 0; k < 8; ++k) ss += xv[k] * xv[k];
            const bf16x8 ah = *(const LAS bf16x8*)(sWa + t * RW_STRIDE + 32 * s + 8 * g), al = *(const LAS bf16x8*)(sWa + 16 * RW_STRIDE + t * RW_STRIDE + 32 * s + 8 * g);
            acc = __builtin_amdgcn_mfma_f32_16x16x32_bf16(ah, bh, acc, 0, 0, 0);
            acc = __builtin_amdgcn_mfma_f32_16x16x32_bf16(al, bh, acc, 0, 0, 0);
            if ((s & 1) == 1) __builtin_amdgcn_sched_barrier(0);
    }
    ss += swz_xor<16>(ss);
    { const auto r = __builtin_amdgcn_permlane32_swap(__float_as_uint(ss), __float_as_uint(ss), false, false); ss = __uint_as_float(r[0]) + __uint_as_float(r[1]); }
    const float rs = rsqf_(ss * (1.f / D) + RMS_EPS);
    am = fmaxf(am, swz_xor<16>(am));
    { const auto r = __builtin_amdgcn_permlane32_swap(__float_as_uint(am), __float_as_uint(am), false, false); am = fmaxf(__uint_as_float(r[0]), __uint_as_float(r[1])); }
    const float qinv = am > 0.f ? 127.f / am : 0.f, qs = am * (1.f / 127.f);
    float sc[4]; float mx = -INFINITY;
#pragma unroll
    for (int i = 0; i < 4; ++i) { sc[i] = acc[i] * rs + rb[4 * g + i]; mx = fmaxf(mx, sc[i]); }
    mx = fmaxf(mx, swz_xor<16>(mx));
    { const auto r = __builtin_amdgcn_permlane32_swap(__float_as_uint(mx), __float_as_uint(mx), false, false); mx = fmaxf(__uint_as_float(r[0]), __uint_as_float(r[1])); }
    float sum = 0.f;
#pragma unroll
    for (int i = 0; i < 4; ++i) { sc[i] = __expf(sc[i] - mx); sum += sc[i]; }
    sum += swz_xor<16>(sum);
    { const auto r = __builtin_amdgcn_permlane32_swap(__float_as_uint(sum), __float_as_uint(sum), false, false); sum = __uint_as_float(r[0]) + __uint_as_float(r[1]); }
    const float isum = rcpf_(sum);
#pragma unroll
    for (int i = 0; i < 4; ++i) sc[i] *= isum;
    float gs;
    { const float hi1 = fmaxf(sc[0], sc[1]), lo1 = fminf(sc[0], sc[1]), hi2 = fmaxf(sc[2], sc[3]), lo2 = fminf(sc[2], sc[3]);
      gs = fmaxf(hi1, hi2) + fmaxf(fminf(hi1, hi2), fmaxf(lo1, lo2)); }
    const float g1 = swz_xor<16>(gs);
    float g2, g3;
    { const auto r = __builtin_amdgcn_permlane32_swap(__float_as_uint(gs), __float_as_uint(gs), false, false); g2 = (g & 2) ? __uint_as_float(r[0]) : __uint_as_float(r[1]); }
    { const auto r = __builtin_amdgcn_permlane32_swap(__float_as_uint(g1), __float_as_uint(g1), false, false); g3 = (g & 2) ? __uint_as_float(r[0]) : __uint_as_float(r[1]); }
    const bool win = ((gs > g1) || (gs == g1 && g < (g ^ 1))) && ((gs > g2) || (gs == g2 && g < (g ^ 2))) && ((gs > g3) || (gs == g3 && g < (g ^ 3)));
    if (win) {
        int i0 = 0; float b0 = sc[0];
#pragma unroll
        for (int k = 1; k < 4; ++k) if (sc[k] > b0) { b0 = sc[k]; i0 = k; }
        int i1 = -1; float b1 = -1.f;
#pragma unroll
        for (int k = 0; k < 4; ++k) if (k != i0 && sc[k] > b1) { b1 = sc[k]; i1 = k; }
        const int e0 = 4 * g + i0, e1 = 4 * g + i1; const float wn = rcpf_(b0 + b1);
        const unsigned l0 = atomicAdd((unsigned*)&sCnt[e0], 1u), l1 = atomicAdd((unsigned*)&sCnt[e1], 1u);
        sRec[lt * 8 + 0] = (unsigned)e0; sRec[lt * 8 + 1] = l0; sRec[lt * 8 + 2] = (unsigned)e1; sRec[lt * 8 + 3] = l1; sRec[lt * 8 + 4] = __float_as_uint(b0 * wn); sRec[lt * 8 + 5] = __float_as_uint(b1 * wn); sRec[lt * 8 + 6] = __float_as_uint(rs * qs);
    }
#pragma unroll
    for (int s = 0; s < 32; ++s) { u32x4 xs = xr[s]; asm volatile("" : "+v"(xs));
            const unsigned xw[4] = {xs.x, xs.y, xs.z, xs.w};
            const f32x4 q0 = *(const LAS f32x4*)(sGb + 32 * s + 8 * g), q1 = *(const LAS f32x4*)(sGb + 32 * s + 8 * g + 4);
            const int i0 = (int)__builtin_rintf(bflo(xw[0]) * q0.x * qinv), i1 = (int)__builtin_rintf(bfhi(xw[0]) * q0.y * qinv), i2 = (int)__builtin_rintf(bflo(xw[1]) * q0.z * qinv), i3 = (int)__builtin_rintf(bfhi(xw[1]) * q0.w * qinv);
            const int i4 = (int)__builtin_rintf(bflo(xw[2]) * q1.x * qinv), i5 = (int)__builtin_rintf(bfhi(xw[2]) * q1.y * qinv), i6 = (int)__builtin_rintf(bflo(xw[3]) * q1.z * qinv), i7 = (int)__builtin_rintf(bfhi(xw[3]) * q1.w * qinv);
            u32x2 o; o.x = (unsigned)(i0 & 0xff) | ((unsigned)(i1 & 0xff) << 8) | ((unsigned)(i2 & 0xff) << 16) | ((unsigned)(i3 & 0xff) << 24);
            o.y = (unsigned)(i4 & 0xff) | ((unsigned)(i5 & 0xff) << 8) | ((unsigned)(i6 & 0xff) << 16) | ((unsigned)(i7 & 0xff) << 24);
            *(u32x2*)(hrow + 32 * s) = o;
            if ((s & 1) == 1) __builtin_amdgcn_sched_barrier(0); }
    }
    __syncthreads();
    if (tid < 16) sBase[tid] = __hip_atomic_fetch_add(gcnt + tid * CNT_PAD, sCnt[tid], __ATOMIC_RELAXED, __HIP_MEMORY_SCOPE_AGENT);
    __syncthreads();
    if (tid < TPB) { const int tk = c.bid * TPB + tid; const unsigned e0 = sRec[tid * 8], e1 = sRec[tid * 8 + 2];
        const unsigned p0 = sBase[e0] + sRec[tid * 8 + 1], p1 = sBase[e1] + sRec[tid * 8 + 3];
        u32x4 r; r.x = (e0 << 20) | p0; r.y = (e1 << 20) | p1; r.z = sRec[tid * 8 + 4]; r.w = sRec[tid * 8 + 5];
        *(u32x4*)(c.rec + (size_t)tk * 4) = r;
        const float rsv = __uint_as_float(sRec[tid * 8 + 6]);
        c.list[(size_t)e0 * TT + p0] = tk; c.list[(size_t)e1 * TT + p1] = tk; c.rsl[(size_t)e0 * TT + p0] = rsv; c.rsl[(size_t)e1 * TT + p1] = rsv; }
}

struct PlainOrder {
    int nM, nN, G, c; const char* A; const char* Bt; size_t a_tile, b_tile; int r0, r1;
    __device__ __forceinline__ bool next(int i, pg8::Unit& u) const { u.g = 0; if (r0 + i >= r1) return false; return pg8::static_tile(nM, nN, G, c, r0 + i, u.pm, u.pn); }
    __device__ __forceinline__ const char* aptr(const pg8::Unit& u) const { return A + (size_t)u.pm * a_tile; }
    __device__ __forceinline__ const char* bptr(const pg8::Unit& u) const { return Bt + (size_t)u.pn * b_tile; }
    __device__ __forceinline__ unsigned arow(const pg8::Unit&, int) const { return 0u; }
};
struct MergeOrder {
    int G, c; const char* proj; const char* wbr;
    __device__ __forceinline__ bool next(int i, pg8::Unit& u) const { u.g = i % 3; u.pn = ((i / 3) + (c >> 3)) & 3; u.pm = c; return i < 12; }
    __device__ __forceinline__ const char* aptr(const pg8::Unit& u) const { const int col = u.g == 0 ? C_OG : (u.g == 1 ? C_YB : C_QKV); return proj + ((size_t)u.pm * 128 * NP + col) * 2; }
    __device__ __forceinline__ const char* bptr(const pg8::Unit& u) const { return wbr + ((size_t)u.g * D + (size_t)u.pn * 256) * 512; }
    __device__ __forceinline__ unsigned arow(const pg8::Unit&, int) const { return 0u; }
};
template <bool UP> struct MoeOrder {
    int G, c; LAS const int* pt; LAS const int* lc; const char* A; const char* W; const int* list;
    __device__ __forceinline__ bool next(int i, pg8::Unit& u) const { const int x = c & 7, j = c >> 3, tau = (G >> 2) * i + 8 * x + (j >> 2); if (tau >= pt[NE]) return false;
        int e = 0;
#pragma unroll
        for (int k = 1; k < NE; ++k) e += (tau >= pt[k]) ? 1 : 0;
        u.pm = tau; u.pn = j & 3; u.g = e; return true; }
    __device__ __forceinline__ const char* aptr(const pg8::Unit& u) const { return UP ? A : A + (size_t)u.pm * 256 * FF; }
    __device__ __forceinline__ const char* bptr(const pg8::Unit& u) const { return UP ? W + ((size_t)u.g * 1024 + (size_t)u.pn * 256) * D : W + ((size_t)u.g * D + (size_t)u.pn * 256) * FF; }
    __device__ __forceinline__ unsigned arow(const pg8::Unit& u, int r) const { int p = (u.pm - pt[u.g]) * 256 + r; const int n = lc[u.g]; p = p < n ? p : n - 1;
        return (unsigned)list[(size_t)u.g * TT + p] * (unsigned)D; }
};

__device__ __forceinline__ int lane_fresh() { int l; asm volatile("v_mbcnt_lo_u32_b32 %0, -1, 0\n\tv_mbcnt_hi_u32_b32 %0, -1, %0" : "=v"(l)); return l; }
struct EpiStoreBf16 {
    static constexpr bool PERM = true;
    bf16_t* O; int ldc; float sc;
    __device__ __forceinline__ void operator()(const f32x4 (&acc)[2][2][4][2], const pg8::Unit& u, int wr, int wc, int, int) const {
        const int ln_ = lane_fresh(), fr = ln_ & 15, fq = ln_ >> 4;
        const int row0 = u.pm * 256 + wr * 64 + fr, col0 = u.pn * 256 + wc * 32 + 8 * fq;
#pragma unroll
        for (int ai = 0; ai < 2; ++ai)
#pragma unroll
            for (int m = 0; m < 4; ++m) { bf16_t* rowp = O + (size_t)(row0 + ai * 128 + m * 16) * ldc + col0;
#pragma unroll
                for (int bj = 0; bj < 2; ++bj) { const f32x4 v0 = acc[ai][bj][m][0] * sc, v1 = acc[ai][bj][m][1] * sc;
                    u32x4 w; w.x = pg8::cvt_pk_bf16(v0[0], v0[1]); w.y = pg8::cvt_pk_bf16(v0[2], v0[3]); w.z = pg8::cvt_pk_bf16(v1[0], v1[1]); w.w = pg8::cvt_pk_bf16(v1[2], v1[3]);
                    __builtin_nontemporal_store(w, (u32x4*)(rowp + bj * 128)); } }
    }
};
struct EpiProj {
    static constexpr bool PERM = true;
    bf16_t* O; const float* sa  ; const unsigned* cmax  ;
    __device__ __forceinline__ void operator()(const i32x4 (&acc)[2][2][4][2], const pg8::Unit& u, int wr, int wc, int fr, int fq) const {
        const int row0 = u.pm * 256 + wr * 64 + fr, col0 = u.pn * 256 + wc * 32 + 8 * fq;
        f32x4 sb0[2], sb1[2];
#pragma unroll
        for (int bj = 0; bj < 2; ++bj) { const u32x4 m0 = *(const u32x4*)(cmax + col0 + bj * 128), m1 = *(const u32x4*)(cmax + col0 + bj * 128 + 4); const float k = 1.f / 127.f;
            sb0[bj] = (f32x4){__uint_as_float(m0.x) * k, __uint_as_float(m0.y) * k, __uint_as_float(m0.z) * k, __uint_as_float(m0.w) * k};
            sb1[bj] = (f32x4){__uint_as_float(m1.x) * k, __uint_as_float(m1.y) * k, __uint_as_float(m1.z) * k, __uint_as_float(m1.w) * k}; }
        float sar[2][4];
#pragma unroll
        for (int ai = 0; ai < 2; ++ai)
#pragma unroll
            for (int m = 0; m < 4; ++m) sar[ai][m] = sa[row0 + ai * 128 + m * 16];
        if (u.pn * 256 >= C_G) {
#pragma unroll
            for (int ai = 0; ai < 2; ++ai)
#pragma unroll
                for (int m = 0; m < 4; ++m) { unsigned char* rowp = (unsigned char*)(O + (size_t)(row0 + ai * 128 + m * 16) * NP + C_G) + (col0 - C_G);
#pragma unroll
                    for (int bj = 0; bj < 2; ++bj) { const i32x4 a0 = acc[ai][bj][m][0], a1 = acc[ai][bj][m][1]; const float nl2 = -1.4426950408889634f * sar[ai][m]; const f32x4 s0 = sb0[bj] * nl2, s1 = sb1[bj] * nl2;
                        unsigned q[8];
#pragma unroll
                        for (int k = 0; k < 4; ++k) { q[k] = (unsigned)(__builtin_amdgcn_rcpf(1.f + __builtin_amdgcn_exp2f((float)a0[k] * s0[k])) * 255.f + 0.5f); q[4 + k] = (unsigned)(__builtin_amdgcn_rcpf(1.f + __builtin_amdgcn_exp2f((float)a1[k] * s1[k])) * 255.f + 0.5f); }
                        u32x2 w; w.x = q[0] | (q[1] << 8) | (q[2] << 16) | (q[3] << 24); w.y = q[4] | (q[5] << 8) | (q[6] << 16) | (q[7] << 24);
                        __builtin_nontemporal_store(w, (u32x2*)(rowp + bj * 128)); } }
        } else {
#pragma unroll
            for (int ai = 0; ai < 2; ++ai)
#pragma unroll
                for (int m = 0; m < 4; ++m) { bf16_t* rowp = O + (size_t)(row0 + ai * 128 + m * 16) * NP + col0;
#pragma unroll
                    for (int bj = 0; bj < 2; ++bj) { const i32x4 a0 = acc[ai][bj][m][0], a1 = acc[ai][bj][m][1]; const f32x4 s0 = sb0[bj] * sar[ai][m], s1 = sb1[bj] * sar[ai][m];
                        u32x4 w; w.x = pk2((float)a0[0] * s0[0], (float)a0[1] * s0[1]); w.y = pk2((float)a0[2] * s0[2], (float)a0[3] * s0[3]); w.z = pk2((float)a1[0] * s1[0], (float)a1[1] * s1[1]); w.w = pk2((float)a1[2] * s1[2], (float)a1[3] * s1[3]);
                        __builtin_nontemporal_store(w, (u32x4*)(rowp + bj * 128)); } }
        }
    }
};
struct EpiMerge {
    static constexpr bool PERM = true;
    const bf16_t* proj; bf16_t* mg; const float* sbr  ; const unsigned* cmax  ; LAS unsigned* rmax  ;
    struct Pf { u32x2 gv[4][2]; float sar[4]; };
    static constexpr int PF_LOADS = 12, EPI_STORES = 8;
    static __device__ __forceinline__ bool stored(const pg8::Unit& u) { return u.g == 0; }
    __device__ __forceinline__ void prefetch(Pf& pf, const pg8::Unit& u, int wr, int wc) const {
        const int ln_ = lane_fresh(), fr_ = ln_ & 15, fq_ = ln_ >> 4;
        const unsigned lrow = (unsigned)(wr * 64 + fr_), lcol = (unsigned)(wc * 32 + 8 * fq_);
        const int upm = __builtin_amdgcn_readfirstlane(u.pm), upn = __builtin_amdgcn_readfirstlane(u.pn), ug = __builtin_amdgcn_readfirstlane(u.g);
        const unsigned char* gB = (const unsigned char*)(proj + (size_t)(upm * 128) * NP + C_G) + ug * D + upn * 256;
        const unsigned char* sB = (const unsigned char*)(sbr + (size_t)ug * TC + upm * 128);
        const unsigned gl = lrow * (unsigned)(NP * 2) + lcol, sl = lrow * 4u;
#pragma unroll
        for (int m = 0; m < 4; ++m) { const unsigned rr = (unsigned)(m * 16); pf.sar[m] = *(const float*)(sB + (sl + rr * 4u));
#pragma unroll
            for (int bj = 0; bj < 2; ++bj) pf.gv[m][bj] = *(const u32x2*)(gB + (gl + rr * (unsigned)(NP * 2) + (unsigned)(bj * 128))); }
    }
    __device__ __forceinline__ void operator()(i32x4 (&acc)[2][2][4][2], const pg8::Unit& u, int wr, int wc, const Pf& pf, bool has_next, const pg8::Unit& un, Pf& pfn) const {
        const int ln_ = lane_fresh(), fr_ = ln_ & 15, fq_ = ln_ >> 4;
        const unsigned lrow = (unsigned)(wr * 64 + fr_), lcol = (unsigned)(wc * 32 + 8 * fq_);
        const int upm = __builtin_amdgcn_readfirstlane(u.pm), upn = __builtin_amdgcn_readfirstlane(u.pn), ug = __builtin_amdgcn_readfirstlane(u.g);
        unsigned char* mB = (unsigned char*)(mg + (size_t)(upm * 128) * D + upn * 256);
        const unsigned char* cB = (const unsigned char*)(cmax + ug * 1024 + upn * 256);
        const unsigned ml = lrow * (unsigned)(D * 2) + lcol * 2u, cl = lcol * 4u;
        float rmx[4] = {0.f, 0.f, 0.f, 0.f};
        u32x4 cm0[2], cm1[2];
#pragma unroll
        for (int bj = 0; bj < 2; ++bj) { cm0[bj] = *(const u32x4*)(cB + (cl + (unsigned)(bj * 512))); cm1[bj] = *(const u32x4*)(cB + (cl + (unsigned)(bj * 512 + 16))); }
        asm volatile("" ::: "memory");
        if (has_next) prefetch(pfn, un, wr, wc);
        asm volatile("" ::: "memory");
#pragma unroll
        for (int bj = 0; bj < 2; ++bj) {
            const u32x4 m0 = cm0[bj], m1 = cm1[bj];
            const f32x4 c0 = (f32x4){__uint_as_float(m0.x), __uint_as_float(m0.y), __uint_as_float(m0.z), __uint_as_float(m0.w)}, c1 = (f32x4){__uint_as_float(m1.x), __uint_as_float(m1.y), __uint_as_float(m1.z), __uint_as_float(m1.w)};
#pragma unroll
            for (int m = 0; m < 4; ++m) { const unsigned rr = (unsigned)(m * 16);
                const u32x2 g = pf.gv[m][bj];
                const i32x4 a0 = acc[0][bj][m][0], a1 = acc[0][bj][m][1];
                const float k255 = pf.sar[m] * (1.f / (255.f * 127.f));
                const f32x4 s0 = c0 * k255, s1 = c1 * k255;
                f32x4 t0, t1;
                if (ug == 0) { t0 = (f32x4){0.f, 0.f, 0.f, 0.f}; t1 = t0; }
                else { const i32x4 tp = acc[1][bj][m][0]; t0 = (f32x4){bflo((unsigned)tp[0]), bfhi((unsigned)tp[0]), bflo((unsigned)tp[1]), bfhi((unsigned)tp[1])}; t1 = (f32x4){bflo((unsigned)tp[2]), bfhi((unsigned)tp[2]), bflo((unsigned)tp[3]), bfhi((unsigned)tp[3])}; }
                t0[0] += (float)a0[0] * s0[0] * (float)(g.x & 0xffu); t0[1] += (float)a0[1] * s0[1] * (float)((g.x >> 8) & 0xffu);
                t0[2] += (float)a0[2] * s0[2] * (float)((g.x >> 16) & 0xffu); t0[3] += (float)a0[3] * s0[3] * (float)(g.x >> 24);
                t1[0] += (float)a1[0] * s1[0] * (float)(g.y & 0xffu); t1[1] += (float)a1[1] * s1[1] * (float)((g.y >> 8) & 0xffu);
                t1[2] += (float)a1[2] * s1[2] * (float)((g.y >> 16) & 0xffu); t1[3] += (float)a1[3] * s1[3] * (float)(g.y >> 24);
                u32x4 w; w.x = pk2(t0[0], t0[1]); w.y = pk2(t0[2], t0[3]); w.z = pk2(t1[0], t1[1]); w.w = pk2(t1[2], t1[3]);
                acc[1][bj][m][0] = __builtin_bit_cast(i32x4, w);
                if (ug == 2) { rmx[m] = fmaxf(rmx[m], fmaxf(fmaxf(fmaxf(fabsf(t0[0]), fabsf(t0[1])), fmaxf(fabsf(t0[2]), fabsf(t0[3]))), fmaxf(fmaxf(fabsf(t1[0]), fabsf(t1[1])), fmaxf(fabsf(t1[2]), fabsf(t1[3])))));
                    *(u32x4*)(mB + (ml + rr * (unsigned)(D * 2) + (unsigned)(bj * 256))) = w; } }
        }
        if (ug == 2) {
#pragma unroll
            for (int m = 0; m < 4; ++m) { float v = rmx[m]; v = fmaxf(v, swz_xor<16>(v));
                { const auto rr = __builtin_amdgcn_permlane32_swap(__float_as_uint(v), __float_as_uint(v), false, false); v = fmaxf(__uint_as_float(rr[0]), __uint_as_float(rr[1])); }
                if (fq_ == 0) atomicMax((unsigned*)(rmax + (wr * 64 + m * 16 + fr_)), __float_as_uint(v)); }
        }
    }
};
__device__ __forceinline__ void merge_rows_to_i8(const Ctx& c, LAS const unsigned* rmax) {
    const int lane = c.lane, w = c.wave;
    asm volatile("s_waitcnt vmcnt(0) lgkmcnt(0)" ::: "memory"); __syncthreads();
#pragma unroll 1
    for (int r0 = w * 16; r0 < w * 16 + 16; r0 += 8) {
        u32x4 a[8], b[8];
#pragma unroll
        for (int j = 0; j < 8; ++j) { const u32x4* p = (const u32x4*)(c.act + ((size_t)c.bid * 128 + r0 + j) * D) + 2 * lane; a[j] = p[0]; b[j] = p[1]; }
#pragma unroll
        for (int j = 0; j < 8; ++j) { const float mx = __uint_as_float(rmax[r0 + j]); const float inv = mx > 0.f ? 127.f / mx : 0.f;
            const unsigned wv[8] = {a[j].x, a[j].y, a[j].z, a[j].w, b[j].x, b[j].y, b[j].z, b[j].w};
            unsigned o[4];
#pragma unroll
            for (int k = 0; k < 4; ++k) { const int i0 = (int)__builtin_rintf(bflo(wv[2 * k]) * inv), i1 = (int)__builtin_rintf(bfhi(wv[2 * k]) * inv), i2 = (int)__builtin_rintf(bflo(wv[2 * k + 1]) * inv), i3 = (int)__builtin_rintf(bfhi(wv[2 * k + 1]) * inv);
                o[k] = (unsigned)(i0 & 0xff) | ((unsigned)(i1 & 0xff) << 8) | ((unsigned)(i2 & 0xff) << 16) | ((unsigned)(i3 & 0xff) << 24); }
            u32x4 q; q.x = o[0]; q.y = o[1]; q.z = o[2]; q.w = o[3];
            *((u32x4*)(c.act + ((size_t)c.bid * 128 + r0 + j) * D) + lane) = q;
            if (lane == 0) c.smg[(size_t)c.chunk * TC + (size_t)c.bid * 128 + r0 + j] = mx * (1.f / 127.f); }
    }
}
struct OwnOrder {
    int c, nN; const char* A; const char* Bt; size_t a_tile, b_tile;
    __device__ __forceinline__ bool next(int i, pg8::Unit& u) const { u.g = 0; u.pm = c; u.pn = (i + (c >> 3)) & (nN - 1); return i < nN; }
    __device__ __forceinline__ const char* aptr(const pg8::Unit& u) const { return A + (size_t)u.pm * a_tile; }
    __device__ __forceinline__ const char* bptr(const pg8::Unit& u) const { return Bt + (size_t)u.pn * b_tile; }
    __device__ __forceinline__ unsigned arow(const pg8::Unit&, int) const { return 0u; }
};
template <bool BASE_BF16> struct EpiResid {
    static constexpr bool PERM = true;
    const void* base; bf16_t* out; const float* smg  ; const unsigned* cmax  ;
    __device__ __forceinline__ void operator()(const i32x4 (&acc)[2][2][4][2], const pg8::Unit& u, int wr, int wc, int, int) const {
        const int ln_ = lane_fresh(), fr = ln_ & 15, fq = ln_ >> 4;
        const int upm = __builtin_amdgcn_readfirstlane(u.pm), upn = __builtin_amdgcn_readfirstlane(u.pn);
        const unsigned lrow = (unsigned)(wr * 64 + fr), lcol = (unsigned)(wc * 32 + 8 * fq);
        constexpr unsigned BP = BASE_BF16 ? 2u : 4u;
        const unsigned char* bB = (const unsigned char*)base + ((size_t)(upm * 256) * D + upn * 256) * BP;
        unsigned char* oB = (unsigned char*)(out + (size_t)(upm * 256) * D + upn * 256);
        const unsigned char* sB = (const unsigned char*)(smg + upm * 256);
        const unsigned char* cB = (const unsigned char*)(cmax + upn * 256);
        unsigned bl = (lrow * (unsigned)D + lcol) * BP, ol = (lrow * (unsigned)D + lcol) * 2u, sl = lrow * 4u; const unsigned cl = lcol * 4u;
        f32x4 sb0[2], sb1[2];
#pragma unroll
        for (int bj = 0; bj < 2; ++bj) { const u32x4 m0 = *(const u32x4*)(cB + (cl + (unsigned)(bj * 512))), m1 = *(const u32x4*)(cB + (cl + (unsigned)(bj * 512 + 16))); const float k = 1.f / 127.f;
            sb0[bj] = (f32x4){__uint_as_float(m0.x) * k, __uint_as_float(m0.y) * k, __uint_as_float(m0.z) * k, __uint_as_float(m0.w) * k};
            sb1[bj] = (f32x4){__uint_as_float(m1.x) * k, __uint_as_float(m1.y) * k, __uint_as_float(m1.z) * k, __uint_as_float(m1.w) * k}; }
#pragma unroll
        for (int aim = 0; aim < 4; ++aim) { const int ai = aim >> 1, mh = (aim & 1) * 2;
            asm volatile("" : "+v"(bl), "+v"(ol), "+v"(sl));
            f32x4 b0[2][2], b1[2][2]; float sar[2];
#pragma unroll
            for (int mm = 0; mm < 2; ++mm) { const unsigned rr = (unsigned)(ai * 128 + (mh + mm) * 16); sar[mm] = *(const float*)(sB + (sl + rr * 4u));
#pragma unroll
                for (int bj = 0; bj < 2; ++bj) { const unsigned bo = bl + (rr * (unsigned)D + (unsigned)(bj * 128)) * BP;
                    if (BASE_BF16) { const u32x4 w = *(const u32x4*)(bB + bo);
                        b0[mm][bj] = (f32x4){bflo(w.x), bfhi(w.x), bflo(w.y), bfhi(w.y)}; b1[mm][bj] = (f32x4){bflo(w.z), bfhi(w.z), bflo(w.w), bfhi(w.w)}; }
                    else { b0[mm][bj] = *(const f32x4*)(bB + bo); b1[mm][bj] = *(const f32x4*)(bB + (bo + 16u)); } } }
            asm volatile("" ::: "memory");
#pragma unroll
            for (int mm = 0; mm < 2; ++mm) { const int m = mh + mm; const unsigned rr = (unsigned)(ai * 128 + m * 16);
#pragma unroll
                for (int bj = 0; bj < 2; ++bj) { const i32x4 a0 = acc[ai][bj][m][0], a1 = acc[ai][bj][m][1]; const f32x4 s0 = sb0[bj] * sar[mm], s1 = sb1[bj] * sar[mm];
                    const f32x4 v0 = b0[mm][bj] + (f32x4){(float)a0[0], (float)a0[1], (float)a0[2], (float)a0[3]} * s0, v1 = b1[mm][bj] + (f32x4){(float)a1[0], (float)a1[1], (float)a1[2], (float)a1[3]} * s1;
                    u32x4 w; w.x = pk2(v0[0], v0[1]); w.y = pk2(v0[2], v0[3]); w.z = pk2(v1[0], v1[1]); w.w = pk2(v1[2], v1[3]);
                    *(u32x4*)(oB + (ol + (rr * (unsigned)D + (unsigned)(bj * 128)) * 2u)) = w; } }
            asm volatile("" ::: "memory");
        }
    }
};
struct EpiSwiGLU {
    static constexpr bool PERM = false;
    bf16_t* hid; const float* rsl; LAS const int* pt; LAS const int* lc; const unsigned* cmax  ;
    __device__ __forceinline__ void operator()(const i32x4 (&acc)[2][2][4][2], const pg8::Unit& u, int wr, int wc, int, int) const {
        const int ln_ = lane_fresh(), fr = ln_ & 15, fq = ln_ >> 4;
        const int row0 = u.pm * 256 + wr * 64 + fr, col0 = u.pn * 128 + wc * 16 + 4 * fq;
        const int pbase = (u.pm - pt[u.g]) * 256 + wr * 64 + fr, nrow = lc[u.g];
        float rsv[2][4]; f32x4 sg[2], su[2];
#pragma unroll
        for (int ai = 0; ai < 2; ++ai)
#pragma unroll
            for (int m = 0; m < 4; ++m) { int p = pbase + ai * 128 + m * 16; p = p < nrow ? p : nrow - 1; rsv[ai][m] = rsl[(size_t)u.g * TT + p]; }
#pragma unroll
        for (int bj = 0; bj < 2; ++bj) { const unsigned* cm = cmax + (size_t)u.g * 1024 + u.pn * 256 + bj * 128 + wc * 32 + 4 * fq; const u32x4 a = *(const u32x4*)cm, b = *(const u32x4*)(cm + 16); const float k = 1.f / 127.f;
            sg[bj] = (f32x4){__uint_as_float(a.x) * k, __uint_as_float(a.y) * k, __uint_as_float(a.z) * k, __uint_as_float(a.w) * k};
            su[bj] = (f32x4){__uint_as_float(b.x) * k, __uint_as_float(b.y) * k, __uint_as_float(b.z) * k, __uint_as_float(b.w) * k}; }
#pragma unroll
        for (int ai = 0; ai < 2; ++ai)
#pragma unroll
            for (int bj = 0; bj < 2; ++bj) { unsigned w[4];
#pragma unroll
                for (int m = 0; m < 4; ++m) { const float rs = rsv[ai][m]; const i32x4 ag = acc[ai][bj][m][0], au = acc[ai][bj][m][1]; float g[4], up[4];
#pragma unroll
                    for (int k = 0; k < 4; ++k) { g[k] = (float)ag[k] * (sg[bj][k] * rs); up[k] = (float)au[k] * (su[bj][k] * rs); }
                    w[m] = pk4_fp8(g[0] * sigmoidf_(g[0]) * up[0] * F8_HSCALE, g[1] * sigmoidf_(g[1]) * up[1] * F8_HSCALE, g[2] * sigmoidf_(g[2]) * up[2] * F8_HSCALE, g[3] * sigmoidf_(g[3]) * up[3] * F8_HSCALE); }
                const auto p01 = __builtin_amdgcn_permlane16_swap(w[0], w[1], false, false), p23 = __builtin_amdgcn_permlane16_swap(w[2], w[3], false, false);
                const auto qx = __builtin_amdgcn_permlane32_swap(p01[0], p23[0], false, false), qy = __builtin_amdgcn_permlane32_swap(p01[1], p23[1], false, false);
                u32x4 o; o.x = qx[0]; o.y = qy[0]; o.z = qx[1]; o.w = qy[1];
                *(u32x4*)((unsigned char*)hid + (size_t)(u.pm * 256 + wr * 64 + ai * 128 + fq * 16 + fr) * FF + u.pn * 128 + bj * 64 + wc * 16) = o; }
    }
};

constexpr int PH_PER_LAYER = 1 + NCH * 4 + 4, PH_TOTAL = 1 + DEPTH * PH_PER_LAYER + 1;
#ifndef MK_LAUNCH_PER_PHASE
#define MK_LAUNCH_PER_PHASE 0
#endif
#ifndef PHMASK
#define PHMASK 0xFFFF
#endif
#ifndef MIXM
#define MIXM 7
#endif
#define EN(j) (((PHMASK) >> (j)) & 1)
typedef const __attribute__((address_space(4))) char* kptr_t;
__device__ __forceinline__ const void* karg_ptr(kptr_t kp, int i) { return *(const void* const __attribute__((address_space(4)))*)(kp + 8 * i); }
__device__ __forceinline__ void make_ctx(Ctx& c, kptr_t& kp, int layer, int chunk, int wave_s) {
    int t = wave_s * 64 + lane_fresh();
    kp = (kptr_t)__builtin_amdgcn_kernarg_segment_ptr(); asm volatile("" : "+s"(kp));
    c.tid = t; c.lane = t & 63; c.wave = __builtin_amdgcn_readfirstlane(t >> 6); c.bid = blockIdx.x; c.G = gridDim.x;
    unsigned char* ws = (unsigned char*)karg_ptr(kp, 25); float* out = (float*)karg_ptr(kp, 24);
    c.ctl = (unsigned*)(ws + WS_CTL);
    c.actf = (bf16_t*)(ws + WS_ACT); c.act = c.actf + (size_t)chunk * TC * D; c.proj = (bf16_t*)(ws + WS_PROJ); c.hid = (bf16_t*)(ws + WS_HID); c.ys = (bf16_t*)(ws + WS_YS);
    c.rec = (unsigned*)(ws + WS_REC); c.list = (int*)(ws + WS_LIST); c.rsl = (float*)(ws + WS_RSL);
    c.chunk = chunk; c.layer = layer; c.pass = layer * NCH + chunk;
    c.xinf = (const float*)karg_ptr(kp, 0); c.xof = out; c.xb = (bf16_t*)(ws + WS_XB); c.x2 = (bf16_t*)out; c.sa = (float*)(ws + WS_SA); c.sbr = (float*)(ws + WS_SBR); c.smg = (float*)(ws + WS_SMG);
    c.x_in = c.xinf + (size_t)chunk * TC * D; c.xo = out + (size_t)chunk * TC * D;
    c.pos = (const int*)karg_ptr(kp, 1) + (size_t)chunk * TC;
    c.lw = ws + WS_W + (size_t)layer * LW_SIZE;
}
#define INP(i) ((const float*)karg_ptr(kp, (i)))
__global__ void __launch_bounds__(NTHR, 2) fwd(Args args) {
    extern __shared__ __attribute__((aligned(16))) unsigned char lds_raw[];
    Ctx c; kptr_t kp;
    c.lds = (LAS unsigned char*)lds_raw;
    const int wave_s = __builtin_amdgcn_readfirstlane((int)threadIdx.x >> 6);
    make_ctx(c, kp, 0, 0, wave_s);
    volatile LAS unsigned* MISC = (volatile LAS unsigned*)(c.lds + MISC_OFF);
    LAS int* sPT = (LAS int*)(c.lds + MISC_OFF + 64);
    LAS int* sLC = (LAS int*)(c.lds + MISC_OFF + 160);
    for (int u = c.tid; u < 1024; u += NTHR) MISC[u] = 0u;
    __syncthreads();
    XcdBarrier bar; bar.bar = c.ctl + CW_BAR; bar.x = 0; bar.st = nullptr;
    if (!MK_LAUNCH_PER_PHASE) bar = xcd_barrier_post(c.ctl + CW_BAR, MISC, c.tid);
    const int lo = args.ph_lo, hi = args.ph_hi;
#define IN(k) (lo <= (k) && (k) < hi)
#ifndef PROBE_MASK
#define PROBE_MASK 0
#endif
#ifndef PROBE_CLK_CLS
#define PROBE_CLK_CLS 2
#endif
#ifndef PROBE_BLOCK
#define PROBE_BLOCK 0
#endif
#ifndef PROBE_K
#define PROBE_K 4
#endif
    unsigned long long t_prev = 0, c_prev = 0; LAS unsigned* sAcc = (LAS unsigned*)(c.lds + MISC_OFF + 512);
    if (PROBE_MASK) { t_prev = __builtin_amdgcn_s_memrealtime(); c_prev = (unsigned long long)clock64(); }
#define STAMP(cls) do { if (PROBE_MASK) { const unsigned long long _n = __builtin_amdgcn_s_memrealtime(); const unsigned long long _ck = (unsigned long long)clock64(); if (blockIdx.x == PROBE_BLOCK && c.tid == 0) { sAcc[(cls)] += (unsigned)(_n - t_prev); if ((cls) == PROBE_CLK_CLS) sAcc[15] += (unsigned)((_ck - c_prev) >> 4); } t_prev = _n; c_prev = _ck; } } while (0)
#ifndef PROBE_SEAM
#define PROBE_SEAM -1
#endif
#ifndef PROBE_GEMM_CLS
#define PROBE_GEMM_CLS -1
#endif
#define GEMM_FLAG(cls) do { if (PROBE_MASK) { if (c.tid == 0) MISC[6] = ((cls) == PROBE_GEMM_CLS) ? 1u : 0u; __syncthreads(); } } while (0)
#define SEAM(k) do { if (IN(k) && IN((k) + 1)) { XcdBarrier _b = bar; kptr_t _k = (kptr_t)__builtin_amdgcn_kernarg_segment_ptr(); asm volatile("" : "+s"(_k)); _b.bar = (unsigned*)((unsigned char*)karg_ptr(_k, 25) + WS_CTL) + CW_BAR; { int _t = wave_s * 64 + lane_fresh(); const unsigned long long _b0 = PROBE_MASK ? __builtin_amdgcn_s_memrealtime() : 0ull; xcd_barrier(_b, _t); if (PROBE_MASK && blockIdx.x == PROBE_BLOCK && _t == 0 && (PROBE_SEAM < 0 || (((k) - 1) % PH_PER_LAYER) == PROBE_SEAM)) sAcc[3] += (unsigned)(__builtin_amdgcn_s_memrealtime() - _b0); } } } while (0)

    if (EN(0) && IN(0)) { Args a2;
#pragma unroll
        for (int i = 0; i < 24; ++i) a2.in[i] = karg_ptr(kp, i);
        a2.ws = (unsigned char*)karg_ptr(kp, 25); a2.out = nullptr; a2.ph_lo = 0; a2.ph_hi = 0;
        float* tmpf = (float*)(a2.ws + WS_XB); unsigned* cmaxb = c.ctl + CW_CMAX;
        phase_prep_fused(a2, cmaxb, c.lds, c.bid, c.G, c.wave, c.lane, c.tid);
        phase_prep(a2, tmpf, cmaxb, c.lds, c.bid * NWAVES + c.wave, c.G * NWAVES, c.wave, c.lane, c.bid * NTHR + c.tid, c.G * NTHR);
        phase_prep_router(a2, (bf16_t*)((unsigned char*)(c.ctl) + WS_RW), c.bid * NTHR + c.tid, c.G * NTHR);
        phase_rope_table((const int*)karg_ptr(kp, 1), (bf16_t*)((unsigned char*)(c.ctl) + WS_BRC + 4 * MiB), c.bid * NTHR + c.tid, c.G * NTHR);
        make_ctx(c, kp, 0, 0, wave_s); phase_norm1<false, true, false>(c, INP(2), sPT); }
    SEAM(0); STAMP(0);

    for (int layer = 0; layer < DEPTH; ++layer) {
        const int pl = 1 + layer * PH_PER_LAYER;
        if (EN(1) && IN(pl)) { make_ctx(c, kp, layer, 0, wave_s);
            const float* g1 = INP(2) + layer * D;
            if (layer > 0) { moe_tables(c.ctl + CW_CNT + CNT_LAYER * (layer - 1), sPT, sLC, c.tid); phase_norm1<true, true, true>(c, g1, sPT); }
        }
        if (layer > 0) { SEAM(pl); } STAMP(1);
        for (int chunk = 0; chunk < NCH; ++chunk) {
            const int pb = pl + 1 + chunk * 4;
            if (EN(2) && IN(pb + 0)) { make_ctx(c, kp, layer, chunk, wave_s);
                EpiProj E{c.proj, c.sa + (size_t)chunk * TC, c.ctl + CW_CMAX + (size_t)layer * NP};
                GEMM_FLAG(2);
                PlainOrder S{TC / 256, NP / 256, c.G, c.bid, (const char*)c.act, (const char*)(c.lw + LW_WIN), (size_t)256 * D, (size_t)256 * D, 0, 1 << 20};
                pg8::gemm_phase<EpiProj, PlainOrder, false, true>(c.lds, S, E, D / 2, D / 2, c.tid);
            }
            SEAM(pb + 0); STAMP(2);
            if (EN(4) && IN(pb + 1)) { make_ctx(c, kp, layer, chunk, wave_s);
                float* lse = (float*)(c.ctl) + (WS_BRC / 4);
                if ((MIXM & 1) && c.bid < 4 * BC) gla_unit(c, c.bid, INP(5) + layer * 256, INP(6) + layer * 128);
                else if ((MIXM & 2) && c.bid < 12 * BC) lru_unit(c, c.bid - 4 * BC, INP(7) + layer * 4 * 512, INP(8) + layer * 512, INP(9) + layer * 8 * 64 * 64,
                                                    INP(10) + layer * 512, INP(11) + layer * 8 * 64 * 64, INP(12) + layer * 512, INP(13) + layer * 512);
                STAMP(12);
                unsigned* qh = c.ctl + CW_Q + 64 * 8 * c.pass;
                if (MIXM & 4) attn_loop(c, qh, MISC + 4, lse, INP(14) + layer * 128, INP(15) + layer * 128, (const bf16_t*)((const unsigned char*)(c.ctl) + WS_BRC + 4 * MiB) + (size_t)chunk * TC * 32);
            }
            SEAM(pb + 1); STAMP(4);
            if (EN(5) && IN(pb + 3)) { make_ctx(c, kp, layer, chunk, wave_s);
                MergeOrder S{c.G, c.bid, (const char*)c.proj, (const char*)(c.lw + LW_WBR)};
                phase_attn_combine(c, (const float*)(c.ctl) + (WS_BRC / 4));
                asm volatile("s_waitcnt vmcnt(0)" ::: "memory"); __syncthreads(); STAMP(11);
                LAS unsigned* rmax = (LAS unsigned*)(c.lds + MISC_OFF + 2048);
                if (c.tid < 128) rmax[c.tid] = 0u;
                EpiMerge E{c.proj, c.act, c.sbr, c.ctl + CW_CMAX3 + (size_t)layer * 3 * 1024, rmax};
                GEMM_FLAG(5);
                pg8::gemm_phase<EpiMerge, MergeOrder, false, true, true>(c.lds, S, E, 256, NP, c.tid);
                merge_rows_to_i8(c, rmax);
            }
            SEAM(pb + 3); STAMP(5);
        }
        const int pm = pl + 2 + NCH * 4;
        if (EN(6) && IN(pm - 1)) { make_ctx(c, kp, layer, 0, wave_s);
            OwnOrder S{c.bid, D / 256, (const char*)c.actf, (const char*)(c.lw + LW_WOUT), (size_t)256 * D * 2, (size_t)256 * D};
            GEMM_FLAG(6);
            const unsigned* cm4 = c.ctl + CW_CMAX4 + (size_t)layer * 1024;
            if (layer == 0) { EpiResid<false> E{(const void*)c.xinf, c.xb, c.smg, cm4}; pg8::gemm_phase<EpiResid<false>, OwnOrder, false, true>(c.lds, S, E, D / 2, D, c.tid); }
            else            { EpiResid<true>  E{(const void*)c.x2,  c.xb, c.smg, cm4}; pg8::gemm_phase<EpiResid<true>,  OwnOrder, false, true>(c.lds, S, E, D / 2, D, c.tid); }
            STAMP(6);
            phase_router(c, INP(18) + layer * D, (const float*)((const unsigned char*)(c.ctl) + WS_RW + (size_t)layer * 131072), INP(20), c.ctl + CW_CNT + CNT_LAYER * layer);
        }
        SEAM(pm + 0); STAMP(7);
        if (EN(8) && IN(pm + 1)) { make_ctx(c, kp, layer, 0, wave_s);
            moe_tables(c.ctl + CW_CNT + CNT_LAYER * layer, sPT, sLC, c.tid);
            MoeOrder<true> S{c.G, c.bid, sPT, sLC, (const char*)c.actf, (const char*)(c.lw + LW_WGU), c.list};
            EpiSwiGLU E{c.hid, c.rsl, sPT, sLC, c.ctl + CW_CMAX2 + (size_t)layer * NE * 1024};
            GEMM_FLAG(8);
            pg8::gemm_phase<EpiSwiGLU, MoeOrder<true>, true, true>(c.lds, S, E, D / 2, D / 2, c.tid);
        }
        SEAM(pm + 1); STAMP(8);
        if (EN(9) && IN(pm + 2)) { make_ctx(c, kp, layer, 0, wave_s);
            moe_tables(c.ctl + CW_CNT + CNT_LAYER * layer, sPT, sLC, c.tid);
            MoeOrder<false> S{c.G, c.bid, sPT, sLC, (const char*)c.hid, (const char*)(c.lw + LW_WDN), c.list};
            EpiStoreBf16 E{c.ys, D, 1.f / (F8_WSCALE * F8_HSCALE)};
            GEMM_FLAG(9);
            pg8::gemm_phase<EpiStoreBf16, MoeOrder<false>, false, false, false, true>(c.lds, S, E, FF / 2, FF / 2, c.tid);
        }
        SEAM(pm + 2); STAMP(9);
    }
    if (EN(10) && IN(PH_TOTAL - 1)) { make_ctx(c, kp, DEPTH - 1, 0, wave_s);
        moe_tables(c.ctl + CW_CNT + CNT_LAYER * (DEPTH - 1), sPT, sLC, c.tid);
        phase_norm1<true, false, true>(c, nullptr, sPT);
    }
    if (PROBE_MASK) {
        make_ctx(c, kp, DEPTH - 1, 0, wave_s);
        STAMP(10);
        if (blockIdx.x == PROBE_BLOCK && c.tid == 0) { unsigned sel = 0; for (int k = 0; k < 16; ++k) if ((PROBE_MASK >> k) & 1) sel += sAcc[k]; __hip_atomic_store(c.ctl + CW_Q + 64 * 40, sel, __ATOMIC_RELAXED, __HIP_MEMORY_SCOPE_AGENT); }
        { XcdBarrier _b = bar; _b.bar = c.ctl + CW_BAR; xcd_barrier(_b, c.tid); }
        const unsigned sel = __hip_atomic_load(c.ctl + CW_Q + 64 * 40, __ATOMIC_RELAXED, __HIP_MEMORY_SCOPE_AGENT);
        const unsigned long long t0 = __builtin_amdgcn_s_memrealtime();
        while (__builtin_amdgcn_s_memrealtime() - t0 < (unsigned long long)sel * PROBE_K) __builtin_amdgcn_s_sleep(8);
    }
#undef IN
#undef SEAM
}

extern "C" void kernel_launch(void* const* d_in, const int* in_sizes, int n_in, void* d_out, int out_size, void* d_ws, size_t ws_size, hipStream_t stream) {
    static int grid = 0;
    if (grid == 0) {
        if (n_in != 24 || in_sizes[0] != BATCH * SEQ * D || out_size != BATCH * SEQ * D || ws_size < WS_END) { fprintf(stderr, "kernel_launch: unexpected shapes / workspace (%zu < %zu)\n", ws_size, (size_t)WS_END); grid = -1; return; }
        int dev = 0, cus = 0;
        if (hipGetDevice(&dev) != hipSuccess || hipDeviceGetAttribute(&cus, hipDeviceAttributeMultiprocessorCount, dev) != hipSuccess || cus < 256) { fprintf(stderr, "kernel_launch: needs a 256-CU device\n"); grid = -1; return; }
        if (hipFuncSetAttribute((const void*)fwd, hipFuncAttributeMaxDynamicSharedMemorySize, LDS_BYTES) != hipSuccess) { fprintf(stderr, "kernel_launch: hipFuncSetAttribute failed\n"); grid = -1; return; }
        int per_cu = 0;
        if (hipOccupancyMaxActiveBlocksPerMultiprocessor(&per_cu, (const void*)fwd, NTHR, LDS_BYTES) != hipSuccess || per_cu < 1) fprintf(stderr, "kernel_launch: occupancy query says %d\n", per_cu);
        (void)hipGetLastError();
        grid = 256;
    }
    if (grid < 0) return;
    if (hipMemsetAsync((char*)d_ws + WS_CTL, 0, CTL_ZERO_BYTES, stream) != hipSuccess) return;
    Args a{};
    for (int i = 0; i < 24; ++i) a.in[i] = d_in[i];
    a.out = (float*)d_out; a.ws = (unsigned char*)d_ws;
#if MK_LAUNCH_PER_PHASE
    for (int k = 0; k < PH_TOTAL; ++k) { a.ph_lo = k; a.ph_hi = k + 1; hipLaunchKernelGGL(fwd, dim3(grid), dim3(NTHR), LDS_BYTES, stream, a); }
#else
    a.ph_lo = 0; a.ph_hi = PH_TOTAL;
    hipLaunchKernelGGL(fwd, dim3(grid), dim3(NTHR), LDS_BYTES, stream, a);
#endif
}
```
